# Optimizing an MI355X kernel written in HIP

```python
import math
import jax, jax.numpy as jnp
from jax import lax
import numpy as np

D_MODEL = 1024
BATCH = 8
SEQ = 4096
DEPTH = 1

CTX_LEN = 256
GRID_W = 64
D_MIX = D_MODEL
GLA_WIDTH = D_MIX // 2
GLA_HEADS = 4
GLA_DK = 64
GLA_DV = GLA_WIDTH // GLA_HEADS
GLA_QK = GLA_HEADS * GLA_DK
GLA_RANK = 16
GLA_GATE_NORM = 16.0
GLA_CHUNK = 64
S5_WIDTH = D_MIX - GLA_WIDTH
S5_CH = 16
S5_GROUPS = S5_WIDTH // S5_CH
S5_STATE = 64
N_EXPERTS = 32
TOP_K = 4
D_FF = D_MODEL
SWIGLU_ALPHA = 1.702
SWIGLU_LIMIT = 7.0
MOE_BLOCK = 128
EPS = 1e-6
IN_SPLITS = (GLA_QK, 2 * GLA_QK, 2 * GLA_QK + GLA_WIDTH, 2 * GLA_QK + 2 * GLA_WIDTH,
             2 * GLA_QK + 2 * GLA_WIDTH + 2 * GLA_RANK)
IN_COLS = IN_SPLITS[-1] + S5_WIDTH

kernel_name = "hybrid_gla_s5_moe_prefix_dit"


def rms_norm(x, w):
    xf = x.astype(jnp.float32)
    y = xf * lax.rsqrt(jnp.mean(xf * xf, axis=-1, keepdims=True) + EPS)
    return (y * w.astype(jnp.float32)).astype(x.dtype)


def modulate(h, shift, scale):
    return h * (1 + scale) + shift


def to_cols(t):
    b, l, ch = t.shape
    rows = l // GRID_W
    return t.reshape(b, rows, GRID_W, ch).transpose(0, 2, 1, 3).reshape(b, l, ch)


def from_cols(t):
    b, l, ch = t.shape
    rows = l // GRID_W
    return t.reshape(b, GRID_W, rows, ch).transpose(0, 2, 1, 3).reshape(b, l, ch)


def gla_chunked(q, k, v, log_a, s0):
    b, h, l, _ = q.shape
    dv = v.shape[-1]
    n = l // GLA_CHUNK

    def chunks(t):
        return jnp.moveaxis(t.reshape(b, h, n, GLA_CHUNK, t.shape[-1]), 2, 0)

    mask = jnp.tril(jnp.ones((GLA_CHUNK, GLA_CHUNK), dtype=bool))[:, :, None]

    def step(S, inp):
        qc, kc, vc, lac = inp
        cum = jnp.cumsum(lac, axis=2)
        inter = jnp.einsum('bhid,bhde->bhie', qc * jnp.exp(cum), S)
        diff = cum[:, :, :, None, :] - cum[:, :, None, :, :]
        decay = jnp.exp(jnp.where(mask, diff, -jnp.inf))
        scores = jnp.sum(qc[:, :, :, None, :] * kc[:, :, None, :, :] * decay, axis=-1)
        intra = jnp.einsum('bhij,bhje->bhie', scores, vc)
        last = cum[:, :, -1:, :]
        S_new = jnp.exp(last[:, :, 0, :])[..., None] * S + jnp.einsum(
            'bhjd,bhje->bhde', kc * jnp.exp(last - cum), vc)
        return S_new, inter + intra

    s_fin, o = lax.scan(step, s0, (chunks(q), chunks(k), chunks(v), chunks(log_a)))
    return jnp.moveaxis(o, 0, 2).reshape(b, h, l, dv), s_fin


def gla_prep(p, lr_up, lr_bias):
    q, k, v, r, lr, u = jnp.split(p, IN_SPLITS, axis=-1)
    b, l, _ = p.shape

    def heads(t, d):
        return t.reshape(b, l, GLA_HEADS, d).transpose(0, 2, 1, 3).astype(jnp.float32)

    g = jnp.einsum('blzr,zrk->zblk', lr.reshape(b, l, 2, GLA_RANK), lr_up) + lr_bias[:, None, None, :]
    log_a = jax.nn.log_sigmoid(g.astype(jnp.float32)) / GLA_GATE_NORM
    log_a = log_a.reshape(2, b, l, GLA_HEADS, GLA_DK).transpose(0, 1, 3, 2, 4)
    return heads(q, GLA_DK) * (GLA_DK ** -0.5), heads(k, GLA_DK), heads(v, GLA_DV), log_a, r, u


def gla_bidir(q, k, v, log_a, s0_f, s0_b):
    o_f, s_f = gla_chunked(q, k, v, log_a[0], s0_f)
    o_b, s_b = gla_chunked(jnp.flip(q, 2), jnp.flip(k, 2), jnp.flip(v, 2), jnp.flip(log_a[1], 2), s0_b)
    return o_f + jnp.flip(o_b, 2), s_f, s_b


def gla_output(o, r, norm_w):
    on = o * lax.rsqrt(jnp.mean(o * o, axis=-1, keepdims=True) + EPS) * norm_w.astype(jnp.float32)
    b, h, l, dv = o.shape
    on = on.transpose(0, 2, 1, 3).reshape(b, l, h * dv).astype(r.dtype)
    return on * jax.nn.silu(r)


def s5_discretize(lam_re, lam_im, log_dt, b_re, b_im, c_re, c_im):
    lam = lax.complex(lam_re.astype(jnp.float32), lam_im.astype(jnp.float32))
    dt = jnp.exp(log_dt.astype(jnp.float32))[:, None]
    lam_bar = jnp.exp(lam * dt)
    b_mat = lax.complex(b_re.astype(jnp.float32), b_im.astype(jnp.float32))
    b_bar = ((lam_bar - 1) / lam)[..., None] * b_mat
    c_mat = lax.complex(c_re.astype(jnp.float32), c_im.astype(jnp.float32))
    return lam_bar, b_bar, c_mat


def s5_states(u, lam_bar, b_bar, h0):
    b, l, _ = u.shape
    uc = u.astype(jnp.float32).reshape(b, l, S5_GROUPS, S5_CH).astype(jnp.complex64)
    bu = jnp.einsum('blgh,gph->lbgp', uc, b_bar)
    bu = bu.at[0].add(lam_bar * h0)
    a = jnp.broadcast_to(lam_bar[None, None], (l, 1) + lam_bar.shape)

    def combine(e1, e2):
        a1, b1 = e1
        a2, b2 = e2
        return a1 * a2, a2 * b1 + b2

    _, states = lax.associative_scan(combine, (a, bu), axis=0)
    return states


def s5_readout(states, c_mat):
    l, b = states.shape[:2]
    return jnp.real(jnp.einsum('lbgp,ghp->blgh', states, c_mat)).reshape(b, l, S5_WIDTH)


def s5_glu(y, u, d, glu_w, glu_b):
    y = y.astype(u.dtype) + d * u
    y = jax.nn.gelu(y)
    return y * jax.nn.sigmoid(y @ glu_w + glu_b)


def token_mixers(h_lat, h_ctx, w_in, lr_up, lr_bias, gla_norm_w, lam_re, lam_im, log_dt,
                 b_re, b_im, c_re, c_im, s5_d, glu_w, glu_b, w_out, need_ctx_out):
    q, k, v, la, r, u = gla_prep(h_lat @ w_in, lr_up, lr_bias)
    qc, kc, vc, lac, rc, uc = gla_prep(h_ctx @ w_in, lr_up, lr_bias)
    b = h_ctx.shape[0]

    z = jnp.zeros((b, GLA_HEADS, GLA_DK, GLA_DV), jnp.float32)
    o_c, sc_f, sc_b = gla_bidir(qc, kc, vc, lac, z, z)
    o_l, _, _ = gla_bidir(q, k, v, la, sc_f, sc_b)
    gla_lat = gla_output(o_l, r, gla_norm_w)

    disc = [s5_discretize(lam_re[d], lam_im[d], log_dt[d], b_re[d], b_im[d], c_re[d], c_im[d])
            for d in range(2)]
    h0 = jnp.zeros((b, S5_GROUPS, S5_STATE), jnp.complex64)
    st_cf = s5_states(uc, disc[0][0], disc[0][1], h0)
    st_cb = s5_states(jnp.flip(uc, 1), disc[1][0], disc[1][1], h0)
    ul = to_cols(u)
    st_f = s5_states(ul, disc[0][0], disc[0][1], st_cf[-1])
    st_b = s5_states(jnp.flip(ul, 1), disc[1][0], disc[1][1], st_cb[-1])
    y = s5_readout(st_f, disc[0][2]) + jnp.flip(s5_readout(st_b, disc[1][2]), 1)
    s5_lat = from_cols(s5_glu(y, ul, s5_d, glu_w, glu_b))

    mix_lat = jnp.concatenate([gla_lat, s5_lat], axis=-1) @ w_out
    if not need_ctx_out:
        return mix_lat, None
    gla_ctx = gla_output(o_c, rc, gla_norm_w)
    yc = s5_readout(st_cf, disc[0][2]) + jnp.flip(s5_readout(st_cb, disc[1][2]), 1)
    s5_ctx = s5_glu(yc, uc, s5_d, glu_w, glu_b)
    mix_ctx = jnp.concatenate([gla_ctx, s5_ctx], axis=-1) @ w_out
    return mix_lat, mix_ctx


def moe_ffn(h, router_w, router_b, w_gu, b_gu, w_down, b_down):
    n = h.shape[0]
    logits = (h @ router_w + router_b).astype(jnp.float32)
    top_val, top_idx = lax.top_k(logits, TOP_K)
    gate = jax.nn.softmax(top_val, axis=-1).astype(h.dtype)
    flat_e = top_idx.reshape(-1)
    flat_tok = jnp.repeat(jnp.arange(n, dtype=jnp.int32), TOP_K)
    flat_w = gate.reshape(-1)
    order = jnp.argsort(flat_e)
    se, stok, sw = flat_e[order], flat_tok[order], flat_w[order]
    counts = jnp.bincount(flat_e, length=N_EXPERTS)
    start = jnp.cumsum(counts) - counts
    padded = ((counts + MOE_BLOCK - 1) // MOE_BLOCK) * MOE_BLOCK
    pend = jnp.cumsum(padded)
    pstart = pend - padded
    dest = pstart[se] + (jnp.arange(n * TOP_K) - start[se])
    n_blocks = -(-(n * TOP_K) // MOE_BLOCK) + N_EXPERTS
    p_rows = n_blocks * MOE_BLOCK
    tok_buf = jnp.zeros((p_rows,), jnp.int32).at[dest].set(stok)
    w_buf = jnp.zeros((p_rows,), h.dtype).at[dest].set(sw)
    blk_expert = jnp.minimum(
        jnp.searchsorted(pend, jnp.arange(n_blocks) * MOE_BLOCK, side='right'), N_EXPERTS - 1)

    def expert_block(args):
        tok, e = args
        xb = h[tok]
        gu = xb @ w_gu[e] + b_gu[e]
        g, lin = jnp.split(gu, 2, axis=-1)
        g = jnp.minimum(g, SWIGLU_LIMIT)
        lin = jnp.clip(lin, -SWIGLU_LIMIT, SWIGLU_LIMIT)
        act = (lin + 1) * (g * jax.nn.sigmoid(SWIGLU_ALPHA * g))
        return act @ w_down[e] + b_down[e]

    ys = lax.map(expert_block, (tok_buf.reshape(n_blocks, MOE_BLOCK), blk_expert))
    return jnp.zeros_like(h).at[tok_buf].add(ys.reshape(p_rows, -1) * w_buf[:, None])


def setup_inputs(seed: int = 0) -> dict:
    key = jax.random.key(seed)
    ks = jax.random.split(key, 32)
    f32 = jnp.float32
    D, L, G, P, H = DEPTH, D_MODEL, S5_GROUPS, S5_STATE, S5_CH
    nrm = lambda k, shape, s: (jax.random.normal(k, shape, f32) * s)
    gain = lambda k, shape: 1.0 + 0.01 * jax.random.normal(k, shape, f32)
    lam_im = jnp.pi * jnp.arange(P, dtype=f32)
    return {
        'x': nrm(ks[0], (BATCH, SEQ, L), 1.0),
        'c': nrm(ks[1], (BATCH, L), 1.0),
        'ctx': nrm(ks[2], (BATCH, CTX_LEN, L), 1.0),
        'c_ctx': nrm(ks[3], (L,), 1.0),
        'ada_w': nrm(ks[4], (D, L, 6 * L), 0.5 * L ** -0.5),
        'ada_b': nrm(ks[5], (D, 6 * L), 0.02),
        'norm_mix_w': gain(ks[6], (D, L)),
        'w_in': nrm(ks[7], (D, L, IN_COLS), L ** -0.5),
        'gla_lr_up': nrm(ks[8], (D, 2, GLA_RANK, GLA_QK), GLA_RANK ** -0.5),
        'gla_lr_bias': nrm(ks[9], (D, 2, GLA_QK), 0.1),
        'gla_norm_w': gain(ks[10], (D, GLA_DV)),
        's5_lam_re': -0.5 + 0.01 * jax.random.normal(ks[11], (D, 2, G, P), f32),
        's5_lam_im': lam_im + 0.01 * jax.random.normal(ks[12], (D, 2, G, P), f32),
        's5_log_dt': jax.random.uniform(ks[13], (D, 2, G), f32, math.log(1e-3), math.log(1e-1)),
        's5_b_re': nrm(ks[14], (D, 2, G, P, H), (2 * H) ** -0.5),
        's5_b_im': nrm(ks[15], (D, 2, G, P, H), (2 * H) ** -0.5),
        's5_c_re': nrm(ks[16], (D, 2, G, H, P), (2 * P) ** -0.5),
        's5_c_im': nrm(ks[17], (D, 2, G, H, P), (2 * P) ** -0.5),
        's5_d': nrm(ks[18], (D, S5_WIDTH), 1.0),
        'glu_w': nrm(ks[19], (D, S5_WIDTH, S5_WIDTH), S5_WIDTH ** -0.5),
        'glu_b': nrm(ks[20], (D, S5_WIDTH), 0.01),
        'w_out': nrm(ks[21], (D, D_MIX, L), D_MIX ** -0.5),
        'norm_ffn_w': gain(ks[22], (D, L)),
        'router_w': nrm(ks[23], (D, L, N_EXPERTS), L ** -0.5),
        'router_b': nrm(ks[24], (D, N_EXPERTS), 0.01),
        'exp_w_gu': nrm(ks[25], (D, N_EXPERTS, L, 2 * D_FF), L ** -0.5),
        'exp_b_gu': nrm(ks[26], (D, N_EXPERTS, 2 * D_FF), 0.01),
        'exp_w_down': nrm(ks[27], (D, N_EXPERTS, D_FF, L), D_FF ** -0.5),
        'exp_b_down': nrm(ks[28], (D, N_EXPERTS, L), 0.01),
        'final_norm_w': gain(ks[29], (L,)),
    }


def reference(x, c, ctx, c_ctx, ada_w, ada_b, norm_mix_w, w_in, gla_lr_up, gla_lr_bias, gla_norm_w,
              s5_lam_re, s5_lam_im, s5_log_dt, s5_b_re, s5_b_im, s5_c_re, s5_c_im, s5_d, glu_w, glu_b,
              w_out, norm_ffn_w, router_w, router_b, exp_w_gu, exp_b_gu, exp_w_down, exp_b_down,
              final_norm_w):
    bsz, seq, dm = x.shape
    for layer in range(DEPTH):
        need_ctx = layer < DEPTH - 1
        mod = jax.nn.silu(c) @ ada_w[layer] + ada_b[layer]
        mod_c = jax.nn.silu(c_ctx) @ ada_w[layer] + ada_b[layer]
        sh1, sc1, g1, sh2, sc2, g2 = jnp.split(mod[:, None, :], 6, axis=-1)
        csh1, csc1, cg1, csh2, csc2, cg2 = jnp.split(mod_c, 6, axis=-1)

        h = modulate(rms_norm(x, norm_mix_w[layer]), sh1, sc1)
        hc = modulate(rms_norm(ctx, norm_mix_w[layer]), csh1, csc1)
        mix, mix_c = token_mixers(h, hc, w_in[layer], gla_lr_up[layer], gla_lr_bias[layer],
                                  gla_norm_w[layer], s5_lam_re[layer], s5_lam_im[layer],
                                  s5_log_dt[layer], s5_b_re[layer], s5_b_im[layer], s5_c_re[layer],
                                  s5_c_im[layer], s5_d[layer], glu_w[layer], glu_b[layer],
                                  w_out[layer], need_ctx)
        x = x + g1 * mix
        h2 = modulate(rms_norm(x, norm_ffn_w[layer]), sh2, sc2)
        ff = moe_ffn(h2.reshape(bsz * seq, dm), router_w[layer], router_b[layer], exp_w_gu[layer],
                     exp_b_gu[layer], exp_w_down[layer], exp_b_down[layer])
        x = x + g2 * ff.reshape(bsz, seq, dm)
        if need_ctx:
            ctx = ctx + cg1 * mix_c
            hc2 = modulate(rms_norm(ctx, norm_ffn_w[layer]), csh2, csc2)
            ffc = moe_ffn(hc2.reshape(-1, dm), router_w[layer], router_b[layer], exp_w_gu[layer],
                          exp_b_gu[layer], exp_w_down[layer], exp_b_down[layer])
            ctx = ctx + cg2 * ffc.reshape(ctx.shape)
    return rms_norm(x, final_norm_w)
```

```cpp
#include <hip/hip_runtime.h>
#include <stdint.h>
#include <stdio.h>

typedef unsigned short bf16_t;
#define DEVI __device__ __forceinline__

constexpr int NB = 8, SEQ = 4096, DM = 1024, CTX = 256;
constexpr int NTOK = NB * SEQ;
constexpr int NCTX = NB * CTX;
constexpr int NROWS = NTOK + NCTX;
constexpr int INC = 2080, INP = 2304;
constexpr int NEXP = 32, TOPK = 4, DFF = 1024;
constexpr int LISTCAP = NTOK;
constexpr int MOEPAD = 256;

constexpr size_t MiB = 1024ull * 1024ull;
constexpr size_t OFF_CTL = 0;
constexpr size_t OFF_MOD = 64 * 1024;
constexpr size_t OFF_S5P = OFF_MOD + 256 * 1024;
constexpr size_t OFF_GATE = OFF_S5P + 1 * MiB;
constexpr size_t OFF_LIST = OFF_GATE + 512 * 1024;
constexpr size_t OFF_WIN = OFF_LIST + 4 * MiB;
constexpr size_t OFF_WGLU = OFF_WIN + (size_t)INP * DM * 2;
constexpr size_t OFF_WOUT = OFF_WGLU + 512 * 512 * 2;
constexpr size_t OFF_WG = OFF_WOUT + (size_t)DM * DM * 2;
constexpr size_t OFF_WD = OFF_WG + (size_t)NEXP * 2048 * DM * 2;
constexpr size_t OFF_S5BF = OFF_WD + (size_t)NEXP * DM * DFF * 2;
constexpr size_t OFF_S5BY = OFF_S5BF + (size_t)32 * 256 * 256 * 2;
constexpr size_t OFF_H = OFF_S5BY + (size_t)32 * 256 * 512 * 2;
constexpr size_t OFF_RA = OFF_H + (size_t)NROWS * DM * 2;
constexpr size_t OFF_QK = OFF_RA;
constexpr size_t OFF_V = OFF_QK + (size_t)NROWS * 512 * 2;
constexpr size_t OFF_R = OFF_V + (size_t)NROWS * 512 * 2;
constexpr size_t OFF_UT = OFF_R + (size_t)NROWS * 512 * 2;
constexpr size_t OFF_LR = OFF_UT + (size_t)NROWS * 512 * 2;
constexpr size_t OFF_U2 = OFF_LR + (size_t)NROWS * 32 * 4;
constexpr size_t OFF_OF = OFF_U2 + (size_t)32 * 2304 * 512 * 2;
constexpr size_t OFF_OB = OFF_OF + (size_t)NTOK * 512 * 4;
constexpr size_t OFF_YF = OFF_OB + (size_t)NTOK * 512 * 4;
constexpr size_t OFF_YB = OFF_YF + (size_t)NTOK * 512 * 4;
constexpr size_t OFF_YS = OFF_YB + (size_t)NTOK * 512 * 4;
constexpr size_t OFF_MIX = OFF_YS + (size_t)NTOK * 512 * 2;
constexpr size_t OFF_RA_END = OFF_MIX + (size_t)NTOK * DM * 2;
constexpr int ACT_ROWS = NTOK * TOPK + NEXP * MOEPAD;
constexpr size_t OFF_ACT = OFF_RA;
constexpr size_t OFF_YSL = OFF_ACT + (size_t)ACT_ROWS * DFF * 2;
constexpr size_t OFF_END2 = OFF_YSL + (size_t)NTOK * TOPK * DM * 2;
constexpr size_t WS_NEED = OFF_RA_END > OFF_END2 ? OFF_RA_END : OFF_END2;
static_assert(WS_NEED <= 1024 * MiB, "workspace map exceeds 1 GiB");

constexpr int CW_CNT = 1024;
constexpr int CW_OFFS = 1088;

DEVI float bf2f(bf16_t b) { return __uint_as_float(((unsigned)b) << 16); }
DEVI bf16_t f2bf(float f) { unsigned u = __float_as_uint(f); u += 0x7fffu + ((u >> 16) & 1u); return (bf16_t)(u >> 16); }
DEVI unsigned pk2(float lo, float hi) { return (unsigned)f2bf(lo) | ((unsigned)f2bf(hi) << 16); }
DEVI float wave_sum(float v) {
#pragma unroll
    for (int o = 1; o < 64; o <<= 1) v += __shfl_xor(v, o);
    return v;
}
DEVI float sigmoidf_(float x) { return 1.f / (1.f + __expf(-x)); }
DEVI float siluf_(float x) { return x / (1.f + __expf(-x)); }
DEVI float logsigmoidf_(float g) { return fminf(g, 0.f) - log1pf(__expf(-fabsf(g))); }
DEVI float gelu_tanh(float x) { const float u = 0.7978845608028654f * (x + 0.044715f * x * x * x); return 0.5f * x * (1.f + tanhf(u)); }

__global__ __launch_bounds__(256) void k_mod(const float* __restrict__ c, const float* __restrict__ c_ctx, const float* __restrict__ ada_w,
                                             const float* __restrict__ ada_b, float* __restrict__ mod) {
    __shared__ float s[9][1024];
    for (int i = threadIdx.x; i < 9 * 1024; i += 256) { const int r = i >> 10, k = i & 1023; const float v = r < 8 ? c[r * 1024 + k] : c_ctx[k]; s[r][k] = siluf_(v); }
    __syncthreads();
    const int j = blockIdx.x * 256 + threadIdx.x;
    float acc[9];
#pragma unroll
    for (int r = 0; r < 9; ++r) acc[r] = 0.f;
    for (int k = 0; k < 1024; ++k) { const float w = ada_w[(size_t)k * 6144 + j];
#pragma unroll
        for (int r = 0; r < 9; ++r) acc[r] += s[r][k] * w; }
    const float bb = ada_b[j];
#pragma unroll
    for (int r = 0; r < 9; ++r) mod[r * 6144 + j] = acc[r] + bb;
}

template <int MODE> DEVI int wsrc_col(int nd) { if (MODE == 1) { const int q = nd >> 3, i = nd & 7; return i < 4 ? 4 * q + i : 1024 + 4 * q + (i - 4); } return nd; }
template <int MODE> __global__ __launch_bounds__(256) void k_wconv(const float* __restrict__ src, bf16_t* __restrict__ dst, int K, int N, int Nd) {
    __shared__ float t[64][65];
    const int e = blockIdx.z; src += (size_t)e * K * N; dst += (size_t)e * Nd * K;
    const int n0 = blockIdx.x * 64, k0 = blockIdx.y * 64, tid = threadIdx.x, nl = tid & 63, kq = tid >> 6;
    const int nd = n0 + nl, sc = wsrc_col<MODE>(nd); const bool valid = sc < N;
#pragma unroll 4
    for (int i = 0; i < 16; ++i) { const int kk = kq + 4 * i; t[kk][nl] = valid ? src[(size_t)(k0 + kk) * N + sc] : 0.f; }
    __syncthreads();
#pragma unroll
    for (int i = 0; i < 2; ++i) { const int ch = tid + 256 * i, n = ch >> 3, c8 = ch & 7;
        uint4 o; o.x = pk2(t[c8 * 8 + 0][n], t[c8 * 8 + 1][n]); o.y = pk2(t[c8 * 8 + 2][n], t[c8 * 8 + 3][n]); o.z = pk2(t[c8 * 8 + 4][n], t[c8 * 8 + 5][n]); o.w = pk2(t[c8 * 8 + 6][n], t[c8 * 8 + 7][n]);
        *(uint4*)(dst + (size_t)(n0 + n) * K + k0 + c8 * 8) = o; }
}

struct S5P { float lamb[2][32][64][2]; float bbar[2][32][64][16][2]; };
__global__ void k_s5prep(const float* lam_re, const float* lam_im, const float* log_dt, const float* b_re, const float* b_im, S5P* P) {
    const int i = blockIdx.x * blockDim.x + threadIdx.x; if (i >= 2 * 32 * 64) return;
    const int p = i & 63, g = (i >> 6) & 31, d = i >> 11;
    const double dt = exp((double)log_dt[d * 32 + g]);
    const double lr = lam_re[i], li = lam_im[i];
    const double mag = exp(lr * dt), ar = mag * cos(li * dt), ai = mag * sin(li * dt);
    const double nr = ar - 1.0, ni = ai, den = lr * lr + li * li;
    const double cr = (nr * lr + ni * li) / den, ci = (ni * lr - nr * li) / den;
    P->lamb[d][g][p][0] = (float)ar; P->lamb[d][g][p][1] = (float)ai;
    for (int h = 0; h < 16; ++h) { const double br = b_re[(size_t)i * 16 + h], bi = b_im[(size_t)i * 16 + h];
        P->bbar[d][g][p][h][0] = (float)(cr * br - ci * bi); P->bbar[d][g][p][h][1] = (float)(cr * bi + ci * br); }
}

__global__ __launch_bounds__(256) void k_norm(const float* __restrict__ x, const float* __restrict__ ctx, const float* __restrict__ w, const float* __restrict__ mod,
                                              bf16_t* __restrict__ H, int nrows, int sh_off, int sc_off) {
    const int row = blockIdx.x * 4 + (threadIdx.x >> 6), lane = threadIdx.x & 63; if (row >= nrows) return;
    const float* src; int b;
    if (row < NTOK) { src = x + (size_t)row * DM; b = row / SEQ; } else { src = ctx + (size_t)(row - NTOK) * DM; b = 8; }
    float4 v[4]; float ss = 0.f;
#pragma unroll
    for (int j = 0; j < 4; ++j) { v[j] = *(const float4*)(src + lane * 4 + 256 * j); ss += v[j].x * v[j].x + v[j].y * v[j].y + v[j].z * v[j].z + v[j].w * v[j].w; }
    const float rstd = rsqrtf(wave_sum(ss) * (1.f / DM) + 1e-6f);
    const float* msh = mod + b * 6144 + sh_off; const float* msc = mod + b * 6144 + sc_off;
#pragma unroll
    for (int j = 0; j < 4; ++j) { const int k = lane * 4 + 256 * j;
        const float4 ww = *(const float4*)(w + k), sc = *(const float4*)(msc + k), sh = *(const float4*)(msh + k);
        uint2 o; o.x = pk2(v[j].x * rstd * ww.x * (1.f + sc.x) + sh.x, v[j].y * rstd * ww.y * (1.f + sc.y) + sh.y);
        o.y = pk2(v[j].z * rstd * ww.z * (1.f + sc.z) + sh.z, v[j].w * rstd * ww.w * (1.f + sc.w) + sh.w);
        *(uint2*)(H + (size_t)row * DM + k) = o; }
}

template <class Prob> __global__ __launch_bounds__(256) void k_gemm_naive(Prob P) {
    __shared__ float As[32][68], Bs[32][68];
    const int z = blockIdx.z, M = P.M(z), r0 = blockIdx.y * 64, c0 = blockIdx.x * 64; if (r0 >= M) return;
    const int tid = threadIdx.x, tx = tid & 7, ty = tid >> 3, K = P.K;
    const int lr = tid >> 2, lk = (tid & 3) * 8;
    const bool arow_ok = (r0 + lr) < M;
    const bf16_t* ap = P.A + (size_t)(arow_ok ? P.arow(z, r0 + lr) : 0) * P.lda + lk;
    const bf16_t* bp = P.Bt(z) + (size_t)(c0 + lr) * P.ldb + lk;
    float acc[2][8];
#pragma unroll
    for (int i = 0; i < 2; ++i)
#pragma unroll
        for (int j = 0; j < 8; ++j) acc[i][j] = 0.f;
    for (int k0 = 0; k0 < K; k0 += 32) {
        uint4 av = arow_ok ? *(const uint4*)(ap + k0) : make_uint4(0, 0, 0, 0); const uint4 bv = *(const uint4*)(bp + k0);
        const unsigned aw[4] = {av.x, av.y, av.z, av.w}, bw[4] = {bv.x, bv.y, bv.z, bv.w};
        __syncthreads();
#pragma unroll
        for (int j = 0; j < 4; ++j) { As[lk + 2 * j][lr] = __uint_as_float(aw[j] << 16); As[lk + 2 * j + 1][lr] = __uint_as_float(aw[j] & 0xffff0000u);
            Bs[lk + 2 * j][lr] = __uint_as_float(bw[j] << 16); Bs[lk + 2 * j + 1][lr] = __uint_as_float(bw[j] & 0xffff0000u); }
        __syncthreads();
#pragma unroll 8
        for (int k = 0; k < 32; ++k) { const float a0 = As[k][ty * 2], a1 = As[k][ty * 2 + 1];
            const float4 b0 = *(const float4*)&Bs[k][tx * 8], b1 = *(const float4*)&Bs[k][tx * 8 + 4];
            const float bb[8] = {b0.x, b0.y, b0.z, b0.w, b1.x, b1.y, b1.z, b1.w};
#pragma unroll
            for (int j = 0; j < 8; ++j) { acc[0][j] += a0 * bb[j]; acc[1][j] += a1 * bb[j]; } }
    }
#pragma unroll
    for (int i = 0; i < 2; ++i) { const int r = r0 + ty * 2 + i; if (r < M) P.store(z, r, c0 + tx * 8, acc[i]); }
}

struct ProbIn {
    const bf16_t* A; int lda; const bf16_t* B; int ldb; int K; bf16_t *QK, *V, *R, *UT, *U2; float* LR;
    DEVI int M(int) const { return NROWS; }
    DEVI int arow(int, int r) const { return r; }
    DEVI const bf16_t* Bt(int) const { return B; }
    DEVI void store(int, int r, int c0, const float (&v)[8]) const {
        if (c0 >= INC) return;
        uint4 o; o.x = pk2(v[0], v[1]); o.y = pk2(v[2], v[3]); o.z = pk2(v[4], v[5]); o.w = pk2(v[6], v[7]);
        if (c0 < 512) { *(uint4*)(QK + (size_t)r * 512 + c0) = o; }
        else if (c0 < 1024) { *(uint4*)(V + (size_t)r * 512 + (c0 - 512)) = o; }
        else if (c0 < 1536) { *(uint4*)(R + (size_t)r * 512 + (c0 - 1024)) = o; }
        else if (c0 < 1568) { float* p = LR + (size_t)r * 32 + (c0 - 1536); *(float4*)p = make_float4(v[0], v[1], v[2], v[3]); *(float4*)(p + 4) = make_float4(v[4], v[5], v[6], v[7]); }
        else { const int j = c0 - 1568; *(uint4*)(UT + (size_t)r * 512 + j) = o;
            const int g = j >> 4, ch = j & 15; int urow, ucol;
            if (r < NTOK) { const int b = r >> 12, n = r & 4095, gr = n >> 6, gc = n & 63, s = gc * 64 + gr; urow = b * 256 + (s >> 4); ucol = (s & 15) * 16 + ch; }
            else { const int q = r - NTOK, b = q >> 8, t = q & 255; urow = 2048 + b * 16 + (t >> 4); ucol = (t & 15) * 16 + ch; }
            *(uint4*)(U2 + ((size_t)g * 2304 + urow) * 512 + ucol) = o; }
    }
};
struct ProbGlu {
    const bf16_t* A; int lda; const bf16_t* B; int ldb; int K; const float* bias; bf16_t* MIX;
    DEVI int M(int) const { return NTOK; }
    DEVI int arow(int, int r) const { return r; }
    DEVI const bf16_t* Bt(int) const { return B; }
    DEVI void store(int, int r, int c0, const float (&v)[8]) const {
        const uint4 yv = *(const uint4*)(A + (size_t)r * lda + c0); const unsigned yw[4] = {yv.x, yv.y, yv.z, yv.w}; float o[8];
#pragma unroll
        for (int j = 0; j < 4; ++j) { const float y0 = __uint_as_float(yw[j] << 16), y1 = __uint_as_float(yw[j] & 0xffff0000u);
            o[2 * j] = y0 * sigmoidf_(v[2 * j] + bias[c0 + 2 * j]); o[2 * j + 1] = y1 * sigmoidf_(v[2 * j + 1] + bias[c0 + 2 * j + 1]); }
        uint4 w; w.x = pk2(o[0], o[1]); w.y = pk2(o[2], o[3]); w.z = pk2(o[4], o[5]); w.w = pk2(o[6], o[7]);
        *(uint4*)(MIX + (size_t)r * DM + 512 + c0) = w;
    }
};
struct ProbOut {
    const bf16_t* A; int lda; const bf16_t* B; int ldb; int K; const float* x; const float* mod; float* X1;
    DEVI int M(int) const { return NTOK; }
    DEVI int arow(int, int r) const { return r; }
    DEVI const bf16_t* Bt(int) const { return B; }
    DEVI void store(int, int r, int c0, const float (&v)[8]) const {
        const float* g1 = mod + (r >> 12) * 6144 + 2048 + c0; const float* xp = x + (size_t)r * DM + c0; float* op = X1 + (size_t)r * DM + c0;
        const float4 x0 = *(const float4*)xp, x1 = *(const float4*)(xp + 4), ga = *(const float4*)g1, gb = *(const float4*)(g1 + 4);
        *(float4*)op = make_float4(x0.x + ga.x * v[0], x0.y + ga.y * v[1], x0.z + ga.z * v[2], x0.w + ga.w * v[3]);
        *(float4*)(op + 4) = make_float4(x1.x + gb.x * v[4], x1.y + gb.y * v[5], x1.z + gb.z * v[6], x1.w + gb.w * v[7]);
    }
};
struct ProbMoe1 {
    const bf16_t* A; int lda; const bf16_t* B; int ldb; int K; const int* cnt; const int* offs; const int* list; const float* b_gu; bf16_t* ACT;
    DEVI int M(int z) const { return cnt[z]; }
    DEVI int arow(int z, int r) const { return list[z * LISTCAP + r] >> 2; }
    DEVI const bf16_t* Bt(int z) const { return B + (size_t)z * 2048 * DM; }
    DEVI void store(int z, int r, int c0, const float (&v)[8]) const {
        const int f0 = (c0 >> 3) * 4; const float* bg = b_gu + (size_t)z * 2048 + f0; float a[4];
#pragma unroll
        for (int i = 0; i < 4; ++i) { float g = v[i] + bg[i], l = v[4 + i] + bg[1024 + i]; g = fminf(g, 7.f); l = fminf(fmaxf(l, -7.f), 7.f); a[i] = (l + 1.f) * (g * sigmoidf_(1.702f * g)); }
        uint2 o; o.x = pk2(a[0], a[1]); o.y = pk2(a[2], a[3]);
        *(uint2*)(ACT + (size_t)(offs[z] + r) * DFF + f0) = o;
    }
};
struct ProbMoe2 {
    const bf16_t* A; int lda; const bf16_t* B; int ldb; int K; const int* cnt; const int* offs; const int* list; const float* b_down; const float* gate; bf16_t* YSL;
    DEVI int M(int z) const { return cnt[z]; }
    DEVI int arow(int z, int r) const { return offs[z] + r; }
    DEVI const bf16_t* Bt(int z) const { return B + (size_t)z * DM * DFF; }
    DEVI void store(int z, int r, int c0, const float (&v)[8]) const {
        const int ent = list[z * LISTCAP + r]; const float gt = gate[ent]; const float* bd = b_down + (size_t)z * DM + c0;
        uint4 o; o.x = pk2((v[0] + bd[0]) * gt, (v[1] + bd[1]) * gt); o.y = pk2((v[2] + bd[2]) * gt, (v[3] + bd[3]) * gt);
        o.z = pk2((v[4] + bd[4]) * gt, (v[5] + bd[5]) * gt); o.w = pk2((v[6] + bd[6]) * gt, (v[7] + bd[7]) * gt);
        *(uint4*)(YSL + (size_t)ent * DM + c0) = o;
    }
};

__global__ __launch_bounds__(512) void k_gla_naive(const bf16_t* __restrict__ QK, const bf16_t* __restrict__ V, const float* __restrict__ LR, const float* __restrict__ lr_up,
                                                   const float* __restrict__ lr_bias, float* __restrict__ OF, float* __restrict__ OB) {
    __shared__ float sq[64], sk[64], sa[64], sv[128], red[4][128];
    const int dir = blockIdx.x & 1, hh = (blockIdx.x >> 1) & 3, b = blockIdx.x >> 3, tid = threadIdx.x, e = tid & 127, dg = tid >> 7;
    float up[16]; float bias = 0.f;
    if (tid < 64) { for (int r = 0; r < 16; ++r) up[r] = lr_up[dir * 4096 + r * 256 + hh * 64 + tid]; bias = lr_bias[dir * 256 + hh * 64 + tid]; }
    float S[16];
#pragma unroll
    for (int i = 0; i < 16; ++i) S[i] = 0.f;
    float* O = dir ? OB : OF;
    for (int step = 0; step < CTX + SEQ; ++step) {
        int row;
        if (step < CTX) row = NTOK + b * CTX + (dir ? CTX - 1 - step : step);
        else { const int t = step - CTX; row = b * SEQ + (dir ? SEQ - 1 - t : t); }
        if (tid < 64) { const float* lp = LR + (size_t)row * 32 + dir * 16; float g = bias;
#pragma unroll
            for (int r = 0; r < 16; ++r) g += lp[r] * up[r];
            sa[tid] = __expf(logsigmoidf_(g) * (1.f / 16.f));
            sq[tid] = bf2f(QK[(size_t)row * 512 + hh * 64 + tid]) * 0.125f; sk[tid] = bf2f(QK[(size_t)row * 512 + 256 + hh * 64 + tid]); }
        else if (tid < 192) sv[tid - 64] = bf2f(V[(size_t)row * 512 + hh * 128 + (tid - 64)]);
        __syncthreads();
        const float v = sv[e]; float part = 0.f;
#pragma unroll
        for (int i = 0; i < 16; ++i) { const int d = dg * 16 + i; S[i] = sa[d] * S[i] + sk[d] * v; part += sq[d] * S[i]; }
        if (step >= CTX) red[dg][e] = part;
        __syncthreads();
        if (step >= CTX && dg == 0) O[(size_t)row * 512 + hh * 128 + e] = (red[0][e] + red[1][e]) + (red[2][e] + red[3][e]);
    }
}
__global__ __launch_bounds__(256) void k_gla_post(const float* __restrict__ OF, const float* __restrict__ OB, const bf16_t* __restrict__ R, const float* __restrict__ nw, bf16_t* __restrict__ MIX) {
    const int tok = blockIdx.x * 4 + (threadIdx.x >> 6), lane = threadIdx.x & 63, c0 = lane * 8;
    float o[8]; float ss = 0.f;
#pragma unroll
    for (int j = 0; j < 8; ++j) { o[j] = OF[(size_t)tok * 512 + c0 + j] + OB[(size_t)tok * 512 + c0 + j]; ss += o[j] * o[j]; }
    ss += __shfl_xor(ss, 1); ss += __shfl_xor(ss, 2); ss += __shfl_xor(ss, 4); ss += __shfl_xor(ss, 8);
    const float rstd = rsqrtf(ss * (1.f / 128.f) + 1e-6f);
    float w[8];
#pragma unroll
    for (int j = 0; j < 8; ++j) { const float r = bf2f(R[(size_t)tok * 512 + c0 + j]); w[j] = o[j] * rstd * nw[(c0 + j) & 127] * siluf_(r); }
    uint4 q; q.x = pk2(w[0], w[1]); q.y = pk2(w[2], w[3]); q.z = pk2(w[4], w[5]); q.w = pk2(w[6], w[7]);
    *(uint4*)(MIX + (size_t)tok * DM + c0) = q;
}

__global__ __launch_bounds__(256) void k_s5_naive(const bf16_t* __restrict__ UT, const S5P* __restrict__ P, const float* __restrict__ c_re, const float* __restrict__ c_im,
                                                  float* __restrict__ YF, float* __restrict__ YB) {
    __shared__ float hs[4][2][64];
    const int w = threadIdx.x >> 6, lane = threadIdx.x & 63, id = blockIdx.x * 4 + w, g = id & 31, dir = (id >> 5) & 1, b = id >> 6;
    const float lr = P->lamb[dir][g][lane][0], li = P->lamb[dir][g][lane][1];
    float br[16], bi[16];
#pragma unroll
    for (int h = 0; h < 16; ++h) { br[h] = P->bbar[dir][g][lane][h][0]; bi[h] = P->bbar[dir][g][lane][h][1]; }
    const int ch = lane & 15, part = lane >> 4;
    float cr[16], ci[16];
#pragma unroll
    for (int i = 0; i < 16; ++i) { const size_t ix = (((size_t)dir * 32 + g) * 16 + ch) * 64 + part * 16 + i; cr[i] = c_re[ix]; ci[i] = c_im[ix]; }
    float hr = 0.f, hi = 0.f; float* Y = dir ? YB : YF;
    for (int step = 0; step < CTX + SEQ; ++step) {
        int row;
        if (step < CTX) row = NTOK + b * CTX + (dir ? CTX - 1 - step : step);
        else { const int t = step - CTX, s = dir ? SEQ - 1 - t : t; row = b * SEQ + (s & 63) * 64 + (s >> 6); }
        const uint4 u0 = *(const uint4*)(UT + (size_t)row * 512 + g * 16), u1 = *(const uint4*)(UT + (size_t)row * 512 + g * 16 + 8);
        const unsigned uw[8] = {u0.x, u0.y, u0.z, u0.w, u1.x, u1.y, u1.z, u1.w};
        float bur = 0.f, bui = 0.f;
#pragma unroll
        for (int j = 0; j < 8; ++j) { const float ua = __uint_as_float(uw[j] << 16), ub = __uint_as_float(uw[j] & 0xffff0000u);
            bur += br[2 * j] * ua + br[2 * j + 1] * ub; bui += bi[2 * j] * ua + bi[2 * j + 1] * ub; }
        const float nr = lr * hr - li * hi + bur, ni = lr * hi + li * hr + bui; hr = nr; hi = ni;
        if (step >= CTX) {
            hs[w][0][lane] = hr; hs[w][1][lane] = hi;
            asm volatile("s_waitcnt lgkmcnt(0)" ::: "memory");
            float acc = 0.f;
#pragma unroll
            for (int i = 0; i < 16; ++i) acc += cr[i] * hs[w][0][part * 16 + i] - ci[i] * hs[w][1][part * 16 + i];
            acc += __shfl_xor(acc, 16); acc += __shfl_xor(acc, 32);
            asm volatile("s_waitcnt lgkmcnt(0)" ::: "memory");
            if (lane < 16) Y[(size_t)row * 512 + g * 16 + lane] = acc;
        }
    }
}
__global__ __launch_bounds__(256) void k_s5_post(const float* __restrict__ YF, const float* __restrict__ YB, const bf16_t* __restrict__ UT, const float* __restrict__ dvec, bf16_t* __restrict__ YS) {
    const size_t i = (size_t)blockIdx.x * 256 + threadIdx.x; const int j = (int)(i & 511);
    const float y = YF[i] + YB[i] + dvec[j] * bf2f(UT[i]);
    YS[i] = f2bf(gelu_tanh(y));
}

__global__ __launch_bounds__(256) void k_router(const float* __restrict__ X1, const float* __restrict__ w, const float* __restrict__ mod, const float* __restrict__ rw, const float* __restrict__ rb,
                                                bf16_t* __restrict__ H2, int* __restrict__ cnt, int* __restrict__ list, float* __restrict__ gate) {
    __shared__ float hrow[4][1024];
    const int wv = threadIdx.x >> 6, tok = blockIdx.x * 4 + wv, lane = threadIdx.x & 63, b = tok / SEQ;
    const float* src = X1 + (size_t)tok * DM;
    float4 v[4]; float ss = 0.f;
#pragma unroll
    for (int j = 0; j < 4; ++j) { v[j] = *(const float4*)(src + lane * 4 + 256 * j); ss += v[j].x * v[j].x + v[j].y * v[j].y + v[j].z * v[j].z + v[j].w * v[j].w; }
    const float rstd = rsqrtf(wave_sum(ss) * (1.f / DM) + 1e-6f);
    const float* msh = mod + b * 6144 + 3072; const float* msc = mod + b * 6144 + 4096;
#pragma unroll
    for (int j = 0; j < 4; ++j) { const int k = lane * 4 + 256 * j;
        const float4 ww = *(const float4*)(w + k), sc = *(const float4*)(msc + k), sh = *(const float4*)(msh + k);
        float4 h; h.x = v[j].x * rstd * ww.x * (1.f + sc.x) + sh.x; h.y = v[j].y * rstd * ww.y * (1.f + sc.y) + sh.y; h.z = v[j].z * rstd * ww.z * (1.f + sc.z) + sh.z; h.w = v[j].w * rstd * ww.w * (1.f + sc.w) + sh.w;
        *(float4*)&hrow[wv][k] = h;
        uint2 o; o.x = pk2(h.x, h.y); o.y = pk2(h.z, h.w); *(uint2*)(H2 + (size_t)tok * DM + k) = o; }
    asm volatile("s_waitcnt lgkmcnt(0)" ::: "memory");
    const int e = lane & 31, half = lane >> 5; float lg = 0.f;
    for (int k = half * 512; k < half * 512 + 512; ++k) lg += hrow[wv][k] * rw[k * 32 + e];
    lg += __shfl_xor(lg, 32); lg += rb[e];
    float val = lg; float tv[4]; int ti[4];
#pragma unroll
    for (int t = 0; t < 4; ++t) { float bv = val; int bi = e;
#pragma unroll
        for (int o = 1; o < 32; o <<= 1) { const float ov = __shfl_xor(bv, o); const int oi = __shfl_xor(bi, o); if (ov > bv || (ov == bv && oi < bi)) { bv = ov; bi = oi; } }
        tv[t] = bv; ti[t] = bi; if (e == bi) val = -3.0e38f; }
    const float e1 = __expf(tv[1] - tv[0]), e2 = __expf(tv[2] - tv[0]), e3 = __expf(tv[3] - tv[0]), inv = 1.f / (1.f + e1 + e2 + e3);
    if (lane < 4) { const float gv = lane == 0 ? inv : lane == 1 ? e1 * inv : lane == 2 ? e2 * inv : e3 * inv; const int ex = lane == 0 ? ti[0] : lane == 1 ? ti[1] : lane == 2 ? ti[2] : ti[3];
        const int slot = atomicAdd(&cnt[ex], 1); list[ex * LISTCAP + slot] = tok * 4 + lane; gate[tok * 4 + lane] = gv; }
}
__global__ void k_offsets(const int* cnt, int* offs) { if (threadIdx.x == 0) { int o = 0; for (int e = 0; e < NEXP; ++e) { offs[e] = o; o += (cnt[e] + MOEPAD - 1) / MOEPAD * MOEPAD; } offs[NEXP] = o; } }

__global__ __launch_bounds__(256) void k_final(float* __restrict__ X1, const bf16_t* __restrict__ YSL, const float* __restrict__ mod, const float* __restrict__ fw) {
    const int tok = blockIdx.x * 4 + (threadIdx.x >> 6), lane = threadIdx.x & 63, b = tok / SEQ;
    float* row = X1 + (size_t)tok * DM; const float* g2 = mod + b * 6144 + 5120;
    float4 v[4]; float ss = 0.f;
#pragma unroll
    for (int j = 0; j < 4; ++j) { const int k = lane * 4 + 256 * j; v[j] = *(const float4*)(row + k); float f[4] = {0.f, 0.f, 0.f, 0.f};
#pragma unroll
        for (int s = 0; s < 4; ++s) { const uint2 y = *(const uint2*)(YSL + ((size_t)tok * 4 + s) * DM + k);
            f[0] += __uint_as_float(y.x << 16); f[1] += __uint_as_float(y.x & 0xffff0000u); f[2] += __uint_as_float(y.y << 16); f[3] += __uint_as_float(y.y & 0xffff0000u); }
        const float4 gg = *(const float4*)(g2 + k);
        v[j].x += gg.x * f[0]; v[j].y += gg.y * f[1]; v[j].z += gg.z * f[2]; v[j].w += gg.w * f[3];
        ss += v[j].x * v[j].x + v[j].y * v[j].y + v[j].z * v[j].z + v[j].w * v[j].w; }
    const float rstd = rsqrtf(wave_sum(ss) * (1.f / DM) + 1e-6f);
#pragma unroll
    for (int j = 0; j < 4; ++j) { const int k = lane * 4 + 256 * j; const float4 ww = *(const float4*)(fw + k);
        *(float4*)(row + k) = make_float4(v[j].x * rstd * ww.x, v[j].y * rstd * ww.y, v[j].z * rstd * ww.z, v[j].w * rstd * ww.w); }
}

extern "C" void kernel_launch(void* const* d_in, const int* in_sizes, int n_in, void* d_out, int out_size, void* d_ws, size_t ws_size, hipStream_t stream) {
    if (ws_size < WS_NEED) { fprintf(stderr, "kernel_launch: workspace too small: %zu < %zu\n", ws_size, (size_t)WS_NEED); return; }
    const float* x = (const float*)d_in[0]; const float* c = (const float*)d_in[1]; const float* ctx = (const float*)d_in[2]; const float* c_ctx = (const float*)d_in[3];
    const float* ada_w = (const float*)d_in[4]; const float* ada_b = (const float*)d_in[5]; const float* norm_mix_w = (const float*)d_in[6]; const float* w_in = (const float*)d_in[7];
    const float* lr_up = (const float*)d_in[8]; const float* lr_bias = (const float*)d_in[9]; const float* gla_norm_w = (const float*)d_in[10];
    const float* lam_re = (const float*)d_in[11]; const float* lam_im = (const float*)d_in[12]; const float* log_dt = (const float*)d_in[13];
    const float* b_re = (const float*)d_in[14]; const float* b_im = (const float*)d_in[15]; const float* c_re = (const float*)d_in[16]; const float* c_im = (const float*)d_in[17];
    const float* s5_d = (const float*)d_in[18]; const float* glu_w = (const float*)d_in[19]; const float* glu_b = (const float*)d_in[20]; const float* w_out = (const float*)d_in[21];
    const float* norm_ffn_w = (const float*)d_in[22]; const float* router_w = (const float*)d_in[23]; const float* router_b = (const float*)d_in[24];
    const float* w_gu = (const float*)d_in[25]; const float* b_gu = (const float*)d_in[26]; const float* w_down = (const float*)d_in[27]; const float* b_down = (const float*)d_in[28];
    const float* final_w = (const float*)d_in[29];
    char* ws = (char*)d_ws; float* out = (float*)d_out;
    unsigned* ctl = (unsigned*)(ws + OFF_CTL); float* mod = (float*)(ws + OFF_MOD); S5P* s5p = (S5P*)(ws + OFF_S5P); float* gate = (float*)(ws + OFF_GATE); int* list = (int*)(ws + OFF_LIST);
    bf16_t* WIN = (bf16_t*)(ws + OFF_WIN); bf16_t* WGLU = (bf16_t*)(ws + OFF_WGLU); bf16_t* WOUT = (bf16_t*)(ws + OFF_WOUT); bf16_t* WG = (bf16_t*)(ws + OFF_WG); bf16_t* WD = (bf16_t*)(ws + OFF_WD);
    bf16_t* H = (bf16_t*)(ws + OFF_H); bf16_t* QK = (bf16_t*)(ws + OFF_QK); bf16_t* V = (bf16_t*)(ws + OFF_V); bf16_t* R = (bf16_t*)(ws + OFF_R); bf16_t* UT = (bf16_t*)(ws + OFF_UT);
    float* LR = (float*)(ws + OFF_LR); bf16_t* U2 = (bf16_t*)(ws + OFF_U2); float* OF = (float*)(ws + OFF_OF); float* OB = (float*)(ws + OFF_OB); float* YF = (float*)(ws + OFF_YF); float* YB = (float*)(ws + OFF_YB);
    bf16_t* YS = (bf16_t*)(ws + OFF_YS); bf16_t* MIX = (bf16_t*)(ws + OFF_MIX); bf16_t* ACT = (bf16_t*)(ws + OFF_ACT); bf16_t* YSL = (bf16_t*)(ws + OFF_YSL);
    int* cnt = (int*)(ctl + CW_CNT); int* offs = (int*)(ctl + CW_OFFS);

    hipMemsetAsync(ws + OFF_CTL, 0, 64 * 1024, stream);
    k_mod<<<24, 256, 0, stream>>>(c, c_ctx, ada_w, ada_b, mod);
    k_s5prep<<<16, 256, 0, stream>>>(lam_re, lam_im, log_dt, b_re, b_im, s5p);
    k_wconv<0><<<dim3(INP / 64, DM / 64, 1), 256, 0, stream>>>(w_in, WIN, DM, INC, INP);
    k_wconv<0><<<dim3(512 / 64, 512 / 64, 1), 256, 0, stream>>>(glu_w, WGLU, 512, 512, 512);
    k_wconv<0><<<dim3(DM / 64, DM / 64, 1), 256, 0, stream>>>(w_out, WOUT, DM, DM, DM);
    k_wconv<1><<<dim3(2048 / 64, DM / 64, NEXP), 256, 0, stream>>>(w_gu, WG, DM, 2048, 2048);
    k_wconv<0><<<dim3(DM / 64, DFF / 64, NEXP), 256, 0, stream>>>(w_down, WD, DFF, DM, DM);
    k_norm<<<NROWS / 4, 256, 0, stream>>>(x, ctx, norm_mix_w, mod, H, NROWS, 0, 1024);
    { ProbIn P{H, DM, WIN, DM, DM, QK, V, R, UT, U2, LR}; k_gemm_naive<ProbIn><<<dim3(INP / 64, NROWS / 64, 1), 256, 0, stream>>>(P); }
    k_gla_naive<<<NB * 4 * 2, 512, 0, stream>>>(QK, V, LR, lr_up, lr_bias, OF, OB);
    k_gla_post<<<NTOK / 4, 256, 0, stream>>>(OF, OB, R, gla_norm_w, MIX);
    k_s5_naive<<<NB * 2 * 32 / 4, 256, 0, stream>>>(UT, s5p, c_re, c_im, YF, YB);
    k_s5_post<<<NTOK * 512 / 256, 256, 0, stream>>>(YF, YB, UT, s5_d, YS);
    { ProbGlu P{YS, 512, WGLU, 512, 512, glu_b, MIX}; k_gemm_naive<ProbGlu><<<dim3(512 / 64, NTOK / 64, 1), 256, 0, stream>>>(P); }
    { ProbOut P{MIX, DM, WOUT, DM, DM, x, mod, out}; k_gemm_naive<ProbOut><<<dim3(DM / 64, NTOK / 64, 1), 256, 0, stream>>>(P); }
    k_router<<<NTOK / 4, 256, 0, stream>>>(out, norm_ffn_w, mod, router_w, router_b, H, cnt, list, gate);
    k_offsets<<<1, 64, 0, stream>>>(cnt, offs);
    { ProbMoe1 P{H, DM, WG, DM, DM, cnt, offs, list, b_gu, ACT}; k_gemm_naive<ProbMoe1><<<dim3(2048 / 64, NTOK / 64, NEXP), 256, 0, stream>>>(P); }
    { ProbMoe2 P{ACT, DFF, WD, DFF, DFF, cnt, offs, list, b_down, gate, YSL}; k_gemm_naive<ProbMoe2><<<dim3(DM / 64, NTOK / 64, NEXP), 256, 0, stream>>>(P); }
    k_final<<<NTOK / 4, 256, 0, stream>>>(out, YSL, mod, final_w);
}
```

```cpp
#include <hip/hip_runtime.h>
#include <stdint.h>
#include <stdio.h>

typedef unsigned short bf16_t;
#define DEVI __device__ __forceinline__
#define LAS __attribute__((address_space(3)))

constexpr int NB = 8, SEQ = 4096, DM = 1024, CTX = 256;
constexpr int NTOK = NB * SEQ;
constexpr int NCTX = NB * CTX;
constexpr int NROWS = NTOK + NCTX;
constexpr int INC = 2080, INP = 2304;
constexpr int NEXP = 32, TOPK = 4, DFF = 1024;
constexpr int LISTCAP = NTOK;
constexpr int MOEPAD = 256;

constexpr size_t MiB = 1024ull * 1024ull;
constexpr size_t OFF_CTL = 0;
constexpr size_t OFF_MOD = 64 * 1024;
constexpr size_t OFF_S5P = OFF_MOD + 256 * 1024;
constexpr size_t OFF_GATE = OFF_S5P + 1 * MiB;
constexpr size_t OFF_LIST = OFF_GATE + 512 * 1024;
constexpr size_t OFF_WIN = OFF_LIST + 4 * MiB;
constexpr size_t OFF_WGLU = OFF_WIN + (size_t)INP * DM * 2;
constexpr size_t OFF_WOUT = OFF_WGLU + 512 * 512 * 2;
constexpr size_t OFF_WG = OFF_WOUT + (size_t)DM * DM * 2;
constexpr size_t OFF_WD = OFF_WG + (size_t)NEXP * 2048 * DM * 2;
constexpr size_t OFF_S5BF = OFF_WD + (size_t)NEXP * DM * DFF * 2;
constexpr size_t OFF_S5BY = OFF_S5BF + (size_t)32 * 256 * 256 * 2;
constexpr size_t OFF_H = OFF_S5BY + (size_t)32 * 256 * 512 * 2;
constexpr size_t OFF_RA = OFF_H + (size_t)NROWS * DM * 2;
constexpr size_t OFF_QK = OFF_RA;
constexpr size_t OFF_V = OFF_QK + (size_t)NROWS * 512 * 2;
constexpr size_t OFF_R = OFF_V + (size_t)NROWS * 512 * 2;
constexpr size_t OFF_UT = OFF_R + (size_t)NROWS * 512 * 2;
constexpr size_t OFF_LR = OFF_UT + (size_t)NROWS * 512 * 2;
constexpr size_t OFF_U2 = OFF_LR + (size_t)NROWS * 32 * 4;
constexpr size_t OFF_OF = OFF_U2 + (size_t)32 * 2304 * 512 * 2;
constexpr size_t OFF_OB = OFF_OF + (size_t)NTOK * 512 * 4;
constexpr size_t OFF_YF = OFF_OB + (size_t)NTOK * 512 * 4;
constexpr size_t OFF_YB = OFF_YF + (size_t)NTOK * 512 * 4;
constexpr size_t OFF_YS = OFF_YB + (size_t)NTOK * 512 * 4;
constexpr size_t OFF_MIX = OFF_YS + (size_t)NTOK * 512 * 2;
constexpr size_t OFF_RA_END = OFF_MIX + (size_t)NTOK * DM * 2;
constexpr int ACT_ROWS = NTOK * TOPK + NEXP * MOEPAD;
constexpr size_t OFF_ACT = OFF_RA;
constexpr size_t OFF_YSL = OFF_ACT + (size_t)ACT_ROWS * DFF * 2;
constexpr size_t OFF_END2 = OFF_YSL + (size_t)NTOK * TOPK * DM * 2;
constexpr size_t WS_NEED = OFF_RA_END > OFF_END2 ? OFF_RA_END : OFF_END2;
static_assert(WS_NEED <= 1024 * MiB, "workspace map exceeds 1 GiB");

constexpr int CW_CNT = 1024;
constexpr int CW_OFFS = 1088;

DEVI float bf2f(bf16_t b) { return __uint_as_float(((unsigned)b) << 16); }
DEVI bf16_t f2bf(float f) { unsigned u = __float_as_uint(f); u += 0x7fffu + ((u >> 16) & 1u); return (bf16_t)(u >> 16); }
DEVI unsigned pk2(float lo, float hi) { return (unsigned)f2bf(lo) | ((unsigned)f2bf(hi) << 16); }
DEVI float wave_sum(float v) {
#pragma unroll
    for (int o = 1; o < 64; o <<= 1) v += __shfl_xor(v, o);
    return v;
}
DEVI float sigmoidf_(float x) { return 1.f / (1.f + __expf(-x)); }
DEVI float siluf_(float x) { return x / (1.f + __expf(-x)); }
DEVI float logsigmoidf_(float g) { return fminf(g, 0.f) - log1pf(__expf(-fabsf(g))); }
DEVI float gelu_tanh(float x) { const float u = 0.7978845608028654f * (x + 0.044715f * x * x * x); return 0.5f * x * (1.f + tanhf(u)); }

__global__ __launch_bounds__(256) void k_mod(const float* __restrict__ c, const float* __restrict__ c_ctx, const float* __restrict__ ada_w,
                                             const float* __restrict__ ada_b, float* __restrict__ mod) {
    __shared__ float s[9][1024];
    for (int i = threadIdx.x; i < 9 * 1024; i += 256) { const int r = i >> 10, k = i & 1023; const float v = r < 8 ? c[r * 1024 + k] : c_ctx[k]; s[r][k] = siluf_(v); }
    __syncthreads();
    const int j = blockIdx.x * 256 + threadIdx.x;
    float acc[9];
#pragma unroll
    for (int r = 0; r < 9; ++r) acc[r] = 0.f;
    for (int k = 0; k < 1024; ++k) { const float w = ada_w[(size_t)k * 6144 + j];
#pragma unroll
        for (int r = 0; r < 9; ++r) acc[r] += s[r][k] * w; }
    const float bb = ada_b[j];
#pragma unroll
    for (int r = 0; r < 9; ++r) mod[r * 6144 + j] = acc[r] + bb;
}

template <int MODE> DEVI int wsrc_col(int nd) { if (MODE == 1) { const int q = nd >> 3, i = nd & 7; return i < 4 ? 4 * q + i : 1024 + 4 * q + (i - 4); } return nd; }
template <int MODE> __global__ __launch_bounds__(256) void k_wconv(const float* __restrict__ src, bf16_t* __restrict__ dst, int K, int N, int Nd) {
    __shared__ float t[64][65];
    const int e = blockIdx.z; src += (size_t)e * K * N; dst += (size_t)e * Nd * K;
    const int n0 = blockIdx.x * 64, k0 = blockIdx.y * 64, tid = threadIdx.x, nl = tid & 63, kq = tid >> 6;
    const int nd = n0 + nl, sc = wsrc_col<MODE>(nd); const bool valid = sc < N;
#pragma unroll 4
    for (int i = 0; i < 16; ++i) { const int kk = kq + 4 * i; t[kk][nl] = valid ? src[(size_t)(k0 + kk) * N + sc] : 0.f; }
    __syncthreads();
#pragma unroll
    for (int i = 0; i < 2; ++i) { const int ch = tid + 256 * i, n = ch >> 3, c8 = ch & 7;
        uint4 o; o.x = pk2(t[c8 * 8 + 0][n], t[c8 * 8 + 1][n]); o.y = pk2(t[c8 * 8 + 2][n], t[c8 * 8 + 3][n]); o.z = pk2(t[c8 * 8 + 4][n], t[c8 * 8 + 5][n]); o.w = pk2(t[c8 * 8 + 6][n], t[c8 * 8 + 7][n]);
        *(uint4*)(dst + (size_t)(n0 + n) * K + k0 + c8 * 8) = o; }
}

struct S5P { float lamb[2][32][64][2]; float bbar[2][32][64][16][2]; };
DEVI void s5prep_one(const float* lam_re, const float* lam_im, const float* log_dt, const float* b_re, const float* b_im, S5P* P, int i) {
    const int p = i & 63, g = (i >> 6) & 31, d = i >> 11;
    const double dt = exp((double)log_dt[d * 32 + g]);
    const double lr = lam_re[i], li = lam_im[i];
    const double mag = exp(lr * dt), ar = mag * cos(li * dt), ai = mag * sin(li * dt);
    const double nr = ar - 1.0, ni = ai, den = lr * lr + li * li;
    const double cr = (nr * lr + ni * li) / den, ci = (ni * lr - nr * li) / den;
    P->lamb[d][g][p][0] = (float)ar; P->lamb[d][g][p][1] = (float)ai;
    for (int h = 0; h < 16; ++h) { const double br = b_re[(size_t)i * 16 + h], bi = b_im[(size_t)i * 16 + h];
        P->bbar[d][g][p][h][0] = (float)(cr * br - ci * bi); P->bbar[d][g][p][h][1] = (float)(cr * bi + ci * br); }
}
__global__ void k_s5prep(const float* lam_re, const float* lam_im, const float* log_dt, const float* b_re, const float* b_im, S5P* P) {
    const int i = blockIdx.x * blockDim.x + threadIdx.x; if (i >= 2 * 32 * 64) return;
    s5prep_one(lam_re, lam_im, log_dt, b_re, b_im, P, i);
}

DEVI void norm_row(const float* __restrict__ x, const float* __restrict__ ctx, const float* __restrict__ w, const float* __restrict__ mod,
                                              bf16_t* __restrict__ H, int row, int lane, int sh_off, int sc_off) {
    const float* src; int b;
    if (row < NTOK) { src = x + (size_t)row * DM; b = row / SEQ; } else { src = ctx + (size_t)(row - NTOK) * DM; b = 8; }
    float4 v[4]; float ss = 0.f;
#pragma unroll
    for (int j = 0; j < 4; ++j) { v[j] = *(const float4*)(src + lane * 4 + 256 * j); ss += v[j].x * v[j].x + v[j].y * v[j].y + v[j].z * v[j].z + v[j].w * v[j].w; }
    const float rstd = rsqrtf(wave_sum(ss) * (1.f / DM) + 1e-6f);
    const float* msh = mod + b * 6144 + sh_off; const float* msc = mod + b * 6144 + sc_off;
#pragma unroll
    for (int j = 0; j < 4; ++j) { const int k = lane * 4 + 256 * j;
        const float4 ww = *(const float4*)(w + k), sc = *(const float4*)(msc + k), sh = *(const float4*)(msh + k);
        uint2 o; o.x = pk2(v[j].x * rstd * ww.x * (1.f + sc.x) + sh.x, v[j].y * rstd * ww.y * (1.f + sc.y) + sh.y);
        o.y = pk2(v[j].z * rstd * ww.z * (1.f + sc.z) + sh.z, v[j].w * rstd * ww.w * (1.f + sc.w) + sh.w);
        *(uint2*)(H + (size_t)row * DM + k) = o; }
}
__global__ __launch_bounds__(256) void k_norm(const float* __restrict__ x, const float* __restrict__ ctx, const float* __restrict__ w, const float* __restrict__ mod,
                                              bf16_t* __restrict__ H, int nrows, int sh_off, int sc_off) {
    const int row = blockIdx.x * 4 + (threadIdx.x >> 6), lane = threadIdx.x & 63; if (row >= nrows) return;
    norm_row(x, ctx, w, mod, H, row, lane, sh_off, sc_off);
}

DEVI void dense_unit(int L, int nM, int nN, int& pm, int& pn) {
    const int nwg = nM * nN; int wgid = L; { const int q = nwg / 8, r = nwg % 8, xcd = wgid % 8, off = wgid / 8; wgid = (xcd < r ? xcd * (q + 1) : r * (q + 1) + (xcd - r) * q) + off; }
    const int nig = 8 * nN, gid = wgid / nig, fm = gid * 8, gsz = (nM - fm) < 8 ? (nM - fm) : 8;
    pm = fm + ((wgid % nig) % gsz); pn = (wgid % nig) / gsz;
}
template <class Prob> __global__ __launch_bounds__(256) void k_gemm_naive(Prob P) {
    __shared__ float As[32][68], Bs[32][68];
    const int z = blockIdx.z, M = P.M(z), r0 = blockIdx.y * 64, c0 = blockIdx.x * 64; if (r0 >= M) return;
    const int tid = threadIdx.x, tx = tid & 7, ty = tid >> 3, K = P.K;
    const int lr = tid >> 2, lk = (tid & 3) * 8;
    const bool arow_ok = (r0 + lr) < M;
    const bf16_t* ap = P.A + (size_t)(arow_ok ? P.arow(z, r0 + lr) : 0) * P.lda + lk;
    const bf16_t* bp = P.Bt(z) + (size_t)(c0 + lr) * P.ldb + lk;
    float acc[2][8];
#pragma unroll
    for (int i = 0; i < 2; ++i)
#pragma unroll
        for (int j = 0; j < 8; ++j) acc[i][j] = 0.f;
    for (int k0 = 0; k0 < K; k0 += 32) {
        uint4 av = arow_ok ? *(const uint4*)(ap + k0) : make_uint4(0, 0, 0, 0); const uint4 bv = *(const uint4*)(bp + k0);
        const unsigned aw[4] = {av.x, av.y, av.z, av.w}, bw[4] = {bv.x, bv.y, bv.z, bv.w};
        __syncthreads();
#pragma unroll
        for (int j = 0; j < 4; ++j) { As[lk + 2 * j][lr] = __uint_as_float(aw[j] << 16); As[lk + 2 * j + 1][lr] = __uint_as_float(aw[j] & 0xffff0000u);
            Bs[lk + 2 * j][lr] = __uint_as_float(bw[j] << 16); Bs[lk + 2 * j + 1][lr] = __uint_as_float(bw[j] & 0xffff0000u); }
        __syncthreads();
#pragma unroll 8
        for (int k = 0; k < 32; ++k) { const float a0 = As[k][ty * 2], a1 = As[k][ty * 2 + 1];
            const float4 b0 = *(const float4*)&Bs[k][tx * 8], b1 = *(const float4*)&Bs[k][tx * 8 + 4];
            const float bb[8] = {b0.x, b0.y, b0.z, b0.w, b1.x, b1.y, b1.z, b1.w};
#pragma unroll
            for (int j = 0; j < 8; ++j) { acc[0][j] += a0 * bb[j]; acc[1][j] += a1 * bb[j]; } }
    }
#pragma unroll
    for (int i = 0; i < 2; ++i) { const int r = r0 + ty * 2 + i; if (r < M) P.store(z, r, c0 + tx * 8, acc[i]); }
}

struct ProbIn {
    const bf16_t* A; int lda; const bf16_t* B; int ldb; int K; bf16_t *QK, *V, *R, *UT, *U2; float* LR;
    DEVI int M(int) const { return NROWS; }
    DEVI int arow(int, int r) const { return r; }
    DEVI int nunits() const { return (NROWS / 256) * (INP / 256); }
    DEVI void unit(int L, int& z, int& pm, int& pn) const { z = 0; dense_unit(L, NROWS / 256, INP / 256, pm, pn); }
    DEVI unsigned aoffb(int, int r) const { return (unsigned)r * (unsigned)(lda * 2); }
    DEVI const bf16_t* Bt(int) const { return B; }
    DEVI void store(int, int r, int c0, const float (&v)[8]) const {
        if (c0 >= INC) return;
        uint4 o; o.x = pk2(v[0], v[1]); o.y = pk2(v[2], v[3]); o.z = pk2(v[4], v[5]); o.w = pk2(v[6], v[7]);
        if (c0 < 512) { *(uint4*)(QK + (size_t)r * 512 + c0) = o; }
        else if (c0 < 1024) { *(uint4*)(V + (size_t)r * 512 + (c0 - 512)) = o; }
        else if (c0 < 1536) { *(uint4*)(R + (size_t)r * 512 + (c0 - 1024)) = o; }
        else if (c0 < 1568) { float* p = LR + (size_t)r * 32 + (c0 - 1536); *(float4*)p = make_float4(v[0], v[1], v[2], v[3]); *(float4*)(p + 4) = make_float4(v[4], v[5], v[6], v[7]); }
        else { const int j = c0 - 1568; *(uint4*)(UT + (size_t)r * 512 + j) = o;
            const int g = j >> 4, ch = j & 15; int urow, ucol;
            if (r < NTOK) { const int b = r >> 12, n = r & 4095, gr = n >> 6, gc = n & 63, s = gc * 64 + gr; urow = b * 256 + (s >> 4); ucol = (s & 15) * 16 + ch; }
            else { const int q = r - NTOK, b = q >> 8, t = q & 255; urow = 2048 + b * 16 + (t >> 4); ucol = (t & 15) * 16 + ch; }
            *(uint4*)(U2 + ((size_t)g * 2304 + urow) * 512 + ucol) = o; }
    }
};
struct ProbGlu {
    const bf16_t* A; int lda; const bf16_t* B; int ldb; int K; const float* bias; bf16_t* MIX;
    DEVI int M(int) const { return NTOK; }
    DEVI int arow(int, int r) const { return r; }
    DEVI int nunits() const { return (NTOK / 256) * 2; }
    DEVI void unit(int L, int& z, int& pm, int& pn) const { z = 0; dense_unit(L, NTOK / 256, 2, pm, pn); }
    DEVI unsigned aoffb(int, int r) const { return (unsigned)r * (unsigned)(lda * 2); }
    DEVI const bf16_t* Bt(int) const { return B; }
    DEVI void store(int, int r, int c0, const float (&v)[8]) const {
        const uint4 yv = *(const uint4*)(A + (size_t)r * lda + c0); const unsigned yw[4] = {yv.x, yv.y, yv.z, yv.w}; float o[8];
#pragma unroll
        for (int j = 0; j < 4; ++j) { const float y0 = __uint_as_float(yw[j] << 16), y1 = __uint_as_float(yw[j] & 0xffff0000u);
            o[2 * j] = y0 * sigmoidf_(v[2 * j] + bias[c0 + 2 * j]); o[2 * j + 1] = y1 * sigmoidf_(v[2 * j + 1] + bias[c0 + 2 * j + 1]); }
        uint4 w; w.x = pk2(o[0], o[1]); w.y = pk2(o[2], o[3]); w.z = pk2(o[4], o[5]); w.w = pk2(o[6], o[7]);
        *(uint4*)(MIX + (size_t)r * DM + 512 + c0) = w;
    }
};
struct ProbOut {
    const bf16_t* A; int lda; const bf16_t* B; int ldb; int K; const float* x; const float* mod; float* X1;
    DEVI int M(int) const { return NTOK; }
    DEVI int arow(int, int r) const { return r; }
    DEVI int nunits() const { return (NTOK / 256) * 4; }
    DEVI void unit(int L, int& z, int& pm, int& pn) const { z = 0; dense_unit(L, NTOK / 256, 4, pm, pn); }
    DEVI unsigned aoffb(int, int r) const { return (unsigned)r * (unsigned)(lda * 2); }
    DEVI const bf16_t* Bt(int) const { return B; }
    DEVI void store(int, int r, int c0, const float (&v)[8]) const {
        const float* g1 = mod + (r >> 12) * 6144 + 2048 + c0; const float* xp = x + (size_t)r * DM + c0; float* op = X1 + (size_t)r * DM + c0;
        const float4 x0 = *(const float4*)xp, x1 = *(const float4*)(xp + 4), ga = *(const float4*)g1, gb = *(const float4*)(g1 + 4);
        *(float4*)op = make_float4(x0.x + ga.x * v[0], x0.y + ga.y * v[1], x0.z + ga.z * v[2], x0.w + ga.w * v[3]);
        *(float4*)(op + 4) = make_float4(x1.x + gb.x * v[4], x1.y + gb.y * v[5], x1.z + gb.z * v[6], x1.w + gb.w * v[7]);
    }
};
struct ProbMoe1 {
    const bf16_t* A; int lda; const bf16_t* B; int ldb; int K; const int* cnt; const int* offs; const int* list; const float* b_gu; bf16_t* ACT;
    DEVI int M(int z) const { return cnt[z]; }
    DEVI int arow(int z, int r) const { return list[z * LISTCAP + r] >> 2; }
    DEVI const bf16_t* Bt(int z) const { return B + (size_t)z * 2048 * DM; }
    DEVI void store(int z, int r, int c0, const float (&v)[8]) const {
        const int f0 = (c0 >> 3) * 4; const float* bg = b_gu + (size_t)z * 2048 + f0; float a[4];
#pragma unroll
        for (int i = 0; i < 4; ++i) { float g = v[i] + bg[i], l = v[4 + i] + bg[1024 + i]; g = fminf(g, 7.f); l = fminf(fmaxf(l, -7.f), 7.f); a[i] = (l + 1.f) * (g * sigmoidf_(1.702f * g)); }
        uint2 o; o.x = pk2(a[0], a[1]); o.y = pk2(a[2], a[3]);
        *(uint2*)(ACT + (size_t)(offs[z] + r) * DFF + f0) = o;
    }
};
struct ProbMoe2 {
    const bf16_t* A; int lda; const bf16_t* B; int ldb; int K; const int* cnt; const int* offs; const int* list; const float* b_down; const float* gate; bf16_t* YSL;
    DEVI int M(int z) const { return cnt[z]; }
    DEVI int arow(int z, int r) const { return offs[z] + r; }
    DEVI const bf16_t* Bt(int z) const { return B + (size_t)z * DM * DFF; }
    DEVI void store(int z, int r, int c0, const float (&v)[8]) const {
        const int ent = list[z * LISTCAP + r]; const float gt = gate[ent]; const float* bd = b_down + (size_t)z * DM + c0;
        uint4 o; o.x = pk2((v[0] + bd[0]) * gt, (v[1] + bd[1]) * gt); o.y = pk2((v[2] + bd[2]) * gt, (v[3] + bd[3]) * gt);
        o.z = pk2((v[4] + bd[4]) * gt, (v[5] + bd[5]) * gt); o.w = pk2((v[6] + bd[6]) * gt, (v[7] + bd[7]) * gt);
        *(uint4*)(YSL + (size_t)ent * DM + c0) = o;
    }
};

DEVI void gla_naive_body(const bf16_t* __restrict__ QK, const bf16_t* __restrict__ V, const float* __restrict__ LR, const float* __restrict__ lr_up,
                                                   const float* __restrict__ lr_bias, float* __restrict__ OF, float* __restrict__ OB, LAS float* sm, int item) {
    LAS float* sq = sm; LAS float* sk = sm + 64; LAS float* sa = sm + 128; LAS float* sv = sm + 192; LAS float* red = sm + 320;
    const int dir = item & 1, hh = (item >> 1) & 3, b = item >> 3, tid = threadIdx.x, e = tid & 127, dg = tid >> 7;
    float up[16]; float bias = 0.f;
    if (tid < 64) { for (int r = 0; r < 16; ++r) up[r] = lr_up[dir * 4096 + r * 256 + hh * 64 + tid]; bias = lr_bias[dir * 256 + hh * 64 + tid]; }
    float S[16];
#pragma unroll
    for (int i = 0; i < 16; ++i) S[i] = 0.f;
    float* O = dir ? OB : OF;
    for (int step = 0; step < CTX + SEQ; ++step) {
        int row;
        if (step < CTX) row = NTOK + b * CTX + (dir ? CTX - 1 - step : step);
        else { const int t = step - CTX; row = b * SEQ + (dir ? SEQ - 1 - t : t); }
        if (tid < 64) { const float* lp = LR + (size_t)row * 32 + dir * 16; float g = bias;
#pragma unroll
            for (int r = 0; r < 16; ++r) g += lp[r] * up[r];
            sa[tid] = __expf(logsigmoidf_(g) * (1.f / 16.f));
            sq[tid] = bf2f(QK[(size_t)row * 512 + hh * 64 + tid]) * 0.125f; sk[tid] = bf2f(QK[(size_t)row * 512 + 256 + hh * 64 + tid]); }
        else if (tid < 192) sv[tid - 64] = bf2f(V[(size_t)row * 512 + hh * 128 + (tid - 64)]);
        __syncthreads();
        const float v = sv[e]; float part = 0.f;
#pragma unroll
        for (int i = 0; i < 16; ++i) { const int d = dg * 16 + i; S[i] = sa[d] * S[i] + sk[d] * v; part += sq[d] * S[i]; }
        if (step >= CTX) red[dg * 128 + e] = part;
        __syncthreads();
        if (step >= CTX && dg == 0) O[(size_t)row * 512 + hh * 128 + e] = (red[e] + red[128 + e]) + (red[256 + e] + red[384 + e]);
    }
}
__global__ __launch_bounds__(512) void k_gla_naive(const bf16_t* __restrict__ QK, const bf16_t* __restrict__ V, const float* __restrict__ LR, const float* __restrict__ lr_up,
                                                   const float* __restrict__ lr_bias, float* __restrict__ OF, float* __restrict__ OB) {
    __shared__ float sm[832];
    gla_naive_body(QK, V, LR, lr_up, lr_bias, OF, OB, (LAS float*)sm, blockIdx.x);
}
DEVI void gla_post_row(const float* __restrict__ OF, const float* __restrict__ OB, const bf16_t* __restrict__ R, const float* __restrict__ nw, bf16_t* __restrict__ MIX, int tok, int lane) {
    const int c0 = lane * 8;
    float o[8]; float ss = 0.f;
#pragma unroll
    for (int j = 0; j < 8; ++j) { o[j] = OF[(size_t)tok * 512 + c0 + j] + OB[(size_t)tok * 512 + c0 + j]; ss += o[j] * o[j]; }
    ss += __shfl_xor(ss, 1); ss += __shfl_xor(ss, 2); ss += __shfl_xor(ss, 4); ss += __shfl_xor(ss, 8);
    const float rstd = rsqrtf(ss * (1.f / 128.f) + 1e-6f);
    float w[8];
#pragma unroll
    for (int j = 0; j < 8; ++j) { const float r = bf2f(R[(size_t)tok * 512 + c0 + j]); w[j] = o[j] * rstd * nw[(c0 + j) & 127] * siluf_(r); }
    uint4 q; q.x = pk2(w[0], w[1]); q.y = pk2(w[2], w[3]); q.z = pk2(w[4], w[5]); q.w = pk2(w[6], w[7]);
    *(uint4*)(MIX + (size_t)tok * DM + c0) = q;
}
__global__ __launch_bounds__(256) void k_gla_post(const float* __restrict__ OF, const float* __restrict__ OB, const bf16_t* __restrict__ R, const float* __restrict__ nw, bf16_t* __restrict__ MIX) {
    gla_post_row(OF, OB, R, nw, MIX, blockIdx.x * 4 + (threadIdx.x >> 6), threadIdx.x & 63);
}

DEVI void s5_naive_body(const bf16_t* __restrict__ UT, const S5P* __restrict__ P, const float* __restrict__ c_re, const float* __restrict__ c_im,
                                                  float* __restrict__ YF, float* __restrict__ YB, LAS float* hsw  , int id, int lane) {
    const int g = id & 31, dir = (id >> 5) & 1, b = id >> 6;
    const float lr = P->lamb[dir][g][lane][0], li = P->lamb[dir][g][lane][1];
    float br[16], bi[16];
#pragma unroll
    for (int h = 0; h < 16; ++h) { br[h] = P->bbar[dir][g][lane][h][0]; bi[h] = P->bbar[dir][g][lane][h][1]; }
    const int ch = lane & 15, part = lane >> 4;
    float cr[16], ci[16];
#pragma unroll
    for (int i = 0; i < 16; ++i) { const size_t ix = (((size_t)dir * 32 + g) * 16 + ch) * 64 + part * 16 + i; cr[i] = c_re[ix]; ci[i] = c_im[ix]; }
    float hr = 0.f, hi = 0.f; float* Y = dir ? YB : YF;
    for (int step = 0; step < CTX + SEQ; ++step) {
        int row;
        if (step < CTX) row = NTOK + b * CTX + (dir ? CTX - 1 - step : step);
        else { const int t = step - CTX, s = dir ? SEQ - 1 - t : t; row = b * SEQ + (s & 63) * 64 + (s >> 6); }
        const uint4 u0 = *(const uint4*)(UT + (size_t)row * 512 + g * 16), u1 = *(const uint4*)(UT + (size_t)row * 512 + g * 16 + 8);
        const unsigned uw[8] = {u0.x, u0.y, u0.z, u0.w, u1.x, u1.y, u1.z, u1.w};
        float bur = 0.f, bui = 0.f;
#pragma unroll
        for (int j = 0; j < 8; ++j) { const float ua = __uint_as_float(uw[j] << 16), ub = __uint_as_float(uw[j] & 0xffff0000u);
            bur += br[2 * j] * ua + br[2 * j + 1] * ub; bui += bi[2 * j] * ua + bi[2 * j + 1] * ub; }
        const float nr = lr * hr - li * hi + bur, ni = lr * hi + li * hr + bui; hr = nr; hi = ni;
        if (step >= CTX) {
            hsw[lane] = hr; hsw[64 + lane] = hi;
            asm volatile("s_waitcnt lgkmcnt(0)" ::: "memory");
            float acc = 0.f;
#pragma unroll
            for (int i = 0; i < 16; ++i) acc += cr[i] * hsw[part * 16 + i] - ci[i] * hsw[64 + part * 16 + i];
            acc += __shfl_xor(acc, 16); acc += __shfl_xor(acc, 32);
            asm volatile("s_waitcnt lgkmcnt(0)" ::: "memory");
            if (lane < 16) Y[(size_t)row * 512 + g * 16 + lane] = acc;
        }
    }
}
__global__ __launch_bounds__(256) void k_s5_naive(const bf16_t* __restrict__ UT, const S5P* __restrict__ P, const float* __restrict__ c_re, const float* __restrict__ c_im,
                                                  float* __restrict__ YF, float* __restrict__ YB) {
    __shared__ float hs[4][128];
    const int w = threadIdx.x >> 6;
    s5_naive_body(UT, P, c_re, c_im, YF, YB, (LAS float*)hs[w], blockIdx.x * 4 + w, threadIdx.x & 63);
}
__global__ __launch_bounds__(256) void k_s5_post(const float* __restrict__ YF, const float* __restrict__ YB, const bf16_t* __restrict__ UT, const float* __restrict__ dvec, bf16_t* __restrict__ YS) {
    const size_t i = (size_t)blockIdx.x * 256 + threadIdx.x; const int j = (int)(i & 511);
    const float y = YF[i] + YB[i] + dvec[j] * bf2f(UT[i]);
    YS[i] = f2bf(gelu_tanh(y));
}

DEVI void router_row(const float* __restrict__ X1, const float* __restrict__ w, const float* __restrict__ mod, const float* __restrict__ rw, const float* __restrict__ rb,
                                                bf16_t* __restrict__ H2, int* __restrict__ cnt, int* __restrict__ list, float* __restrict__ gate, LAS float* hrw  , int tok, int lane) {
    const int b = tok / SEQ;
    const float* src = X1 + (size_t)tok * DM;
    float4 v[4]; float ss = 0.f;
#pragma unroll
    for (int j = 0; j < 4; ++j) { v[j] = *(const float4*)(src + lane * 4 + 256 * j); ss += v[j].x * v[j].x + v[j].y * v[j].y + v[j].z * v[j].z + v[j].w * v[j].w; }
    const float rstd = rsqrtf(wave_sum(ss) * (1.f / DM) + 1e-6f);
    const float* msh = mod + b * 6144 + 3072; const float* msc = mod + b * 6144 + 4096;
#pragma unroll
    for (int j = 0; j < 4; ++j) { const int k = lane * 4 + 256 * j;
        const float4 ww = *(const float4*)(w + k), sc = *(const float4*)(msc + k), sh = *(const float4*)(msh + k);
        float4 h; h.x = v[j].x * rstd * ww.x * (1.f + sc.x) + sh.x; h.y = v[j].y * rstd * ww.y * (1.f + sc.y) + sh.y; h.z = v[j].z * rstd * ww.z * (1.f + sc.z) + sh.z; h.w = v[j].w * rstd * ww.w * (1.f + sc.w) + sh.w;
        hrw[k] = h.x; hrw[k + 1] = h.y; hrw[k + 2] = h.z; hrw[k + 3] = h.w;
        uint2 o; o.x = pk2(h.x, h.y); o.y = pk2(h.z, h.w); *(uint2*)(H2 + (size_t)tok * DM + k) = o; }
    asm volatile("s_waitcnt lgkmcnt(0)" ::: "memory");
    const int e = lane & 31, half = lane >> 5; float lg = 0.f;
    for (int k = half * 512; k < half * 512 + 512; ++k) lg += hrw[k] * rw[k * 32 + e];
    lg += __shfl_xor(lg, 32); lg += rb[e];
    float val = lg; float tv[4]; int ti[4];
#pragma unroll
    for (int t = 0; t < 4; ++t) { float bv = val; int bi = e;
#pragma unroll
        for (int o = 1; o < 32; o <<= 1) { const float ov = __shfl_xor(bv, o); const int oi = __shfl_xor(bi, o); if (ov > bv || (ov == bv && oi < bi)) { bv = ov; bi = oi; } }
        tv[t] = bv; ti[t] = bi; if (e == bi) val = -3.0e38f; }
    const float e1 = __expf(tv[1] - tv[0]), e2 = __expf(tv[2] - tv[0]), e3 = __expf(tv[3] - tv[0]), inv = 1.f / (1.f + e1 + e2 + e3);
    if (lane < 4) { const float gv = lane == 0 ? inv : lane == 1 ? e1 * inv : lane == 2 ? e2 * inv : e3 * inv; const int ex = lane == 0 ? ti[0] : lane == 1 ? ti[1] : lane == 2 ? ti[2] : ti[3];
        const int slot = atomicAdd(&cnt[ex], 1); list[ex * LISTCAP + slot] = tok * 4 + lane; gate[tok * 4 + lane] = gv; }
}
__global__ __launch_bounds__(256) void k_router(const float* __restrict__ X1, const float* __restrict__ w, const float* __restrict__ mod, const float* __restrict__ rw, const float* __restrict__ rb,
                                                bf16_t* __restrict__ H2, int* __restrict__ cnt, int* __restrict__ list, float* __restrict__ gate) {
    __shared__ float hrow[4][1024];
    const int wv = threadIdx.x >> 6;
    router_row(X1, w, mod, rw, rb, H2, cnt, list, gate, (LAS float*)hrow[wv], blockIdx.x * 4 + wv, threadIdx.x & 63);
}
__global__ void k_offsets(const int* cnt, int* offs) { if (threadIdx.x == 0) { int o = 0; for (int e = 0; e < NEXP; ++e) { offs[e] = o; o += (cnt[e] + MOEPAD - 1) / MOEPAD * MOEPAD; } offs[NEXP] = o; } }

DEVI void final_row(float* __restrict__ X1, const bf16_t* __restrict__ YSL, const float* __restrict__ mod, const float* __restrict__ fw, int tok, int lane) {
    const int b = tok / SEQ;
    float* row = X1 + (size_t)tok * DM; const float* g2 = mod + b * 6144 + 5120;
    float4 v[4]; float ss = 0.f;
#pragma unroll
    for (int j = 0; j < 4; ++j) { const int k = lane * 4 + 256 * j; v[j] = *(const float4*)(row + k); float f[4] = {0.f, 0.f, 0.f, 0.f};
#pragma unroll
        for (int s = 0; s < 4; ++s) { const uint2 y = *(const uint2*)(YSL + ((size_t)tok * 4 + s) * DM + k);
            f[0] += __uint_as_float(y.x << 16); f[1] += __uint_as_float(y.x & 0xffff0000u); f[2] += __uint_as_float(y.y << 16); f[3] += __uint_as_float(y.y & 0xffff0000u); }
        const float4 gg = *(const float4*)(g2 + k);
        v[j].x += gg.x * f[0]; v[j].y += gg.y * f[1]; v[j].z += gg.z * f[2]; v[j].w += gg.w * f[3];
        ss += v[j].x * v[j].x + v[j].y * v[j].y + v[j].z * v[j].z + v[j].w * v[j].w; }
    const float rstd = rsqrtf(wave_sum(ss) * (1.f / DM) + 1e-6f);
#pragma unroll
    for (int j = 0; j < 4; ++j) { const int k = lane * 4 + 256 * j; const float4 ww = *(const float4*)(fw + k);
        *(float4*)(row + k) = make_float4(v[j].x * rstd * ww.x, v[j].y * rstd * ww.y, v[j].z * rstd * ww.z, v[j].w * rstd * ww.w); }
}
__global__ __launch_bounds__(256) void k_final(float* __restrict__ X1, const bf16_t* __restrict__ YSL, const float* __restrict__ mod, const float* __restrict__ fw) {
    final_row(X1, YSL, mod, fw, blockIdx.x * 4 + (threadIdx.x >> 6), threadIdx.x & 63);
}

typedef short bf16x8 __attribute__((ext_vector_type(8)));
typedef float f32x4 __attribute__((ext_vector_type(4)));
constexpr int NWAVES = 8, NTHR = 512;
constexpr int BM = 256, BK = 64, HALF = 128, HTB = HALF * BK * 2, STAGE_BYTES = 8 * HTB;
constexpr int MISC_OFF = STAGE_BYTES, MISC_BYTES = 1024, LDS_BYTES = STAGE_BYTES + MISC_BYTES;
constexpr int CW_BAR = 4096;

#define XB_TMO      128
#define XB_XCNT(j)  (256  + 64 * (j))
#define XB_XSUB(j)  (1280 + 64 * (j))
#define XB_XGEN(j)  (2304 + 64 * (j))
#define XB_TOP      3328
#define XB_TOPGEN   3392
#define XCD_BAR_WORDS 3456
#define XB_SPIN_CAP (1u << 18)
DEVI unsigned xb_ld(unsigned* p)              { return __hip_atomic_load(p, __ATOMIC_RELAXED, __HIP_MEMORY_SCOPE_AGENT); }
DEVI unsigned xb_add(unsigned* p, unsigned v) { return __hip_atomic_fetch_add(p, v, __ATOMIC_RELAXED, __HIP_MEMORY_SCOPE_AGENT); }
DEVI unsigned xb_xcc_id() { return (unsigned)__builtin_amdgcn_s_getreg((3 << 11) | 20) & 0xFu; }
#define XB_SPIN(cond, bar) do { unsigned _sp = 0; while (cond) { __builtin_amdgcn_s_sleep(1); \
    if ((++_sp & 255u) == 0u) { if (xb_ld(&(bar)[XB_TMO])) break; if (_sp > XB_SPIN_CAP) { atomicAdd(&(bar)[XB_TMO], 1u); break; } } } } while (0)
struct XcdBarrier { unsigned* bar; unsigned x; volatile LAS unsigned* st; };
DEVI XcdBarrier xcd_barrier_post(unsigned* bar, volatile LAS unsigned* st) {
    XcdBarrier b; b.bar = bar; b.x = xb_xcc_id(); b.st = st;
    if (threadIdx.x == 0) (void)xb_add(&bar[XB_XCNT(b.x)], 1u);
    return b;
}
DEVI void xcd_barrier_complete(unsigned* bar, unsigned x, unsigned& nloc, unsigned& nx) {
    const unsigned G = gridDim.x * gridDim.y * gridDim.z;
    unsigned sum, cnt, mine, sp = 0u;
    for (;;) {
        sum = 0u; cnt = 0u; mine = 0u;
#pragma unroll
        for (unsigned j = 0; j < 16; ++j) { const unsigned c = xb_ld(&bar[XB_XCNT(j)]); sum += c; cnt += (c > 0u) ? 1u : 0u; mine = (j == x) ? c : mine; }
        if (sum == G) break;
        __builtin_amdgcn_s_sleep(1);
        if ((++sp & 255u) == 0u) { if (xb_ld(&bar[XB_TMO])) break; if (sp > XB_SPIN_CAP) { atomicAdd(&bar[XB_TMO], 1u); break; } }
    }
    nloc = mine > 0u ? mine : 1u; nx = cnt > 0u ? cnt : 1u;
}
DEVI void xcd_barrier(const XcdBarrier& b) {
    asm volatile("s_waitcnt vmcnt(0)" ::: "memory");
    __syncthreads();
    if (threadIdx.x == 0) {
        unsigned* bar = b.bar;
        __builtin_amdgcn_s_waitcnt(0);
        unsigned nloc = b.st[0], nx = b.st[1];
        if (nloc == 0u) { xcd_barrier_complete(bar, b.x, nloc, nx); b.st[0] = nloc; b.st[1] = nx; }
        const unsigned old = xb_add(&bar[XB_XSUB(b.x)], 1u);
        const unsigned gen = old / nloc;
        if (old + 1u == (gen + 1u) * nloc) {
            __builtin_amdgcn_fence(__ATOMIC_RELEASE, "agent");
            asm volatile("s_waitcnt vmcnt(0)" ::: "memory");
            const unsigned og = xb_add(&bar[XB_TOP], 1u);
            const unsigned tg = og / nx;
            if (og + 1u == (tg + 1u) * nx) xb_add(&bar[XB_TOPGEN], 1u);
            else XB_SPIN(xb_ld(&bar[XB_TOPGEN]) == tg, bar);
            __builtin_amdgcn_fence(__ATOMIC_ACQUIRE, "agent");
            xb_add(&bar[XB_XGEN(b.x)], 1u);
            asm volatile("s_waitcnt vmcnt(0)" ::: "memory");
        } else {
            XB_SPIN(xb_ld(&bar[XB_XGEN(b.x)]) == gen, bar);
            __builtin_amdgcn_fence(__ATOMIC_ACQUIRE, "agent");
            asm volatile("s_waitcnt vmcnt(0)" ::: "memory");
        }
    }
    __syncthreads();
}

DEVI int lds_byte(int r, int c) { const int st = (r >> 4) * 2 + (c >> 5), rr = r & 15, cc = c & 31, ob = rr * 64 + cc * 2; return st * 1024 + (ob ^ (((ob >> 9) & 1) << 5)); }
DEVI void stage_rc(int b, int& R, int& C) { const int st = b / 1024, sb = b % 1024, swz = sb ^ (((sb >> 9) & 1) << 5); R = (st >> 1) * 16 + swz / 64; C = (st & 1) * 32 + (swz % 64) / 2; }
DEVI int perm32(int rho) { const int n = rho >> 4, i = rho & 15; return 8 * (i >> 2) + 4 * n + (i & 3); }
template <class Prob>
DEVI void gemm_phase(LAS unsigned char* lds, const Prob& P, int G, int c) {
    const int tid = threadIdx.x, wid = __builtin_amdgcn_readfirstlane(tid >> 6), lane = tid & 63, wr = wid >> 2, wc = wid & 3, fr = lane & 15, fq = lane >> 4;
    const int K = P.K, nt = K / BK;
    const int nun = P.nunits();
    int L = c; if (L >= nun) return;
    int Rs0, Cs0, Rs1, Cs1; stage_rc(tid * 16, Rs0, Cs0); stage_rc(tid * 16 + 8192, Rs1, Cs1);
    unsigned voffB[2];
    voffB[0] = (unsigned)(((Rs0 & ~31) + perm32(Rs0 & 31)) * K + Cs0) * 2u; voffB[1] = (unsigned)(((Rs1 & ~31) + perm32(Rs1 & 31)) * K + Cs1) * 2u;
    const size_t kstep = (size_t)(BK * 2), hstepB = (size_t)HALF * K * 2, tstepB = 2 * hstepB;
    const unsigned ldsw = (unsigned)wid * 1024u;
    const int aoff = lds_byte(wr * 64 + fr, fq * 8), boff = lds_byte(wc * 32 + fr, fq * 8);
#define G_SA(b, h) (((b) * 2 + (h)) * HTB)
#define G_SB(b, h) ((4 + (b) * 2 + (h)) * HTB)
#define G_STAGE_B(bufoff, gbase) do { _Pragma("unroll") for (int _i = 0; _i < 2; ++_i) \
        __builtin_amdgcn_global_load_lds((const unsigned*)((const char*)(gbase) + voffB[_i]), (LAS unsigned*)(lds + (bufoff) + ldsw + _i * 8192), 16, 0, 0); } while (0)
#define G_STAGE_A(bufoff, gbase, v0, v1) do { \
        __builtin_amdgcn_global_load_lds((const unsigned*)((const char*)(gbase) + (v0)), (LAS unsigned*)(lds + (bufoff) + ldsw), 16, 0, 0); \
        __builtin_amdgcn_global_load_lds((const unsigned*)((const char*)(gbase) + (v1)), (LAS unsigned*)(lds + (bufoff) + ldsw + 8192), 16, 0, 0); } while (0)
#define G_LDA(dst, b, h) do { _Pragma("unroll") for (int m = 0; m < 4; ++m) _Pragma("unroll") for (int k = 0; k < 2; ++k) dst[m][k] = *(const LAS bf16x8*)(lds + G_SA(b, h) + aoff + m * 2048 + k * 1024); } while (0)
#define G_LDB(dst, b, h) do { _Pragma("unroll") for (int n = 0; n < 2; ++n) _Pragma("unroll") for (int k = 0; k < 2; ++k) dst[n][k] = *(const LAS bf16x8*)(lds + G_SB(b, h) + boff + n * 2048 + k * 1024); } while (0)
#define G_MMA(ai, bj, At, Bt) do { __builtin_amdgcn_s_setprio(1); _Pragma("unroll") for (int m = 0; m < 4; ++m) _Pragma("unroll") for (int n = 0; n < 2; ++n) _Pragma("unroll") for (int k = 0; k < 2; ++k) \
        acc[ai][bj][m][n] = __builtin_amdgcn_mfma_f32_16x16x32_bf16(Bt[n][k], At[m][k], acc[ai][bj][m][n], 0, 0, 0); __builtin_amdgcn_s_setprio(0); } while (0)
#define G_WAIT_V(n) asm volatile("s_waitcnt vmcnt(" #n ")" ::: "memory")
#define G_WAIT_L(n) asm volatile("s_waitcnt lgkmcnt(" #n ")" ::: "memory")
#define G_BAR __builtin_amdgcn_s_barrier()
#define G_SCHED __builtin_amdgcn_sched_barrier(0)
    int z, pm, pn; P.unit(L, z, pm, pn);
    z = __builtin_amdgcn_readfirstlane(z); pm = __builtin_amdgcn_readfirstlane(pm); pn = __builtin_amdgcn_readfirstlane(pn);
    unsigned vA00 = P.aoffb(z, pm * BM + Rs0) + Cs0 * 2, vA01 = P.aoffb(z, pm * BM + Rs1) + Cs1 * 2;
    unsigned vA10 = P.aoffb(z, pm * BM + HALF + Rs0) + Cs0 * 2, vA11 = P.aoffb(z, pm * BM + HALF + Rs1) + Cs1 * 2;
    const char* const Ab = (const char*)P.A;
    const char* cB = (const char*)P.Bt(z) + (size_t)pn * tstepB;
    f32x4 acc[2][2][4][2];
    bf16x8 At[4][2], B0[2][2], B1[2][2];
    G_STAGE_B(G_SB(0, 0), cB); G_STAGE_A(G_SA(0, 0), Ab, vA00, vA01); G_STAGE_B(G_SB(0, 1), cB + hstepB); G_STAGE_A(G_SA(0, 1), Ab, vA10, vA11);
    if (wr == 1) G_BAR;
    G_WAIT_V(4); G_BAR;
    G_STAGE_B(G_SB(1, 0), cB + kstep); G_STAGE_A(G_SA(1, 0), Ab + kstep, vA00, vA01); G_STAGE_B(G_SB(1, 1), cB + hstepB + kstep);
    G_WAIT_V(6); G_BAR;
    for (;;) {
        const int Ln = L + G; const bool has_next = Ln < nun;
        int nz = z, npm = pm, npn = pn; if (has_next) P.unit(Ln, nz, npm, npn);
        nz = __builtin_amdgcn_readfirstlane(nz); npm = __builtin_amdgcn_readfirstlane(npm); npn = __builtin_amdgcn_readfirstlane(npn);
        const char* nB = has_next ? (const char*)P.Bt(nz) + (size_t)npn * tstepB : cB;
#pragma unroll
        for (int a = 0; a < 2; ++a)
#pragma unroll
            for (int b = 0; b < 2; ++b)
#pragma unroll
                for (int m = 0; m < 4; ++m)
#pragma unroll
                    for (int n = 0; n < 2; ++n) acc[a][b][m][n] = (f32x4){0.f, 0.f, 0.f, 0.f};
        for (int t = 0; t < nt; t += 2) {
            const bool last = (t == nt - 2);
            unsigned n00 = vA00, n01 = vA01, n10 = vA10, n11 = vA11;
            if (last && has_next) { n00 = P.aoffb(nz, npm * BM + Rs0) + Cs0 * 2; n01 = P.aoffb(nz, npm * BM + Rs1) + Cs1 * 2;
                n10 = P.aoffb(nz, npm * BM + HALF + Rs0) + Cs0 * 2; n11 = P.aoffb(nz, npm * BM + HALF + Rs1) + Cs1 * 2; }
            const char* a1 = Ab + (size_t)(t + 1) * kstep;
            const char* a2 = last ? Ab : Ab + (size_t)(t + 2) * kstep; const char* b2 = last ? nB : cB + (size_t)(t + 2) * kstep;
            const char* a3 = a2 + kstep; const char* b3 = b2 + kstep;
            G_LDB(B0, 0, 0); G_SCHED; G_LDA(At, 0, 0); G_STAGE_A(G_SA(1, 1), a1, vA10, vA11);
            G_WAIT_L(8); G_BAR; G_WAIT_L(0); G_MMA(0, 0, At, B0); G_BAR; G_SCHED;
            if (last) { vA00 = n00; vA01 = n01; vA10 = n10; vA11 = n11; }
            G_LDB(B1, 0, 1); G_STAGE_B(G_SB(0, 0), b2);
            G_BAR; G_WAIT_L(0); G_MMA(0, 1, At, B1); G_BAR;
            G_LDA(At, 0, 1); G_STAGE_A(G_SA(0, 0), a2, vA00, vA01);
            G_BAR; G_WAIT_L(0); G_MMA(1, 0, At, B0); G_BAR; G_SCHED;
            G_STAGE_B(G_SB(0, 1), b2 + hstepB);
            G_WAIT_V(6); G_BAR; G_MMA(1, 1, At, B1); G_BAR;
            G_LDB(B0, 1, 0); G_SCHED; G_LDA(At, 1, 0); G_STAGE_A(G_SA(0, 1), a2, vA10, vA11);
            G_WAIT_L(8); G_BAR; G_WAIT_L(0); G_MMA(0, 0, At, B0); G_BAR; G_SCHED;
            G_LDB(B1, 1, 1); G_STAGE_B(G_SB(1, 0), b3);
            G_BAR; G_WAIT_L(0); G_MMA(0, 1, At, B1); G_BAR;
            G_LDA(At, 1, 1); G_STAGE_A(G_SA(1, 0), a3, vA00, vA01);
            G_BAR; G_WAIT_L(0); G_MMA(1, 0, At, B0); G_BAR; G_SCHED;
            G_STAGE_B(G_SB(1, 1), b3 + hstepB);
            G_WAIT_V(6); G_BAR; G_MMA(1, 1, At, B1); G_BAR;
        }
        { const int Mz = __builtin_amdgcn_readfirstlane(P.M(z));
#pragma unroll
          for (int ai = 0; ai < 2; ++ai)
#pragma unroll
            for (int m = 0; m < 4; ++m) { const int row = pm * BM + ai * HALF + wr * 64 + m * 16 + fr;
                if (row < Mz) {
#pragma unroll
                    for (int bj = 0; bj < 2; ++bj) { const int c0 = pn * BM + bj * HALF + wc * 32 + 8 * fq;
                        const f32x4 v0 = acc[ai][bj][m][0], v1 = acc[ai][bj][m][1];
                        const float v[8] = {v0[0], v0[1], v0[2], v0[3], v1[0], v1[1], v1[2], v1[3]};
                        P.store(z, row, c0, v); } }
                asm volatile("" ::: "memory"); } }
        if (!has_next) break;
        z = nz; pm = npm; pn = npn; cB = nB; L = Ln;
    }
    G_WAIT_V(0);
    if (wr == 0) G_BAR;
    G_BAR;
}

struct FMoe1 {
    const bf16_t* A; const bf16_t* B; int K; const int* cnt; const int* list; const float* b_gu; bf16_t* ACT; const LAS int* ub;
    static constexpr int NT = 8;
    DEVI int ubs(int e) const { return __builtin_amdgcn_readfirstlane(ub[e]); }
    DEVI int nunits() const { return ubs(NEXP) * NT; }
    DEVI void unit(int L, int& z, int& pm, int& pn) const { int e = 0; while (e < NEXP - 1 && L >= ubs(e + 1) * NT) ++e; const int u0 = ubs(e), l = L - u0 * NT, mt = ubs(e + 1) - u0; z = e; pm = l % mt; pn = l / mt; }
    DEVI int M(int z) const { return cnt[z]; }
    DEVI unsigned aoffb(int z, int r) const { const int t = r < cnt[z] ? (list[z * LISTCAP + r] >> 2) : 0; return (unsigned)t * (unsigned)(DM * 2); }
    DEVI const bf16_t* Bt(int z) const { return B + (size_t)z * 2048 * DM; }
    DEVI void store(int z, int r, int c0, const float (&v)[8]) const {
        const int f0 = (c0 >> 3) * 4; const float* bg = b_gu + (size_t)z * 2048 + f0; float a[4];
#pragma unroll
        for (int i = 0; i < 4; ++i) { float g = v[i] + bg[i], l = v[4 + i] + bg[1024 + i]; g = fminf(g, 7.f); l = fminf(fmaxf(l, -7.f), 7.f); a[i] = (l + 1.f) * (g * sigmoidf_(1.702f * g)); }
        uint2 o; o.x = pk2(a[0], a[1]); o.y = pk2(a[2], a[3]);
        *(uint2*)(ACT + (size_t)(ub[z] * 256 + r) * DFF + f0) = o;
    }
};
struct FMoe2 {
    const bf16_t* A; const bf16_t* B; int K; const int* cnt; const int* list; const float* b_down; const float* gate; bf16_t* YSL; const LAS int* ub;
    static constexpr int NT = 4;
    DEVI int ubs(int e) const { return __builtin_amdgcn_readfirstlane(ub[e]); }
    DEVI int nunits() const { return ubs(NEXP) * NT; }
    DEVI void unit(int L, int& z, int& pm, int& pn) const { int e = 0; while (e < NEXP - 1 && L >= ubs(e + 1) * NT) ++e; const int u0 = ubs(e), l = L - u0 * NT, mt = ubs(e + 1) - u0; z = e; pm = l % mt; pn = l / mt; }
    DEVI int M(int z) const { return cnt[z]; }
    DEVI unsigned aoffb(int z, int r) const { return (unsigned)(ub[z] * 256 + r) * (unsigned)(DFF * 2); }
    DEVI const bf16_t* Bt(int z) const { return B + (size_t)z * DM * DFF; }
    DEVI void store(int z, int r, int c0, const float (&v)[8]) const {
        const int ent = list[z * LISTCAP + r]; const float gt = gate[ent]; const float* bd = b_down + (size_t)z * DM + c0;
        uint4 o; o.x = pk2((v[0] + bd[0]) * gt, (v[1] + bd[1]) * gt); o.y = pk2((v[2] + bd[2]) * gt, (v[3] + bd[3]) * gt);
        o.z = pk2((v[4] + bd[4]) * gt, (v[5] + bd[5]) * gt); o.w = pk2((v[6] + bd[6]) * gt, (v[7] + bd[7]) * gt);
        *(uint4*)(YSL + (size_t)ent * DM + c0) = o;
    }
};

struct MArgs { const float* in[30]; float* out; unsigned char* ws; int ph_lo, ph_hi; };
constexpr int NPH = 11;

DEVI void wconv_tile(const float* __restrict__ src, bf16_t* __restrict__ dst, int K, int N, int mode, int n0, int k0, LAS float* t, int ht, bool act) {
    const int nl = ht & 63, kq = ht >> 6;
    if (act) { const int nd = n0 + nl, sc = mode ? wsrc_col<1>(nd) : nd; const bool valid = sc < N;
#pragma unroll 4
        for (int i = 0; i < 16; ++i) { const int kk = kq + 4 * i; t[kk * 65 + nl] = valid ? src[(size_t)(k0 + kk) * N + sc] : 0.f; } }
    __syncthreads();
    if (act) {
#pragma unroll
        for (int i = 0; i < 2; ++i) { const int ch = ht + 256 * i, n = ch >> 3, c8 = ch & 7; const LAS float* q = t + (c8 * 8) * 65 + n;
            uint4 o; o.x = pk2(q[0], q[65]); o.y = pk2(q[2 * 65], q[3 * 65]); o.z = pk2(q[4 * 65], q[5 * 65]); o.w = pk2(q[6 * 65], q[7 * 65]);
            *(uint4*)(dst + (size_t)(n0 + n) * K + k0 + c8 * 8) = o; } }
    __syncthreads();
}

DEVI void ph_prep(const MArgs& a, LAS unsigned char* lds, int bid, int G) {
    const int tid = threadIdx.x, wave = tid >> 6, lane = tid & 63;
    unsigned char* ws = a.ws;
    if (bid < 96) {
        LAS float* s = (LAS float*)lds; LAS float* part = (LAS float*)(lds + 36864);
        const float* c = a.in[1]; const float* cc = a.in[3]; const float* ada_w = a.in[4]; const float* ada_b = a.in[5]; float* mod = (float*)(ws + OFF_MOD);
        for (int i = tid; i < 9216; i += NTHR) { const int r = i >> 10, k = i & 1023; const float v = r < 8 ? c[r * 1024 + k] : cc[k]; s[i] = siluf_(v); }
        __syncthreads();
        const int j = bid * 64 + lane; float acc[9];
#pragma unroll
        for (int r = 0; r < 9; ++r) acc[r] = 0.f;
#pragma unroll 4
        for (int k = wave * 128; k < wave * 128 + 128; ++k) { const float w = ada_w[(size_t)k * 6144 + j];
#pragma unroll
            for (int r = 0; r < 9; ++r) acc[r] += s[r * 1024 + k] * w; }
#pragma unroll
        for (int r = 0; r < 9; ++r) part[(wave * 9 + r) * 64 + lane] = acc[r];
        __syncthreads();
        for (int i = tid; i < 576; i += NTHR) { const int r = i >> 6, l = i & 63; float sum = 0.f;
#pragma unroll
            for (int w = 0; w < 8; ++w) sum += part[(w * 9 + r) * 64 + l];
            mod[r * 6144 + bid * 64 + l] = sum + ada_b[bid * 64 + l]; }
        __syncthreads();
    } else if (bid < 104) {
        s5prep_one(a.in[11], a.in[12], a.in[13], a.in[14], a.in[15], (S5P*)(ws + OFF_S5P), (bid - 96) * NTHR + tid);
    }
    constexpr int I0 = 36 * 16, I1 = I0 + 8 * 8, I2 = I1 + 16 * 16, I3 = I2 + 32 * 32 * 16, I4 = I3 + 32 * 16 * 16;
    const int half = tid >> 8, ht = tid & 255; LAS float* t = (LAS float*)(lds + half * 17408);
    for (int base = bid * 2; base < I4; base += 2 * G) {
        const int it = base + half; const bool act = it < I4;
        const float* src = nullptr; bf16_t* dst = nullptr; int K = 0, N = 0, mode = 0, n0 = 0, k0 = 0;
        if (act) {
            if (it < I0) { src = a.in[7]; dst = (bf16_t*)(ws + OFF_WIN); K = DM; N = INC; n0 = (it % 36) * 64; k0 = (it / 36) * 64; }
            else if (it < I1) { const int r = it - I0; src = a.in[19]; dst = (bf16_t*)(ws + OFF_WGLU); K = 512; N = 512; n0 = (r % 8) * 64; k0 = (r / 8) * 64; }
            else if (it < I2) { const int r = it - I1; src = a.in[21]; dst = (bf16_t*)(ws + OFF_WOUT); K = DM; N = DM; n0 = (r % 16) * 64; k0 = (r / 16) * 64; }
            else if (it < I3) { const int r = it - I2, e = r / 512, q = r % 512; src = a.in[25] + (size_t)e * DM * 2048; dst = (bf16_t*)(ws + OFF_WG) + (size_t)e * 2048 * DM; K = DM; N = 2048; mode = 1; n0 = (q % 32) * 64; k0 = (q / 32) * 64; }
            else { const int r = it - I3, e = r / 256, q = r % 256; src = a.in[27] + (size_t)e * DFF * DM; dst = (bf16_t*)(ws + OFF_WD) + (size_t)e * DM * DFF; K = DFF; N = DM; n0 = (q % 16) * 64; k0 = (q / 16) * 64; }
        }
        wconv_tile(src, dst, K, N, mode, n0, k0, t, ht, act);
    }
}

DEVI void build_ub(const int* cnt, volatile LAS int* ub) {
    if (threadIdx.x == 0) { int o = 0; for (int e = 0; e < NEXP; ++e) { ub[e] = o; o += (cnt[e] + 255) >> 8; } ub[NEXP] = o; }
    __syncthreads();
}

__global__ void __launch_bounds__(NTHR, 2) mega(MArgs a) {
    extern __shared__ __attribute__((aligned(16))) unsigned char lds_raw[];
    LAS unsigned char* lds = (LAS unsigned char*)lds_raw;
    volatile LAS unsigned* MISC = (volatile LAS unsigned*)(lds + MISC_OFF);
    const int tid = threadIdx.x, lane = tid & 63, wave = __builtin_amdgcn_readfirstlane(tid >> 6), G = gridDim.x, bid = blockIdx.x;
    const int gw = bid * NWAVES + wave, NGW = G * NWAVES;
    for (int u = tid; u < MISC_BYTES / 4; u += NTHR) MISC[u] = 0u;
    __syncthreads();
    unsigned char* ws = a.ws; unsigned* ctl = (unsigned*)(ws + OFF_CTL);
    const bool multi = (a.ph_hi - a.ph_lo) > 1;
    XcdBarrier bar; bar.bar = ctl + CW_BAR; bar.x = 0; bar.st = MISC;
    if (multi) bar = xcd_barrier_post(ctl + CW_BAR, MISC);
    volatile LAS int* ub = (volatile LAS int*)(MISC + 16);
#define IN(k) (a.ph_lo <= (k) && (k) < a.ph_hi)
#define SEAM(k) do { if (IN(k) && IN((k) + 1)) xcd_barrier(bar); } while (0)
    float* mod = (float*)(ws + OFF_MOD); S5P* s5p = (S5P*)(ws + OFF_S5P); float* gate = (float*)(ws + OFF_GATE); int* list = (int*)(ws + OFF_LIST);
    bf16_t* WIN = (bf16_t*)(ws + OFF_WIN); bf16_t* WGLU = (bf16_t*)(ws + OFF_WGLU); bf16_t* WOUT = (bf16_t*)(ws + OFF_WOUT); bf16_t* WG = (bf16_t*)(ws + OFF_WG); bf16_t* WD = (bf16_t*)(ws + OFF_WD);
    bf16_t* H = (bf16_t*)(ws + OFF_H); bf16_t* QK = (bf16_t*)(ws + OFF_QK); bf16_t* V = (bf16_t*)(ws + OFF_V); bf16_t* R = (bf16_t*)(ws + OFF_R); bf16_t* UT = (bf16_t*)(ws + OFF_UT);
    float* LR = (float*)(ws + OFF_LR); bf16_t* U2 = (bf16_t*)(ws + OFF_U2); float* OF = (float*)(ws + OFF_OF); float* OB = (float*)(ws + OFF_OB); float* YF = (float*)(ws + OFF_YF); float* YB = (float*)(ws + OFF_YB);
    bf16_t* YS = (bf16_t*)(ws + OFF_YS); bf16_t* MIX = (bf16_t*)(ws + OFF_MIX); bf16_t* ACT = (bf16_t*)(ws + OFF_ACT); bf16_t* YSL = (bf16_t*)(ws + OFF_YSL);
    int* cnt = (int*)(ctl + CW_CNT);

    if (IN(0)) ph_prep(a, lds, bid, G);
    SEAM(0);
    if (IN(1)) for (int row = gw; row < NROWS; row += NGW) norm_row(a.in[0], a.in[2], a.in[6], mod, H, row, lane, 0, 1024);
    SEAM(1);
    if (IN(2)) { ProbIn P{H, DM, WIN, DM, DM, QK, V, R, UT, U2, LR}; gemm_phase(lds, P, G, bid); }
    SEAM(2);
    if (IN(3)) {
        if (bid < 64) gla_naive_body(QK, V, LR, a.in[8], a.in[9], OF, OB, (LAS float*)lds, bid);
        else if (bid < 128) s5_naive_body(UT, s5p, a.in[16], a.in[17], YF, YB, (LAS float*)lds + wave * 128, (bid - 64) * NWAVES + wave, lane);
    }
    SEAM(3);
    if (IN(4)) {
        for (int tok = gw; tok < NTOK; tok += NGW) gla_post_row(OF, OB, R, a.in[10], MIX, tok, lane);
        const float* dvec = a.in[18];
        for (size_t i = (size_t)bid * NTHR + tid; i < (size_t)NTOK * 512; i += (size_t)G * NTHR) { const int j = (int)(i & 511); YS[i] = f2bf(gelu_tanh(YF[i] + YB[i] + dvec[j] * bf2f(UT[i]))); }
    }
    SEAM(4);
    if (IN(5)) { ProbGlu P{YS, 512, WGLU, 512, 512, a.in[20], MIX}; gemm_phase(lds, P, G, bid); }
    SEAM(5);
    if (IN(6)) { ProbOut P{MIX, DM, WOUT, DM, DM, a.in[0], mod, a.out}; gemm_phase(lds, P, G, bid); }
    SEAM(6);
    if (IN(7)) for (int tok = gw; tok < NTOK; tok += NGW) router_row(a.out, a.in[22], mod, a.in[23], a.in[24], H, cnt, list, gate, (LAS float*)lds + wave * 1024, tok, lane);
    SEAM(7);
    if (IN(8)) { build_ub(cnt, ub); FMoe1 P{H, WG, DM, cnt, list, a.in[26], ACT, (const LAS int*)ub}; gemm_phase(lds, P, G, bid); }
    SEAM(8);
    if (IN(9)) { build_ub(cnt, ub); FMoe2 P{ACT, WD, DFF, cnt, list, a.in[28], gate, YSL, (const LAS int*)ub}; gemm_phase(lds, P, G, bid); }
    SEAM(9);
    if (IN(10)) for (int tok = gw; tok < NTOK; tok += NGW) final_row(a.out, YSL, mod, a.in[29], tok, lane);
#undef IN
#undef SEAM
}

#ifndef MEGA_SINGLE
#define MEGA_SINGLE 1
#endif
extern "C" void kernel_launch(void* const* d_in, const int* in_sizes, int n_in, void* d_out, int out_size, void* d_ws, size_t ws_size, hipStream_t stream) {
    static int grid = 0;
    if (grid == 0) {
        if (ws_size < WS_NEED || n_in != 30) { fprintf(stderr, "kernel_launch: workspace too small (%zu < %zu) or n_in %d != 30\n", ws_size, (size_t)WS_NEED, n_in); grid = -1; return; }
        int dev = 0, cus = 0, per_cu = 0;
        if (hipGetDevice(&dev) != hipSuccess || hipDeviceGetAttribute(&cus, hipDeviceAttributeMultiprocessorCount, dev) != hipSuccess) { grid = -1; return; }
        if (hipFuncSetAttribute((const void*)mega, hipFuncAttributeMaxDynamicSharedMemorySize, LDS_BYTES) != hipSuccess) { fprintf(stderr, "kernel_launch: hipFuncSetAttribute failed\n"); grid = -1; return; }
        if (hipOccupancyMaxActiveBlocksPerMultiprocessor(&per_cu, (const void*)mega, NTHR, LDS_BYTES) != hipSuccess || per_cu < 1) { fprintf(stderr, "kernel_launch: occupancy query says %d blocks per CU\n", per_cu); per_cu = 1; }
        (void)hipGetLastError();
        grid = cus;
    }
    if (grid < 0) return;
    (void)hipMemsetAsync((char*)d_ws + OFF_CTL, 0, 64 * 1024, stream);
    MArgs a{};
    for (int i = 0; i < 30; ++i) a.in[i] = (const float*)d_in[i];
    a.out = (float*)d_out; a.ws = (unsigned char*)d_ws;
#if MEGA_SINGLE
    a.ph_lo = 0; a.ph_hi = NPH;
    { void* args[] = {&a}; hipError_t e = hipLaunchCooperativeKernel((const void*)mega, dim3(grid), dim3(NTHR), args, LDS_BYTES, stream);
      if (e != hipSuccess) fprintf(stderr, "kernel_launch: cooperative launch failed: %s (grid %d)\n", hipGetErrorString(e), grid); }
#else
    for (int p = 0; p < NPH; ++p) { a.ph_lo = p; a.ph_hi = p + 1; hipLaunchKernelGGL(mega, dim3(grid), dim3(NTHR), LDS_BYTES, stream, a); }
#endif
}

#ifdef RES_TEST
__global__ void __launch_bounds__(NTHR, 2) t_in(MArgs a) { extern __shared__ __attribute__((aligned(16))) unsigned char l[]; unsigned char* ws = a.ws;
  ProbIn P{(bf16_t*)(ws + OFF_H), DM, (bf16_t*)(ws + OFF_WIN), DM, DM, (bf16_t*)(ws + OFF_QK), (bf16_t*)(ws + OFF_V), (bf16_t*)(ws + OFF_R), (bf16_t*)(ws + OFF_UT), (bf16_t*)(ws + OFF_U2), (float*)(ws + OFF_LR)}; gemm_phase((LAS unsigned char*)l, P, gridDim.x, blockIdx.x); }
__global__ void __launch_bounds__(NTHR, 2) t_glu(MArgs a) { extern __shared__ __attribute__((aligned(16))) unsigned char l[]; unsigned char* ws = a.ws;
  ProbGlu P{(bf16_t*)(ws + OFF_YS), 512, (bf16_t*)(ws + OFF_WGLU), 512, 512, a.in[20], (bf16_t*)(ws + OFF_MIX)}; gemm_phase((LAS unsigned char*)l, P, gridDim.x, blockIdx.x); }
__global__ void __launch_bounds__(NTHR, 2) t_out(MArgs a) { extern __shared__ __attribute__((aligned(16))) unsigned char l[]; unsigned char* ws = a.ws;
  ProbOut P{(bf16_t*)(ws + OFF_MIX), DM, (bf16_t*)(ws + OFF_WOUT), DM, DM, a.in[0], (float*)(ws + OFF_MOD), a.out}; gemm_phase((LAS unsigned char*)l, P, gridDim.x, blockIdx.x); }
__global__ void __launch_bounds__(NTHR, 2) t_m1(MArgs a) { extern __shared__ __attribute__((aligned(16))) unsigned char l[]; unsigned char* ws = a.ws; LAS unsigned char* lds = (LAS unsigned char*)l;
  FMoe1 P{(bf16_t*)(ws + OFF_H), (bf16_t*)(ws + OFF_WG), DM, (int*)(ws + 4096), (int*)(ws + OFF_LIST), a.in[26], (bf16_t*)(ws + OFF_ACT), (const LAS int*)(lds + MISC_OFF + 64)}; gemm_phase(lds, P, gridDim.x, blockIdx.x); }
__global__ void __launch_bounds__(NTHR, 2) t_m2(MArgs a) { extern __shared__ __attribute__((aligned(16))) unsigned char l[]; unsigned char* ws = a.ws; LAS unsigned char* lds = (LAS unsigned char*)l;
  FMoe2 P{(bf16_t*)(ws + OFF_ACT), (bf16_t*)(ws + OFF_WD), DFF, (int*)(ws + 4096), (int*)(ws + OFF_LIST), a.in[28], (float*)(ws + OFF_GATE), (bf16_t*)(ws + OFF_YSL), (const LAS int*)(lds + MISC_OFF + 64)}; gemm_phase(lds, P, gridDim.x, blockIdx.x); }
#endif
```

```cpp
#include <hip/hip_runtime.h>
#include <stdint.h>
#include <stdio.h>

typedef unsigned short bf16_t;
#define DEVI __device__ __forceinline__
#define LAS __attribute__((address_space(3)))

constexpr int NB = 8, SEQ = 4096, DM = 1024, CTX = 256;
constexpr int NTOK = NB * SEQ;
constexpr int NCTX = NB * CTX;
constexpr int NROWS = NTOK + NCTX;
constexpr int INC = 2080, INP = 2304;
constexpr int NEXP = 32, TOPK = 4, DFF = 1024;
constexpr int LISTCAP = NTOK;
constexpr int MOEPAD = 256;

constexpr size_t MiB = 1024ull * 1024ull;
constexpr size_t OFF_CTL = 0;
constexpr size_t OFF_MOD = 64 * 1024;
constexpr size_t OFF_S5P = OFF_MOD + 256 * 1024;
constexpr size_t OFF_GATE = OFF_S5P + 1 * MiB;
constexpr size_t OFF_LIST = OFF_GATE + 512 * 1024;
constexpr size_t OFF_WIN = OFF_LIST + 4 * MiB;
constexpr size_t OFF_WGLU = OFF_WIN + (size_t)INP * DM * 2;
constexpr size_t OFF_WOUT = OFF_WGLU + 512 * 512 * 2;
constexpr size_t OFF_WG = OFF_WOUT + (size_t)DM * DM * 2;
constexpr size_t OFF_WD = OFF_WG + (size_t)NEXP * 2048 * DM * 2;
constexpr size_t OFF_S5BF = OFF_WD + (size_t)NEXP * DM * DFF * 2;
constexpr size_t OFF_S5BY = OFF_S5BF + (size_t)32 * 256 * 256 * 2;
constexpr size_t OFF_H = OFF_S5BY + (size_t)32 * 256 * 512 * 2;
constexpr size_t OFF_RA = OFF_H + (size_t)NROWS * DM * 2;
constexpr size_t OFF_QK = OFF_RA;
constexpr size_t OFF_V = OFF_QK + (size_t)NROWS * 512 * 2;
constexpr size_t OFF_R = OFF_V + (size_t)NROWS * 512 * 2;
constexpr size_t OFF_UT = OFF_R + (size_t)NROWS * 512 * 2;
constexpr size_t OFF_LR = OFF_UT + (size_t)NROWS * 512 * 2;
constexpr size_t OFF_U2 = OFF_LR + (size_t)NROWS * 32 * 4;
constexpr size_t OFF_YS = OFF_U2 + (size_t)32 * 2304 * 512 * 2;
constexpr size_t OFF_MIX = OFF_YS + (size_t)NTOK * 512 * 2;
constexpr size_t OFF_F = OFF_MIX + (size_t)NTOK * DM * 2;
constexpr size_t OFF_UCH = OFF_F + (size_t)32 * 2304 * 256 * 4;
constexpr size_t OFF_ADEC = OFF_UCH + (size_t)64 * 68 * 8192 * 2;
constexpr size_t OFF_SST = OFF_ADEC + (size_t)64 * 68 * 64 * 4;
constexpr size_t OFF_RA_END = OFF_SST + (size_t)64 * 64 * 8192 * 2;
constexpr int ACT_ROWS = NTOK * TOPK + NEXP * MOEPAD;
constexpr size_t OFF_ACT = OFF_RA;
constexpr size_t OFF_YSL = OFF_ACT + (size_t)ACT_ROWS * DFF * 2;
constexpr size_t OFF_END2 = OFF_YSL + (size_t)NTOK * TOPK * DM * 2;
constexpr size_t WS_NEED = OFF_RA_END > OFF_END2 ? OFF_RA_END : OFF_END2;
static_assert(WS_NEED <= 1024 * MiB, "workspace map exceeds 1 GiB");

constexpr int CW_CNT = 1024;
constexpr int CW_OFFS = 1088;

DEVI float bf2f(bf16_t b) { return __uint_as_float(((unsigned)b) << 16); }
DEVI bf16_t f2bf(float f) { unsigned u = __float_as_uint(f); u += 0x7fffu + ((u >> 16) & 1u); return (bf16_t)(u >> 16); }
DEVI unsigned pk2(float lo, float hi) { return (unsigned)f2bf(lo) | ((unsigned)f2bf(hi) << 16); }
DEVI float wave_sum(float v) {
#pragma unroll
    for (int o = 1; o < 64; o <<= 1) v += __shfl_xor(v, o);
    return v;
}
DEVI float sigmoidf_(float x) { return 1.f / (1.f + __expf(-x)); }
DEVI float siluf_(float x) { return x / (1.f + __expf(-x)); }
DEVI float logsigmoidf_(float g) { return fminf(g, 0.f) - log1pf(__expf(-fabsf(g))); }
DEVI float gelu_tanh(float x) { const float u = 0.7978845608028654f * (x + 0.044715f * x * x * x); return 0.5f * x * (1.f + tanhf(u)); }

__global__ __launch_bounds__(256) void k_mod(const float* __restrict__ c, const float* __restrict__ c_ctx, const float* __restrict__ ada_w,
                                             const float* __restrict__ ada_b, float* __restrict__ mod) {
    __shared__ float s[9][1024];
    for (int i = threadIdx.x; i < 9 * 1024; i += 256) { const int r = i >> 10, k = i & 1023; const float v = r < 8 ? c[r * 1024 + k] : c_ctx[k]; s[r][k] = siluf_(v); }
    __syncthreads();
    const int j = blockIdx.x * 256 + threadIdx.x;
    float acc[9];
#pragma unroll
    for (int r = 0; r < 9; ++r) acc[r] = 0.f;
    for (int k = 0; k < 1024; ++k) { const float w = ada_w[(size_t)k * 6144 + j];
#pragma unroll
        for (int r = 0; r < 9; ++r) acc[r] += s[r][k] * w; }
    const float bb = ada_b[j];
#pragma unroll
    for (int r = 0; r < 9; ++r) mod[r * 6144 + j] = acc[r] + bb;
}

template <int MODE> DEVI int wsrc_col(int nd) { if (MODE == 1) { const int q = nd >> 3, i = nd & 7; return i < 4 ? 4 * q + i : 1024 + 4 * q + (i - 4); } return nd; }
template <int MODE> __global__ __launch_bounds__(256) void k_wconv(const float* __restrict__ src, bf16_t* __restrict__ dst, int K, int N, int Nd) {
    __shared__ float t[64][65];
    const int e = blockIdx.z; src += (size_t)e * K * N; dst += (size_t)e * Nd * K;
    const int n0 = blockIdx.x * 64, k0 = blockIdx.y * 64, tid = threadIdx.x, nl = tid & 63, kq = tid >> 6;
    const int nd = n0 + nl, sc = wsrc_col<MODE>(nd); const bool valid = sc < N;
#pragma unroll 4
    for (int i = 0; i < 16; ++i) { const int kk = kq + 4 * i; t[kk][nl] = valid ? src[(size_t)(k0 + kk) * N + sc] : 0.f; }
    __syncthreads();
#pragma unroll
    for (int i = 0; i < 2; ++i) { const int ch = tid + 256 * i, n = ch >> 3, c8 = ch & 7;
        uint4 o; o.x = pk2(t[c8 * 8 + 0][n], t[c8 * 8 + 1][n]); o.y = pk2(t[c8 * 8 + 2][n], t[c8 * 8 + 3][n]); o.z = pk2(t[c8 * 8 + 4][n], t[c8 * 8 + 5][n]); o.w = pk2(t[c8 * 8 + 6][n], t[c8 * 8 + 7][n]);
        *(uint4*)(dst + (size_t)(n0 + n) * K + k0 + c8 * 8) = o; }
}

struct S5P { float lamb[2][32][64][2]; float bbar[2][32][64][16][2]; float lam16[2][32][64][2]; };
DEVI void s5prep_one(const float* lam_re, const float* lam_im, const float* log_dt, const float* b_re, const float* b_im, S5P* P, int i) {
    const int p = i & 63, g = (i >> 6) & 31, d = i >> 11;
    const double dt = exp((double)log_dt[d * 32 + g]);
    const double lr = lam_re[i], li = lam_im[i];
    const double mag = exp(lr * dt), ar = mag * cos(li * dt), ai = mag * sin(li * dt);
    const double nr = ar - 1.0, ni = ai, den = lr * lr + li * li;
    const double cr = (nr * lr + ni * li) / den, ci = (ni * lr - nr * li) / den;
    P->lamb[d][g][p][0] = (float)ar; P->lamb[d][g][p][1] = (float)ai;
    for (int h = 0; h < 16; ++h) { const double br = b_re[(size_t)i * 16 + h], bi = b_im[(size_t)i * 16 + h];
        P->bbar[d][g][p][h][0] = (float)(cr * br - ci * bi); P->bbar[d][g][p][h][1] = (float)(cr * bi + ci * br); }
}
__global__ void k_s5prep(const float* lam_re, const float* lam_im, const float* log_dt, const float* b_re, const float* b_im, S5P* P) {
    const int i = blockIdx.x * blockDim.x + threadIdx.x; if (i >= 2 * 32 * 64) return;
    s5prep_one(lam_re, lam_im, log_dt, b_re, b_im, P, i);
}

DEVI void norm_row(const float* __restrict__ x, const float* __restrict__ ctx, const float* __restrict__ w, const float* __restrict__ mod,
                                              bf16_t* __restrict__ H, int row, int lane, int sh_off, int sc_off) {
    const float* src; int b;
    if (row < NTOK) { src = x + (size_t)row * DM; b = row / SEQ; } else { src = ctx + (size_t)(row - NTOK) * DM; b = 8; }
    float4 v[4]; float ss = 0.f;
#pragma unroll
    for (int j = 0; j < 4; ++j) { v[j] = *(const float4*)(src + lane * 4 + 256 * j); ss += v[j].x * v[j].x + v[j].y * v[j].y + v[j].z * v[j].z + v[j].w * v[j].w; }
    const float rstd = rsqrtf(wave_sum(ss) * (1.f / DM) + 1e-6f);
    const float* msh = mod + b * 6144 + sh_off; const float* msc = mod + b * 6144 + sc_off;
#pragma unroll
    for (int j = 0; j < 4; ++j) { const int k = lane * 4 + 256 * j;
        const float4 ww = *(const float4*)(w + k), sc = *(const float4*)(msc + k), sh = *(const float4*)(msh + k);
        uint2 o; o.x = pk2(v[j].x * rstd * ww.x * (1.f + sc.x) + sh.x, v[j].y * rstd * ww.y * (1.f + sc.y) + sh.y);
        o.y = pk2(v[j].z * rstd * ww.z * (1.f + sc.z) + sh.z, v[j].w * rstd * ww.w * (1.f + sc.w) + sh.w);
        *(uint2*)(H + (size_t)row * DM + k) = o; }
}
__global__ __launch_bounds__(256) void k_norm(const float* __restrict__ x, const float* __restrict__ ctx, const float* __restrict__ w, const float* __restrict__ mod,
                                              bf16_t* __restrict__ H, int nrows, int sh_off, int sc_off) {
    const int row = blockIdx.x * 4 + (threadIdx.x >> 6), lane = threadIdx.x & 63; if (row >= nrows) return;
    norm_row(x, ctx, w, mod, H, row, lane, sh_off, sc_off);
}

DEVI void dense_unit(int L, int nM, int nN, int& pm, int& pn) {
    const int nwg = nM * nN; int wgid = L; { const int q = nwg / 8, r = nwg % 8, xcd = wgid % 8, off = wgid / 8; wgid = (xcd < r ? xcd * (q + 1) : r * (q + 1) + (xcd - r) * q) + off; }
    const int nig = 8 * nN, gid = wgid / nig, fm = gid * 8, gsz = (nM - fm) < 8 ? (nM - fm) : 8;
    pm = fm + ((wgid % nig) % gsz); pn = (wgid % nig) / gsz;
}
template <class Prob> __global__ __launch_bounds__(256) void k_gemm_naive(Prob P) {
    __shared__ float As[32][68], Bs[32][68];
    const int z = blockIdx.z, M = P.M(z), r0 = blockIdx.y * 64, c0 = blockIdx.x * 64; if (r0 >= M) return;
    const int tid = threadIdx.x, tx = tid & 7, ty = tid >> 3, K = P.K;
    const int lr = tid >> 2, lk = (tid & 3) * 8;
    const bool arow_ok = (r0 + lr) < M;
    const bf16_t* ap = P.A + (size_t)(arow_ok ? P.arow(z, r0 + lr) : 0) * P.lda + lk;
    const bf16_t* bp = P.Bt(z) + (size_t)(c0 + lr) * P.ldb + lk;
    float acc[2][8];
#pragma unroll
    for (int i = 0; i < 2; ++i)
#pragma unroll
        for (int j = 0; j < 8; ++j) acc[i][j] = 0.f;
    for (int k0 = 0; k0 < K; k0 += 32) {
        uint4 av = arow_ok ? *(const uint4*)(ap + k0) : make_uint4(0, 0, 0, 0); const uint4 bv = *(const uint4*)(bp + k0);
        const unsigned aw[4] = {av.x, av.y, av.z, av.w}, bw[4] = {bv.x, bv.y, bv.z, bv.w};
        __syncthreads();
#pragma unroll
        for (int j = 0; j < 4; ++j) { As[lk + 2 * j][lr] = __uint_as_float(aw[j] << 16); As[lk + 2 * j + 1][lr] = __uint_as_float(aw[j] & 0xffff0000u);
            Bs[lk + 2 * j][lr] = __uint_as_float(bw[j] << 16); Bs[lk + 2 * j + 1][lr] = __uint_as_float(bw[j] & 0xffff0000u); }
        __syncthreads();
#pragma unroll 8
        for (int k = 0; k < 32; ++k) { const float a0 = As[k][ty * 2], a1 = As[k][ty * 2 + 1];
            const float4 b0 = *(const float4*)&Bs[k][tx * 8], b1 = *(const float4*)&Bs[k][tx * 8 + 4];
            const float bb[8] = {b0.x, b0.y, b0.z, b0.w, b1.x, b1.y, b1.z, b1.w};
#pragma unroll
            for (int j = 0; j < 8; ++j) { acc[0][j] += a0 * bb[j]; acc[1][j] += a1 * bb[j]; } }
    }
#pragma unroll
    for (int i = 0; i < 2; ++i) { const int r = r0 + ty * 2 + i; if (r < M) P.store(z, r, c0 + tx * 8, acc[i]); }
}

struct ProbIn {
    const bf16_t* A; int lda; const bf16_t* B; int ldb; int K; bf16_t *QK, *V, *R, *UT, *U2; float* LR;
    DEVI int M(int) const { return NROWS; }
    DEVI int arow(int, int r) const { return r; }
    DEVI int nunits() const { return (NROWS / 256) * (INP / 256); }
    DEVI void unit(int L, int& z, int& pm, int& pn) const { z = 0; dense_unit(L, NROWS / 256, INP / 256, pm, pn); }
    DEVI unsigned aoffb(int, int r) const { return (unsigned)r * (unsigned)(lda * 2); }
    DEVI const bf16_t* Bt(int) const { return B; }
    DEVI void store(int, int r, int c0, const float (&v)[8]) const {
        if (c0 >= INC) return;
        uint4 o; o.x = pk2(v[0], v[1]); o.y = pk2(v[2], v[3]); o.z = pk2(v[4], v[5]); o.w = pk2(v[6], v[7]);
        if (c0 < 512) { *(uint4*)(QK + (size_t)r * 512 + c0) = o; }
        else if (c0 < 1024) { *(uint4*)(V + (size_t)r * 512 + (c0 - 512)) = o; }
        else if (c0 < 1536) { *(uint4*)(R + (size_t)r * 512 + (c0 - 1024)) = o; }
        else if (c0 < 1568) { float* p = LR + (size_t)r * 32 + (c0 - 1536); *(float4*)p = make_float4(v[0], v[1], v[2], v[3]); *(float4*)(p + 4) = make_float4(v[4], v[5], v[6], v[7]); }
        else { const int j = c0 - 1568; *(uint4*)(UT + (size_t)r * 512 + j) = o;
            const int g = j >> 4, ch = j & 15; int urow, ucol;
            if (r < NTOK) { const int b = r >> 12, n = r & 4095, gr = n >> 6, gc = n & 63, s = gc * 64 + gr; urow = b * 256 + (s >> 4); ucol = (s & 15) * 16 + ch; }
            else { const int q = r - NTOK, b = q >> 8, t = q & 255; urow = 2048 + b * 16 + (t >> 4); ucol = (t & 15) * 16 + ch; }
            *(uint4*)(U2 + ((size_t)g * 2304 + urow) * 512 + ucol) = o; }
    }
};
struct ProbGlu {
    const bf16_t* A; int lda; const bf16_t* B; int ldb; int K; const float* bias; bf16_t* MIX;
    DEVI int M(int) const { return NTOK; }
    DEVI int arow(int, int r) const { return r; }
    DEVI int nunits() const { return (NTOK / 256) * 2; }
    DEVI void unit(int L, int& z, int& pm, int& pn) const { z = 0; dense_unit(L, NTOK / 256, 2, pm, pn); }
    DEVI unsigned aoffb(int, int r) const { return (unsigned)r * (unsigned)(lda * 2); }
    DEVI const bf16_t* Bt(int) const { return B; }
    DEVI void store(int, int r, int c0, const float (&v)[8]) const {
        const uint4 yv = *(const uint4*)(A + (size_t)r * lda + c0); const unsigned yw[4] = {yv.x, yv.y, yv.z, yv.w}; float o[8];
#pragma unroll
        for (int j = 0; j < 4; ++j) { const float y0 = __uint_as_float(yw[j] << 16), y1 = __uint_as_float(yw[j] & 0xffff0000u);
            o[2 * j] = y0 * sigmoidf_(v[2 * j] + bias[c0 + 2 * j]); o[2 * j + 1] = y1 * sigmoidf_(v[2 * j + 1] + bias[c0 + 2 * j + 1]); }
        uint4 w; w.x = pk2(o[0], o[1]); w.y = pk2(o[2], o[3]); w.z = pk2(o[4], o[5]); w.w = pk2(o[6], o[7]);
        *(uint4*)(MIX + (size_t)r * DM + 512 + c0) = w;
    }
};
struct ProbOut {
    const bf16_t* A; int lda; const bf16_t* B; int ldb; int K; const float* x; const float* mod; float* X1;
    DEVI int M(int) const { return NTOK; }
    DEVI int arow(int, int r) const { return r; }
    DEVI int nunits() const { return (NTOK / 256) * 4; }
    DEVI void unit(int L, int& z, int& pm, int& pn) const { z = 0; dense_unit(L, NTOK / 256, 4, pm, pn); }
    DEVI unsigned aoffb(int, int r) const { return (unsigned)r * (unsigned)(lda * 2); }
    DEVI const bf16_t* Bt(int) const { return B; }
    DEVI void store(int, int r, int c0, const float (&v)[8]) const {
        const float* g1 = mod + (r >> 12) * 6144 + 2048 + c0; const float* xp = x + (size_t)r * DM + c0; float* op = X1 + (size_t)r * DM + c0;
        const float4 x0 = *(const float4*)xp, x1 = *(const float4*)(xp + 4), ga = *(const float4*)g1, gb = *(const float4*)(g1 + 4);
        *(float4*)op = make_float4(x0.x + ga.x * v[0], x0.y + ga.y * v[1], x0.z + ga.z * v[2], x0.w + ga.w * v[3]);
        *(float4*)(op + 4) = make_float4(x1.x + gb.x * v[4], x1.y + gb.y * v[5], x1.z + gb.z * v[6], x1.w + gb.w * v[7]);
    }
};
struct ProbMoe1 {
    const bf16_t* A; int lda; const bf16_t* B; int ldb; int K; const int* cnt; const int* offs; const int* list; const float* b_gu; bf16_t* ACT;
    DEVI int M(int z) const { return cnt[z]; }
    DEVI int arow(int z, int r) const { return list[z * LISTCAP + r] >> 2; }
    DEVI const bf16_t* Bt(int z) const { return B + (size_t)z * 2048 * DM; }
    DEVI void store(int z, int r, int c0, const float (&v)[8]) const {
        const int f0 = (c0 >> 3) * 4; const float* bg = b_gu + (size_t)z * 2048 + f0; float a[4];
#pragma unroll
        for (int i = 0; i < 4; ++i) { float g = v[i] + bg[i], l = v[4 + i] + bg[1024 + i]; g = fminf(g, 7.f); l = fminf(fmaxf(l, -7.f), 7.f); a[i] = (l + 1.f) * (g * sigmoidf_(1.702f * g)); }
        uint2 o; o.x = pk2(a[0], a[1]); o.y = pk2(a[2], a[3]);
        *(uint2*)(ACT + (size_t)(offs[z] + r) * DFF + f0) = o;
    }
};
struct ProbMoe2 {
    const bf16_t* A; int lda; const bf16_t* B; int ldb; int K; const int* cnt; const int* offs; const int* list; const float* b_down; const float* gate; bf16_t* YSL;
    DEVI int M(int z) const { return cnt[z]; }
    DEVI int arow(int z, int r) const { return offs[z] + r; }
    DEVI const bf16_t* Bt(int z) const { return B + (size_t)z * DM * DFF; }
    DEVI void store(int z, int r, int c0, const float (&v)[8]) const {
        const int ent = list[z * LISTCAP + r]; const float gt = gate[ent]; const float* bd = b_down + (size_t)z * DM + c0;
        uint4 o; o.x = pk2((v[0] + bd[0]) * gt, (v[1] + bd[1]) * gt); o.y = pk2((v[2] + bd[2]) * gt, (v[3] + bd[3]) * gt);
        o.z = pk2((v[4] + bd[4]) * gt, (v[5] + bd[5]) * gt); o.w = pk2((v[6] + bd[6]) * gt, (v[7] + bd[7]) * gt);
        *(uint4*)(YSL + (size_t)ent * DM + c0) = o;
    }
};

DEVI void gla_naive_body(const bf16_t* __restrict__ QK, const bf16_t* __restrict__ V, const float* __restrict__ LR, const float* __restrict__ lr_up,
                                                   const float* __restrict__ lr_bias, float* __restrict__ OF, float* __restrict__ OB, LAS float* sm, int item) {
    LAS float* sq = sm; LAS float* sk = sm + 64; LAS float* sa = sm + 128; LAS float* sv = sm + 192; LAS float* red = sm + 320;
    const int dir = item & 1, hh = (item >> 1) & 3, b = item >> 3, tid = threadIdx.x, e = tid & 127, dg = tid >> 7;
    float up[16]; float bias = 0.f;
    if (tid < 64) { for (int r = 0; r < 16; ++r) up[r] = lr_up[dir * 4096 + r * 256 + hh * 64 + tid]; bias = lr_bias[dir * 256 + hh * 64 + tid]; }
    float S[16];
#pragma unroll
    for (int i = 0; i < 16; ++i) S[i] = 0.f;
    float* O = dir ? OB : OF;
    for (int step = 0; step < CTX + SEQ; ++step) {
        int row;
        if (step < CTX) row = NTOK + b * CTX + (dir ? CTX - 1 - step : step);
        else { const int t = step - CTX; row = b * SEQ + (dir ? SEQ - 1 - t : t); }
        if (tid < 64) { const float* lp = LR + (size_t)row * 32 + dir * 16; float g = bias;
#pragma unroll
            for (int r = 0; r < 16; ++r) g += lp[r] * up[r];
            sa[tid] = __expf(logsigmoidf_(g) * (1.f / 16.f));
            sq[tid] = bf2f(QK[(size_t)row * 512 + hh * 64 + tid]) * 0.125f; sk[tid] = bf2f(QK[(size_t)row * 512 + 256 + hh * 64 + tid]); }
        else if (tid < 192) sv[tid - 64] = bf2f(V[(size_t)row * 512 + hh * 128 + (tid - 64)]);
        __syncthreads();
        const float v = sv[e]; float part = 0.f;
#pragma unroll
        for (int i = 0; i < 16; ++i) { const int d = dg * 16 + i; S[i] = sa[d] * S[i] + sk[d] * v; part += sq[d] * S[i]; }
        if (step >= CTX) red[dg * 128 + e] = part;
        __syncthreads();
        if (step >= CTX && dg == 0) O[(size_t)row * 512 + hh * 128 + e] = (red[e] + red[128 + e]) + (red[256 + e] + red[384 + e]);
    }
}
__global__ __launch_bounds__(512) void k_gla_naive(const bf16_t* __restrict__ QK, const bf16_t* __restrict__ V, const float* __restrict__ LR, const float* __restrict__ lr_up,
                                                   const float* __restrict__ lr_bias, float* __restrict__ OF, float* __restrict__ OB) {
    __shared__ float sm[832];
    gla_naive_body(QK, V, LR, lr_up, lr_bias, OF, OB, (LAS float*)sm, blockIdx.x);
}
DEVI void gla_post_row(const float* __restrict__ OF, const float* __restrict__ OB, const bf16_t* __restrict__ R, const float* __restrict__ nw, bf16_t* __restrict__ MIX, int tok, int lane) {
    const int c0 = lane * 8;
    float o[8]; float ss = 0.f;
#pragma unroll
    for (int j = 0; j < 8; ++j) { o[j] = OF[(size_t)tok * 512 + c0 + j] + OB[(size_t)tok * 512 + c0 + j]; ss += o[j] * o[j]; }
    ss += __shfl_xor(ss, 1); ss += __shfl_xor(ss, 2); ss += __shfl_xor(ss, 4); ss += __shfl_xor(ss, 8);
    const float rstd = rsqrtf(ss * (1.f / 128.f) + 1e-6f);
    float w[8];
#pragma unroll
    for (int j = 0; j < 8; ++j) { const float r = bf2f(R[(size_t)tok * 512 + c0 + j]); w[j] = o[j] * rstd * nw[(c0 + j) & 127] * siluf_(r); }
    uint4 q; q.x = pk2(w[0], w[1]); q.y = pk2(w[2], w[3]); q.z = pk2(w[4], w[5]); q.w = pk2(w[6], w[7]);
    *(uint4*)(MIX + (size_t)tok * DM + c0) = q;
}
__global__ __launch_bounds__(256) void k_gla_post(const float* __restrict__ OF, const float* __restrict__ OB, const bf16_t* __restrict__ R, const float* __restrict__ nw, bf16_t* __restrict__ MIX) {
    gla_post_row(OF, OB, R, nw, MIX, blockIdx.x * 4 + (threadIdx.x >> 6), threadIdx.x & 63);
}

DEVI void s5_naive_body(const bf16_t* __restrict__ UT, const S5P* __restrict__ P, const float* __restrict__ c_re, const float* __restrict__ c_im,
                                                  float* __restrict__ YF, float* __restrict__ YB, LAS float* hsw  , int id, int lane) {
    const int g = id & 31, dir = (id >> 5) & 1, b = id >> 6;
    const float lr = P->lamb[dir][g][lane][0], li = P->lamb[dir][g][lane][1];
    float br[16], bi[16];
#pragma unroll
    for (int h = 0; h < 16; ++h) { br[h] = P->bbar[dir][g][lane][h][0]; bi[h] = P->bbar[dir][g][lane][h][1]; }
    const int ch = lane & 15, part = lane >> 4;
    float cr[16], ci[16];
#pragma unroll
    for (int i = 0; i < 16; ++i) { const size_t ix = (((size_t)dir * 32 + g) * 16 + ch) * 64 + part * 16 + i; cr[i] = c_re[ix]; ci[i] = c_im[ix]; }
    float hr = 0.f, hi = 0.f; float* Y = dir ? YB : YF;
    for (int step = 0; step < CTX + SEQ; ++step) {
        int row;
        if (step < CTX) row = NTOK + b * CTX + (dir ? CTX - 1 - step : step);
        else { const int t = step - CTX, s = dir ? SEQ - 1 - t : t; row = b * SEQ + (s & 63) * 64 + (s >> 6); }
        const uint4 u0 = *(const uint4*)(UT + (size_t)row * 512 + g * 16), u1 = *(const uint4*)(UT + (size_t)row * 512 + g * 16 + 8);
        const unsigned uw[8] = {u0.x, u0.y, u0.z, u0.w, u1.x, u1.y, u1.z, u1.w};
        float bur = 0.f, bui = 0.f;
#pragma unroll
        for (int j = 0; j < 8; ++j) { const float ua = __uint_as_float(uw[j] << 16), ub = __uint_as_float(uw[j] & 0xffff0000u);
            bur += br[2 * j] * ua + br[2 * j + 1] * ub; bui += bi[2 * j] * ua + bi[2 * j + 1] * ub; }
        const float nr = lr * hr - li * hi + bur, ni = lr * hi + li * hr + bui; hr = nr; hi = ni;
        if (step >= CTX) {
            hsw[lane] = hr; hsw[64 + lane] = hi;
            asm volatile("s_waitcnt lgkmcnt(0)" ::: "memory");
            float acc = 0.f;
#pragma unroll
            for (int i = 0; i < 16; ++i) acc += cr[i] * hsw[part * 16 + i] - ci[i] * hsw[64 + part * 16 + i];
            acc += __shfl_xor(acc, 16); acc += __shfl_xor(acc, 32);
            asm volatile("s_waitcnt lgkmcnt(0)" ::: "memory");
            if (lane < 16) Y[(size_t)row * 512 + g * 16 + lane] = acc;
        }
    }
}
__global__ __launch_bounds__(256) void k_s5_naive(const bf16_t* __restrict__ UT, const S5P* __restrict__ P, const float* __restrict__ c_re, const float* __restrict__ c_im,
                                                  float* __restrict__ YF, float* __restrict__ YB) {
    __shared__ float hs[4][128];
    const int w = threadIdx.x >> 6;
    s5_naive_body(UT, P, c_re, c_im, YF, YB, (LAS float*)hs[w], blockIdx.x * 4 + w, threadIdx.x & 63);
}
__global__ __launch_bounds__(256) void k_s5_post(const float* __restrict__ YF, const float* __restrict__ YB, const bf16_t* __restrict__ UT, const float* __restrict__ dvec, bf16_t* __restrict__ YS) {
    const size_t i = (size_t)blockIdx.x * 256 + threadIdx.x; const int j = (int)(i & 511);
    const float y = YF[i] + YB[i] + dvec[j] * bf2f(UT[i]);
    YS[i] = f2bf(gelu_tanh(y));
}

DEVI void router_row(const float* __restrict__ X1, const float* __restrict__ w, const float* __restrict__ mod, const float* __restrict__ rw, const float* __restrict__ rb,
                                                bf16_t* __restrict__ H2, int* __restrict__ cnt, int* __restrict__ list, float* __restrict__ gate, LAS float* hrw  , int tok, int lane) {
    const int b = tok / SEQ;
    const float* src = X1 + (size_t)tok * DM;
    float4 v[4]; float ss = 0.f;
#pragma unroll
    for (int j = 0; j < 4; ++j) { v[j] = *(const float4*)(src + lane * 4 + 256 * j); ss += v[j].x * v[j].x + v[j].y * v[j].y + v[j].z * v[j].z + v[j].w * v[j].w; }
    const float rstd = rsqrtf(wave_sum(ss) * (1.f / DM) + 1e-6f);
    const float* msh = mod + b * 6144 + 3072; const float* msc = mod + b * 6144 + 4096;
#pragma unroll
    for (int j = 0; j < 4; ++j) { const int k = lane * 4 + 256 * j;
        const float4 ww = *(const float4*)(w + k), sc = *(const float4*)(msc + k), sh = *(const float4*)(msh + k);
        float4 h; h.x = v[j].x * rstd * ww.x * (1.f + sc.x) + sh.x; h.y = v[j].y * rstd * ww.y * (1.f + sc.y) + sh.y; h.z = v[j].z * rstd * ww.z * (1.f + sc.z) + sh.z; h.w = v[j].w * rstd * ww.w * (1.f + sc.w) + sh.w;
        hrw[k] = h.x; hrw[k + 1] = h.y; hrw[k + 2] = h.z; hrw[k + 3] = h.w;
        uint2 o; o.x = pk2(h.x, h.y); o.y = pk2(h.z, h.w); *(uint2*)(H2 + (size_t)tok * DM + k) = o; }
    asm volatile("s_waitcnt lgkmcnt(0)" ::: "memory");
    const int e = lane & 31, half = lane >> 5; float lg = 0.f;
    for (int k = half * 512; k < half * 512 + 512; ++k) lg += hrw[k] * rw[k * 32 + e];
    lg += __shfl_xor(lg, 32); lg += rb[e];
    float val = lg; float tv[4]; int ti[4];
#pragma unroll
    for (int t = 0; t < 4; ++t) { float bv = val; int bi = e;
#pragma unroll
        for (int o = 1; o < 32; o <<= 1) { const float ov = __shfl_xor(bv, o); const int oi = __shfl_xor(bi, o); if (ov > bv || (ov == bv && oi < bi)) { bv = ov; bi = oi; } }
        tv[t] = bv; ti[t] = bi; if (e == bi) val = -3.0e38f; }
    const float e1 = __expf(tv[1] - tv[0]), e2 = __expf(tv[2] - tv[0]), e3 = __expf(tv[3] - tv[0]), inv = 1.f / (1.f + e1 + e2 + e3);
    if (lane < 4) { const float gv = lane == 0 ? inv : lane == 1 ? e1 * inv : lane == 2 ? e2 * inv : e3 * inv; const int ex = lane == 0 ? ti[0] : lane == 1 ? ti[1] : lane == 2 ? ti[2] : ti[3];
        const int slot = atomicAdd(&cnt[ex], 1); list[ex * LISTCAP + slot] = tok * 4 + lane; gate[tok * 4 + lane] = gv; }
}
__global__ __launch_bounds__(256) void k_router(const float* __restrict__ X1, const float* __restrict__ w, const float* __restrict__ mod, const float* __restrict__ rw, const float* __restrict__ rb,
                                                bf16_t* __restrict__ H2, int* __restrict__ cnt, int* __restrict__ list, float* __restrict__ gate) {
    __shared__ float hrow[4][1024];
    const int wv = threadIdx.x >> 6;
    router_row(X1, w, mod, rw, rb, H2, cnt, list, gate, (LAS float*)hrow[wv], blockIdx.x * 4 + wv, threadIdx.x & 63);
}
__global__ void k_offsets(const int* cnt, int* offs) { if (threadIdx.x == 0) { int o = 0; for (int e = 0; e < NEXP; ++e) { offs[e] = o; o += (cnt[e] + MOEPAD - 1) / MOEPAD * MOEPAD; } offs[NEXP] = o; } }

DEVI void final_row(float* __restrict__ X1, const bf16_t* __restrict__ YSL, const float* __restrict__ mod, const float* __restrict__ fw, int tok, int lane) {
    const int b = tok / SEQ;
    float* row = X1 + (size_t)tok * DM; const float* g2 = mod + b * 6144 + 5120;
    float4 v[4]; float ss = 0.f;
#pragma unroll
    for (int j = 0; j < 4; ++j) { const int k = lane * 4 + 256 * j; v[j] = *(const float4*)(row + k); float f[4] = {0.f, 0.f, 0.f, 0.f};
#pragma unroll
        for (int s = 0; s < 4; ++s) { const uint2 y = *(const uint2*)(YSL + ((size_t)tok * 4 + s) * DM + k);
            f[0] += __uint_as_float(y.x << 16); f[1] += __uint_as_float(y.x & 0xffff0000u); f[2] += __uint_as_float(y.y << 16); f[3] += __uint_as_float(y.y & 0xffff0000u); }
        const float4 gg = *(const float4*)(g2 + k);
        v[j].x += gg.x * f[0]; v[j].y += gg.y * f[1]; v[j].z += gg.z * f[2]; v[j].w += gg.w * f[3];
        ss += v[j].x * v[j].x + v[j].y * v[j].y + v[j].z * v[j].z + v[j].w * v[j].w; }
    const float rstd = rsqrtf(wave_sum(ss) * (1.f / DM) + 1e-6f);
#pragma unroll
    for (int j = 0; j < 4; ++j) { const int k = lane * 4 + 256 * j; const float4 ww = *(const float4*)(fw + k);
        *(float4*)(row + k) = make_float4(v[j].x * rstd * ww.x, v[j].y * rstd * ww.y, v[j].z * rstd * ww.z, v[j].w * rstd * ww.w); }
}
__global__ __launch_bounds__(256) void k_final(float* __restrict__ X1, const bf16_t* __restrict__ YSL, const float* __restrict__ mod, const float* __restrict__ fw) {
    final_row(X1, YSL, mod, fw, blockIdx.x * 4 + (threadIdx.x >> 6), threadIdx.x & 63);
}

typedef short bf16x8 __attribute__((ext_vector_type(8)));
typedef float f32x4 __attribute__((ext_vector_type(4)));
typedef unsigned u32x4 __attribute__((ext_vector_type(4)));
typedef unsigned u32x2 __attribute__((ext_vector_type(2)));
constexpr int NWAVES = 8, NTHR = 512;
constexpr int BM = 256, BK = 64, HALF = 128, HTB = HALF * BK * 2, STAGE_BYTES = 8 * HTB;
constexpr int MISC_OFF = STAGE_BYTES, MISC_BYTES = 1024, LDS_BYTES = STAGE_BYTES + MISC_BYTES;
constexpr int CW_BAR = 4096;

#define XB_TMO      128
#define XB_XCNT(j)  (256  + 64 * (j))
#define XB_XSUB(j)  (1280 + 64 * (j))
#define XB_XGEN(j)  (2304 + 64 * (j))
#define XB_TOP      3328
#define XB_TOPGEN   3392
#define XCD_BAR_WORDS 3456
#define XB_SPIN_CAP (1u << 18)
DEVI unsigned xb_ld(unsigned* p)              { return __hip_atomic_load(p, __ATOMIC_RELAXED, __HIP_MEMORY_SCOPE_AGENT); }
DEVI unsigned xb_add(unsigned* p, unsigned v) { return __hip_atomic_fetch_add(p, v, __ATOMIC_RELAXED, __HIP_MEMORY_SCOPE_AGENT); }
DEVI unsigned xb_xcc_id() { return (unsigned)__builtin_amdgcn_s_getreg((3 << 11) | 20) & 0xFu; }
#define XB_SPIN(cond, bar) do { unsigned _sp = 0; while (cond) { __builtin_amdgcn_s_sleep(1); \
    if ((++_sp & 255u) == 0u) { if (xb_ld(&(bar)[XB_TMO])) break; if (_sp > XB_SPIN_CAP) { atomicAdd(&(bar)[XB_TMO], 1u); break; } } } } while (0)
struct XcdBarrier { unsigned* bar; unsigned x; volatile LAS unsigned* st; };
DEVI XcdBarrier xcd_barrier_post(unsigned* bar, volatile LAS unsigned* st) {
    XcdBarrier b; b.bar = bar; b.x = xb_xcc_id(); b.st = st;
    if (threadIdx.x == 0) (void)xb_add(&bar[XB_XCNT(b.x)], 1u);
    return b;
}
DEVI void xcd_barrier_complete(unsigned* bar, unsigned x, unsigned& nloc, unsigned& nx) {
    const unsigned G = gridDim.x * gridDim.y * gridDim.z;
    unsigned sum, cnt, mine, sp = 0u;
    for (;;) {
        sum = 0u; cnt = 0u; mine = 0u;
#pragma unroll
        for (unsigned j = 0; j < 16; ++j) { const unsigned c = xb_ld(&bar[XB_XCNT(j)]); sum += c; cnt += (c > 0u) ? 1u : 0u; mine = (j == x) ? c : mine; }
        if (sum == G) break;
        __builtin_amdgcn_s_sleep(1);
        if ((++sp & 255u) == 0u) { if (xb_ld(&bar[XB_TMO])) break; if (sp > XB_SPIN_CAP) { atomicAdd(&bar[XB_TMO], 1u); break; } }
    }
    nloc = mine > 0u ? mine : 1u; nx = cnt > 0u ? cnt : 1u;
}
DEVI void xcd_barrier(const XcdBarrier& b) {
    asm volatile("s_waitcnt vmcnt(0)" ::: "memory");
    __syncthreads();
    if (threadIdx.x == 0) {
        unsigned* bar = b.bar;
        __builtin_amdgcn_s_waitcnt(0);
        unsigned nloc = b.st[0], nx = b.st[1];
        if (nloc == 0u) { xcd_barrier_complete(bar, b.x, nloc, nx); b.st[0] = nloc; b.st[1] = nx; }
        const unsigned old = xb_add(&bar[XB_XSUB(b.x)], 1u);
        const unsigned gen = old / nloc;
        if (old + 1u == (gen + 1u) * nloc) {
            __builtin_amdgcn_fence(__ATOMIC_RELEASE, "agent");
            asm volatile("s_waitcnt vmcnt(0)" ::: "memory");
            const unsigned og = xb_add(&bar[XB_TOP], 1u);
            const unsigned tg = og / nx;
            if (og + 1u == (tg + 1u) * nx) xb_add(&bar[XB_TOPGEN], 1u);
            else XB_SPIN(xb_ld(&bar[XB_TOPGEN]) == tg, bar);
            __builtin_amdgcn_fence(__ATOMIC_ACQUIRE, "agent");
            xb_add(&bar[XB_XGEN(b.x)], 1u);
            asm volatile("s_waitcnt vmcnt(0)" ::: "memory");
        } else {
            XB_SPIN(xb_ld(&bar[XB_XGEN(b.x)]) == gen, bar);
            __builtin_amdgcn_fence(__ATOMIC_ACQUIRE, "agent");
            asm volatile("s_waitcnt vmcnt(0)" ::: "memory");
        }
    }
    __syncthreads();
}

DEVI int lds_byte(int r, int c) { const int st = (r >> 4) * 2 + (c >> 5), rr = r & 15, cc = c & 31, ob = rr * 64 + cc * 2; return st * 1024 + (ob ^ (((ob >> 9) & 1) << 5)); }
DEVI void stage_rc(int b, int& R, int& C) { const int st = b / 1024, sb = b % 1024, swz = sb ^ (((sb >> 9) & 1) << 5); R = (st >> 1) * 16 + swz / 64; C = (st & 1) * 32 + (swz % 64) / 2; }
DEVI int perm32(int rho) { const int n = rho >> 4, i = rho & 15; return 8 * (i >> 2) + 4 * n + (i & 3); }
template <class Prob>
DEVI void gemm_phase(LAS unsigned char* lds, const Prob& P, int G, int c) {
    int tid = threadIdx.x; asm volatile("" : "+v"(tid));
    const int wid = __builtin_amdgcn_readfirstlane(tid >> 6), lane = tid & 63, wr = wid >> 2, wc = wid & 3, fr = lane & 15, fq = lane >> 4;
    const int K = P.K, nt = K / BK;
    const int nun = P.nunits();
    int L = c; if (L >= nun) return;
    int Rs0, Cs0, Rs1, Cs1; stage_rc(tid * 16, Rs0, Cs0); stage_rc(tid * 16 + 8192, Rs1, Cs1);
    unsigned voffB[2];
    voffB[0] = (unsigned)(((Rs0 & ~31) + perm32(Rs0 & 31)) * K + Cs0) * 2u; voffB[1] = (unsigned)(((Rs1 & ~31) + perm32(Rs1 & 31)) * K + Cs1) * 2u;
    const size_t kstep = (size_t)(BK * 2), hstepB = (size_t)HALF * K * 2, tstepB = 2 * hstepB;
    const unsigned ldsw = (unsigned)wid * 1024u;
    const int aoff = lds_byte(wr * 64 + fr, fq * 8), boff = lds_byte(wc * 32 + fr, fq * 8);
#define G_SA(b, h) (((b) * 2 + (h)) * HTB)
#define G_SB(b, h) ((4 + (b) * 2 + (h)) * HTB)
#define G_STAGE_B(bufoff, gbase) do { _Pragma("unroll") for (int _i = 0; _i < 2; ++_i) \
        __builtin_amdgcn_global_load_lds((const unsigned*)((const char*)(gbase) + voffB[_i]), (LAS unsigned*)(lds + (bufoff) + ldsw + _i * 8192), 16, 0, 0); } while (0)
#define G_STAGE_A(bufoff, gbase, v0, v1) do { \
        __builtin_amdgcn_global_load_lds((const unsigned*)((const char*)(gbase) + (v0)), (LAS unsigned*)(lds + (bufoff) + ldsw), 16, 0, 0); \
        __builtin_amdgcn_global_load_lds((const unsigned*)((const char*)(gbase) + (v1)), (LAS unsigned*)(lds + (bufoff) + ldsw + 8192), 16, 0, 0); } while (0)
#define G_LDA(dst, b, h) do { _Pragma("unroll") for (int m = 0; m < 4; ++m) _Pragma("unroll") for (int k = 0; k < 2; ++k) dst[m][k] = *(const LAS bf16x8*)(lds + G_SA(b, h) + aoff + m * 2048 + k * 1024); } while (0)
#define G_LDB(dst, b, h) do { _Pragma("unroll") for (int n = 0; n < 2; ++n) _Pragma("unroll") for (int k = 0; k < 2; ++k) dst[n][k] = *(const LAS bf16x8*)(lds + G_SB(b, h) + boff + n * 2048 + k * 1024); } while (0)
#define G_MMA(ai, bj, At, Bt) do { __builtin_amdgcn_s_setprio(1); _Pragma("unroll") for (int m = 0; m < 4; ++m) _Pragma("unroll") for (int n = 0; n < 2; ++n) _Pragma("unroll") for (int k = 0; k < 2; ++k) \
        acc[ai][bj][m][n] = __builtin_amdgcn_mfma_f32_16x16x32_bf16(Bt[n][k], At[m][k], acc[ai][bj][m][n], 0, 0, 0); __builtin_amdgcn_s_setprio(0); } while (0)
#define G_WAIT_V(n) asm volatile("s_waitcnt vmcnt(" #n ")" ::: "memory")
#define G_WAIT_L(n) asm volatile("s_waitcnt lgkmcnt(" #n ")" ::: "memory")
#define G_BAR __builtin_amdgcn_s_barrier()
#define G_SCHED __builtin_amdgcn_sched_barrier(0)
    int z, pm, pn; P.unit(L, z, pm, pn);
    z = __builtin_amdgcn_readfirstlane(z); pm = __builtin_amdgcn_readfirstlane(pm); pn = __builtin_amdgcn_readfirstlane(pn);
    unsigned vA00 = P.aoffb(z, pm * BM + Rs0) + Cs0 * 2, vA01 = P.aoffb(z, pm * BM + Rs1) + Cs1 * 2;
    unsigned vA10 = P.aoffb(z, pm * BM + HALF + Rs0) + Cs0 * 2, vA11 = P.aoffb(z, pm * BM + HALF + Rs1) + Cs1 * 2;
    const char* const Ab = (const char*)P.A;
    const char* cB = (const char*)P.Bt(z) + (size_t)pn * tstepB;
    f32x4 acc[2][2][4][2];
    bf16x8 At[4][2], B0[2][2], B1[2][2];
    G_STAGE_B(G_SB(0, 0), cB); G_STAGE_A(G_SA(0, 0), Ab, vA00, vA01); G_STAGE_B(G_SB(0, 1), cB + hstepB); G_STAGE_A(G_SA(0, 1), Ab, vA10, vA11);
    if (wr == 1) G_BAR;
    G_WAIT_V(4); G_BAR;
    G_STAGE_B(G_SB(1, 0), cB + kstep); G_STAGE_A(G_SA(1, 0), Ab + kstep, vA00, vA01); G_STAGE_B(G_SB(1, 1), cB + hstepB + kstep);
    G_WAIT_V(6); G_BAR;
    for (;;) {
        const int Ln = L + G; const bool has_next = Ln < nun;
        int nz = z, npm = pm, npn = pn; if (has_next) P.unit(Ln, nz, npm, npn);
        nz = __builtin_amdgcn_readfirstlane(nz); npm = __builtin_amdgcn_readfirstlane(npm); npn = __builtin_amdgcn_readfirstlane(npn);
        const char* nB = has_next ? (const char*)P.Bt(nz) + (size_t)npn * tstepB : cB;
#pragma unroll
        for (int a = 0; a < 2; ++a)
#pragma unroll
            for (int b = 0; b < 2; ++b)
#pragma unroll
                for (int m = 0; m < 4; ++m)
#pragma unroll
                    for (int n = 0; n < 2; ++n) acc[a][b][m][n] = (f32x4){0.f, 0.f, 0.f, 0.f};
#pragma unroll 1
        for (int t = 0; t < nt; t += 2) {
            const bool last = (t == nt - 2);
            unsigned n00 = vA00, n01 = vA01, n10 = vA10, n11 = vA11;
            if (last && has_next) { n00 = P.aoffb(nz, npm * BM + Rs0) + Cs0 * 2; n01 = P.aoffb(nz, npm * BM + Rs1) + Cs1 * 2;
                n10 = P.aoffb(nz, npm * BM + HALF + Rs0) + Cs0 * 2; n11 = P.aoffb(nz, npm * BM + HALF + Rs1) + Cs1 * 2; }
            const char* a1 = Ab + (size_t)(t + 1) * kstep;
            const char* a2 = last ? Ab : Ab + (size_t)(t + 2) * kstep; const char* b2 = last ? nB : cB + (size_t)(t + 2) * kstep;
            const char* a3 = a2 + kstep; const char* b3 = b2 + kstep;
            G_LDB(B0, 0, 0); G_SCHED; G_LDA(At, 0, 0); G_STAGE_A(G_SA(1, 1), a1, vA10, vA11);
            G_WAIT_L(8); G_BAR; G_WAIT_L(0); G_MMA(0, 0, At, B0); G_BAR; G_SCHED;
            if (last) { vA00 = n00; vA01 = n01; vA10 = n10; vA11 = n11; }
            G_LDB(B1, 0, 1); G_STAGE_B(G_SB(0, 0), b2);
            G_BAR; G_WAIT_L(0); G_MMA(0, 1, At, B1); G_BAR;
            G_LDA(At, 0, 1); G_STAGE_A(G_SA(0, 0), a2, vA00, vA01);
            G_BAR; G_WAIT_L(0); G_MMA(1, 0, At, B0); G_BAR; G_SCHED;
            G_STAGE_B(G_SB(0, 1), b2 + hstepB);
            G_WAIT_V(6); G_BAR; G_MMA(1, 1, At, B1); G_BAR;
            G_LDB(B0, 1, 0); G_SCHED; G_LDA(At, 1, 0); G_STAGE_A(G_SA(0, 1), a2, vA10, vA11);
            G_WAIT_L(8); G_BAR; G_WAIT_L(0); G_MMA(0, 0, At, B0); G_BAR; G_SCHED;
            G_LDB(B1, 1, 1); G_STAGE_B(G_SB(1, 0), b3);
            G_BAR; G_WAIT_L(0); G_MMA(0, 1, At, B1); G_BAR;
            G_LDA(At, 1, 1); G_STAGE_A(G_SA(1, 0), a3, vA00, vA01);
            G_BAR; G_WAIT_L(0); G_MMA(1, 0, At, B0); G_BAR; G_SCHED;
            G_STAGE_B(G_SB(1, 1), b3 + hstepB);
            G_WAIT_V(6); G_BAR; G_MMA(1, 1, At, B1); G_BAR;
        }
        { const int Mz = __builtin_amdgcn_readfirstlane(P.M(z));
#pragma unroll
          for (int ai = 0; ai < 2; ++ai)
#pragma unroll
            for (int m = 0; m < 4; ++m) { const int row = pm * BM + ai * HALF + wr * 64 + m * 16 + fr;
                if (row < Mz) {
#pragma unroll
                    for (int bj = 0; bj < 2; ++bj) { const int c0 = pn * BM + bj * HALF + wc * 32 + 8 * fq;
                        const f32x4 v0 = acc[ai][bj][m][0], v1 = acc[ai][bj][m][1];
                        const float v[8] = {v0[0], v0[1], v0[2], v0[3], v1[0], v1[1], v1[2], v1[3]};
                        P.store(z, row, c0, v); } }
                asm volatile("" ::: "memory"); } }
        if (!has_next) break;
        z = nz; pm = npm; pn = npn; cB = nB; L = Ln;
    }
    G_WAIT_V(0);
    if (wr == 0) G_BAR;
    G_BAR;
}

struct FMoe1 {
    const bf16_t* A; const bf16_t* B; int K; const int* cnt; const int* list; const float* b_gu; bf16_t* ACT; const LAS int* ub;
    static constexpr int NT = 8;
    DEVI int ubs(int e) const { return __builtin_amdgcn_readfirstlane(ub[e]); }
    DEVI int nunits() const { return ubs(NEXP) * NT; }
    DEVI void unit(int L, int& z, int& pm, int& pn) const { int e = 0; while (e < NEXP - 1 && L >= ubs(e + 1) * NT) ++e; const int u0 = ubs(e), l = L - u0 * NT, mt = ubs(e + 1) - u0; z = e; pm = l % mt; pn = l / mt; }
    DEVI int M(int z) const { return cnt[z]; }
    DEVI unsigned aoffb(int z, int r) const { const int t = r < cnt[z] ? (list[z * LISTCAP + r] >> 2) : 0; return (unsigned)t * (unsigned)(DM * 2); }
    DEVI const bf16_t* Bt(int z) const { return B + (size_t)z * 2048 * DM; }
    DEVI void store(int z, int r, int c0, const float (&v)[8]) const {
        const int f0 = (c0 >> 3) * 4; const float* bg = b_gu + (size_t)z * 2048 + f0; float a[4];
#pragma unroll
        for (int i = 0; i < 4; ++i) { float g = v[i] + bg[i], l = v[4 + i] + bg[1024 + i]; g = fminf(g, 7.f); l = fminf(fmaxf(l, -7.f), 7.f); a[i] = (l + 1.f) * (g * sigmoidf_(1.702f * g)); }
        uint2 o; o.x = pk2(a[0], a[1]); o.y = pk2(a[2], a[3]);
        *(uint2*)(ACT + (size_t)(ub[z] * 256 + r) * DFF + f0) = o;
    }
};
struct FMoe2 {
    const bf16_t* A; const bf16_t* B; int K; const int* cnt; const int* list; const float* b_down; const float* gate; bf16_t* YSL; const LAS int* ub;
    static constexpr int NT = 4;
    DEVI int ubs(int e) const { return __builtin_amdgcn_readfirstlane(ub[e]); }
    DEVI int nunits() const { return ubs(NEXP) * NT; }
    DEVI void unit(int L, int& z, int& pm, int& pn) const { int e = 0; while (e < NEXP - 1 && L >= ubs(e + 1) * NT) ++e; const int u0 = ubs(e), l = L - u0 * NT, mt = ubs(e + 1) - u0; z = e; pm = l % mt; pn = l / mt; }
    DEVI int M(int z) const { return cnt[z]; }
    DEVI unsigned aoffb(int z, int r) const { return (unsigned)(ub[z] * 256 + r) * (unsigned)(DFF * 2); }
    DEVI const bf16_t* Bt(int z) const { return B + (size_t)z * DM * DFF; }
    DEVI void store(int z, int r, int c0, const float (&v)[8]) const {
        const int ent = list[z * LISTCAP + r]; const float gt = gate[ent]; const float* bd = b_down + (size_t)z * DM + c0;
        uint4 o; o.x = pk2((v[0] + bd[0]) * gt, (v[1] + bd[1]) * gt); o.y = pk2((v[2] + bd[2]) * gt, (v[3] + bd[3]) * gt);
        o.z = pk2((v[4] + bd[4]) * gt, (v[5] + bd[5]) * gt); o.w = pk2((v[6] + bd[6]) * gt, (v[7] + bd[7]) * gt);
        *(uint4*)(YSL + (size_t)ent * DM + c0) = o;
    }
};

struct MArgs { const float* in[30]; float* out; unsigned char* ws; int ph_lo, ph_hi; };
struct MArgs_in { const float *lam_re, *lam_im, *log_dt, *b_re, *b_im, *c_re, *c_im; };

constexpr int GL_LRS = 0, GL_TOT = 8192, GL_QF = 12288, GL_KF = 21504, GL_QB = 30720, GL_KB = 39936, GL_VT = 49152, GL_PP = 67584, GL_SSQ = 76800, GL_UST = 67584;
constexpr int GL_LD = 72;

struct GlaPtrs { const bf16_t* QK; const bf16_t* V; const bf16_t* R; const float* LR; const float* lr_up; const float* lr_bias; const float* nw; bf16_t* UCH; float* ADEC; bf16_t* SST; bf16_t* MIX; };

DEVI void gla_gates(const GlaPtrs& G, LAS unsigned char* lds, int h, int d, int to, float (&cf)[8], float (&cb)[8]) {
    const LAS float* LRS = (const LAS float*)(lds + GL_LRS); LAS float* TOT = (LAS float*)(lds + GL_TOT);
#pragma unroll
    for (int dir = 0; dir < 2; ++dir) {
        float up[16];
#pragma unroll
        for (int r = 0; r < 16; ++r) up[r] = G.lr_up[dir * 4096 + r * 256 + h * 64 + d];
        const float bias = G.lr_bias[dir * 256 + h * 64 + d];
        float la[8];
#pragma unroll
        for (int j = 0; j < 8; ++j) { const LAS f32x4* lp = (const LAS f32x4*)(LRS + (to * 8 + j) * 32 + dir * 16); float g = bias;
#pragma unroll
            for (int q = 0; q < 4; ++q) { const f32x4 x = lp[q]; g += x[0] * up[4 * q] + x[1] * up[4 * q + 1] + x[2] * up[4 * q + 2] + x[3] * up[4 * q + 3]; }
            la[j] = logsigmoidf_(g) * (1.f / 16.f); }
        if (dir == 0) { cf[0] = la[0];
#pragma unroll
            for (int j = 1; j < 8; ++j) cf[j] = cf[j - 1] + la[j];
            TOT[(0 * 8 + to) * 64 + d] = cf[7]; }
        else { cb[7] = la[7];
#pragma unroll
            for (int j = 6; j >= 0; --j) cb[j] = cb[j + 1] + la[j];
            TOT[(1 * 8 + to) * 64 + d] = cb[0]; }
    }
}
DEVI void gla_stage(const GlaPtrs& G, LAS unsigned char* lds, int row0, int h, int tid) {
    *(LAS f32x4*)(lds + GL_LRS + tid * 16) = *(const f32x4*)(G.LR + (size_t)row0 * 32 + tid * 4);
    const int ep = tid & 63, to = tid >> 6; unsigned w[8];
#pragma unroll
    for (int j = 0; j < 8; ++j) w[j] = *(const unsigned*)(G.V + (size_t)(row0 + to * 8 + j) * 512 + h * 128 + 2 * ep);
    u32x4 lo, hi;
    lo.x = (w[0] & 0xffffu) | (w[1] << 16); lo.y = (w[2] & 0xffffu) | (w[3] << 16); lo.z = (w[4] & 0xffffu) | (w[5] << 16); lo.w = (w[6] & 0xffffu) | (w[7] << 16);
    hi.x = (w[0] >> 16) | (w[1] & 0xffff0000u); hi.y = (w[2] >> 16) | (w[3] & 0xffff0000u); hi.z = (w[4] >> 16) | (w[5] & 0xffff0000u); hi.w = (w[6] >> 16) | (w[7] & 0xffff0000u);
    *(LAS u32x4*)(lds + GL_VT + ((2 * ep) * GL_LD + to * 8) * 2) = lo;
    *(LAS u32x4*)(lds + GL_VT + ((2 * ep + 1) * GL_LD + to * 8) * 2) = hi;
}

DEVI void gla_a_item(const GlaPtrs& G, LAS unsigned char* lds, int item) {
    int tid = threadIdx.x; asm volatile("" : "+v"(tid));
    const int wave = __builtin_amdgcn_readfirstlane(tid >> 6), lane = tid & 63, d = lane, to = wave, fr = lane & 15, fq = lane >> 4;
    const int ch = item % 68, bh = item / 68, h = bh & 3, b = bh >> 2;
    const int row0 = ch < 4 ? NTOK + b * CTX + ch * 64 : b * SEQ + (ch - 4) * 64;
    gla_stage(G, lds, row0, h, tid);
    bf16_t kk[8];
#pragma unroll
    for (int j = 0; j < 8; ++j) kk[j] = G.QK[(size_t)(row0 + to * 8 + j) * 512 + 256 + h * 64 + d];
    __syncthreads();
    float cf[8], cb[8];
    gla_gates(G, lds, h, d, to, cf, cb);
    __syncthreads();
    const LAS float* TOT = (const LAS float*)(lds + GL_TOT);
    float offf = 0.f, offb = 0.f, totf = 0.f, totb = 0.f;
#pragma unroll
    for (int t = 0; t < 8; ++t) { const float a = TOT[(0 * 8 + t) * 64 + d], c = TOT[(1 * 8 + t) * 64 + d]; totf += a; totb += c; if (t < to) offf += a; if (t > to) offb += c; }
    float of[8], ob[8];
#pragma unroll
    for (int j = 0; j < 8; ++j) { const float kf = bf2f(kk[j]); of[j] = kf * __expf(totf - (cf[j] + offf)); ob[j] = kf * __expf(totb - (cb[j] + offb)); }
    { u32x4 w; w.x = pk2(of[0], of[1]); w.y = pk2(of[2], of[3]); w.z = pk2(of[4], of[5]); w.w = pk2(of[6], of[7]); *(LAS u32x4*)(lds + GL_QF + (d * GL_LD + to * 8) * 2) = w;
      w.x = pk2(ob[0], ob[1]); w.y = pk2(ob[2], ob[3]); w.z = pk2(ob[4], ob[5]); w.w = pk2(ob[6], ob[7]); *(LAS u32x4*)(lds + GL_KF + (d * GL_LD + to * 8) * 2) = w; }
    const int chain_f = bh * 2, step_f = ch < 4 ? ch : ch, step_b = ch < 4 ? 3 - ch : 4 + (67 - ch);
    if (to == 0) { G.ADEC[((size_t)chain_f * 68 + step_f) * 64 + d] = __expf(totf); G.ADEC[((size_t)(chain_f + 1) * 68 + step_b) * 64 + d] = __expf(totb); }
    __syncthreads();
    f32x4 acc[2][4];
#pragma unroll
    for (int dr = 0; dr < 2; ++dr)
#pragma unroll
        for (int dt = 0; dt < 4; ++dt) acc[dr][dt] = (f32x4){0.f, 0.f, 0.f, 0.f};
#pragma unroll
    for (int ks = 0; ks < 2; ++ks) { const bf16x8 a = *(const LAS bf16x8*)(lds + GL_VT + ((wave * 16 + fr) * GL_LD + ks * 32 + fq * 8) * 2);
#pragma unroll
        for (int dt = 0; dt < 4; ++dt) { const bf16x8 b0 = *(const LAS bf16x8*)(lds + GL_QF + ((dt * 16 + fr) * GL_LD + ks * 32 + fq * 8) * 2);
            const bf16x8 b1 = *(const LAS bf16x8*)(lds + GL_KF + ((dt * 16 + fr) * GL_LD + ks * 32 + fq * 8) * 2);
            acc[0][dt] = __builtin_amdgcn_mfma_f32_16x16x32_bf16(a, b0, acc[0][dt], 0, 0, 0); acc[1][dt] = __builtin_amdgcn_mfma_f32_16x16x32_bf16(a, b1, acc[1][dt], 0, 0, 0); } }
#pragma unroll
    for (int dr = 0; dr < 2; ++dr)
#pragma unroll
        for (int dt = 0; dt < 4; ++dt)
#pragma unroll
            for (int rg = 0; rg < 4; ++rg) *(LAS bf16_t*)(lds + GL_UST + ((dr * 128 + wave * 16 + 4 * fq + rg) * 64 + dt * 16 + fr) * 2) = f2bf(acc[dr][dt][rg]);
    __syncthreads();
#pragma unroll
    for (int i = 0; i < 4; ++i) { const int q = tid + i * NTHR, dr = q >> 10, off = (q & 1023) * 8;
        const u32x4 w = *(const LAS u32x4*)(lds + GL_UST + (dr * 8192 + off) * 2);
        const size_t chain = (size_t)chain_f + dr; const int step = dr ? step_b : step_f;
        *(u32x4*)(G.UCH + (chain * 68 + step) * 8192 + off) = w; }
    __syncthreads();
}

DEVI void gla_b_block(const GlaPtrs& G, LAS unsigned char* lds, int blk) {
    int tid = threadIdx.x; asm volatile("" : "+v"(tid));
    const int chain = blk >> 2, e = (blk & 3) * 32 + (tid >> 4), d4 = (tid & 15) * 4;
    for (int i = tid; i < 68 * 16; i += NTHR) ((LAS f32x4*)lds)[i] = ((const f32x4*)(G.ADEC + (size_t)chain * 68 * 64))[i];
    __syncthreads();
    const bf16_t* up = G.UCH + ((size_t)chain * 68 * 128 + e) * 64 + d4;
    bf16_t* sp = G.SST + ((size_t)chain * 64 * 128 + e) * 64 + d4;
    float S0 = 0.f, S1 = 0.f, S2 = 0.f, S3 = 0.f;
    uint2 cur[17], nxt[17];
#pragma unroll
    for (int j = 0; j < 17; ++j) cur[j] = *(const uint2*)(up + (size_t)j * 8192);
#pragma unroll 1
    for (int bt = 0; bt < 4; ++bt) {
        if (bt < 3) {
#pragma unroll
            for (int j = 0; j < 17; ++j) nxt[j] = *(const uint2*)(up + (size_t)((bt + 1) * 17 + j) * 8192); }
#pragma unroll
        for (int j = 0; j < 17; ++j) { const int step = bt * 17 + j;
            if (step >= 4) { uint2 o; o.x = pk2(S0, S1); o.y = pk2(S2, S3); *(uint2*)(sp + (size_t)(step - 4) * 8192) = o; }
            const f32x4 a = *(const LAS f32x4*)(lds + (step * 64 + d4) * 4);
            S0 = a[0] * S0 + __uint_as_float(cur[j].x << 16); S1 = a[1] * S1 + __uint_as_float(cur[j].x & 0xffff0000u);
            S2 = a[2] * S2 + __uint_as_float(cur[j].y << 16); S3 = a[3] * S3 + __uint_as_float(cur[j].y & 0xffff0000u); }
#pragma unroll
        for (int j = 0; j < 17; ++j) cur[j] = nxt[j];
    }
    __syncthreads();
}

DEVI void gla_c_item(const GlaPtrs& G, LAS unsigned char* lds, int item) {
    int tid = threadIdx.x; asm volatile("" : "+v"(tid));
    const int wave = __builtin_amdgcn_readfirstlane(tid >> 6), lane = tid & 63, d = lane, to = wave, fr = lane & 15, fq = lane >> 4;
    const int c = item & 63, bh = item >> 6, h = bh & 3, b = bh >> 2;
    const int row0 = b * SEQ + c * 64;
    gla_stage(G, lds, row0, h, tid);
    bf16_t qq[8], kk[8];
#pragma unroll
    for (int j = 0; j < 8; ++j) { const size_t o = (size_t)(row0 + to * 8 + j) * 512 + h * 64 + d; qq[j] = G.QK[o]; kk[j] = G.QK[o + 256]; }
    __syncthreads();
    float cf[8], cb[8];
    gla_gates(G, lds, h, d, to, cf, cb);
    __syncthreads();
    { const LAS float* TOT = (const LAS float*)(lds + GL_TOT);
      float offf = 0.f, offb = 0.f;
#pragma unroll
      for (int t = 0; t < 8; ++t) { if (t < to) offf += TOT[(0 * 8 + t) * 64 + d]; if (t > to) offb += TOT[(1 * 8 + t) * 64 + d]; }
#pragma unroll
      for (int j = 0; j < 8; ++j) { const float qf = bf2f(qq[j]) * 0.125f, kf = bf2f(kk[j]);
          const float ef = __expf(fmaxf(cf[j] + offf, -80.f)), eb = __expf(fmaxf(cb[j] + offb, -80.f));
          const int o = ((to * 8 + j) * GL_LD + d) * 2;
          *(LAS bf16_t*)(lds + GL_QF + o) = f2bf(qf * ef); *(LAS bf16_t*)(lds + GL_KF + o) = f2bf(kf * __builtin_amdgcn_rcpf(ef));
          *(LAS bf16_t*)(lds + GL_QB + o) = f2bf(qf * eb); *(LAS bf16_t*)(lds + GL_KB + o) = f2bf(kf * __builtin_amdgcn_rcpf(eb)); } }
    __syncthreads();
    { const int ti = wave >> 1;
#pragma unroll
      for (int u = 0; u < 2; ++u) { const int tj = (wave & 1) * 2 + u;
          f32x4 af = (f32x4){0.f, 0.f, 0.f, 0.f}, ab = (f32x4){0.f, 0.f, 0.f, 0.f};
          if (tj <= ti) {
#pragma unroll
              for (int ks = 0; ks < 2; ++ks) { const bf16x8 a = *(const LAS bf16x8*)(lds + GL_KF + ((tj * 16 + fr) * GL_LD + ks * 32 + fq * 8) * 2), bb = *(const LAS bf16x8*)(lds + GL_QF + ((ti * 16 + fr) * GL_LD + ks * 32 + fq * 8) * 2);
                  af = __builtin_amdgcn_mfma_f32_16x16x32_bf16(a, bb, af, 0, 0, 0); } }
          if (tj >= ti) {
#pragma unroll
              for (int ks = 0; ks < 2; ++ks) { const bf16x8 a = *(const LAS bf16x8*)(lds + GL_KB + ((tj * 16 + fr) * GL_LD + ks * 32 + fq * 8) * 2), bb = *(const LAS bf16x8*)(lds + GL_QB + ((ti * 16 + fr) * GL_LD + ks * 32 + fq * 8) * 2);
                  ab = __builtin_amdgcn_mfma_f32_16x16x32_bf16(a, bb, ab, 0, 0, 0); } }
          float p[4];
#pragma unroll
          for (int rg = 0; rg < 4; ++rg) { const int i = ti * 16 + fr, j = tj * 16 + 4 * fq + rg; p[rg] = (j <= i ? af[rg] : 0.f) + (j >= i ? ab[rg] : 0.f); }
          u32x2 w; w.x = pk2(p[0], p[1]); w.y = pk2(p[2], p[3]);
          *(LAS u32x2*)(lds + GL_PP + ((ti * 16 + fr) * GL_LD + tj * 16 + 4 * fq) * 2) = w; } }
    __syncthreads();
    const int tg = wave & 3, eh = wave >> 2;
    f32x4 acc[4];
#pragma unroll
    for (int et = 0; et < 4; ++et) acc[et] = (f32x4){0.f, 0.f, 0.f, 0.f};
    { const bf16_t* Sf = G.SST + ((size_t)(bh * 2) * 64 + c) * 8192; const bf16_t* Sb = G.SST + ((size_t)(bh * 2 + 1) * 64 + (63 - c)) * 8192;
#pragma unroll
      for (int ks = 0; ks < 2; ++ks) {
          const int bo = ((tg * 16 + fr) * GL_LD + ks * 32 + fq * 8) * 2;
          const bf16x8 bP = *(const LAS bf16x8*)(lds + GL_PP + bo), bF = *(const LAS bf16x8*)(lds + GL_QF + bo), bB = *(const LAS bf16x8*)(lds + GL_QB + bo);
#pragma unroll
          for (int et = 0; et < 4; ++et) { const int e = eh * 64 + et * 16 + fr;
              const bf16x8 aV = *(const LAS bf16x8*)(lds + GL_VT + (e * GL_LD + ks * 32 + fq * 8) * 2);
              const bf16x8 aF = *(const bf16x8*)(Sf + e * 64 + ks * 32 + fq * 8), aB = *(const bf16x8*)(Sb + e * 64 + ks * 32 + fq * 8);
              acc[et] = __builtin_amdgcn_mfma_f32_16x16x32_bf16(aV, bP, acc[et], 0, 0, 0);
              acc[et] = __builtin_amdgcn_mfma_f32_16x16x32_bf16(aF, bF, acc[et], 0, 0, 0);
              acc[et] = __builtin_amdgcn_mfma_f32_16x16x32_bf16(aB, bB, acc[et], 0, 0, 0); } } }
    float ss = 0.f;
#pragma unroll
    for (int et = 0; et < 4; ++et) ss += acc[et][0] * acc[et][0] + acc[et][1] * acc[et][1] + acc[et][2] * acc[et][2] + acc[et][3] * acc[et][3];
    ss += __shfl_xor(ss, 16); ss += __shfl_xor(ss, 32);
    LAS float* SSQ = (LAS float*)(lds + GL_SSQ);
    if (fq == 0) SSQ[eh * 64 + tg * 16 + fr] = ss;
    __syncthreads();
    const float rstd = rsqrtf((SSQ[tg * 16 + fr] + SSQ[64 + tg * 16 + fr]) * (1.f / 128.f) + 1e-6f);
    const int tok = row0 + tg * 16 + fr;
#pragma unroll
    for (int et = 0; et < 4; ++et) { const int e = eh * 64 + et * 16 + 4 * fq;
        const uint2 rv = *(const uint2*)(G.R + (size_t)tok * 512 + h * 128 + e); const f32x4 nw = *(const f32x4*)(G.nw + e);
        const float r0 = __uint_as_float(rv.x << 16), r1 = __uint_as_float(rv.x & 0xffff0000u), r2 = __uint_as_float(rv.y << 16), r3 = __uint_as_float(rv.y & 0xffff0000u);
        uint2 w; w.x = pk2(acc[et][0] * rstd * nw[0] * siluf_(r0), acc[et][1] * rstd * nw[1] * siluf_(r1)); w.y = pk2(acc[et][2] * rstd * nw[2] * siluf_(r2), acc[et][3] * rstd * nw[3] * siluf_(r3));
        *(uint2*)(G.MIX + (size_t)tok * DM + h * 128 + e) = w; }
    __syncthreads();
}

DEVI void s5w_build(const MArgs_in& in, unsigned char* ws, LAS unsigned char* lds, int g) {
    LAS float* LP = (LAS float*)lds;
    LAS float* BB = LP + 2 * 17 * 64 * 2;
    LAS float* CC = BB + 2 * 64 * 16 * 2;
    LAS float* KK = CC + 2 * 16 * 64 * 2;
    LAS float* CO = KK + 2 * 16 * 256;
    const int tid = threadIdx.x;
    S5P* P = (S5P*)(ws + OFF_S5P);
    for (int t = tid; t < 2 * 64 * 17; t += NTHR) { const int n = t % 17, p = (t / 17) & 63, d = t / (17 * 64); const int i = (d * 32 + g) * 64 + p;
        const double dt = exp((double)in.log_dt[d * 32 + g]), lr = in.lam_re[i], li = in.lam_im[i];
        const double mag = exp(n * lr * dt), ar = mag * cos(n * li * dt), ai = mag * sin(n * li * dt);
        LP[((d * 17 + n) * 64 + p) * 2] = (float)ar; LP[((d * 17 + n) * 64 + p) * 2 + 1] = (float)ai;
        if (n == 1) { const double nr = ar - 1.0, ni = ai, den = lr * lr + li * li; CO[(d * 64 + p) * 2] = (float)((nr * lr + ni * li) / den); CO[(d * 64 + p) * 2 + 1] = (float)((ni * lr - nr * li) / den); }
        if (n == 16) { P->lam16[d][g][p][0] = (float)ar; P->lam16[d][g][p][1] = (float)ai; } }
    for (int t = tid; t < 2 * 16 * 64; t += NTHR) { const int p = t & 63, h = (t >> 6) & 15, d = t >> 10; const size_t ix = (((size_t)d * 32 + g) * 16 + h) * 64 + p;
        CC[((d * 16 + h) * 64 + p) * 2] = in.c_re[ix]; CC[((d * 16 + h) * 64 + p) * 2 + 1] = in.c_im[ix]; }
    __syncthreads();
    for (int t = tid; t < 2 * 64 * 16; t += NTHR) { const int h = t & 15, p = (t >> 4) & 63, d = t >> 10; const size_t ix = (((size_t)d * 32 + g) * 64 + p) * 16 + h;
        const float br = in.b_re[ix], bi = in.b_im[ix], cr = CO[(d * 64 + p) * 2], ci = CO[(d * 64 + p) * 2 + 1];
        BB[((d * 64 + p) * 16 + h) * 2] = cr * br - ci * bi; BB[((d * 64 + p) * 16 + h) * 2 + 1] = cr * bi + ci * br; }
    __syncthreads();
    for (int t = tid; t < 2 * 16 * 256; t += NTHR) { const int hp = t & 15, h = (t >> 4) & 15, n = (t >> 8) & 15, d = t >> 12; float acc = 0.f;
        for (int p = 0; p < 64; ++p) { const float cr = CC[((d * 16 + h) * 64 + p) * 2], ci = CC[((d * 16 + h) * 64 + p) * 2 + 1], lr = LP[((d * 17 + n) * 64 + p) * 2], li = LP[((d * 17 + n) * 64 + p) * 2 + 1];
            const float tr = cr * lr - ci * li, ti = cr * li + ci * lr; acc += tr * BB[((d * 64 + p) * 16 + hp) * 2] - ti * BB[((d * 64 + p) * 16 + hp) * 2 + 1]; }
        KK[(d * 16 + n) * 256 + h * 16 + hp] = acc; }
    __syncthreads();
    bf16_t* BF = (bf16_t*)(ws + OFF_S5BF) + (size_t)g * 256 * 256;
    for (int t = tid; t < 256 * 32; t += NTHR) { const int k8 = t & 31, row = t >> 5, p = row & 63, im = (row >> 6) & 1, d = row >> 7; float o[8];
#pragma unroll
        for (int q = 0; q < 8; ++q) { const int k = k8 * 8 + q, j = k >> 4, hp = k & 15, pw = d ? j : 15 - j;
            const float lr = LP[((d * 17 + pw) * 64 + p) * 2], li = LP[((d * 17 + pw) * 64 + p) * 2 + 1], br = BB[((d * 64 + p) * 16 + hp) * 2], bi = BB[((d * 64 + p) * 16 + hp) * 2 + 1];
            o[q] = im ? lr * bi + li * br : lr * br - li * bi; }
        uint4 w; w.x = pk2(o[0], o[1]); w.y = pk2(o[2], o[3]); w.z = pk2(o[4], o[5]); w.w = pk2(o[6], o[7]);
        *(uint4*)(BF + (size_t)row * 256 + k8 * 8) = w; }
    bf16_t* BY = (bf16_t*)(ws + OFF_S5BY) + (size_t)g * 256 * 512;
    for (int t = tid; t < 256 * 64; t += NTHR) { const int k8 = t & 63, n = t >> 6, i = n >> 4, h = n & 15; float o[8];
#pragma unroll
        for (int q = 0; q < 8; ++q) { const int k = k8 * 8 + q; float v;
            if (k < 256) { const int j = k >> 4, hp = k & 15; v = 0.f; if (i >= j) v += KK[(0 * 16 + (i - j)) * 256 + h * 16 + hp]; if (j >= i) v += KK[(1 * 16 + (j - i)) * 256 + h * 16 + hp]; }
            else { const int d = (k - 256) >> 7, r = (k - 256) & 127, p = r & 63, im = r >> 6, pw = d ? 16 - i : i + 1;
                const float cr = CC[((d * 16 + h) * 64 + p) * 2], ci = CC[((d * 16 + h) * 64 + p) * 2 + 1], lr = LP[((d * 17 + pw) * 64 + p) * 2], li = LP[((d * 17 + pw) * 64 + p) * 2 + 1];
                v = im ? -(cr * li + ci * lr) : cr * lr - ci * li; }
            o[q] = v; }
        uint4 w; w.x = pk2(o[0], o[1]); w.y = pk2(o[2], o[3]); w.z = pk2(o[4], o[5]); w.w = pk2(o[6], o[7]);
        *(uint4*)(BY + (size_t)n * 512 + k8 * 8) = w; }
    __syncthreads();
}
struct ProbS5F {
    const bf16_t* A; const bf16_t* B; int K; float* F;
    DEVI int nunits() const { return 32 * 9; }
    DEVI void unit(int L, int& z, int& pm, int& pn) const { z = L & 31; pm = L >> 5; pn = 0; }
    DEVI int M(int) const { return 2304; }
    DEVI unsigned aoffb(int z, int r) const { return (unsigned)(z * 2304 + r) * 1024u; }
    DEVI const bf16_t* Bt(int z) const { return B + (size_t)z * 256 * 256; }
    DEVI void store(int z, int r, int c0, const float (&v)[8]) const { float* p = F + ((size_t)z * 2304 + r) * 256 + c0; *(float4*)p = make_float4(v[0], v[1], v[2], v[3]); *(float4*)(p + 4) = make_float4(v[4], v[5], v[6], v[7]); }
};
struct ProbS5Y {
    const bf16_t* A; const bf16_t* B; int K; const float* dvec; bf16_t* YS;
    DEVI int nunits() const { return 32 * 8; }
    DEVI void unit(int L, int& z, int& pm, int& pn) const { z = L & 31; pm = L >> 5; pn = 0; }
    DEVI int M(int) const { return 2048; }
    DEVI unsigned aoffb(int z, int r) const { return (unsigned)(z * 2304 + r) * 1024u; }
    DEVI const bf16_t* Bt(int z) const { return B + (size_t)z * 256 * 512; }
    DEVI void store(int z, int r, int c0, const float (&v)[8]) const {
        const int b = r >> 8, sq = ((r & 255) << 4) + (c0 >> 4), gc = sq >> 6, gr = sq & 63, tok = b * SEQ + gr * 64 + gc, ch = z * 16 + (c0 & 15);
        const uint4 uv = *(const uint4*)(A + ((size_t)z * 2304 + r) * 512 + c0); const unsigned uw[4] = {uv.x, uv.y, uv.z, uv.w};
        const float4 d0 = *(const float4*)(dvec + ch), d1 = *(const float4*)(dvec + ch + 4); const float dd[8] = {d0.x, d0.y, d0.z, d0.w, d1.x, d1.y, d1.z, d1.w}; float o[8];
#pragma unroll
        for (int j = 0; j < 4; ++j) { o[2 * j] = gelu_tanh(v[2 * j] + dd[2 * j] * __uint_as_float(uw[j] << 16)); o[2 * j + 1] = gelu_tanh(v[2 * j + 1] + dd[2 * j + 1] * __uint_as_float(uw[j] & 0xffff0000u)); }
        uint4 w; w.x = pk2(o[0], o[1]); w.y = pk2(o[2], o[3]); w.z = pk2(o[4], o[5]); w.w = pk2(o[6], o[7]);
        *(uint4*)(YS + (size_t)tok * 512 + ch) = w;
    }
};
DEVI void s5_carry(const float* __restrict__ F, bf16_t* __restrict__ U2, const S5P* __restrict__ P, int id, int lane) {
    const int g = id & 31, dir = (id >> 5) & 1, b = id >> 6;
    const float l16r = P->lam16[dir][g][lane][0], l16i = P->lam16[dir][g][lane][1];
    const float* Fg = F + (size_t)g * 2304 * 256 + dir * 128 + lane;
    bf16_t* Ug = U2 + (size_t)g * 2304 * 512 + 256 + dir * 128 + lane;
    float hr = 0.f, hi = 0.f;
    float fr[16], fi[16], nr[16], ni[16];
#define S5_ROW(bt, j) ((bt) == 0 ? 2048 + b * 16 + (dir ? 15 - (j) : (j)) : b * 256 + (dir ? 255 - (((bt) - 1) * 16 + (j)) : ((bt) - 1) * 16 + (j)))
#pragma unroll
    for (int j = 0; j < 16; ++j) { const int row = S5_ROW(0, j); fr[j] = Fg[(size_t)row * 256]; fi[j] = Fg[(size_t)row * 256 + 64]; }
    for (int bt = 0; bt < 17; ++bt) {
        if (bt < 16) {
#pragma unroll
            for (int j = 0; j < 16; ++j) { const int row = S5_ROW(bt + 1, j); nr[j] = Fg[(size_t)row * 256]; ni[j] = Fg[(size_t)row * 256 + 64]; } }
#pragma unroll
        for (int j = 0; j < 16; ++j) {
            if (bt > 0) { const int row = S5_ROW(bt, j); Ug[(size_t)row * 512] = f2bf(hr); Ug[(size_t)row * 512 + 64] = f2bf(hi); }
            const float tr = l16r * hr - l16i * hi + fr[j], ti = l16r * hi + l16i * hr + fi[j]; hr = tr; hi = ti; }
#pragma unroll
        for (int j = 0; j < 16; ++j) { fr[j] = nr[j]; fi[j] = ni[j]; }
    }
#undef S5_ROW
}


constexpr int NPH = 12;

DEVI void wconv_tile(const float* __restrict__ src, bf16_t* __restrict__ dst, int K, int N, int mode, int n0, int k0, LAS float* t, int ht, bool act) {
    const int nl = ht & 63, kq = ht >> 6;
    if (act) { const int nd = n0 + nl, sc = mode ? wsrc_col<1>(nd) : nd; const bool valid = sc < N;
#pragma unroll 4
        for (int i = 0; i < 16; ++i) { const int kk = kq + 4 * i; t[kk * 65 + nl] = valid ? src[(size_t)(k0 + kk) * N + sc] : 0.f; } }
    __syncthreads();
    if (act) {
#pragma unroll
        for (int i = 0; i < 2; ++i) { const int ch = ht + 256 * i, n = ch >> 3, c8 = ch & 7; const LAS float* q = t + (c8 * 8) * 65 + n;
            uint4 o; o.x = pk2(q[0], q[65]); o.y = pk2(q[2 * 65], q[3 * 65]); o.z = pk2(q[4 * 65], q[5 * 65]); o.w = pk2(q[6 * 65], q[7 * 65]);
            *(uint4*)(dst + (size_t)(n0 + n) * K + k0 + c8 * 8) = o; } }
    __syncthreads();
}

DEVI void ph_prep(const MArgs& a, LAS unsigned char* lds, int bid, int G) {
    const int tid = threadIdx.x, wave = tid >> 6, lane = tid & 63;
    unsigned char* ws = a.ws;
    if (bid < 96) {
        LAS float* s = (LAS float*)lds; LAS float* part = (LAS float*)(lds + 36864);
        const float* c = a.in[1]; const float* cc = a.in[3]; const float* ada_w = a.in[4]; const float* ada_b = a.in[5]; float* mod = (float*)(ws + OFF_MOD);
        for (int i = tid; i < 9216; i += NTHR) { const int r = i >> 10, k = i & 1023; const float v = r < 8 ? c[r * 1024 + k] : cc[k]; s[i] = siluf_(v); }
        __syncthreads();
        const int j = bid * 64 + lane; float acc[9];
#pragma unroll
        for (int r = 0; r < 9; ++r) acc[r] = 0.f;
#pragma unroll 4
        for (int k = wave * 128; k < wave * 128 + 128; ++k) { const float w = ada_w[(size_t)k * 6144 + j];
#pragma unroll
            for (int r = 0; r < 9; ++r) acc[r] += s[r * 1024 + k] * w; }
#pragma unroll
        for (int r = 0; r < 9; ++r) part[(wave * 9 + r) * 64 + lane] = acc[r];
        __syncthreads();
        for (int i = tid; i < 576; i += NTHR) { const int r = i >> 6, l = i & 63; float sum = 0.f;
#pragma unroll
            for (int w = 0; w < 8; ++w) sum += part[(w * 9 + r) * 64 + l];
            mod[r * 6144 + bid * 64 + l] = sum + ada_b[bid * 64 + l]; }
        __syncthreads();
    } else if (bid < 104) {
        s5prep_one(a.in[11], a.in[12], a.in[13], a.in[14], a.in[15], (S5P*)(ws + OFF_S5P), (bid - 96) * NTHR + tid);
    }
    else if (bid < 136) { MArgs_in in{a.in[11], a.in[12], a.in[13], a.in[14], a.in[15], a.in[16], a.in[17]}; s5w_build(in, ws, lds, bid - 104); }
    constexpr int I0 = 36 * 16, I1 = I0 + 8 * 8, I2 = I1 + 16 * 16, I3 = I2 + 32 * 32 * 16, I4 = I3 + 32 * 16 * 16;
    const int half = tid >> 8, ht = tid & 255; LAS float* t = (LAS float*)(lds + half * 17408);
    for (int base = bid * 2; base < I4; base += 2 * G) {
        const int it = base + half; const bool act = it < I4;
        const float* src = nullptr; bf16_t* dst = nullptr; int K = 0, N = 0, mode = 0, n0 = 0, k0 = 0;
        if (act) {
            if (it < I0) { src = a.in[7]; dst = (bf16_t*)(ws + OFF_WIN); K = DM; N = INC; n0 = (it % 36) * 64; k0 = (it / 36) * 64; }
            else if (it < I1) { const int r = it - I0; src = a.in[19]; dst = (bf16_t*)(ws + OFF_WGLU); K = 512; N = 512; n0 = (r % 8) * 64; k0 = (r / 8) * 64; }
            else if (it < I2) { const int r = it - I1; src = a.in[21]; dst = (bf16_t*)(ws + OFF_WOUT); K = DM; N = DM; n0 = (r % 16) * 64; k0 = (r / 16) * 64; }
            else if (it < I3) { const int r = it - I2, e = r / 512, q = r % 512; src = a.in[25] + (size_t)e * DM * 2048; dst = (bf16_t*)(ws + OFF_WG) + (size_t)e * 2048 * DM; K = DM; N = 2048; mode = 1; n0 = (q % 32) * 64; k0 = (q / 32) * 64; }
            else { const int r = it - I3, e = r / 256, q = r % 256; src = a.in[27] + (size_t)e * DFF * DM; dst = (bf16_t*)(ws + OFF_WD) + (size_t)e * DM * DFF; K = DFF; N = DM; n0 = (q % 16) * 64; k0 = (q / 16) * 64; }
        }
        wconv_tile(src, dst, K, N, mode, n0, k0, t, ht, act);
    }
}

DEVI void build_ub(const int* cnt, volatile LAS int* ub) {
    if (threadIdx.x == 0) { int o = 0; for (int e = 0; e < NEXP; ++e) { ub[e] = o; o += (cnt[e] + 255) >> 8; } ub[NEXP] = o; }
    __syncthreads();
}

__global__ void __launch_bounds__(NTHR, 2) mega(MArgs a) {
    extern __shared__ __attribute__((aligned(16))) unsigned char lds_raw[];
    LAS unsigned char* lds = (LAS unsigned char*)lds_raw;
    volatile LAS unsigned* MISC = (volatile LAS unsigned*)(lds + MISC_OFF);
    const int tid = threadIdx.x, wave = __builtin_amdgcn_readfirstlane(tid >> 6), G = gridDim.x, bid = blockIdx.x;
    const int gw = bid * NWAVES + wave, NGW = G * NWAVES;
    for (int u = tid; u < MISC_BYTES / 4; u += NTHR) MISC[u] = 0u;
    __syncthreads();
    unsigned char* ws = a.ws; unsigned* ctl = (unsigned*)(ws + OFF_CTL);
    const bool multi = (a.ph_hi - a.ph_lo) > 1;
    XcdBarrier bar; bar.bar = ctl + CW_BAR; bar.x = 0; bar.st = MISC;
    if (multi) bar = xcd_barrier_post(ctl + CW_BAR, MISC);
    volatile LAS int* ub = (volatile LAS int*)(MISC + 16);
#define IN(k) (a.ph_lo <= (k) && (k) < a.ph_hi)
#define FRESH_LANE int ft_ = threadIdx.x; asm volatile("" : "+v"(ft_)); const int lane = ft_ & 63; (void)lane
#define SEAM(k) do { if (IN(k) && IN((k) + 1)) xcd_barrier(bar); } while (0)
    float* mod = (float*)(ws + OFF_MOD); S5P* s5p = (S5P*)(ws + OFF_S5P); float* gate = (float*)(ws + OFF_GATE); int* list = (int*)(ws + OFF_LIST);
    bf16_t* WIN = (bf16_t*)(ws + OFF_WIN); bf16_t* WGLU = (bf16_t*)(ws + OFF_WGLU); bf16_t* WOUT = (bf16_t*)(ws + OFF_WOUT); bf16_t* WG = (bf16_t*)(ws + OFF_WG); bf16_t* WD = (bf16_t*)(ws + OFF_WD);
    bf16_t* H = (bf16_t*)(ws + OFF_H); bf16_t* QK = (bf16_t*)(ws + OFF_QK); bf16_t* V = (bf16_t*)(ws + OFF_V); bf16_t* R = (bf16_t*)(ws + OFF_R); bf16_t* UT = (bf16_t*)(ws + OFF_UT);
    float* LR = (float*)(ws + OFF_LR); bf16_t* U2 = (bf16_t*)(ws + OFF_U2);
    bf16_t* YS = (bf16_t*)(ws + OFF_YS); bf16_t* MIX = (bf16_t*)(ws + OFF_MIX); bf16_t* ACT = (bf16_t*)(ws + OFF_ACT); bf16_t* YSL = (bf16_t*)(ws + OFF_YSL);
    int* cnt = (int*)(ctl + CW_CNT);

    if (IN(0)) ph_prep(a, lds, bid, G);
    SEAM(0);
    if (IN(1)) { FRESH_LANE; for (int row = gw; row < NROWS; row += NGW) norm_row(a.in[0], a.in[2], a.in[6], mod, H, row, lane, 0, 1024); }
    SEAM(1);
    if (IN(2)) { ProbIn P{H, DM, WIN, DM, DM, QK, V, R, UT, U2, LR}; gemm_phase(lds, P, G, bid); }
    SEAM(2);
    float* Fb = (float*)(ws + OFF_F); bf16_t* S5BF = (bf16_t*)(ws + OFF_S5BF); bf16_t* S5BY = (bf16_t*)(ws + OFF_S5BY);
    const GlaPtrs GP{QK, V, R, LR, a.in[8], a.in[9], a.in[10], (bf16_t*)(ws + OFF_UCH), (float*)(ws + OFF_ADEC), (bf16_t*)(ws + OFF_SST), MIX};
    if (IN(3)) {
        { ProbS5F P{U2, S5BF, 256, Fb}; gemm_phase(lds, P, G, bid); }
        for (int it = bid; it < NB * 4 * 68; it += G) gla_a_item(GP, lds, it);
    }
    SEAM(3);
    if (IN(4)) {
        for (int blk = bid; blk < 256; blk += G) gla_b_block(GP, lds, blk);
        { FRESH_LANE; if (gw < NB * 32 * 2) s5_carry(Fb, U2, s5p, gw, lane); }
    }
    SEAM(4);
    if (IN(5)) {
        { ProbS5Y P{U2, S5BY, 512, a.in[18], YS}; gemm_phase(lds, P, G, bid); }
        for (int it = bid; it < NB * 4 * 64; it += G) gla_c_item(GP, lds, it);
    }
    SEAM(5);
    if (IN(6)) { ProbGlu P{YS, 512, WGLU, 512, 512, a.in[20], MIX}; gemm_phase(lds, P, G, bid); }
    SEAM(6);
    if (IN(7)) { ProbOut P{MIX, DM, WOUT, DM, DM, a.in[0], mod, a.out}; gemm_phase(lds, P, G, bid); }
    SEAM(7);
    if (IN(8)) { FRESH_LANE; for (int tok = gw; tok < NTOK; tok += NGW) router_row(a.out, a.in[22], mod, a.in[23], a.in[24], H, cnt, list, gate, (LAS float*)lds + wave * 1024, tok, lane); }
    SEAM(8);
    if (IN(9)) { build_ub(cnt, ub); FMoe1 P{H, WG, DM, cnt, list, a.in[26], ACT, (const LAS int*)ub}; gemm_phase(lds, P, G, bid); }
    SEAM(9);
    if (IN(10)) { build_ub(cnt, ub); FMoe2 P{ACT, WD, DFF, cnt, list, a.in[28], gate, YSL, (const LAS int*)ub}; gemm_phase(lds, P, G, bid); }
    SEAM(10);
    if (IN(11)) { FRESH_LANE; for (int tok = gw; tok < NTOK; tok += NGW) final_row(a.out, YSL, mod, a.in[29], tok, lane); }
#undef IN
#undef SEAM
}

#ifndef MEGA_SINGLE
#define MEGA_SINGLE 1
#endif
extern "C" void kernel_launch(void* const* d_in, const int* in_sizes, int n_in, void* d_out, int out_size, void* d_ws, size_t ws_size, hipStream_t stream) {
    static int grid = 0;
    if (grid == 0) {
        if (ws_size < WS_NEED || n_in != 30) { fprintf(stderr, "kernel_launch: workspace too small (%zu < %zu) or n_in %d != 30\n", ws_size, (size_t)WS_NEED, n_in); grid = -1; return; }
        int dev = 0, cus = 0, per_cu = 0;
        if (hipGetDevice(&dev) != hipSuccess || hipDeviceGetAttribute(&cus, hipDeviceAttributeMultiprocessorCount, dev) != hipSuccess) { grid = -1; return; }
        if (hipFuncSetAttribute((const void*)mega, hipFuncAttributeMaxDynamicSharedMemorySize, LDS_BYTES) != hipSuccess) { fprintf(stderr, "kernel_launch: hipFuncSetAttribute failed\n"); grid = -1; return; }
        if (hipOccupancyMaxActiveBlocksPerMultiprocessor(&per_cu, (const void*)mega, NTHR, LDS_BYTES) != hipSuccess || per_cu < 1) { fprintf(stderr, "kernel_launch: occupancy query says %d blocks per CU\n", per_cu); per_cu = 1; }
        (void)hipGetLastError();
        grid = cus;
    }
    if (grid < 0) return;
    (void)hipMemsetAsync((char*)d_ws + OFF_CTL, 0, 64 * 1024, stream);
    MArgs a{};
    for (int i = 0; i < 30; ++i) a.in[i] = (const float*)d_in[i];
    a.out = (float*)d_out; a.ws = (unsigned char*)d_ws;
#if MEGA_SINGLE
    a.ph_lo = 0; a.ph_hi = NPH;
    { void* args[] = {&a}; hipError_t e = hipLaunchCooperativeKernel((const void*)mega, dim3(grid), dim3(NTHR), args, LDS_BYTES, stream);
      if (e != hipSuccess) fprintf(stderr, "kernel_launch: cooperative launch failed: %s (grid %d)\n", hipGetErrorString(e), grid); }
#else
    for (int p = 0; p < NPH; ++p) { a.ph_lo = p; a.ph_hi = p + 1; hipLaunchKernelGGL(mega, dim3(grid), dim3(NTHR), LDS_BYTES, stream, a); }
#endif
}

#ifdef RES_TEST
__global__ void __launch_bounds__(NTHR, 2) t_in(MArgs a) { extern __shared__ __attribute__((aligned(16))) unsigned char l[]; unsigned char* ws = a.ws;
  ProbIn P{(bf16_t*)(ws + OFF_H), DM, (bf16_t*)(ws + OFF_WIN), DM, DM, (bf16_t*)(ws + OFF_QK), (bf16_t*)(ws + OFF_V), (bf16_t*)(ws + OFF_R), (bf16_t*)(ws + OFF_UT), (bf16_t*)(ws + OFF_U2), (float*)(ws + OFF_LR)}; gemm_phase((LAS unsigned char*)l, P, gridDim.x, blockIdx.x); }
__global__ void __launch_bounds__(NTHR, 2) t_glu(MArgs a) { extern __shared__ __attribute__((aligned(16))) unsigned char l[]; unsigned char* ws = a.ws;
  ProbGlu P{(bf16_t*)(ws + OFF_YS), 512, (bf16_t*)(ws + OFF_WGLU), 512, 512, a.in[20], (bf16_t*)(ws + OFF_MIX)}; gemm_phase((LAS unsigned char*)l, P, gridDim.x, blockIdx.x); }
__global__ void __launch_bounds__(NTHR, 2) t_out(MArgs a) { extern __shared__ __attribute__((aligned(16))) unsigned char l[]; unsigned char* ws = a.ws;
  ProbOut P{(bf16_t*)(ws + OFF_MIX), DM, (bf16_t*)(ws + OFF_WOUT), DM, DM, a.in[0], (float*)(ws + OFF_MOD), a.out}; gemm_phase((LAS unsigned char*)l, P, gridDim.x, blockIdx.x); }
__global__ void __launch_bounds__(NTHR, 2) t_m1(MArgs a) { extern __shared__ __attribute__((aligned(16))) unsigned char l[]; unsigned char* ws = a.ws; LAS unsigned char* lds = (LAS unsigned char*)l;
  FMoe1 P{(bf16_t*)(ws + OFF_H), (bf16_t*)(ws + OFF_WG), DM, (int*)(ws + 4096), (int*)(ws + OFF_LIST), a.in[26], (bf16_t*)(ws + OFF_ACT), (const LAS int*)(lds + MISC_OFF + 64)}; gemm_phase(lds, P, gridDim.x, blockIdx.x); }
__global__ void __launch_bounds__(NTHR, 2) t_m2(MArgs a) { extern __shared__ __attribute__((aligned(16))) unsigned char l[]; unsigned char* ws = a.ws; LAS unsigned char* lds = (LAS unsigned char*)l;
  FMoe2 P{(bf16_t*)(ws + OFF_ACT), (bf16_t*)(ws + OFF_WD), DFF, (int*)(ws + 4096), (int*)(ws + OFF_LIST), a.in[28], (float*)(ws + OFF_GATE), (bf16_t*)(ws + OFF_YSL), (const LAS int*)(lds + MISC_OFF + 64)}; gemm_phase(lds, P, gridDim.x, blockIdx.x); }
#endif
```

```cpp
#include <hip/hip_runtime.h>
#include <stdint.h>
#include <stdio.h>

typedef unsigned short bf16_t;
#define DEVI __device__ __forceinline__
#define LAS __attribute__((address_space(3)))

constexpr int NB = 8, SEQ = 4096, DM = 1024, CTX = 256;
constexpr int NTOK = NB * SEQ;
constexpr int NCTX = NB * CTX;
constexpr int NROWS = NTOK + NCTX;
constexpr int INC = 2080, INP = 2304;
constexpr int NEXP = 32, TOPK = 4, DFF = 1024;
constexpr int LISTCAP = NTOK;
constexpr int MOEPAD = 256;

constexpr size_t MiB = 1024ull * 1024ull;
constexpr size_t OFF_CTL = 0;
constexpr size_t OFF_MOD = 64 * 1024;
constexpr size_t OFF_S5P = OFF_MOD + 256 * 1024;
constexpr size_t OFF_GATE = OFF_S5P + 1 * MiB;
constexpr size_t OFF_LIST = OFF_GATE + 512 * 1024;
constexpr size_t OFF_WIN = OFF_LIST + 4 * MiB;
constexpr size_t OFF_WGLU = OFF_WIN + (size_t)INP * DM * 2;
constexpr size_t OFF_WOUT = OFF_WGLU + 512 * 512 * 2;
constexpr size_t OFF_WG = OFF_WOUT + (size_t)DM * DM * 2;
constexpr size_t OFF_WD = OFF_WG + (size_t)NEXP * 2048 * DM * 2;
constexpr size_t OFF_S5BF = OFF_WD + (size_t)NEXP * DM * DFF * 2;
constexpr size_t OFF_S5BY = OFF_S5BF + (size_t)32 * 256 * 256 * 2;
constexpr size_t OFF_H = OFF_S5BY + (size_t)32 * 256 * 512 * 2;
constexpr size_t OFF_RA = OFF_H + (size_t)NROWS * DM * 2;
constexpr size_t OFF_QK = OFF_RA;
constexpr size_t OFF_V = OFF_QK + (size_t)NROWS * 512 * 2;
constexpr size_t OFF_R = OFF_V + (size_t)NROWS * 512 * 2;
constexpr size_t OFF_UT = OFF_R + (size_t)NROWS * 512 * 2;
constexpr size_t OFF_LR = OFF_UT + (size_t)NROWS * 512 * 2;
constexpr size_t OFF_U2 = OFF_LR + (size_t)NROWS * 32 * 4;
constexpr size_t OFF_YS = OFF_U2 + (size_t)32 * 2304 * 512 * 2;
constexpr size_t OFF_MIX = OFF_YS + (size_t)NTOK * 512 * 2;
constexpr size_t OFF_F = OFF_MIX + (size_t)NTOK * DM * 2;
constexpr size_t OFF_UCH = OFF_F + (size_t)32 * 2304 * 256 * 4;
constexpr size_t OFF_ADEC = OFF_UCH + (size_t)64 * 68 * 8192 * 2;
constexpr size_t OFF_SST = OFF_ADEC + (size_t)64 * 68 * 64 * 4;
constexpr size_t OFF_RA_END = OFF_SST + (size_t)64 * 64 * 8192 * 2;
constexpr int ACT_ROWS = NTOK * TOPK + NEXP * MOEPAD;
constexpr size_t OFF_ACT = OFF_RA;
constexpr size_t OFF_YSL = OFF_ACT + (size_t)ACT_ROWS * DFF * 2;
constexpr size_t OFF_END2 = OFF_YSL + (size_t)NTOK * TOPK * DM * 2;
constexpr size_t WS_NEED = OFF_RA_END > OFF_END2 ? OFF_RA_END : OFF_END2;
static_assert(WS_NEED <= 1024 * MiB, "workspace map exceeds 1 GiB");

constexpr int CW_CNT = 1024;
constexpr int CW_OFFS = 1088;

DEVI float bf2f(bf16_t b) { return __uint_as_float(((unsigned)b) << 16); }
DEVI bf16_t f2bf(float f) { unsigned u = __float_as_uint(f); u += 0x7fffu + ((u >> 16) & 1u); return (bf16_t)(u >> 16); }
DEVI unsigned pk2(float lo, float hi) { return (unsigned)f2bf(lo) | ((unsigned)f2bf(hi) << 16); }
DEVI float wave_sum(float v) {
#pragma unroll
    for (int o = 1; o < 64; o <<= 1) v += __shfl_xor(v, o);
    return v;
}
DEVI float sigmoidf_(float x) { return 1.f / (1.f + __expf(-x)); }
DEVI float siluf_(float x) { return x / (1.f + __expf(-x)); }
DEVI float logsigmoidf_(float g) { return fminf(g, 0.f) - __logf(1.f + __expf(-fabsf(g))); }
DEVI float gelu_tanh(float x) { const float u = 0.7978845608028654f * (x + 0.044715f * x * x * x); return x / (1.f + __expf(-2.f * u)); }

__global__ __launch_bounds__(256) void k_mod(const float* __restrict__ c, const float* __restrict__ c_ctx, const float* __restrict__ ada_w,
                                             const float* __restrict__ ada_b, float* __restrict__ mod) {
    __shared__ float s[9][1024];
    for (int i = threadIdx.x; i < 9 * 1024; i += 256) { const int r = i >> 10, k = i & 1023; const float v = r < 8 ? c[r * 1024 + k] : c_ctx[k]; s[r][k] = siluf_(v); }
    __syncthreads();
    const int j = blockIdx.x * 256 + threadIdx.x;
    float acc[9];
#pragma unroll
    for (int r = 0; r < 9; ++r) acc[r] = 0.f;
    for (int k = 0; k < 1024; ++k) { const float w = ada_w[(size_t)k * 6144 + j];
#pragma unroll
        for (int r = 0; r < 9; ++r) acc[r] += s[r][k] * w; }
    const float bb = ada_b[j];
#pragma unroll
    for (int r = 0; r < 9; ++r) mod[r * 6144 + j] = acc[r] + bb;
}

template <int MODE> DEVI int wsrc_col(int nd) { if (MODE == 1) { const int q = nd >> 3, i = nd & 7; return i < 4 ? 4 * q + i : 1024 + 4 * q + (i - 4); } return nd; }
template <int MODE> __global__ __launch_bounds__(256) void k_wconv(const float* __restrict__ src, bf16_t* __restrict__ dst, int K, int N, int Nd) {
    __shared__ float t[64][65];
    const int e = blockIdx.z; src += (size_t)e * K * N; dst += (size_t)e * Nd * K;
    const int n0 = blockIdx.x * 64, k0 = blockIdx.y * 64, tid = threadIdx.x, nl = tid & 63, kq = tid >> 6;
    const int nd = n0 + nl, sc = wsrc_col<MODE>(nd); const bool valid = sc < N;
#pragma unroll 4
    for (int i = 0; i < 16; ++i) { const int kk = kq + 4 * i; t[kk][nl] = valid ? src[(size_t)(k0 + kk) * N + sc] : 0.f; }
    __syncthreads();
#pragma unroll
    for (int i = 0; i < 2; ++i) { const int ch = tid + 256 * i, n = ch >> 3, c8 = ch & 7;
        uint4 o; o.x = pk2(t[c8 * 8 + 0][n], t[c8 * 8 + 1][n]); o.y = pk2(t[c8 * 8 + 2][n], t[c8 * 8 + 3][n]); o.z = pk2(t[c8 * 8 + 4][n], t[c8 * 8 + 5][n]); o.w = pk2(t[c8 * 8 + 6][n], t[c8 * 8 + 7][n]);
        *(uint4*)(dst + (size_t)(n0 + n) * K + k0 + c8 * 8) = o; }
}

struct S5P { float lamb[2][32][64][2]; float bbar[2][32][64][16][2]; float lam16[2][32][64][2]; };
DEVI void s5prep_one(const float* lam_re, const float* lam_im, const float* log_dt, const float* b_re, const float* b_im, S5P* P, int i) {
    const int p = i & 63, g = (i >> 6) & 31, d = i >> 11;
    const double dt = exp((double)log_dt[d * 32 + g]);
    const double lr = lam_re[i], li = lam_im[i];
    const double mag = exp(lr * dt), ar = mag * cos(li * dt), ai = mag * sin(li * dt);
    const double nr = ar - 1.0, ni = ai, den = lr * lr + li * li;
    const double cr = (nr * lr + ni * li) / den, ci = (ni * lr - nr * li) / den;
    P->lamb[d][g][p][0] = (float)ar; P->lamb[d][g][p][1] = (float)ai;
    for (int h = 0; h < 16; ++h) { const double br = b_re[(size_t)i * 16 + h], bi = b_im[(size_t)i * 16 + h];
        P->bbar[d][g][p][h][0] = (float)(cr * br - ci * bi); P->bbar[d][g][p][h][1] = (float)(cr * bi + ci * br); }
}
__global__ void k_s5prep(const float* lam_re, const float* lam_im, const float* log_dt, const float* b_re, const float* b_im, S5P* P) {
    const int i = blockIdx.x * blockDim.x + threadIdx.x; if (i >= 2 * 32 * 64) return;
    s5prep_one(lam_re, lam_im, log_dt, b_re, b_im, P, i);
}

DEVI void norm_row(const float* __restrict__ x, const float* __restrict__ ctx, const float* __restrict__ w, const float* __restrict__ mod,
                                              bf16_t* __restrict__ H, int row, int lane, int sh_off, int sc_off) {
    const float* src; int b;
    if (row < NTOK) { src = x + (size_t)row * DM; b = row / SEQ; } else { src = ctx + (size_t)(row - NTOK) * DM; b = 8; }
    float4 v[4]; float ss = 0.f;
#pragma unroll
    for (int j = 0; j < 4; ++j) { v[j] = *(const float4*)(src + lane * 4 + 256 * j); ss += v[j].x * v[j].x + v[j].y * v[j].y + v[j].z * v[j].z + v[j].w * v[j].w; }
    const float rstd = rsqrtf(wave_sum(ss) * (1.f / DM) + 1e-6f);
    const float* msh = mod + b * 6144 + sh_off; const float* msc = mod + b * 6144 + sc_off;
#pragma unroll
    for (int j = 0; j < 4; ++j) { const int k = lane * 4 + 256 * j;
        const float4 ww = *(const float4*)(w + k), sc = *(const float4*)(msc + k), sh = *(const float4*)(msh + k);
        uint2 o; o.x = pk2(v[j].x * rstd * ww.x * (1.f + sc.x) + sh.x, v[j].y * rstd * ww.y * (1.f + sc.y) + sh.y);
        o.y = pk2(v[j].z * rstd * ww.z * (1.f + sc.z) + sh.z, v[j].w * rstd * ww.w * (1.f + sc.w) + sh.w);
        *(uint2*)(H + (size_t)row * DM + k) = o; }
}
__global__ __launch_bounds__(256) void k_norm(const float* __restrict__ x, const float* __restrict__ ctx, const float* __restrict__ w, const float* __restrict__ mod,
                                              bf16_t* __restrict__ H, int nrows, int sh_off, int sc_off) {
    const int row = blockIdx.x * 4 + (threadIdx.x >> 6), lane = threadIdx.x & 63; if (row >= nrows) return;
    norm_row(x, ctx, w, mod, H, row, lane, sh_off, sc_off);
}

DEVI void dense_unit(int L, int nM, int nN, int& pm, int& pn) {
    const int nwg = nM * nN; int wgid = L; { const int q = nwg / 8, r = nwg % 8, xcd = wgid % 8, off = wgid / 8; wgid = (xcd < r ? xcd * (q + 1) : r * (q + 1) + (xcd - r) * q) + off; }
    const int nig = 8 * nN, gid = wgid / nig, fm = gid * 8, gsz = (nM - fm) < 8 ? (nM - fm) : 8;
    pm = fm + ((wgid % nig) % gsz); pn = (wgid % nig) / gsz;
}
template <class Prob> __global__ __launch_bounds__(256) void k_gemm_naive(Prob P) {
    __shared__ float As[32][68], Bs[32][68];
    const int z = blockIdx.z, M = P.M(z), r0 = blockIdx.y * 64, c0 = blockIdx.x * 64; if (r0 >= M) return;
    const int tid = threadIdx.x, tx = tid & 7, ty = tid >> 3, K = P.K;
    const int lr = tid >> 2, lk = (tid & 3) * 8;
    const bool arow_ok = (r0 + lr) < M;
    const bf16_t* ap = P.A + (size_t)(arow_ok ? P.arow(z, r0 + lr) : 0) * P.lda + lk;
    const bf16_t* bp = P.Bt(z) + (size_t)(c0 + lr) * P.ldb + lk;
    float acc[2][8];
#pragma unroll
    for (int i = 0; i < 2; ++i)
#pragma unroll
        for (int j = 0; j < 8; ++j) acc[i][j] = 0.f;
    for (int k0 = 0; k0 < K; k0 += 32) {
        uint4 av = arow_ok ? *(const uint4*)(ap + k0) : make_uint4(0, 0, 0, 0); const uint4 bv = *(const uint4*)(bp + k0);
        const unsigned aw[4] = {av.x, av.y, av.z, av.w}, bw[4] = {bv.x, bv.y, bv.z, bv.w};
        __syncthreads();
#pragma unroll
        for (int j = 0; j < 4; ++j) { As[lk + 2 * j][lr] = __uint_as_float(aw[j] << 16); As[lk + 2 * j + 1][lr] = __uint_as_float(aw[j] & 0xffff0000u);
            Bs[lk + 2 * j][lr] = __uint_as_float(bw[j] << 16); Bs[lk + 2 * j + 1][lr] = __uint_as_float(bw[j] & 0xffff0000u); }
        __syncthreads();
#pragma unroll 8
        for (int k = 0; k < 32; ++k) { const float a0 = As[k][ty * 2], a1 = As[k][ty * 2 + 1];
            const float4 b0 = *(const float4*)&Bs[k][tx * 8], b1 = *(const float4*)&Bs[k][tx * 8 + 4];
            const float bb[8] = {b0.x, b0.y, b0.z, b0.w, b1.x, b1.y, b1.z, b1.w};
#pragma unroll
            for (int j = 0; j < 8; ++j) { acc[0][j] += a0 * bb[j]; acc[1][j] += a1 * bb[j]; } }
    }
#pragma unroll
    for (int i = 0; i < 2; ++i) { const int r = r0 + ty * 2 + i; if (r < M) P.store(z, r, c0 + tx * 8, acc[i]); }
}

struct ProbIn {
    static constexpr bool HOIST = false;
    const bf16_t* A; int lda; const bf16_t* B; int ldb; int K; bf16_t *QK, *V, *R, *UT, *U2; float* LR;
    DEVI int M(int) const { return NROWS; }
    DEVI int arow(int, int r) const { return r; }
    DEVI int nunits() const { return (NROWS / 256) * (INP / 256); }
    DEVI void unit(int L, int& z, int& pm, int& pn) const { z = 0; dense_unit(L, NROWS / 256, INP / 256, pm, pn); }
    DEVI unsigned aoffb(int, int r) const { return (unsigned)r * (unsigned)(lda * 2); }
    DEVI const bf16_t* Bt(int) const { return B; }
    DEVI void store(int, int r, int c0, const float (&v)[8]) const {
        if (c0 >= INC) return;
        uint4 o; o.x = pk2(v[0], v[1]); o.y = pk2(v[2], v[3]); o.z = pk2(v[4], v[5]); o.w = pk2(v[6], v[7]);
        if (c0 < 512) { *(uint4*)(QK + (size_t)r * 512 + c0) = o; }
        else if (c0 < 1024) { *(uint4*)(V + (size_t)r * 512 + (c0 - 512)) = o; }
        else if (c0 < 1536) { *(uint4*)(R + (size_t)r * 512 + (c0 - 1024)) = o; }
        else if (c0 < 1568) { float* p = LR + (size_t)r * 32 + (c0 - 1536); *(float4*)p = make_float4(v[0], v[1], v[2], v[3]); *(float4*)(p + 4) = make_float4(v[4], v[5], v[6], v[7]); }
        else { const int j = c0 - 1568; *(uint4*)(UT + (size_t)r * 512 + j) = o;
            const int g = j >> 4, ch = j & 15; int urow, ucol;
            if (r < NTOK) { const int b = r >> 12, n = r & 4095, gr = n >> 6, gc = n & 63, s = gc * 64 + gr; urow = b * 256 + (s >> 4); ucol = (s & 15) * 16 + ch; }
            else { const int q = r - NTOK, b = q >> 8, t = q & 255; urow = 2048 + b * 16 + (t >> 4); ucol = (t & 15) * 16 + ch; }
            *(uint4*)(U2 + ((size_t)g * 2304 + urow) * 512 + ucol) = o; }
    }
};
struct ProbGlu {
    static constexpr bool HOIST = false;
    const bf16_t* A; int lda; const bf16_t* B; int ldb; int K; const float* bias; bf16_t* MIX;
    DEVI int M(int) const { return NTOK; }
    DEVI int arow(int, int r) const { return r; }
    DEVI int nunits() const { return (NTOK / 256) * 2; }
    DEVI void unit(int L, int& z, int& pm, int& pn) const { z = 0; dense_unit(L, NTOK / 256, 2, pm, pn); }
    DEVI unsigned aoffb(int, int r) const { return (unsigned)r * (unsigned)(lda * 2); }
    DEVI const bf16_t* Bt(int) const { return B; }
    DEVI void store(int, int r, int c0, const float (&v)[8]) const {
        const uint4 yv = *(const uint4*)(A + (size_t)r * lda + c0); const unsigned yw[4] = {yv.x, yv.y, yv.z, yv.w}; float o[8];
#pragma unroll
        for (int j = 0; j < 4; ++j) { const float y0 = __uint_as_float(yw[j] << 16), y1 = __uint_as_float(yw[j] & 0xffff0000u);
            o[2 * j] = y0 * sigmoidf_(v[2 * j] + bias[c0 + 2 * j]); o[2 * j + 1] = y1 * sigmoidf_(v[2 * j + 1] + bias[c0 + 2 * j + 1]); }
        uint4 w; w.x = pk2(o[0], o[1]); w.y = pk2(o[2], o[3]); w.z = pk2(o[4], o[5]); w.w = pk2(o[6], o[7]);
        *(uint4*)(MIX + (size_t)r * DM + 512 + c0) = w;
    }
};
struct ProbOut {
    static constexpr bool HOIST = false;
    const bf16_t* A; int lda; const bf16_t* B; int ldb; int K; const float* x; const float* mod; float* X1;
    DEVI int M(int) const { return NTOK; }
    DEVI int arow(int, int r) const { return r; }
    DEVI int nunits() const { return (NTOK / 256) * 4; }
    DEVI void unit(int L, int& z, int& pm, int& pn) const { z = 0; dense_unit(L, NTOK / 256, 4, pm, pn); }
    DEVI unsigned aoffb(int, int r) const { return (unsigned)r * (unsigned)(lda * 2); }
    DEVI const bf16_t* Bt(int) const { return B; }
    DEVI void store(int, int r, int c0, const float (&v)[8]) const {
        const float* g1 = mod + (r >> 12) * 6144 + 2048 + c0; const float* xp = x + (size_t)r * DM + c0; float* op = X1 + (size_t)r * DM + c0;
        const float4 x0 = *(const float4*)xp, x1 = *(const float4*)(xp + 4), ga = *(const float4*)g1, gb = *(const float4*)(g1 + 4);
        *(float4*)op = make_float4(x0.x + ga.x * v[0], x0.y + ga.y * v[1], x0.z + ga.z * v[2], x0.w + ga.w * v[3]);
        *(float4*)(op + 4) = make_float4(x1.x + gb.x * v[4], x1.y + gb.y * v[5], x1.z + gb.z * v[6], x1.w + gb.w * v[7]);
    }
};
struct ProbMoe1 {
    const bf16_t* A; int lda; const bf16_t* B; int ldb; int K; const int* cnt; const int* offs; const int* list; const float* b_gu; bf16_t* ACT;
    DEVI int M(int z) const { return cnt[z]; }
    DEVI int arow(int z, int r) const { return list[z * LISTCAP + r] >> 2; }
    DEVI const bf16_t* Bt(int z) const { return B + (size_t)z * 2048 * DM; }
    DEVI void store(int z, int r, int c0, const float (&v)[8]) const {
        const int f0 = (c0 >> 3) * 4; const float* bg = b_gu + (size_t)z * 2048 + f0; float a[4];
#pragma unroll
        for (int i = 0; i < 4; ++i) { float g = v[i] + bg[i], l = v[4 + i] + bg[1024 + i]; g = fminf(g, 7.f); l = fminf(fmaxf(l, -7.f), 7.f); a[i] = (l + 1.f) * (g * sigmoidf_(1.702f * g)); }
        uint2 o; o.x = pk2(a[0], a[1]); o.y = pk2(a[2], a[3]);
        *(uint2*)(ACT + (size_t)(offs[z] + r) * DFF + f0) = o;
    }
};
struct ProbMoe2 {
    const bf16_t* A; int lda; const bf16_t* B; int ldb; int K; const int* cnt; const int* offs; const int* list; const float* b_down; const float* gate; bf16_t* YSL;
    DEVI int M(int z) const { return cnt[z]; }
    DEVI int arow(int z, int r) const { return offs[z] + r; }
    DEVI const bf16_t* Bt(int z) const { return B + (size_t)z * DM * DFF; }
    DEVI void store(int z, int r, int c0, const float (&v)[8]) const {
        const int ent = list[z * LISTCAP + r]; const float gt = gate[ent]; const float* bd = b_down + (size_t)z * DM + c0;
        uint4 o; o.x = pk2((v[0] + bd[0]) * gt, (v[1] + bd[1]) * gt); o.y = pk2((v[2] + bd[2]) * gt, (v[3] + bd[3]) * gt);
        o.z = pk2((v[4] + bd[4]) * gt, (v[5] + bd[5]) * gt); o.w = pk2((v[6] + bd[6]) * gt, (v[7] + bd[7]) * gt);
        *(uint4*)(YSL + (size_t)ent * DM + c0) = o;
    }
};

DEVI void gla_naive_body(const bf16_t* __restrict__ QK, const bf16_t* __restrict__ V, const float* __restrict__ LR, const float* __restrict__ lr_up,
                                                   const float* __restrict__ lr_bias, float* __restrict__ OF, float* __restrict__ OB, LAS float* sm, int item) {
    LAS float* sq = sm; LAS float* sk = sm + 64; LAS float* sa = sm + 128; LAS float* sv = sm + 192; LAS float* red = sm + 320;
    const int dir = item & 1, hh = (item >> 1) & 3, b = item >> 3, tid = threadIdx.x, e = tid & 127, dg = tid >> 7;
    float up[16]; float bias = 0.f;
    if (tid < 64) { for (int r = 0; r < 16; ++r) up[r] = lr_up[dir * 4096 + r * 256 + hh * 64 + tid]; bias = lr_bias[dir * 256 + hh * 64 + tid]; }
    float S[16];
#pragma unroll
    for (int i = 0; i < 16; ++i) S[i] = 0.f;
    float* O = dir ? OB : OF;
    for (int step = 0; step < CTX + SEQ; ++step) {
        int row;
        if (step < CTX) row = NTOK + b * CTX + (dir ? CTX - 1 - step : step);
        else { const int t = step - CTX; row = b * SEQ + (dir ? SEQ - 1 - t : t); }
        if (tid < 64) { const float* lp = LR + (size_t)row * 32 + dir * 16; float g = bias;
#pragma unroll
            for (int r = 0; r < 16; ++r) g += lp[r] * up[r];
            sa[tid] = __expf(logsigmoidf_(g) * (1.f / 16.f));
            sq[tid] = bf2f(QK[(size_t)row * 512 + hh * 64 + tid]) * 0.125f; sk[tid] = bf2f(QK[(size_t)row * 512 + 256 + hh * 64 + tid]); }
        else if (tid < 192) sv[tid - 64] = bf2f(V[(size_t)row * 512 + hh * 128 + (tid - 64)]);
        __syncthreads();
        const float v = sv[e]; float part = 0.f;
#pragma unroll
        for (int i = 0; i < 16; ++i) { const int d = dg * 16 + i; S[i] = sa[d] * S[i] + sk[d] * v; part += sq[d] * S[i]; }
        if (step >= CTX) red[dg * 128 + e] = part;
        __syncthreads();
        if (step >= CTX && dg == 0) O[(size_t)row * 512 + hh * 128 + e] = (red[e] + red[128 + e]) + (red[256 + e] + red[384 + e]);
    }
}
__global__ __launch_bounds__(512) void k_gla_naive(const bf16_t* __restrict__ QK, const bf16_t* __restrict__ V, const float* __restrict__ LR, const float* __restrict__ lr_up,
                                                   const float* __restrict__ lr_bias, float* __restrict__ OF, float* __restrict__ OB) {
    __shared__ float sm[832];
    gla_naive_body(QK, V, LR, lr_up, lr_bias, OF, OB, (LAS float*)sm, blockIdx.x);
}
DEVI void gla_post_row(const float* __restrict__ OF, const float* __restrict__ OB, const bf16_t* __restrict__ R, const float* __restrict__ nw, bf16_t* __restrict__ MIX, int tok, int lane) {
    const int c0 = lane * 8;
    float o[8]; float ss = 0.f;
#pragma unroll
    for (int j = 0; j < 8; ++j) { o[j] = OF[(size_t)tok * 512 + c0 + j] + OB[(size_t)tok * 512 + c0 + j]; ss += o[j] * o[j]; }
    ss += __shfl_xor(ss, 1); ss += __shfl_xor(ss, 2); ss += __shfl_xor(ss, 4); ss += __shfl_xor(ss, 8);
    const float rstd = rsqrtf(ss * (1.f / 128.f) + 1e-6f);
    float w[8];
#pragma unroll
    for (int j = 0; j < 8; ++j) { const float r = bf2f(R[(size_t)tok * 512 + c0 + j]); w[j] = o[j] * rstd * nw[(c0 + j) & 127] * siluf_(r); }
    uint4 q; q.x = pk2(w[0], w[1]); q.y = pk2(w[2], w[3]); q.z = pk2(w[4], w[5]); q.w = pk2(w[6], w[7]);
    *(uint4*)(MIX + (size_t)tok * DM + c0) = q;
}
__global__ __launch_bounds__(256) void k_gla_post(const float* __restrict__ OF, const float* __restrict__ OB, const bf16_t* __restrict__ R, const float* __restrict__ nw, bf16_t* __restrict__ MIX) {
    gla_post_row(OF, OB, R, nw, MIX, blockIdx.x * 4 + (threadIdx.x >> 6), threadIdx.x & 63);
}

DEVI void s5_naive_body(const bf16_t* __restrict__ UT, const S5P* __restrict__ P, const float* __restrict__ c_re, const float* __restrict__ c_im,
                                                  float* __restrict__ YF, float* __restrict__ YB, LAS float* hsw  , int id, int lane) {
    const int g = id & 31, dir = (id >> 5) & 1, b = id >> 6;
    const float lr = P->lamb[dir][g][lane][0], li = P->lamb[dir][g][lane][1];
    float br[16], bi[16];
#pragma unroll
    for (int h = 0; h < 16; ++h) { br[h] = P->bbar[dir][g][lane][h][0]; bi[h] = P->bbar[dir][g][lane][h][1]; }
    const int ch = lane & 15, part = lane >> 4;
    float cr[16], ci[16];
#pragma unroll
    for (int i = 0; i < 16; ++i) { const size_t ix = (((size_t)dir * 32 + g) * 16 + ch) * 64 + part * 16 + i; cr[i] = c_re[ix]; ci[i] = c_im[ix]; }
    float hr = 0.f, hi = 0.f; float* Y = dir ? YB : YF;
    for (int step = 0; step < CTX + SEQ; ++step) {
        int row;
        if (step < CTX) row = NTOK + b * CTX + (dir ? CTX - 1 - step : step);
        else { const int t = step - CTX, s = dir ? SEQ - 1 - t : t; row = b * SEQ + (s & 63) * 64 + (s >> 6); }
        const uint4 u0 = *(const uint4*)(UT + (size_t)row * 512 + g * 16), u1 = *(const uint4*)(UT + (size_t)row * 512 + g * 16 + 8);
        const unsigned uw[8] = {u0.x, u0.y, u0.z, u0.w, u1.x, u1.y, u1.z, u1.w};
        float bur = 0.f, bui = 0.f;
#pragma unroll
        for (int j = 0; j < 8; ++j) { const float ua = __uint_as_float(uw[j] << 16), ub = __uint_as_float(uw[j] & 0xffff0000u);
            bur += br[2 * j] * ua + br[2 * j + 1] * ub; bui += bi[2 * j] * ua + bi[2 * j + 1] * ub; }
        const float nr = lr * hr - li * hi + bur, ni = lr * hi + li * hr + bui; hr = nr; hi = ni;
        if (step >= CTX) {
            hsw[lane] = hr; hsw[64 + lane] = hi;
            asm volatile("s_waitcnt lgkmcnt(0)" ::: "memory");
            float acc = 0.f;
#pragma unroll
            for (int i = 0; i < 16; ++i) acc += cr[i] * hsw[part * 16 + i] - ci[i] * hsw[64 + part * 16 + i];
            acc += __shfl_xor(acc, 16); acc += __shfl_xor(acc, 32);
            asm volatile("s_waitcnt lgkmcnt(0)" ::: "memory");
            if (lane < 16) Y[(size_t)row * 512 + g * 16 + lane] = acc;
        }
    }
}
__global__ __launch_bounds__(256) void k_s5_naive(const bf16_t* __restrict__ UT, const S5P* __restrict__ P, const float* __restrict__ c_re, const float* __restrict__ c_im,
                                                  float* __restrict__ YF, float* __restrict__ YB) {
    __shared__ float hs[4][128];
    const int w = threadIdx.x >> 6;
    s5_naive_body(UT, P, c_re, c_im, YF, YB, (LAS float*)hs[w], blockIdx.x * 4 + w, threadIdx.x & 63);
}
__global__ __launch_bounds__(256) void k_s5_post(const float* __restrict__ YF, const float* __restrict__ YB, const bf16_t* __restrict__ UT, const float* __restrict__ dvec, bf16_t* __restrict__ YS) {
    const size_t i = (size_t)blockIdx.x * 256 + threadIdx.x; const int j = (int)(i & 511);
    const float y = YF[i] + YB[i] + dvec[j] * bf2f(UT[i]);
    YS[i] = f2bf(gelu_tanh(y));
}

DEVI void router_row(const float* __restrict__ X1, const float* __restrict__ w, const float* __restrict__ mod, const float* __restrict__ rw, const float* __restrict__ rb,
                                                bf16_t* __restrict__ H2, int* __restrict__ cnt, int* __restrict__ list, float* __restrict__ gate, LAS float* hrw  , int tok, int lane) {
    const int b = tok / SEQ;
    const float* src = X1 + (size_t)tok * DM;
    float4 v[4]; float ss = 0.f;
#pragma unroll
    for (int j = 0; j < 4; ++j) { v[j] = *(const float4*)(src + lane * 4 + 256 * j); ss += v[j].x * v[j].x + v[j].y * v[j].y + v[j].z * v[j].z + v[j].w * v[j].w; }
    const float rstd = rsqrtf(wave_sum(ss) * (1.f / DM) + 1e-6f);
    const float* msh = mod + b * 6144 + 3072; const float* msc = mod + b * 6144 + 4096;
#pragma unroll
    for (int j = 0; j < 4; ++j) { const int k = lane * 4 + 256 * j;
        const float4 ww = *(const float4*)(w + k), sc = *(const float4*)(msc + k), sh = *(const float4*)(msh + k);
        float4 h; h.x = v[j].x * rstd * ww.x * (1.f + sc.x) + sh.x; h.y = v[j].y * rstd * ww.y * (1.f + sc.y) + sh.y; h.z = v[j].z * rstd * ww.z * (1.f + sc.z) + sh.z; h.w = v[j].w * rstd * ww.w * (1.f + sc.w) + sh.w;
        hrw[k] = h.x; hrw[k + 1] = h.y; hrw[k + 2] = h.z; hrw[k + 3] = h.w;
        uint2 o; o.x = pk2(h.x, h.y); o.y = pk2(h.z, h.w); *(uint2*)(H2 + (size_t)tok * DM + k) = o; }
    asm volatile("s_waitcnt lgkmcnt(0)" ::: "memory");
    const int e = lane & 31, half = lane >> 5; float lg = 0.f;
    for (int k = half * 512; k < half * 512 + 512; ++k) lg += hrw[k] * rw[k * 32 + e];
    lg += __shfl_xor(lg, 32); lg += rb[e];
    float val = lg; float tv[4]; int ti[4];
#pragma unroll
    for (int t = 0; t < 4; ++t) { float bv = val; int bi = e;
#pragma unroll
        for (int o = 1; o < 32; o <<= 1) { const float ov = __shfl_xor(bv, o); const int oi = __shfl_xor(bi, o); if (ov > bv || (ov == bv && oi < bi)) { bv = ov; bi = oi; } }
        tv[t] = bv; ti[t] = bi; if (e == bi) val = -3.0e38f; }
    const float e1 = __expf(tv[1] - tv[0]), e2 = __expf(tv[2] - tv[0]), e3 = __expf(tv[3] - tv[0]), inv = 1.f / (1.f + e1 + e2 + e3);
    if (lane < 4) { const float gv = lane == 0 ? inv : lane == 1 ? e1 * inv : lane == 2 ? e2 * inv : e3 * inv; const int ex = lane == 0 ? ti[0] : lane == 1 ? ti[1] : lane == 2 ? ti[2] : ti[3];
        const int slot = atomicAdd(&cnt[ex], 1); list[ex * LISTCAP + slot] = tok * 4 + lane; gate[tok * 4 + lane] = gv; }
}
__global__ __launch_bounds__(256) void k_router(const float* __restrict__ X1, const float* __restrict__ w, const float* __restrict__ mod, const float* __restrict__ rw, const float* __restrict__ rb,
                                                bf16_t* __restrict__ H2, int* __restrict__ cnt, int* __restrict__ list, float* __restrict__ gate) {
    __shared__ float hrow[4][1024];
    const int wv = threadIdx.x >> 6;
    router_row(X1, w, mod, rw, rb, H2, cnt, list, gate, (LAS float*)hrow[wv], blockIdx.x * 4 + wv, threadIdx.x & 63);
}
__global__ void k_offsets(const int* cnt, int* offs) { if (threadIdx.x == 0) { int o = 0; for (int e = 0; e < NEXP; ++e) { offs[e] = o; o += (cnt[e] + MOEPAD - 1) / MOEPAD * MOEPAD; } offs[NEXP] = o; } }

DEVI void final_row(float* __restrict__ X1, const bf16_t* __restrict__ YSL, const float* __restrict__ mod, const float* __restrict__ fw, int tok, int lane) {
    const int b = tok / SEQ;
    float* row = X1 + (size_t)tok * DM; const float* g2 = mod + b * 6144 + 5120;
    float4 v[4]; float ss = 0.f;
#pragma unroll
    for (int j = 0; j < 4; ++j) { const int k = lane * 4 + 256 * j; v[j] = *(const float4*)(row + k); float f[4] = {0.f, 0.f, 0.f, 0.f};
#pragma unroll
        for (int s = 0; s < 4; ++s) { const uint2 y = *(const uint2*)(YSL + ((size_t)tok * 4 + s) * DM + k);
            f[0] += __uint_as_float(y.x << 16); f[1] += __uint_as_float(y.x & 0xffff0000u); f[2] += __uint_as_float(y.y << 16); f[3] += __uint_as_float(y.y & 0xffff0000u); }
        const float4 gg = *(const float4*)(g2 + k);
        v[j].x += gg.x * f[0]; v[j].y += gg.y * f[1]; v[j].z += gg.z * f[2]; v[j].w += gg.w * f[3];
        ss += v[j].x * v[j].x + v[j].y * v[j].y + v[j].z * v[j].z + v[j].w * v[j].w; }
    const float rstd = rsqrtf(wave_sum(ss) * (1.f / DM) + 1e-6f);
#pragma unroll
    for (int j = 0; j < 4; ++j) { const int k = lane * 4 + 256 * j; const float4 ww = *(const float4*)(fw + k);
        *(float4*)(row + k) = make_float4(v[j].x * rstd * ww.x, v[j].y * rstd * ww.y, v[j].z * rstd * ww.z, v[j].w * rstd * ww.w); }
}
__global__ __launch_bounds__(256) void k_final(float* __restrict__ X1, const bf16_t* __restrict__ YSL, const float* __restrict__ mod, const float* __restrict__ fw) {
    final_row(X1, YSL, mod, fw, blockIdx.x * 4 + (threadIdx.x >> 6), threadIdx.x & 63);
}

typedef short bf16x8 __attribute__((ext_vector_type(8)));
typedef float f32x4 __attribute__((ext_vector_type(4)));
typedef unsigned u32x4 __attribute__((ext_vector_type(4)));
typedef unsigned u32x2 __attribute__((ext_vector_type(2)));
constexpr int NWAVES = 8, NTHR = 512;
constexpr int BM = 256, BK = 64, HALF = 128, HTB = HALF * BK * 2, STAGE_BYTES = 8 * HTB;
constexpr int MISC_OFF = STAGE_BYTES, MISC_BYTES = 1024, LDS_BYTES = STAGE_BYTES + MISC_BYTES;
constexpr int CW_BAR = 4096;

#define XB_TMO      128
#define XB_XCNT(j)  (256  + 64 * (j))
#define XB_XSUB(j)  (1280 + 64 * (j))
#define XB_XGEN(j)  (2304 + 64 * (j))
#define XB_TOP      3328
#define XB_TOPGEN   3392
#define XCD_BAR_WORDS 3456
#define XB_SPIN_CAP (1u << 18)
DEVI unsigned xb_ld(unsigned* p)              { return __hip_atomic_load(p, __ATOMIC_RELAXED, __HIP_MEMORY_SCOPE_AGENT); }
DEVI unsigned xb_add(unsigned* p, unsigned v) { return __hip_atomic_fetch_add(p, v, __ATOMIC_RELAXED, __HIP_MEMORY_SCOPE_AGENT); }
DEVI unsigned xb_xcc_id() { return (unsigned)__builtin_amdgcn_s_getreg((3 << 11) | 20) & 0xFu; }
#define XB_SPIN(cond, bar) do { unsigned _sp = 0; while (cond) { __builtin_amdgcn_s_sleep(1); \
    if ((++_sp & 255u) == 0u) { if (xb_ld(&(bar)[XB_TMO])) break; if (_sp > XB_SPIN_CAP) { atomicAdd(&(bar)[XB_TMO], 1u); break; } } } } while (0)
struct XcdBarrier { unsigned* bar; unsigned x; volatile LAS unsigned* st; };
DEVI XcdBarrier xcd_barrier_post(unsigned* bar, volatile LAS unsigned* st) {
    XcdBarrier b; b.bar = bar; b.x = xb_xcc_id(); b.st = st;
    if (threadIdx.x == 0) (void)xb_add(&bar[XB_XCNT(b.x)], 1u);
    return b;
}
DEVI void xcd_barrier_complete(unsigned* bar, unsigned x, unsigned& nloc, unsigned& nx) {
    const unsigned G = gridDim.x * gridDim.y * gridDim.z;
    unsigned sum, cnt, mine, sp = 0u;
    for (;;) {
        sum = 0u; cnt = 0u; mine = 0u;
#pragma unroll
        for (unsigned j = 0; j < 16; ++j) { const unsigned c = xb_ld(&bar[XB_XCNT(j)]); sum += c; cnt += (c > 0u) ? 1u : 0u; mine = (j == x) ? c : mine; }
        if (sum == G) break;
        __builtin_amdgcn_s_sleep(1);
        if ((++sp & 255u) == 0u) { if (xb_ld(&bar[XB_TMO])) break; if (sp > XB_SPIN_CAP) { atomicAdd(&bar[XB_TMO], 1u); break; } }
    }
    nloc = mine > 0u ? mine : 1u; nx = cnt > 0u ? cnt : 1u;
}
DEVI void xcd_barrier(const XcdBarrier& b) {
    asm volatile("s_waitcnt vmcnt(0)" ::: "memory");
    __syncthreads();
    if (threadIdx.x == 0) {
        unsigned* bar = b.bar;
        __builtin_amdgcn_s_waitcnt(0);
        unsigned nloc = b.st[0], nx = b.st[1];
        if (nloc == 0u) { xcd_barrier_complete(bar, b.x, nloc, nx); b.st[0] = nloc; b.st[1] = nx; }
        const unsigned old = xb_add(&bar[XB_XSUB(b.x)], 1u);
        const unsigned gen = old / nloc;
        if (old + 1u == (gen + 1u) * nloc) {
            __builtin_amdgcn_fence(__ATOMIC_RELEASE, "agent");
            asm volatile("s_waitcnt vmcnt(0)" ::: "memory");
            const unsigned og = xb_add(&bar[XB_TOP], 1u);
            const unsigned tg = og / nx;
            if (og + 1u == (tg + 1u) * nx) xb_add(&bar[XB_TOPGEN], 1u);
            else XB_SPIN(xb_ld(&bar[XB_TOPGEN]) == tg, bar);
            __builtin_amdgcn_fence(__ATOMIC_ACQUIRE, "agent");
            xb_add(&bar[XB_XGEN(b.x)], 1u);
            asm volatile("s_waitcnt vmcnt(0)" ::: "memory");
        } else {
            XB_SPIN(xb_ld(&bar[XB_XGEN(b.x)]) == gen, bar);
            __builtin_amdgcn_fence(__ATOMIC_ACQUIRE, "agent");
            asm volatile("s_waitcnt vmcnt(0)" ::: "memory");
        }
    }
    __syncthreads();
}

DEVI int lds_byte(int r, int c) { const int st = (r >> 4) * 2 + (c >> 5), rr = r & 15, cc = c & 31, ob = rr * 64 + cc * 2; return st * 1024 + (ob ^ (((ob >> 9) & 1) << 5)); }
DEVI void stage_rc(int b, int& R, int& C) { const int st = b / 1024, sb = b % 1024, swz = sb ^ (((sb >> 9) & 1) << 5); R = (st >> 1) * 16 + swz / 64; C = (st & 1) * 32 + (swz % 64) / 2; }
DEVI int perm32(int rho) { const int n = rho >> 4, i = rho & 15; return 8 * (i >> 2) + 4 * n + (i & 3); }
template <class Prob>
DEVI void gemm_phase(LAS unsigned char* lds, const Prob& P, int G, int c) {
    int tid = threadIdx.x; asm volatile("" : "+v"(tid));
    const int wid = __builtin_amdgcn_readfirstlane(tid >> 6), lane = tid & 63, wr = wid >> 2, wc = wid & 3, fr = lane & 15, fq = lane >> 4;
    const int K = P.K, nt = K / BK;
    const int nun = P.nunits();
    int L = c; if (L >= nun) return;
    int Rs0, Cs0, Rs1, Cs1; stage_rc(tid * 16, Rs0, Cs0); stage_rc(tid * 16 + 8192, Rs1, Cs1);
    unsigned voffB[2];
    voffB[0] = (unsigned)(((Rs0 & ~31) + perm32(Rs0 & 31)) * K + Cs0) * 2u; voffB[1] = (unsigned)(((Rs1 & ~31) + perm32(Rs1 & 31)) * K + Cs1) * 2u;
    const size_t kstep = (size_t)(BK * 2), hstepB = (size_t)HALF * K * 2, tstepB = 2 * hstepB;
    const unsigned ldsw = (unsigned)wid * 1024u;
    const int aoff = lds_byte(wr * 64 + fr, fq * 8), boff = lds_byte(wc * 32 + fr, fq * 8);
#define G_SA(b, h) (((b) * 2 + (h)) * HTB)
#define G_SB(b, h) ((4 + (b) * 2 + (h)) * HTB)
#define G_STAGE_B(bufoff, gbase) do { _Pragma("unroll") for (int _i = 0; _i < 2; ++_i) \
        __builtin_amdgcn_global_load_lds((const unsigned*)((const char*)(gbase) + voffB[_i]), (LAS unsigned*)(lds + (bufoff) + ldsw + _i * 8192), 16, 0, 0); } while (0)
#define G_STAGE_A(bufoff, gbase, v0, v1) do { \
        __builtin_amdgcn_global_load_lds((const unsigned*)((const char*)(gbase) + (v0)), (LAS unsigned*)(lds + (bufoff) + ldsw), 16, 0, 0); \
        __builtin_amdgcn_global_load_lds((const unsigned*)((const char*)(gbase) + (v1)), (LAS unsigned*)(lds + (bufoff) + ldsw + 8192), 16, 0, 0); } while (0)
#define G_LDA(dst, b, h) do { _Pragma("unroll") for (int m = 0; m < 4; ++m) _Pragma("unroll") for (int k = 0; k < 2; ++k) dst[m][k] = *(const LAS bf16x8*)(lds + G_SA(b, h) + aoff + m * 2048 + k * 1024); } while (0)
#define G_LDB(dst, b, h) do { _Pragma("unroll") for (int n = 0; n < 2; ++n) _Pragma("unroll") for (int k = 0; k < 2; ++k) dst[n][k] = *(const LAS bf16x8*)(lds + G_SB(b, h) + boff + n * 2048 + k * 1024); } while (0)
#define G_MMA(ai, bj, At, Bt) do { __builtin_amdgcn_s_setprio(1); _Pragma("unroll") for (int m = 0; m < 4; ++m) _Pragma("unroll") for (int n = 0; n < 2; ++n) _Pragma("unroll") for (int k = 0; k < 2; ++k) \
        acc[ai][bj][m][n] = __builtin_amdgcn_mfma_f32_16x16x32_bf16(Bt[n][k], At[m][k], acc[ai][bj][m][n], 0, 0, 0); __builtin_amdgcn_s_setprio(0); } while (0)
#define G_WAIT_V(n) asm volatile("s_waitcnt vmcnt(" #n ")" ::: "memory")
#define G_WAIT_L(n) asm volatile("s_waitcnt lgkmcnt(" #n ")" ::: "memory")
#define G_BAR __builtin_amdgcn_s_barrier()
#define G_SCHED __builtin_amdgcn_sched_barrier(0)
    int z, pm, pn; P.unit(L, z, pm, pn);
    z = __builtin_amdgcn_readfirstlane(z); pm = __builtin_amdgcn_readfirstlane(pm); pn = __builtin_amdgcn_readfirstlane(pn);
    unsigned vA00 = P.aoffb(z, pm * BM + Rs0) + Cs0 * 2, vA01 = P.aoffb(z, pm * BM + Rs1) + Cs1 * 2;
    unsigned vA10 = P.aoffb(z, pm * BM + HALF + Rs0) + Cs0 * 2, vA11 = P.aoffb(z, pm * BM + HALF + Rs1) + Cs1 * 2;
    const char* const Ab = (const char*)P.A;
    const char* cB = (const char*)P.Bt(z) + (size_t)pn * tstepB;
    f32x4 acc[2][2][4][2];
    bf16x8 At[4][2], B0[2][2], B1[2][2];
    G_STAGE_B(G_SB(0, 0), cB); G_STAGE_A(G_SA(0, 0), Ab, vA00, vA01); G_STAGE_B(G_SB(0, 1), cB + hstepB); G_STAGE_A(G_SA(0, 1), Ab, vA10, vA11);
    if (wr == 1) G_BAR;
    G_WAIT_V(4); G_BAR;
    G_STAGE_B(G_SB(1, 0), cB + kstep); G_STAGE_A(G_SA(1, 0), Ab + kstep, vA00, vA01); G_STAGE_B(G_SB(1, 1), cB + hstepB + kstep);
    G_WAIT_V(6); G_BAR;
    for (;;) {
        const int Ln = L + G; const bool has_next = Ln < nun;
        int nz = z, npm = pm, npn = pn; if (has_next) P.unit(Ln, nz, npm, npn);
        nz = __builtin_amdgcn_readfirstlane(nz); npm = __builtin_amdgcn_readfirstlane(npm); npn = __builtin_amdgcn_readfirstlane(npn);
        const char* nB = has_next ? (const char*)P.Bt(nz) + (size_t)npn * tstepB : cB;
#pragma unroll
        for (int a = 0; a < 2; ++a)
#pragma unroll
            for (int b = 0; b < 2; ++b)
#pragma unroll
                for (int m = 0; m < 4; ++m)
#pragma unroll
                    for (int n = 0; n < 2; ++n) acc[a][b][m][n] = (f32x4){0.f, 0.f, 0.f, 0.f};
#pragma unroll 1
        for (int t = 0; t < nt; t += 2) {
            const bool last = (t == nt - 2);
            unsigned n00 = vA00, n01 = vA01, n10 = vA10, n11 = vA11;
            if (last && has_next) { n00 = P.aoffb(nz, npm * BM + Rs0) + Cs0 * 2; n01 = P.aoffb(nz, npm * BM + Rs1) + Cs1 * 2;
                n10 = P.aoffb(nz, npm * BM + HALF + Rs0) + Cs0 * 2; n11 = P.aoffb(nz, npm * BM + HALF + Rs1) + Cs1 * 2; }
            const char* a1 = Ab + (size_t)(t + 1) * kstep;
            const char* a2 = last ? Ab : Ab + (size_t)(t + 2) * kstep; const char* b2 = last ? nB : cB + (size_t)(t + 2) * kstep;
            const char* a3 = a2 + kstep; const char* b3 = b2 + kstep;
            G_LDB(B0, 0, 0); G_SCHED; G_LDA(At, 0, 0); G_STAGE_A(G_SA(1, 1), a1, vA10, vA11);
            G_WAIT_L(8); G_BAR; G_WAIT_L(0); G_MMA(0, 0, At, B0); G_BAR; G_SCHED;
            if (last) { vA00 = n00; vA01 = n01; vA10 = n10; vA11 = n11; }
            G_LDB(B1, 0, 1); G_STAGE_B(G_SB(0, 0), b2);
            G_BAR; G_WAIT_L(0); G_MMA(0, 1, At, B1); G_BAR;
            G_LDA(At, 0, 1); G_STAGE_A(G_SA(0, 0), a2, vA00, vA01);
            G_BAR; G_WAIT_L(0); G_MMA(1, 0, At, B0); G_BAR; G_SCHED;
            G_STAGE_B(G_SB(0, 1), b2 + hstepB);
            G_WAIT_V(6); G_BAR; G_MMA(1, 1, At, B1); G_BAR;
            G_LDB(B0, 1, 0); G_SCHED; G_LDA(At, 1, 0); G_STAGE_A(G_SA(0, 1), a2, vA10, vA11);
            G_WAIT_L(8); G_BAR; G_WAIT_L(0); G_MMA(0, 0, At, B0); G_BAR; G_SCHED;
            G_LDB(B1, 1, 1); G_STAGE_B(G_SB(1, 0), b3);
            G_BAR; G_WAIT_L(0); G_MMA(0, 1, At, B1); G_BAR;
            G_LDA(At, 1, 1); G_STAGE_A(G_SA(1, 0), a3, vA00, vA01);
            G_BAR; G_WAIT_L(0); G_MMA(1, 0, At, B0); G_BAR; G_SCHED;
            G_STAGE_B(G_SB(1, 1), b3 + hstepB);
            G_WAIT_V(6); G_BAR; G_MMA(1, 1, At, B1); G_BAR;
        }
        { const int Mz = __builtin_amdgcn_readfirstlane(P.M(z));
          const int cb0 = pn * BM + wc * 32 + 8 * fq, rb0 = pm * BM + wr * 64 + fr;
          if constexpr (Prob::HOIST) {
              typename Prob::ColCtx cc[2]; typename Prob::RowCtx rc[2][4];
#pragma unroll
              for (int bj = 0; bj < 2; ++bj) cc[bj] = P.colctx(z, cb0 + bj * HALF);
#pragma unroll
              for (int ai = 0; ai < 2; ++ai)
#pragma unroll
                  for (int m = 0; m < 4; ++m) { const int row = rb0 + ai * HALF + m * 16; rc[ai][m] = P.rowctx(z, row, row < Mz); }
#pragma unroll
              for (int ai = 0; ai < 2; ++ai)
#pragma unroll
                  for (int m = 0; m < 4; ++m) { const int row = rb0 + ai * HALF + m * 16;
                      if (row < Mz) {
#pragma unroll
                          for (int bj = 0; bj < 2; ++bj) { const f32x4 v0 = acc[ai][bj][m][0], v1 = acc[ai][bj][m][1];
                              const float v[8] = {v0[0], v0[1], v0[2], v0[3], v1[0], v1[1], v1[2], v1[3]};
                              P.storeh(cc[bj], rc[ai][m], cb0 + bj * HALF, v); } } }
          } else {
#pragma unroll
          for (int ai = 0; ai < 2; ++ai)
#pragma unroll
            for (int m = 0; m < 4; ++m) { const int row = rb0 + ai * HALF + m * 16;
                if (row < Mz) {
#pragma unroll
                    for (int bj = 0; bj < 2; ++bj) { const int c0 = cb0 + bj * HALF;
                        const f32x4 v0 = acc[ai][bj][m][0], v1 = acc[ai][bj][m][1];
                        const float v[8] = {v0[0], v0[1], v0[2], v0[3], v1[0], v1[1], v1[2], v1[3]};
                        P.store(z, row, c0, v); } }
                asm volatile("" ::: "memory"); } } }
        if (!has_next) break;
        z = nz; pm = npm; pn = npn; cB = nB; L = Ln;
    }
    G_WAIT_V(0);
    if (wr == 0) G_BAR;
    G_BAR;
}

template <int NT> DEVI void moe_unit(const LAS int* ub, int L, int G, int& z, int& pm, int& pn) {
    const int nun = __builtin_amdgcn_readfirstlane(ub[NEXP]) * NT;
    int Lq = L;
    if ((G & 7) == 0) { const int i = L / G, c = L - i * G, x = c & 7, j = c >> 3, per = G >> 3; Lq = (i * 8 + x) * per + j; }
    if (Lq >= nun) { z = -1; pm = 0; pn = 0; return; }
    int e = 0; while (e < NEXP - 1 && Lq >= __builtin_amdgcn_readfirstlane(ub[e + 1]) * NT) ++e;
    const int l = Lq - __builtin_amdgcn_readfirstlane(ub[e]) * NT; z = e; pm = l / NT; pn = l % NT;
}
struct FMoe1 {
    static constexpr bool HOIST = true; static constexpr int NT = 8;
    const bf16_t* A; const bf16_t* B; int K; const int* cnt; const int* list; const float* b_gu; bf16_t* ACT; const LAS int* ub; int G;
    struct ColCtx { float bg[4], bl[4]; int f0; }; struct RowCtx { bf16_t* p; };
    DEVI int ubs(int e) const { return __builtin_amdgcn_readfirstlane(ub[e]); }
    DEVI int nunits() const { const int n = ubs(NEXP) * NT; return (G & 7) == 0 ? (n + G - 1) / G * G : n; }
    DEVI void unit(int L, int& z, int& pm, int& pn) const { moe_unit<NT>(ub, L, G, z, pm, pn); }
    DEVI int M(int z) const { return z < 0 ? 0 : cnt[z]; }
    DEVI unsigned aoffb(int z, int r) const { const int t = (z >= 0 && r < cnt[z]) ? (list[z * LISTCAP + r] >> 2) : 0; return (unsigned)t * (unsigned)(DM * 2); }
    DEVI const bf16_t* Bt(int z) const { return B + (size_t)(z < 0 ? 0 : z) * 2048 * DM; }
    DEVI ColCtx colctx(int z, int c0) const { ColCtx c; c.f0 = (c0 >> 3) * 4; const float* bp = b_gu + (size_t)(z < 0 ? 0 : z) * 2048 + c.f0; const float4 g = *(const float4*)bp, l = *(const float4*)(bp + 1024);
        c.bg[0] = g.x; c.bg[1] = g.y; c.bg[2] = g.z; c.bg[3] = g.w; c.bl[0] = l.x; c.bl[1] = l.y; c.bl[2] = l.z; c.bl[3] = l.w; return c; }
    DEVI RowCtx rowctx(int z, int r, bool) const { RowCtx x; x.p = ACT + (size_t)(ubs(z < 0 ? 0 : z) * 256 + r) * DFF; return x; }
    DEVI void storeh(const ColCtx& c, const RowCtx& x, int, const float (&v)[8]) const { float a[4];
#pragma unroll
        for (int i = 0; i < 4; ++i) { float g = v[i] + c.bg[i], l = v[4 + i] + c.bl[i]; g = fminf(g, 7.f); l = fminf(fmaxf(l, -7.f), 7.f); a[i] = (l + 1.f) * g * __builtin_amdgcn_rcpf(1.f + __expf(-1.702f * g)); }
        uint2 o; o.x = pk2(a[0], a[1]); o.y = pk2(a[2], a[3]); *(uint2*)(x.p + c.f0) = o; }
    DEVI void store(int, int, int, const float (&)[8]) const {}
};
struct FMoe2 {
    static constexpr bool HOIST = true; static constexpr int NT = 4;
    const bf16_t* A; const bf16_t* B; int K; const int* cnt; const int* list; const float* b_down; const float* gate; bf16_t* YSL; const LAS int* ub; int G;
    struct ColCtx { float bd[8]; }; struct RowCtx { bf16_t* p; float gt; };
    DEVI int ubs(int e) const { return __builtin_amdgcn_readfirstlane(ub[e]); }
    DEVI int nunits() const { const int n = ubs(NEXP) * NT; return (G & 7) == 0 ? (n + G - 1) / G * G : n; }
    DEVI void unit(int L, int& z, int& pm, int& pn) const { moe_unit<NT>(ub, L, G, z, pm, pn); }
    DEVI int M(int z) const { return z < 0 ? 0 : cnt[z]; }
    DEVI unsigned aoffb(int z, int r) const { return (unsigned)(ubs(z < 0 ? 0 : z) * 256 + r) * (unsigned)(DFF * 2); }
    DEVI const bf16_t* Bt(int z) const { return B + (size_t)(z < 0 ? 0 : z) * DM * DFF; }
    DEVI ColCtx colctx(int z, int c0) const { ColCtx c; const float* bp = b_down + (size_t)(z < 0 ? 0 : z) * DM + c0; const float4 a = *(const float4*)bp, b = *(const float4*)(bp + 4);
        c.bd[0] = a.x; c.bd[1] = a.y; c.bd[2] = a.z; c.bd[3] = a.w; c.bd[4] = b.x; c.bd[5] = b.y; c.bd[6] = b.z; c.bd[7] = b.w; return c; }
    DEVI RowCtx rowctx(int z, int r, bool ok) const { RowCtx x; const int ent = ok ? list[z * LISTCAP + r] : 0; x.gt = gate[ent]; x.p = YSL + (size_t)ent * DM; return x; }
    DEVI void storeh(const ColCtx& c, const RowCtx& x, int c0, const float (&v)[8]) const {
        uint4 o; o.x = pk2((v[0] + c.bd[0]) * x.gt, (v[1] + c.bd[1]) * x.gt); o.y = pk2((v[2] + c.bd[2]) * x.gt, (v[3] + c.bd[3]) * x.gt);
        o.z = pk2((v[4] + c.bd[4]) * x.gt, (v[5] + c.bd[5]) * x.gt); o.w = pk2((v[6] + c.bd[6]) * x.gt, (v[7] + c.bd[7]) * x.gt);
        *(uint4*)(x.p + c0) = o; }
    DEVI void store(int, int, int, const float (&)[8]) const {}
};

struct MArgs { const float* in[30]; float* out; unsigned char* ws; int ph_lo, ph_hi; };
struct MArgs_in { const float *lam_re, *lam_im, *log_dt, *b_re, *b_im, *c_re, *c_im; };

constexpr int GL_LRS = 0, GL_TOT = 8192, GL_QF = 12288, GL_KF = 21504, GL_QB = 30720, GL_KB = 39936, GL_VT = 49152, GL_PP = 67584, GL_SSQ = 76800, GL_UST = 67584;
constexpr int GL_LD = 72;

struct GlaPtrs { const bf16_t* QK; const bf16_t* V; const bf16_t* R; const float* LR; const float* lr_up; const float* lr_bias; const float* nw; bf16_t* UCH; float* ADEC; bf16_t* SST; bf16_t* MIX; };

DEVI void gla_gates(const GlaPtrs& G, LAS unsigned char* lds, int h, int d, int to, float (&cf)[8], float (&cb)[8]) {
    const LAS float* LRS = (const LAS float*)(lds + GL_LRS); LAS float* TOT = (LAS float*)(lds + GL_TOT);
#pragma unroll
    for (int dir = 0; dir < 2; ++dir) {
        float up[16];
#pragma unroll
        for (int r = 0; r < 16; ++r) up[r] = G.lr_up[dir * 4096 + r * 256 + h * 64 + d];
        const float bias = G.lr_bias[dir * 256 + h * 64 + d];
        float la[8];
#pragma unroll
        for (int j = 0; j < 8; ++j) { const LAS f32x4* lp = (const LAS f32x4*)(LRS + (to * 8 + j) * 32 + dir * 16); float g = bias;
#pragma unroll
            for (int q = 0; q < 4; ++q) { const f32x4 x = lp[q]; g += x[0] * up[4 * q] + x[1] * up[4 * q + 1] + x[2] * up[4 * q + 2] + x[3] * up[4 * q + 3]; }
            la[j] = logsigmoidf_(g) * (1.f / 16.f); }
        if (dir == 0) { cf[0] = la[0];
#pragma unroll
            for (int j = 1; j < 8; ++j) cf[j] = cf[j - 1] + la[j];
            TOT[(0 * 8 + to) * 64 + d] = cf[7]; }
        else { cb[7] = la[7];
#pragma unroll
            for (int j = 6; j >= 0; --j) cb[j] = cb[j + 1] + la[j];
            TOT[(1 * 8 + to) * 64 + d] = cb[0]; }
    }
}
DEVI void gla_stage(const GlaPtrs& G, LAS unsigned char* lds, int row0, int h, int tid) {
    *(LAS f32x4*)(lds + GL_LRS + tid * 16) = *(const f32x4*)(G.LR + (size_t)row0 * 32 + tid * 4);
    const int ep = tid & 63, to = tid >> 6; unsigned w[8];
#pragma unroll
    for (int j = 0; j < 8; ++j) w[j] = *(const unsigned*)(G.V + (size_t)(row0 + to * 8 + j) * 512 + h * 128 + 2 * ep);
    u32x4 lo, hi;
    lo.x = (w[0] & 0xffffu) | (w[1] << 16); lo.y = (w[2] & 0xffffu) | (w[3] << 16); lo.z = (w[4] & 0xffffu) | (w[5] << 16); lo.w = (w[6] & 0xffffu) | (w[7] << 16);
    hi.x = (w[0] >> 16) | (w[1] & 0xffff0000u); hi.y = (w[2] >> 16) | (w[3] & 0xffff0000u); hi.z = (w[4] >> 16) | (w[5] & 0xffff0000u); hi.w = (w[6] >> 16) | (w[7] & 0xffff0000u);
    *(LAS u32x4*)(lds + GL_VT + ((2 * ep) * GL_LD + to * 8) * 2) = lo;
    *(LAS u32x4*)(lds + GL_VT + ((2 * ep + 1) * GL_LD + to * 8) * 2) = hi;
}

DEVI void gla_a_item(const GlaPtrs& G, LAS unsigned char* lds, int item) {
    int tid = threadIdx.x; asm volatile("" : "+v"(tid));
    const int wave = __builtin_amdgcn_readfirstlane(tid >> 6), lane = tid & 63, d = lane, to = wave, fr = lane & 15, fq = lane >> 4;
    const int ch = item % 68, bh = item / 68, h = bh & 3, b = bh >> 2;
    const int row0 = ch < 4 ? NTOK + b * CTX + ch * 64 : b * SEQ + (ch - 4) * 64;
    gla_stage(G, lds, row0, h, tid);
    bf16_t kk[8];
#pragma unroll
    for (int j = 0; j < 8; ++j) kk[j] = G.QK[(size_t)(row0 + to * 8 + j) * 512 + 256 + h * 64 + d];
    __syncthreads();
    float cf[8], cb[8];
    gla_gates(G, lds, h, d, to, cf, cb);
    __syncthreads();
    const LAS float* TOT = (const LAS float*)(lds + GL_TOT);
    float offf = 0.f, offb = 0.f, totf = 0.f, totb = 0.f;
#pragma unroll
    for (int t = 0; t < 8; ++t) { const float a = TOT[(0 * 8 + t) * 64 + d], c = TOT[(1 * 8 + t) * 64 + d]; totf += a; totb += c; if (t < to) offf += a; if (t > to) offb += c; }
    float of[8], ob[8];
#pragma unroll
    for (int j = 0; j < 8; ++j) { const float kf = bf2f(kk[j]); of[j] = kf * __expf(totf - (cf[j] + offf)); ob[j] = kf * __expf(totb - (cb[j] + offb)); }
    { u32x4 w; w.x = pk2(of[0], of[1]); w.y = pk2(of[2], of[3]); w.z = pk2(of[4], of[5]); w.w = pk2(of[6], of[7]); *(LAS u32x4*)(lds + GL_QF + (d * GL_LD + to * 8) * 2) = w;
      w.x = pk2(ob[0], ob[1]); w.y = pk2(ob[2], ob[3]); w.z = pk2(ob[4], ob[5]); w.w = pk2(ob[6], ob[7]); *(LAS u32x4*)(lds + GL_KF + (d * GL_LD + to * 8) * 2) = w; }
    const int chain_f = bh * 2, step_f = ch < 4 ? ch : ch, step_b = ch < 4 ? 3 - ch : 4 + (67 - ch);
    if (to == 0) { G.ADEC[((size_t)chain_f * 68 + step_f) * 64 + d] = __expf(totf); G.ADEC[((size_t)(chain_f + 1) * 68 + step_b) * 64 + d] = __expf(totb); }
    __syncthreads();
    f32x4 acc[2][4];
#pragma unroll
    for (int dr = 0; dr < 2; ++dr)
#pragma unroll
        for (int dt = 0; dt < 4; ++dt) acc[dr][dt] = (f32x4){0.f, 0.f, 0.f, 0.f};
#pragma unroll
    for (int ks = 0; ks < 2; ++ks) { const bf16x8 a = *(const LAS bf16x8*)(lds + GL_VT + ((wave * 16 + fr) * GL_LD + ks * 32 + fq * 8) * 2);
#pragma unroll
        for (int dt = 0; dt < 4; ++dt) { const bf16x8 b0 = *(const LAS bf16x8*)(lds + GL_QF + ((dt * 16 + fr) * GL_LD + ks * 32 + fq * 8) * 2);
            const bf16x8 b1 = *(const LAS bf16x8*)(lds + GL_KF + ((dt * 16 + fr) * GL_LD + ks * 32 + fq * 8) * 2);
            acc[0][dt] = __builtin_amdgcn_mfma_f32_16x16x32_bf16(a, b0, acc[0][dt], 0, 0, 0); acc[1][dt] = __builtin_amdgcn_mfma_f32_16x16x32_bf16(a, b1, acc[1][dt], 0, 0, 0); } }
#pragma unroll
    for (int dr = 0; dr < 2; ++dr)
#pragma unroll
        for (int dt = 0; dt < 4; ++dt)
#pragma unroll
            for (int rg = 0; rg < 4; ++rg) *(LAS bf16_t*)(lds + GL_UST + ((dr * 128 + wave * 16 + 4 * fq + rg) * 64 + dt * 16 + fr) * 2) = f2bf(acc[dr][dt][rg]);
    __syncthreads();
#pragma unroll
    for (int i = 0; i < 4; ++i) { const int q = tid + i * NTHR, dr = q >> 10, off = (q & 1023) * 8;
        const u32x4 w = *(const LAS u32x4*)(lds + GL_UST + (dr * 8192 + off) * 2);
        const size_t chain = (size_t)chain_f + dr; const int step = dr ? step_b : step_f;
        *(u32x4*)(G.UCH + (chain * 68 + step) * 8192 + off) = w; }
    __syncthreads();
}

DEVI void gla_b_block(const GlaPtrs& G, LAS unsigned char* lds, int blk) {
    int tid = threadIdx.x; asm volatile("" : "+v"(tid));
    const int chain = blk >> 2, e = (blk & 3) * 32 + (tid >> 4), d4 = (tid & 15) * 4;
    for (int i = tid; i < 68 * 16; i += NTHR) ((LAS f32x4*)lds)[i] = ((const f32x4*)(G.ADEC + (size_t)chain * 68 * 64))[i];
    __syncthreads();
    const bf16_t* up = G.UCH + ((size_t)chain * 68 * 128 + e) * 64 + d4;
    bf16_t* sp = G.SST + ((size_t)chain * 64 * 128 + e) * 64 + d4;
    float S0 = 0.f, S1 = 0.f, S2 = 0.f, S3 = 0.f;
    uint2 cur[17], nxt[17];
#pragma unroll
    for (int j = 0; j < 17; ++j) cur[j] = *(const uint2*)(up + (size_t)j * 8192);
#pragma unroll 1
    for (int bt = 0; bt < 4; ++bt) {
        if (bt < 3) {
#pragma unroll
            for (int j = 0; j < 17; ++j) nxt[j] = *(const uint2*)(up + (size_t)((bt + 1) * 17 + j) * 8192); }
#pragma unroll
        for (int j = 0; j < 17; ++j) { const int step = bt * 17 + j;
            if (step >= 4) { uint2 o; o.x = pk2(S0, S1); o.y = pk2(S2, S3); *(uint2*)(sp + (size_t)(step - 4) * 8192) = o; }
            const f32x4 a = *(const LAS f32x4*)(lds + (step * 64 + d4) * 4);
            S0 = a[0] * S0 + __uint_as_float(cur[j].x << 16); S1 = a[1] * S1 + __uint_as_float(cur[j].x & 0xffff0000u);
            S2 = a[2] * S2 + __uint_as_float(cur[j].y << 16); S3 = a[3] * S3 + __uint_as_float(cur[j].y & 0xffff0000u); }
#pragma unroll
        for (int j = 0; j < 17; ++j) cur[j] = nxt[j];
    }
    __syncthreads();
}

DEVI void gla_c_item(const GlaPtrs& G, LAS unsigned char* lds, int item) {
    int tid = threadIdx.x; asm volatile("" : "+v"(tid));
    const int wave = __builtin_amdgcn_readfirstlane(tid >> 6), lane = tid & 63, d = lane, to = wave, fr = lane & 15, fq = lane >> 4;
    const int c = item & 63, bh = item >> 6, h = bh & 3, b = bh >> 2;
    const int row0 = b * SEQ + c * 64;
    gla_stage(G, lds, row0, h, tid);
    bf16_t qq[8], kk[8];
#pragma unroll
    for (int j = 0; j < 8; ++j) { const size_t o = (size_t)(row0 + to * 8 + j) * 512 + h * 64 + d; qq[j] = G.QK[o]; kk[j] = G.QK[o + 256]; }
    __syncthreads();
    float cf[8], cb[8];
    gla_gates(G, lds, h, d, to, cf, cb);
    __syncthreads();
    { const LAS float* TOT = (const LAS float*)(lds + GL_TOT);
      float offf = 0.f, offb = 0.f;
#pragma unroll
      for (int t = 0; t < 8; ++t) { if (t < to) offf += TOT[(0 * 8 + t) * 64 + d]; if (t > to) offb += TOT[(1 * 8 + t) * 64 + d]; }
#pragma unroll
      for (int j = 0; j < 8; ++j) { const float qf = bf2f(qq[j]) * 0.125f, kf = bf2f(kk[j]);
          const float ef = __expf(fmaxf(cf[j] + offf, -80.f)), eb = __expf(fmaxf(cb[j] + offb, -80.f));
          const int o = ((to * 8 + j) * GL_LD + d) * 2;
          *(LAS bf16_t*)(lds + GL_QF + o) = f2bf(qf * ef); *(LAS bf16_t*)(lds + GL_KF + o) = f2bf(kf * __builtin_amdgcn_rcpf(ef));
          *(LAS bf16_t*)(lds + GL_QB + o) = f2bf(qf * eb); *(LAS bf16_t*)(lds + GL_KB + o) = f2bf(kf * __builtin_amdgcn_rcpf(eb)); } }
    __syncthreads();
    { const int ti = wave >> 1;
#pragma unroll
      for (int u = 0; u < 2; ++u) { const int tj = (wave & 1) * 2 + u;
          f32x4 af = (f32x4){0.f, 0.f, 0.f, 0.f}, ab = (f32x4){0.f, 0.f, 0.f, 0.f};
          if (tj <= ti) {
#pragma unroll
              for (int ks = 0; ks < 2; ++ks) { const bf16x8 a = *(const LAS bf16x8*)(lds + GL_KF + ((tj * 16 + fr) * GL_LD + ks * 32 + fq * 8) * 2), bb = *(const LAS bf16x8*)(lds + GL_QF + ((ti * 16 + fr) * GL_LD + ks * 32 + fq * 8) * 2);
                  af = __builtin_amdgcn_mfma_f32_16x16x32_bf16(a, bb, af, 0, 0, 0); } }
          if (tj >= ti) {
#pragma unroll
              for (int ks = 0; ks < 2; ++ks) { const bf16x8 a = *(const LAS bf16x8*)(lds + GL_KB + ((tj * 16 + fr) * GL_LD + ks * 32 + fq * 8) * 2), bb = *(const LAS bf16x8*)(lds + GL_QB + ((ti * 16 + fr) * GL_LD + ks * 32 + fq * 8) * 2);
                  ab = __builtin_amdgcn_mfma_f32_16x16x32_bf16(a, bb, ab, 0, 0, 0); } }
          float p[4];
#pragma unroll
          for (int rg = 0; rg < 4; ++rg) { const int i = ti * 16 + fr, j = tj * 16 + 4 * fq + rg; p[rg] = (j <= i ? af[rg] : 0.f) + (j >= i ? ab[rg] : 0.f); }
          u32x2 w; w.x = pk2(p[0], p[1]); w.y = pk2(p[2], p[3]);
          *(LAS u32x2*)(lds + GL_PP + ((ti * 16 + fr) * GL_LD + tj * 16 + 4 * fq) * 2) = w; } }
    __syncthreads();
    const int tg = wave & 3, eh = wave >> 2;
    f32x4 acc[4];
#pragma unroll
    for (int et = 0; et < 4; ++et) acc[et] = (f32x4){0.f, 0.f, 0.f, 0.f};
    { const bf16_t* Sf = G.SST + ((size_t)(bh * 2) * 64 + c) * 8192; const bf16_t* Sb = G.SST + ((size_t)(bh * 2 + 1) * 64 + (63 - c)) * 8192;
#pragma unroll
      for (int ks = 0; ks < 2; ++ks) {
          const int bo = ((tg * 16 + fr) * GL_LD + ks * 32 + fq * 8) * 2;
          const bf16x8 bP = *(const LAS bf16x8*)(lds + GL_PP + bo), bF = *(const LAS bf16x8*)(lds + GL_QF + bo), bB = *(const LAS bf16x8*)(lds + GL_QB + bo);
#pragma unroll
          for (int et = 0; et < 4; ++et) { const int e = eh * 64 + et * 16 + fr;
              const bf16x8 aV = *(const LAS bf16x8*)(lds + GL_VT + (e * GL_LD + ks * 32 + fq * 8) * 2);
              const bf16x8 aF = *(const bf16x8*)(Sf + e * 64 + ks * 32 + fq * 8), aB = *(const bf16x8*)(Sb + e * 64 + ks * 32 + fq * 8);
              acc[et] = __builtin_amdgcn_mfma_f32_16x16x32_bf16(aV, bP, acc[et], 0, 0, 0);
              acc[et] = __builtin_amdgcn_mfma_f32_16x16x32_bf16(aF, bF, acc[et], 0, 0, 0);
              acc[et] = __builtin_amdgcn_mfma_f32_16x16x32_bf16(aB, bB, acc[et], 0, 0, 0); } } }
    float ss = 0.f;
#pragma unroll
    for (int et = 0; et < 4; ++et) ss += acc[et][0] * acc[et][0] + acc[et][1] * acc[et][1] + acc[et][2] * acc[et][2] + acc[et][3] * acc[et][3];
    ss += __shfl_xor(ss, 16); ss += __shfl_xor(ss, 32);
    LAS float* SSQ = (LAS float*)(lds + GL_SSQ);
    if (fq == 0) SSQ[eh * 64 + tg * 16 + fr] = ss;
    __syncthreads();
    const float rstd = rsqrtf((SSQ[tg * 16 + fr] + SSQ[64 + tg * 16 + fr]) * (1.f / 128.f) + 1e-6f);
    const int tok = row0 + tg * 16 + fr;
#pragma unroll
    for (int et = 0; et < 4; ++et) { const int e = eh * 64 + et * 16 + 4 * fq;
        const uint2 rv = *(const uint2*)(G.R + (size_t)tok * 512 + h * 128 + e); const f32x4 nw = *(const f32x4*)(G.nw + e);
        const float r0 = __uint_as_float(rv.x << 16), r1 = __uint_as_float(rv.x & 0xffff0000u), r2 = __uint_as_float(rv.y << 16), r3 = __uint_as_float(rv.y & 0xffff0000u);
        uint2 w; w.x = pk2(acc[et][0] * rstd * nw[0] * siluf_(r0), acc[et][1] * rstd * nw[1] * siluf_(r1)); w.y = pk2(acc[et][2] * rstd * nw[2] * siluf_(r2), acc[et][3] * rstd * nw[3] * siluf_(r3));
        *(uint2*)(G.MIX + (size_t)tok * DM + h * 128 + e) = w; }
    __syncthreads();
}

DEVI void s5w_build(const MArgs_in& in, unsigned char* ws, LAS unsigned char* lds, int g) {
    LAS float* LP = (LAS float*)lds;
    LAS float* BB = LP + 2 * 17 * 64 * 2;
    LAS float* CC = BB + 2 * 64 * 16 * 2;
    LAS float* KK = CC + 2 * 16 * 64 * 2;
    LAS float* CO = KK + 2 * 16 * 256;
    const int tid = threadIdx.x;
    S5P* P = (S5P*)(ws + OFF_S5P);
    for (int t = tid; t < 2 * 64 * 17; t += NTHR) { const int n = t % 17, p = (t / 17) & 63, d = t / (17 * 64); const int i = (d * 32 + g) * 64 + p;
        const double dt = exp((double)in.log_dt[d * 32 + g]), lr = in.lam_re[i], li = in.lam_im[i];
        const double mag = exp(n * lr * dt), ar = mag * cos(n * li * dt), ai = mag * sin(n * li * dt);
        LP[((d * 17 + n) * 64 + p) * 2] = (float)ar; LP[((d * 17 + n) * 64 + p) * 2 + 1] = (float)ai;
        if (n == 1) { const double nr = ar - 1.0, ni = ai, den = lr * lr + li * li; CO[(d * 64 + p) * 2] = (float)((nr * lr + ni * li) / den); CO[(d * 64 + p) * 2 + 1] = (float)((ni * lr - nr * li) / den); }
        if (n == 16) { P->lam16[d][g][p][0] = (float)ar; P->lam16[d][g][p][1] = (float)ai; } }
    for (int t = tid; t < 2 * 16 * 64; t += NTHR) { const int p = t & 63, h = (t >> 6) & 15, d = t >> 10; const size_t ix = (((size_t)d * 32 + g) * 16 + h) * 64 + p;
        CC[((d * 16 + h) * 64 + p) * 2] = in.c_re[ix]; CC[((d * 16 + h) * 64 + p) * 2 + 1] = in.c_im[ix]; }
    __syncthreads();
    for (int t = tid; t < 2 * 64 * 16; t += NTHR) { const int h = t & 15, p = (t >> 4) & 63, d = t >> 10; const size_t ix = (((size_t)d * 32 + g) * 64 + p) * 16 + h;
        const float br = in.b_re[ix], bi = in.b_im[ix], cr = CO[(d * 64 + p) * 2], ci = CO[(d * 64 + p) * 2 + 1];
        BB[((d * 64 + p) * 16 + h) * 2] = cr * br - ci * bi; BB[((d * 64 + p) * 16 + h) * 2 + 1] = cr * bi + ci * br; }
    __syncthreads();
    for (int t = tid; t < 2 * 16 * 256; t += NTHR) { const int hp = t & 15, h = (t >> 4) & 15, n = (t >> 8) & 15, d = t >> 12; float acc = 0.f;
        for (int p = 0; p < 64; ++p) { const float cr = CC[((d * 16 + h) * 64 + p) * 2], ci = CC[((d * 16 + h) * 64 + p) * 2 + 1], lr = LP[((d * 17 + n) * 64 + p) * 2], li = LP[((d * 17 + n) * 64 + p) * 2 + 1];
            const float tr = cr * lr - ci * li, ti = cr * li + ci * lr; acc += tr * BB[((d * 64 + p) * 16 + hp) * 2] - ti * BB[((d * 64 + p) * 16 + hp) * 2 + 1]; }
        KK[(d * 16 + n) * 256 + h * 16 + hp] = acc; }
    __syncthreads();
    bf16_t* BF = (bf16_t*)(ws + OFF_S5BF) + (size_t)g * 256 * 256;
    for (int t = tid; t < 256 * 32; t += NTHR) { const int k8 = t & 31, row = t >> 5, p = row & 63, im = (row >> 6) & 1, d = row >> 7; float o[8];
#pragma unroll
        for (int q = 0; q < 8; ++q) { const int k = k8 * 8 + q, j = k >> 4, hp = k & 15, pw = d ? j : 15 - j;
            const float lr = LP[((d * 17 + pw) * 64 + p) * 2], li = LP[((d * 17 + pw) * 64 + p) * 2 + 1], br = BB[((d * 64 + p) * 16 + hp) * 2], bi = BB[((d * 64 + p) * 16 + hp) * 2 + 1];
            o[q] = im ? lr * bi + li * br : lr * br - li * bi; }
        uint4 w; w.x = pk2(o[0], o[1]); w.y = pk2(o[2], o[3]); w.z = pk2(o[4], o[5]); w.w = pk2(o[6], o[7]);
        *(uint4*)(BF + (size_t)row * 256 + k8 * 8) = w; }
    bf16_t* BY = (bf16_t*)(ws + OFF_S5BY) + (size_t)g * 256 * 512;
    for (int t = tid; t < 256 * 64; t += NTHR) { const int k8 = t & 63, n = t >> 6, i = n >> 4, h = n & 15; float o[8];
#pragma unroll
        for (int q = 0; q < 8; ++q) { const int k = k8 * 8 + q; float v;
            if (k < 256) { const int j = k >> 4, hp = k & 15; v = 0.f; if (i >= j) v += KK[(0 * 16 + (i - j)) * 256 + h * 16 + hp]; if (j >= i) v += KK[(1 * 16 + (j - i)) * 256 + h * 16 + hp]; }
            else { const int d = (k - 256) >> 7, r = (k - 256) & 127, p = r & 63, im = r >> 6, pw = d ? 16 - i : i + 1;
                const float cr = CC[((d * 16 + h) * 64 + p) * 2], ci = CC[((d * 16 + h) * 64 + p) * 2 + 1], lr = LP[((d * 17 + pw) * 64 + p) * 2], li = LP[((d * 17 + pw) * 64 + p) * 2 + 1];
                v = im ? -(cr * li + ci * lr) : cr * lr - ci * li; }
            o[q] = v; }
        uint4 w; w.x = pk2(o[0], o[1]); w.y = pk2(o[2], o[3]); w.z = pk2(o[4], o[5]); w.w = pk2(o[6], o[7]);
        *(uint4*)(BY + (size_t)n * 512 + k8 * 8) = w; }
    __syncthreads();
}
struct ProbS5F {
    static constexpr bool HOIST = false;
    const bf16_t* A; const bf16_t* B; int K; float* F;
    DEVI int nunits() const { return 32 * 9; }
    DEVI void unit(int L, int& z, int& pm, int& pn) const { z = L & 31; pm = L >> 5; pn = 0; }
    DEVI int M(int) const { return 2304; }
    DEVI unsigned aoffb(int z, int r) const { return (unsigned)(z * 2304 + r) * 1024u; }
    DEVI const bf16_t* Bt(int z) const { return B + (size_t)z * 256 * 256; }
    DEVI void store(int z, int r, int c0, const float (&v)[8]) const { float* p = F + ((size_t)z * 2304 + r) * 256 + c0; *(float4*)p = make_float4(v[0], v[1], v[2], v[3]); *(float4*)(p + 4) = make_float4(v[4], v[5], v[6], v[7]); }
};
struct ProbS5Y {
    static constexpr bool HOIST = false;
    const bf16_t* A; const bf16_t* B; int K; const float* dvec; bf16_t* YS;
    DEVI int nunits() const { return 32 * 8; }
    DEVI void unit(int L, int& z, int& pm, int& pn) const { z = L & 31; pm = L >> 5; pn = 0; }
    DEVI int M(int) const { return 2048; }
    DEVI unsigned aoffb(int z, int r) const { return (unsigned)(z * 2304 + r) * 1024u; }
    DEVI const bf16_t* Bt(int z) const { return B + (size_t)z * 256 * 512; }
    DEVI void store(int z, int r, int c0, const float (&v)[8]) const {
        const int b = r >> 8, sq = ((r & 255) << 4) + (c0 >> 4), gc = sq >> 6, gr = sq & 63, tok = b * SEQ + gr * 64 + gc, ch = z * 16 + (c0 & 15);
        const uint4 uv = *(const uint4*)(A + ((size_t)z * 2304 + r) * 512 + c0); const unsigned uw[4] = {uv.x, uv.y, uv.z, uv.w};
        const float4 d0 = *(const float4*)(dvec + ch), d1 = *(const float4*)(dvec + ch + 4); const float dd[8] = {d0.x, d0.y, d0.z, d0.w, d1.x, d1.y, d1.z, d1.w}; float o[8];
#pragma unroll
        for (int j = 0; j < 4; ++j) { o[2 * j] = gelu_tanh(v[2 * j] + dd[2 * j] * __uint_as_float(uw[j] << 16)); o[2 * j + 1] = gelu_tanh(v[2 * j + 1] + dd[2 * j + 1] * __uint_as_float(uw[j] & 0xffff0000u)); }
        uint4 w; w.x = pk2(o[0], o[1]); w.y = pk2(o[2], o[3]); w.z = pk2(o[4], o[5]); w.w = pk2(o[6], o[7]);
        *(uint4*)(YS + (size_t)tok * 512 + ch) = w;
    }
};
DEVI void s5_carry(const float* __restrict__ F, bf16_t* __restrict__ U2, const S5P* __restrict__ P, int id, int lane) {
    const int g = id & 31, dir = (id >> 5) & 1, b = id >> 6;
    const float l16r = P->lam16[dir][g][lane][0], l16i = P->lam16[dir][g][lane][1];
    const float* Fg = F + (size_t)g * 2304 * 256 + dir * 128 + lane;
    bf16_t* Ug = U2 + (size_t)g * 2304 * 512 + 256 + dir * 128 + lane;
    float hr = 0.f, hi = 0.f;
    float fr[16], fi[16], nr[16], ni[16];
#define S5_ROW(bt, j) ((bt) == 0 ? 2048 + b * 16 + (dir ? 15 - (j) : (j)) : b * 256 + (dir ? 255 - (((bt) - 1) * 16 + (j)) : ((bt) - 1) * 16 + (j)))
#pragma unroll
    for (int j = 0; j < 16; ++j) { const int row = S5_ROW(0, j); fr[j] = Fg[(size_t)row * 256]; fi[j] = Fg[(size_t)row * 256 + 64]; }
    for (int bt = 0; bt < 17; ++bt) {
        if (bt < 16) {
#pragma unroll
            for (int j = 0; j < 16; ++j) { const int row = S5_ROW(bt + 1, j); nr[j] = Fg[(size_t)row * 256]; ni[j] = Fg[(size_t)row * 256 + 64]; } }
#pragma unroll
        for (int j = 0; j < 16; ++j) {
            if (bt > 0) { const int row = S5_ROW(bt, j); Ug[(size_t)row * 512] = f2bf(hr); Ug[(size_t)row * 512 + 64] = f2bf(hi); }
            const float tr = l16r * hr - l16i * hi + fr[j], ti = l16r * hi + l16i * hr + fi[j]; hr = tr; hi = ti; }
#pragma unroll
        for (int j = 0; j < 16; ++j) { fr[j] = nr[j]; fi[j] = ni[j]; }
    }
#undef S5_ROW
}


constexpr int NPH = 12;

struct WItem { const float* src; bf16_t* dst; int K, N, mode, n0, k0; bool act; };
DEVI WItem wconv_decode(const MArgs& a, unsigned char* ws, int it) {
    constexpr int I0 = 36 * 16, I1 = I0 + 8 * 8, I2 = I1 + 16 * 16, I3 = I2 + 32 * 32 * 16, I4 = I3 + 32 * 16 * 16;
    WItem w; w.src = nullptr; w.dst = nullptr; w.K = 0; w.N = 0; w.mode = 0; w.n0 = 0; w.k0 = 0; w.act = it < I4;
    if (w.act) {
        if (it < I0) { w.src = a.in[7]; w.dst = (bf16_t*)(ws + OFF_WIN); w.K = DM; w.N = INC; w.n0 = (it % 36) * 64; w.k0 = (it / 36) * 64; }
        else if (it < I1) { const int r = it - I0; w.src = a.in[19]; w.dst = (bf16_t*)(ws + OFF_WGLU); w.K = 512; w.N = 512; w.n0 = (r % 8) * 64; w.k0 = (r / 8) * 64; }
        else if (it < I2) { const int r = it - I1; w.src = a.in[21]; w.dst = (bf16_t*)(ws + OFF_WOUT); w.K = DM; w.N = DM; w.n0 = (r % 16) * 64; w.k0 = (r / 16) * 64; }
        else if (it < I3) { const int r = it - I2, e = r / 512, q = r % 512; w.src = a.in[25] + (size_t)e * DM * 2048; w.dst = (bf16_t*)(ws + OFF_WG) + (size_t)e * 2048 * DM; w.K = DM; w.N = 2048; w.mode = 1; w.n0 = (q % 32) * 64; w.k0 = (q / 32) * 64; }
        else { const int r = it - I3, e = r / 256, q = r % 256; w.src = a.in[27] + (size_t)e * DFF * DM; w.dst = (bf16_t*)(ws + OFF_WD) + (size_t)e * DM * DFF; w.K = DFF; w.N = DM; w.n0 = (q % 16) * 64; w.k0 = (q / 16) * 64; }
    }
    return w;
}
DEVI void wconv_load(const WItem& w, int ht, f32x4 (&r)[4]) {
    const int l16 = ht & 15, kr = ht >> 4;
    int col; if (w.mode) col = (l16 < 8 ? 0 : 1024) + 4 * (w.n0 >> 3) + 4 * (l16 & 7); else col = w.n0 + 4 * l16;
    const bool ok = w.act && col < w.N;
#pragma unroll
    for (int i = 0; i < 4; ++i) r[i] = ok ? *(const f32x4*)(w.src + (size_t)(w.k0 + kr + 16 * i) * w.N + col) : (f32x4){0.f, 0.f, 0.f, 0.f};
}
DEVI void ph_prep(const MArgs& a, LAS unsigned char* lds, int bid, int G) {
    const int tid = threadIdx.x, wave = tid >> 6, lane = tid & 63;
    unsigned char* ws = a.ws;
    if (bid < 96) {
        LAS float* s = (LAS float*)lds; LAS float* part = (LAS float*)(lds + 36864);
        const float* c = a.in[1]; const float* cc = a.in[3]; const float* ada_w = a.in[4]; const float* ada_b = a.in[5]; float* mod = (float*)(ws + OFF_MOD);
        for (int i = tid; i < 9216; i += NTHR) { const int r = i >> 10, k = i & 1023; const float v = r < 8 ? c[r * 1024 + k] : cc[k]; s[i] = siluf_(v); }
        __syncthreads();
        const int j = bid * 64 + lane; float acc[9];
#pragma unroll
        for (int r = 0; r < 9; ++r) acc[r] = 0.f;
#pragma unroll 4
        for (int k = wave * 128; k < wave * 128 + 128; ++k) { const float w = ada_w[(size_t)k * 6144 + j];
#pragma unroll
            for (int r = 0; r < 9; ++r) acc[r] += s[r * 1024 + k] * w; }
#pragma unroll
        for (int r = 0; r < 9; ++r) part[(wave * 9 + r) * 64 + lane] = acc[r];
        __syncthreads();
        for (int i = tid; i < 576; i += NTHR) { const int r = i >> 6, l = i & 63; float sum = 0.f;
#pragma unroll
            for (int w = 0; w < 8; ++w) sum += part[(w * 9 + r) * 64 + l];
            mod[r * 6144 + bid * 64 + l] = sum + ada_b[bid * 64 + l]; }
        __syncthreads();
    } else if (bid < 104) {
        s5prep_one(a.in[11], a.in[12], a.in[13], a.in[14], a.in[15], (S5P*)(ws + OFF_S5P), (bid - 96) * NTHR + tid);
    }
    else if (bid < 136) { MArgs_in in{a.in[11], a.in[12], a.in[13], a.in[14], a.in[15], a.in[16], a.in[17]}; s5w_build(in, ws, lds, bid - 104); }
    { constexpr int I4 = 36 * 16 + 8 * 8 + 16 * 16 + 32 * 32 * 16 + 32 * 16 * 16;
      const int half = tid >> 8, ht = tid & 255; LAS float* t = (LAS float*)(lds + half * 17408);
      const int l16 = ht & 15, kr = ht >> 4;
      const bool worker = (G <= 136) || bid < 104 || bid >= 136;
      const int wid_ = (G <= 136) ? bid : (bid < 104 ? bid : bid - 32), GW = (G <= 136) ? G : G - 32;
      WItem cur = wconv_decode(a, ws, worker ? wid_ * 2 + half : I4); f32x4 rc[4]; wconv_load(cur, ht, rc);
      for (int base = worker ? wid_ * 2 : I4; base < I4; base += 2 * GW) {
          const WItem nxt = wconv_decode(a, ws, base + 2 * GW + half); f32x4 rn[4]; wconv_load(nxt, ht, rn);
          if (cur.act) { const int rb = cur.mode ? (l16 & 7) * 8 + (l16 >> 3) * 4 : 4 * l16;
#pragma unroll
              for (int i = 0; i < 4; ++i) { LAS float* q = t + (kr + 16 * i) * 65 + rb; q[0] = rc[i][0]; q[1] = rc[i][1]; q[2] = rc[i][2]; q[3] = rc[i][3]; } }
          __syncthreads();
          if (cur.act) {
#pragma unroll
              for (int i = 0; i < 2; ++i) { const int ch = ht + 256 * i, n = ch >> 3, c8 = ch & 7; const LAS float* q = t + (c8 * 8) * 65 + n;
                  uint4 o; o.x = pk2(q[0], q[65]); o.y = pk2(q[2 * 65], q[3 * 65]); o.z = pk2(q[4 * 65], q[5 * 65]); o.w = pk2(q[6 * 65], q[7 * 65]);
                  *(uint4*)(cur.dst + (size_t)(cur.n0 + n) * cur.K + cur.k0 + c8 * 8) = o; } }
          __syncthreads();
          cur = nxt;
#pragma unroll
          for (int i = 0; i < 4; ++i) rc[i] = rn[i];
      } }
}


DEVI void ph_router(const float* __restrict__ X1, const float* __restrict__ w, const float* __restrict__ mod, const float* __restrict__ rw, const float* __restrict__ rb,
                    bf16_t* __restrict__ H2, int* __restrict__ cnt, int* __restrict__ list, float* __restrict__ gate, LAS unsigned char* lds, int bid, int G) {
    int tid = threadIdx.x; asm volatile("" : "+v"(tid));
    const int wave = __builtin_amdgcn_readfirstlane(tid >> 6), lane = tid & 63, e = tid & 31, ks = tid >> 5;
    LAS float* hrow = (LAS float*)lds;
    LAS float* part = (LAS float*)(lds + 32768);
    float wreg[64];
#pragma unroll
    for (int i = 0; i < 64; ++i) wreg[i] = rw[(ks * 64 + i) * 32 + e];
    const float rbe = rb[e];
    const int per = (NTOK + G - 1) / G;
    const int t0 = bid * per, t1 = (t0 + per) < NTOK ? (t0 + per) : NTOK;
    float4 v[4];
    { const int tok = t0 + wave; if (tok < t1) {
#pragma unroll
        for (int j = 0; j < 4; ++j) v[j] = *(const float4*)(X1 + (size_t)tok * DM + lane * 4 + 256 * j); } }
    for (int tb = t0; tb < t1; tb += 8) {
        const int tok = tb + wave;
        if (tok < t1) {
            const int b = tok / SEQ; float ss = 0.f;
#pragma unroll
            for (int j = 0; j < 4; ++j) ss += v[j].x * v[j].x + v[j].y * v[j].y + v[j].z * v[j].z + v[j].w * v[j].w;
            const float rstd = rsqrtf(wave_sum(ss) * (1.f / DM) + 1e-6f);
            const float* msh = mod + b * 6144 + 3072; const float* msc = mod + b * 6144 + 4096;
#pragma unroll
            for (int j = 0; j < 4; ++j) { const int k = lane * 4 + 256 * j;
                const float4 ww = *(const float4*)(w + k), sc = *(const float4*)(msc + k), sh = *(const float4*)(msh + k);
                f32x4 hv; hv[0] = v[j].x * rstd * ww.x * (1.f + sc.x) + sh.x; hv[1] = v[j].y * rstd * ww.y * (1.f + sc.y) + sh.y; hv[2] = v[j].z * rstd * ww.z * (1.f + sc.z) + sh.z; hv[3] = v[j].w * rstd * ww.w * (1.f + sc.w) + sh.w;
                *(LAS f32x4*)(hrow + wave * 1024 + k) = hv;
                uint2 o; o.x = pk2(hv[0], hv[1]); o.y = pk2(hv[2], hv[3]); *(uint2*)(H2 + (size_t)tok * DM + k) = o; }
        }
        { const int ntok = tb + 8 + wave; if (ntok < t1) {
#pragma unroll
            for (int j = 0; j < 4; ++j) v[j] = *(const float4*)(X1 + (size_t)ntok * DM + lane * 4 + 256 * j); } }
        __syncthreads();
        float acc[8];
#pragma unroll
        for (int t = 0; t < 8; ++t) acc[t] = 0.f;
#pragma unroll
        for (int i4 = 0; i4 < 16; ++i4) {
#pragma unroll
            for (int t = 0; t < 8; ++t) { const f32x4 hx = *(const LAS f32x4*)(hrow + t * 1024 + ks * 64 + i4 * 4);
                acc[t] += hx[0] * wreg[4 * i4] + hx[1] * wreg[4 * i4 + 1] + hx[2] * wreg[4 * i4 + 2] + hx[3] * wreg[4 * i4 + 3]; } }
#pragma unroll
        for (int t = 0; t < 8; ++t) part[(ks * 8 + t) * 32 + e] = acc[t];
        __syncthreads();
        if (wave < 4) {
            const int t = wave * 2 + (lane >> 5), tk = tb + t;
            float lg = rbe;
#pragma unroll
            for (int q = 0; q < 16; ++q) lg += part[(q * 8 + t) * 32 + e];
            float val = lg; float tv[4]; int ti[4];
#pragma unroll
            for (int r = 0; r < 4; ++r) { float bv = val; int bi = e;
#pragma unroll
                for (int o = 1; o < 32; o <<= 1) { const float ov = __shfl_xor(bv, o); const int oi = __shfl_xor(bi, o); if (ov > bv || (ov == bv && oi < bi)) { bv = ov; bi = oi; } }
                tv[r] = bv; ti[r] = bi; if (e == bi) val = -3.0e38f; }
            const float e1 = __expf(tv[1] - tv[0]), e2 = __expf(tv[2] - tv[0]), e3 = __expf(tv[3] - tv[0]), inv = 1.f / (1.f + e1 + e2 + e3);
            if (e < 4 && tk < t1) { const float gv = e == 0 ? inv : e == 1 ? e1 * inv : e == 2 ? e2 * inv : e3 * inv; const int ex = e == 0 ? ti[0] : e == 1 ? ti[1] : e == 2 ? ti[2] : ti[3];
                const int slot = atomicAdd(&cnt[ex], 1); list[ex * LISTCAP + slot] = tk * 4 + e; gate[tk * 4 + e] = gv; }
        }
    }
    __syncthreads();
}

DEVI void build_ub(const int* cnt, volatile LAS int* ub) {
    if (threadIdx.x == 0) { int o = 0; for (int e = 0; e < NEXP; ++e) { ub[e] = o; o += (cnt[e] + 255) >> 8; } ub[NEXP] = o; }
    __syncthreads();
}

__global__ void __launch_bounds__(NTHR, 2) mega(MArgs a) {
    extern __shared__ __attribute__((aligned(16))) unsigned char lds_raw[];
    LAS unsigned char* lds = (LAS unsigned char*)lds_raw;
    volatile LAS unsigned* MISC = (volatile LAS unsigned*)(lds + MISC_OFF);
    const int tid = threadIdx.x, wave = __builtin_amdgcn_readfirstlane(tid >> 6), G = gridDim.x, bid = blockIdx.x;
    const int gw = bid * NWAVES + wave, NGW = G * NWAVES;
    for (int u = tid; u < MISC_BYTES / 4; u += NTHR) MISC[u] = 0u;
    __syncthreads();
    unsigned char* ws = a.ws; unsigned* ctl = (unsigned*)(ws + OFF_CTL);
    const bool multi = (a.ph_hi - a.ph_lo) > 1;
    XcdBarrier bar; bar.bar = ctl + CW_BAR; bar.x = 0; bar.st = MISC;
    if (multi) bar = xcd_barrier_post(ctl + CW_BAR, MISC);
    volatile LAS int* ub = (volatile LAS int*)(MISC + 16);
#ifndef PROBE_REP
#define PROBE_REP 0
#endif
#define IN(k) (a.ph_lo <= (k) && (k) < a.ph_hi)
#define NREP(k) (1 + ((PROBE_REP >> (k)) & 1))
#define FRESH_LANE int ft_ = threadIdx.x; asm volatile("" : "+v"(ft_)); const int lane = ft_ & 63; (void)lane
#define SEAM(k) do { if (IN(k) && IN((k) + 1)) xcd_barrier(bar); } while (0)
    float* mod = (float*)(ws + OFF_MOD); S5P* s5p = (S5P*)(ws + OFF_S5P); float* gate = (float*)(ws + OFF_GATE); int* list = (int*)(ws + OFF_LIST);
    bf16_t* WIN = (bf16_t*)(ws + OFF_WIN); bf16_t* WGLU = (bf16_t*)(ws + OFF_WGLU); bf16_t* WOUT = (bf16_t*)(ws + OFF_WOUT); bf16_t* WG = (bf16_t*)(ws + OFF_WG); bf16_t* WD = (bf16_t*)(ws + OFF_WD);
    bf16_t* H = (bf16_t*)(ws + OFF_H); bf16_t* QK = (bf16_t*)(ws + OFF_QK); bf16_t* V = (bf16_t*)(ws + OFF_V); bf16_t* R = (bf16_t*)(ws + OFF_R); bf16_t* UT = (bf16_t*)(ws + OFF_UT);
    float* LR = (float*)(ws + OFF_LR); bf16_t* U2 = (bf16_t*)(ws + OFF_U2);
    bf16_t* YS = (bf16_t*)(ws + OFF_YS); bf16_t* MIX = (bf16_t*)(ws + OFF_MIX); bf16_t* ACT = (bf16_t*)(ws + OFF_ACT); bf16_t* YSL = (bf16_t*)(ws + OFF_YSL);
    int* cnt = (int*)(ctl + CW_CNT);

    if (IN(0)) for (int rp = 0; rp < NREP(0); ++rp) ph_prep(a, lds, bid, G);
    SEAM(0);
    if (IN(1)) for (int rp = 0; rp < NREP(1); ++rp) { FRESH_LANE; for (int row = gw; row < NROWS; row += NGW) norm_row(a.in[0], a.in[2], a.in[6], mod, H, row, lane, 0, 1024); }
    SEAM(1);
    if (IN(2)) for (int rp = 0; rp < NREP(2); ++rp) { ProbIn P{H, DM, WIN, DM, DM, QK, V, R, UT, U2, LR}; gemm_phase(lds, P, G, bid); }
    SEAM(2);
    float* Fb = (float*)(ws + OFF_F); bf16_t* S5BF = (bf16_t*)(ws + OFF_S5BF); bf16_t* S5BY = (bf16_t*)(ws + OFF_S5BY);
    const GlaPtrs GP{QK, V, R, LR, a.in[8], a.in[9], a.in[10], (bf16_t*)(ws + OFF_UCH), (float*)(ws + OFF_ADEC), (bf16_t*)(ws + OFF_SST), MIX};
    if (IN(3)) for (int rp = 0; rp < NREP(3); ++rp) {
        { ProbS5F P{U2, S5BF, 256, Fb}; gemm_phase(lds, P, G, bid); }
        for (int it = bid; it < NB * 4 * 68; it += G) gla_a_item(GP, lds, it);
    }
    SEAM(3);
    if (IN(4)) for (int rp = 0; rp < NREP(4); ++rp) {
        for (int blk = bid; blk < 256; blk += G) gla_b_block(GP, lds, blk);
        { FRESH_LANE; if (gw < NB * 32 * 2) s5_carry(Fb, U2, s5p, gw, lane); }
    }
    SEAM(4);
    if (IN(5)) for (int rp = 0; rp < NREP(5); ++rp) {
        { ProbS5Y P{U2, S5BY, 512, a.in[18], YS}; gemm_phase(lds, P, G, bid); }
        for (int it = bid; it < NB * 4 * 64; it += G) gla_c_item(GP, lds, it);
    }
    SEAM(5);
    if (IN(6)) for (int rp = 0; rp < NREP(6); ++rp) { ProbGlu P{YS, 512, WGLU, 512, 512, a.in[20], MIX}; gemm_phase(lds, P, G, bid); }
    SEAM(6);
    if (IN(7)) for (int rp = 0; rp < NREP(7); ++rp) { ProbOut P{MIX, DM, WOUT, DM, DM, a.in[0], mod, a.out}; gemm_phase(lds, P, G, bid); }
    SEAM(7);
    if (IN(8)) ph_router(a.out, a.in[22], mod, a.in[23], a.in[24], H, cnt, list, gate, lds, bid, G);
    SEAM(8);
    if (IN(9)) for (int rp = 0; rp < NREP(9); ++rp) { build_ub(cnt, ub); FMoe1 P{H, WG, DM, cnt, list, a.in[26], ACT, (const LAS int*)ub, G}; gemm_phase(lds, P, G, bid); }
    SEAM(9);
    if (IN(10)) for (int rp = 0; rp < NREP(10); ++rp) { build_ub(cnt, ub); FMoe2 P{ACT, WD, DFF, cnt, list, a.in[28], gate, YSL, (const LAS int*)ub, G}; gemm_phase(lds, P, G, bid); }
    SEAM(10);
    if (IN(11)) { FRESH_LANE; for (int tok = gw; tok < NTOK; tok += NGW) final_row(a.out, YSL, mod, a.in[29], tok, lane); }
#undef IN
#undef SEAM
}

#ifndef MEGA_SINGLE
#define MEGA_SINGLE 1
#endif
extern "C" void kernel_launch(void* const* d_in, const int* in_sizes, int n_in, void* d_out, int out_size, void* d_ws, size_t ws_size, hipStream_t stream) {
    static int grid = 0;
    if (grid == 0) {
        if (ws_size < WS_NEED || n_in != 30) { fprintf(stderr, "kernel_launch: workspace too small (%zu < %zu) or n_in %d != 30\n", ws_size, (size_t)WS_NEED, n_in); grid = -1; return; }
        int dev = 0, cus = 0, per_cu = 0;
        if (hipGetDevice(&dev) != hipSuccess || hipDeviceGetAttribute(&cus, hipDeviceAttributeMultiprocessorCount, dev) != hipSuccess) { grid = -1; return; }
        if (hipFuncSetAttribute((const void*)mega, hipFuncAttributeMaxDynamicSharedMemorySize, LDS_BYTES) != hipSuccess) { fprintf(stderr, "kernel_launch: hipFuncSetAttribute failed\n"); grid = -1; return; }
        if (hipOccupancyMaxActiveBlocksPerMultiprocessor(&per_cu, (const void*)mega, NTHR, LDS_BYTES) != hipSuccess || per_cu < 1) { fprintf(stderr, "kernel_launch: occupancy query says %d blocks per CU\n", per_cu); per_cu = 1; }
        (void)hipGetLastError();
        grid = cus;
    }
    if (grid < 0) return;
    (void)hipMemsetAsync((char*)d_ws + OFF_CTL, 0, 64 * 1024, stream);
    MArgs a{};
    for (int i = 0; i < 30; ++i) a.in[i] = (const float*)d_in[i];
    a.out = (float*)d_out; a.ws = (unsigned char*)d_ws;
#if MEGA_SINGLE
    a.ph_lo = 0; a.ph_hi = NPH;
    { void* args[] = {&a}; hipError_t e = hipLaunchCooperativeKernel((const void*)mega, dim3(grid), dim3(NTHR), args, LDS_BYTES, stream);
      if (e != hipSuccess) fprintf(stderr, "kernel_launch: cooperative launch failed: %s (grid %d)\n", hipGetErrorString(e), grid); }
#else
    for (int p = 0; p < NPH; ++p) { a.ph_lo = p; a.ph_hi = p + 1; hipLaunchKernelGGL(mega, dim3(grid), dim3(NTHR), LDS_BYTES, stream, a); }
#endif
}
```

```cpp
#include <hip/hip_runtime.h>
#include <stdint.h>
#include <stdio.h>

typedef unsigned short bf16_t;
#define DEVI __device__ __forceinline__
#define LAS __attribute__((address_space(3)))

constexpr int NB = 8, SEQ = 4096, DM = 1024, CTX = 256;
constexpr int NTOK = NB * SEQ;
constexpr int NCTX = NB * CTX;
constexpr int NROWS = NTOK + NCTX;
constexpr int INC = 2080, INP = 2304;
constexpr int NEXP = 32, TOPK = 4, DFF = 1024;
constexpr int LISTCAP = NTOK;
constexpr int MOEPAD = 256;

constexpr size_t MiB = 1024ull * 1024ull;
constexpr size_t OFF_CTL = 0;
constexpr size_t OFF_MOD = 64 * 1024;
constexpr size_t OFF_S5P = OFF_MOD + 256 * 1024;
constexpr size_t OFF_GATE = OFF_S5P + 1 * MiB;
constexpr size_t OFF_EPOS = OFF_GATE + 512 * 1024;
constexpr size_t OFF_LIST = OFF_EPOS + 512 * 1024;
constexpr size_t OFF_WIN = OFF_LIST + 4 * MiB;
constexpr size_t OFF_WGLU = OFF_WIN + (size_t)INP * DM * 2;
constexpr size_t OFF_WOUT = OFF_WGLU + 512 * 512 * 2;
constexpr size_t OFF_WG = OFF_WOUT + (size_t)DM * DM * 2;
constexpr size_t OFF_WD = OFF_WG + (size_t)NEXP * 2048 * DM * 2;
constexpr size_t OFF_S5BF = OFF_WD + (size_t)NEXP * DM * DFF * 2;
constexpr size_t OFF_S5BY = OFF_S5BF + (size_t)32 * 256 * 256 * 2;
constexpr size_t OFF_H = OFF_S5BY + (size_t)32 * 256 * 512 * 2;
constexpr size_t OFF_RA = OFF_H + (size_t)NROWS * DM * 2;
constexpr size_t OFF_QK = OFF_RA;
constexpr size_t OFF_V = OFF_QK + (size_t)NROWS * 512 * 2;
constexpr size_t OFF_R = OFF_V + (size_t)NROWS * 512 * 2;
constexpr size_t OFF_UT = OFF_R + (size_t)NROWS * 512 * 2;
constexpr size_t OFF_LR = OFF_UT + (size_t)NROWS * 512 * 2;
constexpr size_t OFF_U2 = OFF_LR + (size_t)NROWS * 32 * 4;
constexpr size_t OFF_YS = OFF_U2 + (size_t)32 * 2304 * 512 * 2;
constexpr size_t OFF_MIX = OFF_YS + (size_t)NTOK * 512 * 2;
constexpr size_t OFF_F = OFF_MIX + (size_t)NTOK * DM * 2;
constexpr size_t OFF_UCH = OFF_F + (size_t)32 * 2304 * 256 * 4;
constexpr size_t OFF_ADEC = OFF_UCH + (size_t)64 * 68 * 8192 * 2;
constexpr size_t OFF_SST = OFF_ADEC + (size_t)64 * 68 * 64 * 4;
constexpr size_t OFF_RA_END = OFF_SST + (size_t)64 * 64 * 8192 * 2;
constexpr int ACT_ROWS = NTOK * TOPK + NEXP * MOEPAD;
constexpr size_t OFF_ACT = OFF_RA;
constexpr size_t OFF_YSL = OFF_ACT + (size_t)ACT_ROWS * DFF * 2;
constexpr size_t OFF_END2 = OFF_YSL + (size_t)ACT_ROWS * DM * 2;
constexpr size_t WS_NEED = OFF_RA_END > OFF_END2 ? OFF_RA_END : OFF_END2;
static_assert(WS_NEED <= 1024 * MiB, "workspace map exceeds 1 GiB");

constexpr int CW_CNT = 1024;
constexpr int CW_OFFS = 1088;

DEVI float bf2f(bf16_t b) { return __uint_as_float(((unsigned)b) << 16); }
DEVI bf16_t f2bf(float f) { unsigned u = __float_as_uint(f); u += 0x7fffu + ((u >> 16) & 1u); return (bf16_t)(u >> 16); }
DEVI unsigned pk2(float lo, float hi) { unsigned r; asm("v_cvt_pk_bf16_f32 %0, %1, %2" : "=v"(r) : "v"(lo), "v"(hi)); return r; }
DEVI float wave_sum(float v) {
#pragma unroll
    for (int o = 1; o < 64; o <<= 1) v += __shfl_xor(v, o);
    return v;
}
DEVI float sigmoidf_(float x) { return 1.f / (1.f + __expf(-x)); }
DEVI float siluf_(float x) { return x / (1.f + __expf(-x)); }
DEVI float logsigmoidf_(float g) { return fminf(g, 0.f) - __logf(1.f + __expf(-fabsf(g))); }
DEVI float gelu_tanh(float x) { const float u = 0.7978845608028654f * (x + 0.044715f * x * x * x); return x / (1.f + __expf(-2.f * u)); }

__global__ __launch_bounds__(256) void k_mod(const float* __restrict__ c, const float* __restrict__ c_ctx, const float* __restrict__ ada_w,
                                             const float* __restrict__ ada_b, float* __restrict__ mod) {
    __shared__ float s[9][1024];
    for (int i = threadIdx.x; i < 9 * 1024; i += 256) { const int r = i >> 10, k = i & 1023; const float v = r < 8 ? c[r * 1024 + k] : c_ctx[k]; s[r][k] = siluf_(v); }
    __syncthreads();
    const int j = blockIdx.x * 256 + threadIdx.x;
    float acc[9];
#pragma unroll
    for (int r = 0; r < 9; ++r) acc[r] = 0.f;
    for (int k = 0; k < 1024; ++k) { const float w = ada_w[(size_t)k * 6144 + j];
#pragma unroll
        for (int r = 0; r < 9; ++r) acc[r] += s[r][k] * w; }
    const float bb = ada_b[j];
#pragma unroll
    for (int r = 0; r < 9; ++r) mod[r * 6144 + j] = acc[r] + bb;
}

template <int MODE> DEVI int wsrc_col(int nd) { if (MODE == 1) { return ((nd >> 7) & 1) * 1024 + (nd >> 8) * 128 + (nd & 127); } return nd; }
template <int MODE> __global__ __launch_bounds__(256) void k_wconv(const float* __restrict__ src, bf16_t* __restrict__ dst, int K, int N, int Nd) {
    __shared__ float t[64][65];
    const int e = blockIdx.z; src += (size_t)e * K * N; dst += (size_t)e * Nd * K;
    const int n0 = blockIdx.x * 64, k0 = blockIdx.y * 64, tid = threadIdx.x, nl = tid & 63, kq = tid >> 6;
    const int nd = n0 + nl, sc = wsrc_col<MODE>(nd); const bool valid = sc < N;
#pragma unroll 4
    for (int i = 0; i < 16; ++i) { const int kk = kq + 4 * i; t[kk][nl] = valid ? src[(size_t)(k0 + kk) * N + sc] : 0.f; }
    __syncthreads();
#pragma unroll
    for (int i = 0; i < 2; ++i) { const int ch = tid + 256 * i, n = ch >> 3, c8 = ch & 7;
        uint4 o; o.x = pk2(t[c8 * 8 + 0][n], t[c8 * 8 + 1][n]); o.y = pk2(t[c8 * 8 + 2][n], t[c8 * 8 + 3][n]); o.z = pk2(t[c8 * 8 + 4][n], t[c8 * 8 + 5][n]); o.w = pk2(t[c8 * 8 + 6][n], t[c8 * 8 + 7][n]);
        *(uint4*)(dst + (size_t)(n0 + n) * K + k0 + c8 * 8) = o; }
}

struct S5P { float lamb[2][32][64][2]; float bbar[2][32][64][16][2]; float lam16[2][32][64][2]; };
DEVI void s5prep_one(const float* lam_re, const float* lam_im, const float* log_dt, const float* b_re, const float* b_im, S5P* P, int i) {
    const int p = i & 63, g = (i >> 6) & 31, d = i >> 11;
    const double dt = exp((double)log_dt[d * 32 + g]);
    const double lr = lam_re[i], li = lam_im[i];
    const double mag = exp(lr * dt), ar = mag * cos(li * dt), ai = mag * sin(li * dt);
    const double nr = ar - 1.0, ni = ai, den = lr * lr + li * li;
    const double cr = (nr * lr + ni * li) / den, ci = (ni * lr - nr * li) / den;
    P->lamb[d][g][p][0] = (float)ar; P->lamb[d][g][p][1] = (float)ai;
    for (int h = 0; h < 16; ++h) { const double br = b_re[(size_t)i * 16 + h], bi = b_im[(size_t)i * 16 + h];
        P->bbar[d][g][p][h][0] = (float)(cr * br - ci * bi); P->bbar[d][g][p][h][1] = (float)(cr * bi + ci * br); }
}
__global__ void k_s5prep(const float* lam_re, const float* lam_im, const float* log_dt, const float* b_re, const float* b_im, S5P* P) {
    const int i = blockIdx.x * blockDim.x + threadIdx.x; if (i >= 2 * 32 * 64) return;
    s5prep_one(lam_re, lam_im, log_dt, b_re, b_im, P, i);
}

DEVI void norm_row(const float* __restrict__ x, const float* __restrict__ ctx, const float* __restrict__ w, const float* __restrict__ mod,
                                              bf16_t* __restrict__ H, int row, int lane, int sh_off, int sc_off) {
    const float* src; int b;
    if (row < NTOK) { src = x + (size_t)row * DM; b = row / SEQ; } else { src = ctx + (size_t)(row - NTOK) * DM; b = 8; }
    float4 v[4]; float ss = 0.f;
#pragma unroll
    for (int j = 0; j < 4; ++j) { v[j] = *(const float4*)(src + lane * 4 + 256 * j); ss += v[j].x * v[j].x + v[j].y * v[j].y + v[j].z * v[j].z + v[j].w * v[j].w; }
    const float rstd = rsqrtf(wave_sum(ss) * (1.f / DM) + 1e-6f);
    const float* msh = mod + b * 6144 + sh_off; const float* msc = mod + b * 6144 + sc_off;
#pragma unroll
    for (int j = 0; j < 4; ++j) { const int k = lane * 4 + 256 * j;
        const float4 ww = *(const float4*)(w + k), sc = *(const float4*)(msc + k), sh = *(const float4*)(msh + k);
        uint2 o; o.x = pk2(v[j].x * rstd * ww.x * (1.f + sc.x) + sh.x, v[j].y * rstd * ww.y * (1.f + sc.y) + sh.y);
        o.y = pk2(v[j].z * rstd * ww.z * (1.f + sc.z) + sh.z, v[j].w * rstd * ww.w * (1.f + sc.w) + sh.w);
        *(uint2*)(H + (size_t)row * DM + k) = o; }
}
__global__ __launch_bounds__(256) void k_norm(const float* __restrict__ x, const float* __restrict__ ctx, const float* __restrict__ w, const float* __restrict__ mod,
                                              bf16_t* __restrict__ H, int nrows, int sh_off, int sc_off) {
    const int row = blockIdx.x * 4 + (threadIdx.x >> 6), lane = threadIdx.x & 63; if (row >= nrows) return;
    norm_row(x, ctx, w, mod, H, row, lane, sh_off, sc_off);
}

DEVI void dense_unit(int L, int nM, int nN, int& pm, int& pn) {
    const int nwg = nM * nN; int wgid = L; { const int q = nwg / 8, r = nwg % 8, xcd = wgid % 8, off = wgid / 8; wgid = (xcd < r ? xcd * (q + 1) : r * (q + 1) + (xcd - r) * q) + off; }
    const int nig = 8 * nN, gid = wgid / nig, fm = gid * 8, gsz = (nM - fm) < 8 ? (nM - fm) : 8;
    pm = fm + ((wgid % nig) % gsz); pn = (wgid % nig) / gsz;
}
template <class Prob> __global__ __launch_bounds__(256) void k_gemm_naive(Prob P) {
    __shared__ float As[32][68], Bs[32][68];
    const int z = blockIdx.z, M = P.M(z), r0 = blockIdx.y * 64, c0 = blockIdx.x * 64; if (r0 >= M) return;
    const int tid = threadIdx.x, tx = tid & 7, ty = tid >> 3, K = P.K;
    const int lr = tid >> 2, lk = (tid & 3) * 8;
    const bool arow_ok = (r0 + lr) < M;
    const bf16_t* ap = P.A + (size_t)(arow_ok ? P.arow(z, r0 + lr) : 0) * P.lda + lk;
    const bf16_t* bp = P.Bt(z) + (size_t)(c0 + lr) * P.ldb + lk;
    float acc[2][8];
#pragma unroll
    for (int i = 0; i < 2; ++i)
#pragma unroll
        for (int j = 0; j < 8; ++j) acc[i][j] = 0.f;
    for (int k0 = 0; k0 < K; k0 += 32) {
        uint4 av = arow_ok ? *(const uint4*)(ap + k0) : make_uint4(0, 0, 0, 0); const uint4 bv = *(const uint4*)(bp + k0);
        const unsigned aw[4] = {av.x, av.y, av.z, av.w}, bw[4] = {bv.x, bv.y, bv.z, bv.w};
        __syncthreads();
#pragma unroll
        for (int j = 0; j < 4; ++j) { As[lk + 2 * j][lr] = __uint_as_float(aw[j] << 16); As[lk + 2 * j + 1][lr] = __uint_as_float(aw[j] & 0xffff0000u);
            Bs[lk + 2 * j][lr] = __uint_as_float(bw[j] << 16); Bs[lk + 2 * j + 1][lr] = __uint_as_float(bw[j] & 0xffff0000u); }
        __syncthreads();
#pragma unroll 8
        for (int k = 0; k < 32; ++k) { const float a0 = As[k][ty * 2], a1 = As[k][ty * 2 + 1];
            const float4 b0 = *(const float4*)&Bs[k][tx * 8], b1 = *(const float4*)&Bs[k][tx * 8 + 4];
            const float bb[8] = {b0.x, b0.y, b0.z, b0.w, b1.x, b1.y, b1.z, b1.w};
#pragma unroll
            for (int j = 0; j < 8; ++j) { acc[0][j] += a0 * bb[j]; acc[1][j] += a1 * bb[j]; } }
    }
#pragma unroll
    for (int i = 0; i < 2; ++i) { const int r = r0 + ty * 2 + i; if (r < M) P.store(z, r, c0 + tx * 8, acc[i]); }
}

struct ProbIn {
    static constexpr bool HOIST = false, PAIR = false;
    const bf16_t* A; int lda; const bf16_t* B; int ldb; int K; bf16_t *QK, *V, *R, *UT, *U2; float* LR;
    DEVI int M(int) const { return NROWS; }
    DEVI int arow(int, int r) const { return r; }
    DEVI int nunits() const { return (NROWS / 256) * (INP / 256); }
    DEVI void unit(int L, int& z, int& pm, int& pn) const { z = 0; dense_unit(L, NROWS / 256, INP / 256, pm, pn); }
    DEVI unsigned aoffb(int, int r) const { return (unsigned)r * (unsigned)(lda * 2); }
    DEVI const bf16_t* Bt(int) const { return B; }
    DEVI void store(int, int r, int c0, const float (&v)[8]) const {
        if (c0 >= INC) return;
        uint4 o; o.x = pk2(v[0], v[1]); o.y = pk2(v[2], v[3]); o.z = pk2(v[4], v[5]); o.w = pk2(v[6], v[7]);
        if (c0 < 512) { *(uint4*)(QK + (size_t)r * 512 + c0) = o; }
        else if (c0 < 1024) { *(uint4*)(V + (size_t)r * 512 + (c0 - 512)) = o; }
        else if (c0 < 1536) { *(uint4*)(R + (size_t)r * 512 + (c0 - 1024)) = o; }
        else if (c0 < 1568) { float* p = LR + (size_t)r * 32 + (c0 - 1536); *(float4*)p = make_float4(v[0], v[1], v[2], v[3]); *(float4*)(p + 4) = make_float4(v[4], v[5], v[6], v[7]); }
        else { const int j = c0 - 1568;
            const int g = j >> 4, ch = j & 15; int urow, ucol;
            if (r < NTOK) { const int b = r >> 12, n = r & 4095, gr = n >> 6, gc = n & 63, s = gc * 64 + gr; urow = b * 256 + (s >> 4); ucol = (s & 15) * 16 + ch; }
            else { const int q = r - NTOK, b = q >> 8, t = q & 255; urow = 2048 + b * 16 + (t >> 4); ucol = (t & 15) * 16 + ch; }
            *(uint4*)(U2 + ((size_t)g * 2304 + urow) * 512 + ucol) = o; }
    }
};
struct ProbGlu {
    static constexpr bool HOIST = false, PAIR = false;
    const bf16_t* A; int lda; const bf16_t* B; int ldb; int K; const float* bias; bf16_t* MIX;
    DEVI int M(int) const { return NTOK; }
    DEVI int arow(int, int r) const { return r; }
    DEVI int nunits() const { return (NTOK / 256) * 2; }
    DEVI void unit(int L, int& z, int& pm, int& pn) const { z = 0; dense_unit(L, NTOK / 256, 2, pm, pn); }
    DEVI unsigned aoffb(int, int r) const { return (unsigned)r * (unsigned)(lda * 2); }
    DEVI const bf16_t* Bt(int) const { return B; }
    DEVI void store(int, int r, int c0, const float (&v)[8]) const {
        const uint4 yv = *(const uint4*)(A + (size_t)r * lda + c0); const unsigned yw[4] = {yv.x, yv.y, yv.z, yv.w}; float o[8];
#pragma unroll
        for (int j = 0; j < 4; ++j) { const float y0 = __uint_as_float(yw[j] << 16), y1 = __uint_as_float(yw[j] & 0xffff0000u);
            o[2 * j] = y0 * sigmoidf_(v[2 * j] + bias[c0 + 2 * j]); o[2 * j + 1] = y1 * sigmoidf_(v[2 * j + 1] + bias[c0 + 2 * j + 1]); }
        uint4 w; w.x = pk2(o[0], o[1]); w.y = pk2(o[2], o[3]); w.z = pk2(o[4], o[5]); w.w = pk2(o[6], o[7]);
        *(uint4*)(MIX + (size_t)r * DM + 512 + c0) = w;
    }
};
struct ProbOut {
    static constexpr bool HOIST = false, PAIR = false;
    const bf16_t* A; int lda; const bf16_t* B; int ldb; int K; const float* x; const float* mod; float* X1;
    DEVI int M(int) const { return NTOK; }
    DEVI int arow(int, int r) const { return r; }
    DEVI int nunits() const { return (NTOK / 256) * 4; }
    DEVI void unit(int L, int& z, int& pm, int& pn) const { z = 0; dense_unit(L, NTOK / 256, 4, pm, pn); }
    DEVI unsigned aoffb(int, int r) const { return (unsigned)r * (unsigned)(lda * 2); }
    DEVI const bf16_t* Bt(int) const { return B; }
    DEVI void store(int, int r, int c0, const float (&v)[8]) const {
        const float* g1 = mod + (r >> 12) * 6144 + 2048 + c0; const float* xp = x + (size_t)r * DM + c0; float* op = X1 + (size_t)r * DM + c0;
        const float4 x0 = *(const float4*)xp, x1 = *(const float4*)(xp + 4), ga = *(const float4*)g1, gb = *(const float4*)(g1 + 4);
        *(float4*)op = make_float4(x0.x + ga.x * v[0], x0.y + ga.y * v[1], x0.z + ga.z * v[2], x0.w + ga.w * v[3]);
        *(float4*)(op + 4) = make_float4(x1.x + gb.x * v[4], x1.y + gb.y * v[5], x1.z + gb.z * v[6], x1.w + gb.w * v[7]);
    }
};
struct ProbMoe1 {
    const bf16_t* A; int lda; const bf16_t* B; int ldb; int K; const int* cnt; const int* offs; const int* list; const float* b_gu; bf16_t* ACT;
    DEVI int M(int z) const { return cnt[z]; }
    DEVI int arow(int z, int r) const { return list[z * LISTCAP + r] >> 2; }
    DEVI const bf16_t* Bt(int z) const { return B + (size_t)z * 2048 * DM; }
    DEVI void store(int, int, int, const float (&)[8]) const {}
};
struct ProbMoe2 {
    const bf16_t* A; int lda; const bf16_t* B; int ldb; int K; const int* cnt; const int* offs; const int* list; const float* b_down; const float* gate; bf16_t* YSL;
    DEVI int M(int z) const { return cnt[z]; }
    DEVI int arow(int z, int r) const { return offs[z] + r; }
    DEVI const bf16_t* Bt(int z) const { return B + (size_t)z * DM * DFF; }
    DEVI void store(int z, int r, int c0, const float (&v)[8]) const {
        const int ent = list[z * LISTCAP + r]; const float gt = gate[ent]; const float* bd = b_down + (size_t)z * DM + c0;
        uint4 o; o.x = pk2((v[0] + bd[0]) * gt, (v[1] + bd[1]) * gt); o.y = pk2((v[2] + bd[2]) * gt, (v[3] + bd[3]) * gt);
        o.z = pk2((v[4] + bd[4]) * gt, (v[5] + bd[5]) * gt); o.w = pk2((v[6] + bd[6]) * gt, (v[7] + bd[7]) * gt);
        *(uint4*)(YSL + (size_t)ent * DM + c0) = o;
    }
};

DEVI void gla_naive_body(const bf16_t* __restrict__ QK, const bf16_t* __restrict__ V, const float* __restrict__ LR, const float* __restrict__ lr_up,
                                                   const float* __restrict__ lr_bias, float* __restrict__ OF, float* __restrict__ OB, LAS float* sm, int item) {
    LAS float* sq = sm; LAS float* sk = sm + 64; LAS float* sa = sm + 128; LAS float* sv = sm + 192; LAS float* red = sm + 320;
    const int dir = item & 1, hh = (item >> 1) & 3, b = item >> 3, tid = threadIdx.x, e = tid & 127, dg = tid >> 7;
    float up[16]; float bias = 0.f;
    if (tid < 64) { for (int r = 0; r < 16; ++r) up[r] = lr_up[dir * 4096 + r * 256 + hh * 64 + tid]; bias = lr_bias[dir * 256 + hh * 64 + tid]; }
    float S[16];
#pragma unroll
    for (int i = 0; i < 16; ++i) S[i] = 0.f;
    float* O = dir ? OB : OF;
    for (int step = 0; step < CTX + SEQ; ++step) {
        int row;
        if (step < CTX) row = NTOK + b * CTX + (dir ? CTX - 1 - step : step);
        else { const int t = step - CTX; row = b * SEQ + (dir ? SEQ - 1 - t : t); }
        if (tid < 64) { const float* lp = LR + (size_t)row * 32 + dir * 16; float g = bias;
#pragma unroll
            for (int r = 0; r < 16; ++r) g += lp[r] * up[r];
            sa[tid] = __expf(logsigmoidf_(g) * (1.f / 16.f));
            sq[tid] = bf2f(QK[(size_t)row * 512 + hh * 64 + tid]) * 0.125f; sk[tid] = bf2f(QK[(size_t)row * 512 + 256 + hh * 64 + tid]); }
        else if (tid < 192) sv[tid - 64] = bf2f(V[(size_t)row * 512 + hh * 128 + (tid - 64)]);
        __syncthreads();
        const float v = sv[e]; float part = 0.f;
#pragma unroll
        for (int i = 0; i < 16; ++i) { const int d = dg * 16 + i; S[i] = sa[d] * S[i] + sk[d] * v; part += sq[d] * S[i]; }
        if (step >= CTX) red[dg * 128 + e] = part;
        __syncthreads();
        if (step >= CTX && dg == 0) O[(size_t)row * 512 + hh * 128 + e] = (red[e] + red[128 + e]) + (red[256 + e] + red[384 + e]);
    }
}
__global__ __launch_bounds__(512) void k_gla_naive(const bf16_t* __restrict__ QK, const bf16_t* __restrict__ V, const float* __restrict__ LR, const float* __restrict__ lr_up,
                                                   const float* __restrict__ lr_bias, float* __restrict__ OF, float* __restrict__ OB) {
    __shared__ float sm[832];
    gla_naive_body(QK, V, LR, lr_up, lr_bias, OF, OB, (LAS float*)sm, blockIdx.x);
}
DEVI void gla_post_row(const float* __restrict__ OF, const float* __restrict__ OB, const bf16_t* __restrict__ R, const float* __restrict__ nw, bf16_t* __restrict__ MIX, int tok, int lane) {
    const int c0 = lane * 8;
    float o[8]; float ss = 0.f;
#pragma unroll
    for (int j = 0; j < 8; ++j) { o[j] = OF[(size_t)tok * 512 + c0 + j] + OB[(size_t)tok * 512 + c0 + j]; ss += o[j] * o[j]; }
    ss += __shfl_xor(ss, 1); ss += __shfl_xor(ss, 2); ss += __shfl_xor(ss, 4); ss += __shfl_xor(ss, 8);
    const float rstd = rsqrtf(ss * (1.f / 128.f) + 1e-6f);
    float w[8];
#pragma unroll
    for (int j = 0; j < 8; ++j) { const float r = bf2f(R[(size_t)tok * 512 + c0 + j]); w[j] = o[j] * rstd * nw[(c0 + j) & 127] * siluf_(r); }
    uint4 q; q.x = pk2(w[0], w[1]); q.y = pk2(w[2], w[3]); q.z = pk2(w[4], w[5]); q.w = pk2(w[6], w[7]);
    *(uint4*)(MIX + (size_t)tok * DM + c0) = q;
}
__global__ __launch_bounds__(256) void k_gla_post(const float* __restrict__ OF, const float* __restrict__ OB, const bf16_t* __restrict__ R, const float* __restrict__ nw, bf16_t* __restrict__ MIX) {
    gla_post_row(OF, OB, R, nw, MIX, blockIdx.x * 4 + (threadIdx.x >> 6), threadIdx.x & 63);
}

DEVI void s5_naive_body(const bf16_t* __restrict__ UT, const S5P* __restrict__ P, const float* __restrict__ c_re, const float* __restrict__ c_im,
                                                  float* __restrict__ YF, float* __restrict__ YB, LAS float* hsw  , int id, int lane) {
    const int g = id & 31, dir = (id >> 5) & 1, b = id >> 6;
    const float lr = P->lamb[dir][g][lane][0], li = P->lamb[dir][g][lane][1];
    float br[16], bi[16];
#pragma unroll
    for (int h = 0; h < 16; ++h) { br[h] = P->bbar[dir][g][lane][h][0]; bi[h] = P->bbar[dir][g][lane][h][1]; }
    const int ch = lane & 15, part = lane >> 4;
    float cr[16], ci[16];
#pragma unroll
    for (int i = 0; i < 16; ++i) { const size_t ix = (((size_t)dir * 32 + g) * 16 + ch) * 64 + part * 16 + i; cr[i] = c_re[ix]; ci[i] = c_im[ix]; }
    float hr = 0.f, hi = 0.f; float* Y = dir ? YB : YF;
    for (int step = 0; step < CTX + SEQ; ++step) {
        int row;
        if (step < CTX) row = NTOK + b * CTX + (dir ? CTX - 1 - step : step);
        else { const int t = step - CTX, s = dir ? SEQ - 1 - t : t; row = b * SEQ + (s & 63) * 64 + (s >> 6); }
        const uint4 u0 = *(const uint4*)(UT + (size_t)row * 512 + g * 16), u1 = *(const uint4*)(UT + (size_t)row * 512 + g * 16 + 8);
        const unsigned uw[8] = {u0.x, u0.y, u0.z, u0.w, u1.x, u1.y, u1.z, u1.w};
        float bur = 0.f, bui = 0.f;
#pragma unroll
        for (int j = 0; j < 8; ++j) { const float ua = __uint_as_float(uw[j] << 16), ub = __uint_as_float(uw[j] & 0xffff0000u);
            bur += br[2 * j] * ua + br[2 * j + 1] * ub; bui += bi[2 * j] * ua + bi[2 * j + 1] * ub; }
        const float nr = lr * hr - li * hi + bur, ni = lr * hi + li * hr + bui; hr = nr; hi = ni;
        if (step >= CTX) {
            hsw[lane] = hr; hsw[64 + lane] = hi;
            asm volatile("s_waitcnt lgkmcnt(0)" ::: "memory");
            float acc = 0.f;
#pragma unroll
            for (int i = 0; i < 16; ++i) acc += cr[i] * hsw[part * 16 + i] - ci[i] * hsw[64 + part * 16 + i];
            acc += __shfl_xor(acc, 16); acc += __shfl_xor(acc, 32);
            asm volatile("s_waitcnt lgkmcnt(0)" ::: "memory");
            if (lane < 16) Y[(size_t)row * 512 + g * 16 + lane] = acc;
        }
    }
}
__global__ __launch_bounds__(256) void k_s5_naive(const bf16_t* __restrict__ UT, const S5P* __restrict__ P, const float* __restrict__ c_re, const float* __restrict__ c_im,
                                                  float* __restrict__ YF, float* __restrict__ YB) {
    __shared__ float hs[4][128];
    const int w = threadIdx.x >> 6;
    s5_naive_body(UT, P, c_re, c_im, YF, YB, (LAS float*)hs[w], blockIdx.x * 4 + w, threadIdx.x & 63);
}
__global__ __launch_bounds__(256) void k_s5_post(const float* __restrict__ YF, const float* __restrict__ YB, const bf16_t* __restrict__ UT, const float* __restrict__ dvec, bf16_t* __restrict__ YS) {
    const size_t i = (size_t)blockIdx.x * 256 + threadIdx.x; const int j = (int)(i & 511);
    const float y = YF[i] + YB[i] + dvec[j] * bf2f(UT[i]);
    YS[i] = f2bf(gelu_tanh(y));
}

DEVI void router_row(const float* __restrict__ X1, const float* __restrict__ w, const float* __restrict__ mod, const float* __restrict__ rw, const float* __restrict__ rb,
                                                bf16_t* __restrict__ H2, int* __restrict__ cnt, int* __restrict__ list, float* __restrict__ gate, LAS float* hrw  , int tok, int lane) {
    const int b = tok / SEQ;
    const float* src = X1 + (size_t)tok * DM;
    float4 v[4]; float ss = 0.f;
#pragma unroll
    for (int j = 0; j < 4; ++j) { v[j] = *(const float4*)(src + lane * 4 + 256 * j); ss += v[j].x * v[j].x + v[j].y * v[j].y + v[j].z * v[j].z + v[j].w * v[j].w; }
    const float rstd = rsqrtf(wave_sum(ss) * (1.f / DM) + 1e-6f);
    const float* msh = mod + b * 6144 + 3072; const float* msc = mod + b * 6144 + 4096;
#pragma unroll
    for (int j = 0; j < 4; ++j) { const int k = lane * 4 + 256 * j;
        const float4 ww = *(const float4*)(w + k), sc = *(const float4*)(msc + k), sh = *(const float4*)(msh + k);
        float4 h; h.x = v[j].x * rstd * ww.x * (1.f + sc.x) + sh.x; h.y = v[j].y * rstd * ww.y * (1.f + sc.y) + sh.y; h.z = v[j].z * rstd * ww.z * (1.f + sc.z) + sh.z; h.w = v[j].w * rstd * ww.w * (1.f + sc.w) + sh.w;
        hrw[k] = h.x; hrw[k + 1] = h.y; hrw[k + 2] = h.z; hrw[k + 3] = h.w;
        uint2 o; o.x = pk2(h.x, h.y); o.y = pk2(h.z, h.w); *(uint2*)(H2 + (size_t)tok * DM + k) = o; }
    asm volatile("s_waitcnt lgkmcnt(0)" ::: "memory");
    const int e = lane & 31, half = lane >> 5; float lg = 0.f;
    for (int k = half * 512; k < half * 512 + 512; ++k) lg += hrw[k] * rw[k * 32 + e];
    lg += __shfl_xor(lg, 32); lg += rb[e];
    float val = lg; float tv[4]; int ti[4];
#pragma unroll
    for (int t = 0; t < 4; ++t) { float bv = val; int bi = e;
#pragma unroll
        for (int o = 1; o < 32; o <<= 1) { const float ov = __shfl_xor(bv, o); const int oi = __shfl_xor(bi, o); if (ov > bv || (ov == bv && oi < bi)) { bv = ov; bi = oi; } }
        tv[t] = bv; ti[t] = bi; if (e == bi) val = -3.0e38f; }
    const float e1 = __expf(tv[1] - tv[0]), e2 = __expf(tv[2] - tv[0]), e3 = __expf(tv[3] - tv[0]), inv = 1.f / (1.f + e1 + e2 + e3);
    if (lane < 4) { const float gv = lane == 0 ? inv : lane == 1 ? e1 * inv : lane == 2 ? e2 * inv : e3 * inv; const int ex = lane == 0 ? ti[0] : lane == 1 ? ti[1] : lane == 2 ? ti[2] : ti[3];
        const int slot = atomicAdd(&cnt[ex], 1); list[ex * LISTCAP + slot] = tok * 4 + lane; gate[tok * 4 + lane] = gv; }
}
__global__ __launch_bounds__(256) void k_router(const float* __restrict__ X1, const float* __restrict__ w, const float* __restrict__ mod, const float* __restrict__ rw, const float* __restrict__ rb,
                                                bf16_t* __restrict__ H2, int* __restrict__ cnt, int* __restrict__ list, float* __restrict__ gate) {
    __shared__ float hrow[4][1024];
    const int wv = threadIdx.x >> 6;
    router_row(X1, w, mod, rw, rb, H2, cnt, list, gate, (LAS float*)hrow[wv], blockIdx.x * 4 + wv, threadIdx.x & 63);
}
__global__ void k_offsets(const int* cnt, int* offs) { if (threadIdx.x == 0) { int o = 0; for (int e = 0; e < NEXP; ++e) { offs[e] = o; o += (cnt[e] + MOEPAD - 1) / MOEPAD * MOEPAD; } offs[NEXP] = o; } }

DEVI void final_row(float* __restrict__ X1, const bf16_t* __restrict__ Y2, const float* __restrict__ mod, const float* __restrict__ fw, const float* __restrict__ gate, const int* __restrict__ epos,
                    const LAS int* ub, int tok, int lane, float* __restrict__ OUT = nullptr) {
    const int b = tok / SEQ;
    float* row = X1 + (size_t)tok * DM; float* orow = OUT ? OUT + (size_t)tok * DM : row; const float* g2 = mod + b * 6144 + 5120;
    const int4 ep = *(const int4*)(epos + tok * 4); const float4 gt = *(const float4*)(gate + tok * 4);
    const bf16_t* y0 = Y2 + (size_t)(ub[ep.x / LISTCAP] * 256 + ep.x % LISTCAP) * DM; const bf16_t* y1 = Y2 + (size_t)(ub[ep.y / LISTCAP] * 256 + ep.y % LISTCAP) * DM;
    const bf16_t* y2 = Y2 + (size_t)(ub[ep.z / LISTCAP] * 256 + ep.z % LISTCAP) * DM; const bf16_t* y3 = Y2 + (size_t)(ub[ep.w / LISTCAP] * 256 + ep.w % LISTCAP) * DM;
    float4 v[4]; float ss = 0.f;
#pragma unroll
    for (int j = 0; j < 4; ++j) { const int k = lane * 4 + 256 * j; v[j] = *(const float4*)(row + k);
        const uint2 a0 = *(const uint2*)(y0 + k), a1 = *(const uint2*)(y1 + k), a2 = *(const uint2*)(y2 + k), a3 = *(const uint2*)(y3 + k);
        float f[4];
        f[0] = gt.x * __uint_as_float(a0.x << 16) + gt.y * __uint_as_float(a1.x << 16) + gt.z * __uint_as_float(a2.x << 16) + gt.w * __uint_as_float(a3.x << 16);
        f[1] = gt.x * __uint_as_float(a0.x & 0xffff0000u) + gt.y * __uint_as_float(a1.x & 0xffff0000u) + gt.z * __uint_as_float(a2.x & 0xffff0000u) + gt.w * __uint_as_float(a3.x & 0xffff0000u);
        f[2] = gt.x * __uint_as_float(a0.y << 16) + gt.y * __uint_as_float(a1.y << 16) + gt.z * __uint_as_float(a2.y << 16) + gt.w * __uint_as_float(a3.y << 16);
        f[3] = gt.x * __uint_as_float(a0.y & 0xffff0000u) + gt.y * __uint_as_float(a1.y & 0xffff0000u) + gt.z * __uint_as_float(a2.y & 0xffff0000u) + gt.w * __uint_as_float(a3.y & 0xffff0000u);
        const float4 gg = *(const float4*)(g2 + k);
        v[j].x += gg.x * f[0]; v[j].y += gg.y * f[1]; v[j].z += gg.z * f[2]; v[j].w += gg.w * f[3];
        ss += v[j].x * v[j].x + v[j].y * v[j].y + v[j].z * v[j].z + v[j].w * v[j].w; }
    const float rstd = rsqrtf(wave_sum(ss) * (1.f / DM) + 1e-6f);
#pragma unroll
    for (int j = 0; j < 4; ++j) { const int k = lane * 4 + 256 * j; const float4 ww = *(const float4*)(fw + k);
        *(float4*)(orow + k) = make_float4(v[j].x * rstd * ww.x, v[j].y * rstd * ww.y, v[j].z * rstd * ww.z, v[j].w * rstd * ww.w); }
}

typedef short bf16x8 __attribute__((ext_vector_type(8)));
typedef float f32x4 __attribute__((ext_vector_type(4)));
typedef unsigned u32x4 __attribute__((ext_vector_type(4)));
typedef unsigned u32x2 __attribute__((ext_vector_type(2)));
constexpr int NWAVES = 8, NTHR = 512;
constexpr int BM = 256, BK = 64, HALF = 128, HTB = HALF * BK * 2, STAGE_BYTES = 8 * HTB;
constexpr int MISC_OFF = STAGE_BYTES, MISC_BYTES = 1024, LDS_BYTES = STAGE_BYTES + MISC_BYTES;
constexpr int CW_BAR = 4096;

#define XB_TMO      128
#define XB_XCNT(j)  (256  + 64 * (j))
#define XB_XSUB(j)  (1280 + 64 * (j))
#define XB_XGEN(j)  (2304 + 64 * (j))
#define XB_TOP      3328
#define XB_TOPGEN   3392
#define XCD_BAR_WORDS 3456
#define XB_SPIN_CAP (1u << 18)
DEVI unsigned xb_ld(unsigned* p)              { return __hip_atomic_load(p, __ATOMIC_RELAXED, __HIP_MEMORY_SCOPE_AGENT); }
DEVI unsigned xb_add(unsigned* p, unsigned v) { return __hip_atomic_fetch_add(p, v, __ATOMIC_RELAXED, __HIP_MEMORY_SCOPE_AGENT); }
DEVI unsigned xb_xcc_id() { return (unsigned)__builtin_amdgcn_s_getreg((3 << 11) | 20) & 0xFu; }
#define XB_SPIN(cond, bar) do { unsigned _sp = 0; while (cond) { __builtin_amdgcn_s_sleep(1); \
    if ((++_sp & 255u) == 0u) { if (xb_ld(&(bar)[XB_TMO])) break; if (_sp > XB_SPIN_CAP) { atomicAdd(&(bar)[XB_TMO], 1u); break; } } } } while (0)
struct XcdBarrier { unsigned* bar; unsigned x; volatile LAS unsigned* st; };
DEVI XcdBarrier xcd_barrier_post(unsigned* bar, volatile LAS unsigned* st) {
    XcdBarrier b; b.bar = bar; b.x = xb_xcc_id(); b.st = st;
    if (threadIdx.x == 0) (void)xb_add(&bar[XB_XCNT(b.x)], 1u);
    return b;
}
DEVI void xcd_barrier_complete(unsigned* bar, unsigned x, unsigned& nloc, unsigned& nx) {
    const unsigned G = gridDim.x * gridDim.y * gridDim.z;
    unsigned sum, cnt, mine, sp = 0u;
    for (;;) {
        sum = 0u; cnt = 0u; mine = 0u;
#pragma unroll
        for (unsigned j = 0; j < 16; ++j) { const unsigned c = xb_ld(&bar[XB_XCNT(j)]); sum += c; cnt += (c > 0u) ? 1u : 0u; mine = (j == x) ? c : mine; }
        if (sum == G) break;
        __builtin_amdgcn_s_sleep(1);
        if ((++sp & 255u) == 0u) { if (xb_ld(&bar[XB_TMO])) break; if (sp > XB_SPIN_CAP) { atomicAdd(&bar[XB_TMO], 1u); break; } }
    }
    nloc = mine > 0u ? mine : 1u; nx = cnt > 0u ? cnt : 1u;
}
DEVI void xcd_barrier(const XcdBarrier& b) {
    asm volatile("s_waitcnt vmcnt(0)" ::: "memory");
    __syncthreads();
    if (threadIdx.x == 0) {
        unsigned* bar = b.bar;
        __builtin_amdgcn_s_waitcnt(0);
        unsigned nloc = b.st[0], nx = b.st[1];
        if (nloc == 0u) { xcd_barrier_complete(bar, b.x, nloc, nx); b.st[0] = nloc; b.st[1] = nx; }
        const unsigned old = xb_add(&bar[XB_XSUB(b.x)], 1u);
        const unsigned gen = old / nloc;
        if (old + 1u == (gen + 1u) * nloc) {
            __builtin_amdgcn_fence(__ATOMIC_RELEASE, "agent");
            asm volatile("s_waitcnt vmcnt(0)" ::: "memory");
            const unsigned og = xb_add(&bar[XB_TOP], 1u);
            const unsigned tg = og / nx;
            if (og + 1u == (tg + 1u) * nx) xb_add(&bar[XB_TOPGEN], 1u);
            else XB_SPIN(xb_ld(&bar[XB_TOPGEN]) == tg, bar);
            __builtin_amdgcn_fence(__ATOMIC_ACQUIRE, "agent");
            xb_add(&bar[XB_XGEN(b.x)], 1u);
            asm volatile("s_waitcnt vmcnt(0)" ::: "memory");
        } else {
            XB_SPIN(xb_ld(&bar[XB_XGEN(b.x)]) == gen, bar);
            __builtin_amdgcn_fence(__ATOMIC_ACQUIRE, "agent");
            asm volatile("s_waitcnt vmcnt(0)" ::: "memory");
        }
    }
    __syncthreads();
}

DEVI int lds_byte(int r, int c) { const int st = (r >> 4) * 2 + (c >> 5), rr = r & 15, cc = c & 31, ob = rr * 64 + cc * 2; return st * 1024 + (ob ^ (((ob >> 9) & 1) << 5)); }
DEVI void stage_rc(int b, int& R, int& C) { const int st = b / 1024, sb = b % 1024, swz = sb ^ (((sb >> 9) & 1) << 5); R = (st >> 1) * 16 + swz / 64; C = (st & 1) * 32 + (swz % 64) / 2; }
DEVI int perm32(int rho) { const int n = rho >> 4, i = rho & 15; return 8 * (i >> 2) + 4 * n + (i & 3); }
template <int VMODE = 0, class Prob>
DEVI void gemm_phase(LAS unsigned char* lds, const Prob& P, int G, int c) {
    int tid = threadIdx.x; asm volatile("" : "+v"(tid));
    const int wid = __builtin_amdgcn_readfirstlane(tid >> 6), lane = tid & 63, wr = wid >> 2, wc = wid & 3, fr = lane & 15, fq = lane >> 4;
    const int K = P.K, nt = K / BK;
    const int nun = P.nunits();
    int L = c; if (L >= nun) return;
    int Rs0, Cs0, Rs1, Cs1; stage_rc(tid * 16, Rs0, Cs0); stage_rc(tid * 16 + 8192, Rs1, Cs1);
    unsigned voffB[2];
    voffB[0] = (unsigned)(((Rs0 & ~31) + perm32(Rs0 & 31)) * K + Cs0) * 2u; voffB[1] = (unsigned)(((Rs1 & ~31) + perm32(Rs1 & 31)) * K + Cs1) * 2u;
    const size_t kstep = (size_t)(BK * 2), hstepB = (size_t)HALF * K * 2, tstepB = 2 * hstepB;
    const unsigned ldsw = (unsigned)wid * 1024u;
    const int aoff = lds_byte(wr * 64 + fr, fq * 8), boff = lds_byte(wc * 32 + fr, fq * 8);
#define G_SA(b, h) (((b) * 2 + (h)) * HTB)
#define G_SB(b, h) ((4 + (b) * 2 + (h)) * HTB)
#define G_STAGE_B(bufoff, gbase) do { _Pragma("unroll") for (int _i = 0; _i < 2; ++_i) \
        __builtin_amdgcn_global_load_lds((const unsigned*)((const char*)(gbase) + voffB[_i]), (LAS unsigned*)(lds + (bufoff) + ldsw + _i * 8192), 16, 0, 0); } while (0)
#define G_STAGE_A(bufoff, gbase, v0, v1) do { \
        __builtin_amdgcn_global_load_lds((const unsigned*)((const char*)(gbase) + (v0)), (LAS unsigned*)(lds + (bufoff) + ldsw), 16, 0, 0); \
        __builtin_amdgcn_global_load_lds((const unsigned*)((const char*)(gbase) + (v1)), (LAS unsigned*)(lds + (bufoff) + ldsw + 8192), 16, 0, 0); } while (0)
#define G_LDA(dst, b, h) do { _Pragma("unroll") for (int m = 0; m < 4; ++m) _Pragma("unroll") for (int k = 0; k < 2; ++k) dst[m][k] = *(const LAS bf16x8*)(lds + G_SA(b, h) + aoff + m * 2048 + k * 1024); } while (0)
#define G_LDB(dst, b, h) do { _Pragma("unroll") for (int n = 0; n < 2; ++n) _Pragma("unroll") for (int k = 0; k < 2; ++k) dst[n][k] = *(const LAS bf16x8*)(lds + G_SB(b, h) + boff + n * 2048 + k * 1024); } while (0)
#define G_MMA(ai, bj, At, Bt) do { __builtin_amdgcn_s_setprio(1); _Pragma("unroll") for (int m = 0; m < 4; ++m) _Pragma("unroll") for (int n = 0; n < 2; ++n) _Pragma("unroll") for (int k = 0; k < 2; ++k) \
        acc[ai][bj][m][n] = __builtin_amdgcn_mfma_f32_16x16x32_bf16(Bt[n][k], At[m][k], acc[ai][bj][m][n], 0, 0, 0); __builtin_amdgcn_s_setprio(0); } while (0)
#define G_WAIT_V(n) asm volatile("s_waitcnt vmcnt(" #n ")" ::: "memory")
#define G_WAIT_L(n) asm volatile("s_waitcnt lgkmcnt(" #n ")" ::: "memory")
#define G_BAR __builtin_amdgcn_s_barrier()
#define G_SCHED __builtin_amdgcn_sched_barrier(0)
    int z, pm, pn; P.unit(L, z, pm, pn);
    z = __builtin_amdgcn_readfirstlane(z); pm = __builtin_amdgcn_readfirstlane(pm); pn = __builtin_amdgcn_readfirstlane(pn);
    unsigned vA00 = P.aoffb(z, pm * BM + Rs0) + Cs0 * 2, vA01 = P.aoffb(z, pm * BM + Rs1) + Cs1 * 2;
    unsigned vA10 = P.aoffb(z, pm * BM + HALF + Rs0) + Cs0 * 2, vA11 = P.aoffb(z, pm * BM + HALF + Rs1) + Cs1 * 2;
    const char* const Ab = (const char*)P.A;
    const char* cB = (const char*)P.Bt(z) + (size_t)pn * tstepB;
    f32x4 acc[2][2][4][2];
    bf16x8 At[4][2], B0[2][2], B1[2][2];
    G_STAGE_B(G_SB(0, 0), cB); G_STAGE_A(G_SA(0, 0), Ab, vA00, vA01); G_STAGE_B(G_SB(0, 1), cB + hstepB); G_STAGE_A(G_SA(0, 1), Ab, vA10, vA11);
    if (wr == 1) G_BAR;
    G_WAIT_V(4); G_BAR;
    G_STAGE_B(G_SB(1, 0), cB + kstep); G_STAGE_A(G_SA(1, 0), Ab + kstep, vA00, vA01); G_STAGE_B(G_SB(1, 1), cB + hstepB + kstep);
    G_WAIT_V(6); G_BAR;
    for (;;) {
        const int Ln = L + G; const bool has_next = Ln < nun;
        int nz = z, npm = pm, npn = pn; if (has_next) P.unit(Ln, nz, npm, npn);
        nz = __builtin_amdgcn_readfirstlane(nz); npm = __builtin_amdgcn_readfirstlane(npm); npn = __builtin_amdgcn_readfirstlane(npn);
        const char* nB = has_next ? (const char*)P.Bt(nz) + (size_t)npn * tstepB : cB;
#pragma unroll
        for (int a = 0; a < 2; ++a)
#pragma unroll
            for (int b = 0; b < 2; ++b)
#pragma unroll
                for (int m = 0; m < 4; ++m)
#pragma unroll
                    for (int n = 0; n < 2; ++n) acc[a][b][m][n] = (f32x4){0.f, 0.f, 0.f, 0.f};
#pragma unroll 1
        for (int t = 0; t < nt; t += 2) {
            const bool last = (t == nt - 2);
            unsigned n00 = vA00, n01 = vA01, n10 = vA10, n11 = vA11;
            if (last && has_next) { n00 = P.aoffb(nz, npm * BM + Rs0) + Cs0 * 2; n01 = P.aoffb(nz, npm * BM + Rs1) + Cs1 * 2;
                n10 = P.aoffb(nz, npm * BM + HALF + Rs0) + Cs0 * 2; n11 = P.aoffb(nz, npm * BM + HALF + Rs1) + Cs1 * 2; }
            const char* a1 = Ab + (size_t)(t + 1) * kstep;
            const char* a2 = last ? Ab : Ab + (size_t)(t + 2) * kstep; const char* b2 = last ? nB : cB + (size_t)(t + 2) * kstep;
            const char* a3 = a2 + kstep; const char* b3 = b2 + kstep;
            G_LDB(B0, 0, 0); G_SCHED; G_LDA(At, 0, 0); G_STAGE_A(G_SA(1, 1), a1, vA10, vA11);
            G_WAIT_L(8); G_BAR; G_WAIT_L(0); G_MMA(0, 0, At, B0); G_BAR; G_SCHED;
            if (last) { vA00 = n00; vA01 = n01; vA10 = n10; vA11 = n11; }
            G_LDB(B1, 0, 1); G_STAGE_B(G_SB(0, 0), b2);
            G_BAR; G_WAIT_L(0); G_MMA(0, 1, At, B1); G_BAR;
            G_LDA(At, 0, 1); G_STAGE_A(G_SA(0, 0), a2, vA00, vA01);
            G_BAR; G_WAIT_L(0); G_MMA(1, 0, At, B0); G_BAR; G_SCHED;
            G_STAGE_B(G_SB(0, 1), b2 + hstepB);
            G_WAIT_V(6); G_BAR; G_MMA(1, 1, At, B1); G_BAR;
            G_LDB(B0, 1, 0); G_SCHED; G_LDA(At, 1, 0); G_STAGE_A(G_SA(0, 1), a2, vA10, vA11);
            G_WAIT_L(8); G_BAR; G_WAIT_L(0); G_MMA(0, 0, At, B0); G_BAR; G_SCHED;
            G_LDB(B1, 1, 1); G_STAGE_B(G_SB(1, 0), b3);
            G_BAR; G_WAIT_L(0); G_MMA(0, 1, At, B1); G_BAR;
            G_LDA(At, 1, 1); G_STAGE_A(G_SA(1, 0), a3, vA00, vA01);
            G_BAR; G_WAIT_L(0); G_MMA(1, 0, At, B0); G_BAR; G_SCHED;
            G_STAGE_B(G_SB(1, 1), b3 + hstepB);
            G_WAIT_V(6); G_BAR; G_MMA(1, 1, At, B1); G_BAR;
        }
        if constexpr (VMODE == 1) {
#pragma unroll
            for (int a_ = 0; a_ < 2; ++a_)
#pragma unroll
                for (int b_ = 0; b_ < 2; ++b_)
#pragma unroll
                    for (int m_ = 0; m_ < 4; ++m_)
#pragma unroll
                        for (int n_ = 0; n_ < 2; ++n_) asm volatile("" :: "v"(acc[a_][b_][m_][n_]));
        } else
        { const int Mz = VMODE == 2 ? 0 : __builtin_amdgcn_readfirstlane(P.M(z));
          if constexpr (VMODE == 2) {
#pragma unroll
            for (int a_ = 0; a_ < 2; ++a_)
#pragma unroll
                for (int b_ = 0; b_ < 2; ++b_)
#pragma unroll
                    for (int m_ = 0; m_ < 4; ++m_)
#pragma unroll
                        for (int n_ = 0; n_ < 2; ++n_) asm volatile("" :: "v"(acc[a_][b_][m_][n_])); }
          const int cb0 = pn * BM + wc * 32 + 8 * fq, rb0 = pm * BM + wr * 64 + fr;
          if constexpr (Prob::PAIR) {
              const typename Prob::ColCtx cc = P.colctx(z, cb0);
              typename Prob::RowCtx rc[2][4];
#pragma unroll
              for (int ai = 0; ai < 2; ++ai)
#pragma unroll
                  for (int m = 0; m < 4; ++m) { const int row = rb0 + ai * HALF + m * 16; rc[ai][m] = P.rowctx(z, row, row < Mz); }
#pragma unroll
              for (int ai = 0; ai < 2; ++ai)
#pragma unroll
                  for (int m = 0; m < 4; ++m) { const int row = rb0 + ai * HALF + m * 16;
                      if (row < Mz) { const f32x4 g0 = acc[ai][0][m][0], g1 = acc[ai][0][m][1], l0 = acc[ai][1][m][0], l1 = acc[ai][1][m][1];
                          const float vg[8] = {g0[0], g0[1], g0[2], g0[3], g1[0], g1[1], g1[2], g1[3]}, vl[8] = {l0[0], l0[1], l0[2], l0[3], l1[0], l1[1], l1[2], l1[3]};
                          P.storepair(cc, rc[ai][m], vg, vl); } }
          } else if constexpr (Prob::HOIST) {
              typename Prob::ColCtx cc[2]; typename Prob::RowCtx rc[2][4];
#pragma unroll
              for (int bj = 0; bj < 2; ++bj) cc[bj] = P.colctx(z, cb0 + bj * HALF);
#pragma unroll
              for (int ai = 0; ai < 2; ++ai)
#pragma unroll
                  for (int m = 0; m < 4; ++m) { const int row = rb0 + ai * HALF + m * 16; rc[ai][m] = P.rowctx(z, row, row < Mz); }
#pragma unroll
              for (int ai = 0; ai < 2; ++ai)
#pragma unroll
                  for (int m = 0; m < 4; ++m) { const int row = rb0 + ai * HALF + m * 16;
                      if (row < Mz) {
#pragma unroll
                          for (int bj = 0; bj < 2; ++bj) { const f32x4 v0 = acc[ai][bj][m][0], v1 = acc[ai][bj][m][1];
                              const float v[8] = {v0[0], v0[1], v0[2], v0[3], v1[0], v1[1], v1[2], v1[3]};
                              P.storeh(cc[bj], rc[ai][m], cb0 + bj * HALF, v); } } }
          } else {
#pragma unroll
          for (int ai = 0; ai < 2; ++ai)
#pragma unroll
            for (int m = 0; m < 4; ++m) { const int row = rb0 + ai * HALF + m * 16;
                if (row < Mz) {
#pragma unroll
                    for (int bj = 0; bj < 2; ++bj) { const int c0 = cb0 + bj * HALF;
                        const f32x4 v0 = acc[ai][bj][m][0], v1 = acc[ai][bj][m][1];
                        const float v[8] = {v0[0], v0[1], v0[2], v0[3], v1[0], v1[1], v1[2], v1[3]};
                        P.store(z, row, c0, v); } }
                asm volatile("" ::: "memory"); } } }
        if (!has_next) break;
        z = nz; pm = npm; pn = npn; cB = nB; L = Ln;
    }
    G_WAIT_V(0);
    if (wr == 0) G_BAR;
    G_BAR;
}

template <int NT, bool REV> DEVI void moe_unit(const LAS int* ub, int L, int G, int& z, int& pm, int& pn) {
    const int nun = __builtin_amdgcn_readfirstlane(ub[NEXP]) * NT;
    int Lq = L;
    if ((G & 7) == 0) { const int i = L / G, c = L - i * G, x = c & 7, j = c >> 3, per = G >> 3; Lq = (i * 8 + x) * per + j; }
    if (Lq >= nun) { z = -1; pm = 0; pn = 0; return; }
    if (REV) Lq = nun - 1 - Lq;
    int e = 0; while (e < NEXP - 1 && Lq >= __builtin_amdgcn_readfirstlane(ub[e + 1]) * NT) ++e;
    const int l = Lq - __builtin_amdgcn_readfirstlane(ub[e]) * NT; z = e; pm = l / NT; pn = l % NT;
}
struct FMoe1 {
    static constexpr bool HOIST = true, PAIR = true, RV = false; static constexpr int NT = 8;
    const bf16_t* A; const bf16_t* B; int K; const int* cnt; const int* list; const float* b_gu; bf16_t* ACT; const LAS int* ub; int G;
    struct ColCtx { float bg[8], bl[8]; int f0; }; struct RowCtx { bf16_t* p; };
    DEVI int ubs(int e) const { return __builtin_amdgcn_readfirstlane(ub[e]); }
    DEVI int nunits() const { const int n = ubs(NEXP) * NT; return (G & 7) == 0 ? (n + G - 1) / G * G : n; }
    DEVI void unit(int L, int& z, int& pm, int& pn) const { moe_unit<NT, RV>(ub, L, G, z, pm, pn); }
    DEVI int M(int z) const { return z < 0 ? 0 : cnt[z]; }
    DEVI unsigned aoffb(int z, int r) const { const int t = (z >= 0 && r < cnt[z]) ? (list[z * LISTCAP + r] >> 2) : 0; return (unsigned)t * (unsigned)(DM * 2); }
    DEVI const bf16_t* Bt(int z) const { return B + (size_t)(z < 0 ? 0 : z) * 2048 * DM; }
    DEVI ColCtx colctx(int z, int c0) const { ColCtx c; c.f0 = (c0 >> 8) * 128 + (c0 & 127); const float* bp = b_gu + (size_t)(z < 0 ? 0 : z) * 2048 + c.f0;
        const float4 g0 = *(const float4*)bp, g1 = *(const float4*)(bp + 4), l0 = *(const float4*)(bp + 1024), l1 = *(const float4*)(bp + 1028);
        c.bg[0] = g0.x; c.bg[1] = g0.y; c.bg[2] = g0.z; c.bg[3] = g0.w; c.bg[4] = g1.x; c.bg[5] = g1.y; c.bg[6] = g1.z; c.bg[7] = g1.w;
        c.bl[0] = l0.x; c.bl[1] = l0.y; c.bl[2] = l0.z; c.bl[3] = l0.w; c.bl[4] = l1.x; c.bl[5] = l1.y; c.bl[6] = l1.z; c.bl[7] = l1.w; return c; }
    DEVI RowCtx rowctx(int z, int r, bool) const { RowCtx x; x.p = ACT + (size_t)(ubs(z < 0 ? 0 : z) * 256 + r) * DFF; return x; }
    DEVI void storepair(const ColCtx& c, const RowCtx& x, const float (&vg)[8], const float (&vl)[8]) const { float a[8];
#pragma unroll
        for (int i = 0; i < 8; ++i) { float g = vg[i] + c.bg[i], l = vl[i] + c.bl[i]; g = fminf(g, 7.f); l = fminf(fmaxf(l, -7.f), 7.f); a[i] = (l + 1.f) * g * __builtin_amdgcn_rcpf(1.f + __expf(-1.702f * g)); }
        uint4 o; o.x = pk2(a[0], a[1]); o.y = pk2(a[2], a[3]); o.z = pk2(a[4], a[5]); o.w = pk2(a[6], a[7]); *(uint4*)(x.p + c.f0) = o; }
    DEVI void storeh(const ColCtx&, const RowCtx&, int, const float (&)[8]) const {}
    DEVI void store(int, int, int, const float (&)[8]) const {}
};
struct FMoe2 {
    static constexpr bool HOIST = true, PAIR = false, RV = true; static constexpr int NT = 4;
    const bf16_t* A; const bf16_t* B; int K; const int* cnt; const float* b_down; bf16_t* Y2; const LAS int* ub; int G;
    struct ColCtx { float bd[8]; }; struct RowCtx { bf16_t* p; };
    DEVI int ubs(int e) const { return __builtin_amdgcn_readfirstlane(ub[e]); }
    DEVI int nunits() const { const int n = ubs(NEXP) * NT; return (G & 7) == 0 ? (n + G - 1) / G * G : n; }
    DEVI void unit(int L, int& z, int& pm, int& pn) const { moe_unit<NT, RV>(ub, L, G, z, pm, pn); }
    DEVI int M(int z) const { return z < 0 ? 0 : cnt[z]; }
    DEVI unsigned aoffb(int z, int r) const { return (unsigned)(ubs(z < 0 ? 0 : z) * 256 + r) * (unsigned)(DFF * 2); }
    DEVI const bf16_t* Bt(int z) const { return B + (size_t)(z < 0 ? 0 : z) * DM * DFF; }
    DEVI ColCtx colctx(int z, int c0) const { ColCtx c; const float* bp = b_down + (size_t)(z < 0 ? 0 : z) * DM + c0; const float4 a = *(const float4*)bp, b = *(const float4*)(bp + 4);
        c.bd[0] = a.x; c.bd[1] = a.y; c.bd[2] = a.z; c.bd[3] = a.w; c.bd[4] = b.x; c.bd[5] = b.y; c.bd[6] = b.z; c.bd[7] = b.w; return c; }
    DEVI RowCtx rowctx(int z, int r, bool) const { RowCtx x; x.p = Y2 + (size_t)(ubs(z < 0 ? 0 : z) * 256 + r) * DM; return x; }
    DEVI void storeh(const ColCtx& c, const RowCtx& x, int c0, const float (&v)[8]) const {
        uint4 o; o.x = pk2(v[0] + c.bd[0], v[1] + c.bd[1]); o.y = pk2(v[2] + c.bd[2], v[3] + c.bd[3]); o.z = pk2(v[4] + c.bd[4], v[5] + c.bd[5]); o.w = pk2(v[6] + c.bd[6], v[7] + c.bd[7]);
        *(uint4*)(x.p + c0) = o; }
    DEVI void store(int, int, int, const float (&)[8]) const {}
};

struct MArgs { const float* in[30]; float* out; unsigned char* ws; int ph_lo, ph_hi; };
struct MArgs_in { const float *lam_re, *lam_im, *log_dt, *b_re, *b_im, *c_re, *c_im; };

constexpr int GL_LRS = 0, GL_TOT = 8192, GL_QF = 12288, GL_KF = 21504, GL_QB = 30720, GL_KB = 39936, GL_VT = 49152, GL_PP = 67584, GL_SSQ = 76800, GL_UST = 67584;
constexpr int GL_LD = 72;

struct GlaPtrs { const bf16_t* QK; const bf16_t* V; const bf16_t* R; const float* LR; const float* lr_up; const float* lr_bias; const float* nw; bf16_t* UCH; float* ADEC; bf16_t* SST; bf16_t* MIX; };

DEVI void gla_gates(const GlaPtrs& G, LAS unsigned char* lds, int h, int d, int to, float (&cf)[8], float (&cb)[8]) {
    const LAS float* LRS = (const LAS float*)(lds + GL_LRS); LAS float* TOT = (LAS float*)(lds + GL_TOT);
#pragma unroll
    for (int dir = 0; dir < 2; ++dir) {
        float up[16];
#pragma unroll
        for (int r = 0; r < 16; ++r) up[r] = G.lr_up[dir * 4096 + r * 256 + h * 64 + d];
        const float bias = G.lr_bias[dir * 256 + h * 64 + d];
        float la[8];
#pragma unroll
        for (int j = 0; j < 8; ++j) { const LAS f32x4* lp = (const LAS f32x4*)(LRS + (to * 8 + j) * 32 + dir * 16); float g = bias;
#pragma unroll
            for (int q = 0; q < 4; ++q) { const f32x4 x = lp[q]; g += x[0] * up[4 * q] + x[1] * up[4 * q + 1] + x[2] * up[4 * q + 2] + x[3] * up[4 * q + 3]; }
            la[j] = logsigmoidf_(g) * (1.f / 16.f); }
        if (dir == 0) { cf[0] = la[0];
#pragma unroll
            for (int j = 1; j < 8; ++j) cf[j] = cf[j - 1] + la[j];
            TOT[(0 * 8 + to) * 64 + d] = cf[7]; }
        else { cb[7] = la[7];
#pragma unroll
            for (int j = 6; j >= 0; --j) cb[j] = cb[j + 1] + la[j];
            TOT[(1 * 8 + to) * 64 + d] = cb[0]; }
    }
}
DEVI void gla_stage(const GlaPtrs& G, LAS unsigned char* lds, int row0, int h, int tid) {
    *(LAS f32x4*)(lds + GL_LRS + tid * 16) = *(const f32x4*)(G.LR + (size_t)row0 * 32 + tid * 4);
    const int ep = tid & 63, to = tid >> 6; unsigned w[8];
#pragma unroll
    for (int j = 0; j < 8; ++j) w[j] = *(const unsigned*)(G.V + (size_t)(row0 + to * 8 + j) * 512 + h * 128 + 2 * ep);
    u32x4 lo, hi;
    lo.x = (w[0] & 0xffffu) | (w[1] << 16); lo.y = (w[2] & 0xffffu) | (w[3] << 16); lo.z = (w[4] & 0xffffu) | (w[5] << 16); lo.w = (w[6] & 0xffffu) | (w[7] << 16);
    hi.x = (w[0] >> 16) | (w[1] & 0xffff0000u); hi.y = (w[2] >> 16) | (w[3] & 0xffff0000u); hi.z = (w[4] >> 16) | (w[5] & 0xffff0000u); hi.w = (w[6] >> 16) | (w[7] & 0xffff0000u);
    *(LAS u32x4*)(lds + GL_VT + ((2 * ep) * GL_LD + to * 8) * 2) = lo;
    *(LAS u32x4*)(lds + GL_VT + ((2 * ep + 1) * GL_LD + to * 8) * 2) = hi;
}

DEVI void gla_a_item(const GlaPtrs& G, LAS unsigned char* lds, int item) {
    int tid = threadIdx.x; asm volatile("" : "+v"(tid));
    const int wave = __builtin_amdgcn_readfirstlane(tid >> 6), lane = tid & 63, d = lane, to = wave, fr = lane & 15, fq = lane >> 4;
    const int ch = item % 68, bh = item / 68, h = bh & 3, b = bh >> 2;
    const int row0 = ch < 4 ? NTOK + b * CTX + ch * 64 : b * SEQ + (ch - 4) * 64;
    gla_stage(G, lds, row0, h, tid);
    bf16_t kk[8];
#pragma unroll
    for (int j = 0; j < 8; ++j) kk[j] = G.QK[(size_t)(row0 + to * 8 + j) * 512 + 256 + h * 64 + d];
    __syncthreads();
    float cf[8], cb[8];
    gla_gates(G, lds, h, d, to, cf, cb);
    __syncthreads();
    const LAS float* TOT = (const LAS float*)(lds + GL_TOT);
    float offf = 0.f, offb = 0.f, totf = 0.f, totb = 0.f;
#pragma unroll
    for (int t = 0; t < 8; ++t) { const float a = TOT[(0 * 8 + t) * 64 + d], c = TOT[(1 * 8 + t) * 64 + d]; totf += a; totb += c; if (t < to) offf += a; if (t > to) offb += c; }
    float of[8], ob[8];
#pragma unroll
    for (int j = 0; j < 8; ++j) { const float kf = bf2f(kk[j]); of[j] = kf * __expf(totf - (cf[j] + offf)); ob[j] = kf * __expf(totb - (cb[j] + offb)); }
    { u32x4 w; w.x = pk2(of[0], of[1]); w.y = pk2(of[2], of[3]); w.z = pk2(of[4], of[5]); w.w = pk2(of[6], of[7]); *(LAS u32x4*)(lds + GL_QF + (d * GL_LD + to * 8) * 2) = w;
      w.x = pk2(ob[0], ob[1]); w.y = pk2(ob[2], ob[3]); w.z = pk2(ob[4], ob[5]); w.w = pk2(ob[6], ob[7]); *(LAS u32x4*)(lds + GL_KF + (d * GL_LD + to * 8) * 2) = w; }
    const int chain_f = bh * 2, step_f = ch < 4 ? ch : ch, step_b = ch < 4 ? 3 - ch : 4 + (67 - ch);
    if (to == 0) { G.ADEC[((size_t)chain_f * 68 + step_f) * 64 + d] = __expf(totf); G.ADEC[((size_t)(chain_f + 1) * 68 + step_b) * 64 + d] = __expf(totb); }
    __syncthreads();
    f32x4 acc[2][4];
#pragma unroll
    for (int dr = 0; dr < 2; ++dr)
#pragma unroll
        for (int dt = 0; dt < 4; ++dt) acc[dr][dt] = (f32x4){0.f, 0.f, 0.f, 0.f};
#pragma unroll
    for (int ks = 0; ks < 2; ++ks) { const bf16x8 a = *(const LAS bf16x8*)(lds + GL_VT + ((wave * 16 + fr) * GL_LD + ks * 32 + fq * 8) * 2);
#pragma unroll
        for (int dt = 0; dt < 4; ++dt) { const bf16x8 b0 = *(const LAS bf16x8*)(lds + GL_QF + ((dt * 16 + fr) * GL_LD + ks * 32 + fq * 8) * 2);
            const bf16x8 b1 = *(const LAS bf16x8*)(lds + GL_KF + ((dt * 16 + fr) * GL_LD + ks * 32 + fq * 8) * 2);
            acc[0][dt] = __builtin_amdgcn_mfma_f32_16x16x32_bf16(a, b0, acc[0][dt], 0, 0, 0); acc[1][dt] = __builtin_amdgcn_mfma_f32_16x16x32_bf16(a, b1, acc[1][dt], 0, 0, 0); } }
#pragma unroll
    for (int dr = 0; dr < 2; ++dr)
#pragma unroll
        for (int dt = 0; dt < 4; ++dt)
#pragma unroll
            for (int rg = 0; rg < 4; ++rg) *(LAS bf16_t*)(lds + GL_UST + ((dr * 128 + wave * 16 + 4 * fq + rg) * 64 + dt * 16 + fr) * 2) = f2bf(acc[dr][dt][rg]);
    __syncthreads();
#pragma unroll
    for (int i = 0; i < 4; ++i) { const int q = tid + i * NTHR, dr = q >> 10, off = (q & 1023) * 8;
        const u32x4 w = *(const LAS u32x4*)(lds + GL_UST + (dr * 8192 + off) * 2);
        const size_t chain = (size_t)chain_f + dr; const int step = dr ? step_b : step_f;
        *(u32x4*)(G.UCH + (chain * 68 + step) * 8192 + off) = w; }
    __syncthreads();
}

DEVI void gla_b_block(const GlaPtrs& G, LAS unsigned char* lds, int blk) {
    int tid = threadIdx.x; asm volatile("" : "+v"(tid));
    const int chain = blk >> 2, e = (blk & 3) * 32 + (tid >> 4), d4 = (tid & 15) * 4;
    for (int i = tid; i < 68 * 16; i += NTHR) ((LAS f32x4*)lds)[i] = ((const f32x4*)(G.ADEC + (size_t)chain * 68 * 64))[i];
    __syncthreads();
    const bf16_t* up = G.UCH + ((size_t)chain * 68 * 128 + e) * 64 + d4;
    bf16_t* sp = G.SST + ((size_t)chain * 64 * 128 + e) * 64 + d4;
    float S0 = 0.f, S1 = 0.f, S2 = 0.f, S3 = 0.f;
    uint2 cur[17], nxt[17];
#pragma unroll
    for (int j = 0; j < 17; ++j) cur[j] = *(const uint2*)(up + (size_t)j * 8192);
#pragma unroll 1
    for (int bt = 0; bt < 4; ++bt) {
        if (bt < 3) {
#pragma unroll
            for (int j = 0; j < 17; ++j) nxt[j] = *(const uint2*)(up + (size_t)((bt + 1) * 17 + j) * 8192); }
#pragma unroll
        for (int j = 0; j < 17; ++j) { const int step = bt * 17 + j;
            if (step >= 4) { uint2 o; o.x = pk2(S0, S1); o.y = pk2(S2, S3); *(uint2*)(sp + (size_t)(step - 4) * 8192) = o; }
            const f32x4 a = *(const LAS f32x4*)(lds + (step * 64 + d4) * 4);
            S0 = a[0] * S0 + __uint_as_float(cur[j].x << 16); S1 = a[1] * S1 + __uint_as_float(cur[j].x & 0xffff0000u);
            S2 = a[2] * S2 + __uint_as_float(cur[j].y << 16); S3 = a[3] * S3 + __uint_as_float(cur[j].y & 0xffff0000u); }
#pragma unroll
        for (int j = 0; j < 17; ++j) cur[j] = nxt[j];
    }
    __syncthreads();
}

DEVI void gla_c_item(const GlaPtrs& G, LAS unsigned char* lds, int item) {
    int tid = threadIdx.x; asm volatile("" : "+v"(tid));
    const int wave = __builtin_amdgcn_readfirstlane(tid >> 6), lane = tid & 63, d = lane, to = wave, fr = lane & 15, fq = lane >> 4;
    const int c = item & 63, bh = item >> 6, h = bh & 3, b = bh >> 2;
    const int row0 = b * SEQ + c * 64;
    gla_stage(G, lds, row0, h, tid);
    bf16_t qq[8], kk[8];
#pragma unroll
    for (int j = 0; j < 8; ++j) { const size_t o = (size_t)(row0 + to * 8 + j) * 512 + h * 64 + d; qq[j] = G.QK[o]; kk[j] = G.QK[o + 256]; }
    __syncthreads();
    float cf[8], cb[8];
    gla_gates(G, lds, h, d, to, cf, cb);
    __syncthreads();
    { const LAS float* TOT = (const LAS float*)(lds + GL_TOT);
      float offf = 0.f, offb = 0.f;
#pragma unroll
      for (int t = 0; t < 8; ++t) { if (t < to) offf += TOT[(0 * 8 + t) * 64 + d]; if (t > to) offb += TOT[(1 * 8 + t) * 64 + d]; }
#pragma unroll
      for (int j = 0; j < 8; ++j) { const float qf = bf2f(qq[j]) * 0.125f, kf = bf2f(kk[j]);
          const float ef = __expf(fmaxf(cf[j] + offf, -80.f)), eb = __expf(fmaxf(cb[j] + offb, -80.f));
          const int o = ((to * 8 + j) * GL_LD + d) * 2;
          *(LAS bf16_t*)(lds + GL_QF + o) = f2bf(qf * ef); *(LAS bf16_t*)(lds + GL_KF + o) = f2bf(kf * __builtin_amdgcn_rcpf(ef));
          *(LAS bf16_t*)(lds + GL_QB + o) = f2bf(qf * eb); *(LAS bf16_t*)(lds + GL_KB + o) = f2bf(kf * __builtin_amdgcn_rcpf(eb)); } }
    __syncthreads();
    { const int ti = wave >> 1;
#pragma unroll
      for (int u = 0; u < 2; ++u) { const int tj = (wave & 1) * 2 + u;
          f32x4 af = (f32x4){0.f, 0.f, 0.f, 0.f}, ab = (f32x4){0.f, 0.f, 0.f, 0.f};
          if (tj <= ti) {
#pragma unroll
              for (int ks = 0; ks < 2; ++ks) { const bf16x8 a = *(const LAS bf16x8*)(lds + GL_KF + ((tj * 16 + fr) * GL_LD + ks * 32 + fq * 8) * 2), bb = *(const LAS bf16x8*)(lds + GL_QF + ((ti * 16 + fr) * GL_LD + ks * 32 + fq * 8) * 2);
                  af = __builtin_amdgcn_mfma_f32_16x16x32_bf16(a, bb, af, 0, 0, 0); } }
          if (tj >= ti) {
#pragma unroll
              for (int ks = 0; ks < 2; ++ks) { const bf16x8 a = *(const LAS bf16x8*)(lds + GL_KB + ((tj * 16 + fr) * GL_LD + ks * 32 + fq * 8) * 2), bb = *(const LAS bf16x8*)(lds + GL_QB + ((ti * 16 + fr) * GL_LD + ks * 32 + fq * 8) * 2);
                  ab = __builtin_amdgcn_mfma_f32_16x16x32_bf16(a, bb, ab, 0, 0, 0); } }
          float p[4];
#pragma unroll
          for (int rg = 0; rg < 4; ++rg) { const int i = ti * 16 + fr, j = tj * 16 + 4 * fq + rg; p[rg] = (j <= i ? af[rg] : 0.f) + (j >= i ? ab[rg] : 0.f); }
          u32x2 w; w.x = pk2(p[0], p[1]); w.y = pk2(p[2], p[3]);
          *(LAS u32x2*)(lds + GL_PP + ((ti * 16 + fr) * GL_LD + tj * 16 + 4 * fq) * 2) = w; } }
    __syncthreads();
    const int tg = wave & 3, eh = wave >> 2;
    f32x4 acc[4];
#pragma unroll
    for (int et = 0; et < 4; ++et) acc[et] = (f32x4){0.f, 0.f, 0.f, 0.f};
    { const bf16_t* Sf = G.SST + ((size_t)(bh * 2) * 64 + c) * 8192; const bf16_t* Sb = G.SST + ((size_t)(bh * 2 + 1) * 64 + (63 - c)) * 8192;
#pragma unroll
      for (int ks = 0; ks < 2; ++ks) {
          const int bo = ((tg * 16 + fr) * GL_LD + ks * 32 + fq * 8) * 2;
          const bf16x8 bP = *(const LAS bf16x8*)(lds + GL_PP + bo), bF = *(const LAS bf16x8*)(lds + GL_QF + bo), bB = *(const LAS bf16x8*)(lds + GL_QB + bo);
#pragma unroll
          for (int et = 0; et < 4; ++et) { const int e = eh * 64 + et * 16 + fr;
              const bf16x8 aV = *(const LAS bf16x8*)(lds + GL_VT + (e * GL_LD + ks * 32 + fq * 8) * 2);
              const bf16x8 aF = *(const bf16x8*)(Sf + e * 64 + ks * 32 + fq * 8), aB = *(const bf16x8*)(Sb + e * 64 + ks * 32 + fq * 8);
              acc[et] = __builtin_amdgcn_mfma_f32_16x16x32_bf16(aV, bP, acc[et], 0, 0, 0);
              acc[et] = __builtin_amdgcn_mfma_f32_16x16x32_bf16(aF, bF, acc[et], 0, 0, 0);
              acc[et] = __builtin_amdgcn_mfma_f32_16x16x32_bf16(aB, bB, acc[et], 0, 0, 0); } } }
    float ss = 0.f;
#pragma unroll
    for (int et = 0; et < 4; ++et) ss += acc[et][0] * acc[et][0] + acc[et][1] * acc[et][1] + acc[et][2] * acc[et][2] + acc[et][3] * acc[et][3];
    ss += __shfl_xor(ss, 16); ss += __shfl_xor(ss, 32);
    LAS float* SSQ = (LAS float*)(lds + GL_SSQ);
    if (fq == 0) SSQ[eh * 64 + tg * 16 + fr] = ss;
    __syncthreads();
    const float rstd = rsqrtf((SSQ[tg * 16 + fr] + SSQ[64 + tg * 16 + fr]) * (1.f / 128.f) + 1e-6f);
    const int tok = row0 + tg * 16 + fr;
#pragma unroll
    for (int et = 0; et < 4; ++et) { const int e = eh * 64 + et * 16 + 4 * fq;
        const uint2 rv = *(const uint2*)(G.R + (size_t)tok * 512 + h * 128 + e); const f32x4 nw = *(const f32x4*)(G.nw + e);
        const float r0 = __uint_as_float(rv.x << 16), r1 = __uint_as_float(rv.x & 0xffff0000u), r2 = __uint_as_float(rv.y << 16), r3 = __uint_as_float(rv.y & 0xffff0000u);
        uint2 w; w.x = pk2(acc[et][0] * rstd * nw[0] * siluf_(r0), acc[et][1] * rstd * nw[1] * siluf_(r1)); w.y = pk2(acc[et][2] * rstd * nw[2] * siluf_(r2), acc[et][3] * rstd * nw[3] * siluf_(r3));
        *(uint2*)(G.MIX + (size_t)tok * DM + h * 128 + e) = w; }
    __syncthreads();
}

DEVI void s5w_build(const MArgs_in& in, unsigned char* ws, LAS unsigned char* lds, int g) {
    LAS float* LP = (LAS float*)lds;
    LAS float* BB = LP + 2 * 17 * 64 * 2;
    LAS float* CC = BB + 2 * 64 * 16 * 2;
    LAS float* KK = CC + 2 * 16 * 64 * 2;
    LAS float* CO = KK + 2 * 16 * 256;
    const int tid = threadIdx.x;
    S5P* P = (S5P*)(ws + OFF_S5P);
    for (int t = tid; t < 2 * 64 * 17; t += NTHR) { const int n = t % 17, p = (t / 17) & 63, d = t / (17 * 64); const int i = (d * 32 + g) * 64 + p;
        const double dt = exp((double)in.log_dt[d * 32 + g]), lr = in.lam_re[i], li = in.lam_im[i];
        const double mag = exp(n * lr * dt), ar = mag * cos(n * li * dt), ai = mag * sin(n * li * dt);
        LP[((d * 17 + n) * 64 + p) * 2] = (float)ar; LP[((d * 17 + n) * 64 + p) * 2 + 1] = (float)ai;
        if (n == 1) { const double nr = ar - 1.0, ni = ai, den = lr * lr + li * li; CO[(d * 64 + p) * 2] = (float)((nr * lr + ni * li) / den); CO[(d * 64 + p) * 2 + 1] = (float)((ni * lr - nr * li) / den); }
        if (n == 16) { P->lam16[d][g][p][0] = (float)ar; P->lam16[d][g][p][1] = (float)ai; } }
    for (int t = tid; t < 2 * 16 * 64; t += NTHR) { const int p = t & 63, h = (t >> 6) & 15, d = t >> 10; const size_t ix = (((size_t)d * 32 + g) * 16 + h) * 64 + p;
        CC[((d * 16 + h) * 64 + p) * 2] = in.c_re[ix]; CC[((d * 16 + h) * 64 + p) * 2 + 1] = in.c_im[ix]; }
    __syncthreads();
    for (int t = tid; t < 2 * 64 * 16; t += NTHR) { const int h = t & 15, p = (t >> 4) & 63, d = t >> 10; const size_t ix = (((size_t)d * 32 + g) * 64 + p) * 16 + h;
        const float br = in.b_re[ix], bi = in.b_im[ix], cr = CO[(d * 64 + p) * 2], ci = CO[(d * 64 + p) * 2 + 1];
        BB[((d * 64 + p) * 16 + h) * 2] = cr * br - ci * bi; BB[((d * 64 + p) * 16 + h) * 2 + 1] = cr * bi + ci * br; }
    __syncthreads();
    for (int t = tid; t < 2 * 16 * 256; t += NTHR) { const int hp = t & 15, h = (t >> 4) & 15, n = (t >> 8) & 15, d = t >> 12; float acc = 0.f;
        for (int p = 0; p < 64; ++p) { const float cr = CC[((d * 16 + h) * 64 + p) * 2], ci = CC[((d * 16 + h) * 64 + p) * 2 + 1], lr = LP[((d * 17 + n) * 64 + p) * 2], li = LP[((d * 17 + n) * 64 + p) * 2 + 1];
            const float tr = cr * lr - ci * li, ti = cr * li + ci * lr; acc += tr * BB[((d * 64 + p) * 16 + hp) * 2] - ti * BB[((d * 64 + p) * 16 + hp) * 2 + 1]; }
        KK[(d * 16 + n) * 256 + h * 16 + hp] = acc; }
    __syncthreads();
    bf16_t* BF = (bf16_t*)(ws + OFF_S5BF) + (size_t)g * 256 * 256;
    for (int t = tid; t < 256 * 32; t += NTHR) { const int k8 = t & 31, row = t >> 5, p = row & 63, im = (row >> 6) & 1, d = row >> 7; float o[8];
#pragma unroll
        for (int q = 0; q < 8; ++q) { const int k = k8 * 8 + q, j = k >> 4, hp = k & 15, pw = d ? j : 15 - j;
            const float lr = LP[((d * 17 + pw) * 64 + p) * 2], li = LP[((d * 17 + pw) * 64 + p) * 2 + 1], br = BB[((d * 64 + p) * 16 + hp) * 2], bi = BB[((d * 64 + p) * 16 + hp) * 2 + 1];
            o[q] = im ? lr * bi + li * br : lr * br - li * bi; }
        uint4 w; w.x = pk2(o[0], o[1]); w.y = pk2(o[2], o[3]); w.z = pk2(o[4], o[5]); w.w = pk2(o[6], o[7]);
        *(uint4*)(BF + (size_t)row * 256 + k8 * 8) = w; }
    bf16_t* BY = (bf16_t*)(ws + OFF_S5BY) + (size_t)g * 256 * 512;
    for (int t = tid; t < 256 * 64; t += NTHR) { const int k8 = t & 63, n = t >> 6, i = n >> 4, h = n & 15; float o[8];
#pragma unroll
        for (int q = 0; q < 8; ++q) { const int k = k8 * 8 + q; float v;
            if (k < 256) { const int j = k >> 4, hp = k & 15; v = 0.f; if (i >= j) v += KK[(0 * 16 + (i - j)) * 256 + h * 16 + hp]; if (j >= i) v += KK[(1 * 16 + (j - i)) * 256 + h * 16 + hp]; }
            else { const int d = (k - 256) >> 7, r = (k - 256) & 127, p = r & 63, im = r >> 6, pw = d ? 16 - i : i + 1;
                const float cr = CC[((d * 16 + h) * 64 + p) * 2], ci = CC[((d * 16 + h) * 64 + p) * 2 + 1], lr = LP[((d * 17 + pw) * 64 + p) * 2], li = LP[((d * 17 + pw) * 64 + p) * 2 + 1];
                v = im ? -(cr * li + ci * lr) : cr * lr - ci * li; }
            o[q] = v; }
        uint4 w; w.x = pk2(o[0], o[1]); w.y = pk2(o[2], o[3]); w.z = pk2(o[4], o[5]); w.w = pk2(o[6], o[7]);
        *(uint4*)(BY + (size_t)n * 512 + k8 * 8) = w; }
    __syncthreads();
}
struct ProbS5F {
    static constexpr bool HOIST = false, PAIR = false;
    const bf16_t* A; const bf16_t* B; int K; float* F;
    DEVI int nunits() const { return 32 * 9; }
    DEVI void unit(int L, int& z, int& pm, int& pn) const { z = L & 31; pm = L >> 5; pn = 0; }
    DEVI int M(int) const { return 2304; }
    DEVI unsigned aoffb(int z, int r) const { return (unsigned)(z * 2304 + r) * 1024u; }
    DEVI const bf16_t* Bt(int z) const { return B + (size_t)z * 256 * 256; }
    DEVI void store(int z, int r, int c0, const float (&v)[8]) const { float* p = F + ((size_t)z * 2304 + r) * 256 + c0; *(float4*)p = make_float4(v[0], v[1], v[2], v[3]); *(float4*)(p + 4) = make_float4(v[4], v[5], v[6], v[7]); }
};
struct ProbS5Y {
    static constexpr bool HOIST = false, PAIR = false;
    const bf16_t* A; const bf16_t* B; int K; const float* dvec; bf16_t* YS;
    DEVI int nunits() const { return 32 * 8; }
    DEVI void unit(int L, int& z, int& pm, int& pn) const { z = L & 31; pm = L >> 5; pn = 0; }
    DEVI int M(int) const { return 2048; }
    DEVI unsigned aoffb(int z, int r) const { return (unsigned)(z * 2304 + r) * 1024u; }
    DEVI const bf16_t* Bt(int z) const { return B + (size_t)z * 256 * 512; }
    DEVI void store(int z, int r, int c0, const float (&v)[8]) const {
        const int b = r >> 8, sq = ((r & 255) << 4) + (c0 >> 4), gc = sq >> 6, gr = sq & 63, tok = b * SEQ + gr * 64 + gc, ch = z * 16 + (c0 & 15);
        const uint4 uv = *(const uint4*)(A + ((size_t)z * 2304 + r) * 512 + c0); const unsigned uw[4] = {uv.x, uv.y, uv.z, uv.w};
        const float4 d0 = *(const float4*)(dvec + ch), d1 = *(const float4*)(dvec + ch + 4); const float dd[8] = {d0.x, d0.y, d0.z, d0.w, d1.x, d1.y, d1.z, d1.w}; float o[8];
#pragma unroll
        for (int j = 0; j < 4; ++j) { o[2 * j] = gelu_tanh(v[2 * j] + dd[2 * j] * __uint_as_float(uw[j] << 16)); o[2 * j + 1] = gelu_tanh(v[2 * j + 1] + dd[2 * j + 1] * __uint_as_float(uw[j] & 0xffff0000u)); }
        uint4 w; w.x = pk2(o[0], o[1]); w.y = pk2(o[2], o[3]); w.z = pk2(o[4], o[5]); w.w = pk2(o[6], o[7]);
        *(uint4*)(YS + (size_t)tok * 512 + ch) = w;
    }
};
DEVI void s5_carry(const float* __restrict__ F, bf16_t* __restrict__ U2, const S5P* __restrict__ P, int id, int lane) {
    const int g = id & 31, dir = (id >> 5) & 1, b = id >> 6;
    const float l16r = P->lam16[dir][g][lane][0], l16i = P->lam16[dir][g][lane][1];
    const float* Fg = F + (size_t)g * 2304 * 256 + dir * 128 + lane;
    bf16_t* Ug = U2 + (size_t)g * 2304 * 512 + 256 + dir * 128 + lane;
    float hr = 0.f, hi = 0.f;
    float fr[16], fi[16], nr[16], ni[16];
#define S5_ROW(bt, j) ((bt) == 0 ? 2048 + b * 16 + (dir ? 15 - (j) : (j)) : b * 256 + (dir ? 255 - (((bt) - 1) * 16 + (j)) : ((bt) - 1) * 16 + (j)))
#pragma unroll
    for (int j = 0; j < 16; ++j) { const int row = S5_ROW(0, j); fr[j] = Fg[(size_t)row * 256]; fi[j] = Fg[(size_t)row * 256 + 64]; }
    for (int bt = 0; bt < 17; ++bt) {
        if (bt < 16) {
#pragma unroll
            for (int j = 0; j < 16; ++j) { const int row = S5_ROW(bt + 1, j); nr[j] = Fg[(size_t)row * 256]; ni[j] = Fg[(size_t)row * 256 + 64]; } }
#pragma unroll
        for (int j = 0; j < 16; ++j) {
            if (bt > 0) { const int row = S5_ROW(bt, j); Ug[(size_t)row * 512] = f2bf(hr); Ug[(size_t)row * 512 + 64] = f2bf(hi); }
            const float tr = l16r * hr - l16i * hi + fr[j], ti = l16r * hi + l16i * hr + fi[j]; hr = tr; hi = ti; }
#pragma unroll
        for (int j = 0; j < 16; ++j) { fr[j] = nr[j]; fi[j] = ni[j]; }
    }
#undef S5_ROW
}


constexpr int NPH = 12;

struct WItem { const float* src; bf16_t* dst; int K, N, mode, n0, k0; bool act; };
DEVI WItem wconv_decode(const MArgs& a, unsigned char* ws, int it) {
    constexpr int I0 = 36 * 8, I1 = I0 + 8 * 4, I2 = I1 + 16 * 8, I3 = I2 + 32 * 32 * 8, I4 = I3 + 32 * 16 * 8;
    WItem w; w.src = nullptr; w.dst = nullptr; w.K = 0; w.N = 0; w.mode = 0; w.n0 = 0; w.k0 = 0; w.act = it < I4;
    if (w.act) {
        if (it < I0) { w.src = a.in[7]; w.dst = (bf16_t*)(ws + OFF_WIN); w.K = DM; w.N = INC; w.n0 = (it % 36) * 64; w.k0 = (it / 36) * 128; }
        else if (it < I1) { const int r = it - I0; w.src = a.in[19]; w.dst = (bf16_t*)(ws + OFF_WGLU); w.K = 512; w.N = 512; w.n0 = (r % 8) * 64; w.k0 = (r / 8) * 128; }
        else if (it < I2) { const int r = it - I1; w.src = a.in[21]; w.dst = (bf16_t*)(ws + OFF_WOUT); w.K = DM; w.N = DM; w.n0 = (r % 16) * 64; w.k0 = (r / 16) * 128; }
        else if (it < I3) { const int r = it - I2, e = r / 256, q = r % 256; w.src = a.in[25] + (size_t)e * DM * 2048; w.dst = (bf16_t*)(ws + OFF_WG) + (size_t)e * 2048 * DM; w.K = DM; w.N = 2048; w.mode = 1; w.n0 = (q % 32) * 64; w.k0 = (q / 32) * 128; }
        else { const int r = it - I3, e = r / 128, q = r % 128; w.src = a.in[27] + (size_t)e * DFF * DM; w.dst = (bf16_t*)(ws + OFF_WD) + (size_t)e * DM * DFF; w.K = DFF; w.N = DM; w.n0 = (q % 16) * 64; w.k0 = (q / 16) * 128; }
    }
    return w;
}
DEVI void wconv_load(const WItem& w, int ht, f32x4 (&r)[8]) {
    const int l16 = ht & 15, kr = ht >> 4;
    const int col = (w.mode ? ((w.n0 >> 7) & 1) * 1024 + (w.n0 >> 8) * 128 + (w.n0 & 127) : w.n0) + 4 * l16;
    const bool ok = w.act && col < w.N;
#pragma unroll
    for (int i = 0; i < 8; ++i) r[i] = ok ? *(const f32x4*)(w.src + (size_t)(w.k0 + kr + 16 * i) * w.N + col) : (f32x4){0.f, 0.f, 0.f, 0.f};
}
DEVI void ph_prep(const MArgs& a, LAS unsigned char* lds, int bid, int G) {
    const int tid = threadIdx.x, wave = tid >> 6, lane = tid & 63;
    unsigned char* ws = a.ws;
    if (bid < 96) {
        LAS float* s = (LAS float*)lds; LAS float* part = (LAS float*)(lds + 36864);
        const float* c = a.in[1]; const float* cc = a.in[3]; const float* ada_w = a.in[4]; const float* ada_b = a.in[5]; float* mod = (float*)(ws + OFF_MOD);
        for (int i = tid; i < 9216; i += NTHR) { const int r = i >> 10, k = i & 1023; const float v = r < 8 ? c[r * 1024 + k] : cc[k]; s[i] = siluf_(v); }
        __syncthreads();
        const int j = bid * 64 + lane; float acc[9];
#pragma unroll
        for (int r = 0; r < 9; ++r) acc[r] = 0.f;
#pragma unroll 4
        for (int k = wave * 128; k < wave * 128 + 128; ++k) { const float w = ada_w[(size_t)k * 6144 + j];
#pragma unroll
            for (int r = 0; r < 9; ++r) acc[r] += s[r * 1024 + k] * w; }
#pragma unroll
        for (int r = 0; r < 9; ++r) part[(wave * 9 + r) * 64 + lane] = acc[r];
        __syncthreads();
        for (int i = tid; i < 576; i += NTHR) { const int r = i >> 6, l = i & 63; float sum = 0.f;
#pragma unroll
            for (int w = 0; w < 8; ++w) sum += part[(w * 9 + r) * 64 + l];
            mod[r * 6144 + bid * 64 + l] = sum + ada_b[bid * 64 + l]; }
        __syncthreads();
    } else if (bid < 104) {
        s5prep_one(a.in[11], a.in[12], a.in[13], a.in[14], a.in[15], (S5P*)(ws + OFF_S5P), (bid - 96) * NTHR + tid);
    }
    else if (bid < 136) { MArgs_in in{a.in[11], a.in[12], a.in[13], a.in[14], a.in[15], a.in[16], a.in[17]}; s5w_build(in, ws, lds, bid - 104); }
    { constexpr int I4 = 36 * 8 + 8 * 4 + 16 * 8 + 32 * 32 * 8 + 32 * 16 * 8;
      const int half = tid >> 8, ht = tid & 255; LAS float* t = (LAS float*)(lds + half * 33280);
      const int l16 = ht & 15, kr = ht >> 4;
      const bool worker = (G <= 136) || bid < 104 || bid >= 136;
      const int wid_ = (G <= 136) ? bid : (bid < 104 ? bid : bid - 32), GW = (G <= 136) ? G : G - 32;
      WItem cur = wconv_decode(a, ws, worker ? wid_ * 2 + half : I4); f32x4 rc[8]; wconv_load(cur, ht, rc);
      for (int base = worker ? wid_ * 2 : I4; base < I4; base += 2 * GW) {
          const WItem nxt = wconv_decode(a, ws, base + 2 * GW + half); f32x4 rn[8]; wconv_load(nxt, ht, rn);
          if (cur.act) { const int rb = 4 * l16;
#pragma unroll
              for (int i = 0; i < 8; ++i) { LAS float* q = t + (kr + 16 * i) * 65 + rb; q[0] = rc[i][0]; q[1] = rc[i][1]; q[2] = rc[i][2]; q[3] = rc[i][3]; } }
          __syncthreads();
          if (cur.act) {
#pragma unroll
              for (int i = 0; i < 4; ++i) { const int ch = ht + 256 * i, n = ch >> 4, c8 = ch & 15; const LAS float* q = t + (c8 * 8) * 65 + n;
                  uint4 o; o.x = pk2(q[0], q[65]); o.y = pk2(q[2 * 65], q[3 * 65]); o.z = pk2(q[4 * 65], q[5 * 65]); o.w = pk2(q[6 * 65], q[7 * 65]);
                  *(uint4*)(cur.dst + (size_t)(cur.n0 + n) * cur.K + cur.k0 + c8 * 8) = o; } }
          __syncthreads();
          cur = nxt;
#pragma unroll
          for (int i = 0; i < 8; ++i) rc[i] = rn[i];
      } }
}


DEVI void ph_router(const float* __restrict__ X1, const float* __restrict__ w, const float* __restrict__ mod, const float* __restrict__ rw, const float* __restrict__ rb,
                    bf16_t* __restrict__ H2, int* __restrict__ cnt, int* __restrict__ list, float* __restrict__ gate, int* __restrict__ epos, LAS unsigned char* lds, int bid, int G, bool commit) {
    int tid = threadIdx.x; asm volatile("" : "+v"(tid));
    const int wave = __builtin_amdgcn_readfirstlane(tid >> 6), lane = tid & 63, e16 = lane & 15, kq = lane >> 4;
    constexpr int HS = 1028;
    LAS float* hrow = (LAS float*)lds;
    LAS float* part = (LAS float*)(lds + 16 * HS * 4);
    LAS int* lcnt = (LAS int*)(lds + 16 * HS * 4 + 16384);
    LAS int* gbase = lcnt + 32; LAS int* ent = lcnt + 64;
    if (tid < 64) lcnt[tid] = 0;
    float wreg[2][32];
#pragma unroll
    for (int et = 0; et < 2; ++et)
#pragma unroll
        for (int q = 0; q < 32; ++q) wreg[et][q] = rw[(wave * 128 + kq * 32 + q) * 32 + et * 16 + e16];
    const float rbe = rb[lane & 31];
    const int per = (NTOK + G - 1) / G;
    const int t0 = bid * per, t1 = (t0 + per) < NTOK ? (t0 + per) : NTOK;
    float4 v[2][4];
#pragma unroll
    for (int u = 0; u < 2; ++u) { const int tok = t0 + wave * 2 + u; if (tok < t1) {
#pragma unroll
        for (int j = 0; j < 4; ++j) v[u][j] = *(const float4*)(X1 + (size_t)tok * DM + lane * 4 + 256 * j); } }
    for (int tb = t0; tb < t1; tb += 16) {
#pragma unroll
        for (int u = 0; u < 2; ++u) { const int tok = tb + wave * 2 + u;
            if (tok < t1) {
                const int b = tok / SEQ; float ss = 0.f;
#pragma unroll
                for (int j = 0; j < 4; ++j) ss += v[u][j].x * v[u][j].x + v[u][j].y * v[u][j].y + v[u][j].z * v[u][j].z + v[u][j].w * v[u][j].w;
                const float rstd = rsqrtf(wave_sum(ss) * (1.f / DM) + 1e-6f);
                const float* msh = mod + b * 6144 + 3072; const float* msc = mod + b * 6144 + 4096;
#pragma unroll
                for (int j = 0; j < 4; ++j) { const int k = lane * 4 + 256 * j;
                    const float4 ww = *(const float4*)(w + k), sc = *(const float4*)(msc + k), sh = *(const float4*)(msh + k);
                    f32x4 hv; hv[0] = v[u][j].x * rstd * ww.x * (1.f + sc.x) + sh.x; hv[1] = v[u][j].y * rstd * ww.y * (1.f + sc.y) + sh.y; hv[2] = v[u][j].z * rstd * ww.z * (1.f + sc.z) + sh.z; hv[3] = v[u][j].w * rstd * ww.w * (1.f + sc.w) + sh.w;
                    *(LAS f32x4*)(hrow + (wave * 2 + u) * HS + k) = hv;
                    uint2 o; o.x = pk2(hv[0], hv[1]); o.y = pk2(hv[2], hv[3]); *(uint2*)(H2 + (size_t)tok * DM + k) = o; }
            } else {
#pragma unroll
                for (int j = 0; j < 4; ++j) *(LAS f32x4*)(hrow + (wave * 2 + u) * HS + lane * 4 + 256 * j) = (f32x4){0.f, 0.f, 0.f, 0.f}; }
        }
#pragma unroll
        for (int u = 0; u < 2; ++u) { const int ntok = tb + 16 + wave * 2 + u; if (ntok < t1) {
#pragma unroll
            for (int j = 0; j < 4; ++j) v[u][j] = *(const float4*)(X1 + (size_t)ntok * DM + lane * 4 + 256 * j); } }
        __syncthreads();
        f32x4 acc0 = (f32x4){0.f, 0.f, 0.f, 0.f}, acc1 = (f32x4){0.f, 0.f, 0.f, 0.f};
#pragma unroll
        for (int i = 0; i < 8; ++i) { const f32x4 ar = *(const LAS f32x4*)(hrow + e16 * HS + wave * 128 + kq * 32 + 4 * i);
#pragma unroll
            for (int c = 0; c < 4; ++c) { acc0 = __builtin_amdgcn_mfma_f32_16x16x4f32(ar[c], wreg[0][4 * i + c], acc0, 0, 0, 0); acc1 = __builtin_amdgcn_mfma_f32_16x16x4f32(ar[c], wreg[1][4 * i + c], acc1, 0, 0, 0); } }
#pragma unroll
        for (int rg = 0; rg < 4; ++rg) { part[((wave * 2 + 0) * 16 + 4 * kq + rg) * 16 + e16] = acc0[rg]; part[((wave * 2 + 1) * 16 + 4 * kq + rg) * 16 + e16] = acc1[rg]; }
        __syncthreads();
        {
            const int t = wave * 2 + (lane >> 5), tk = tb + t, e = lane & 31, et = e >> 4, ee = e & 15;
            float lg = rbe;
#pragma unroll
            for (int q = 0; q < 8; ++q) lg += part[((q * 2 + et) * 16 + t) * 16 + ee];
            float val = lg; float tv[4]; int ti[4];
#pragma unroll
            for (int r = 0; r < 4; ++r) { float bv = val; int bi = e;
#pragma unroll
                for (int o = 1; o < 32; o <<= 1) { const float ov = __shfl_xor(bv, o); const int oi = __shfl_xor(bi, o); if (ov > bv || (ov == bv && oi < bi)) { bv = ov; bi = oi; } }
                tv[r] = bv; ti[r] = bi; if (e == bi) val = -3.0e38f; }
            const float e1 = __expf(tv[1] - tv[0]), e2 = __expf(tv[2] - tv[0]), e3 = __expf(tv[3] - tv[0]), inv = 1.f / (1.f + e1 + e2 + e3);
            if (e < 4 && tk < t1 && commit) { const float gv = e == 0 ? inv : e == 1 ? e1 * inv : e == 2 ? e2 * inv : e3 * inv; const int ex = e == 0 ? ti[0] : e == 1 ? ti[1] : e == 2 ? ti[2] : ti[3];
                const int ls = __hip_atomic_fetch_add(&lcnt[ex], 1, __ATOMIC_RELAXED, __HIP_MEMORY_SCOPE_WORKGROUP); ent[(tk - t0) * 4 + e] = (ex << 16) | ls; gate[tk * 4 + e] = gv; }
        }
    }
    __syncthreads();
    if (commit) {
        if (tid < NEXP) { const int c = lcnt[tid]; gbase[tid] = c ? atomicAdd(&cnt[tid], c) : 0; }
        __syncthreads();
        for (int i = tid; i < (t1 - t0) * 4; i += NTHR) { const int en = ent[i], ex = en >> 16, slot = gbase[ex] + (en & 0xffff), tk4 = t0 * 4 + i;
            list[ex * LISTCAP + slot] = tk4; epos[tk4] = ex * LISTCAP + slot; }
    }
    __syncthreads();
}

DEVI void build_ub(const int* cnt, volatile LAS int* ub) {
    if (threadIdx.x == 0) { int o = 0; for (int e = 0; e < NEXP; ++e) { ub[e] = o; o += (cnt[e] + 255) >> 8; } ub[NEXP] = o; }
    __syncthreads();
}

__global__ void __launch_bounds__(NTHR, 2) mega(MArgs a) {
    extern __shared__ __attribute__((aligned(16))) unsigned char lds_raw[];
    LAS unsigned char* lds = (LAS unsigned char*)lds_raw;
    volatile LAS unsigned* MISC = (volatile LAS unsigned*)(lds + MISC_OFF);
    const int tid = threadIdx.x, wave = __builtin_amdgcn_readfirstlane(tid >> 6), G = gridDim.x, bid = blockIdx.x;
    const int gw = bid * NWAVES + wave, NGW = G * NWAVES;
    for (int u = tid; u < MISC_BYTES / 4; u += NTHR) MISC[u] = 0u;
    __syncthreads();
    unsigned char* ws = a.ws; unsigned* ctl = (unsigned*)(ws + OFF_CTL);
    const bool multi = (a.ph_hi - a.ph_lo) > 1;
    XcdBarrier bar; bar.bar = ctl + CW_BAR; bar.x = 0; bar.st = MISC;
    if (multi) bar = xcd_barrier_post(ctl + CW_BAR, MISC);
    volatile LAS int* ub = (volatile LAS int*)(MISC + 16);
#ifndef PROBE_REP
#define PROBE_REP 0
#endif
#define IN(k) (a.ph_lo <= (k) && (k) < a.ph_hi)
#define NREP(k) (1 + ((PROBE_REP >> (k)) & 1))
#ifndef PROBE_VPH
#define PROBE_VPH -1
#endif
#ifndef PROBE_VMODE
#define PROBE_VMODE 1
#endif
#define FRESH_LANE int ft_ = threadIdx.x; asm volatile("" : "+v"(ft_)); const int lane = ft_ & 63; (void)lane
#define SEAM(k) do { if (IN(k) && IN((k) + 1)) xcd_barrier(bar); } while (0)
    float* mod = (float*)(ws + OFF_MOD); S5P* s5p = (S5P*)(ws + OFF_S5P); float* gate = (float*)(ws + OFF_GATE); int* list = (int*)(ws + OFF_LIST);
    bf16_t* WIN = (bf16_t*)(ws + OFF_WIN); bf16_t* WGLU = (bf16_t*)(ws + OFF_WGLU); bf16_t* WOUT = (bf16_t*)(ws + OFF_WOUT); bf16_t* WG = (bf16_t*)(ws + OFF_WG); bf16_t* WD = (bf16_t*)(ws + OFF_WD);
    bf16_t* H = (bf16_t*)(ws + OFF_H); bf16_t* QK = (bf16_t*)(ws + OFF_QK); bf16_t* V = (bf16_t*)(ws + OFF_V); bf16_t* R = (bf16_t*)(ws + OFF_R); bf16_t* UT = (bf16_t*)(ws + OFF_UT);
    float* LR = (float*)(ws + OFF_LR); bf16_t* U2 = (bf16_t*)(ws + OFF_U2);
    bf16_t* YS = (bf16_t*)(ws + OFF_YS); bf16_t* MIX = (bf16_t*)(ws + OFF_MIX); bf16_t* ACT = (bf16_t*)(ws + OFF_ACT); bf16_t* YSL = (bf16_t*)(ws + OFF_YSL);
    int* cnt = (int*)(ctl + CW_CNT);

    if (IN(0)) for (int rp = 0; rp < NREP(0); ++rp) ph_prep(a, lds, bid, G);
    SEAM(0);
    if (IN(1)) for (int rp = 0; rp < NREP(1); ++rp) { FRESH_LANE; for (int row = gw; row < NROWS; row += NGW) norm_row(a.in[0], a.in[2], a.in[6], mod, H, row, lane, 0, 1024); }
    SEAM(1);
    if (IN(2) && PROBE_VPH == 2) { ProbIn P{H, DM, WIN, DM, DM, QK, V, R, UT, U2, LR}; gemm_phase<PROBE_VMODE>(lds, P, G, bid); }
    if (IN(2)) for (int rp = 0; rp < NREP(2); ++rp) { ProbIn P{H, DM, WIN, DM, DM, QK, V, R, UT, U2, LR}; gemm_phase(lds, P, G, bid); }
    SEAM(2);
    float* Fb = (float*)(ws + OFF_F); bf16_t* S5BF = (bf16_t*)(ws + OFF_S5BF); bf16_t* S5BY = (bf16_t*)(ws + OFF_S5BY);
    const GlaPtrs GP{QK, V, R, LR, a.in[8], a.in[9], a.in[10], (bf16_t*)(ws + OFF_UCH), (float*)(ws + OFF_ADEC), (bf16_t*)(ws + OFF_SST), MIX};
    if (IN(3)) for (int rp = 0; rp < NREP(3); ++rp) {
        { ProbS5F P{U2, S5BF, 256, Fb}; gemm_phase(lds, P, G, bid); }
        for (int it = bid; it < NB * 4 * 68; it += G) gla_a_item(GP, lds, it);
    }
    SEAM(3);
    if (IN(4)) for (int rp = 0; rp < NREP(4); ++rp) {
        for (int blk = bid; blk < 256; blk += G) gla_b_block(GP, lds, blk);
        { FRESH_LANE; if (gw < NB * 32 * 2) s5_carry(Fb, U2, s5p, gw, lane); }
    }
    SEAM(4);
    if (IN(5)) for (int rp = 0; rp < NREP(5); ++rp) {
        { ProbS5Y P{U2, S5BY, 512, a.in[18], YS}; gemm_phase(lds, P, G, bid); }
        for (int it = bid; it < NB * 4 * 64; it += G) gla_c_item(GP, lds, it);
    }
    SEAM(5);
    if (IN(6)) for (int rp = 0; rp < NREP(6); ++rp) { ProbGlu P{YS, 512, WGLU, 512, 512, a.in[20], MIX}; gemm_phase(lds, P, G, bid); }
    SEAM(6);
    if (IN(7)) for (int rp = 0; rp < NREP(7); ++rp) { ProbOut P{MIX, DM, WOUT, DM, DM, a.in[0], mod, a.out}; gemm_phase(lds, P, G, bid); }
    SEAM(7);
    if (IN(8)) for (int rp = NREP(8) - 1; rp >= 0; --rp) ph_router(a.out, a.in[22], mod, a.in[23], a.in[24], H, cnt, list, gate, (int*)(ws + OFF_EPOS), lds, bid, G, rp == 0);
    SEAM(8);
    if (IN(9) && PROBE_VPH == 9) { build_ub(cnt, ub); FMoe1 P{H, WG, DM, cnt, list, a.in[26], ACT, (const LAS int*)ub, G}; gemm_phase<PROBE_VMODE>(lds, P, G, bid); }
    if (IN(9)) for (int rp = 0; rp < NREP(9); ++rp) { build_ub(cnt, ub); FMoe1 P{H, WG, DM, cnt, list, a.in[26], ACT, (const LAS int*)ub, G}; gemm_phase(lds, P, G, bid); }
    SEAM(9);
    if (IN(10) && PROBE_VPH == 10) { build_ub(cnt, ub); FMoe2 P{ACT, WD, DFF, cnt, a.in[28], YSL, (const LAS int*)ub, G}; gemm_phase<PROBE_VMODE>(lds, P, G, bid); }
    if (IN(10)) for (int rp = 0; rp < NREP(10); ++rp) { build_ub(cnt, ub); FMoe2 P{ACT, WD, DFF, cnt, a.in[28], YSL, (const LAS int*)ub, G}; gemm_phase(lds, P, G, bid); }
    SEAM(10);
    if (IN(11)) { build_ub(cnt, ub); for (int rp = NREP(11) - 1; rp >= 0; --rp) { FRESH_LANE; for (int tok = gw; tok < NTOK; tok += NGW) final_row(a.out, YSL, mod, a.in[29], gate, (const int*)(ws + OFF_EPOS), (const LAS int*)ub, tok, lane, rp ? (float*)(ws + OFF_WG) : nullptr); } }
#undef IN
#undef SEAM
}

#ifndef MEGA_SINGLE
#define MEGA_SINGLE 1
#endif
extern "C" void kernel_launch(void* const* d_in, const int* in_sizes, int n_in, void* d_out, int out_size, void* d_ws, size_t ws_size, hipStream_t stream) {
    static int grid = 0;
    if (grid == 0) {
        if (ws_size < WS_NEED || n_in != 30) { fprintf(stderr, "kernel_launch: workspace too small (%zu < %zu) or n_in %d != 30\n", ws_size, (size_t)WS_NEED, n_in); grid = -1; return; }
        int dev = 0, cus = 0, per_cu = 0;
        if (hipGetDevice(&dev) != hipSuccess || hipDeviceGetAttribute(&cus, hipDeviceAttributeMultiprocessorCount, dev) != hipSuccess) { grid = -1; return; }
        if (hipFuncSetAttribute((const void*)mega, hipFuncAttributeMaxDynamicSharedMemorySize, LDS_BYTES) != hipSuccess) { fprintf(stderr, "kernel_launch: hipFuncSetAttribute failed\n"); grid = -1; return; }
        if (hipOccupancyMaxActiveBlocksPerMultiprocessor(&per_cu, (const void*)mega, NTHR, LDS_BYTES) != hipSuccess || per_cu < 1) { fprintf(stderr, "kernel_launch: occupancy query says %d blocks per CU\n", per_cu); per_cu = 1; }
        (void)hipGetLastError();
        grid = cus;
    }
    if (grid < 0) return;
    (void)hipMemsetAsync((char*)d_ws + OFF_CTL, 0, 64 * 1024, stream);
    MArgs a{};
    for (int i = 0; i < 30; ++i) a.in[i] = (const float*)d_in[i];
    a.out = (float*)d_out; a.ws = (unsigned char*)d_ws;
#if MEGA_SINGLE
    a.ph_lo = 0; a.ph_hi = NPH;
    { void* args[] = {&a}; hipError_t e = hipLaunchCooperativeKernel((const void*)mega, dim3(grid), dim3(NTHR), args, LDS_BYTES, stream);
      if (e != hipSuccess) fprintf(stderr, "kernel_launch: cooperative launch failed: %s (grid %d)\n", hipGetErrorString(e), grid); }
#else
    for (int p = 0; p < NPH; ++p) { a.ph_lo = p; a.ph_hi = p + 1; hipLaunchKernelGGL(mega, dim3(grid), dim3(NTHR), LDS_BYTES, stream, a); }
#endif
}
```

```cpp
#include <hip/hip_runtime.h>
#include <stdint.h>
#include <stdio.h>

typedef unsigned short bf16_t;
#define DEVI __device__ __forceinline__
#define LAS __attribute__((address_space(3)))

constexpr int NB = 8, SEQ = 4096, DM = 1024, CTX = 256;
constexpr int NTOK = NB * SEQ;
constexpr int NCTX = NB * CTX;
constexpr int NROWS = NTOK + NCTX;
constexpr int INC = 2080, INP = 2304;
constexpr int NEXP = 32, TOPK = 4, DFF = 1024;
constexpr int LISTCAP = NTOK;
constexpr int MOEPAD = 256;

constexpr size_t MiB = 1024ull * 1024ull;
constexpr size_t OFF_CTL = 0;
constexpr size_t OFF_MOD = 64 * 1024;
constexpr size_t OFF_S5P = OFF_MOD + 256 * 1024;
constexpr size_t OFF_GATE = OFF_S5P + 1 * MiB;
constexpr size_t OFF_EPOS = OFF_GATE + 512 * 1024;
constexpr size_t OFF_LIST = OFF_EPOS + 512 * 1024;
constexpr size_t OFF_WIN = OFF_LIST + 4 * MiB;
constexpr size_t OFF_WGLU = OFF_WIN + (size_t)INP * DM * 2;
constexpr size_t OFF_WOUT = OFF_WGLU + 512 * 512 * 2;
constexpr size_t OFF_WG = OFF_WOUT + (size_t)DM * DM * 2;
constexpr size_t OFF_WD = OFF_WG + (size_t)NEXP * 2048 * DM * 2;
constexpr size_t OFF_S5BF = OFF_WD + (size_t)NEXP * DM * DFF * 2;
constexpr size_t OFF_S5BY = OFF_S5BF + (size_t)32 * 256 * 256 * 2;
constexpr size_t OFF_H = OFF_S5BY + (size_t)32 * 256 * 512 * 2;
constexpr size_t OFF_RA = OFF_H + (size_t)NROWS * DM * 2;
constexpr size_t OFF_QK = OFF_RA;
constexpr size_t OFF_V = OFF_QK + (size_t)NROWS * 512 * 2;
constexpr size_t OFF_R = OFF_V + (size_t)NROWS * 512 * 2;
constexpr size_t OFF_UT = OFF_R + (size_t)NROWS * 512 * 2;
constexpr size_t OFF_LR = OFF_UT + (size_t)NROWS * 512 * 2;
constexpr size_t OFF_U2 = OFF_LR + (size_t)NROWS * 32 * 4;
constexpr size_t OFF_YS = OFF_U2 + (size_t)32 * 2304 * 512 * 2;
constexpr size_t OFF_MIX = OFF_YS + (size_t)NTOK * 512 * 2;
constexpr size_t OFF_F = OFF_MIX + (size_t)NTOK * DM * 2;
constexpr size_t OFF_UCH = OFF_F + (size_t)32 * 2304 * 256 * 4;
constexpr size_t OFF_ADEC = OFF_UCH + (size_t)64 * 68 * 8192 * 2;
constexpr size_t OFF_SST = OFF_ADEC + (size_t)64 * 68 * 64 * 4;
constexpr size_t OFF_GLT = OFF_SST + (size_t)64 * 64 * 8192 * 2;
constexpr size_t OFF_RA_END = OFF_GLT + (size_t)2048 * 4 * 4096 * 2;
constexpr int ACT_ROWS = NTOK * TOPK + NEXP * MOEPAD;
constexpr size_t OFF_ACT = OFF_RA;
constexpr size_t OFF_YSL = OFF_ACT + (size_t)ACT_ROWS * DFF * 2;
constexpr size_t OFF_END2 = OFF_YSL + (size_t)ACT_ROWS * DM * 2;
constexpr size_t WS_NEED = OFF_RA_END > OFF_END2 ? OFF_RA_END : OFF_END2;
static_assert(WS_NEED <= 1024 * MiB, "workspace map exceeds 1 GiB");

constexpr int CW_CNT = 1024;
constexpr int CW_OFFS = 1088;
constexpr int CW_WQ = 1200;

DEVI float bf2f(bf16_t b) { return __uint_as_float(((unsigned)b) << 16); }
DEVI bf16_t f2bf(float f) { unsigned u = __float_as_uint(f); u += 0x7fffu + ((u >> 16) & 1u); return (bf16_t)(u >> 16); }
DEVI unsigned pk2(float lo, float hi) { unsigned r; asm("v_cvt_pk_bf16_f32 %0, %1, %2" : "=v"(r) : "v"(lo), "v"(hi)); return r; }
DEVI float wave_sum(float v) {
#pragma unroll
    for (int o = 1; o < 64; o <<= 1) v += __shfl_xor(v, o);
    return v;
}
DEVI float sigmoidf_(float x) { return 1.f / (1.f + __expf(-x)); }
DEVI float siluf_(float x) { return x / (1.f + __expf(-x)); }
DEVI float logsigmoidf_(float g) { return fminf(g, 0.f) - __logf(1.f + __expf(-fabsf(g))); }
DEVI float gelu_tanh(float x) { const float u = 0.7978845608028654f * (x + 0.044715f * x * x * x); return x / (1.f + __expf(-2.f * u)); }

__global__ __launch_bounds__(256) void k_mod(const float* __restrict__ c, const float* __restrict__ c_ctx, const float* __restrict__ ada_w,
                                             const float* __restrict__ ada_b, float* __restrict__ mod) {
    __shared__ float s[9][1024];
    for (int i = threadIdx.x; i < 9 * 1024; i += 256) { const int r = i >> 10, k = i & 1023; const float v = r < 8 ? c[r * 1024 + k] : c_ctx[k]; s[r][k] = siluf_(v); }
    __syncthreads();
    const int j = blockIdx.x * 256 + threadIdx.x;
    float acc[9];
#pragma unroll
    for (int r = 0; r < 9; ++r) acc[r] = 0.f;
    for (int k = 0; k < 1024; ++k) { const float w = ada_w[(size_t)k * 6144 + j];
#pragma unroll
        for (int r = 0; r < 9; ++r) acc[r] += s[r][k] * w; }
    const float bb = ada_b[j];
#pragma unroll
    for (int r = 0; r < 9; ++r) mod[r * 6144 + j] = acc[r] + bb;
}

template <int MODE> DEVI int wsrc_col(int nd) { if (MODE == 1) { return ((nd >> 7) & 1) * 1024 + (nd >> 8) * 128 + (nd & 127); } return nd; }
template <int MODE> __global__ __launch_bounds__(256) void k_wconv(const float* __restrict__ src, bf16_t* __restrict__ dst, int K, int N, int Nd) {
    __shared__ float t[64][65];
    const int e = blockIdx.z; src += (size_t)e * K * N; dst += (size_t)e * Nd * K;
    const int n0 = blockIdx.x * 64, k0 = blockIdx.y * 64, tid = threadIdx.x, nl = tid & 63, kq = tid >> 6;
    const int nd = n0 + nl, sc = wsrc_col<MODE>(nd); const bool valid = sc < N;
#pragma unroll 4
    for (int i = 0; i < 16; ++i) { const int kk = kq + 4 * i; t[kk][nl] = valid ? src[(size_t)(k0 + kk) * N + sc] : 0.f; }
    __syncthreads();
#pragma unroll
    for (int i = 0; i < 2; ++i) { const int ch = tid + 256 * i, n = ch >> 3, c8 = ch & 7;
        uint4 o; o.x = pk2(t[c8 * 8 + 0][n], t[c8 * 8 + 1][n]); o.y = pk2(t[c8 * 8 + 2][n], t[c8 * 8 + 3][n]); o.z = pk2(t[c8 * 8 + 4][n], t[c8 * 8 + 5][n]); o.w = pk2(t[c8 * 8 + 6][n], t[c8 * 8 + 7][n]);
        *(uint4*)(dst + (size_t)(n0 + n) * K + k0 + c8 * 8) = o; }
}

struct S5P { float lamb[2][32][64][2]; float bbar[2][32][64][16][2]; float lam16[2][32][64][2]; };
DEVI void s5prep_one(const float* lam_re, const float* lam_im, const float* log_dt, const float* b_re, const float* b_im, S5P* P, int i) {
    const int p = i & 63, g = (i >> 6) & 31, d = i >> 11;
    const double dt = exp((double)log_dt[d * 32 + g]);
    const double lr = lam_re[i], li = lam_im[i];
    const double mag = exp(lr * dt), ar = mag * cos(li * dt), ai = mag * sin(li * dt);
    const double nr = ar - 1.0, ni = ai, den = lr * lr + li * li;
    const double cr = (nr * lr + ni * li) / den, ci = (ni * lr - nr * li) / den;
    P->lamb[d][g][p][0] = (float)ar; P->lamb[d][g][p][1] = (float)ai;
    for (int h = 0; h < 16; ++h) { const double br = b_re[(size_t)i * 16 + h], bi = b_im[(size_t)i * 16 + h];
        P->bbar[d][g][p][h][0] = (float)(cr * br - ci * bi); P->bbar[d][g][p][h][1] = (float)(cr * bi + ci * br); }
}
__global__ void k_s5prep(const float* lam_re, const float* lam_im, const float* log_dt, const float* b_re, const float* b_im, S5P* P) {
    const int i = blockIdx.x * blockDim.x + threadIdx.x; if (i >= 2 * 32 * 64) return;
    s5prep_one(lam_re, lam_im, log_dt, b_re, b_im, P, i);
}

DEVI void norm_row(const float* __restrict__ x, const float* __restrict__ ctx, const float* __restrict__ w, const float* __restrict__ mod,
                                              bf16_t* __restrict__ H, int row, int lane, int sh_off, int sc_off) {
    const float* src; int b;
    if (row < NTOK) { src = x + (size_t)row * DM; b = row / SEQ; } else { src = ctx + (size_t)(row - NTOK) * DM; b = 8; }
    float4 v[4]; float ss = 0.f;
#pragma unroll
    for (int j = 0; j < 4; ++j) { v[j] = *(const float4*)(src + lane * 4 + 256 * j); ss += v[j].x * v[j].x + v[j].y * v[j].y + v[j].z * v[j].z + v[j].w * v[j].w; }
    const float rstd = rsqrtf(wave_sum(ss) * (1.f / DM) + 1e-6f);
    const float* msh = mod + b * 6144 + sh_off; const float* msc = mod + b * 6144 + sc_off;
#pragma unroll
    for (int j = 0; j < 4; ++j) { const int k = lane * 4 + 256 * j;
        const float4 ww = *(const float4*)(w + k), sc = *(const float4*)(msc + k), sh = *(const float4*)(msh + k);
        uint2 o; o.x = pk2(v[j].x * rstd * ww.x * (1.f + sc.x) + sh.x, v[j].y * rstd * ww.y * (1.f + sc.y) + sh.y);
        o.y = pk2(v[j].z * rstd * ww.z * (1.f + sc.z) + sh.z, v[j].w * rstd * ww.w * (1.f + sc.w) + sh.w);
        *(uint2*)(H + (size_t)row * DM + k) = o; }
}
__global__ __launch_bounds__(256) void k_norm(const float* __restrict__ x, const float* __restrict__ ctx, const float* __restrict__ w, const float* __restrict__ mod,
                                              bf16_t* __restrict__ H, int nrows, int sh_off, int sc_off) {
    const int row = blockIdx.x * 4 + (threadIdx.x >> 6), lane = threadIdx.x & 63; if (row >= nrows) return;
    norm_row(x, ctx, w, mod, H, row, lane, sh_off, sc_off);
}

DEVI void dense_unit(int L, int nM, int nN, int& pm, int& pn) {
    const int nwg = nM * nN; int wgid = L; { const int q = nwg / 8, r = nwg % 8, xcd = wgid % 8, off = wgid / 8; wgid = (xcd < r ? xcd * (q + 1) : r * (q + 1) + (xcd - r) * q) + off; }
    const int nig = 8 * nN, gid = wgid / nig, fm = gid * 8, gsz = (nM - fm) < 8 ? (nM - fm) : 8;
    pm = fm + ((wgid % nig) % gsz); pn = (wgid % nig) / gsz;
}
template <class Prob> __global__ __launch_bounds__(256) void k_gemm_naive(Prob P) {
    __shared__ float As[32][68], Bs[32][68];
    const int z = blockIdx.z, M = P.M(z), r0 = blockIdx.y * 64, c0 = blockIdx.x * 64; if (r0 >= M) return;
    const int tid = threadIdx.x, tx = tid & 7, ty = tid >> 3, K = P.K;
    const int lr = tid >> 2, lk = (tid & 3) * 8;
    const bool arow_ok = (r0 + lr) < M;
    const bf16_t* ap = P.A + (size_t)(arow_ok ? P.arow(z, r0 + lr) : 0) * P.lda + lk;
    const bf16_t* bp = P.Bt(z) + (size_t)(c0 + lr) * P.ldb + lk;
    float acc[2][8];
#pragma unroll
    for (int i = 0; i < 2; ++i)
#pragma unroll
        for (int j = 0; j < 8; ++j) acc[i][j] = 0.f;
    for (int k0 = 0; k0 < K; k0 += 32) {
        uint4 av = arow_ok ? *(const uint4*)(ap + k0) : make_uint4(0, 0, 0, 0); const uint4 bv = *(const uint4*)(bp + k0);
        const unsigned aw[4] = {av.x, av.y, av.z, av.w}, bw[4] = {bv.x, bv.y, bv.z, bv.w};
        __syncthreads();
#pragma unroll
        for (int j = 0; j < 4; ++j) { As[lk + 2 * j][lr] = __uint_as_float(aw[j] << 16); As[lk + 2 * j + 1][lr] = __uint_as_float(aw[j] & 0xffff0000u);
            Bs[lk + 2 * j][lr] = __uint_as_float(bw[j] << 16); Bs[lk + 2 * j + 1][lr] = __uint_as_float(bw[j] & 0xffff0000u); }
        __syncthreads();
#pragma unroll 8
        for (int k = 0; k < 32; ++k) { const float a0 = As[k][ty * 2], a1 = As[k][ty * 2 + 1];
            const float4 b0 = *(const float4*)&Bs[k][tx * 8], b1 = *(const float4*)&Bs[k][tx * 8 + 4];
            const float bb[8] = {b0.x, b0.y, b0.z, b0.w, b1.x, b1.y, b1.z, b1.w};
#pragma unroll
            for (int j = 0; j < 8; ++j) { acc[0][j] += a0 * bb[j]; acc[1][j] += a1 * bb[j]; } }
    }
#pragma unroll
    for (int i = 0; i < 2; ++i) { const int r = r0 + ty * 2 + i; if (r < M) P.store(z, r, c0 + tx * 8, acc[i]); }
}

struct ProbIn {
    static constexpr bool HOIST = false, PAIR = false;
    const bf16_t* A; int lda; const bf16_t* B; int ldb; int K; bf16_t *QK, *V, *R, *UT, *U2; float* LR;
    DEVI int M(int) const { return NROWS; }
    DEVI int arow(int, int r) const { return r; }
    DEVI int nunits() const { return (NROWS / 256) * (INP / 256); }
    DEVI void unit(int L, int& z, int& pm, int& pn) const { z = 0; dense_unit(L, NROWS / 256, INP / 256, pm, pn); }
    DEVI unsigned aoffb(int, int r) const { return (unsigned)r * (unsigned)(lda * 2); }
    DEVI const bf16_t* Bt(int) const { return B; }
    DEVI void store(int, int r, int c0, const float (&v)[8]) const {
        if (c0 >= INC) return;
        uint4 o; o.x = pk2(v[0], v[1]); o.y = pk2(v[2], v[3]); o.z = pk2(v[4], v[5]); o.w = pk2(v[6], v[7]);
        if (c0 < 512) { *(uint4*)(QK + (size_t)r * 512 + c0) = o; }
        else if (c0 < 1024) { *(uint4*)(V + (size_t)r * 512 + (c0 - 512)) = o; }
        else if (c0 < 1536) { *(uint4*)(R + (size_t)r * 512 + (c0 - 1024)) = o; }
        else if (c0 < 1568) { float* p = LR + (size_t)r * 32 + (c0 - 1536); *(float4*)p = make_float4(v[0], v[1], v[2], v[3]); *(float4*)(p + 4) = make_float4(v[4], v[5], v[6], v[7]); }
        else { const int j = c0 - 1568;
            const int g = j >> 4, ch = j & 15; int urow, ucol;
            if (r < NTOK) { const int b = r >> 12, n = r & 4095, gr = n >> 6, gc = n & 63, s = gc * 64 + gr; urow = b * 256 + (s >> 4); ucol = (s & 15) * 16 + ch; }
            else { const int q = r - NTOK, b = q >> 8, t = q & 255; urow = 2048 + b * 16 + (t >> 4); ucol = (t & 15) * 16 + ch; }
            *(uint4*)(U2 + ((size_t)g * 2304 + urow) * 512 + ucol) = o; }
    }
};
struct ProbGlu {
    static constexpr bool HOIST = false, PAIR = false;
    const bf16_t* A; int lda; const bf16_t* B; int ldb; int K; const float* bias; bf16_t* MIX;
    DEVI int M(int) const { return NTOK; }
    DEVI int arow(int, int r) const { return r; }
    DEVI int nunits() const { return (NTOK / 256) * 2; }
    DEVI void unit(int L, int& z, int& pm, int& pn) const { z = 0; dense_unit(L, NTOK / 256, 2, pm, pn); }
    DEVI unsigned aoffb(int, int r) const { return (unsigned)r * (unsigned)(lda * 2); }
    DEVI const bf16_t* Bt(int) const { return B; }
    DEVI void store(int, int r, int c0, const float (&v)[8]) const {
        const uint4 yv = *(const uint4*)(A + (size_t)r * lda + c0); const unsigned yw[4] = {yv.x, yv.y, yv.z, yv.w}; float o[8];
#pragma unroll
        for (int j = 0; j < 4; ++j) { const float y0 = __uint_as_float(yw[j] << 16), y1 = __uint_as_float(yw[j] & 0xffff0000u);
            o[2 * j] = y0 * sigmoidf_(v[2 * j] + bias[c0 + 2 * j]); o[2 * j + 1] = y1 * sigmoidf_(v[2 * j + 1] + bias[c0 + 2 * j + 1]); }
        uint4 w; w.x = pk2(o[0], o[1]); w.y = pk2(o[2], o[3]); w.z = pk2(o[4], o[5]); w.w = pk2(o[6], o[7]);
        *(uint4*)(MIX + (size_t)r * DM + 512 + c0) = w;
    }
};
struct ProbOut {
    static constexpr bool HOIST = false, PAIR = false;
    const bf16_t* A; int lda; const bf16_t* B; int ldb; int K; const float* x; const float* mod; float* X1;
    DEVI int M(int) const { return NTOK; }
    DEVI int arow(int, int r) const { return r; }
    DEVI int nunits() const { return (NTOK / 256) * 4; }
    DEVI void unit(int L, int& z, int& pm, int& pn) const { z = 0; dense_unit(L, NTOK / 256, 4, pm, pn); }
    DEVI unsigned aoffb(int, int r) const { return (unsigned)r * (unsigned)(lda * 2); }
    DEVI const bf16_t* Bt(int) const { return B; }
    DEVI void store(int, int r, int c0, const float (&v)[8]) const {
        uint4 o; o.x = pk2(v[0], v[1]); o.y = pk2(v[2], v[3]); o.z = pk2(v[4], v[5]); o.w = pk2(v[6], v[7]);
        *(uint4*)((bf16_t*)(X1 + (size_t)r * DM) + DM + c0) = o;
    }
};
struct ProbMoe1 {
    const bf16_t* A; int lda; const bf16_t* B; int ldb; int K; const int* cnt; const int* offs; const int* list; const float* b_gu; bf16_t* ACT;
    DEVI int M(int z) const { return cnt[z]; }
    DEVI int arow(int z, int r) const { return list[z * LISTCAP + r] >> 2; }
    DEVI const bf16_t* Bt(int z) const { return B + (size_t)z * 2048 * DM; }
    DEVI void store(int, int, int, const float (&)[8]) const {}
};
struct ProbMoe2 {
    const bf16_t* A; int lda; const bf16_t* B; int ldb; int K; const int* cnt; const int* offs; const int* list; const float* b_down; const float* gate; bf16_t* YSL;
    DEVI int M(int z) const { return cnt[z]; }
    DEVI int arow(int z, int r) const { return offs[z] + r; }
    DEVI const bf16_t* Bt(int z) const { return B + (size_t)z * DM * DFF; }
    DEVI void store(int z, int r, int c0, const float (&v)[8]) const {
        const int ent = list[z * LISTCAP + r]; const float gt = gate[ent]; const float* bd = b_down + (size_t)z * DM + c0;
        uint4 o; o.x = pk2((v[0] + bd[0]) * gt, (v[1] + bd[1]) * gt); o.y = pk2((v[2] + bd[2]) * gt, (v[3] + bd[3]) * gt);
        o.z = pk2((v[4] + bd[4]) * gt, (v[5] + bd[5]) * gt); o.w = pk2((v[6] + bd[6]) * gt, (v[7] + bd[7]) * gt);
        *(uint4*)(YSL + (size_t)ent * DM + c0) = o;
    }
};

DEVI void gla_naive_body(const bf16_t* __restrict__ QK, const bf16_t* __restrict__ V, const float* __restrict__ LR, const float* __restrict__ lr_up,
                                                   const float* __restrict__ lr_bias, float* __restrict__ OF, float* __restrict__ OB, LAS float* sm, int item) {
    LAS float* sq = sm; LAS float* sk = sm + 64; LAS float* sa = sm + 128; LAS float* sv = sm + 192; LAS float* red = sm + 320;
    const int dir = item & 1, hh = (item >> 1) & 3, b = item >> 3, tid = threadIdx.x, e = tid & 127, dg = tid >> 7;
    float up[16]; float bias = 0.f;
    if (tid < 64) { for (int r = 0; r < 16; ++r) up[r] = lr_up[dir * 4096 + r * 256 + hh * 64 + tid]; bias = lr_bias[dir * 256 + hh * 64 + tid]; }
    float S[16];
#pragma unroll
    for (int i = 0; i < 16; ++i) S[i] = 0.f;
    float* O = dir ? OB : OF;
    for (int step = 0; step < CTX + SEQ; ++step) {
        int row;
        if (step < CTX) row = NTOK + b * CTX + (dir ? CTX - 1 - step : step);
        else { const int t = step - CTX; row = b * SEQ + (dir ? SEQ - 1 - t : t); }
        if (tid < 64) { const float* lp = LR + (size_t)row * 32 + dir * 16; float g = bias;
#pragma unroll
            for (int r = 0; r < 16; ++r) g += lp[r] * up[r];
            sa[tid] = __expf(logsigmoidf_(g) * (1.f / 16.f));
            sq[tid] = bf2f(QK[(size_t)row * 512 + hh * 64 + tid]) * 0.125f; sk[tid] = bf2f(QK[(size_t)row * 512 + 256 + hh * 64 + tid]); }
        else if (tid < 192) sv[tid - 64] = bf2f(V[(size_t)row * 512 + hh * 128 + (tid - 64)]);
        __syncthreads();
        const float v = sv[e]; float part = 0.f;
#pragma unroll
        for (int i = 0; i < 16; ++i) { const int d = dg * 16 + i; S[i] = sa[d] * S[i] + sk[d] * v; part += sq[d] * S[i]; }
        if (step >= CTX) red[dg * 128 + e] = part;
        __syncthreads();
        if (step >= CTX && dg == 0) O[(size_t)row * 512 + hh * 128 + e] = (red[e] + red[128 + e]) + (red[256 + e] + red[384 + e]);
    }
}
__global__ __launch_bounds__(512) void k_gla_naive(const bf16_t* __restrict__ QK, const bf16_t* __restrict__ V, const float* __restrict__ LR, const float* __restrict__ lr_up,
                                                   const float* __restrict__ lr_bias, float* __restrict__ OF, float* __restrict__ OB) {
    __shared__ float sm[832];
    gla_naive_body(QK, V, LR, lr_up, lr_bias, OF, OB, (LAS float*)sm, blockIdx.x);
}
DEVI void gla_post_row(const float* __restrict__ OF, const float* __restrict__ OB, const bf16_t* __restrict__ R, const float* __restrict__ nw, bf16_t* __restrict__ MIX, int tok, int lane) {
    const int c0 = lane * 8;
    float o[8]; float ss = 0.f;
#pragma unroll
    for (int j = 0; j < 8; ++j) { o[j] = OF[(size_t)tok * 512 + c0 + j] + OB[(size_t)tok * 512 + c0 + j]; ss += o[j] * o[j]; }
    ss += __shfl_xor(ss, 1); ss += __shfl_xor(ss, 2); ss += __shfl_xor(ss, 4); ss += __shfl_xor(ss, 8);
    const float rstd = rsqrtf(ss * (1.f / 128.f) + 1e-6f);
    float w[8];
#pragma unroll
    for (int j = 0; j < 8; ++j) { const float r = bf2f(R[(size_t)tok * 512 + c0 + j]); w[j] = o[j] * rstd * nw[(c0 + j) & 127] * siluf_(r); }
    uint4 q; q.x = pk2(w[0], w[1]); q.y = pk2(w[2], w[3]); q.z = pk2(w[4], w[5]); q.w = pk2(w[6], w[7]);
    *(uint4*)(MIX + (size_t)tok * DM + c0) = q;
}
__global__ __launch_bounds__(256) void k_gla_post(const float* __restrict__ OF, const float* __restrict__ OB, const bf16_t* __restrict__ R, const float* __restrict__ nw, bf16_t* __restrict__ MIX) {
    gla_post_row(OF, OB, R, nw, MIX, blockIdx.x * 4 + (threadIdx.x >> 6), threadIdx.x & 63);
}

DEVI void s5_naive_body(const bf16_t* __restrict__ UT, const S5P* __restrict__ P, const float* __restrict__ c_re, const float* __restrict__ c_im,
                                                  float* __restrict__ YF, float* __restrict__ YB, LAS float* hsw  , int id, int lane) {
    const int g = id & 31, dir = (id >> 5) & 1, b = id >> 6;
    const float lr = P->lamb[dir][g][lane][0], li = P->lamb[dir][g][lane][1];
    float br[16], bi[16];
#pragma unroll
    for (int h = 0; h < 16; ++h) { br[h] = P->bbar[dir][g][lane][h][0]; bi[h] = P->bbar[dir][g][lane][h][1]; }
    const int ch = lane & 15, part = lane >> 4;
    float cr[16], ci[16];
#pragma unroll
    for (int i = 0; i < 16; ++i) { const size_t ix = (((size_t)dir * 32 + g) * 16 + ch) * 64 + part * 16 + i; cr[i] = c_re[ix]; ci[i] = c_im[ix]; }
    float hr = 0.f, hi = 0.f; float* Y = dir ? YB : YF;
    for (int step = 0; step < CTX + SEQ; ++step) {
        int row;
        if (step < CTX) row = NTOK + b * CTX + (dir ? CTX - 1 - step : step);
        else { const int t = step - CTX, s = dir ? SEQ - 1 - t : t; row = b * SEQ + (s & 63) * 64 + (s >> 6); }
        const uint4 u0 = *(const uint4*)(UT + (size_t)row * 512 + g * 16), u1 = *(const uint4*)(UT + (size_t)row * 512 + g * 16 + 8);
        const unsigned uw[8] = {u0.x, u0.y, u0.z, u0.w, u1.x, u1.y, u1.z, u1.w};
        float bur = 0.f, bui = 0.f;
#pragma unroll
        for (int j = 0; j < 8; ++j) { const float ua = __uint_as_float(uw[j] << 16), ub = __uint_as_float(uw[j] & 0xffff0000u);
            bur += br[2 * j] * ua + br[2 * j + 1] * ub; bui += bi[2 * j] * ua + bi[2 * j + 1] * ub; }
        const float nr = lr * hr - li * hi + bur, ni = lr * hi + li * hr + bui; hr = nr; hi = ni;
        if (step >= CTX) {
            hsw[lane] = hr; hsw[64 + lane] = hi;
            asm volatile("s_waitcnt lgkmcnt(0)" ::: "memory");
            float acc = 0.f;
#pragma unroll
            for (int i = 0; i < 16; ++i) acc += cr[i] * hsw[part * 16 + i] - ci[i] * hsw[64 + part * 16 + i];
            acc += __shfl_xor(acc, 16); acc += __shfl_xor(acc, 32);
            asm volatile("s_waitcnt lgkmcnt(0)" ::: "memory");
            if (lane < 16) Y[(size_t)row * 512 + g * 16 + lane] = acc;
        }
    }
}
__global__ __launch_bounds__(256) void k_s5_naive(const bf16_t* __restrict__ UT, const S5P* __restrict__ P, const float* __restrict__ c_re, const float* __restrict__ c_im,
                                                  float* __restrict__ YF, float* __restrict__ YB) {
    __shared__ float hs[4][128];
    const int w = threadIdx.x >> 6;
    s5_naive_body(UT, P, c_re, c_im, YF, YB, (LAS float*)hs[w], blockIdx.x * 4 + w, threadIdx.x & 63);
}
__global__ __launch_bounds__(256) void k_s5_post(const float* __restrict__ YF, const float* __restrict__ YB, const bf16_t* __restrict__ UT, const float* __restrict__ dvec, bf16_t* __restrict__ YS) {
    const size_t i = (size_t)blockIdx.x * 256 + threadIdx.x; const int j = (int)(i & 511);
    const float y = YF[i] + YB[i] + dvec[j] * bf2f(UT[i]);
    YS[i] = f2bf(gelu_tanh(y));
}

DEVI void router_row(const float* __restrict__ X1, const float* __restrict__ w, const float* __restrict__ mod, const float* __restrict__ rw, const float* __restrict__ rb,
                                                bf16_t* __restrict__ H2, int* __restrict__ cnt, int* __restrict__ list, float* __restrict__ gate, LAS float* hrw  , int tok, int lane) {
    const int b = tok / SEQ;
    const float* src = X1 + (size_t)tok * DM;
    float4 v[4]; float ss = 0.f;
#pragma unroll
    for (int j = 0; j < 4; ++j) { v[j] = *(const float4*)(src + lane * 4 + 256 * j); ss += v[j].x * v[j].x + v[j].y * v[j].y + v[j].z * v[j].z + v[j].w * v[j].w; }
    const float rstd = rsqrtf(wave_sum(ss) * (1.f / DM) + 1e-6f);
    const float* msh = mod + b * 6144 + 3072; const float* msc = mod + b * 6144 + 4096;
#pragma unroll
    for (int j = 0; j < 4; ++j) { const int k = lane * 4 + 256 * j;
        const float4 ww = *(const float4*)(w + k), sc = *(const float4*)(msc + k), sh = *(const float4*)(msh + k);
        float4 h; h.x = v[j].x * rstd * ww.x * (1.f + sc.x) + sh.x; h.y = v[j].y * rstd * ww.y * (1.f + sc.y) + sh.y; h.z = v[j].z * rstd * ww.z * (1.f + sc.z) + sh.z; h.w = v[j].w * rstd * ww.w * (1.f + sc.w) + sh.w;
        hrw[k] = h.x; hrw[k + 1] = h.y; hrw[k + 2] = h.z; hrw[k + 3] = h.w;
        uint2 o; o.x = pk2(h.x, h.y); o.y = pk2(h.z, h.w); *(uint2*)(H2 + (size_t)tok * DM + k) = o; }
    asm volatile("s_waitcnt lgkmcnt(0)" ::: "memory");
    const int e = lane & 31, half = lane >> 5; float lg = 0.f;
    for (int k = half * 512; k < half * 512 + 512; ++k) lg += hrw[k] * rw[k * 32 + e];
    lg += __shfl_xor(lg, 32); lg += rb[e];
    float val = lg; float tv[4]; int ti[4];
#pragma unroll
    for (int t = 0; t < 4; ++t) { float bv = val; int bi = e;
#pragma unroll
        for (int o = 1; o < 32; o <<= 1) { const float ov = __shfl_xor(bv, o); const int oi = __shfl_xor(bi, o); if (ov > bv || (ov == bv && oi < bi)) { bv = ov; bi = oi; } }
        tv[t] = bv; ti[t] = bi; if (e == bi) val = -3.0e38f; }
    const float e1 = __expf(tv[1] - tv[0]), e2 = __expf(tv[2] - tv[0]), e3 = __expf(tv[3] - tv[0]), inv = 1.f / (1.f + e1 + e2 + e3);
    if (lane < 4) { const float gv = lane == 0 ? inv : lane == 1 ? e1 * inv : lane == 2 ? e2 * inv : e3 * inv; const int ex = lane == 0 ? ti[0] : lane == 1 ? ti[1] : lane == 2 ? ti[2] : ti[3];
        const int slot = atomicAdd(&cnt[ex], 1); list[ex * LISTCAP + slot] = tok * 4 + lane; gate[tok * 4 + lane] = gv; }
}
__global__ __launch_bounds__(256) void k_router(const float* __restrict__ X1, const float* __restrict__ w, const float* __restrict__ mod, const float* __restrict__ rw, const float* __restrict__ rb,
                                                bf16_t* __restrict__ H2, int* __restrict__ cnt, int* __restrict__ list, float* __restrict__ gate) {
    __shared__ float hrow[4][1024];
    const int wv = threadIdx.x >> 6;
    router_row(X1, w, mod, rw, rb, H2, cnt, list, gate, (LAS float*)hrow[wv], blockIdx.x * 4 + wv, threadIdx.x & 63);
}
__global__ void k_offsets(const int* cnt, int* offs) { if (threadIdx.x == 0) { int o = 0; for (int e = 0; e < NEXP; ++e) { offs[e] = o; o += (cnt[e] + MOEPAD - 1) / MOEPAD * MOEPAD; } offs[NEXP] = o; } }

DEVI void final_row(const float* __restrict__ X, float* __restrict__ X1, const bf16_t* __restrict__ Y2, const float* __restrict__ mod, const float* __restrict__ fw, const float* __restrict__ gate, const int* __restrict__ epos,
                    const LAS int* ub, int tok, int lane, float* __restrict__ OUT = nullptr) {
    const int b = tok / SEQ;
    float* row = X1 + (size_t)tok * DM; float* orow = OUT ? OUT + (size_t)tok * DM : row; const float* g2 = mod + b * 6144 + 5120; const float* g1p = mod + b * 6144 + 2048;
    const float* xrow = X + (size_t)tok * DM; const bf16_t* mrow = (const bf16_t*)row + DM;
    const int4 ep = *(const int4*)(epos + tok * 4); const float4 gt = *(const float4*)(gate + tok * 4);
    const bf16_t* y0 = Y2 + (size_t)(ub[ep.x / LISTCAP] * 256 + ep.x % LISTCAP) * DM; const bf16_t* y1 = Y2 + (size_t)(ub[ep.y / LISTCAP] * 256 + ep.y % LISTCAP) * DM;
    const bf16_t* y2 = Y2 + (size_t)(ub[ep.z / LISTCAP] * 256 + ep.z % LISTCAP) * DM; const bf16_t* y3 = Y2 + (size_t)(ub[ep.w / LISTCAP] * 256 + ep.w % LISTCAP) * DM;
    float4 v[4]; float ss = 0.f;
#pragma unroll
    for (int j = 0; j < 4; ++j) { const int k = lane * 4 + 256 * j; v[j] = *(const float4*)(xrow + k);
        { const uint2 mm = *(const uint2*)(mrow + k); const float4 g1 = *(const float4*)(g1p + k);
          v[j].x += g1.x * __uint_as_float(mm.x << 16); v[j].y += g1.y * __uint_as_float(mm.x & 0xffff0000u); v[j].z += g1.z * __uint_as_float(mm.y << 16); v[j].w += g1.w * __uint_as_float(mm.y & 0xffff0000u); }
        const uint2 a0 = *(const uint2*)(y0 + k), a1 = *(const uint2*)(y1 + k), a2 = *(const uint2*)(y2 + k), a3 = *(const uint2*)(y3 + k);
        float f[4];
        f[0] = gt.x * __uint_as_float(a0.x << 16) + gt.y * __uint_as_float(a1.x << 16) + gt.z * __uint_as_float(a2.x << 16) + gt.w * __uint_as_float(a3.x << 16);
        f[1] = gt.x * __uint_as_float(a0.x & 0xffff0000u) + gt.y * __uint_as_float(a1.x & 0xffff0000u) + gt.z * __uint_as_float(a2.x & 0xffff0000u) + gt.w * __uint_as_float(a3.x & 0xffff0000u);
        f[2] = gt.x * __uint_as_float(a0.y << 16) + gt.y * __uint_as_float(a1.y << 16) + gt.z * __uint_as_float(a2.y << 16) + gt.w * __uint_as_float(a3.y << 16);
        f[3] = gt.x * __uint_as_float(a0.y & 0xffff0000u) + gt.y * __uint_as_float(a1.y & 0xffff0000u) + gt.z * __uint_as_float(a2.y & 0xffff0000u) + gt.w * __uint_as_float(a3.y & 0xffff0000u);
        const float4 gg = *(const float4*)(g2 + k);
        v[j].x += gg.x * f[0]; v[j].y += gg.y * f[1]; v[j].z += gg.z * f[2]; v[j].w += gg.w * f[3];
        ss += v[j].x * v[j].x + v[j].y * v[j].y + v[j].z * v[j].z + v[j].w * v[j].w; }
    const float rstd = rsqrtf(wave_sum(ss) * (1.f / DM) + 1e-6f);
#pragma unroll
    for (int j = 0; j < 4; ++j) { const int k = lane * 4 + 256 * j; const float4 ww = *(const float4*)(fw + k);
        *(float4*)(orow + k) = make_float4(v[j].x * rstd * ww.x, v[j].y * rstd * ww.y, v[j].z * rstd * ww.z, v[j].w * rstd * ww.w); }
}

typedef short bf16x8 __attribute__((ext_vector_type(8)));
typedef float f32x4 __attribute__((ext_vector_type(4)));
typedef unsigned u32x4 __attribute__((ext_vector_type(4)));
typedef unsigned u32x2 __attribute__((ext_vector_type(2)));
constexpr int NWAVES = 8, NTHR = 512;
constexpr int BM = 256, BK = 64, HALF = 128, HTB = HALF * BK * 2, STAGE_BYTES = 8 * HTB;
constexpr int MISC_OFF = 147456, MISC_BYTES = 1024, LDS_BYTES = MISC_OFF + MISC_BYTES;
constexpr int CW_BAR = 4096;

#define XB_TMO      128
#define XB_XCNT(j)  (256  + 64 * (j))
#define XB_XSUB(j)  (1280 + 64 * (j))
#define XB_XGEN(j)  (2304 + 64 * (j))
#define XB_TOP      3328
#define XB_TOPGEN   3392
#define XCD_BAR_WORDS 3456
#define XB_SPIN_CAP (1u << 18)
DEVI unsigned xb_ld(unsigned* p)              { return __hip_atomic_load(p, __ATOMIC_RELAXED, __HIP_MEMORY_SCOPE_AGENT); }
DEVI unsigned xb_add(unsigned* p, unsigned v) { return __hip_atomic_fetch_add(p, v, __ATOMIC_RELAXED, __HIP_MEMORY_SCOPE_AGENT); }
DEVI unsigned xb_xcc_id() { return (unsigned)__builtin_amdgcn_s_getreg((3 << 11) | 20) & 0xFu; }
#define XB_SPIN(cond, bar) do { unsigned _sp = 0; while (cond) { __builtin_amdgcn_s_sleep(1); \
    if ((++_sp & 255u) == 0u) { if (xb_ld(&(bar)[XB_TMO])) break; if (_sp > XB_SPIN_CAP) { atomicAdd(&(bar)[XB_TMO], 1u); break; } } } } while (0)
struct XcdBarrier { unsigned* bar; unsigned x; volatile LAS unsigned* st; };
DEVI XcdBarrier xcd_barrier_post(unsigned* bar, volatile LAS unsigned* st) {
    XcdBarrier b; b.bar = bar; b.x = xb_xcc_id(); b.st = st;
    if (threadIdx.x == 0) (void)xb_add(&bar[XB_XCNT(b.x)], 1u);
    return b;
}
DEVI void xcd_barrier_complete(unsigned* bar, unsigned x, unsigned& nloc, unsigned& nx) {
    const unsigned G = gridDim.x * gridDim.y * gridDim.z;
    unsigned sum, cnt, mine, sp = 0u;
    for (;;) {
        sum = 0u; cnt = 0u; mine = 0u;
#pragma unroll
        for (unsigned j = 0; j < 16; ++j) { const unsigned c = xb_ld(&bar[XB_XCNT(j)]); sum += c; cnt += (c > 0u) ? 1u : 0u; mine = (j == x) ? c : mine; }
        if (sum == G) break;
        __builtin_amdgcn_s_sleep(1);
        if ((++sp & 255u) == 0u) { if (xb_ld(&bar[XB_TMO])) break; if (sp > XB_SPIN_CAP) { atomicAdd(&bar[XB_TMO], 1u); break; } }
    }
    nloc = mine > 0u ? mine : 1u; nx = cnt > 0u ? cnt : 1u;
}
DEVI void xcd_barrier(const XcdBarrier& b) {
    asm volatile("s_waitcnt vmcnt(0)" ::: "memory");
    __syncthreads();
    if (threadIdx.x == 0) {
        unsigned* bar = b.bar;
        __builtin_amdgcn_s_waitcnt(0);
        unsigned nloc = b.st[0], nx = b.st[1];
        if (nloc == 0u) { xcd_barrier_complete(bar, b.x, nloc, nx); b.st[0] = nloc; b.st[1] = nx; }
        const unsigned old = xb_add(&bar[XB_XSUB(b.x)], 1u);
        const unsigned gen = old / nloc;
        if (old + 1u == (gen + 1u) * nloc) {
            __builtin_amdgcn_fence(__ATOMIC_RELEASE, "agent");
            asm volatile("s_waitcnt vmcnt(0)" ::: "memory");
            const unsigned og = xb_add(&bar[XB_TOP], 1u);
            const unsigned tg = og / nx;
            if (og + 1u == (tg + 1u) * nx) xb_add(&bar[XB_TOPGEN], 1u);
            else XB_SPIN(xb_ld(&bar[XB_TOPGEN]) == tg, bar);
            __builtin_amdgcn_fence(__ATOMIC_ACQUIRE, "agent");
            xb_add(&bar[XB_XGEN(b.x)], 1u);
            asm volatile("s_waitcnt vmcnt(0)" ::: "memory");
        } else {
            XB_SPIN(xb_ld(&bar[XB_XGEN(b.x)]) == gen, bar);
            __builtin_amdgcn_fence(__ATOMIC_ACQUIRE, "agent");
            asm volatile("s_waitcnt vmcnt(0)" ::: "memory");
        }
    }
    __syncthreads();
}

DEVI int lds_byte(int r, int c) { const int st = (r >> 4) * 2 + (c >> 5), rr = r & 15, cc = c & 31, ob = rr * 64 + cc * 2; return st * 1024 + (ob ^ (((ob >> 9) & 1) << 5)); }
DEVI void stage_rc(int b, int& R, int& C) { const int st = b / 1024, sb = b % 1024, swz = sb ^ (((sb >> 9) & 1) << 5); R = (st >> 1) * 16 + swz / 64; C = (st & 1) * 32 + (swz % 64) / 2; }
DEVI int perm32(int rho) { const int n = rho >> 4, i = rho & 15; return 8 * (i >> 2) + 4 * n + (i & 3); }
template <int VMODE = 0, class Prob>
DEVI void gemm_phase(LAS unsigned char* lds, const Prob& P, int G, int c) {
    int tid = threadIdx.x; asm volatile("" : "+v"(tid));
    const int wid = __builtin_amdgcn_readfirstlane(tid >> 6), lane = tid & 63, wr = wid >> 2, wc = wid & 3, fr = lane & 15, fq = lane >> 4;
    const int K = P.K, nt = K / BK;
    const int nun = P.nunits();
    int L = c; if (L >= nun) return;
    int Rs0, Cs0, Rs1, Cs1; stage_rc(tid * 16, Rs0, Cs0); stage_rc(tid * 16 + 8192, Rs1, Cs1);
    unsigned voffB[2];
    voffB[0] = (unsigned)(((Rs0 & ~31) + perm32(Rs0 & 31)) * K + Cs0) * 2u; voffB[1] = (unsigned)(((Rs1 & ~31) + perm32(Rs1 & 31)) * K + Cs1) * 2u;
    const size_t kstep = (size_t)(BK * 2), hstepB = (size_t)HALF * K * 2, tstepB = 2 * hstepB;
    const unsigned ldsw = (unsigned)wid * 1024u;
    const int aoff = lds_byte(wr * 64 + fr, fq * 8), boff = lds_byte(wc * 32 + fr, fq * 8);
#define G_SA(b, h) (((b) * 2 + (h)) * HTB)
#define G_SB(b, h) ((4 + (b) * 2 + (h)) * HTB)
#define G_STAGE_B(bufoff, gbase) do { _Pragma("unroll") for (int _i = 0; _i < 2; ++_i) \
        __builtin_amdgcn_global_load_lds((const unsigned*)((const char*)(gbase) + voffB[_i]), (LAS unsigned*)(lds + (bufoff) + ldsw + _i * 8192), 16, 0, 0); } while (0)
#define G_STAGE_A(bufoff, gbase, v0, v1) do { \
        __builtin_amdgcn_global_load_lds((const unsigned*)((const char*)(gbase) + (v0)), (LAS unsigned*)(lds + (bufoff) + ldsw), 16, 0, 0); \
        __builtin_amdgcn_global_load_lds((const unsigned*)((const char*)(gbase) + (v1)), (LAS unsigned*)(lds + (bufoff) + ldsw + 8192), 16, 0, 0); } while (0)
#define G_LDA(dst, b, h) do { _Pragma("unroll") for (int m = 0; m < 4; ++m) _Pragma("unroll") for (int k = 0; k < 2; ++k) dst[m][k] = *(const LAS bf16x8*)(lds + G_SA(b, h) + aoff + m * 2048 + k * 1024); } while (0)
#define G_LDB(dst, b, h) do { _Pragma("unroll") for (int n = 0; n < 2; ++n) _Pragma("unroll") for (int k = 0; k < 2; ++k) dst[n][k] = *(const LAS bf16x8*)(lds + G_SB(b, h) + boff + n * 2048 + k * 1024); } while (0)
#define G_MMA(ai, bj, At, Bt) do { __builtin_amdgcn_s_setprio(1); _Pragma("unroll") for (int m = 0; m < 4; ++m) _Pragma("unroll") for (int n = 0; n < 2; ++n) _Pragma("unroll") for (int k = 0; k < 2; ++k) \
        acc[ai][bj][m][n] = __builtin_amdgcn_mfma_f32_16x16x32_bf16(Bt[n][k], At[m][k], acc[ai][bj][m][n], 0, 0, 0); __builtin_amdgcn_s_setprio(0); } while (0)
#define G_WAIT_V(n) asm volatile("s_waitcnt vmcnt(" #n ")" ::: "memory")
#define G_WAIT_L(n) asm volatile("s_waitcnt lgkmcnt(" #n ")" ::: "memory")
#define G_BAR __builtin_amdgcn_s_barrier()
#define G_SCHED __builtin_amdgcn_sched_barrier(0)
    int z, pm, pn; P.unit(L, z, pm, pn);
    z = __builtin_amdgcn_readfirstlane(z); pm = __builtin_amdgcn_readfirstlane(pm); pn = __builtin_amdgcn_readfirstlane(pn);
    unsigned vA00 = P.aoffb(z, pm * BM + Rs0) + Cs0 * 2, vA01 = P.aoffb(z, pm * BM + Rs1) + Cs1 * 2;
    unsigned vA10 = P.aoffb(z, pm * BM + HALF + Rs0) + Cs0 * 2, vA11 = P.aoffb(z, pm * BM + HALF + Rs1) + Cs1 * 2;
    const char* const Ab = (const char*)P.A;
    const char* cB = (const char*)P.Bt(z) + (size_t)pn * tstepB;
    f32x4 acc[2][2][4][2];
    bf16x8 At[4][2], B0[2][2], B1[2][2];
    G_STAGE_B(G_SB(0, 0), cB); G_STAGE_A(G_SA(0, 0), Ab, vA00, vA01); G_STAGE_B(G_SB(0, 1), cB + hstepB); G_STAGE_A(G_SA(0, 1), Ab, vA10, vA11);
    if (wr == 1) G_BAR;
    G_WAIT_V(4); G_BAR;
    G_STAGE_B(G_SB(1, 0), cB + kstep); G_STAGE_A(G_SA(1, 0), Ab + kstep, vA00, vA01); G_STAGE_B(G_SB(1, 1), cB + hstepB + kstep);
    G_WAIT_V(6); G_BAR;
    for (;;) {
        const int Ln = L + G; const bool has_next = Ln < nun;
        int nz = z, npm = pm, npn = pn; if (has_next) P.unit(Ln, nz, npm, npn);
        nz = __builtin_amdgcn_readfirstlane(nz); npm = __builtin_amdgcn_readfirstlane(npm); npn = __builtin_amdgcn_readfirstlane(npn);
        const char* nB = has_next ? (const char*)P.Bt(nz) + (size_t)npn * tstepB : cB;
#pragma unroll
        for (int a = 0; a < 2; ++a)
#pragma unroll
            for (int b = 0; b < 2; ++b)
#pragma unroll
                for (int m = 0; m < 4; ++m)
#pragma unroll
                    for (int n = 0; n < 2; ++n) acc[a][b][m][n] = (f32x4){0.f, 0.f, 0.f, 0.f};
#pragma unroll 1
        for (int t = 0; t < nt; t += 2) {
            const bool last = (t == nt - 2);
            unsigned n00 = vA00, n01 = vA01, n10 = vA10, n11 = vA11;
            if (last && has_next) { n00 = P.aoffb(nz, npm * BM + Rs0) + Cs0 * 2; n01 = P.aoffb(nz, npm * BM + Rs1) + Cs1 * 2;
                n10 = P.aoffb(nz, npm * BM + HALF + Rs0) + Cs0 * 2; n11 = P.aoffb(nz, npm * BM + HALF + Rs1) + Cs1 * 2; }
            const char* a1 = Ab + (size_t)(t + 1) * kstep;
            const char* a2 = last ? Ab : Ab + (size_t)(t + 2) * kstep; const char* b2 = last ? nB : cB + (size_t)(t + 2) * kstep;
            const char* a3 = a2 + kstep; const char* b3 = b2 + kstep;
            G_LDB(B0, 0, 0); G_SCHED; G_LDA(At, 0, 0); G_STAGE_A(G_SA(1, 1), a1, vA10, vA11);
            G_WAIT_L(8); G_BAR; G_WAIT_L(0); G_MMA(0, 0, At, B0); G_BAR; G_SCHED;
            if (last) { vA00 = n00; vA01 = n01; vA10 = n10; vA11 = n11; }
            G_LDB(B1, 0, 1); G_STAGE_B(G_SB(0, 0), b2);
            G_BAR; G_WAIT_L(0); G_MMA(0, 1, At, B1); G_BAR;
            G_LDA(At, 0, 1); G_STAGE_A(G_SA(0, 0), a2, vA00, vA01);
            G_BAR; G_WAIT_L(0); G_MMA(1, 0, At, B0); G_BAR; G_SCHED;
            G_STAGE_B(G_SB(0, 1), b2 + hstepB);
            G_WAIT_V(6); G_BAR; G_MMA(1, 1, At, B1); G_BAR;
            G_LDB(B0, 1, 0); G_SCHED; G_LDA(At, 1, 0); G_STAGE_A(G_SA(0, 1), a2, vA10, vA11);
            G_WAIT_L(8); G_BAR; G_WAIT_L(0); G_MMA(0, 0, At, B0); G_BAR; G_SCHED;
            G_LDB(B1, 1, 1); G_STAGE_B(G_SB(1, 0), b3);
            G_BAR; G_WAIT_L(0); G_MMA(0, 1, At, B1); G_BAR;
            G_LDA(At, 1, 1); G_STAGE_A(G_SA(1, 0), a3, vA00, vA01);
            G_BAR; G_WAIT_L(0); G_MMA(1, 0, At, B0); G_BAR; G_SCHED;
            G_STAGE_B(G_SB(1, 1), b3 + hstepB);
            G_WAIT_V(6); G_BAR; G_MMA(1, 1, At, B1); G_BAR;
        }
        if constexpr (VMODE == 1) {
#pragma unroll
            for (int a_ = 0; a_ < 2; ++a_)
#pragma unroll
                for (int b_ = 0; b_ < 2; ++b_)
#pragma unroll
                    for (int m_ = 0; m_ < 4; ++m_)
#pragma unroll
                        for (int n_ = 0; n_ < 2; ++n_) asm volatile("" :: "v"(acc[a_][b_][m_][n_]));
        } else
        { const int Mz = VMODE == 2 ? 0 : __builtin_amdgcn_readfirstlane(P.M(z));
          if constexpr (VMODE == 2) {
#pragma unroll
            for (int a_ = 0; a_ < 2; ++a_)
#pragma unroll
                for (int b_ = 0; b_ < 2; ++b_)
#pragma unroll
                    for (int m_ = 0; m_ < 4; ++m_)
#pragma unroll
                        for (int n_ = 0; n_ < 2; ++n_) asm volatile("" :: "v"(acc[a_][b_][m_][n_])); }
          const int cb0 = pn * BM + wc * 32 + 8 * fq, rb0 = pm * BM + wr * 64 + fr;
          if constexpr (Prob::PAIR) {
              const typename Prob::ColCtx cc = P.colctx(z, cb0);
              typename Prob::RowCtx rc[2][4];
#pragma unroll
              for (int ai = 0; ai < 2; ++ai)
#pragma unroll
                  for (int m = 0; m < 4; ++m) { const int row = rb0 + ai * HALF + m * 16; rc[ai][m] = P.rowctx(z, row, row < Mz); }
#pragma unroll
              for (int ai = 0; ai < 2; ++ai)
#pragma unroll
                  for (int m = 0; m < 4; ++m) { const int row = rb0 + ai * HALF + m * 16;
                      if (row < Mz) { const f32x4 g0 = acc[ai][0][m][0], g1 = acc[ai][0][m][1], l0 = acc[ai][1][m][0], l1 = acc[ai][1][m][1];
                          const float vg[8] = {g0[0], g0[1], g0[2], g0[3], g1[0], g1[1], g1[2], g1[3]}, vl[8] = {l0[0], l0[1], l0[2], l0[3], l1[0], l1[1], l1[2], l1[3]};
                          P.storepair(cc, rc[ai][m], vg, vl); } }
          } else if constexpr (Prob::HOIST) {
              typename Prob::ColCtx cc[2]; typename Prob::RowCtx rc[2][4];
#pragma unroll
              for (int bj = 0; bj < 2; ++bj) cc[bj] = P.colctx(z, cb0 + bj * HALF);
#pragma unroll
              for (int ai = 0; ai < 2; ++ai)
#pragma unroll
                  for (int m = 0; m < 4; ++m) { const int row = rb0 + ai * HALF + m * 16; rc[ai][m] = P.rowctx(z, row, row < Mz); }
#pragma unroll
              for (int ai = 0; ai < 2; ++ai)
#pragma unroll
                  for (int m = 0; m < 4; ++m) { const int row = rb0 + ai * HALF + m * 16;
                      if (row < Mz) {
#pragma unroll
                          for (int bj = 0; bj < 2; ++bj) { const f32x4 v0 = acc[ai][bj][m][0], v1 = acc[ai][bj][m][1];
                              const float v[8] = {v0[0], v0[1], v0[2], v0[3], v1[0], v1[1], v1[2], v1[3]};
                              P.storeh(cc[bj], rc[ai][m], cb0 + bj * HALF, v); } } }
          } else {
#pragma unroll
          for (int ai = 0; ai < 2; ++ai)
#pragma unroll
            for (int m = 0; m < 4; ++m) { const int row = rb0 + ai * HALF + m * 16;
                if (row < Mz) {
#pragma unroll
                    for (int bj = 0; bj < 2; ++bj) { const int c0 = cb0 + bj * HALF;
                        const f32x4 v0 = acc[ai][bj][m][0], v1 = acc[ai][bj][m][1];
                        const float v[8] = {v0[0], v0[1], v0[2], v0[3], v1[0], v1[1], v1[2], v1[3]};
                        P.store(z, row, c0, v); } }
                asm volatile("" ::: "memory"); } } }
        if (!has_next) break;
        z = nz; pm = npm; pn = npn; cB = nB; L = Ln;
    }
    G_WAIT_V(0);
    if (wr == 0) G_BAR;
    G_BAR;
}

template <int NT, bool REV> DEVI void moe_unit(const LAS int* ub, int L, int G, int& z, int& pm, int& pn) {
    const int nun = __builtin_amdgcn_readfirstlane(ub[NEXP]) * NT;
    int Lq = L;
    if ((G & 7) == 0) { const int i = L / G, c = L - i * G, x = c & 7, j = c >> 3, per = G >> 3; Lq = (i * 8 + x) * per + j; }
    if (Lq >= nun) { z = -1; pm = 0; pn = 0; return; }
    if (REV) Lq = nun - 1 - Lq;
    int e = 0; while (e < NEXP - 1 && Lq >= __builtin_amdgcn_readfirstlane(ub[e + 1]) * NT) ++e;
    const int l = Lq - __builtin_amdgcn_readfirstlane(ub[e]) * NT; z = e; pm = l / NT; pn = l % NT;
}
struct FMoe1 {
    static constexpr bool HOIST = true, PAIR = true, RV = false; static constexpr int NT = 8;
    const bf16_t* A; const bf16_t* B; int K; const int* cnt; const int* list; const float* b_gu; bf16_t* ACT; const LAS int* ub; int G;
    struct ColCtx { float bg[8], bl[8]; int f0; }; struct RowCtx { bf16_t* p; };
    DEVI int ubs(int e) const { return __builtin_amdgcn_readfirstlane(ub[e]); }
    DEVI int nunits() const { const int n = ubs(NEXP) * NT; return (G & 7) == 0 ? (n + G - 1) / G * G : n; }
    DEVI void unit(int L, int& z, int& pm, int& pn) const { moe_unit<NT, RV>(ub, L, G, z, pm, pn); }
    DEVI int M(int z) const { return z < 0 ? 0 : cnt[z]; }
    DEVI unsigned aoffb(int z, int r) const { const int t = (z >= 0 && r < cnt[z]) ? (list[z * LISTCAP + r] >> 2) : 0; return (unsigned)t * (unsigned)(DM * 2); }
    DEVI const bf16_t* Bt(int z) const { return B + (size_t)(z < 0 ? 0 : z) * 2048 * DM; }
    DEVI ColCtx colctx(int z, int c0) const { ColCtx c; c.f0 = (c0 >> 8) * 128 + (c0 & 127); const float* bp = b_gu + (size_t)(z < 0 ? 0 : z) * 2048 + c.f0;
        const float4 g0 = *(const float4*)bp, g1 = *(const float4*)(bp + 4), l0 = *(const float4*)(bp + 1024), l1 = *(const float4*)(bp + 1028);
        c.bg[0] = g0.x; c.bg[1] = g0.y; c.bg[2] = g0.z; c.bg[3] = g0.w; c.bg[4] = g1.x; c.bg[5] = g1.y; c.bg[6] = g1.z; c.bg[7] = g1.w;
        c.bl[0] = l0.x; c.bl[1] = l0.y; c.bl[2] = l0.z; c.bl[3] = l0.w; c.bl[4] = l1.x; c.bl[5] = l1.y; c.bl[6] = l1.z; c.bl[7] = l1.w; return c; }
    DEVI RowCtx rowctx(int z, int r, bool) const { RowCtx x; x.p = ACT + (size_t)(ubs(z < 0 ? 0 : z) * 256 + r) * DFF; return x; }
    DEVI void storepair(const ColCtx& c, const RowCtx& x, const float (&vg)[8], const float (&vl)[8]) const { float a[8];
#pragma unroll
        for (int i = 0; i < 8; ++i) { float g = vg[i] + c.bg[i], l = vl[i] + c.bl[i]; g = fminf(g, 7.f); l = fminf(fmaxf(l, -7.f), 7.f); a[i] = (l + 1.f) * g * __builtin_amdgcn_rcpf(1.f + __expf(-1.702f * g)); }
        uint4 o; o.x = pk2(a[0], a[1]); o.y = pk2(a[2], a[3]); o.z = pk2(a[4], a[5]); o.w = pk2(a[6], a[7]); *(uint4*)(x.p + c.f0) = o; }
    DEVI void storeh(const ColCtx&, const RowCtx&, int, const float (&)[8]) const {}
    DEVI void store(int, int, int, const float (&)[8]) const {}
};
struct FMoe2 {
    static constexpr bool HOIST = true, PAIR = false, RV = true; static constexpr int NT = 4;
    const bf16_t* A; const bf16_t* B; int K; const int* cnt; const float* b_down; bf16_t* Y2; const LAS int* ub; int G;
    struct ColCtx { float bd[8]; }; struct RowCtx { bf16_t* p; };
    DEVI int ubs(int e) const { return __builtin_amdgcn_readfirstlane(ub[e]); }
    DEVI int nunits() const { const int n = ubs(NEXP) * NT; return (G & 7) == 0 ? (n + G - 1) / G * G : n; }
    DEVI void unit(int L, int& z, int& pm, int& pn) const { moe_unit<NT, RV>(ub, L, G, z, pm, pn); }
    DEVI int M(int z) const { return z < 0 ? 0 : cnt[z]; }
    DEVI unsigned aoffb(int z, int r) const { return (unsigned)(ubs(z < 0 ? 0 : z) * 256 + r) * (unsigned)(DFF * 2); }
    DEVI const bf16_t* Bt(int z) const { return B + (size_t)(z < 0 ? 0 : z) * DM * DFF; }
    DEVI ColCtx colctx(int z, int c0) const { ColCtx c; const float* bp = b_down + (size_t)(z < 0 ? 0 : z) * DM + c0; const float4 a = *(const float4*)bp, b = *(const float4*)(bp + 4);
        c.bd[0] = a.x; c.bd[1] = a.y; c.bd[2] = a.z; c.bd[3] = a.w; c.bd[4] = b.x; c.bd[5] = b.y; c.bd[6] = b.z; c.bd[7] = b.w; return c; }
    DEVI RowCtx rowctx(int z, int r, bool) const { RowCtx x; x.p = Y2 + (size_t)(ubs(z < 0 ? 0 : z) * 256 + r) * DM; return x; }
    DEVI void storeh(const ColCtx& c, const RowCtx& x, int c0, const float (&v)[8]) const {
        uint4 o; o.x = pk2(v[0] + c.bd[0], v[1] + c.bd[1]); o.y = pk2(v[2] + c.bd[2], v[3] + c.bd[3]); o.z = pk2(v[4] + c.bd[4], v[5] + c.bd[5]); o.w = pk2(v[6] + c.bd[6], v[7] + c.bd[7]);
        *(uint4*)(x.p + c0) = o; }
    DEVI void store(int, int, int, const float (&)[8]) const {}
};

struct MArgs { const float* in[30]; float* out; unsigned char* ws; int ph_lo, ph_hi; };
struct MArgs_in { const float *lam_re, *lam_im, *log_dt, *b_re, *b_im, *c_re, *c_im; };

constexpr int GL_LRS = 0, GL_TOT = 8192, GL_QF = 12288, GL_KF = 21504, GL_QB = 30720, GL_KB = 39936, GL_VT = 49152, GL_PP = 67584, GL_SSQ = 76800, GL_UST = 67584;
constexpr int GL_LD = 72;

struct GlaPtrs { const bf16_t* QK; const bf16_t* V; const bf16_t* R; const float* LR; const float* lr_up; const float* lr_bias; const float* nw; bf16_t* UCH; float* ADEC; bf16_t* SST; bf16_t* MIX; bf16_t* GLT; };

DEVI void gla_gates(const GlaPtrs& G, LAS unsigned char* lds, int h, int d, int to, float (&cf)[8], float (&cb)[8]) {
    const LAS float* LRS = (const LAS float*)(lds + GL_LRS); LAS float* TOT = (LAS float*)(lds + GL_TOT);
#pragma unroll
    for (int dir = 0; dir < 2; ++dir) {
        float up[16];
#pragma unroll
        for (int r = 0; r < 16; ++r) up[r] = G.lr_up[dir * 4096 + r * 256 + h * 64 + d];
        const float bias = G.lr_bias[dir * 256 + h * 64 + d];
        float la[8];
#pragma unroll
        for (int j = 0; j < 8; ++j) { const LAS f32x4* lp = (const LAS f32x4*)(LRS + (to * 8 + j) * 32 + dir * 16); float g = bias;
#pragma unroll
            for (int q = 0; q < 4; ++q) { const f32x4 x = lp[q]; g += x[0] * up[4 * q] + x[1] * up[4 * q + 1] + x[2] * up[4 * q + 2] + x[3] * up[4 * q + 3]; }
            la[j] = logsigmoidf_(g) * (1.f / 16.f); }
        if (dir == 0) { cf[0] = la[0];
#pragma unroll
            for (int j = 1; j < 8; ++j) cf[j] = cf[j - 1] + la[j];
            TOT[(0 * 8 + to) * 64 + d] = cf[7]; }
        else { cb[7] = la[7];
#pragma unroll
            for (int j = 6; j >= 0; --j) cb[j] = cb[j + 1] + la[j];
            TOT[(1 * 8 + to) * 64 + d] = cb[0]; }
    }
}
DEVI void gla_stage(const GlaPtrs& G, LAS unsigned char* lds, int row0, int h, int tid) {
    *(LAS f32x4*)(lds + GL_LRS + tid * 16) = *(const f32x4*)(G.LR + (size_t)row0 * 32 + tid * 4);
    const int ep = tid & 63, to = tid >> 6; unsigned w[8];
#pragma unroll
    for (int j = 0; j < 8; ++j) w[j] = *(const unsigned*)(G.V + (size_t)(row0 + to * 8 + j) * 512 + h * 128 + 2 * ep);
    u32x4 lo, hi;
    lo.x = (w[0] & 0xffffu) | (w[1] << 16); lo.y = (w[2] & 0xffffu) | (w[3] << 16); lo.z = (w[4] & 0xffffu) | (w[5] << 16); lo.w = (w[6] & 0xffffu) | (w[7] << 16);
    hi.x = (w[0] >> 16) | (w[1] & 0xffff0000u); hi.y = (w[2] >> 16) | (w[3] & 0xffff0000u); hi.z = (w[4] >> 16) | (w[5] & 0xffff0000u); hi.w = (w[6] >> 16) | (w[7] & 0xffff0000u);
    *(LAS u32x4*)(lds + GL_VT + ((2 * ep) * GL_LD + to * 8) * 2) = lo;
    *(LAS u32x4*)(lds + GL_VT + ((2 * ep + 1) * GL_LD + to * 8) * 2) = hi;
}

DEVI void gla_a_item(const GlaPtrs& G, LAS unsigned char* lds, int item) {
    int tid = threadIdx.x; asm volatile("" : "+v"(tid));
    const int wave = __builtin_amdgcn_readfirstlane(tid >> 6), lane = tid & 63, d = lane, to = wave, fr = lane & 15, fq = lane >> 4;
    const int ch = item % 68, bh = item / 68, h = bh & 3, b = bh >> 2;
    const int row0 = ch < 4 ? NTOK + b * CTX + ch * 64 : b * SEQ + (ch - 4) * 64;
    gla_stage(G, lds, row0, h, tid);
    bf16_t kk[8];
#pragma unroll
    for (int j = 0; j < 8; ++j) kk[j] = G.QK[(size_t)(row0 + to * 8 + j) * 512 + 256 + h * 64 + d];
    __syncthreads();
    float cf[8], cb[8];
    gla_gates(G, lds, h, d, to, cf, cb);
    __syncthreads();
    const LAS float* TOT = (const LAS float*)(lds + GL_TOT);
    float offf = 0.f, offb = 0.f, totf = 0.f, totb = 0.f;
#pragma unroll
    for (int t = 0; t < 8; ++t) { const float a = TOT[(0 * 8 + t) * 64 + d], c = TOT[(1 * 8 + t) * 64 + d]; totf += a; totb += c; if (t < to) offf += a; if (t > to) offb += c; }
    float of[8], ob[8];
#pragma unroll
    for (int j = 0; j < 8; ++j) { const float kf = bf2f(kk[j]); of[j] = kf * __expf(totf - (cf[j] + offf)); ob[j] = kf * __expf(totb - (cb[j] + offb)); }
    { u32x4 w; w.x = pk2(of[0], of[1]); w.y = pk2(of[2], of[3]); w.z = pk2(of[4], of[5]); w.w = pk2(of[6], of[7]); *(LAS u32x4*)(lds + GL_QF + (d * GL_LD + to * 8) * 2) = w;
      w.x = pk2(ob[0], ob[1]); w.y = pk2(ob[2], ob[3]); w.z = pk2(ob[4], ob[5]); w.w = pk2(ob[6], ob[7]); *(LAS u32x4*)(lds + GL_KF + (d * GL_LD + to * 8) * 2) = w; }
    const int chain_f = bh * 2, step_f = ch < 4 ? ch : ch, step_b = ch < 4 ? 3 - ch : 4 + (67 - ch);
    if (to == 0) { G.ADEC[((size_t)chain_f * 68 + step_f) * 64 + d] = __expf(totf); G.ADEC[((size_t)(chain_f + 1) * 68 + step_b) * 64 + d] = __expf(totb); }
    __syncthreads();
    f32x4 acc[2][4];
#pragma unroll
    for (int dr = 0; dr < 2; ++dr)
#pragma unroll
        for (int dt = 0; dt < 4; ++dt) acc[dr][dt] = (f32x4){0.f, 0.f, 0.f, 0.f};
#pragma unroll
    for (int ks = 0; ks < 2; ++ks) { const bf16x8 a = *(const LAS bf16x8*)(lds + GL_VT + ((wave * 16 + fr) * GL_LD + ks * 32 + fq * 8) * 2);
#pragma unroll
        for (int dt = 0; dt < 4; ++dt) { const bf16x8 b0 = *(const LAS bf16x8*)(lds + GL_QF + ((dt * 16 + fr) * GL_LD + ks * 32 + fq * 8) * 2);
            const bf16x8 b1 = *(const LAS bf16x8*)(lds + GL_KF + ((dt * 16 + fr) * GL_LD + ks * 32 + fq * 8) * 2);
            acc[0][dt] = __builtin_amdgcn_mfma_f32_16x16x32_bf16(a, b0, acc[0][dt], 0, 0, 0); acc[1][dt] = __builtin_amdgcn_mfma_f32_16x16x32_bf16(a, b1, acc[1][dt], 0, 0, 0); } }
#pragma unroll
    for (int dr = 0; dr < 2; ++dr)
#pragma unroll
        for (int dt = 0; dt < 4; ++dt)
#pragma unroll
            for (int rg = 0; rg < 4; ++rg) *(LAS bf16_t*)(lds + GL_UST + ((dr * 128 + wave * 16 + 4 * fq + rg) * 64 + dt * 16 + fr) * 2) = f2bf(acc[dr][dt][rg]);
    __syncthreads();
#pragma unroll
    for (int i = 0; i < 4; ++i) { const int q = tid + i * NTHR, dr = q >> 10, off = (q & 1023) * 8;
        const u32x4 w = *(const LAS u32x4*)(lds + GL_UST + (dr * 8192 + off) * 2);
        const size_t chain = (size_t)chain_f + dr; const int step = dr ? step_b : step_f;
        *(u32x4*)(G.UCH + (chain * 68 + step) * 8192 + off) = w; }
    __syncthreads();
}

DEVI void gla_b_block(const GlaPtrs& G, LAS unsigned char* lds, int blk) {
    int tid = threadIdx.x; asm volatile("" : "+v"(tid));
    const int chain = blk >> 2, e = (blk & 3) * 32 + (tid >> 4), d4 = (tid & 15) * 4;
    for (int i = tid; i < 68 * 16; i += NTHR) ((LAS f32x4*)lds)[i] = ((const f32x4*)(G.ADEC + (size_t)chain * 68 * 64))[i];
    __syncthreads();
    const bf16_t* up = G.UCH + ((size_t)chain * 68 * 128 + e) * 64 + d4;
    bf16_t* sp = G.SST + ((size_t)chain * 64 * 128 + e) * 64 + d4;
    float S0 = 0.f, S1 = 0.f, S2 = 0.f, S3 = 0.f;
    uint2 cur[17], nxt[17];
#pragma unroll
    for (int j = 0; j < 17; ++j) cur[j] = *(const uint2*)(up + (size_t)j * 8192);
#pragma unroll 1
    for (int bt = 0; bt < 4; ++bt) {
        if (bt < 3) {
#pragma unroll
            for (int j = 0; j < 17; ++j) nxt[j] = *(const uint2*)(up + (size_t)((bt + 1) * 17 + j) * 8192); }
#pragma unroll
        for (int j = 0; j < 17; ++j) { const int step = bt * 17 + j;
            if (step >= 4) { uint2 o; o.x = pk2(S0, S1); o.y = pk2(S2, S3); *(uint2*)(sp + (size_t)(step - 4) * 8192) = o; }
            const f32x4 a = *(const LAS f32x4*)(lds + (step * 64 + d4) * 4);
            S0 = a[0] * S0 + __uint_as_float(cur[j].x << 16); S1 = a[1] * S1 + __uint_as_float(cur[j].x & 0xffff0000u);
            S2 = a[2] * S2 + __uint_as_float(cur[j].y << 16); S3 = a[3] * S3 + __uint_as_float(cur[j].y & 0xffff0000u); }
#pragma unroll
        for (int j = 0; j < 17; ++j) cur[j] = nxt[j];
    }
    __syncthreads();
}

DEVI void gla_c_item(const GlaPtrs& G, LAS unsigned char* lds, int item) {
    int tid = threadIdx.x; asm volatile("" : "+v"(tid));
    const int wave = __builtin_amdgcn_readfirstlane(tid >> 6), lane = tid & 63, d = lane, to = wave, fr = lane & 15, fq = lane >> 4;
    const int c = item & 63, bh = item >> 6, h = bh & 3, b = bh >> 2;
    const int row0 = b * SEQ + c * 64;
    gla_stage(G, lds, row0, h, tid);
    bf16_t qq[8], kk[8];
#pragma unroll
    for (int j = 0; j < 8; ++j) { const size_t o = (size_t)(row0 + to * 8 + j) * 512 + h * 64 + d; qq[j] = G.QK[o]; kk[j] = G.QK[o + 256]; }
    __syncthreads();
    float cf[8], cb[8];
    gla_gates(G, lds, h, d, to, cf, cb);
    __syncthreads();
    { const LAS float* TOT = (const LAS float*)(lds + GL_TOT);
      float offf = 0.f, offb = 0.f;
#pragma unroll
      for (int t = 0; t < 8; ++t) { if (t < to) offf += TOT[(0 * 8 + t) * 64 + d]; if (t > to) offb += TOT[(1 * 8 + t) * 64 + d]; }
#pragma unroll
      for (int j = 0; j < 8; ++j) { const float qf = bf2f(qq[j]) * 0.125f, kf = bf2f(kk[j]);
          const float ef = __expf(fmaxf(cf[j] + offf, -80.f)), eb = __expf(fmaxf(cb[j] + offb, -80.f));
          const int o = ((to * 8 + j) * GL_LD + d) * 2;
          *(LAS bf16_t*)(lds + GL_QF + o) = f2bf(qf * ef); *(LAS bf16_t*)(lds + GL_KF + o) = f2bf(kf * __builtin_amdgcn_rcpf(ef));
          *(LAS bf16_t*)(lds + GL_QB + o) = f2bf(qf * eb); *(LAS bf16_t*)(lds + GL_KB + o) = f2bf(kf * __builtin_amdgcn_rcpf(eb)); } }
    __syncthreads();
    { const int ti = wave >> 1;
#pragma unroll
      for (int u = 0; u < 2; ++u) { const int tj = (wave & 1) * 2 + u;
          f32x4 af = (f32x4){0.f, 0.f, 0.f, 0.f}, ab = (f32x4){0.f, 0.f, 0.f, 0.f};
          if (tj <= ti) {
#pragma unroll
              for (int ks = 0; ks < 2; ++ks) { const bf16x8 a = *(const LAS bf16x8*)(lds + GL_KF + ((tj * 16 + fr) * GL_LD + ks * 32 + fq * 8) * 2), bb = *(const LAS bf16x8*)(lds + GL_QF + ((ti * 16 + fr) * GL_LD + ks * 32 + fq * 8) * 2);
                  af = __builtin_amdgcn_mfma_f32_16x16x32_bf16(a, bb, af, 0, 0, 0); } }
          if (tj >= ti) {
#pragma unroll
              for (int ks = 0; ks < 2; ++ks) { const bf16x8 a = *(const LAS bf16x8*)(lds + GL_KB + ((tj * 16 + fr) * GL_LD + ks * 32 + fq * 8) * 2), bb = *(const LAS bf16x8*)(lds + GL_QB + ((ti * 16 + fr) * GL_LD + ks * 32 + fq * 8) * 2);
                  ab = __builtin_amdgcn_mfma_f32_16x16x32_bf16(a, bb, ab, 0, 0, 0); } }
          float p[4];
#pragma unroll
          for (int rg = 0; rg < 4; ++rg) { const int i = ti * 16 + fr, j = tj * 16 + 4 * fq + rg; p[rg] = (j <= i ? af[rg] : 0.f) + (j >= i ? ab[rg] : 0.f); }
          u32x2 w; w.x = pk2(p[0], p[1]); w.y = pk2(p[2], p[3]);
          *(LAS u32x2*)(lds + GL_PP + ((ti * 16 + fr) * GL_LD + tj * 16 + 4 * fq) * 2) = w; } }
    __syncthreads();
    const int tg = wave & 3, eh = wave >> 2;
    f32x4 acc[4];
#pragma unroll
    for (int et = 0; et < 4; ++et) acc[et] = (f32x4){0.f, 0.f, 0.f, 0.f};
    { const bf16_t* Sf = G.SST + ((size_t)(bh * 2) * 64 + c) * 8192; const bf16_t* Sb = G.SST + ((size_t)(bh * 2 + 1) * 64 + (63 - c)) * 8192;
#pragma unroll
      for (int ks = 0; ks < 2; ++ks) {
          const int bo = ((tg * 16 + fr) * GL_LD + ks * 32 + fq * 8) * 2;
          const bf16x8 bP = *(const LAS bf16x8*)(lds + GL_PP + bo), bF = *(const LAS bf16x8*)(lds + GL_QF + bo), bB = *(const LAS bf16x8*)(lds + GL_QB + bo);
#pragma unroll
          for (int et = 0; et < 4; ++et) { const int e = eh * 64 + et * 16 + fr;
              const bf16x8 aV = *(const LAS bf16x8*)(lds + GL_VT + (e * GL_LD + ks * 32 + fq * 8) * 2);
              const bf16x8 aF = *(const bf16x8*)(Sf + e * 64 + ks * 32 + fq * 8), aB = *(const bf16x8*)(Sb + e * 64 + ks * 32 + fq * 8);
              acc[et] = __builtin_amdgcn_mfma_f32_16x16x32_bf16(aV, bP, acc[et], 0, 0, 0);
              acc[et] = __builtin_amdgcn_mfma_f32_16x16x32_bf16(aF, bF, acc[et], 0, 0, 0);
              acc[et] = __builtin_amdgcn_mfma_f32_16x16x32_bf16(aB, bB, acc[et], 0, 0, 0); } } }
    float ss = 0.f;
#pragma unroll
    for (int et = 0; et < 4; ++et) ss += acc[et][0] * acc[et][0] + acc[et][1] * acc[et][1] + acc[et][2] * acc[et][2] + acc[et][3] * acc[et][3];
    ss += __shfl_xor(ss, 16); ss += __shfl_xor(ss, 32);
    LAS float* SSQ = (LAS float*)(lds + GL_SSQ);
    if (fq == 0) SSQ[eh * 64 + tg * 16 + fr] = ss;
    __syncthreads();
    const float rstd = rsqrtf((SSQ[tg * 16 + fr] + SSQ[64 + tg * 16 + fr]) * (1.f / 128.f) + 1e-6f);
    const int tok = row0 + tg * 16 + fr;
#pragma unroll
    for (int et = 0; et < 4; ++et) { const int e = eh * 64 + et * 16 + 4 * fq;
        const uint2 rv = *(const uint2*)(G.R + (size_t)tok * 512 + h * 128 + e); const f32x4 nw = *(const f32x4*)(G.nw + e);
        const float r0 = __uint_as_float(rv.x << 16), r1 = __uint_as_float(rv.x & 0xffff0000u), r2 = __uint_as_float(rv.y << 16), r3 = __uint_as_float(rv.y & 0xffff0000u);
        uint2 w; w.x = pk2(acc[et][0] * rstd * nw[0] * siluf_(r0), acc[et][1] * rstd * nw[1] * siluf_(r1)); w.y = pk2(acc[et][2] * rstd * nw[2] * siluf_(r2), acc[et][3] * rstd * nw[3] * siluf_(r3));
        *(uint2*)(G.MIX + (size_t)tok * DM + h * 128 + e) = w; }
    __syncthreads();
}

constexpr int GL_SF = 77312, GL_SB = 95744, GL_RQ = 114176, GL_RK = 122368;

struct GateW { float up[2][16]; float bias[2]; };
DEVI GateW gla_gatew(const GlaPtrs& G, int h, int d) { GateW w;
#pragma unroll
    for (int dir = 0; dir < 2; ++dir) {
#pragma unroll
        for (int r = 0; r < 16; ++r) w.up[dir][r] = G.lr_up[dir * 4096 + r * 256 + h * 64 + d];
        w.bias[dir] = G.lr_bias[dir * 256 + h * 64 + d]; }
    return w; }
DEVI void gla_gates2(const GateW& W, LAS unsigned char* lds, int d, int to, float (&cf)[8], float (&cb)[8]) {
    const LAS float* LRS = (const LAS float*)(lds + GL_LRS); LAS float* TOT = (LAS float*)(lds + GL_TOT);
#pragma unroll
    for (int dir = 0; dir < 2; ++dir) {
        float la[8];
#pragma unroll
        for (int j = 0; j < 8; ++j) { const LAS f32x4* lp = (const LAS f32x4*)(LRS + (to * 8 + j) * 32 + dir * 16); float g = W.bias[dir];
#pragma unroll
            for (int q = 0; q < 4; ++q) { const f32x4 x = lp[q]; g += x[0] * W.up[dir][4 * q] + x[1] * W.up[dir][4 * q + 1] + x[2] * W.up[dir][4 * q + 2] + x[3] * W.up[dir][4 * q + 3]; }
            la[j] = logsigmoidf_(g) * (1.f / 16.f); }
        if (dir == 0) { cf[0] = la[0];
#pragma unroll
            for (int j = 1; j < 8; ++j) cf[j] = cf[j - 1] + la[j];
            TOT[(0 * 8 + to) * 64 + d] = cf[7]; }
        else { cb[7] = la[7];
#pragma unroll
            for (int j = 6; j >= 0; --j) cb[j] = cb[j + 1] + la[j];
            TOT[(1 * 8 + to) * 64 + d] = cb[0]; }
    }
}
struct GIn { f32x4 lr; unsigned vv[8]; u32x4 kraw; u32x4 qraw; u32x4 sraw[4]; u32x2 rr[4]; };
template <bool WQ> DEVI void gla_load_common(const GlaPtrs& G, int row0, int h, int tid, GIn& I) {
    I.lr = *(const f32x4*)(G.LR + (size_t)row0 * 32 + tid * 4);
    const int ep = tid & 63, to = tid >> 6;
#pragma unroll
    for (int j = 0; j < 8; ++j) I.vv[j] = *(const unsigned*)(G.V + (size_t)(row0 + to * 8 + j) * 512 + h * 128 + 2 * ep);
    const int tok = tid >> 3, chunk = tid & 7;
    I.kraw = *(const u32x4*)(G.QK + (size_t)(row0 + tok) * 512 + 256 + h * 64 + chunk * 8);
    if (WQ) I.qraw = *(const u32x4*)(G.QK + (size_t)(row0 + tok) * 512 + h * 64 + chunk * 8);
}
template <bool WQ> DEVI void gla_stage_common(LAS unsigned char* lds, int tid, const GIn& I) {
    *(LAS f32x4*)(lds + GL_LRS + tid * 16) = I.lr;
    const int ep = tid & 63, to = tid >> 6; const unsigned* w = I.vv;
    u32x4 lo, hi;
    lo.x = (w[0] & 0xffffu) | (w[1] << 16); lo.y = (w[2] & 0xffffu) | (w[3] << 16); lo.z = (w[4] & 0xffffu) | (w[5] << 16); lo.w = (w[6] & 0xffffu) | (w[7] << 16);
    hi.x = (w[0] >> 16) | (w[1] & 0xffff0000u); hi.y = (w[2] >> 16) | (w[3] & 0xffff0000u); hi.z = (w[4] >> 16) | (w[5] & 0xffff0000u); hi.w = (w[6] >> 16) | (w[7] & 0xffff0000u);
    *(LAS u32x4*)(lds + GL_VT + ((2 * ep) * GL_LD + to * 8) * 2) = lo;
    *(LAS u32x4*)(lds + GL_VT + ((2 * ep + 1) * GL_LD + to * 8) * 2) = hi;
    *(LAS u32x4*)(lds + GL_RK + tid * 16) = I.kraw;
    if (WQ) *(LAS u32x4*)(lds + GL_RQ + tid * 16) = I.qraw;
}

DEVI void gla_a_phase(const GlaPtrs& G, LAS unsigned char* lds, int bid, int Gsz) {
    int tid = threadIdx.x; asm volatile("" : "+v"(tid));
    const int wave = __builtin_amdgcn_readfirstlane(tid >> 6), lane = tid & 63, d = lane, to = wave, fr = lane & 15, fq = lane >> 4;
    constexpr int NIT = NB * 4 * 68;
    if (bid >= NIT) return;
#define GA_ROW0(it) (((it) % 68) < 4 ? NTOK + (((it) / 68) >> 2) * CTX + ((it) % 68) * 64 : (((it) / 68) >> 2) * SEQ + (((it) % 68) - 4) * 64)
    GIn cur; gla_load_common<true>(G, GA_ROW0(bid), (bid / 68) & 3, tid, cur);
    int hw = -1; GateW W;
    for (int item = bid; item < NIT; item += Gsz) {
        const int ch = item % 68, bh = item / 68, h = bh & 3;
        if (h != hw) { W = gla_gatew(G, h, d); hw = h; }
        gla_stage_common<true>(lds, tid, cur);
        __syncthreads();
        { const int nit = item + Gsz; if (nit < NIT) gla_load_common<true>(G, GA_ROW0(nit), (nit / 68) & 3, tid, cur); }
        float cf[8], cb[8];
        gla_gates2(W, lds, d, to, cf, cb);
        __syncthreads();
        const LAS float* TOT = (const LAS float*)(lds + GL_TOT);
        float offf = 0.f, offb = 0.f, totf = 0.f, totb = 0.f;
#pragma unroll
        for (int t = 0; t < 8; ++t) { const float a = TOT[(0 * 8 + t) * 64 + d], c = TOT[(1 * 8 + t) * 64 + d]; totf += a; totb += c; if (t < to) offf += a; if (t > to) offb += c; }
        float of[8], ob[8];
        bf16_t* gt = G.GLT + ((size_t)(bh * 64 + (ch - 4)) * 4) * 4096;
#pragma unroll
        for (int j = 0; j < 8; ++j) { const int ro = ((to * 8 + j) * 64 + d) * 2; const float kf = bf2f(*(const LAS bf16_t*)(lds + GL_RK + ro));
            of[j] = kf * __expf(totf - (cf[j] + offf)); ob[j] = kf * __expf(totb - (cb[j] + offb));
            if (ch >= 4) { const float qf = bf2f(*(const LAS bf16_t*)(lds + GL_RQ + ro)) * 0.125f;
                const float ef = __expf(fmaxf(cf[j] + offf, -80.f)), eb = __expf(fmaxf(cb[j] + offb, -80.f)); const int go = (to * 8 + j) * 64 + d;
                gt[go] = f2bf(qf * ef); gt[4096 + go] = f2bf(kf * __builtin_amdgcn_rcpf(ef)); gt[8192 + go] = f2bf(qf * eb); gt[12288 + go] = f2bf(kf * __builtin_amdgcn_rcpf(eb)); } }
        { u32x4 w; w.x = pk2(of[0], of[1]); w.y = pk2(of[2], of[3]); w.z = pk2(of[4], of[5]); w.w = pk2(of[6], of[7]); *(LAS u32x4*)(lds + GL_QF + (d * GL_LD + to * 8) * 2) = w;
          w.x = pk2(ob[0], ob[1]); w.y = pk2(ob[2], ob[3]); w.z = pk2(ob[4], ob[5]); w.w = pk2(ob[6], ob[7]); *(LAS u32x4*)(lds + GL_KF + (d * GL_LD + to * 8) * 2) = w; }
        const int chain_f = bh * 2, step_f = ch, step_b = ch < 4 ? 3 - ch : 71 - ch;
        if (to == 0) { G.ADEC[((size_t)chain_f * 68 + step_f) * 64 + d] = __expf(totf); G.ADEC[((size_t)(chain_f + 1) * 68 + step_b) * 64 + d] = __expf(totb); }
        __syncthreads();
        f32x4 acc[2][4];
#pragma unroll
        for (int dr = 0; dr < 2; ++dr)
#pragma unroll
            for (int dt = 0; dt < 4; ++dt) acc[dr][dt] = (f32x4){0.f, 0.f, 0.f, 0.f};
#pragma unroll
        for (int ks = 0; ks < 2; ++ks) { const bf16x8 a = *(const LAS bf16x8*)(lds + GL_VT + ((wave * 16 + fr) * GL_LD + ks * 32 + fq * 8) * 2);
#pragma unroll
            for (int dt = 0; dt < 4; ++dt) { const bf16x8 b0 = *(const LAS bf16x8*)(lds + GL_QF + ((dt * 16 + fr) * GL_LD + ks * 32 + fq * 8) * 2);
                const bf16x8 b1 = *(const LAS bf16x8*)(lds + GL_KF + ((dt * 16 + fr) * GL_LD + ks * 32 + fq * 8) * 2);
                acc[0][dt] = __builtin_amdgcn_mfma_f32_16x16x32_bf16(a, b0, acc[0][dt], 0, 0, 0); acc[1][dt] = __builtin_amdgcn_mfma_f32_16x16x32_bf16(a, b1, acc[1][dt], 0, 0, 0); } }
#pragma unroll
        for (int dr = 0; dr < 2; ++dr)
#pragma unroll
            for (int dt = 0; dt < 4; ++dt)
#pragma unroll
                for (int rg = 0; rg < 4; ++rg) *(LAS bf16_t*)(lds + GL_UST + ((dr * 128 + wave * 16 + 4 * fq + rg) * 64 + dt * 16 + fr) * 2) = f2bf(acc[dr][dt][rg]);
        __syncthreads();
#pragma unroll
        for (int i = 0; i < 4; ++i) { const int q = tid + i * NTHR, dr = q >> 10, off = (q & 1023) * 8;
            const u32x4 w = *(const LAS u32x4*)(lds + GL_UST + (dr * 8192 + off) * 2);
            const size_t chain = (size_t)chain_f + dr; const int step = dr ? step_b : step_f;
            *(u32x4*)(G.UCH + (chain * 68 + step) * 8192 + off) = w; }
    }
#undef GA_ROW0
    __syncthreads();
}

struct CIn { unsigned vv[8]; u32x4 tl[4]; u32x4 sraw[4]; u32x2 rr[4]; };
DEVI void gla_c_load(const GlaPtrs& G, int item, int tid, int wave, int fr, int fq, CIn& I) {
    const int c = item & 63, bh = item >> 6, h = bh & 3, b = bh >> 2, row0 = b * SEQ + c * 64;
    const int ep = tid & 63, to = tid >> 6;
#pragma unroll
    for (int j = 0; j < 8; ++j) I.vv[j] = *(const unsigned*)(G.V + (size_t)(row0 + to * 8 + j) * 512 + h * 128 + 2 * ep);
    const bf16_t* gt = G.GLT + (size_t)item * 4 * 4096;
#pragma unroll
    for (int t = 0; t < 4; ++t) I.tl[t] = *(const u32x4*)(gt + t * 4096 + tid * 8);
    const bf16_t* Sf = G.SST + ((size_t)(bh * 2) * 64 + c) * 8192; const bf16_t* Sb = G.SST + ((size_t)(bh * 2 + 1) * 64 + (63 - c)) * 8192;
    I.sraw[0] = *(const u32x4*)(Sf + tid * 8); I.sraw[1] = *(const u32x4*)(Sf + (tid + NTHR) * 8); I.sraw[2] = *(const u32x4*)(Sb + tid * 8); I.sraw[3] = *(const u32x4*)(Sb + (tid + NTHR) * 8);
    const int tg = wave & 3, eh = wave >> 2, tok = row0 + tg * 16 + fr;
#pragma unroll
    for (int et = 0; et < 4; ++et) I.rr[et] = *(const u32x2*)(G.R + (size_t)tok * 512 + h * 128 + eh * 64 + et * 16 + 4 * fq);
}
DEVI void gla_c_phase(const GlaPtrs& G, LAS unsigned char* lds, int bid, int Gsz) {
    int tid = threadIdx.x; asm volatile("" : "+v"(tid));
    const int wave = __builtin_amdgcn_readfirstlane(tid >> 6), lane = tid & 63, fr = lane & 15, fq = lane >> 4;
    constexpr int NIT = NB * 4 * 64;
    if (bid >= NIT) return;
    const int tg = wave & 3, eh = wave >> 2;
    f32x4 nwv[4];
#pragma unroll
    for (int et = 0; et < 4; ++et) nwv[et] = *(const f32x4*)(G.nw + eh * 64 + et * 16 + 4 * fq);
    CIn cur; gla_c_load(G, bid, tid, wave, fr, fq, cur);
    for (int item = bid; item < NIT; item += Gsz) {
        const int c = item & 63, bh = item >> 6, h = bh & 3, b = bh >> 2, row0 = b * SEQ + c * 64;
        { const int ep = tid & 63, to = tid >> 6; const unsigned* w = cur.vv;
          u32x4 lo, hi;
          lo.x = (w[0] & 0xffffu) | (w[1] << 16); lo.y = (w[2] & 0xffffu) | (w[3] << 16); lo.z = (w[4] & 0xffffu) | (w[5] << 16); lo.w = (w[6] & 0xffffu) | (w[7] << 16);
          hi.x = (w[0] >> 16) | (w[1] & 0xffff0000u); hi.y = (w[2] >> 16) | (w[3] & 0xffff0000u); hi.z = (w[4] >> 16) | (w[5] & 0xffff0000u); hi.w = (w[6] >> 16) | (w[7] & 0xffff0000u);
          *(LAS u32x4*)(lds + GL_VT + ((2 * ep) * GL_LD + to * 8) * 2) = lo; *(LAS u32x4*)(lds + GL_VT + ((2 * ep + 1) * GL_LD + to * 8) * 2) = hi; }
        { const int r0 = tid >> 3, ck = tid & 7;
          *(LAS u32x4*)(lds + GL_QF + (r0 * GL_LD + ck * 8) * 2) = cur.tl[0]; *(LAS u32x4*)(lds + GL_KF + (r0 * GL_LD + ck * 8) * 2) = cur.tl[1];
          *(LAS u32x4*)(lds + GL_QB + (r0 * GL_LD + ck * 8) * 2) = cur.tl[2]; *(LAS u32x4*)(lds + GL_KB + (r0 * GL_LD + ck * 8) * 2) = cur.tl[3];
          *(LAS u32x4*)(lds + GL_SF + (r0 * GL_LD + ck * 8) * 2) = cur.sraw[0]; *(LAS u32x4*)(lds + GL_SF + ((r0 + 64) * GL_LD + ck * 8) * 2) = cur.sraw[1];
          *(LAS u32x4*)(lds + GL_SB + (r0 * GL_LD + ck * 8) * 2) = cur.sraw[2]; *(LAS u32x4*)(lds + GL_SB + ((r0 + 64) * GL_LD + ck * 8) * 2) = cur.sraw[3]; }
        u32x2 rcur[4];
#pragma unroll
        for (int et = 0; et < 4; ++et) rcur[et] = cur.rr[et];
        __syncthreads();
        { const int nit = item + Gsz; if (nit < NIT) gla_c_load(G, nit, tid, wave, fr, fq, cur); }
        { const int ti = wave >> 1;
#pragma unroll
          for (int u = 0; u < 2; ++u) { const int tj = (wave & 1) * 2 + u;
              f32x4 af = (f32x4){0.f, 0.f, 0.f, 0.f}, ab = (f32x4){0.f, 0.f, 0.f, 0.f};
              if (tj <= ti) {
#pragma unroll
                  for (int ks = 0; ks < 2; ++ks) { const bf16x8 a = *(const LAS bf16x8*)(lds + GL_KF + ((tj * 16 + fr) * GL_LD + ks * 32 + fq * 8) * 2), bb = *(const LAS bf16x8*)(lds + GL_QF + ((ti * 16 + fr) * GL_LD + ks * 32 + fq * 8) * 2);
                      af = __builtin_amdgcn_mfma_f32_16x16x32_bf16(a, bb, af, 0, 0, 0); } }
              if (tj >= ti) {
#pragma unroll
                  for (int ks = 0; ks < 2; ++ks) { const bf16x8 a = *(const LAS bf16x8*)(lds + GL_KB + ((tj * 16 + fr) * GL_LD + ks * 32 + fq * 8) * 2), bb = *(const LAS bf16x8*)(lds + GL_QB + ((ti * 16 + fr) * GL_LD + ks * 32 + fq * 8) * 2);
                      ab = __builtin_amdgcn_mfma_f32_16x16x32_bf16(a, bb, ab, 0, 0, 0); } }
              float p[4];
#pragma unroll
              for (int rg = 0; rg < 4; ++rg) { const int i = ti * 16 + fr, j = tj * 16 + 4 * fq + rg; p[rg] = (j <= i ? af[rg] : 0.f) + (j >= i ? ab[rg] : 0.f); }
              u32x2 w; w.x = pk2(p[0], p[1]); w.y = pk2(p[2], p[3]);
              *(LAS u32x2*)(lds + GL_PP + ((ti * 16 + fr) * GL_LD + tj * 16 + 4 * fq) * 2) = w; } }
        __syncthreads();
        f32x4 acc[4];
#pragma unroll
        for (int et = 0; et < 4; ++et) acc[et] = (f32x4){0.f, 0.f, 0.f, 0.f};
#pragma unroll
        for (int ks = 0; ks < 2; ++ks) {
            const int bo = ((tg * 16 + fr) * GL_LD + ks * 32 + fq * 8) * 2;
            const bf16x8 bP = *(const LAS bf16x8*)(lds + GL_PP + bo), bF = *(const LAS bf16x8*)(lds + GL_QF + bo), bB = *(const LAS bf16x8*)(lds + GL_QB + bo);
#pragma unroll
            for (int et = 0; et < 4; ++et) { const int ao = ((eh * 64 + et * 16 + fr) * GL_LD + ks * 32 + fq * 8) * 2;
                const bf16x8 aV = *(const LAS bf16x8*)(lds + GL_VT + ao), aF = *(const LAS bf16x8*)(lds + GL_SF + ao), aB = *(const LAS bf16x8*)(lds + GL_SB + ao);
                acc[et] = __builtin_amdgcn_mfma_f32_16x16x32_bf16(aV, bP, acc[et], 0, 0, 0);
                acc[et] = __builtin_amdgcn_mfma_f32_16x16x32_bf16(aF, bF, acc[et], 0, 0, 0);
                acc[et] = __builtin_amdgcn_mfma_f32_16x16x32_bf16(aB, bB, acc[et], 0, 0, 0); } }
        float ss = 0.f;
#pragma unroll
        for (int et = 0; et < 4; ++et) ss += acc[et][0] * acc[et][0] + acc[et][1] * acc[et][1] + acc[et][2] * acc[et][2] + acc[et][3] * acc[et][3];
        ss += __shfl_xor(ss, 16); ss += __shfl_xor(ss, 32);
        LAS float* SSQ = (LAS float*)(lds + GL_SSQ);
        if (fq == 0) SSQ[eh * 64 + tg * 16 + fr] = ss;
        __syncthreads();
        const float rstd = rsqrtf((SSQ[tg * 16 + fr] + SSQ[64 + tg * 16 + fr]) * (1.f / 128.f) + 1e-6f);
        const int tok = row0 + tg * 16 + fr;
#pragma unroll
        for (int et = 0; et < 4; ++et) { const int e = eh * 64 + et * 16 + 4 * fq; const u32x2 rv = rcur[et];
            const float r0 = __uint_as_float(rv.x << 16), r1 = __uint_as_float(rv.x & 0xffff0000u), r2 = __uint_as_float(rv.y << 16), r3 = __uint_as_float(rv.y & 0xffff0000u);
            uint2 w; w.x = pk2(acc[et][0] * rstd * nwv[et][0] * siluf_(r0), acc[et][1] * rstd * nwv[et][1] * siluf_(r1)); w.y = pk2(acc[et][2] * rstd * nwv[et][2] * siluf_(r2), acc[et][3] * rstd * nwv[et][3] * siluf_(r3));
            *(uint2*)(G.MIX + (size_t)tok * DM + h * 128 + e) = w; }
    }
    __syncthreads();
}

DEVI void s5w_build(const MArgs_in& in, unsigned char* ws, LAS unsigned char* lds, int g) {
    LAS float* LP = (LAS float*)lds;
    LAS float* BB = LP + 2 * 17 * 64 * 2;
    LAS float* CC = BB + 2 * 64 * 16 * 2;
    LAS float* KK = CC + 2 * 16 * 64 * 2;
    LAS float* CO = KK + 2 * 16 * 256;
    const int tid = threadIdx.x;
    S5P* P = (S5P*)(ws + OFF_S5P);
    if (tid < 128) { const int p = tid & 63, d = tid >> 6; const int i = (d * 32 + g) * 64 + p;
        const double dt = exp((double)in.log_dt[d * 32 + g]), lr = in.lam_re[i], li = in.lam_im[i];
        const double mag = exp(lr * dt), ar = mag * cos(li * dt), ai = mag * sin(li * dt);
        { const double nr = ar - 1.0, ni = ai, den = lr * lr + li * li; CO[(d * 64 + p) * 2] = (float)((nr * lr + ni * li) / den); CO[(d * 64 + p) * 2 + 1] = (float)((ni * lr - nr * li) / den); }
        double pr = 1.0, pi = 0.0;
        for (int n = 0; n < 17; ++n) { LP[((d * 17 + n) * 64 + p) * 2] = (float)pr; LP[((d * 17 + n) * 64 + p) * 2 + 1] = (float)pi;
            if (n == 16) { P->lam16[d][g][p][0] = (float)pr; P->lam16[d][g][p][1] = (float)pi; }
            const double tr = pr * ar - pi * ai, ti = pr * ai + pi * ar; pr = tr; pi = ti; } }
    for (int t = tid; t < 2 * 16 * 64; t += NTHR) { const int p = t & 63, h = (t >> 6) & 15, d = t >> 10; const size_t ix = (((size_t)d * 32 + g) * 16 + h) * 64 + p;
        CC[((d * 16 + h) * 64 + p) * 2] = in.c_re[ix]; CC[((d * 16 + h) * 64 + p) * 2 + 1] = in.c_im[ix]; }
    __syncthreads();
    for (int t = tid; t < 2 * 64 * 16; t += NTHR) { const int h = t & 15, p = (t >> 4) & 63, d = t >> 10; const size_t ix = (((size_t)d * 32 + g) * 64 + p) * 16 + h;
        const float br = in.b_re[ix], bi = in.b_im[ix], cr = CO[(d * 64 + p) * 2], ci = CO[(d * 64 + p) * 2 + 1];
        BB[((d * 64 + p) * 16 + h) * 2] = cr * br - ci * bi; BB[((d * 64 + p) * 16 + h) * 2 + 1] = cr * bi + ci * br; }
    __syncthreads();
    { const int h = tid & 15, n = (tid >> 4) & 15, d = tid >> 8; float acc[16];
#pragma unroll
      for (int q = 0; q < 16; ++q) acc[q] = 0.f;
      for (int p = 0; p < 64; ++p) { const float cr = CC[((d * 16 + h) * 64 + p) * 2], ci = CC[((d * 16 + h) * 64 + p) * 2 + 1], lr = LP[((d * 17 + n) * 64 + p) * 2], li = LP[((d * 17 + n) * 64 + p) * 2 + 1];
          const float tr = cr * lr - ci * li, ti = cr * li + ci * lr; const LAS f32x4* bb = (const LAS f32x4*)(BB + ((d * 64 + p) * 16) * 2);
#pragma unroll
          for (int q = 0; q < 8; ++q) { const f32x4 x = bb[q]; acc[2 * q] += tr * x[0] - ti * x[1]; acc[2 * q + 1] += tr * x[2] - ti * x[3]; } }
#pragma unroll
      for (int q = 0; q < 16; ++q) KK[(d * 16 + n) * 256 + h * 16 + q] = acc[q]; }
    __syncthreads();
    bf16_t* BF = (bf16_t*)(ws + OFF_S5BF) + (size_t)g * 256 * 256;
    for (int t = tid; t < 256 * 32; t += NTHR) { const int k8 = t & 31, row = t >> 5, p = (row & 127) >> 1, im = row & 1, d = row >> 7; float o[8];
#pragma unroll
        for (int q = 0; q < 8; ++q) { const int k = k8 * 8 + q, j = k >> 4, hp = k & 15, pw = d ? j : 15 - j;
            const float lr = LP[((d * 17 + pw) * 64 + p) * 2], li = LP[((d * 17 + pw) * 64 + p) * 2 + 1], br = BB[((d * 64 + p) * 16 + hp) * 2], bi = BB[((d * 64 + p) * 16 + hp) * 2 + 1];
            o[q] = im ? lr * bi + li * br : lr * br - li * bi; }
        uint4 w; w.x = pk2(o[0], o[1]); w.y = pk2(o[2], o[3]); w.z = pk2(o[4], o[5]); w.w = pk2(o[6], o[7]);
        *(uint4*)(BF + (size_t)row * 256 + k8 * 8) = w; }
    bf16_t* BY = (bf16_t*)(ws + OFF_S5BY) + (size_t)g * 256 * 512;
    for (int t = tid; t < 256 * 64; t += NTHR) { const int k8 = t & 63, n = t >> 6, i = n >> 4, h = n & 15; float o[8];
#pragma unroll
        for (int q = 0; q < 8; ++q) { const int k = k8 * 8 + q; float v;
            if (k < 256) { const int j = k >> 4, hp = k & 15; v = 0.f; if (i >= j) v += KK[(0 * 16 + (i - j)) * 256 + h * 16 + hp]; if (j >= i) v += KK[(1 * 16 + (j - i)) * 256 + h * 16 + hp]; }
            else { const int d = (k - 256) >> 7, r = (k - 256) & 127, p = r >> 1, im = r & 1, pw = d ? 16 - i : i + 1;
                const float cr = CC[((d * 16 + h) * 64 + p) * 2], ci = CC[((d * 16 + h) * 64 + p) * 2 + 1], lr = LP[((d * 17 + pw) * 64 + p) * 2], li = LP[((d * 17 + pw) * 64 + p) * 2 + 1];
                v = im ? -(cr * li + ci * lr) : cr * lr - ci * li; }
            o[q] = v; }
        uint4 w; w.x = pk2(o[0], o[1]); w.y = pk2(o[2], o[3]); w.z = pk2(o[4], o[5]); w.w = pk2(o[6], o[7]);
        *(uint4*)(BY + (size_t)n * 512 + k8 * 8) = w; }
    __syncthreads();
}
struct ProbS5F {
    static constexpr bool HOIST = false, PAIR = false;
    const bf16_t* A; const bf16_t* B; int K; float* F;
    DEVI int nunits() const { return 32 * 9; }
    DEVI void unit(int L, int& z, int& pm, int& pn) const { z = L & 31; pm = L >> 5; pn = 0; }
    DEVI int M(int) const { return 2304; }
    DEVI unsigned aoffb(int z, int r) const { return (unsigned)(z * 2304 + r) * 1024u; }
    DEVI const bf16_t* Bt(int z) const { return B + (size_t)z * 256 * 256; }
    DEVI void store(int z, int r, int c0, const float (&v)[8]) const { float* p = F + ((size_t)z * 2304 + r) * 256 + c0; *(float4*)p = make_float4(v[0], v[1], v[2], v[3]); *(float4*)(p + 4) = make_float4(v[4], v[5], v[6], v[7]); }
};
struct ProbS5Y {
    static constexpr bool HOIST = false, PAIR = false;
    const bf16_t* A; const bf16_t* B; int K; const float* dvec; bf16_t* YS;
    DEVI int nunits() const { return 32 * 8; }
    DEVI void unit(int L, int& z, int& pm, int& pn) const { z = L & 31; pm = L >> 5; pn = 0; }
    DEVI int M(int) const { return 2048; }
    DEVI unsigned aoffb(int z, int r) const { return (unsigned)(z * 2304 + r) * 1024u; }
    DEVI const bf16_t* Bt(int z) const { return B + (size_t)z * 256 * 512; }
    DEVI void store(int z, int r, int c0, const float (&v)[8]) const {
        const int b = r >> 8, sq = ((r & 255) << 4) + (c0 >> 4), gc = sq >> 6, gr = sq & 63, tok = b * SEQ + gr * 64 + gc, ch = z * 16 + (c0 & 15);
        const uint4 uv = *(const uint4*)(A + ((size_t)z * 2304 + r) * 512 + c0); const unsigned uw[4] = {uv.x, uv.y, uv.z, uv.w};
        const float4 d0 = *(const float4*)(dvec + ch), d1 = *(const float4*)(dvec + ch + 4); const float dd[8] = {d0.x, d0.y, d0.z, d0.w, d1.x, d1.y, d1.z, d1.w}; float o[8];
#pragma unroll
        for (int j = 0; j < 4; ++j) { o[2 * j] = gelu_tanh(v[2 * j] + dd[2 * j] * __uint_as_float(uw[j] << 16)); o[2 * j + 1] = gelu_tanh(v[2 * j + 1] + dd[2 * j + 1] * __uint_as_float(uw[j] & 0xffff0000u)); }
        uint4 w; w.x = pk2(o[0], o[1]); w.y = pk2(o[2], o[3]); w.z = pk2(o[4], o[5]); w.w = pk2(o[6], o[7]);
        *(uint4*)(YS + (size_t)tok * 512 + ch) = w;
    }
};
typedef float f32x2_t __attribute__((ext_vector_type(2)));
DEVI int s5_row(int st, int b, int dir) { return st < 16 ? 2048 + b * 16 + (dir ? 15 - st : st) : b * 256 + (dir ? 271 - st : st - 16); }
DEVI void s5_carry(const float* __restrict__ F, bf16_t* __restrict__ U2, const S5P* __restrict__ P, int id, int lane) {
    const int g = id & 31, dir = (id >> 5) & 1, b = id >> 6;
    const float l16r = P->lam16[dir][g][lane][0], l16i = P->lam16[dir][g][lane][1];
    const float* Fg = F + (size_t)g * 2304 * 256 + dir * 128 + 2 * lane;
    bf16_t* Ug = U2 + (size_t)g * 2304 * 512 + 256 + dir * 128 + 2 * lane;
    float hr = 0.f, hi = 0.f;
    f32x2_t b0[17], b1[17], b2[17], b3[17];
#define S5_LOAD(buf, bt) do { _Pragma("unroll") for (int j = 0; j < 17; ++j) buf[j] = *(const f32x2_t*)(Fg + (size_t)s5_row((bt) * 17 + j, b, dir) * 256); } while (0)
#define S5_PROC(buf, bt) do { _Pragma("unroll") for (int j = 0; j < 17; ++j) { const int st = (bt) * 17 + j; \
        if (st >= 16) *(unsigned*)(Ug + (size_t)s5_row(st, b, dir) * 512) = pk2(hr, hi); \
        const float tr = l16r * hr - l16i * hi + buf[j][0], ti = l16r * hi + l16i * hr + buf[j][1]; hr = tr; hi = ti; } } while (0)
    S5_LOAD(b0, 0); S5_LOAD(b1, 1); S5_LOAD(b2, 2);
#pragma unroll 1
    for (int bt = 0; bt < 16; bt += 4) {
        S5_LOAD(b3, bt + 3); S5_PROC(b0, bt);
        if (bt + 4 < 16) S5_LOAD(b0, bt + 4);
        S5_PROC(b1, bt + 1);
        if (bt + 5 < 16) S5_LOAD(b1, bt + 5);
        S5_PROC(b2, bt + 2);
        if (bt + 6 < 16) S5_LOAD(b2, bt + 6);
        S5_PROC(b3, bt + 3);
    }
#undef S5_LOAD
#undef S5_PROC
}
DEVI void ph_scans(const GlaPtrs& G, const float* __restrict__ F, bf16_t* __restrict__ U2, const S5P* __restrict__ P, LAS unsigned char* lds, int blk, bool do_gla, bool do_s5) {
    int tid = threadIdx.x; asm volatile("" : "+v"(tid));
    const int wave = __builtin_amdgcn_readfirstlane(tid >> 6), lane = tid & 63;
    const int chain = blk >> 2;
    if (do_gla) for (int i = tid; i < 68 * 16; i += NTHR) ((LAS f32x4*)lds)[i] = ((const f32x4*)(G.ADEC + (size_t)chain * 68 * 64))[i];
    __syncthreads();
    if (wave < 4) { if (do_gla) {
        const int e = (blk & 3) * 32 + (tid >> 3), d8 = (tid & 7) * 8;
        const bf16_t* up = G.UCH + ((size_t)chain * 68 * 128 + e) * 64 + d8;
        bf16_t* sp = G.SST + ((size_t)chain * 64 * 128 + e) * 64 + d8;
        float S[8];
#pragma unroll
        for (int q = 0; q < 8; ++q) S[q] = 0.f;
        u32x4 cur[17], nxt[17];
#pragma unroll
        for (int j = 0; j < 17; ++j) cur[j] = *(const u32x4*)(up + (size_t)j * 8192);
#pragma unroll 1
        for (int bt = 0; bt < 4; ++bt) {
            if (bt < 3) {
#pragma unroll
                for (int j = 0; j < 17; ++j) nxt[j] = *(const u32x4*)(up + (size_t)((bt + 1) * 17 + j) * 8192); }
#pragma unroll
            for (int j = 0; j < 17; ++j) { const int step = bt * 17 + j;
                if (step >= 4) { u32x4 o; o.x = pk2(S[0], S[1]); o.y = pk2(S[2], S[3]); o.z = pk2(S[4], S[5]); o.w = pk2(S[6], S[7]); *(u32x4*)(sp + (size_t)(step - 4) * 8192) = o; }
                const f32x4 a0 = *(const LAS f32x4*)(lds + (step * 64 + d8) * 4), a1 = *(const LAS f32x4*)(lds + (step * 64 + d8 + 4) * 4);
                const unsigned w0 = cur[j].x, w1 = cur[j].y, w2 = cur[j].z, w3 = cur[j].w;
                S[0] = a0[0] * S[0] + __uint_as_float(w0 << 16); S[1] = a0[1] * S[1] + __uint_as_float(w0 & 0xffff0000u);
                S[2] = a0[2] * S[2] + __uint_as_float(w1 << 16); S[3] = a0[3] * S[3] + __uint_as_float(w1 & 0xffff0000u);
                S[4] = a1[0] * S[4] + __uint_as_float(w2 << 16); S[5] = a1[1] * S[5] + __uint_as_float(w2 & 0xffff0000u);
                S[6] = a1[2] * S[6] + __uint_as_float(w3 << 16); S[7] = a1[3] * S[7] + __uint_as_float(w3 & 0xffff0000u); }
#pragma unroll
            for (int j = 0; j < 17; ++j) cur[j] = nxt[j];
        } } }
    else if (wave < 6) { if (do_s5) s5_carry(F, U2, P, blk * 2 + (wave - 4), lane); }
    __syncthreads();
}


constexpr int NPH = 12;

struct WItem { const float* src; bf16_t* dst; int K, N, c0, n0, k0; bool act; };
constexpr int WC_ITEMS = 18 * 4 + 4 * 2 + 8 * 4 + 32 * 16 * 4 + 32 * 8 * 4;
DEVI WItem wconv_decode(const MArgs& a, unsigned char* ws, int it) {
    constexpr int I0 = 18 * 4, I1 = I0 + 4 * 2, I2 = I1 + 8 * 4, I3 = I2 + 32 * 16 * 4, I4 = I3 + 32 * 8 * 4;
    WItem w; w.src = a.in[7]; w.dst = nullptr; w.K = DM; w.N = INC; w.c0 = 0; w.n0 = 0; w.k0 = 0; w.act = it < I4;
    if (w.act) {
        if (it < I0) { w.src = a.in[7]; w.dst = (bf16_t*)(ws + OFF_WIN); w.K = DM; w.N = INC; w.n0 = (it % 18) * 128; w.k0 = (it / 18) * 256; w.c0 = w.n0; }
        else if (it < I1) { const int r = it - I0; w.src = a.in[19]; w.dst = (bf16_t*)(ws + OFF_WGLU); w.K = 512; w.N = 512; w.n0 = (r % 4) * 128; w.k0 = (r / 4) * 256; w.c0 = w.n0; }
        else if (it < I2) { const int r = it - I1; w.src = a.in[21]; w.dst = (bf16_t*)(ws + OFF_WOUT); w.K = DM; w.N = DM; w.n0 = (r % 8) * 128; w.k0 = (r / 8) * 256; w.c0 = w.n0; }
        else if (it < I3) { const int r = it - I2, e = r / 64, q = r % 64; w.src = a.in[25] + (size_t)e * DM * 2048; w.dst = (bf16_t*)(ws + OFF_WG) + (size_t)e * 2048 * DM; w.K = DM; w.N = 2048;
            w.n0 = (q % 16) * 128; w.k0 = (q / 16) * 256; w.c0 = wsrc_col<1>(w.n0); }
        else { const int r = it - I3, e = r / 32, q = r % 32; w.src = a.in[27] + (size_t)e * DFF * DM; w.dst = (bf16_t*)(ws + OFF_WD) + (size_t)e * DM * DFF; w.K = DFF; w.N = DM; w.n0 = (q % 8) * 128; w.k0 = (q / 8) * 256; w.c0 = w.n0; }
    }
    return w;
}
DEVI void wconv_load(const WItem& w, int tid, f32x4 (&r)[16]) {
    const int l32 = tid & 31, kr = tid >> 5, col = w.c0 + 4 * l32; const bool ok = col < w.N; const int cc = ok ? col : 0;
    const float* p = w.src + (size_t)(w.k0 + kr) * w.N + cc; const size_t st = (size_t)16 * w.N;
#pragma unroll
    for (int i = 0; i < 16; ++i) r[i] = *(const f32x4*)(p + i * st);
}
DEVI void wconv_store(const WItem& cur, LAS unsigned char* lds, int tid, const f32x4 (&rc)[16]) {
    constexpr int TS = 264;
    const int l32 = tid & 31, kr = tid >> 5;
    const float okf = (cur.c0 + 4 * l32 < cur.N) ? 1.f : 0.f;
    const int sw = ((l32 >> 1) & 15) << 1;
#pragma unroll
    for (int i = 0; i < 16; ++i) { const int k = (kr + 16 * i) ^ sw;
#pragma unroll
        for (int c = 0; c < 4; ++c) *(LAS bf16_t*)(lds + ((4 * l32 + c) * TS + k) * 2) = f2bf(rc[i][c] * okf); }
    __syncthreads();
    if (cur.act) {
#pragma unroll
        for (int i = 0; i < 8; ++i) { const int ch = tid + NTHR * i, n = ch >> 5, c8 = ch & 31, sn = ((n >> 3) & 15) << 1, m = (sn >> 1) & 3;
            const u32x4 v = *(const LAS u32x4*)(lds + (n * TS + ((c8 ^ (sn >> 3)) * 8)) * 2);
            u32x4 o; o.x = (m & 1) ? v.y : v.x; o.y = (m & 1) ? v.x : v.y; o.z = (m & 1) ? v.w : v.z; o.w = (m & 1) ? v.z : v.w;
            if (m & 2) { const unsigned t0 = o.x, t1 = o.y; o.x = o.z; o.y = o.w; o.z = t0; o.w = t1; }
            *(u32x4*)(cur.dst + (size_t)(cur.n0 + n) * cur.K + cur.k0 + c8 * 8) = o; } }
    __syncthreads();
}
DEVI void ph_prep(const MArgs& a, LAS unsigned char* lds, int bid, int G) {
    const int tid = threadIdx.x, wave = tid >> 6, lane = tid & 63;
    unsigned char* ws = a.ws;
    const bool big = G > 136; const int nsp = big ? 32 : G;
    const bool special = !big || (bid >= 104 && bid < 136); const int sid = big ? bid - 104 : bid;
    if (special) {
        for (int i = sid * NTHR + tid; i < 2 * 32 * 64; i += nsp * NTHR) s5prep_one(a.in[11], a.in[12], a.in[13], a.in[14], a.in[15], (S5P*)(ws + OFF_S5P), i);
        for (int g = sid; g < 32; g += nsp) { MArgs_in in{a.in[11], a.in[12], a.in[13], a.in[14], a.in[15], a.in[16], a.in[17]}; s5w_build(in, ws, lds, g); }
    }
    { LAS float* s = (LAS float*)lds; LAS float* part = (LAS float*)(lds + 36864);
      const float* c = a.in[1]; const float* cc = a.in[3]; const float* ada_w = a.in[4]; float* MP = (float*)(ws + OFF_SST);
      typedef float f32x2 __attribute__((ext_vector_type(2)));
      bool have_s = false;
      for (int mi = bid; mi < 256; mi += G) {
          if (!have_s) { for (int i = tid; i < 9216; i += NTHR) { const int r = i >> 10, k = i & 1023; const float v = r < 8 ? c[r * 1024 + k] : cc[k]; s[i] = siluf_(v); } have_s = true; __syncthreads(); }
          const int ks = mi >> 4, cs = mi & 15, k0 = ks * 64 + wave * 8;
          f32x2 wv[3][8];
#pragma unroll
          for (int ps = 0; ps < 3; ++ps)
#pragma unroll
              for (int q = 0; q < 8; ++q) wv[ps][q] = *(const f32x2*)(ada_w + (size_t)(k0 + q) * 6144 + cs * 384 + ps * 128 + lane * 2);
#pragma unroll
          for (int ps = 0; ps < 3; ++ps) { float acc[9][2];
#pragma unroll
              for (int r = 0; r < 9; ++r) { acc[r][0] = 0.f; acc[r][1] = 0.f; }
#pragma unroll
              for (int q = 0; q < 8; ++q) {
#pragma unroll
                  for (int r = 0; r < 9; ++r) { const float sv = s[r * 1024 + k0 + q]; acc[r][0] += sv * wv[ps][q][0]; acc[r][1] += sv * wv[ps][q][1]; } }
#pragma unroll
              for (int r = 0; r < 9; ++r) { part[(wave * 9 + r) * 128 + lane * 2] = acc[r][0]; part[(wave * 9 + r) * 128 + lane * 2 + 1] = acc[r][1]; }
              __syncthreads();
              for (int i = tid; i < 9 * 128; i += NTHR) { const int r = i >> 7, l = i & 127; float sum = 0.f;
#pragma unroll
                  for (int w = 0; w < 8; ++w) sum += part[(w * 9 + r) * 128 + l];
                  MP[((size_t)ks * 9 + r) * 6144 + cs * 384 + ps * 128 + l] = sum; }
              __syncthreads(); }
      } }
    { unsigned* ctr = (unsigned*)(ws + OFF_CTL) + CW_WQ; volatile LAS int* q = (volatile LAS int*)(lds + MISC_OFF + 240);
      __syncthreads();
      if (tid == 0) { q[0] = (int)atomicAdd(ctr, 1u); q[1] = (int)atomicAdd(ctr, 1u); }
      __syncthreads();
      int ia = q[0], ib = q[1];
      f32x4 ra[16], rb[16];
      WItem wa = wconv_decode(a, ws, ia); wconv_load(wa, tid, ra);
      while (ia < WC_ITEMS) {
          const WItem wb = wconv_decode(a, ws, ib); wconv_load(wb, tid, rb);
          if (tid == 0) q[0] = (int)atomicAdd(ctr, 1u);
          wconv_store(wa, lds, tid, ra);
          ia = q[0];
          wa = wconv_decode(a, ws, ia); wconv_load(wa, tid, ra);
          if (tid == 0) q[1] = (int)atomicAdd(ctr, 1u);
          wconv_store(wb, lds, tid, rb);
          ib = q[1];
      } }
}


DEVI void ph_router(const float* __restrict__ X, const float* __restrict__ OUTB, const float* __restrict__ w, const float* __restrict__ mod, const float* __restrict__ rw, const float* __restrict__ rb,
                    bf16_t* __restrict__ H2, int* __restrict__ cnt, int* __restrict__ list, float* __restrict__ gate, int* __restrict__ epos, LAS unsigned char* lds, int bid, int G, bool commit) {
    int tid = threadIdx.x; asm volatile("" : "+v"(tid));
    const int wave = __builtin_amdgcn_readfirstlane(tid >> 6), lane = tid & 63, e16 = lane & 15, kq = lane >> 4;
    constexpr int HS = 1028;
    LAS float* hrow = (LAS float*)lds;
    LAS float* part = (LAS float*)(lds + 16 * HS * 4);
    LAS int* lcnt = (LAS int*)(lds + 16 * HS * 4 + 16384);
    LAS int* gbase = lcnt + 32; LAS int* ent = lcnt + 64;
    if (tid < 64) lcnt[tid] = 0;
    float wreg[2][32];
#pragma unroll
    for (int et = 0; et < 2; ++et)
#pragma unroll
        for (int q = 0; q < 32; ++q) wreg[et][q] = rw[(wave * 128 + kq * 32 + q) * 32 + et * 16 + e16];
    const float rbe = rb[lane & 31];
    const int per = (NTOK + G - 1) / G;
    const int t0 = bid * per, t1 = (t0 + per) < NTOK ? (t0 + per) : NTOK;
    float4 v[2][4]; uint2 mx[2][4];
#pragma unroll
    for (int u = 0; u < 2; ++u) { const int tok = t0 + wave * 2 + u; if (tok < t1) {
#pragma unroll
        for (int j = 0; j < 4; ++j) { v[u][j] = *(const float4*)(X + (size_t)tok * DM + lane * 4 + 256 * j); mx[u][j] = *(const uint2*)((const bf16_t*)(OUTB + (size_t)tok * DM) + DM + lane * 4 + 256 * j); } } }
    for (int tb = t0; tb < t1; tb += 16) {
#pragma unroll
        for (int u = 0; u < 2; ++u) { const int tok = tb + wave * 2 + u;
            if (tok < t1) {
                const int b = tok / SEQ; float ss = 0.f; const float* g1p = mod + b * 6144 + 2048;
#pragma unroll
                for (int j = 0; j < 4; ++j) { const float4 g1 = *(const float4*)(g1p + lane * 4 + 256 * j);
                    v[u][j].x += g1.x * __uint_as_float(mx[u][j].x << 16); v[u][j].y += g1.y * __uint_as_float(mx[u][j].x & 0xffff0000u);
                    v[u][j].z += g1.z * __uint_as_float(mx[u][j].y << 16); v[u][j].w += g1.w * __uint_as_float(mx[u][j].y & 0xffff0000u);
                    ss += v[u][j].x * v[u][j].x + v[u][j].y * v[u][j].y + v[u][j].z * v[u][j].z + v[u][j].w * v[u][j].w; }
                const float rstd = rsqrtf(wave_sum(ss) * (1.f / DM) + 1e-6f);
                const float* msh = mod + b * 6144 + 3072; const float* msc = mod + b * 6144 + 4096;
#pragma unroll
                for (int j = 0; j < 4; ++j) { const int k = lane * 4 + 256 * j;
                    const float4 ww = *(const float4*)(w + k), sc = *(const float4*)(msc + k), sh = *(const float4*)(msh + k);
                    f32x4 hv; hv[0] = v[u][j].x * rstd * ww.x * (1.f + sc.x) + sh.x; hv[1] = v[u][j].y * rstd * ww.y * (1.f + sc.y) + sh.y; hv[2] = v[u][j].z * rstd * ww.z * (1.f + sc.z) + sh.z; hv[3] = v[u][j].w * rstd * ww.w * (1.f + sc.w) + sh.w;
                    *(LAS f32x4*)(hrow + (wave * 2 + u) * HS + k) = hv;
                    uint2 o; o.x = pk2(hv[0], hv[1]); o.y = pk2(hv[2], hv[3]); *(uint2*)(H2 + (size_t)tok * DM + k) = o; }
            } else {
#pragma unroll
                for (int j = 0; j < 4; ++j) *(LAS f32x4*)(hrow + (wave * 2 + u) * HS + lane * 4 + 256 * j) = (f32x4){0.f, 0.f, 0.f, 0.f}; }
        }
#pragma unroll
        for (int u = 0; u < 2; ++u) { const int ntok = tb + 16 + wave * 2 + u; if (ntok < t1) {
#pragma unroll
            for (int j = 0; j < 4; ++j) { v[u][j] = *(const float4*)(X + (size_t)ntok * DM + lane * 4 + 256 * j); mx[u][j] = *(const uint2*)((const bf16_t*)(OUTB + (size_t)ntok * DM) + DM + lane * 4 + 256 * j); } } }
        __syncthreads();
        f32x4 acc0 = (f32x4){0.f, 0.f, 0.f, 0.f}, acc1 = (f32x4){0.f, 0.f, 0.f, 0.f};
#pragma unroll
        for (int i = 0; i < 8; ++i) { const f32x4 ar = *(const LAS f32x4*)(hrow + e16 * HS + wave * 128 + kq * 32 + 4 * i);
#pragma unroll
            for (int c = 0; c < 4; ++c) { acc0 = __builtin_amdgcn_mfma_f32_16x16x4f32(ar[c], wreg[0][4 * i + c], acc0, 0, 0, 0); acc1 = __builtin_amdgcn_mfma_f32_16x16x4f32(ar[c], wreg[1][4 * i + c], acc1, 0, 0, 0); } }
#pragma unroll
        for (int rg = 0; rg < 4; ++rg) { part[((wave * 2 + 0) * 16 + 4 * kq + rg) * 16 + e16] = acc0[rg]; part[((wave * 2 + 1) * 16 + 4 * kq + rg) * 16 + e16] = acc1[rg]; }
        __syncthreads();
        {
            const int t = wave * 2 + (lane >> 5), tk = tb + t, e = lane & 31, et = e >> 4, ee = e & 15;
            float lg = rbe;
#pragma unroll
            for (int q = 0; q < 8; ++q) lg += part[((q * 2 + et) * 16 + t) * 16 + ee];
            float val = lg; float tv[4]; int ti[4];
#pragma unroll
            for (int r = 0; r < 4; ++r) { float bv = val; int bi = e;
#pragma unroll
                for (int o = 1; o < 32; o <<= 1) { const float ov = __shfl_xor(bv, o); const int oi = __shfl_xor(bi, o); if (ov > bv || (ov == bv && oi < bi)) { bv = ov; bi = oi; } }
                tv[r] = bv; ti[r] = bi; if (e == bi) val = -3.0e38f; }
            const float e1 = __expf(tv[1] - tv[0]), e2 = __expf(tv[2] - tv[0]), e3 = __expf(tv[3] - tv[0]), inv = 1.f / (1.f + e1 + e2 + e3);
            if (e < 4 && tk < t1 && commit) { const float gv = e == 0 ? inv : e == 1 ? e1 * inv : e == 2 ? e2 * inv : e3 * inv; const int ex = e == 0 ? ti[0] : e == 1 ? ti[1] : e == 2 ? ti[2] : ti[3];
                const int ls = __hip_atomic_fetch_add(&lcnt[ex], 1, __ATOMIC_RELAXED, __HIP_MEMORY_SCOPE_WORKGROUP); ent[(tk - t0) * 4 + e] = (ex << 16) | ls; gate[tk * 4 + e] = gv; }
        }
    }
    __syncthreads();
    if (commit) {
        if (tid < NEXP) { const int c = lcnt[tid]; gbase[tid] = c ? atomicAdd(&cnt[tid], c) : 0; }
        __syncthreads();
        for (int i = tid; i < (t1 - t0) * 4; i += NTHR) { const int en = ent[i], ex = en >> 16, slot = gbase[ex] + (en & 0xffff), tk4 = t0 * 4 + i;
            list[ex * LISTCAP + slot] = tk4; epos[tk4] = ex * LISTCAP + slot; }
    }
    __syncthreads();
}

DEVI void build_ub(const int* cnt, volatile LAS int* ub) {
    if (threadIdx.x == 0) { int o = 0; for (int e = 0; e < NEXP; ++e) { ub[e] = o; o += (cnt[e] + 255) >> 8; } ub[NEXP] = o; }
    __syncthreads();
}

__global__ void __launch_bounds__(NTHR, 2) mega(MArgs a) {
    extern __shared__ __attribute__((aligned(16))) unsigned char lds_raw[];
    LAS unsigned char* lds = (LAS unsigned char*)lds_raw;
    volatile LAS unsigned* MISC = (volatile LAS unsigned*)(lds + MISC_OFF);
    const int tid = threadIdx.x, wave = __builtin_amdgcn_readfirstlane(tid >> 6), G = gridDim.x, bid = blockIdx.x;
    const int gw = bid * NWAVES + wave, NGW = G * NWAVES;
    for (int u = tid; u < MISC_BYTES / 4; u += NTHR) MISC[u] = 0u;
    __syncthreads();
    unsigned char* ws = a.ws; unsigned* ctl = (unsigned*)(ws + OFF_CTL);
    const bool multi = (a.ph_hi - a.ph_lo) > 1;
    XcdBarrier bar; bar.bar = ctl + CW_BAR; bar.x = 0; bar.st = MISC;
    if (multi) bar = xcd_barrier_post(ctl + CW_BAR, MISC);
    volatile LAS int* ub = (volatile LAS int*)(MISC + 16);
#ifndef PROBE_REP
#define PROBE_REP 0
#endif
#define IN(k) (a.ph_lo <= (k) && (k) < a.ph_hi)
#define NREP(k) (1 + ((PROBE_REP >> (k)) & 1))
#ifndef PROBE_VPH
#define PROBE_VPH -1
#endif
#ifndef PROBE_VMODE
#define PROBE_VMODE 1
#endif
#define FRESH_LANE int ft_ = threadIdx.x; asm volatile("" : "+v"(ft_)); const int lane = ft_ & 63; (void)lane
#ifndef PROBE_TK
#define PROBE_TK -1
#endif
    unsigned long long tstamp_prev = 0ull, tstamp_sel = 0ull;
    if (PROBE_TK >= 0) tstamp_prev = __builtin_amdgcn_s_memrealtime();
#define SEAM(k) do { if (IN(k) && IN((k) + 1)) xcd_barrier(bar); if (PROBE_TK >= 0) { const unsigned long long tn_ = __builtin_amdgcn_s_memrealtime(); if ((k) == PROBE_TK) tstamp_sel = tn_ - tstamp_prev; tstamp_prev = tn_; } } while (0)
    float* mod = (float*)(ws + OFF_MOD); S5P* s5p = (S5P*)(ws + OFF_S5P); float* gate = (float*)(ws + OFF_GATE); int* list = (int*)(ws + OFF_LIST);
    bf16_t* WIN = (bf16_t*)(ws + OFF_WIN); bf16_t* WGLU = (bf16_t*)(ws + OFF_WGLU); bf16_t* WOUT = (bf16_t*)(ws + OFF_WOUT); bf16_t* WG = (bf16_t*)(ws + OFF_WG); bf16_t* WD = (bf16_t*)(ws + OFF_WD);
    bf16_t* H = (bf16_t*)(ws + OFF_H); bf16_t* QK = (bf16_t*)(ws + OFF_QK); bf16_t* V = (bf16_t*)(ws + OFF_V); bf16_t* R = (bf16_t*)(ws + OFF_R); bf16_t* UT = (bf16_t*)(ws + OFF_UT);
    float* LR = (float*)(ws + OFF_LR); bf16_t* U2 = (bf16_t*)(ws + OFF_U2);
    bf16_t* YS = (bf16_t*)(ws + OFF_YS); bf16_t* MIX = (bf16_t*)(ws + OFF_MIX); bf16_t* ACT = (bf16_t*)(ws + OFF_ACT); bf16_t* YSL = (bf16_t*)(ws + OFF_YSL);
    int* cnt = (int*)(ctl + CW_CNT);

    if (IN(0)) for (int rp = 0; rp < NREP(0); ++rp) ph_prep(a, lds, bid, G);
    SEAM(0);
    if (IN(1)) {
        const float* MP = (const float*)(ws + OFF_SST); const float* ada_b = a.in[5];
        for (int i = bid * NTHR + tid; i < 9 * 6144; i += G * NTHR) { const int col = i % 6144; float sum = ada_b[col];
#pragma unroll
            for (int ks = 0; ks < 16; ++ks) sum += MP[(size_t)ks * 9 * 6144 + i];
            mod[i] = sum; }
        if (multi) xcd_barrier(bar);
    }
    if (IN(1)) for (int rp = 0; rp < NREP(1); ++rp) { FRESH_LANE; for (int row = gw; row < NROWS; row += NGW) norm_row(a.in[0], a.in[2], a.in[6], mod, H, row, lane, 0, 1024); }
    SEAM(1);
    if (IN(2) && PROBE_VPH == 2) { ProbIn P{H, DM, WIN, DM, DM, QK, V, R, UT, U2, LR}; gemm_phase<PROBE_VMODE>(lds, P, G, bid); }
    if (IN(2)) for (int rp = 0; rp < NREP(2); ++rp) { ProbIn P{H, DM, WIN, DM, DM, QK, V, R, UT, U2, LR}; gemm_phase(lds, P, G, bid); }
    SEAM(2);
    float* Fb = (float*)(ws + OFF_F); bf16_t* S5BF = (bf16_t*)(ws + OFF_S5BF); bf16_t* S5BY = (bf16_t*)(ws + OFF_S5BY);
    const GlaPtrs GP{QK, V, R, LR, a.in[8], a.in[9], a.in[10], (bf16_t*)(ws + OFF_UCH), (float*)(ws + OFF_ADEC), (bf16_t*)(ws + OFF_SST), MIX, (bf16_t*)(ws + OFF_GLT)};
    if (IN(3)) for (int rp = 0; rp < NREP(3); ++rp) {
        for (int r2 = 0; r2 < NREP(12); ++r2) { ProbS5F P{U2, S5BF, 256, Fb}; gemm_phase(lds, P, G, bid); }
        for (int r2 = 0; r2 < NREP(13); ++r2) gla_a_phase(GP, lds, bid, G);
    }
    SEAM(3);
    if (IN(4)) for (int rp = 0; rp < NREP(4); ++rp) {
        for (int blk = bid; blk < 256; blk += G) ph_scans(GP, Fb, U2, s5p, lds, blk, NREP(16) > 0, true);
    }
    SEAM(4);
    if (IN(5)) for (int rp = 0; rp < NREP(5); ++rp) {
        for (int r2 = 0; r2 < NREP(14); ++r2) { ProbS5Y P{U2, S5BY, 512, a.in[18], YS}; gemm_phase(lds, P, G, bid); }
        for (int r2 = 0; r2 < NREP(15); ++r2) gla_c_phase(GP, lds, bid, G);
    }
    SEAM(5);
    if (IN(6)) for (int rp = 0; rp < NREP(6); ++rp) { ProbGlu P{YS, 512, WGLU, 512, 512, a.in[20], MIX}; gemm_phase(lds, P, G, bid); }
    SEAM(6);
    if (IN(7)) for (int rp = 0; rp < NREP(7); ++rp) { ProbOut P{MIX, DM, WOUT, DM, DM, a.in[0], mod, a.out}; gemm_phase(lds, P, G, bid); }
    SEAM(7);
    if (IN(8)) for (int rp = NREP(8) - 1; rp >= 0; --rp) ph_router(a.in[0], a.out, a.in[22], mod, a.in[23], a.in[24], H, cnt, list, gate, (int*)(ws + OFF_EPOS), lds, bid, G, rp == 0);
    SEAM(8);
    if (IN(9) && PROBE_VPH == 9) { build_ub(cnt, ub); FMoe1 P{H, WG, DM, cnt, list, a.in[26], ACT, (const LAS int*)ub, G}; gemm_phase<PROBE_VMODE>(lds, P, G, bid); }
    if (IN(9)) for (int rp = 0; rp < NREP(9); ++rp) { build_ub(cnt, ub); FMoe1 P{H, WG, DM, cnt, list, a.in[26], ACT, (const LAS int*)ub, G}; gemm_phase(lds, P, G, bid); }
    SEAM(9);
    if (IN(10) && PROBE_VPH == 10) { build_ub(cnt, ub); FMoe2 P{ACT, WD, DFF, cnt, a.in[28], YSL, (const LAS int*)ub, G}; gemm_phase<PROBE_VMODE>(lds, P, G, bid); }
    if (IN(10)) for (int rp = 0; rp < NREP(10); ++rp) { build_ub(cnt, ub); FMoe2 P{ACT, WD, DFF, cnt, a.in[28], YSL, (const LAS int*)ub, G}; gemm_phase(lds, P, G, bid); }
    SEAM(10);
    if (IN(11)) { build_ub(cnt, ub); for (int rp = NREP(11) - 1; rp >= 0; --rp) { FRESH_LANE; for (int tok = gw; tok < NTOK; tok += NGW) final_row(a.in[0], a.out, YSL, mod, a.in[29], gate, (const int*)(ws + OFF_EPOS), (const LAS int*)ub, tok, lane, rp ? (float*)(ws + OFF_WG) : nullptr); } }
    if (PROBE_TK >= 0) { if (PROBE_TK == 11) tstamp_sel = __builtin_amdgcn_s_memrealtime() - tstamp_prev;
        if (bid == 0) { const unsigned long long t0_ = __builtin_amdgcn_s_memrealtime(); while (__builtin_amdgcn_s_memrealtime() - t0_ < 4ull * tstamp_sel) __builtin_amdgcn_s_sleep(8); } }
#undef IN
#undef SEAM
}

#ifndef MEGA_SINGLE
#define MEGA_SINGLE 1
#endif
extern "C" void kernel_launch(void* const* d_in, const int* in_sizes, int n_in, void* d_out, int out_size, void* d_ws, size_t ws_size, hipStream_t stream) {
    static int grid = 0;
    if (grid == 0) {
        if (ws_size < WS_NEED || n_in != 30) { fprintf(stderr, "kernel_launch: workspace too small (%zu < %zu) or n_in %d != 30\n", ws_size, (size_t)WS_NEED, n_in); grid = -1; return; }
        int dev = 0, cus = 0, per_cu = 0;
        if (hipGetDevice(&dev) != hipSuccess || hipDeviceGetAttribute(&cus, hipDeviceAttributeMultiprocessorCount, dev) != hipSuccess) { grid = -1; return; }
        if (hipFuncSetAttribute((const void*)mega, hipFuncAttributeMaxDynamicSharedMemorySize, LDS_BYTES) != hipSuccess) { fprintf(stderr, "kernel_launch: hipFuncSetAttribute failed\n"); grid = -1; return; }
        if (hipOccupancyMaxActiveBlocksPerMultiprocessor(&per_cu, (const void*)mega, NTHR, LDS_BYTES) != hipSuccess || per_cu < 1) { fprintf(stderr, "kernel_launch: occupancy query says %d blocks per CU\n", per_cu); per_cu = 1; }
        (void)hipGetLastError();
        grid = cus;
    }
    if (grid < 0) return;
    (void)hipMemsetAsync((char*)d_ws + OFF_CTL, 0, 64 * 1024, stream);
    MArgs a{};
    for (int i = 0; i < 30; ++i) a.in[i] = (const float*)d_in[i];
    a.out = (float*)d_out; a.ws = (unsigned char*)d_ws;
#if MEGA_SINGLE
    a.ph_lo = 0; a.ph_hi = NPH;
    { void* args[] = {&a}; hipError_t e = hipLaunchCooperativeKernel((const void*)mega, dim3(grid), dim3(NTHR), args, LDS_BYTES, stream);
      if (e != hipSuccess) fprintf(stderr, "kernel_launch: cooperative launch failed: %s (grid %d)\n", hipGetErrorString(e), grid); }
#else
    for (int p = 0; p < NPH; ++p) { a.ph_lo = p; a.ph_hi = p + 1; hipLaunchKernelGGL(mega, dim3(grid), dim3(NTHR), LDS_BYTES, stream, a); }
#endif
}
```

```cpp
#include <hip/hip_runtime.h>
#include <stdint.h>
#include <stdio.h>

typedef unsigned short bf16_t;
#define DEVI __device__ __forceinline__
#define LAS __attribute__((address_space(3)))

constexpr int NB = 8, SEQ = 4096, DM = 1024, CTX = 256;
constexpr int NTOK = NB * SEQ;
constexpr int NCTX = NB * CTX;
constexpr int NROWS = NTOK + NCTX;
constexpr int INC = 2080, INP = 2304;
constexpr int NEXP = 32, TOPK = 4, DFF = 1024;
constexpr int LISTCAP = NTOK;
constexpr int MOEPAD = 256;

constexpr size_t MiB = 1024ull * 1024ull;
constexpr size_t OFF_CTL = 0;
constexpr size_t OFF_MOD = 64 * 1024;
constexpr size_t OFF_S5P = OFF_MOD + 256 * 1024;
constexpr size_t OFF_GATE = OFF_S5P + 1 * MiB;
constexpr size_t OFF_EPOS = OFF_GATE + 512 * 1024;
constexpr size_t OFF_LIST = OFF_EPOS + 512 * 1024;
constexpr size_t OFF_WIN = OFF_LIST + 4 * MiB;
constexpr size_t OFF_WGLU = OFF_WIN + (size_t)INP * DM * 2;
constexpr size_t OFF_WOUT = OFF_WGLU + 512 * 512 * 2;
constexpr size_t OFF_WG = OFF_WOUT + (size_t)DM * DM * 2;
constexpr size_t OFF_WD = OFF_WG + (size_t)NEXP * 2048 * DM * 2;
constexpr size_t OFF_S5BF = OFF_WD + (size_t)NEXP * DM * DFF * 2;
constexpr size_t OFF_S5BY = OFF_S5BF + (size_t)32 * 256 * 256 * 2;
constexpr size_t OFF_H = OFF_S5BY + (size_t)32 * 256 * 512 * 2;
constexpr size_t OFF_RA = OFF_H + (size_t)NROWS * DM * 2;
constexpr size_t OFF_QK = OFF_RA;
constexpr size_t OFF_V = OFF_QK + (size_t)NROWS * 512 * 2;
constexpr size_t OFF_R = OFF_V + (size_t)NROWS * 512 * 2;
constexpr size_t OFF_UT = OFF_R + (size_t)NROWS * 512 * 2;
constexpr size_t OFF_LR = OFF_UT + (size_t)NROWS * 512 * 2;
constexpr size_t OFF_U2 = OFF_LR + (size_t)NROWS * 32 * 4;
constexpr size_t OFF_YS = OFF_U2 + (size_t)32 * 2304 * 512 * 2;
constexpr size_t OFF_MIX = OFF_YS + (size_t)NTOK * 512 * 2;
constexpr size_t OFF_F = OFF_MIX + (size_t)NTOK * DM * 2;
constexpr size_t OFF_UCH = OFF_F + (size_t)32 * 2304 * 256 * 4;
constexpr size_t OFF_ADEC = OFF_UCH + (size_t)64 * 68 * 8192 * 2;
constexpr size_t OFF_SST = OFF_ADEC + (size_t)64 * 68 * 64 * 4;
constexpr size_t OFF_GLT = OFF_SST + (size_t)64 * 64 * 8192 * 2;
constexpr size_t OFF_RA_END = OFF_GLT + (size_t)2048 * 4 * 4096 * 2;
constexpr int ACT_ROWS = NTOK * TOPK + NEXP * MOEPAD;
constexpr size_t OFF_ACT = OFF_RA;
constexpr size_t OFF_YSL = OFF_ACT + (size_t)ACT_ROWS * DFF * 2;
constexpr size_t OFF_END2 = OFF_YSL + (size_t)ACT_ROWS * DM * 2;
constexpr size_t WS_NEED = OFF_RA_END > OFF_END2 ? OFF_RA_END : OFF_END2;
static_assert(WS_NEED <= 1024 * MiB, "workspace map exceeds 1 GiB");

constexpr int CW_CNT = 1024;
constexpr int CW_OFFS = 1088;
constexpr int CW_WQ = 1200;
constexpr int CW_MODC = 1216;
constexpr int CW_GAQ = 1240;

DEVI float bf2f(bf16_t b) { return __uint_as_float(((unsigned)b) << 16); }
DEVI bf16_t f2bf(float f) { unsigned u = __float_as_uint(f); u += 0x7fffu + ((u >> 16) & 1u); return (bf16_t)(u >> 16); }
DEVI unsigned pk2(float lo, float hi) { unsigned r; asm("v_cvt_pk_bf16_f32 %0, %1, %2" : "=v"(r) : "v"(lo), "v"(hi)); return r; }
DEVI float wave_sum(float v) {
#pragma unroll
    for (int o = 1; o < 64; o <<= 1) v += __shfl_xor(v, o);
    return v;
}
DEVI float sigmoidf_(float x) { return 1.f / (1.f + __expf(-x)); }
DEVI float siluf_(float x) { return x / (1.f + __expf(-x)); }
DEVI float logsigmoidf_(float g) { return fminf(g, 0.f) - __logf(1.f + __expf(-fabsf(g))); }
DEVI float gelu_tanh(float x) { const float u = 0.7978845608028654f * (x + 0.044715f * x * x * x); return x / (1.f + __expf(-2.f * u)); }

__global__ __launch_bounds__(256) void k_mod(const float* __restrict__ c, const float* __restrict__ c_ctx, const float* __restrict__ ada_w,
                                             const float* __restrict__ ada_b, float* __restrict__ mod) {
    __shared__ float s[9][1024];
    for (int i = threadIdx.x; i < 9 * 1024; i += 256) { const int r = i >> 10, k = i & 1023; const float v = r < 8 ? c[r * 1024 + k] : c_ctx[k]; s[r][k] = siluf_(v); }
    __syncthreads();
    const int j = blockIdx.x * 256 + threadIdx.x;
    float acc[9];
#pragma unroll
    for (int r = 0; r < 9; ++r) acc[r] = 0.f;
    for (int k = 0; k < 1024; ++k) { const float w = ada_w[(size_t)k * 6144 + j];
#pragma unroll
        for (int r = 0; r < 9; ++r) acc[r] += s[r][k] * w; }
    const float bb = ada_b[j];
#pragma unroll
    for (int r = 0; r < 9; ++r) mod[r * 6144 + j] = acc[r] + bb;
}

template <int MODE> DEVI int wsrc_col(int nd) { if (MODE == 1) { return ((nd >> 7) & 1) * 1024 + (nd >> 8) * 128 + (nd & 127); } return nd; }
template <int MODE> __global__ __launch_bounds__(256) void k_wconv(const float* __restrict__ src, bf16_t* __restrict__ dst, int K, int N, int Nd) {
    __shared__ float t[64][65];
    const int e = blockIdx.z; src += (size_t)e * K * N; dst += (size_t)e * Nd * K;
    const int n0 = blockIdx.x * 64, k0 = blockIdx.y * 64, tid = threadIdx.x, nl = tid & 63, kq = tid >> 6;
    const int nd = n0 + nl, sc = wsrc_col<MODE>(nd); const bool valid = sc < N;
#pragma unroll 4
    for (int i = 0; i < 16; ++i) { const int kk = kq + 4 * i; t[kk][nl] = valid ? src[(size_t)(k0 + kk) * N + sc] : 0.f; }
    __syncthreads();
#pragma unroll
    for (int i = 0; i < 2; ++i) { const int ch = tid + 256 * i, n = ch >> 3, c8 = ch & 7;
        uint4 o; o.x = pk2(t[c8 * 8 + 0][n], t[c8 * 8 + 1][n]); o.y = pk2(t[c8 * 8 + 2][n], t[c8 * 8 + 3][n]); o.z = pk2(t[c8 * 8 + 4][n], t[c8 * 8 + 5][n]); o.w = pk2(t[c8 * 8 + 6][n], t[c8 * 8 + 7][n]);
        *(uint4*)(dst + (size_t)(n0 + n) * K + k0 + c8 * 8) = o; }
}

struct S5P { float lamb[2][32][64][2]; float bbar[2][32][64][16][2]; float lam16[2][32][64][2]; };
DEVI void s5prep_one(const float* lam_re, const float* lam_im, const float* log_dt, const float* b_re, const float* b_im, S5P* P, int i) {
    const int p = i & 63, g = (i >> 6) & 31, d = i >> 11;
    const double dt = exp((double)log_dt[d * 32 + g]);
    const double lr = lam_re[i], li = lam_im[i];
    const double mag = exp(lr * dt), ar = mag * cos(li * dt), ai = mag * sin(li * dt);
    const double nr = ar - 1.0, ni = ai, den = lr * lr + li * li;
    const double cr = (nr * lr + ni * li) / den, ci = (ni * lr - nr * li) / den;
    P->lamb[d][g][p][0] = (float)ar; P->lamb[d][g][p][1] = (float)ai;
    for (int h = 0; h < 16; ++h) { const double br = b_re[(size_t)i * 16 + h], bi = b_im[(size_t)i * 16 + h];
        P->bbar[d][g][p][h][0] = (float)(cr * br - ci * bi); P->bbar[d][g][p][h][1] = (float)(cr * bi + ci * br); }
}
__global__ void k_s5prep(const float* lam_re, const float* lam_im, const float* log_dt, const float* b_re, const float* b_im, S5P* P) {
    const int i = blockIdx.x * blockDim.x + threadIdx.x; if (i >= 2 * 32 * 64) return;
    s5prep_one(lam_re, lam_im, log_dt, b_re, b_im, P, i);
}

DEVI void norm_row(const float* __restrict__ x, const float* __restrict__ ctx, const float* __restrict__ w, const float* __restrict__ mod,
                                              bf16_t* __restrict__ H, int row, int lane, int sh_off, int sc_off) {
    const float* src; int b;
    if (row < NTOK) { src = x + (size_t)row * DM; b = row / SEQ; } else { src = ctx + (size_t)(row - NTOK) * DM; b = 8; }
    float4 v[4]; float ss = 0.f;
#pragma unroll
    for (int j = 0; j < 4; ++j) { v[j] = *(const float4*)(src + lane * 4 + 256 * j); ss += v[j].x * v[j].x + v[j].y * v[j].y + v[j].z * v[j].z + v[j].w * v[j].w; }
    const float rstd = rsqrtf(wave_sum(ss) * (1.f / DM) + 1e-6f);
    const float* msh = mod + b * 6144 + sh_off; const float* msc = mod + b * 6144 + sc_off;
#pragma unroll
    for (int j = 0; j < 4; ++j) { const int k = lane * 4 + 256 * j;
        const float4 ww = *(const float4*)(w + k), sc = *(const float4*)(msc + k), sh = *(const float4*)(msh + k);
        uint2 o; o.x = pk2(v[j].x * rstd * ww.x * (1.f + sc.x) + sh.x, v[j].y * rstd * ww.y * (1.f + sc.y) + sh.y);
        o.y = pk2(v[j].z * rstd * ww.z * (1.f + sc.z) + sh.z, v[j].w * rstd * ww.w * (1.f + sc.w) + sh.w);
        *(uint2*)(H + (size_t)row * DM + k) = o; }
}
__global__ __launch_bounds__(256) void k_norm(const float* __restrict__ x, const float* __restrict__ ctx, const float* __restrict__ w, const float* __restrict__ mod,
                                              bf16_t* __restrict__ H, int nrows, int sh_off, int sc_off) {
    const int row = blockIdx.x * 4 + (threadIdx.x >> 6), lane = threadIdx.x & 63; if (row >= nrows) return;
    norm_row(x, ctx, w, mod, H, row, lane, sh_off, sc_off);
}

DEVI void dense_unit(int L, int nM, int nN, int& pm, int& pn) {
    const int nwg = nM * nN; int wgid = L; { const int q = nwg / 8, r = nwg % 8, xcd = wgid % 8, off = wgid / 8; wgid = (xcd < r ? xcd * (q + 1) : r * (q + 1) + (xcd - r) * q) + off; }
    const int nig = 8 * nN, gid = wgid / nig, fm = gid * 8, gsz = (nM - fm) < 8 ? (nM - fm) : 8;
    pm = fm + ((wgid % nig) % gsz); pn = (wgid % nig) / gsz;
}
template <class Prob> __global__ __launch_bounds__(256) void k_gemm_naive(Prob P) {
    __shared__ float As[32][68], Bs[32][68];
    const int z = blockIdx.z, M = P.M(z), r0 = blockIdx.y * 64, c0 = blockIdx.x * 64; if (r0 >= M) return;
    const int tid = threadIdx.x, tx = tid & 7, ty = tid >> 3, K = P.K;
    const int lr = tid >> 2, lk = (tid & 3) * 8;
    const bool arow_ok = (r0 + lr) < M;
    const bf16_t* ap = P.A + (size_t)(arow_ok ? P.arow(z, r0 + lr) : 0) * P.lda + lk;
    const bf16_t* bp = P.Bt(z) + (size_t)(c0 + lr) * P.ldb + lk;
    float acc[2][8];
#pragma unroll
    for (int i = 0; i < 2; ++i)
#pragma unroll
        for (int j = 0; j < 8; ++j) acc[i][j] = 0.f;
    for (int k0 = 0; k0 < K; k0 += 32) {
        uint4 av = arow_ok ? *(const uint4*)(ap + k0) : make_uint4(0, 0, 0, 0); const uint4 bv = *(const uint4*)(bp + k0);
        const unsigned aw[4] = {av.x, av.y, av.z, av.w}, bw[4] = {bv.x, bv.y, bv.z, bv.w};
        __syncthreads();
#pragma unroll
        for (int j = 0; j < 4; ++j) { As[lk + 2 * j][lr] = __uint_as_float(aw[j] << 16); As[lk + 2 * j + 1][lr] = __uint_as_float(aw[j] & 0xffff0000u);
            Bs[lk + 2 * j][lr] = __uint_as_float(bw[j] << 16); Bs[lk + 2 * j + 1][lr] = __uint_as_float(bw[j] & 0xffff0000u); }
        __syncthreads();
#pragma unroll 8
        for (int k = 0; k < 32; ++k) { const float a0 = As[k][ty * 2], a1 = As[k][ty * 2 + 1];
            const float4 b0 = *(const float4*)&Bs[k][tx * 8], b1 = *(const float4*)&Bs[k][tx * 8 + 4];
            const float bb[8] = {b0.x, b0.y, b0.z, b0.w, b1.x, b1.y, b1.z, b1.w};
#pragma unroll
            for (int j = 0; j < 8; ++j) { acc[0][j] += a0 * bb[j]; acc[1][j] += a1 * bb[j]; } }
    }
#pragma unroll
    for (int i = 0; i < 2; ++i) { const int r = r0 + ty * 2 + i; if (r < M) P.store(z, r, c0 + tx * 8, acc[i]); }
}

struct ProbIn {
    static constexpr bool HOIST = false, PAIR = false;
    const bf16_t* A; int lda; const bf16_t* B; int ldb; int K; bf16_t *QK, *V, *R, *UT, *U2; float* LR;
    DEVI int M(int) const { return NROWS; }
    DEVI int arow(int, int r) const { return r; }
    DEVI int nunits() const { return (NROWS / 256) * (INP / 256); }
    DEVI void unit(int L, int& z, int& pm, int& pn) const { z = 0; dense_unit(L, NROWS / 256, INP / 256, pm, pn); }
    DEVI unsigned aoffb(int, int r) const { return (unsigned)r * (unsigned)(lda * 2); }
    DEVI const bf16_t* Bt(int) const { return B; }
    DEVI void store(int, int r, int c0, const float (&v)[8]) const {
        if (c0 >= INC) return;
        uint4 o; o.x = pk2(v[0], v[1]); o.y = pk2(v[2], v[3]); o.z = pk2(v[4], v[5]); o.w = pk2(v[6], v[7]);
        if (c0 < 512) { *(uint4*)(QK + (size_t)r * 512 + c0) = o; }
        else if (c0 < 1024) { *(uint4*)(V + (size_t)r * 512 + (c0 - 512)) = o; }
        else if (c0 < 1536) { *(uint4*)(R + (size_t)r * 512 + (c0 - 1024)) = o; }
        else if (c0 < 1568) { float* p = LR + (size_t)r * 32 + (c0 - 1536); *(float4*)p = make_float4(v[0], v[1], v[2], v[3]); *(float4*)(p + 4) = make_float4(v[4], v[5], v[6], v[7]); }
        else { const int j = c0 - 1568;
            const int g = j >> 4, ch = j & 15; int urow, ucol;
            if (r < NTOK) { const int b = r >> 12, n = r & 4095, gr = n >> 6, gc = n & 63, s = gc * 64 + gr; urow = b * 256 + (s >> 4); ucol = (s & 15) * 16 + ch; }
            else { const int q = r - NTOK, b = q >> 8, t = q & 255; urow = 2048 + b * 16 + (t >> 4); ucol = (t & 15) * 16 + ch; }
            *(uint4*)(U2 + ((size_t)g * 2304 + urow) * 512 + ucol) = o; }
    }
};
struct ProbGlu {
    static constexpr bool HOIST = false, PAIR = false;
    const bf16_t* A; int lda; const bf16_t* B; int ldb; int K; const float* bias; bf16_t* MIX;
    DEVI int M(int) const { return NTOK; }
    DEVI int arow(int, int r) const { return r; }
    DEVI int nunits() const { return (NTOK / 256) * 2; }
    DEVI void unit(int L, int& z, int& pm, int& pn) const { z = 0; dense_unit(L, NTOK / 256, 2, pm, pn); }
    DEVI unsigned aoffb(int, int r) const { return (unsigned)r * (unsigned)(lda * 2); }
    DEVI const bf16_t* Bt(int) const { return B; }
    DEVI void store(int, int r, int c0, const float (&v)[8]) const {
        const uint4 yv = *(const uint4*)(A + (size_t)r * lda + c0); const unsigned yw[4] = {yv.x, yv.y, yv.z, yv.w}; float o[8];
#pragma unroll
        for (int j = 0; j < 4; ++j) { const float y0 = __uint_as_float(yw[j] << 16), y1 = __uint_as_float(yw[j] & 0xffff0000u);
            o[2 * j] = y0 * sigmoidf_(v[2 * j] + bias[c0 + 2 * j]); o[2 * j + 1] = y1 * sigmoidf_(v[2 * j + 1] + bias[c0 + 2 * j + 1]); }
        uint4 w; w.x = pk2(o[0], o[1]); w.y = pk2(o[2], o[3]); w.z = pk2(o[4], o[5]); w.w = pk2(o[6], o[7]);
        *(uint4*)(MIX + (size_t)r * DM + 512 + c0) = w;
    }
};
struct ProbOut {
    static constexpr bool HOIST = false, PAIR = false;
    const bf16_t* A; int lda; const bf16_t* B; int ldb; int K; const float* x; const float* mod; float* X1;
    DEVI int M(int) const { return NTOK; }
    DEVI int arow(int, int r) const { return r; }
    DEVI int nunits() const { return (NTOK / 256) * 4; }
    DEVI void unit(int L, int& z, int& pm, int& pn) const { z = 0; dense_unit(L, NTOK / 256, 4, pm, pn); }
    DEVI unsigned aoffb(int, int r) const { return (unsigned)r * (unsigned)(lda * 2); }
    DEVI const bf16_t* Bt(int) const { return B; }
    DEVI void store(int, int r, int c0, const float (&v)[8]) const {
        uint4 o; o.x = pk2(v[0], v[1]); o.y = pk2(v[2], v[3]); o.z = pk2(v[4], v[5]); o.w = pk2(v[6], v[7]);
        *(uint4*)((bf16_t*)(X1 + (size_t)r * DM) + DM + c0) = o;
    }
};
struct ProbMoe1 {
    const bf16_t* A; int lda; const bf16_t* B; int ldb; int K; const int* cnt; const int* offs; const int* list; const float* b_gu; bf16_t* ACT;
    DEVI int M(int z) const { return cnt[z]; }
    DEVI int arow(int z, int r) const { return list[z * LISTCAP + r] >> 2; }
    DEVI const bf16_t* Bt(int z) const { return B + (size_t)z * 2048 * DM; }
    DEVI void store(int, int, int, const float (&)[8]) const {}
};
struct ProbMoe2 {
    const bf16_t* A; int lda; const bf16_t* B; int ldb; int K; const int* cnt; const int* offs; const int* list; const float* b_down; const float* gate; bf16_t* YSL;
    DEVI int M(int z) const { return cnt[z]; }
    DEVI int arow(int z, int r) const { return offs[z] + r; }
    DEVI const bf16_t* Bt(int z) const { return B + (size_t)z * DM * DFF; }
    DEVI void store(int z, int r, int c0, const float (&v)[8]) const {
        const int ent = list[z * LISTCAP + r]; const float gt = gate[ent]; const float* bd = b_down + (size_t)z * DM + c0;
        uint4 o; o.x = pk2((v[0] + bd[0]) * gt, (v[1] + bd[1]) * gt); o.y = pk2((v[2] + bd[2]) * gt, (v[3] + bd[3]) * gt);
        o.z = pk2((v[4] + bd[4]) * gt, (v[5] + bd[5]) * gt); o.w = pk2((v[6] + bd[6]) * gt, (v[7] + bd[7]) * gt);
        *(uint4*)(YSL + (size_t)ent * DM + c0) = o;
    }
};

DEVI void gla_naive_body(const bf16_t* __restrict__ QK, const bf16_t* __restrict__ V, const float* __restrict__ LR, const float* __restrict__ lr_up,
                                                   const float* __restrict__ lr_bias, float* __restrict__ OF, float* __restrict__ OB, LAS float* sm, int item) {
    LAS float* sq = sm; LAS float* sk = sm + 64; LAS float* sa = sm + 128; LAS float* sv = sm + 192; LAS float* red = sm + 320;
    const int dir = item & 1, hh = (item >> 1) & 3, b = item >> 3, tid = threadIdx.x, e = tid & 127, dg = tid >> 7;
    float up[16]; float bias = 0.f;
    if (tid < 64) { for (int r = 0; r < 16; ++r) up[r] = lr_up[dir * 4096 + r * 256 + hh * 64 + tid]; bias = lr_bias[dir * 256 + hh * 64 + tid]; }
    float S[16];
#pragma unroll
    for (int i = 0; i < 16; ++i) S[i] = 0.f;
    float* O = dir ? OB : OF;
    for (int step = 0; step < CTX + SEQ; ++step) {
        int row;
        if (step < CTX) row = NTOK + b * CTX + (dir ? CTX - 1 - step : step);
        else { const int t = step - CTX; row = b * SEQ + (dir ? SEQ - 1 - t : t); }
        if (tid < 64) { const float* lp = LR + (size_t)row * 32 + dir * 16; float g = bias;
#pragma unroll
            for (int r = 0; r < 16; ++r) g += lp[r] * up[r];
            sa[tid] = __expf(logsigmoidf_(g) * (1.f / 16.f));
            sq[tid] = bf2f(QK[(size_t)row * 512 + hh * 64 + tid]) * 0.125f; sk[tid] = bf2f(QK[(size_t)row * 512 + 256 + hh * 64 + tid]); }
        else if (tid < 192) sv[tid - 64] = bf2f(V[(size_t)row * 512 + hh * 128 + (tid - 64)]);
        __syncthreads();
        const float v = sv[e]; float part = 0.f;
#pragma unroll
        for (int i = 0; i < 16; ++i) { const int d = dg * 16 + i; S[i] = sa[d] * S[i] + sk[d] * v; part += sq[d] * S[i]; }
        if (step >= CTX) red[dg * 128 + e] = part;
        __syncthreads();
        if (step >= CTX && dg == 0) O[(size_t)row * 512 + hh * 128 + e] = (red[e] + red[128 + e]) + (red[256 + e] + red[384 + e]);
    }
}
__global__ __launch_bounds__(512) void k_gla_naive(const bf16_t* __restrict__ QK, const bf16_t* __restrict__ V, const float* __restrict__ LR, const float* __restrict__ lr_up,
                                                   const float* __restrict__ lr_bias, float* __restrict__ OF, float* __restrict__ OB) {
    __shared__ float sm[832];
    gla_naive_body(QK, V, LR, lr_up, lr_bias, OF, OB, (LAS float*)sm, blockIdx.x);
}
DEVI void gla_post_row(const float* __restrict__ OF, const float* __restrict__ OB, const bf16_t* __restrict__ R, const float* __restrict__ nw, bf16_t* __restrict__ MIX, int tok, int lane) {
    const int c0 = lane * 8;
    float o[8]; float ss = 0.f;
#pragma unroll
    for (int j = 0; j < 8; ++j) { o[j] = OF[(size_t)tok * 512 + c0 + j] + OB[(size_t)tok * 512 + c0 + j]; ss += o[j] * o[j]; }
    ss += __shfl_xor(ss, 1); ss += __shfl_xor(ss, 2); ss += __shfl_xor(ss, 4); ss += __shfl_xor(ss, 8);
    const float rstd = rsqrtf(ss * (1.f / 128.f) + 1e-6f);
    float w[8];
#pragma unroll
    for (int j = 0; j < 8; ++j) { const float r = bf2f(R[(size_t)tok * 512 + c0 + j]); w[j] = o[j] * rstd * nw[(c0 + j) & 127] * siluf_(r); }
    uint4 q; q.x = pk2(w[0], w[1]); q.y = pk2(w[2], w[3]); q.z = pk2(w[4], w[5]); q.w = pk2(w[6], w[7]);
    *(uint4*)(MIX + (size_t)tok * DM + c0) = q;
}
__global__ __launch_bounds__(256) void k_gla_post(const float* __restrict__ OF, const float* __restrict__ OB, const bf16_t* __restrict__ R, const float* __restrict__ nw, bf16_t* __restrict__ MIX) {
    gla_post_row(OF, OB, R, nw, MIX, blockIdx.x * 4 + (threadIdx.x >> 6), threadIdx.x & 63);
}

DEVI void s5_naive_body(const bf16_t* __restrict__ UT, const S5P* __restrict__ P, const float* __restrict__ c_re, const float* __restrict__ c_im,
                                                  float* __restrict__ YF, float* __restrict__ YB, LAS float* hsw  , int id, int lane) {
    const int g = id & 31, dir = (id >> 5) & 1, b = id >> 6;
    const float lr = P->lamb[dir][g][lane][0], li = P->lamb[dir][g][lane][1];
    float br[16], bi[16];
#pragma unroll
    for (int h = 0; h < 16; ++h) { br[h] = P->bbar[dir][g][lane][h][0]; bi[h] = P->bbar[dir][g][lane][h][1]; }
    const int ch = lane & 15, part = lane >> 4;
    float cr[16], ci[16];
#pragma unroll
    for (int i = 0; i < 16; ++i) { const size_t ix = (((size_t)dir * 32 + g) * 16 + ch) * 64 + part * 16 + i; cr[i] = c_re[ix]; ci[i] = c_im[ix]; }
    float hr = 0.f, hi = 0.f; float* Y = dir ? YB : YF;
    for (int step = 0; step < CTX + SEQ; ++step) {
        int row;
        if (step < CTX) row = NTOK + b * CTX + (dir ? CTX - 1 - step : step);
        else { const int t = step - CTX, s = dir ? SEQ - 1 - t : t; row = b * SEQ + (s & 63) * 64 + (s >> 6); }
        const uint4 u0 = *(const uint4*)(UT + (size_t)row * 512 + g * 16), u1 = *(const uint4*)(UT + (size_t)row * 512 + g * 16 + 8);
        const unsigned uw[8] = {u0.x, u0.y, u0.z, u0.w, u1.x, u1.y, u1.z, u1.w};
        float bur = 0.f, bui = 0.f;
#pragma unroll
        for (int j = 0; j < 8; ++j) { const float ua = __uint_as_float(uw[j] << 16), ub = __uint_as_float(uw[j] & 0xffff0000u);
            bur += br[2 * j] * ua + br[2 * j + 1] * ub; bui += bi[2 * j] * ua + bi[2 * j + 1] * ub; }
        const float nr = lr * hr - li * hi + bur, ni = lr * hi + li * hr + bui; hr = nr; hi = ni;
        if (step >= CTX) {
            hsw[lane] = hr; hsw[64 + lane] = hi;
            asm volatile("s_waitcnt lgkmcnt(0)" ::: "memory");
            float acc = 0.f;
#pragma unroll
            for (int i = 0; i < 16; ++i) acc += cr[i] * hsw[part * 16 + i] - ci[i] * hsw[64 + part * 16 + i];
            acc += __shfl_xor(acc, 16); acc += __shfl_xor(acc, 32);
            asm volatile("s_waitcnt lgkmcnt(0)" ::: "memory");
            if (lane < 16) Y[(size_t)row * 512 + g * 16 + lane] = acc;
        }
    }
}
__global__ __launch_bounds__(256) void k_s5_naive(const bf16_t* __restrict__ UT, const S5P* __restrict__ P, const float* __restrict__ c_re, const float* __restrict__ c_im,
                                                  float* __restrict__ YF, float* __restrict__ YB) {
    __shared__ float hs[4][128];
    const int w = threadIdx.x >> 6;
    s5_naive_body(UT, P, c_re, c_im, YF, YB, (LAS float*)hs[w], blockIdx.x * 4 + w, threadIdx.x & 63);
}
__global__ __launch_bounds__(256) void k_s5_post(const float* __restrict__ YF, const float* __restrict__ YB, const bf16_t* __restrict__ UT, const float* __restrict__ dvec, bf16_t* __restrict__ YS) {
    const size_t i = (size_t)blockIdx.x * 256 + threadIdx.x; const int j = (int)(i & 511);
    const float y = YF[i] + YB[i] + dvec[j] * bf2f(UT[i]);
    YS[i] = f2bf(gelu_tanh(y));
}

DEVI void router_row(const float* __restrict__ X1, const float* __restrict__ w, const float* __restrict__ mod, const float* __restrict__ rw, const float* __restrict__ rb,
                                                bf16_t* __restrict__ H2, int* __restrict__ cnt, int* __restrict__ list, float* __restrict__ gate, LAS float* hrw  , int tok, int lane) {
    const int b = tok / SEQ;
    const float* src = X1 + (size_t)tok * DM;
    float4 v[4]; float ss = 0.f;
#pragma unroll
    for (int j = 0; j < 4; ++j) { v[j] = *(const float4*)(src + lane * 4 + 256 * j); ss += v[j].x * v[j].x + v[j].y * v[j].y + v[j].z * v[j].z + v[j].w * v[j].w; }
    const float rstd = rsqrtf(wave_sum(ss) * (1.f / DM) + 1e-6f);
    const float* msh = mod + b * 6144 + 3072; const float* msc = mod + b * 6144 + 4096;
#pragma unroll
    for (int j = 0; j < 4; ++j) { const int k = lane * 4 + 256 * j;
        const float4 ww = *(const float4*)(w + k), sc = *(const float4*)(msc + k), sh = *(const float4*)(msh + k);
        float4 h; h.x = v[j].x * rstd * ww.x * (1.f + sc.x) + sh.x; h.y = v[j].y * rstd * ww.y * (1.f + sc.y) + sh.y; h.z = v[j].z * rstd * ww.z * (1.f + sc.z) + sh.z; h.w = v[j].w * rstd * ww.w * (1.f + sc.w) + sh.w;
        hrw[k] = h.x; hrw[k + 1] = h.y; hrw[k + 2] = h.z; hrw[k + 3] = h.w;
        uint2 o; o.x = pk2(h.x, h.y); o.y = pk2(h.z, h.w); *(uint2*)(H2 + (size_t)tok * DM + k) = o; }
    asm volatile("s_waitcnt lgkmcnt(0)" ::: "memory");
    const int e = lane & 31, half = lane >> 5; float lg = 0.f;
    for (int k = half * 512; k < half * 512 + 512; ++k) lg += hrw[k] * rw[k * 32 + e];
    lg += __shfl_xor(lg, 32); lg += rb[e];
    float val = lg; float tv[4]; int ti[4];
#pragma unroll
    for (int t = 0; t < 4; ++t) { float bv = val; int bi = e;
#pragma unroll
        for (int o = 1; o < 32; o <<= 1) { const float ov = __shfl_xor(bv, o); const int oi = __shfl_xor(bi, o); if (ov > bv || (ov == bv && oi < bi)) { bv = ov; bi = oi; } }
        tv[t] = bv; ti[t] = bi; if (e == bi) val = -3.0e38f; }
    const float e1 = __expf(tv[1] - tv[0]), e2 = __expf(tv[2] - tv[0]), e3 = __expf(tv[3] - tv[0]), inv = 1.f / (1.f + e1 + e2 + e3);
    if (lane < 4) { const float gv = lane == 0 ? inv : lane == 1 ? e1 * inv : lane == 2 ? e2 * inv : e3 * inv; const int ex = lane == 0 ? ti[0] : lane == 1 ? ti[1] : lane == 2 ? ti[2] : ti[3];
        const int slot = atomicAdd(&cnt[ex], 1); list[ex * LISTCAP + slot] = tok * 4 + lane; gate[tok * 4 + lane] = gv; }
}
__global__ __launch_bounds__(256) void k_router(const float* __restrict__ X1, const float* __restrict__ w, const float* __restrict__ mod, const float* __restrict__ rw, const float* __restrict__ rb,
                                                bf16_t* __restrict__ H2, int* __restrict__ cnt, int* __restrict__ list, float* __restrict__ gate) {
    __shared__ float hrow[4][1024];
    const int wv = threadIdx.x >> 6;
    router_row(X1, w, mod, rw, rb, H2, cnt, list, gate, (LAS float*)hrow[wv], blockIdx.x * 4 + wv, threadIdx.x & 63);
}
__global__ void k_offsets(const int* cnt, int* offs) { if (threadIdx.x == 0) { int o = 0; for (int e = 0; e < NEXP; ++e) { offs[e] = o; o += (cnt[e] + MOEPAD - 1) / MOEPAD * MOEPAD; } offs[NEXP] = o; } }

DEVI void final_row(const float* __restrict__ X, float* __restrict__ X1, const bf16_t* __restrict__ Y2, const float* __restrict__ mod, const float* __restrict__ fw, const float* __restrict__ gate, const int* __restrict__ epos,
                    const LAS int* ub, int tok, int lane, float* __restrict__ OUT = nullptr) {
    const int b = tok / SEQ;
    float* row = X1 + (size_t)tok * DM; float* orow = OUT ? OUT + (size_t)tok * DM : row; const float* g2 = mod + b * 6144 + 5120; const float* g1p = mod + b * 6144 + 2048;
    const float* xrow = X + (size_t)tok * DM; const bf16_t* mrow = (const bf16_t*)row + DM;
    const int4 ep = *(const int4*)(epos + tok * 4); const float4 gt = *(const float4*)(gate + tok * 4);
    const bf16_t* y0 = Y2 + (size_t)(ub[ep.x / LISTCAP] * 256 + ep.x % LISTCAP) * DM; const bf16_t* y1 = Y2 + (size_t)(ub[ep.y / LISTCAP] * 256 + ep.y % LISTCAP) * DM;
    const bf16_t* y2 = Y2 + (size_t)(ub[ep.z / LISTCAP] * 256 + ep.z % LISTCAP) * DM; const bf16_t* y3 = Y2 + (size_t)(ub[ep.w / LISTCAP] * 256 + ep.w % LISTCAP) * DM;
    float4 v[4]; float ss = 0.f;
#pragma unroll
    for (int j = 0; j < 4; ++j) { const int k = lane * 4 + 256 * j; v[j] = *(const float4*)(xrow + k);
        { const uint2 mm = *(const uint2*)(mrow + k); const float4 g1 = *(const float4*)(g1p + k);
          v[j].x += g1.x * __uint_as_float(mm.x << 16); v[j].y += g1.y * __uint_as_float(mm.x & 0xffff0000u); v[j].z += g1.z * __uint_as_float(mm.y << 16); v[j].w += g1.w * __uint_as_float(mm.y & 0xffff0000u); }
        const uint2 a0 = *(const uint2*)(y0 + k), a1 = *(const uint2*)(y1 + k), a2 = *(const uint2*)(y2 + k), a3 = *(const uint2*)(y3 + k);
        float f[4];
        f[0] = gt.x * __uint_as_float(a0.x << 16) + gt.y * __uint_as_float(a1.x << 16) + gt.z * __uint_as_float(a2.x << 16) + gt.w * __uint_as_float(a3.x << 16);
        f[1] = gt.x * __uint_as_float(a0.x & 0xffff0000u) + gt.y * __uint_as_float(a1.x & 0xffff0000u) + gt.z * __uint_as_float(a2.x & 0xffff0000u) + gt.w * __uint_as_float(a3.x & 0xffff0000u);
        f[2] = gt.x * __uint_as_float(a0.y << 16) + gt.y * __uint_as_float(a1.y << 16) + gt.z * __uint_as_float(a2.y << 16) + gt.w * __uint_as_float(a3.y << 16);
        f[3] = gt.x * __uint_as_float(a0.y & 0xffff0000u) + gt.y * __uint_as_float(a1.y & 0xffff0000u) + gt.z * __uint_as_float(a2.y & 0xffff0000u) + gt.w * __uint_as_float(a3.y & 0xffff0000u);
        const float4 gg = *(const float4*)(g2 + k);
        v[j].x += gg.x * f[0]; v[j].y += gg.y * f[1]; v[j].z += gg.z * f[2]; v[j].w += gg.w * f[3];
        ss += v[j].x * v[j].x + v[j].y * v[j].y + v[j].z * v[j].z + v[j].w * v[j].w; }
    const float rstd = rsqrtf(wave_sum(ss) * (1.f / DM) + 1e-6f);
#pragma unroll
    for (int j = 0; j < 4; ++j) { const int k = lane * 4 + 256 * j; const float4 ww = *(const float4*)(fw + k);
        *(float4*)(orow + k) = make_float4(v[j].x * rstd * ww.x, v[j].y * rstd * ww.y, v[j].z * rstd * ww.z, v[j].w * rstd * ww.w); }
}

typedef short bf16x8 __attribute__((ext_vector_type(8)));
typedef float f32x4 __attribute__((ext_vector_type(4)));
typedef unsigned u32x4 __attribute__((ext_vector_type(4)));
typedef unsigned u32x2 __attribute__((ext_vector_type(2)));
constexpr int NWAVES = 8, NTHR = 512;
constexpr int BM = 256, BK = 64, HALF = 128, HTB = HALF * BK * 2, STAGE_BYTES = 8 * HTB;
constexpr int MISC_OFF = 147456, MISC_BYTES = 1024, LDS_BYTES = MISC_OFF + MISC_BYTES;
constexpr int CW_BAR = 4096;

#define XB_TMO      128
#define XB_XCNT(j)  (256  + 64 * (j))
#define XB_XSUB(j)  (1280 + 64 * (j))
#define XB_XGEN(j)  (2304 + 64 * (j))
#define XB_TOP      3328
#define XB_TOPGEN   3392
#define XCD_BAR_WORDS 3456
#define XB_SPIN_CAP (1u << 18)
DEVI unsigned xb_ld(unsigned* p)              { return __hip_atomic_load(p, __ATOMIC_RELAXED, __HIP_MEMORY_SCOPE_AGENT); }
DEVI unsigned xb_add(unsigned* p, unsigned v) { return __hip_atomic_fetch_add(p, v, __ATOMIC_RELAXED, __HIP_MEMORY_SCOPE_AGENT); }
DEVI unsigned xb_xcc_id() { return (unsigned)__builtin_amdgcn_s_getreg((3 << 11) | 20) & 0xFu; }
#define XB_SPIN(cond, bar) do { unsigned _sp = 0; while (cond) { __builtin_amdgcn_s_sleep(1); \
    if ((++_sp & 255u) == 0u) { if (xb_ld(&(bar)[XB_TMO])) break; if (_sp > XB_SPIN_CAP) { atomicAdd(&(bar)[XB_TMO], 1u); break; } } } } while (0)
struct XcdBarrier { unsigned* bar; unsigned x; volatile LAS unsigned* st; };
DEVI XcdBarrier xcd_barrier_post(unsigned* bar, volatile LAS unsigned* st) {
    XcdBarrier b; b.bar = bar; b.x = xb_xcc_id(); b.st = st;
    if (threadIdx.x == 0) (void)xb_add(&bar[XB_XCNT(b.x)], 1u);
    return b;
}
DEVI void xcd_barrier_complete(unsigned* bar, unsigned x, unsigned& nloc, unsigned& nx) {
    const unsigned G = gridDim.x * gridDim.y * gridDim.z;
    unsigned sum, cnt, mine, sp = 0u;
    for (;;) {
        sum = 0u; cnt = 0u; mine = 0u;
#pragma unroll
        for (unsigned j = 0; j < 16; ++j) { const unsigned c = xb_ld(&bar[XB_XCNT(j)]); sum += c; cnt += (c > 0u) ? 1u : 0u; mine = (j == x) ? c : mine; }
        if (sum == G) break;
        __builtin_amdgcn_s_sleep(1);
        if ((++sp & 255u) == 0u) { if (xb_ld(&bar[XB_TMO])) break; if (sp > XB_SPIN_CAP) { atomicAdd(&bar[XB_TMO], 1u); break; } }
    }
    nloc = mine > 0u ? mine : 1u; nx = cnt > 0u ? cnt : 1u;
}
DEVI void xcd_barrier(const XcdBarrier& b) {
    asm volatile("s_waitcnt vmcnt(0)" ::: "memory");
    __syncthreads();
    if (threadIdx.x == 0) {
        unsigned* bar = b.bar;
        __builtin_amdgcn_s_waitcnt(0);
        unsigned nloc = b.st[0], nx = b.st[1];
        if (nloc == 0u) { xcd_barrier_complete(bar, b.x, nloc, nx); b.st[0] = nloc; b.st[1] = nx; }
        const unsigned old = xb_add(&bar[XB_XSUB(b.x)], 1u);
        const unsigned gen = old / nloc;
        if (old + 1u == (gen + 1u) * nloc) {
            __builtin_amdgcn_fence(__ATOMIC_RELEASE, "agent");
            asm volatile("s_waitcnt vmcnt(0)" ::: "memory");
            const unsigned og = xb_add(&bar[XB_TOP], 1u);
            const unsigned tg = og / nx;
            if (og + 1u == (tg + 1u) * nx) xb_add(&bar[XB_TOPGEN], 1u);
            else XB_SPIN(xb_ld(&bar[XB_TOPGEN]) == tg, bar);
            __builtin_amdgcn_fence(__ATOMIC_ACQUIRE, "agent");
            xb_add(&bar[XB_XGEN(b.x)], 1u);
            asm volatile("s_waitcnt vmcnt(0)" ::: "memory");
        } else {
            XB_SPIN(xb_ld(&bar[XB_XGEN(b.x)]) == gen, bar);
            __builtin_amdgcn_fence(__ATOMIC_ACQUIRE, "agent");
            asm volatile("s_waitcnt vmcnt(0)" ::: "memory");
        }
    }
    __syncthreads();
}

DEVI int lds_byte(int r, int c) { const int st = (r >> 4) * 2 + (c >> 5), rr = r & 15, cc = c & 31, ob = rr * 64 + cc * 2; return st * 1024 + (ob ^ (((ob >> 9) & 1) << 5)); }
DEVI void stage_rc(int b, int& R, int& C) { const int st = b / 1024, sb = b % 1024, swz = sb ^ (((sb >> 9) & 1) << 5); R = (st >> 1) * 16 + swz / 64; C = (st & 1) * 32 + (swz % 64) / 2; }
DEVI int perm32(int rho) { const int n = rho >> 4, i = rho & 15; return 8 * (i >> 2) + 4 * n + (i & 3); }
template <int VMODE = 0, class Prob>
DEVI void gemm_phase(LAS unsigned char* lds, const Prob& P, int G, int c) {
    int tid = threadIdx.x; asm volatile("" : "+v"(tid));
    const int wid = __builtin_amdgcn_readfirstlane(tid >> 6), lane = tid & 63, wr = wid >> 2, wc = wid & 3, fr = lane & 15, fq = lane >> 4;
    const int K = P.K, nt = K / BK;
    const int nun = P.nunits();
    int L = c; if (L >= nun) return;
    int Rs0, Cs0, Rs1, Cs1; stage_rc(tid * 16, Rs0, Cs0); stage_rc(tid * 16 + 8192, Rs1, Cs1);
    unsigned voffB[2];
    voffB[0] = (unsigned)(((Rs0 & ~31) + perm32(Rs0 & 31)) * K + Cs0) * 2u; voffB[1] = (unsigned)(((Rs1 & ~31) + perm32(Rs1 & 31)) * K + Cs1) * 2u;
    const size_t kstep = (size_t)(BK * 2), hstepB = (size_t)HALF * K * 2, tstepB = 2 * hstepB;
    const unsigned ldsw = (unsigned)wid * 1024u;
    const int aoff = lds_byte(wr * 64 + fr, fq * 8), boff = lds_byte(wc * 32 + fr, fq * 8);
#define G_SA(b, h) (((b) * 2 + (h)) * HTB)
#define G_SB(b, h) ((4 + (b) * 2 + (h)) * HTB)
#define G_STAGE_B(bufoff, gbase) do { _Pragma("unroll") for (int _i = 0; _i < 2; ++_i) \
        __builtin_amdgcn_global_load_lds((const unsigned*)((const char*)(gbase) + voffB[_i]), (LAS unsigned*)(lds + (bufoff) + ldsw + _i * 8192), 16, 0, 0); } while (0)
#define G_STAGE_A(bufoff, gbase, v0, v1) do { \
        __builtin_amdgcn_global_load_lds((const unsigned*)((const char*)(gbase) + (v0)), (LAS unsigned*)(lds + (bufoff) + ldsw), 16, 0, 0); \
        __builtin_amdgcn_global_load_lds((const unsigned*)((const char*)(gbase) + (v1)), (LAS unsigned*)(lds + (bufoff) + ldsw + 8192), 16, 0, 0); } while (0)
#define G_LDA(dst, b, h) do { _Pragma("unroll") for (int m = 0; m < 4; ++m) _Pragma("unroll") for (int k = 0; k < 2; ++k) dst[m][k] = *(const LAS bf16x8*)(lds + G_SA(b, h) + aoff + m * 2048 + k * 1024); } while (0)
#define G_LDB(dst, b, h) do { _Pragma("unroll") for (int n = 0; n < 2; ++n) _Pragma("unroll") for (int k = 0; k < 2; ++k) dst[n][k] = *(const LAS bf16x8*)(lds + G_SB(b, h) + boff + n * 2048 + k * 1024); } while (0)
#define G_MMA(ai, bj, At, Bt) do { __builtin_amdgcn_s_setprio(1); _Pragma("unroll") for (int m = 0; m < 4; ++m) _Pragma("unroll") for (int n = 0; n < 2; ++n) _Pragma("unroll") for (int k = 0; k < 2; ++k) \
        acc[ai][bj][m][n] = __builtin_amdgcn_mfma_f32_16x16x32_bf16(Bt[n][k], At[m][k], acc[ai][bj][m][n], 0, 0, 0); __builtin_amdgcn_s_setprio(0); } while (0)
#define G_WAIT_V(n) asm volatile("s_waitcnt vmcnt(" #n ")" ::: "memory")
#define G_WAIT_L(n) asm volatile("s_waitcnt lgkmcnt(" #n ")" ::: "memory")
#define G_BAR __builtin_amdgcn_s_barrier()
#define G_SCHED __builtin_amdgcn_sched_barrier(0)
    int z, pm, pn; P.unit(L, z, pm, pn);
    z = __builtin_amdgcn_readfirstlane(z); pm = __builtin_amdgcn_readfirstlane(pm); pn = __builtin_amdgcn_readfirstlane(pn);
    unsigned vA00 = P.aoffb(z, pm * BM + Rs0) + Cs0 * 2, vA01 = P.aoffb(z, pm * BM + Rs1) + Cs1 * 2;
    unsigned vA10 = P.aoffb(z, pm * BM + HALF + Rs0) + Cs0 * 2, vA11 = P.aoffb(z, pm * BM + HALF + Rs1) + Cs1 * 2;
    const char* const Ab = (const char*)P.A;
    const char* cB = (const char*)P.Bt(z) + (size_t)pn * tstepB;
    f32x4 acc[2][2][4][2];
    bf16x8 At[4][2], B0[2][2], B1[2][2];
    G_STAGE_B(G_SB(0, 0), cB); G_STAGE_A(G_SA(0, 0), Ab, vA00, vA01); G_STAGE_B(G_SB(0, 1), cB + hstepB); G_STAGE_A(G_SA(0, 1), Ab, vA10, vA11);
    if (wr == 1) G_BAR;
    G_WAIT_V(4); G_BAR;
    G_STAGE_B(G_SB(1, 0), cB + kstep); G_STAGE_A(G_SA(1, 0), Ab + kstep, vA00, vA01); G_STAGE_B(G_SB(1, 1), cB + hstepB + kstep);
    G_WAIT_V(6); G_BAR;
    for (;;) {
        const int Ln = L + G; const bool has_next = Ln < nun;
        int nz = z, npm = pm, npn = pn; if (has_next) P.unit(Ln, nz, npm, npn);
        nz = __builtin_amdgcn_readfirstlane(nz); npm = __builtin_amdgcn_readfirstlane(npm); npn = __builtin_amdgcn_readfirstlane(npn);
        const char* nB = has_next ? (const char*)P.Bt(nz) + (size_t)npn * tstepB : cB;
        unsigned n00 = vA00, n01 = vA01, n10 = vA10, n11 = vA11;
        if (has_next) { n00 = P.aoffb(nz, npm * BM + Rs0) + Cs0 * 2; n01 = P.aoffb(nz, npm * BM + Rs1) + Cs1 * 2;
            n10 = P.aoffb(nz, npm * BM + HALF + Rs0) + Cs0 * 2; n11 = P.aoffb(nz, npm * BM + HALF + Rs1) + Cs1 * 2; }
#pragma unroll
        for (int a = 0; a < 2; ++a)
#pragma unroll
            for (int b = 0; b < 2; ++b)
#pragma unroll
                for (int m = 0; m < 4; ++m)
#pragma unroll
                    for (int n = 0; n < 2; ++n) acc[a][b][m][n] = (f32x4){0.f, 0.f, 0.f, 0.f};
#pragma unroll 1
        for (int t = 0; t < nt; t += 2) {
            const bool last = (t == nt - 2);
            const char* a1 = Ab + (size_t)(t + 1) * kstep;
            const char* a2 = last ? Ab : Ab + (size_t)(t + 2) * kstep; const char* b2 = last ? nB : cB + (size_t)(t + 2) * kstep;
            const char* a3 = a2 + kstep; const char* b3 = b2 + kstep;
            G_LDB(B0, 0, 0); G_SCHED; G_LDA(At, 0, 0); G_STAGE_A(G_SA(1, 1), a1, vA10, vA11);
            G_WAIT_L(8); G_BAR; G_WAIT_L(0); G_MMA(0, 0, At, B0); G_BAR; G_SCHED;
            if (last) { vA00 = n00; vA01 = n01; vA10 = n10; vA11 = n11; }
            G_LDB(B1, 0, 1); G_STAGE_B(G_SB(0, 0), b2);
            G_BAR; G_WAIT_L(0); G_MMA(0, 1, At, B1); G_BAR;
            G_LDA(At, 0, 1); G_STAGE_A(G_SA(0, 0), a2, vA00, vA01);
            G_BAR; G_WAIT_L(0); G_MMA(1, 0, At, B0); G_BAR; G_SCHED;
            G_STAGE_B(G_SB(0, 1), b2 + hstepB);
            G_WAIT_V(6); G_BAR; G_MMA(1, 1, At, B1); G_BAR;
            G_LDB(B0, 1, 0); G_SCHED; G_LDA(At, 1, 0); G_STAGE_A(G_SA(0, 1), a2, vA10, vA11);
            G_WAIT_L(8); G_BAR; G_WAIT_L(0); G_MMA(0, 0, At, B0); G_BAR; G_SCHED;
            G_LDB(B1, 1, 1); G_STAGE_B(G_SB(1, 0), b3);
            G_BAR; G_WAIT_L(0); G_MMA(0, 1, At, B1); G_BAR;
            G_LDA(At, 1, 1); G_STAGE_A(G_SA(1, 0), a3, vA00, vA01);
            G_BAR; G_WAIT_L(0); G_MMA(1, 0, At, B0); G_BAR; G_SCHED;
            G_STAGE_B(G_SB(1, 1), b3 + hstepB);
            G_WAIT_V(6); G_BAR; G_MMA(1, 1, At, B1); G_BAR;
        }
        if constexpr (VMODE == 1) {
#pragma unroll
            for (int a_ = 0; a_ < 2; ++a_)
#pragma unroll
                for (int b_ = 0; b_ < 2; ++b_)
#pragma unroll
                    for (int m_ = 0; m_ < 4; ++m_)
#pragma unroll
                        for (int n_ = 0; n_ < 2; ++n_) asm volatile("" :: "v"(acc[a_][b_][m_][n_]));
        } else
        { const int Mz = VMODE == 2 ? 0 : __builtin_amdgcn_readfirstlane(P.M(z));
          if constexpr (VMODE == 2) {
#pragma unroll
            for (int a_ = 0; a_ < 2; ++a_)
#pragma unroll
                for (int b_ = 0; b_ < 2; ++b_)
#pragma unroll
                    for (int m_ = 0; m_ < 4; ++m_)
#pragma unroll
                        for (int n_ = 0; n_ < 2; ++n_) asm volatile("" :: "v"(acc[a_][b_][m_][n_])); }
          const int cb0 = pn * BM + wc * 32 + 8 * fq, rb0 = pm * BM + wr * 64 + fr;
          if constexpr (Prob::PAIR) {
              const typename Prob::ColCtx cc = P.colctx(z, cb0);
              typename Prob::RowCtx rc[2][4];
#pragma unroll
              for (int ai = 0; ai < 2; ++ai)
#pragma unroll
                  for (int m = 0; m < 4; ++m) { const int row = rb0 + ai * HALF + m * 16; rc[ai][m] = P.rowctx(z, row, row < Mz); }
#pragma unroll
              for (int ai = 0; ai < 2; ++ai)
#pragma unroll
                  for (int m = 0; m < 4; ++m) { const int row = rb0 + ai * HALF + m * 16;
                      if (row < Mz) { const f32x4 g0 = acc[ai][0][m][0], g1 = acc[ai][0][m][1], l0 = acc[ai][1][m][0], l1 = acc[ai][1][m][1];
                          const float vg[8] = {g0[0], g0[1], g0[2], g0[3], g1[0], g1[1], g1[2], g1[3]}, vl[8] = {l0[0], l0[1], l0[2], l0[3], l1[0], l1[1], l1[2], l1[3]};
                          P.storepair(cc, rc[ai][m], vg, vl); } }
          } else if constexpr (Prob::HOIST) {
              typename Prob::ColCtx cc[2]; typename Prob::RowCtx rc[2][4];
#pragma unroll
              for (int bj = 0; bj < 2; ++bj) cc[bj] = P.colctx(z, cb0 + bj * HALF);
#pragma unroll
              for (int ai = 0; ai < 2; ++ai)
#pragma unroll
                  for (int m = 0; m < 4; ++m) { const int row = rb0 + ai * HALF + m * 16; rc[ai][m] = P.rowctx(z, row, row < Mz); }
#pragma unroll
              for (int ai = 0; ai < 2; ++ai)
#pragma unroll
                  for (int m = 0; m < 4; ++m) { const int row = rb0 + ai * HALF + m * 16;
                      if (row < Mz) {
#pragma unroll
                          for (int bj = 0; bj < 2; ++bj) { const f32x4 v0 = acc[ai][bj][m][0], v1 = acc[ai][bj][m][1];
                              const float v[8] = {v0[0], v0[1], v0[2], v0[3], v1[0], v1[1], v1[2], v1[3]};
                              P.storeh(cc[bj], rc[ai][m], cb0 + bj * HALF, v); } } }
          } else {
#pragma unroll
          for (int ai = 0; ai < 2; ++ai)
#pragma unroll
            for (int m = 0; m < 4; ++m) { const int row = rb0 + ai * HALF + m * 16;
                if (row < Mz) {
#pragma unroll
                    for (int bj = 0; bj < 2; ++bj) { const int c0 = cb0 + bj * HALF;
                        const f32x4 v0 = acc[ai][bj][m][0], v1 = acc[ai][bj][m][1];
                        const float v[8] = {v0[0], v0[1], v0[2], v0[3], v1[0], v1[1], v1[2], v1[3]};
                        P.store(z, row, c0, v); } }
                asm volatile("" ::: "memory"); } } }
        if (!has_next) break;
        z = nz; pm = npm; pn = npn; cB = nB; L = Ln;
    }
    G_WAIT_V(0);
    if (wr == 0) G_BAR;
    G_BAR;
}

template <int NT, bool REV> DEVI void moe_unit(const LAS int* ub, int L, int G, int& z, int& pm, int& pn) {
    const int nun = __builtin_amdgcn_readfirstlane(ub[NEXP]) * NT;
    int Lq = L;
    if ((G & 7) == 0) { const int i = L / G, c = L - i * G, x = c & 7, j = c >> 3, per = G >> 3; Lq = (i * 8 + x) * per + j; }
    if (Lq >= nun) { z = -1; pm = 0; pn = 0; return; }
    if (REV) Lq = nun - 1 - Lq;
    int e = 0; while (e < NEXP - 1 && Lq >= __builtin_amdgcn_readfirstlane(ub[e + 1]) * NT) ++e;
    const int l = Lq - __builtin_amdgcn_readfirstlane(ub[e]) * NT; z = e; pm = l / NT; pn = l % NT;
}
struct FMoe1 {
    static constexpr bool HOIST = true, PAIR = true, RV = false; static constexpr int NT = 8;
    const bf16_t* A; const bf16_t* B; int K; const int* cnt; const int* list; const float* b_gu; bf16_t* ACT; const LAS int* ub; int G;
    struct ColCtx { float bg[8], bl[8]; int f0; }; struct RowCtx { bf16_t* p; };
    DEVI int ubs(int e) const { return __builtin_amdgcn_readfirstlane(ub[e]); }
    DEVI int nunits() const { const int n = ubs(NEXP) * NT; return (G & 7) == 0 ? (n + G - 1) / G * G : n; }
    DEVI void unit(int L, int& z, int& pm, int& pn) const { moe_unit<NT, RV>(ub, L, G, z, pm, pn); }
    DEVI int M(int z) const { return z < 0 ? 0 : cnt[z]; }
    DEVI unsigned aoffb(int z, int r) const { const int t = (z >= 0 && r < cnt[z]) ? (list[z * LISTCAP + r] >> 2) : 0; return (unsigned)t * (unsigned)(DM * 2); }
    DEVI const bf16_t* Bt(int z) const { return B + (size_t)(z < 0 ? 0 : z) * 2048 * DM; }
    DEVI ColCtx colctx(int z, int c0) const { ColCtx c; c.f0 = (c0 >> 8) * 128 + (c0 & 127); const float* bp = b_gu + (size_t)(z < 0 ? 0 : z) * 2048 + c.f0;
        const float4 g0 = *(const float4*)bp, g1 = *(const float4*)(bp + 4), l0 = *(const float4*)(bp + 1024), l1 = *(const float4*)(bp + 1028);
        c.bg[0] = g0.x; c.bg[1] = g0.y; c.bg[2] = g0.z; c.bg[3] = g0.w; c.bg[4] = g1.x; c.bg[5] = g1.y; c.bg[6] = g1.z; c.bg[7] = g1.w;
        c.bl[0] = l0.x; c.bl[1] = l0.y; c.bl[2] = l0.z; c.bl[3] = l0.w; c.bl[4] = l1.x; c.bl[5] = l1.y; c.bl[6] = l1.z; c.bl[7] = l1.w; return c; }
    DEVI RowCtx rowctx(int z, int r, bool) const { RowCtx x; x.p = ACT + (size_t)(ubs(z < 0 ? 0 : z) * 256 + r) * DFF; return x; }
    DEVI void storepair(const ColCtx& c, const RowCtx& x, const float (&vg)[8], const float (&vl)[8]) const {
        typedef float f2 __attribute__((ext_vector_type(2))); unsigned w[4];
#pragma unroll
        for (int i = 0; i < 4; ++i) { f2 g = (f2){vg[2 * i], vg[2 * i + 1]} + (f2){c.bg[2 * i], c.bg[2 * i + 1]}, l = (f2){vl[2 * i], vl[2 * i + 1]} + (f2){c.bl[2 * i], c.bl[2 * i + 1]};
            g[0] = fminf(g[0], 7.f); g[1] = fminf(g[1], 7.f); l[0] = __builtin_amdgcn_fmed3f(l[0], -7.f, 7.f); l[1] = __builtin_amdgcn_fmed3f(l[1], -7.f, 7.f);
            const f2 t = g * (-1.702f * 1.44269504f); f2 e; e[0] = __builtin_amdgcn_exp2f(t[0]); e[1] = __builtin_amdgcn_exp2f(t[1]); e = e + 1.f;
            f2 r; r[0] = __builtin_amdgcn_rcpf(e[0]); r[1] = __builtin_amdgcn_rcpf(e[1]);
            const f2 a = (l + 1.f) * g * r; w[i] = pk2(a[0], a[1]); }
        uint4 o; o.x = w[0]; o.y = w[1]; o.z = w[2]; o.w = w[3]; *(uint4*)(x.p + c.f0) = o; }
    DEVI void storeh(const ColCtx&, const RowCtx&, int, const float (&)[8]) const {}
    DEVI void store(int, int, int, const float (&)[8]) const {}
};
struct FMoe2 {
    static constexpr bool HOIST = true, PAIR = false, RV = true; static constexpr int NT = 4;
    const bf16_t* A; const bf16_t* B; int K; const int* cnt; const float* b_down; bf16_t* Y2; const LAS int* ub; int G;
    struct ColCtx { float bd[8]; }; struct RowCtx { bf16_t* p; };
    DEVI int ubs(int e) const { return __builtin_amdgcn_readfirstlane(ub[e]); }
    DEVI int nunits() const { const int n = ubs(NEXP) * NT; return (G & 7) == 0 ? (n + G - 1) / G * G : n; }
    DEVI void unit(int L, int& z, int& pm, int& pn) const { moe_unit<NT, RV>(ub, L, G, z, pm, pn); }
    DEVI int M(int z) const { return z < 0 ? 0 : cnt[z]; }
    DEVI unsigned aoffb(int z, int r) const { return (unsigned)(ubs(z < 0 ? 0 : z) * 256 + r) * (unsigned)(DFF * 2); }
    DEVI const bf16_t* Bt(int z) const { return B + (size_t)(z < 0 ? 0 : z) * DM * DFF; }
    DEVI ColCtx colctx(int z, int c0) const { ColCtx c; const float* bp = b_down + (size_t)(z < 0 ? 0 : z) * DM + c0; const float4 a = *(const float4*)bp, b = *(const float4*)(bp + 4);
        c.bd[0] = a.x; c.bd[1] = a.y; c.bd[2] = a.z; c.bd[3] = a.w; c.bd[4] = b.x; c.bd[5] = b.y; c.bd[6] = b.z; c.bd[7] = b.w; return c; }
    DEVI RowCtx rowctx(int z, int r, bool) const { RowCtx x; x.p = Y2 + (size_t)(ubs(z < 0 ? 0 : z) * 256 + r) * DM; return x; }
    DEVI void storeh(const ColCtx& c, const RowCtx& x, int c0, const float (&v)[8]) const {
        uint4 o; o.x = pk2(v[0] + c.bd[0], v[1] + c.bd[1]); o.y = pk2(v[2] + c.bd[2], v[3] + c.bd[3]); o.z = pk2(v[4] + c.bd[4], v[5] + c.bd[5]); o.w = pk2(v[6] + c.bd[6], v[7] + c.bd[7]);
        *(uint4*)(x.p + c0) = o; }
    DEVI void store(int, int, int, const float (&)[8]) const {}
};

struct MArgs { const float* in[30]; float* out; unsigned char* ws; int ph_lo, ph_hi; };
struct MArgs_in { const float *lam_re, *lam_im, *log_dt, *b_re, *b_im, *c_re, *c_im; };

constexpr int GL_LRS = 0, GL_TOT = 8192, GL_QF = 12288, GL_KF = 21504, GL_QB = 30720, GL_KB = 39936, GL_VT = 49152, GL_PP = 67584, GL_SSQ = 76800, GL_UST = 67584;
constexpr int GL_LD = 72;

struct GlaPtrs { const bf16_t* QK; const bf16_t* V; const bf16_t* R; const float* LR; const float* lr_up; const float* lr_bias; const float* nw; bf16_t* UCH; float* ADEC; bf16_t* SST; bf16_t* MIX; bf16_t* GLT; };

DEVI void gla_gates(const GlaPtrs& G, LAS unsigned char* lds, int h, int d, int to, float (&cf)[8], float (&cb)[8]) {
    const LAS float* LRS = (const LAS float*)(lds + GL_LRS); LAS float* TOT = (LAS float*)(lds + GL_TOT);
#pragma unroll
    for (int dir = 0; dir < 2; ++dir) {
        float up[16];
#pragma unroll
        for (int r = 0; r < 16; ++r) up[r] = G.lr_up[dir * 4096 + r * 256 + h * 64 + d];
        const float bias = G.lr_bias[dir * 256 + h * 64 + d];
        float la[8];
#pragma unroll
        for (int j = 0; j < 8; ++j) { const LAS f32x4* lp = (const LAS f32x4*)(LRS + (to * 8 + j) * 32 + dir * 16); float g = bias;
#pragma unroll
            for (int q = 0; q < 4; ++q) { const f32x4 x = lp[q]; g += x[0] * up[4 * q] + x[1] * up[4 * q + 1] + x[2] * up[4 * q + 2] + x[3] * up[4 * q + 3]; }
            la[j] = logsigmoidf_(g) * (1.f / 16.f); }
        if (dir == 0) { cf[0] = la[0];
#pragma unroll
            for (int j = 1; j < 8; ++j) cf[j] = cf[j - 1] + la[j];
            TOT[(0 * 8 + to) * 64 + d] = cf[7]; }
        else { cb[7] = la[7];
#pragma unroll
            for (int j = 6; j >= 0; --j) cb[j] = cb[j + 1] + la[j];
            TOT[(1 * 8 + to) * 64 + d] = cb[0]; }
    }
}
DEVI void gla_stage(const GlaPtrs& G, LAS unsigned char* lds, int row0, int h, int tid) {
    *(LAS f32x4*)(lds + GL_LRS + tid * 16) = *(const f32x4*)(G.LR + (size_t)row0 * 32 + tid * 4);
    const int ep = tid & 63, to = tid >> 6; unsigned w[8];
#pragma unroll
    for (int j = 0; j < 8; ++j) w[j] = *(const unsigned*)(G.V + (size_t)(row0 + to * 8 + j) * 512 + h * 128 + 2 * ep);
    u32x4 lo, hi;
    lo.x = (w[0] & 0xffffu) | (w[1] << 16); lo.y = (w[2] & 0xffffu) | (w[3] << 16); lo.z = (w[4] & 0xffffu) | (w[5] << 16); lo.w = (w[6] & 0xffffu) | (w[7] << 16);
    hi.x = (w[0] >> 16) | (w[1] & 0xffff0000u); hi.y = (w[2] >> 16) | (w[3] & 0xffff0000u); hi.z = (w[4] >> 16) | (w[5] & 0xffff0000u); hi.w = (w[6] >> 16) | (w[7] & 0xffff0000u);
    *(LAS u32x4*)(lds + GL_VT + ((2 * ep) * GL_LD + to * 8) * 2) = lo;
    *(LAS u32x4*)(lds + GL_VT + ((2 * ep + 1) * GL_LD + to * 8) * 2) = hi;
}

DEVI void gla_a_item(const GlaPtrs& G, LAS unsigned char* lds, int item) {
    int tid = threadIdx.x; asm volatile("" : "+v"(tid));
    const int wave = __builtin_amdgcn_readfirstlane(tid >> 6), lane = tid & 63, d = lane, to = wave, fr = lane & 15, fq = lane >> 4;
    const int ch = item % 68, bh = item / 68, h = bh & 3, b = bh >> 2;
    const int row0 = ch < 4 ? NTOK + b * CTX + ch * 64 : b * SEQ + (ch - 4) * 64;
    gla_stage(G, lds, row0, h, tid);
    bf16_t kk[8];
#pragma unroll
    for (int j = 0; j < 8; ++j) kk[j] = G.QK[(size_t)(row0 + to * 8 + j) * 512 + 256 + h * 64 + d];
    __syncthreads();
    float cf[8], cb[8];
    gla_gates(G, lds, h, d, to, cf, cb);
    __syncthreads();
    const LAS float* TOT = (const LAS float*)(lds + GL_TOT);
    float offf = 0.f, offb = 0.f, totf = 0.f, totb = 0.f;
#pragma unroll
    for (int t = 0; t < 8; ++t) { const float a = TOT[(0 * 8 + t) * 64 + d], c = TOT[(1 * 8 + t) * 64 + d]; totf += a; totb += c; if (t < to) offf += a; if (t > to) offb += c; }
    float of[8], ob[8];
#pragma unroll
    for (int j = 0; j < 8; ++j) { const float kf = bf2f(kk[j]); of[j] = kf * __expf(totf - (cf[j] + offf)); ob[j] = kf * __expf(totb - (cb[j] + offb)); }
    { u32x4 w; w.x = pk2(of[0], of[1]); w.y = pk2(of[2], of[3]); w.z = pk2(of[4], of[5]); w.w = pk2(of[6], of[7]); *(LAS u32x4*)(lds + GL_QF + (d * GL_LD + to * 8) * 2) = w;
      w.x = pk2(ob[0], ob[1]); w.y = pk2(ob[2], ob[3]); w.z = pk2(ob[4], ob[5]); w.w = pk2(ob[6], ob[7]); *(LAS u32x4*)(lds + GL_KF + (d * GL_LD + to * 8) * 2) = w; }
    const int chain_f = bh * 2, step_f = ch < 4 ? ch : ch, step_b = ch < 4 ? 3 - ch : 4 + (67 - ch);
    if (to == 0) { G.ADEC[((size_t)chain_f * 68 + step_f) * 64 + d] = __expf(totf); G.ADEC[((size_t)(chain_f + 1) * 68 + step_b) * 64 + d] = __expf(totb); }
    __syncthreads();
    f32x4 acc[2][4];
#pragma unroll
    for (int dr = 0; dr < 2; ++dr)
#pragma unroll
        for (int dt = 0; dt < 4; ++dt) acc[dr][dt] = (f32x4){0.f, 0.f, 0.f, 0.f};
#pragma unroll
    for (int ks = 0; ks < 2; ++ks) { const bf16x8 a = *(const LAS bf16x8*)(lds + GL_VT + ((wave * 16 + fr) * GL_LD + ks * 32 + fq * 8) * 2);
#pragma unroll
        for (int dt = 0; dt < 4; ++dt) { const bf16x8 b0 = *(const LAS bf16x8*)(lds + GL_QF + ((dt * 16 + fr) * GL_LD + ks * 32 + fq * 8) * 2);
            const bf16x8 b1 = *(const LAS bf16x8*)(lds + GL_KF + ((dt * 16 + fr) * GL_LD + ks * 32 + fq * 8) * 2);
            acc[0][dt] = __builtin_amdgcn_mfma_f32_16x16x32_bf16(a, b0, acc[0][dt], 0, 0, 0); acc[1][dt] = __builtin_amdgcn_mfma_f32_16x16x32_bf16(a, b1, acc[1][dt], 0, 0, 0); } }
#pragma unroll
    for (int dr = 0; dr < 2; ++dr)
#pragma unroll
        for (int dt = 0; dt < 4; ++dt)
#pragma unroll
            for (int rg = 0; rg < 4; ++rg) *(LAS bf16_t*)(lds + GL_UST + ((dr * 128 + wave * 16 + 4 * fq + rg) * 64 + dt * 16 + fr) * 2) = f2bf(acc[dr][dt][rg]);
    __syncthreads();
#pragma unroll
    for (int i = 0; i < 4; ++i) { const int q = tid + i * NTHR, dr = q >> 10, off = (q & 1023) * 8;
        const u32x4 w = *(const LAS u32x4*)(lds + GL_UST + (dr * 8192 + off) * 2);
        const size_t chain = (size_t)chain_f + dr; const int step = dr ? step_b : step_f;
        *(u32x4*)(G.UCH + (chain * 68 + step) * 8192 + off) = w; }
    __syncthreads();
}

DEVI void gla_b_block(const GlaPtrs& G, LAS unsigned char* lds, int blk) {
    int tid = threadIdx.x; asm volatile("" : "+v"(tid));
    const int chain = blk >> 2, e = (blk & 3) * 32 + (tid >> 4), d4 = (tid & 15) * 4;
    for (int i = tid; i < 68 * 16; i += NTHR) ((LAS f32x4*)lds)[i] = ((const f32x4*)(G.ADEC + (size_t)chain * 68 * 64))[i];
    __syncthreads();
    const bf16_t* up = G.UCH + ((size_t)chain * 68 * 128 + e) * 64 + d4;
    bf16_t* sp = G.SST + ((size_t)chain * 64 * 128 + e) * 64 + d4;
    float S0 = 0.f, S1 = 0.f, S2 = 0.f, S3 = 0.f;
    uint2 cur[17], nxt[17];
#pragma unroll
    for (int j = 0; j < 17; ++j) cur[j] = *(const uint2*)(up + (size_t)j * 8192);
#pragma unroll 1
    for (int bt = 0; bt < 4; ++bt) {
        if (bt < 3) {
#pragma unroll
            for (int j = 0; j < 17; ++j) nxt[j] = *(const uint2*)(up + (size_t)((bt + 1) * 17 + j) * 8192); }
#pragma unroll
        for (int j = 0; j < 17; ++j) { const int step = bt * 17 + j;
            if (step >= 4) { uint2 o; o.x = pk2(S0, S1); o.y = pk2(S2, S3); *(uint2*)(sp + (size_t)(step - 4) * 8192) = o; }
            const f32x4 a = *(const LAS f32x4*)(lds + (step * 64 + d4) * 4);
            S0 = a[0] * S0 + __uint_as_float(cur[j].x << 16); S1 = a[1] * S1 + __uint_as_float(cur[j].x & 0xffff0000u);
            S2 = a[2] * S2 + __uint_as_float(cur[j].y << 16); S3 = a[3] * S3 + __uint_as_float(cur[j].y & 0xffff0000u); }
#pragma unroll
        for (int j = 0; j < 17; ++j) cur[j] = nxt[j];
    }
    __syncthreads();
}

DEVI void gla_c_item(const GlaPtrs& G, LAS unsigned char* lds, int item) {
    int tid = threadIdx.x; asm volatile("" : "+v"(tid));
    const int wave = __builtin_amdgcn_readfirstlane(tid >> 6), lane = tid & 63, d = lane, to = wave, fr = lane & 15, fq = lane >> 4;
    const int c = item & 63, bh = item >> 6, h = bh & 3, b = bh >> 2;
    const int row0 = b * SEQ + c * 64;
    gla_stage(G, lds, row0, h, tid);
    bf16_t qq[8], kk[8];
#pragma unroll
    for (int j = 0; j < 8; ++j) { const size_t o = (size_t)(row0 + to * 8 + j) * 512 + h * 64 + d; qq[j] = G.QK[o]; kk[j] = G.QK[o + 256]; }
    __syncthreads();
    float cf[8], cb[8];
    gla_gates(G, lds, h, d, to, cf, cb);
    __syncthreads();
    { const LAS float* TOT = (const LAS float*)(lds + GL_TOT);
      float offf = 0.f, offb = 0.f;
#pragma unroll
      for (int t = 0; t < 8; ++t) { if (t < to) offf += TOT[(0 * 8 + t) * 64 + d]; if (t > to) offb += TOT[(1 * 8 + t) * 64 + d]; }
#pragma unroll
      for (int j = 0; j < 8; ++j) { const float qf = bf2f(qq[j]) * 0.125f, kf = bf2f(kk[j]);
          const float ef = __expf(fmaxf(cf[j] + offf, -80.f)), eb = __expf(fmaxf(cb[j] + offb, -80.f));
          const int o = ((to * 8 + j) * GL_LD + d) * 2;
          *(LAS bf16_t*)(lds + GL_QF + o) = f2bf(qf * ef); *(LAS bf16_t*)(lds + GL_KF + o) = f2bf(kf * __builtin_amdgcn_rcpf(ef));
          *(LAS bf16_t*)(lds + GL_QB + o) = f2bf(qf * eb); *(LAS bf16_t*)(lds + GL_KB + o) = f2bf(kf * __builtin_amdgcn_rcpf(eb)); } }
    __syncthreads();
    { const int ti = wave >> 1;
#pragma unroll
      for (int u = 0; u < 2; ++u) { const int tj = (wave & 1) * 2 + u;
          f32x4 af = (f32x4){0.f, 0.f, 0.f, 0.f}, ab = (f32x4){0.f, 0.f, 0.f, 0.f};
          if (tj <= ti) {
#pragma unroll
              for (int ks = 0; ks < 2; ++ks) { const bf16x8 a = *(const LAS bf16x8*)(lds + GL_KF + ((tj * 16 + fr) * GL_LD + ks * 32 + fq * 8) * 2), bb = *(const LAS bf16x8*)(lds + GL_QF + ((ti * 16 + fr) * GL_LD + ks * 32 + fq * 8) * 2);
                  af = __builtin_amdgcn_mfma_f32_16x16x32_bf16(a, bb, af, 0, 0, 0); } }
          if (tj >= ti) {
#pragma unroll
              for (int ks = 0; ks < 2; ++ks) { const bf16x8 a = *(const LAS bf16x8*)(lds + GL_KB + ((tj * 16 + fr) * GL_LD + ks * 32 + fq * 8) * 2), bb = *(const LAS bf16x8*)(lds + GL_QB + ((ti * 16 + fr) * GL_LD + ks * 32 + fq * 8) * 2);
                  ab = __builtin_amdgcn_mfma_f32_16x16x32_bf16(a, bb, ab, 0, 0, 0); } }
          float p[4];
#pragma unroll
          for (int rg = 0; rg < 4; ++rg) { const int i = ti * 16 + fr, j = tj * 16 + 4 * fq + rg; p[rg] = (j <= i ? af[rg] : 0.f) + (j >= i ? ab[rg] : 0.f); }
          u32x2 w; w.x = pk2(p[0], p[1]); w.y = pk2(p[2], p[3]);
          *(LAS u32x2*)(lds + GL_PP + ((ti * 16 + fr) * GL_LD + tj * 16 + 4 * fq) * 2) = w; } }
    __syncthreads();
    const int tg = wave & 3, eh = wave >> 2;
    f32x4 acc[4];
#pragma unroll
    for (int et = 0; et < 4; ++et) acc[et] = (f32x4){0.f, 0.f, 0.f, 0.f};
    { const bf16_t* Sf = G.SST + ((size_t)(bh * 2) * 64 + c) * 8192; const bf16_t* Sb = G.SST + ((size_t)(bh * 2 + 1) * 64 + (63 - c)) * 8192;
#pragma unroll
      for (int ks = 0; ks < 2; ++ks) {
          const int bo = ((tg * 16 + fr) * GL_LD + ks * 32 + fq * 8) * 2;
          const bf16x8 bP = *(const LAS bf16x8*)(lds + GL_PP + bo), bF = *(const LAS bf16x8*)(lds + GL_QF + bo), bB = *(const LAS bf16x8*)(lds + GL_QB + bo);
#pragma unroll
          for (int et = 0; et < 4; ++et) { const int e = eh * 64 + et * 16 + fr;
              const bf16x8 aV = *(const LAS bf16x8*)(lds + GL_VT + (e * GL_LD + ks * 32 + fq * 8) * 2);
              const bf16x8 aF = *(const bf16x8*)(Sf + e * 64 + ks * 32 + fq * 8), aB = *(const bf16x8*)(Sb + e * 64 + ks * 32 + fq * 8);
              acc[et] = __builtin_amdgcn_mfma_f32_16x16x32_bf16(aV, bP, acc[et], 0, 0, 0);
              acc[et] = __builtin_amdgcn_mfma_f32_16x16x32_bf16(aF, bF, acc[et], 0, 0, 0);
              acc[et] = __builtin_amdgcn_mfma_f32_16x16x32_bf16(aB, bB, acc[et], 0, 0, 0); } } }
    float ss = 0.f;
#pragma unroll
    for (int et = 0; et < 4; ++et) ss += acc[et][0] * acc[et][0] + acc[et][1] * acc[et][1] + acc[et][2] * acc[et][2] + acc[et][3] * acc[et][3];
    ss += __shfl_xor(ss, 16); ss += __shfl_xor(ss, 32);
    LAS float* SSQ = (LAS float*)(lds + GL_SSQ);
    if (fq == 0) SSQ[eh * 64 + tg * 16 + fr] = ss;
    __syncthreads();
    const float rstd = rsqrtf((SSQ[tg * 16 + fr] + SSQ[64 + tg * 16 + fr]) * (1.f / 128.f) + 1e-6f);
    const int tok = row0 + tg * 16 + fr;
#pragma unroll
    for (int et = 0; et < 4; ++et) { const int e = eh * 64 + et * 16 + 4 * fq;
        const uint2 rv = *(const uint2*)(G.R + (size_t)tok * 512 + h * 128 + e); const f32x4 nw = *(const f32x4*)(G.nw + e);
        const float r0 = __uint_as_float(rv.x << 16), r1 = __uint_as_float(rv.x & 0xffff0000u), r2 = __uint_as_float(rv.y << 16), r3 = __uint_as_float(rv.y & 0xffff0000u);
        uint2 w; w.x = pk2(acc[et][0] * rstd * nw[0] * siluf_(r0), acc[et][1] * rstd * nw[1] * siluf_(r1)); w.y = pk2(acc[et][2] * rstd * nw[2] * siluf_(r2), acc[et][3] * rstd * nw[3] * siluf_(r3));
        *(uint2*)(G.MIX + (size_t)tok * DM + h * 128 + e) = w; }
    __syncthreads();
}

constexpr int GL_SF = 77312, GL_SB = 95744, GL_RQ = 114176, GL_RK = 122368;

struct GateW { float up[2][16]; float bias[2]; };
DEVI GateW gla_gatew(const GlaPtrs& G, int h, int d) { GateW w;
#pragma unroll
    for (int dir = 0; dir < 2; ++dir) {
#pragma unroll
        for (int r = 0; r < 16; ++r) w.up[dir][r] = G.lr_up[dir * 4096 + r * 256 + h * 64 + d];
        w.bias[dir] = G.lr_bias[dir * 256 + h * 64 + d]; }
    return w; }
DEVI void gla_gates2(const GateW& W, LAS unsigned char* lds, int d, int to, float (&cf)[8], float (&cb)[8]) {
    const LAS float* LRS = (const LAS float*)(lds + GL_LRS); LAS float* TOT = (LAS float*)(lds + GL_TOT);
#pragma unroll
    for (int dir = 0; dir < 2; ++dir) {
        float la[8];
#pragma unroll
        for (int j = 0; j < 8; ++j) { const LAS f32x4* lp = (const LAS f32x4*)(LRS + (to * 8 + j) * 32 + dir * 16); float g = W.bias[dir];
#pragma unroll
            for (int q = 0; q < 4; ++q) { const f32x4 x = lp[q]; g += x[0] * W.up[dir][4 * q] + x[1] * W.up[dir][4 * q + 1] + x[2] * W.up[dir][4 * q + 2] + x[3] * W.up[dir][4 * q + 3]; }
            la[j] = logsigmoidf_(g) * (1.f / 16.f); }
        if (dir == 0) { cf[0] = la[0];
#pragma unroll
            for (int j = 1; j < 8; ++j) cf[j] = cf[j - 1] + la[j];
            TOT[(0 * 8 + to) * 64 + d] = cf[7]; }
        else { cb[7] = la[7];
#pragma unroll
            for (int j = 6; j >= 0; --j) cb[j] = cb[j + 1] + la[j];
            TOT[(1 * 8 + to) * 64 + d] = cb[0]; }
    }
}
struct GIn { f32x4 lr; unsigned vv[8]; u32x4 kraw; u32x4 qraw; u32x4 sraw[4]; u32x2 rr[4]; };
template <bool WQ> DEVI void gla_load_common(const GlaPtrs& G, int row0, int h, int tid, GIn& I) {
    I.lr = *(const f32x4*)(G.LR + (size_t)row0 * 32 + tid * 4);
    const int ep = tid & 63, to = tid >> 6;
#pragma unroll
    for (int j = 0; j < 8; ++j) I.vv[j] = *(const unsigned*)(G.V + (size_t)(row0 + to * 8 + j) * 512 + h * 128 + 2 * ep);
    const int tok = tid >> 3, chunk = tid & 7;
    I.kraw = *(const u32x4*)(G.QK + (size_t)(row0 + tok) * 512 + 256 + h * 64 + chunk * 8);
    if (WQ) I.qraw = *(const u32x4*)(G.QK + (size_t)(row0 + tok) * 512 + h * 64 + chunk * 8);
}
template <bool WQ> DEVI void gla_stage_common(LAS unsigned char* lds, int tid, const GIn& I) {
    *(LAS f32x4*)(lds + GL_LRS + tid * 16) = I.lr;
    const int ep = tid & 63, to = tid >> 6; const unsigned* w = I.vv;
    u32x4 lo, hi;
    lo.x = (w[0] & 0xffffu) | (w[1] << 16); lo.y = (w[2] & 0xffffu) | (w[3] << 16); lo.z = (w[4] & 0xffffu) | (w[5] << 16); lo.w = (w[6] & 0xffffu) | (w[7] << 16);
    hi.x = (w[0] >> 16) | (w[1] & 0xffff0000u); hi.y = (w[2] >> 16) | (w[3] & 0xffff0000u); hi.z = (w[4] >> 16) | (w[5] & 0xffff0000u); hi.w = (w[6] >> 16) | (w[7] & 0xffff0000u);
    *(LAS u32x4*)(lds + GL_VT + ((2 * ep) * GL_LD + to * 8) * 2) = lo;
    *(LAS u32x4*)(lds + GL_VT + ((2 * ep + 1) * GL_LD + to * 8) * 2) = hi;
    *(LAS u32x4*)(lds + GL_RK + tid * 16) = I.kraw;
    if (WQ) *(LAS u32x4*)(lds + GL_RQ + tid * 16) = I.qraw;
}

DEVI void gla_a_phase(const GlaPtrs& G, LAS unsigned char* lds, int bid, int Gsz) {
    int tid = threadIdx.x; asm volatile("" : "+v"(tid));
    const int wave = __builtin_amdgcn_readfirstlane(tid >> 6), lane = tid & 63, d = lane, to = wave, fr = lane & 15, fq = lane >> 4;
    constexpr int NIT = NB * 4 * 68;
    if (bid >= NIT) return;
#define GA_ROW0(it) (((it) % 68) < 4 ? NTOK + (((it) / 68) >> 2) * CTX + ((it) % 68) * 64 : (((it) / 68) >> 2) * SEQ + (((it) % 68) - 4) * 64)
    GIn cur; gla_load_common<true>(G, GA_ROW0(bid), (bid / 68) & 3, tid, cur);
    int hw = -1; GateW W;
    for (int item = bid; item < NIT; item += Gsz) {
        const int ch = item % 68, bh = item / 68, h = bh & 3;
        if (h != hw) { W = gla_gatew(G, h, d); hw = h; }
        gla_stage_common<true>(lds, tid, cur);
        __syncthreads();
        { const int nit = item + Gsz; if (nit < NIT) gla_load_common<true>(G, GA_ROW0(nit), (nit / 68) & 3, tid, cur); }
        float cf[8], cb[8];
        gla_gates2(W, lds, d, to, cf, cb);
        __syncthreads();
        const LAS float* TOT = (const LAS float*)(lds + GL_TOT);
        float offf = 0.f, offb = 0.f, totf = 0.f, totb = 0.f;
#pragma unroll
        for (int t = 0; t < 8; ++t) { const float a = TOT[(0 * 8 + t) * 64 + d], c = TOT[(1 * 8 + t) * 64 + d]; totf += a; totb += c; if (t < to) offf += a; if (t > to) offb += c; }
        float of[8], ob[8];
        bf16_t* gt = G.GLT + ((size_t)(bh * 64 + (ch - 4)) * 4) * 4096;
#pragma unroll
        for (int j = 0; j < 8; ++j) { const int ro = ((to * 8 + j) * 64 + d) * 2; const float kf = bf2f(*(const LAS bf16_t*)(lds + GL_RK + ro));
            of[j] = kf * __expf(totf - (cf[j] + offf)); ob[j] = kf * __expf(totb - (cb[j] + offb));
            if (ch >= 4) { const float qf = bf2f(*(const LAS bf16_t*)(lds + GL_RQ + ro)) * 0.125f;
                const float ef = __expf(fmaxf(cf[j] + offf, -80.f)), eb = __expf(fmaxf(cb[j] + offb, -80.f)); const int go = (to * 8 + j) * 64 + d;
                gt[go] = f2bf(qf * ef); gt[4096 + go] = f2bf(kf * __builtin_amdgcn_rcpf(ef)); gt[8192 + go] = f2bf(qf * eb); gt[12288 + go] = f2bf(kf * __builtin_amdgcn_rcpf(eb)); } }
        { u32x4 w; w.x = pk2(of[0], of[1]); w.y = pk2(of[2], of[3]); w.z = pk2(of[4], of[5]); w.w = pk2(of[6], of[7]); *(LAS u32x4*)(lds + GL_QF + (d * GL_LD + to * 8) * 2) = w;
          w.x = pk2(ob[0], ob[1]); w.y = pk2(ob[2], ob[3]); w.z = pk2(ob[4], ob[5]); w.w = pk2(ob[6], ob[7]); *(LAS u32x4*)(lds + GL_KF + (d * GL_LD + to * 8) * 2) = w; }
        const int chain_f = bh * 2, step_f = ch, step_b = ch < 4 ? 3 - ch : 71 - ch;
        if (to == 0) { G.ADEC[((size_t)chain_f * 68 + step_f) * 64 + d] = __expf(totf); G.ADEC[((size_t)(chain_f + 1) * 68 + step_b) * 64 + d] = __expf(totb); }
        __syncthreads();
        f32x4 acc[2][4];
#pragma unroll
        for (int dr = 0; dr < 2; ++dr)
#pragma unroll
            for (int dt = 0; dt < 4; ++dt) acc[dr][dt] = (f32x4){0.f, 0.f, 0.f, 0.f};
#pragma unroll
        for (int ks = 0; ks < 2; ++ks) { const bf16x8 a = *(const LAS bf16x8*)(lds + GL_VT + ((wave * 16 + fr) * GL_LD + ks * 32 + fq * 8) * 2);
#pragma unroll
            for (int dt = 0; dt < 4; ++dt) { const bf16x8 b0 = *(const LAS bf16x8*)(lds + GL_QF + ((dt * 16 + fr) * GL_LD + ks * 32 + fq * 8) * 2);
                const bf16x8 b1 = *(const LAS bf16x8*)(lds + GL_KF + ((dt * 16 + fr) * GL_LD + ks * 32 + fq * 8) * 2);
                acc[0][dt] = __builtin_amdgcn_mfma_f32_16x16x32_bf16(a, b0, acc[0][dt], 0, 0, 0); acc[1][dt] = __builtin_amdgcn_mfma_f32_16x16x32_bf16(a, b1, acc[1][dt], 0, 0, 0); } }
#pragma unroll
        for (int dr = 0; dr < 2; ++dr)
#pragma unroll
            for (int dt = 0; dt < 4; ++dt)
#pragma unroll
                for (int rg = 0; rg < 4; ++rg) *(LAS bf16_t*)(lds + GL_UST + ((dr * 128 + wave * 16 + 4 * fq + rg) * 64 + dt * 16 + fr) * 2) = f2bf(acc[dr][dt][rg]);
        __syncthreads();
#pragma unroll
        for (int i = 0; i < 4; ++i) { const int q = tid + i * NTHR, dr = q >> 10, off = (q & 1023) * 8;
            const u32x4 w = *(const LAS u32x4*)(lds + GL_UST + (dr * 8192 + off) * 2);
            const size_t chain = (size_t)chain_f + dr; const int step = dr ? step_b : step_f;
            *(u32x4*)(G.UCH + (chain * 68 + step) * 8192 + off) = w; }
    }
#undef GA_ROW0
    __syncthreads();
}

struct CIn { unsigned vv[8]; u32x4 tl[4]; u32x4 sraw[4]; u32x2 rr[4]; };
DEVI void gla_c_load(const GlaPtrs& G, int item, int tid, int wave, int fr, int fq, CIn& I) {
    const int c = item & 63, bh = item >> 6, h = bh & 3, b = bh >> 2, row0 = b * SEQ + c * 64;
    const int ep = tid & 63, to = tid >> 6;
#pragma unroll
    for (int j = 0; j < 8; ++j) I.vv[j] = *(const unsigned*)(G.V + (size_t)(row0 + to * 8 + j) * 512 + h * 128 + 2 * ep);
    const bf16_t* gt = G.GLT + (size_t)item * 4 * 4096;
#pragma unroll
    for (int t = 0; t < 4; ++t) I.tl[t] = *(const u32x4*)(gt + t * 4096 + tid * 8);
    const bf16_t* Sf = G.SST + ((size_t)(bh * 2) * 64 + c) * 8192; const bf16_t* Sb = G.SST + ((size_t)(bh * 2 + 1) * 64 + (63 - c)) * 8192;
    I.sraw[0] = *(const u32x4*)(Sf + tid * 8); I.sraw[1] = *(const u32x4*)(Sf + (tid + NTHR) * 8); I.sraw[2] = *(const u32x4*)(Sb + tid * 8); I.sraw[3] = *(const u32x4*)(Sb + (tid + NTHR) * 8);
    const int tg = wave & 3, eh = wave >> 2, tok = row0 + tg * 16 + fr;
#pragma unroll
    for (int et = 0; et < 4; ++et) I.rr[et] = *(const u32x2*)(G.R + (size_t)tok * 512 + h * 128 + eh * 64 + et * 16 + 4 * fq);
}
DEVI void gla_c_phase(const GlaPtrs& G, LAS unsigned char* lds, int bid, int Gsz) {
    int tid = threadIdx.x; asm volatile("" : "+v"(tid));
    const int wave = __builtin_amdgcn_readfirstlane(tid >> 6), lane = tid & 63, fr = lane & 15, fq = lane >> 4;
    constexpr int NIT = NB * 4 * 64;
    if (bid >= NIT) return;
    const int tg = wave & 3, eh = wave >> 2;
    f32x4 nwv[4];
#pragma unroll
    for (int et = 0; et < 4; ++et) nwv[et] = *(const f32x4*)(G.nw + eh * 64 + et * 16 + 4 * fq);
    CIn cur; gla_c_load(G, bid, tid, wave, fr, fq, cur);
    for (int item = bid; item < NIT; item += Gsz) {
        const int c = item & 63, bh = item >> 6, h = bh & 3, b = bh >> 2, row0 = b * SEQ + c * 64;
        { const int ep = tid & 63, to = tid >> 6; const unsigned* w = cur.vv;
          u32x4 lo, hi;
          lo.x = (w[0] & 0xffffu) | (w[1] << 16); lo.y = (w[2] & 0xffffu) | (w[3] << 16); lo.z = (w[4] & 0xffffu) | (w[5] << 16); lo.w = (w[6] & 0xffffu) | (w[7] << 16);
          hi.x = (w[0] >> 16) | (w[1] & 0xffff0000u); hi.y = (w[2] >> 16) | (w[3] & 0xffff0000u); hi.z = (w[4] >> 16) | (w[5] & 0xffff0000u); hi.w = (w[6] >> 16) | (w[7] & 0xffff0000u);
          *(LAS u32x4*)(lds + GL_VT + ((2 * ep) * GL_LD + to * 8) * 2) = lo; *(LAS u32x4*)(lds + GL_VT + ((2 * ep + 1) * GL_LD + to * 8) * 2) = hi; }
        { const int r0 = tid >> 3, ck = tid & 7;
          *(LAS u32x4*)(lds + GL_QF + (r0 * GL_LD + ck * 8) * 2) = cur.tl[0]; *(LAS u32x4*)(lds + GL_KF + (r0 * GL_LD + ck * 8) * 2) = cur.tl[1];
          *(LAS u32x4*)(lds + GL_QB + (r0 * GL_LD + ck * 8) * 2) = cur.tl[2]; *(LAS u32x4*)(lds + GL_KB + (r0 * GL_LD + ck * 8) * 2) = cur.tl[3];
          *(LAS u32x4*)(lds + GL_SF + (r0 * GL_LD + ck * 8) * 2) = cur.sraw[0]; *(LAS u32x4*)(lds + GL_SF + ((r0 + 64) * GL_LD + ck * 8) * 2) = cur.sraw[1];
          *(LAS u32x4*)(lds + GL_SB + (r0 * GL_LD + ck * 8) * 2) = cur.sraw[2]; *(LAS u32x4*)(lds + GL_SB + ((r0 + 64) * GL_LD + ck * 8) * 2) = cur.sraw[3]; }
        u32x2 rcur[4];
#pragma unroll
        for (int et = 0; et < 4; ++et) rcur[et] = cur.rr[et];
        __syncthreads();
        { const int nit = item + Gsz; if (nit < NIT) gla_c_load(G, nit, tid, wave, fr, fq, cur); }
        { const int ti = wave >> 1;
#pragma unroll
          for (int u = 0; u < 2; ++u) { const int tj = (wave & 1) * 2 + u;
              f32x4 af = (f32x4){0.f, 0.f, 0.f, 0.f}, ab = (f32x4){0.f, 0.f, 0.f, 0.f};
              if (tj <= ti) {
#pragma unroll
                  for (int ks = 0; ks < 2; ++ks) { const bf16x8 a = *(const LAS bf16x8*)(lds + GL_KF + ((tj * 16 + fr) * GL_LD + ks * 32 + fq * 8) * 2), bb = *(const LAS bf16x8*)(lds + GL_QF + ((ti * 16 + fr) * GL_LD + ks * 32 + fq * 8) * 2);
                      af = __builtin_amdgcn_mfma_f32_16x16x32_bf16(a, bb, af, 0, 0, 0); } }
              if (tj >= ti) {
#pragma unroll
                  for (int ks = 0; ks < 2; ++ks) { const bf16x8 a = *(const LAS bf16x8*)(lds + GL_KB + ((tj * 16 + fr) * GL_LD + ks * 32 + fq * 8) * 2), bb = *(const LAS bf16x8*)(lds + GL_QB + ((ti * 16 + fr) * GL_LD + ks * 32 + fq * 8) * 2);
                      ab = __builtin_amdgcn_mfma_f32_16x16x32_bf16(a, bb, ab, 0, 0, 0); } }
              float p[4];
#pragma unroll
              for (int rg = 0; rg < 4; ++rg) { const int i = ti * 16 + fr, j = tj * 16 + 4 * fq + rg; p[rg] = (j <= i ? af[rg] : 0.f) + (j >= i ? ab[rg] : 0.f); }
              u32x2 w; w.x = pk2(p[0], p[1]); w.y = pk2(p[2], p[3]);
              *(LAS u32x2*)(lds + GL_PP + ((ti * 16 + fr) * GL_LD + tj * 16 + 4 * fq) * 2) = w; } }
        __syncthreads();
        f32x4 acc[4];
#pragma unroll
        for (int et = 0; et < 4; ++et) acc[et] = (f32x4){0.f, 0.f, 0.f, 0.f};
#pragma unroll
        for (int ks = 0; ks < 2; ++ks) {
            const int bo = ((tg * 16 + fr) * GL_LD + ks * 32 + fq * 8) * 2;
            const bf16x8 bP = *(const LAS bf16x8*)(lds + GL_PP + bo), bF = *(const LAS bf16x8*)(lds + GL_QF + bo), bB = *(const LAS bf16x8*)(lds + GL_QB + bo);
#pragma unroll
            for (int et = 0; et < 4; ++et) { const int ao = ((eh * 64 + et * 16 + fr) * GL_LD + ks * 32 + fq * 8) * 2;
                const bf16x8 aV = *(const LAS bf16x8*)(lds + GL_VT + ao), aF = *(const LAS bf16x8*)(lds + GL_SF + ao), aB = *(const LAS bf16x8*)(lds + GL_SB + ao);
                acc[et] = __builtin_amdgcn_mfma_f32_16x16x32_bf16(aV, bP, acc[et], 0, 0, 0);
                acc[et] = __builtin_amdgcn_mfma_f32_16x16x32_bf16(aF, bF, acc[et], 0, 0, 0);
                acc[et] = __builtin_amdgcn_mfma_f32_16x16x32_bf16(aB, bB, acc[et], 0, 0, 0); } }
        float ss = 0.f;
#pragma unroll
        for (int et = 0; et < 4; ++et) ss += acc[et][0] * acc[et][0] + acc[et][1] * acc[et][1] + acc[et][2] * acc[et][2] + acc[et][3] * acc[et][3];
        ss += __shfl_xor(ss, 16); ss += __shfl_xor(ss, 32);
        LAS float* SSQ = (LAS float*)(lds + GL_SSQ);
        if (fq == 0) SSQ[eh * 64 + tg * 16 + fr] = ss;
        __syncthreads();
        const float rstd = rsqrtf((SSQ[tg * 16 + fr] + SSQ[64 + tg * 16 + fr]) * (1.f / 128.f) + 1e-6f);
        const int tok = row0 + tg * 16 + fr;
#pragma unroll
        for (int et = 0; et < 4; ++et) { const int e = eh * 64 + et * 16 + 4 * fq; const u32x2 rv = rcur[et];
            const float r0 = __uint_as_float(rv.x << 16), r1 = __uint_as_float(rv.x & 0xffff0000u), r2 = __uint_as_float(rv.y << 16), r3 = __uint_as_float(rv.y & 0xffff0000u);
            uint2 w; w.x = pk2(acc[et][0] * rstd * nwv[et][0] * siluf_(r0), acc[et][1] * rstd * nwv[et][1] * siluf_(r1)); w.y = pk2(acc[et][2] * rstd * nwv[et][2] * siluf_(r2), acc[et][3] * rstd * nwv[et][3] * siluf_(r3));
            *(uint2*)(G.MIX + (size_t)tok * DM + h * 128 + e) = w; }
    }
    __syncthreads();
}

DEVI void s5w_build(const MArgs_in& in, unsigned char* ws, LAS unsigned char* lds, int g) {
    LAS float* LP = (LAS float*)lds;
    LAS float* BB = LP + 2 * 17 * 64 * 2;
    LAS float* CC = BB + 2 * 64 * 16 * 2;
    LAS float* KK = CC + 2 * 16 * 64 * 2;
    LAS float* CO = KK + 2 * 16 * 256;
    const int tid = threadIdx.x;
    S5P* P = (S5P*)(ws + OFF_S5P);
    if (tid < 128) { const int p = tid & 63, d = tid >> 6; const int i = (d * 32 + g) * 64 + p;
        const double dt = exp((double)in.log_dt[d * 32 + g]), lr = in.lam_re[i], li = in.lam_im[i];
        const double mag = exp(lr * dt), ar = mag * cos(li * dt), ai = mag * sin(li * dt);
        { const double nr = ar - 1.0, ni = ai, den = lr * lr + li * li; CO[(d * 64 + p) * 2] = (float)((nr * lr + ni * li) / den); CO[(d * 64 + p) * 2 + 1] = (float)((ni * lr - nr * li) / den); }
        double pr = 1.0, pi = 0.0;
        for (int n = 0; n < 17; ++n) { LP[((d * 17 + n) * 64 + p) * 2] = (float)pr; LP[((d * 17 + n) * 64 + p) * 2 + 1] = (float)pi;
            if (n == 16) { P->lam16[d][g][p][0] = (float)pr; P->lam16[d][g][p][1] = (float)pi; }
            const double tr = pr * ar - pi * ai, ti = pr * ai + pi * ar; pr = tr; pi = ti; } }
    for (int t = tid; t < 2 * 16 * 64; t += NTHR) { const int p = t & 63, h = (t >> 6) & 15, d = t >> 10; const size_t ix = (((size_t)d * 32 + g) * 16 + h) * 64 + p;
        CC[((d * 16 + h) * 64 + p) * 2] = in.c_re[ix]; CC[((d * 16 + h) * 64 + p) * 2 + 1] = in.c_im[ix]; }
    __syncthreads();
    for (int t = tid; t < 2 * 64 * 16; t += NTHR) { const int h = t & 15, p = (t >> 4) & 63, d = t >> 10; const size_t ix = (((size_t)d * 32 + g) * 64 + p) * 16 + h;
        const float br = in.b_re[ix], bi = in.b_im[ix], cr = CO[(d * 64 + p) * 2], ci = CO[(d * 64 + p) * 2 + 1];
        BB[((d * 64 + p) * 16 + h) * 2] = cr * br - ci * bi; BB[((d * 64 + p) * 16 + h) * 2 + 1] = cr * bi + ci * br; }
    __syncthreads();
    { const int h = tid & 15, n = (tid >> 4) & 15, d = tid >> 8; float acc[16];
#pragma unroll
      for (int q = 0; q < 16; ++q) acc[q] = 0.f;
      for (int p = 0; p < 64; ++p) { const float cr = CC[((d * 16 + h) * 64 + p) * 2], ci = CC[((d * 16 + h) * 64 + p) * 2 + 1], lr = LP[((d * 17 + n) * 64 + p) * 2], li = LP[((d * 17 + n) * 64 + p) * 2 + 1];
          const float tr = cr * lr - ci * li, ti = cr * li + ci * lr; const LAS f32x4* bb = (const LAS f32x4*)(BB + ((d * 64 + p) * 16) * 2);
#pragma unroll
          for (int q = 0; q < 8; ++q) { const f32x4 x = bb[q]; acc[2 * q] += tr * x[0] - ti * x[1]; acc[2 * q + 1] += tr * x[2] - ti * x[3]; } }
#pragma unroll
      for (int q = 0; q < 16; ++q) KK[(d * 16 + n) * 256 + h * 16 + q] = acc[q]; }
    __syncthreads();
    bf16_t* BF = (bf16_t*)(ws + OFF_S5BF) + (size_t)g * 256 * 256;
    for (int t = tid; t < 256 * 32; t += NTHR) { const int k8 = t & 31, row = t >> 5, p = (row & 127) >> 1, im = row & 1, d = row >> 7; float o[8];
#pragma unroll
        for (int q = 0; q < 8; ++q) { const int k = k8 * 8 + q, j = k >> 4, hp = k & 15, pw = d ? j : 15 - j;
            const float lr = LP[((d * 17 + pw) * 64 + p) * 2], li = LP[((d * 17 + pw) * 64 + p) * 2 + 1], br = BB[((d * 64 + p) * 16 + hp) * 2], bi = BB[((d * 64 + p) * 16 + hp) * 2 + 1];
            o[q] = im ? lr * bi + li * br : lr * br - li * bi; }
        uint4 w; w.x = pk2(o[0], o[1]); w.y = pk2(o[2], o[3]); w.z = pk2(o[4], o[5]); w.w = pk2(o[6], o[7]);
        *(uint4*)(BF + (size_t)row * 256 + k8 * 8) = w; }
    bf16_t* BY = (bf16_t*)(ws + OFF_S5BY) + (size_t)g * 256 * 512;
    for (int t = tid; t < 256 * 64; t += NTHR) { const int k8 = t & 63, n = t >> 6, i = n >> 4, h = n & 15; float o[8];
#pragma unroll
        for (int q = 0; q < 8; ++q) { const int k = k8 * 8 + q; float v;
            if (k < 256) { const int j = k >> 4, hp = k & 15; v = 0.f; if (i >= j) v += KK[(0 * 16 + (i - j)) * 256 + h * 16 + hp]; if (j >= i) v += KK[(1 * 16 + (j - i)) * 256 + h * 16 + hp]; }
            else { const int d = (k - 256) >> 7, r = (k - 256) & 127, p = r >> 1, im = r & 1, pw = d ? 16 - i : i + 1;
                const float cr = CC[((d * 16 + h) * 64 + p) * 2], ci = CC[((d * 16 + h) * 64 + p) * 2 + 1], lr = LP[((d * 17 + pw) * 64 + p) * 2], li = LP[((d * 17 + pw) * 64 + p) * 2 + 1];
                v = im ? -(cr * li + ci * lr) : cr * lr - ci * li; }
            o[q] = v; }
        uint4 w; w.x = pk2(o[0], o[1]); w.y = pk2(o[2], o[3]); w.z = pk2(o[4], o[5]); w.w = pk2(o[6], o[7]);
        *(uint4*)(BY + (size_t)n * 512 + k8 * 8) = w; }
    __syncthreads();
}
struct ProbS5F {
    static constexpr bool HOIST = false, PAIR = false;
    const bf16_t* A; const bf16_t* B; int K; float* F;
    DEVI int nunits() const { return 32 * 9; }
    DEVI void unit(int L, int& z, int& pm, int& pn) const { z = L & 31; pm = L >> 5; pn = 0; }
    DEVI int M(int) const { return 2304; }
    DEVI unsigned aoffb(int z, int r) const { return (unsigned)(z * 2304 + r) * 1024u; }
    DEVI const bf16_t* Bt(int z) const { return B + (size_t)z * 256 * 256; }
    DEVI void store(int z, int r, int c0, const float (&v)[8]) const { float* p = F + ((size_t)z * 2304 + r) * 256 + c0; *(float4*)p = make_float4(v[0], v[1], v[2], v[3]); *(float4*)(p + 4) = make_float4(v[4], v[5], v[6], v[7]); }
};
struct ProbS5Y {
    static constexpr bool HOIST = false, PAIR = false;
    const bf16_t* A; const bf16_t* B; int K; const float* dvec; bf16_t* YS;
    DEVI int nunits() const { return 32 * 8; }
    DEVI void unit(int L, int& z, int& pm, int& pn) const { z = L & 31; pm = L >> 5; pn = 0; }
    DEVI int M(int) const { return 2048; }
    DEVI unsigned aoffb(int z, int r) const { return (unsigned)(z * 2304 + r) * 1024u; }
    DEVI const bf16_t* Bt(int z) const { return B + (size_t)z * 256 * 512; }
    DEVI void store(int z, int r, int c0, const float (&v)[8]) const {
        const int b = r >> 8, sq = ((r & 255) << 4) + (c0 >> 4), gc = sq >> 6, gr = sq & 63, tok = b * SEQ + gr * 64 + gc, ch = z * 16 + (c0 & 15);
        const uint4 uv = *(const uint4*)(A + ((size_t)z * 2304 + r) * 512 + c0); const unsigned uw[4] = {uv.x, uv.y, uv.z, uv.w};
        const float4 d0 = *(const float4*)(dvec + ch), d1 = *(const float4*)(dvec + ch + 4); const float dd[8] = {d0.x, d0.y, d0.z, d0.w, d1.x, d1.y, d1.z, d1.w}; float o[8];
#pragma unroll
        for (int j = 0; j < 4; ++j) { o[2 * j] = gelu_tanh(v[2 * j] + dd[2 * j] * __uint_as_float(uw[j] << 16)); o[2 * j + 1] = gelu_tanh(v[2 * j + 1] + dd[2 * j + 1] * __uint_as_float(uw[j] & 0xffff0000u)); }
        uint4 w; w.x = pk2(o[0], o[1]); w.y = pk2(o[2], o[3]); w.z = pk2(o[4], o[5]); w.w = pk2(o[6], o[7]);
        *(uint4*)(YS + (size_t)tok * 512 + ch) = w;
    }
};
typedef float f32x2_t __attribute__((ext_vector_type(2)));
DEVI int s5_row(int st, int b, int dir) { return st < 16 ? 2048 + b * 16 + (dir ? 15 - st : st) : b * 256 + (dir ? 271 - st : st - 16); }
DEVI void s5_carry(const float* __restrict__ F, bf16_t* __restrict__ U2, const S5P* __restrict__ P, int id, int lane) {
    const int g = id & 31, dir = (id >> 5) & 1, b = id >> 6;
    const float l16r = P->lam16[dir][g][lane][0], l16i = P->lam16[dir][g][lane][1];
    const float* Fg = F + (size_t)g * 2304 * 256 + dir * 128 + 2 * lane;
    bf16_t* Ug = U2 + (size_t)g * 2304 * 512 + 256 + dir * 128 + 2 * lane;
    float hr = 0.f, hi = 0.f;
    f32x2_t b0[17], b1[17], b2[17], b3[17];
#define S5_LOAD(buf, bt) do { _Pragma("unroll") for (int j = 0; j < 17; ++j) buf[j] = *(const f32x2_t*)(Fg + (size_t)s5_row((bt) * 17 + j, b, dir) * 256); } while (0)
#define S5_PROC(buf, bt) do { _Pragma("unroll") for (int j = 0; j < 17; ++j) { const int st = (bt) * 17 + j; \
        if (st >= 16) *(unsigned*)(Ug + (size_t)s5_row(st, b, dir) * 512) = pk2(hr, hi); \
        const float tr = l16r * hr - l16i * hi + buf[j][0], ti = l16r * hi + l16i * hr + buf[j][1]; hr = tr; hi = ti; } } while (0)
    S5_LOAD(b0, 0); S5_LOAD(b1, 1); S5_LOAD(b2, 2);
#pragma unroll 1
    for (int bt = 0; bt < 16; bt += 4) {
        S5_LOAD(b3, bt + 3); S5_PROC(b0, bt);
        if (bt + 4 < 16) S5_LOAD(b0, bt + 4);
        S5_PROC(b1, bt + 1);
        if (bt + 5 < 16) S5_LOAD(b1, bt + 5);
        S5_PROC(b2, bt + 2);
        if (bt + 6 < 16) S5_LOAD(b2, bt + 6);
        S5_PROC(b3, bt + 3);
    }
#undef S5_LOAD
#undef S5_PROC
}
DEVI void ph_scans(const GlaPtrs& G, const float* __restrict__ F, bf16_t* __restrict__ U2, const S5P* __restrict__ P, LAS unsigned char* lds, int blk, bool do_gla, bool do_s5) {
    int tid = threadIdx.x; asm volatile("" : "+v"(tid));
    const int wave = __builtin_amdgcn_readfirstlane(tid >> 6), lane = tid & 63;
    const int chain = blk >> 2;
    if (do_gla) for (int i = tid; i < 68 * 16; i += NTHR) ((LAS f32x4*)lds)[i] = ((const f32x4*)(G.ADEC + (size_t)chain * 68 * 64))[i];
    __syncthreads();
    if (wave < 4) { if (do_gla) {
        const int e = (blk & 3) * 32 + (tid >> 3), d8 = (tid & 7) * 8;
        const bf16_t* up = G.UCH + ((size_t)chain * 68 * 128 + e) * 64 + d8;
        bf16_t* sp = G.SST + ((size_t)chain * 64 * 128 + e) * 64 + d8;
        float S[8];
#pragma unroll
        for (int q = 0; q < 8; ++q) S[q] = 0.f;
        u32x4 cur[17], nxt[17];
#pragma unroll
        for (int j = 0; j < 17; ++j) cur[j] = *(const u32x4*)(up + (size_t)j * 8192);
#pragma unroll 1
        for (int bt = 0; bt < 4; ++bt) {
            if (bt < 3) {
#pragma unroll
                for (int j = 0; j < 17; ++j) nxt[j] = *(const u32x4*)(up + (size_t)((bt + 1) * 17 + j) * 8192); }
#pragma unroll
            for (int j = 0; j < 17; ++j) { const int step = bt * 17 + j;
                if (step >= 4) { u32x4 o; o.x = pk2(S[0], S[1]); o.y = pk2(S[2], S[3]); o.z = pk2(S[4], S[5]); o.w = pk2(S[6], S[7]); *(u32x4*)(sp + (size_t)(step - 4) * 8192) = o; }
                const f32x4 a0 = *(const LAS f32x4*)(lds + (step * 64 + d8) * 4), a1 = *(const LAS f32x4*)(lds + (step * 64 + d8 + 4) * 4);
                const unsigned w0 = cur[j].x, w1 = cur[j].y, w2 = cur[j].z, w3 = cur[j].w;
                S[0] = a0[0] * S[0] + __uint_as_float(w0 << 16); S[1] = a0[1] * S[1] + __uint_as_float(w0 & 0xffff0000u);
                S[2] = a0[2] * S[2] + __uint_as_float(w1 << 16); S[3] = a0[3] * S[3] + __uint_as_float(w1 & 0xffff0000u);
                S[4] = a1[0] * S[4] + __uint_as_float(w2 << 16); S[5] = a1[1] * S[5] + __uint_as_float(w2 & 0xffff0000u);
                S[6] = a1[2] * S[6] + __uint_as_float(w3 << 16); S[7] = a1[3] * S[7] + __uint_as_float(w3 & 0xffff0000u); }
#pragma unroll
            for (int j = 0; j < 17; ++j) cur[j] = nxt[j];
        } } }
    else if (wave < 6) { if (do_s5) s5_carry(F, U2, P, blk * 2 + (wave - 4), lane); }
    __syncthreads();
}


constexpr int NPH = 12;

struct WItem { const float* src; bf16_t* dst; int K, N, c0, n0, k0; bool act; };
constexpr int WC_ITEMS = 18 * 4 + 4 * 2 + 8 * 4 + 32 * 16 * 4 + 32 * 8 * 4;
DEVI WItem wconv_decode(const MArgs& a, unsigned char* ws, int it) {
    constexpr int I0 = 18 * 4, I1 = I0 + 4 * 2, I2 = I1 + 8 * 4, I3 = I2 + 32 * 16 * 4, I4 = I3 + 32 * 8 * 4;
    WItem w; w.src = a.in[7]; w.dst = nullptr; w.K = DM; w.N = INC; w.c0 = 0; w.n0 = 0; w.k0 = 0; w.act = it < I4;
    if (w.act) {
        if (it < I0) { w.src = a.in[7]; w.dst = (bf16_t*)(ws + OFF_WIN); w.K = DM; w.N = INC; w.n0 = (it % 18) * 128; w.k0 = (it / 18) * 256; w.c0 = w.n0; }
        else if (it < I1) { const int r = it - I0; w.src = a.in[19]; w.dst = (bf16_t*)(ws + OFF_WGLU); w.K = 512; w.N = 512; w.n0 = (r % 4) * 128; w.k0 = (r / 4) * 256; w.c0 = w.n0; }
        else if (it < I2) { const int r = it - I1; w.src = a.in[21]; w.dst = (bf16_t*)(ws + OFF_WOUT); w.K = DM; w.N = DM; w.n0 = (r % 8) * 128; w.k0 = (r / 8) * 256; w.c0 = w.n0; }
        else if (it < I3) { const int r = it - I2, e = r / 64, q = r % 64; w.src = a.in[25] + (size_t)e * DM * 2048; w.dst = (bf16_t*)(ws + OFF_WG) + (size_t)e * 2048 * DM; w.K = DM; w.N = 2048;
            w.n0 = (q % 16) * 128; w.k0 = (q / 16) * 256; w.c0 = wsrc_col<1>(w.n0); }
        else { const int r = it - I3, e = r / 32, q = r % 32; w.src = a.in[27] + (size_t)e * DFF * DM; w.dst = (bf16_t*)(ws + OFF_WD) + (size_t)e * DM * DFF; w.K = DFF; w.N = DM; w.n0 = (q % 8) * 128; w.k0 = (q / 8) * 256; w.c0 = w.n0; }
    }
    return w;
}
DEVI void wconv_load(const WItem& w, int tid, f32x4 (&r)[16]) {
    const int l32 = tid & 31, kr = tid >> 5, col = w.c0 + 4 * l32; const bool ok = col < w.N; const int cc = ok ? col : 0;
    const float* p = w.src + (size_t)(w.k0 + kr) * w.N + cc; const size_t st = (size_t)16 * w.N;
#pragma unroll
    for (int i = 0; i < 16; ++i) r[i] = *(const f32x4*)(p + i * st);
}
DEVI void wconv_store(const WItem& cur, LAS unsigned char* lds, int tid, const f32x4 (&rc)[16]) {
    constexpr int TS = 264;
    const int l32 = tid & 31, kr = tid >> 5;
    const float okf = (cur.c0 + 4 * l32 < cur.N) ? 1.f : 0.f;
    const int sw = ((l32 >> 1) & 15) << 1;
#pragma unroll
    for (int i = 0; i < 16; ++i) { const int k = (kr + 16 * i) ^ sw;
#pragma unroll
        for (int c = 0; c < 4; ++c) *(LAS bf16_t*)(lds + ((4 * l32 + c) * TS + k) * 2) = f2bf(rc[i][c] * okf); }
    __syncthreads();
    if (cur.act) {
#pragma unroll
        for (int i = 0; i < 8; ++i) { const int ch = tid + NTHR * i, n = ch >> 5, c8 = ch & 31, sn = ((n >> 3) & 15) << 1, m = (sn >> 1) & 3;
            const u32x4 v = *(const LAS u32x4*)(lds + (n * TS + ((c8 ^ (sn >> 3)) * 8)) * 2);
            u32x4 o; o.x = (m & 1) ? v.y : v.x; o.y = (m & 1) ? v.x : v.y; o.z = (m & 1) ? v.w : v.z; o.w = (m & 1) ? v.z : v.w;
            if (m & 2) { const unsigned t0 = o.x, t1 = o.y; o.x = o.z; o.y = o.w; o.z = t0; o.w = t1; }
            *(u32x4*)(cur.dst + (size_t)(cur.n0 + n) * cur.K + cur.k0 + c8 * 8) = o; } }
    __syncthreads();
}
DEVI void ph_prep(const MArgs& a, LAS unsigned char* lds, int bid, int G) {
    const int tid = threadIdx.x, wave = tid >> 6, lane = tid & 63;
    unsigned char* ws = a.ws;
    const bool big = G > 136; const int nsp = big ? 32 : G;
    const bool special = !big || (bid >= 104 && bid < 136); const int sid = big ? bid - 104 : bid;
    if (special) {
        for (int i = sid * NTHR + tid; i < 2 * 32 * 64; i += nsp * NTHR) s5prep_one(a.in[11], a.in[12], a.in[13], a.in[14], a.in[15], (S5P*)(ws + OFF_S5P), i);
        for (int g = sid; g < 32; g += nsp) { MArgs_in in{a.in[11], a.in[12], a.in[13], a.in[14], a.in[15], a.in[16], a.in[17]}; s5w_build(in, ws, lds, g); }
    }
    { LAS float* s = (LAS float*)lds; LAS float* part = (LAS float*)(lds + 36864);
      const float* c = a.in[1]; const float* cc = a.in[3]; const float* ada_w = a.in[4]; float* MP = (float*)(ws + OFF_SST);
      typedef float f32x2 __attribute__((ext_vector_type(2)));
      bool have_s = false;
      for (int mi = bid; mi < 256; mi += G) {
          if (!have_s) { for (int i = tid; i < 9216; i += NTHR) { const int r = i >> 10, k = i & 1023; const float v = r < 8 ? c[r * 1024 + k] : cc[k]; s[i] = siluf_(v); } have_s = true; __syncthreads(); }
          const int ks = mi >> 4, cs = mi & 15, k0 = ks * 64 + wave * 8;
          f32x2 wv[3][8];
#pragma unroll
          for (int ps = 0; ps < 3; ++ps)
#pragma unroll
              for (int q = 0; q < 8; ++q) wv[ps][q] = *(const f32x2*)(ada_w + (size_t)(k0 + q) * 6144 + cs * 384 + ps * 128 + lane * 2);
#pragma unroll
          for (int ps = 0; ps < 3; ++ps) { float acc[9][2];
#pragma unroll
              for (int r = 0; r < 9; ++r) { acc[r][0] = 0.f; acc[r][1] = 0.f; }
#pragma unroll
              for (int q = 0; q < 8; ++q) {
#pragma unroll
                  for (int r = 0; r < 9; ++r) { const float sv = s[r * 1024 + k0 + q]; acc[r][0] += sv * wv[ps][q][0]; acc[r][1] += sv * wv[ps][q][1]; } }
#pragma unroll
              for (int r = 0; r < 9; ++r) { part[(wave * 9 + r) * 128 + lane * 2] = acc[r][0]; part[(wave * 9 + r) * 128 + lane * 2 + 1] = acc[r][1]; }
              __syncthreads();
              for (int i = tid; i < 9 * 128; i += NTHR) { const int r = i >> 7, l = i & 127; float sum = 0.f;
#pragma unroll
                  for (int w = 0; w < 8; ++w) sum += part[(w * 9 + r) * 128 + l];
                  MP[((size_t)ks * 9 + r) * 6144 + cs * 384 + ps * 128 + l] = sum; }
              __syncthreads(); }
          asm volatile("s_waitcnt vmcnt(0)" ::: "memory");
          __syncthreads();
          volatile LAS int* lastf = (volatile LAS int*)(lds + MISC_OFF + 248);
          if (tid == 0) { __builtin_amdgcn_fence(__ATOMIC_RELEASE, "agent"); asm volatile("s_waitcnt vmcnt(0)" ::: "memory");
              const unsigned old = __hip_atomic_fetch_add((unsigned*)(ws + OFF_CTL) + CW_MODC + cs, 1u, __ATOMIC_RELAXED, __HIP_MEMORY_SCOPE_AGENT);
              lastf[0] = (old == 15u) ? 1 : 0;
              if (old == 15u) { __builtin_amdgcn_fence(__ATOMIC_ACQUIRE, "agent"); asm volatile("s_waitcnt vmcnt(0)" ::: "memory"); } }
          __syncthreads();
          if (lastf[0]) { const float* ada_b = a.in[5]; float* mod = (float*)(ws + OFF_MOD);
              for (int i = tid; i < 9 * 384; i += NTHR) { const int r = i / 384, col = cs * 384 + i % 384; float sum = ada_b[col];
#pragma unroll
                  for (int k2 = 0; k2 < 16; ++k2) sum += __hip_atomic_load(MP + ((size_t)k2 * 9 + r) * 6144 + col, __ATOMIC_RELAXED, __HIP_MEMORY_SCOPE_AGENT);
                  mod[r * 6144 + col] = sum; } }
          __syncthreads();
      } }
    { unsigned* ctr = (unsigned*)(ws + OFF_CTL) + CW_WQ; volatile LAS int* q = (volatile LAS int*)(lds + MISC_OFF + 240);
      __syncthreads();
      if (tid == 0) { q[0] = (int)atomicAdd(ctr, 1u); q[1] = (int)atomicAdd(ctr, 1u); }
      __syncthreads();
      int ia = q[0], ib = q[1];
      f32x4 ra[16], rb[16];
      WItem wa = wconv_decode(a, ws, ia); wconv_load(wa, tid, ra);
      while (ia < WC_ITEMS) {
          const WItem wb = wconv_decode(a, ws, ib); wconv_load(wb, tid, rb);
          if (tid == 0) q[0] = (int)atomicAdd(ctr, 1u);
          wconv_store(wa, lds, tid, ra);
          ia = q[0];
          wa = wconv_decode(a, ws, ia); wconv_load(wa, tid, ra);
          if (tid == 0) q[1] = (int)atomicAdd(ctr, 1u);
          wconv_store(wb, lds, tid, rb);
          ib = q[1];
      } }
}


DEVI void ph_router(const float* __restrict__ X, const float* __restrict__ OUTB, const float* __restrict__ w, const float* __restrict__ mod, const float* __restrict__ rw, const float* __restrict__ rb,
                    bf16_t* __restrict__ H2, int* __restrict__ cnt, int* __restrict__ list, float* __restrict__ gate, int* __restrict__ epos, LAS unsigned char* lds, int bid, int G, bool commit) {
    int tid = threadIdx.x; asm volatile("" : "+v"(tid));
    const int wave = __builtin_amdgcn_readfirstlane(tid >> 6), lane = tid & 63, e16 = lane & 15, kq = lane >> 4;
    constexpr int HS = 1028;
    LAS float* hrow = (LAS float*)lds;
    LAS float* part = (LAS float*)(lds + 16 * HS * 4);
    LAS int* lcnt = (LAS int*)(lds + 16 * HS * 4 + 16384);
    LAS int* gbase = lcnt + 32; LAS int* ent = lcnt + 64;
    if (tid < 64) lcnt[tid] = 0;
    float wreg[2][32];
#pragma unroll
    for (int et = 0; et < 2; ++et)
#pragma unroll
        for (int q = 0; q < 32; ++q) wreg[et][q] = rw[(wave * 128 + kq * 32 + q) * 32 + et * 16 + e16];
    const float rbe = rb[lane & 31];
    const int per = (NTOK + G - 1) / G;
    const int t0 = bid * per, t1 = (t0 + per) < NTOK ? (t0 + per) : NTOK;
    const bool onebatch = (SEQ % per) == 0; const int b0 = t0 / SEQ;
    float4 cw[4], csc[4], csh[4], cg1[4];
#pragma unroll
    for (int j = 0; j < 4; ++j) { const int k = lane * 4 + 256 * j; cw[j] = *(const float4*)(w + k); csc[j] = *(const float4*)(mod + b0 * 6144 + 4096 + k); csh[j] = *(const float4*)(mod + b0 * 6144 + 3072 + k); cg1[j] = *(const float4*)(mod + b0 * 6144 + 2048 + k); }
    float4 v[2][4]; uint2 mx[2][4];
#pragma unroll
    for (int u = 0; u < 2; ++u) { const int tok = t0 + wave * 2 + u; if (tok < t1) {
#pragma unroll
        for (int j = 0; j < 4; ++j) { v[u][j] = *(const float4*)(X + (size_t)tok * DM + lane * 4 + 256 * j); mx[u][j] = *(const uint2*)((const bf16_t*)(OUTB + (size_t)tok * DM) + DM + lane * 4 + 256 * j); } } }
    for (int tb = t0; tb < t1; tb += 16) {
#pragma unroll
        for (int u = 0; u < 2; ++u) { const int tok = tb + wave * 2 + u;
            if (tok < t1) {
                const int b = tok / SEQ; float ss = 0.f; const float* g1p = mod + b * 6144 + 2048;
#pragma unroll
                for (int j = 0; j < 4; ++j) { const float4 g1 = onebatch ? cg1[j] : *(const float4*)(g1p + lane * 4 + 256 * j);
                    v[u][j].x += g1.x * __uint_as_float(mx[u][j].x << 16); v[u][j].y += g1.y * __uint_as_float(mx[u][j].x & 0xffff0000u);
                    v[u][j].z += g1.z * __uint_as_float(mx[u][j].y << 16); v[u][j].w += g1.w * __uint_as_float(mx[u][j].y & 0xffff0000u);
                    ss += v[u][j].x * v[u][j].x + v[u][j].y * v[u][j].y + v[u][j].z * v[u][j].z + v[u][j].w * v[u][j].w; }
                const float rstd = rsqrtf(wave_sum(ss) * (1.f / DM) + 1e-6f);
                const float* msh = mod + b * 6144 + 3072; const float* msc = mod + b * 6144 + 4096;
#pragma unroll
                for (int j = 0; j < 4; ++j) { const int k = lane * 4 + 256 * j;
                    const float4 ww = cw[j], sc = onebatch ? csc[j] : *(const float4*)(msc + k), sh = onebatch ? csh[j] : *(const float4*)(msh + k);
                    f32x4 hv; hv[0] = v[u][j].x * rstd * ww.x * (1.f + sc.x) + sh.x; hv[1] = v[u][j].y * rstd * ww.y * (1.f + sc.y) + sh.y; hv[2] = v[u][j].z * rstd * ww.z * (1.f + sc.z) + sh.z; hv[3] = v[u][j].w * rstd * ww.w * (1.f + sc.w) + sh.w;
                    *(LAS f32x4*)(hrow + (wave * 2 + u) * HS + k) = hv;
                    uint2 o; o.x = pk2(hv[0], hv[1]); o.y = pk2(hv[2], hv[3]); *(uint2*)(H2 + (size_t)tok * DM + k) = o; }
            } else {
#pragma unroll
                for (int j = 0; j < 4; ++j) *(LAS f32x4*)(hrow + (wave * 2 + u) * HS + lane * 4 + 256 * j) = (f32x4){0.f, 0.f, 0.f, 0.f}; }
        }
#pragma unroll
        for (int u = 0; u < 2; ++u) { const int ntok = tb + 16 + wave * 2 + u; if (ntok < t1) {
#pragma unroll
            for (int j = 0; j < 4; ++j) { v[u][j] = *(const float4*)(X + (size_t)ntok * DM + lane * 4 + 256 * j); mx[u][j] = *(const uint2*)((const bf16_t*)(OUTB + (size_t)ntok * DM) + DM + lane * 4 + 256 * j); } } }
        __syncthreads();
        f32x4 acc0 = (f32x4){0.f, 0.f, 0.f, 0.f}, acc1 = (f32x4){0.f, 0.f, 0.f, 0.f};
#pragma unroll
        for (int i = 0; i < 8; ++i) { const f32x4 ar = *(const LAS f32x4*)(hrow + e16 * HS + wave * 128 + kq * 32 + 4 * i);
#pragma unroll
            for (int c = 0; c < 4; ++c) { acc0 = __builtin_amdgcn_mfma_f32_16x16x4f32(ar[c], wreg[0][4 * i + c], acc0, 0, 0, 0); acc1 = __builtin_amdgcn_mfma_f32_16x16x4f32(ar[c], wreg[1][4 * i + c], acc1, 0, 0, 0); } }
#pragma unroll
        for (int rg = 0; rg < 4; ++rg) { part[((wave * 2 + 0) * 16 + 4 * kq + rg) * 16 + e16] = acc0[rg]; part[((wave * 2 + 1) * 16 + 4 * kq + rg) * 16 + e16] = acc1[rg]; }
        __syncthreads();
        {
            const int t = wave * 2 + (lane >> 5), tk = tb + t, e = lane & 31, et = e >> 4, ee = e & 15;
            float lg = rbe;
#pragma unroll
            for (int q = 0; q < 8; ++q) lg += part[((q * 2 + et) * 16 + t) * 16 + ee];
            float val = lg; float tv[4]; int ti[4];
#pragma unroll
            for (int r = 0; r < 4; ++r) { float bv = val; int bi = e;
#pragma unroll
                for (int o = 1; o < 32; o <<= 1) { const float ov = __shfl_xor(bv, o); const int oi = __shfl_xor(bi, o); if (ov > bv || (ov == bv && oi < bi)) { bv = ov; bi = oi; } }
                tv[r] = bv; ti[r] = bi; if (e == bi) val = -3.0e38f; }
            const float e1 = __expf(tv[1] - tv[0]), e2 = __expf(tv[2] - tv[0]), e3 = __expf(tv[3] - tv[0]), inv = 1.f / (1.f + e1 + e2 + e3);
            if (e < 4 && tk < t1 && commit) { const float gv = e == 0 ? inv : e == 1 ? e1 * inv : e == 2 ? e2 * inv : e3 * inv; const int ex = e == 0 ? ti[0] : e == 1 ? ti[1] : e == 2 ? ti[2] : ti[3];
                const int ls = __hip_atomic_fetch_add(&lcnt[ex], 1, __ATOMIC_RELAXED, __HIP_MEMORY_SCOPE_WORKGROUP); ent[(tk - t0) * 4 + e] = (ex << 16) | ls; gate[tk * 4 + e] = gv; }
        }
    }
    __syncthreads();
    if (commit) {
        if (tid < NEXP) { const int c = lcnt[tid]; gbase[tid] = c ? atomicAdd(&cnt[tid], c) : 0; }
        __syncthreads();
        for (int i = tid; i < (t1 - t0) * 4; i += NTHR) { const int en = ent[i], ex = en >> 16, slot = gbase[ex] + (en & 0xffff), tk4 = t0 * 4 + i;
            list[ex * LISTCAP + slot] = tk4; epos[tk4] = ex * LISTCAP + slot; }
    }
    __syncthreads();
}

DEVI void build_ub(const int* cnt, volatile LAS int* ub) {
    if (threadIdx.x == 0) { int o = 0; for (int e = 0; e < NEXP; ++e) { ub[e] = o; o += (cnt[e] + 255) >> 8; } ub[NEXP] = o; }
    __syncthreads();
}

__global__ void __launch_bounds__(NTHR, 2) mega(MArgs a) {
    extern __shared__ __attribute__((aligned(16))) unsigned char lds_raw[];
    LAS unsigned char* lds = (LAS unsigned char*)lds_raw;
    volatile LAS unsigned* MISC = (volatile LAS unsigned*)(lds + MISC_OFF);
    const int tid = threadIdx.x, wave = __builtin_amdgcn_readfirstlane(tid >> 6), G = gridDim.x, bid = blockIdx.x;
    const int gw = bid * NWAVES + wave, NGW = G * NWAVES;
    for (int u = tid; u < MISC_BYTES / 4; u += NTHR) MISC[u] = 0u;
    __syncthreads();
    unsigned char* ws = a.ws; unsigned* ctl = (unsigned*)(ws + OFF_CTL);
    const bool multi = (a.ph_hi - a.ph_lo) > 1;
    XcdBarrier bar; bar.bar = ctl + CW_BAR; bar.x = 0; bar.st = MISC;
    if (multi) bar = xcd_barrier_post(ctl + CW_BAR, MISC);
    volatile LAS int* ub = (volatile LAS int*)(MISC + 16);
#ifndef PROBE_REP
#define PROBE_REP 0
#endif
#define IN(k) (a.ph_lo <= (k) && (k) < a.ph_hi)
#define NREP(k) (1 + ((PROBE_REP >> (k)) & 1))
#ifndef PROBE_VPH
#define PROBE_VPH -1
#endif
#ifndef PROBE_VMODE
#define PROBE_VMODE 1
#endif
#define FRESH_LANE int ft_ = threadIdx.x; asm volatile("" : "+v"(ft_)); const int lane = ft_ & 63; (void)lane
#ifndef PROBE_TK
#define PROBE_TK -1
#endif
    unsigned long long tstamp_prev = 0ull, tstamp_sel = 0ull;
    if (PROBE_TK >= 0) tstamp_prev = __builtin_amdgcn_s_memrealtime();
#define SEAM(k) do { if (IN(k) && IN((k) + 1)) xcd_barrier(bar); if (PROBE_TK >= 0) { const unsigned long long tn_ = __builtin_amdgcn_s_memrealtime(); if ((k) == PROBE_TK) tstamp_sel = tn_ - tstamp_prev; tstamp_prev = tn_; } } while (0)
    float* mod = (float*)(ws + OFF_MOD); S5P* s5p = (S5P*)(ws + OFF_S5P); float* gate = (float*)(ws + OFF_GATE); int* list = (int*)(ws + OFF_LIST);
    bf16_t* WIN = (bf16_t*)(ws + OFF_WIN); bf16_t* WGLU = (bf16_t*)(ws + OFF_WGLU); bf16_t* WOUT = (bf16_t*)(ws + OFF_WOUT); bf16_t* WG = (bf16_t*)(ws + OFF_WG); bf16_t* WD = (bf16_t*)(ws + OFF_WD);
    bf16_t* H = (bf16_t*)(ws + OFF_H); bf16_t* QK = (bf16_t*)(ws + OFF_QK); bf16_t* V = (bf16_t*)(ws + OFF_V); bf16_t* R = (bf16_t*)(ws + OFF_R); bf16_t* UT = (bf16_t*)(ws + OFF_UT);
    float* LR = (float*)(ws + OFF_LR); bf16_t* U2 = (bf16_t*)(ws + OFF_U2);
    bf16_t* YS = (bf16_t*)(ws + OFF_YS); bf16_t* MIX = (bf16_t*)(ws + OFF_MIX); bf16_t* ACT = (bf16_t*)(ws + OFF_ACT); bf16_t* YSL = (bf16_t*)(ws + OFF_YSL);
    int* cnt = (int*)(ctl + CW_CNT);

    if (IN(0)) for (int rp = 0; rp < NREP(0); ++rp) ph_prep(a, lds, bid, G);
    SEAM(0);
    if (IN(1)) for (int rp = 0; rp < NREP(1); ++rp) { FRESH_LANE; for (int row = gw; row < NROWS; row += NGW) norm_row(a.in[0], a.in[2], a.in[6], mod, H, row, lane, 0, 1024); }
    SEAM(1);
    if (IN(2) && PROBE_VPH == 2) { ProbIn P{H, DM, WIN, DM, DM, QK, V, R, UT, U2, LR}; gemm_phase<PROBE_VMODE>(lds, P, G, bid); }
    if (IN(2)) for (int rp = 0; rp < NREP(2); ++rp) { ProbIn P{H, DM, WIN, DM, DM, QK, V, R, UT, U2, LR}; gemm_phase(lds, P, G, bid); }
    SEAM(2);
    float* Fb = (float*)(ws + OFF_F); bf16_t* S5BF = (bf16_t*)(ws + OFF_S5BF); bf16_t* S5BY = (bf16_t*)(ws + OFF_S5BY);
    const GlaPtrs GP{QK, V, R, LR, a.in[8], a.in[9], a.in[10], (bf16_t*)(ws + OFF_UCH), (float*)(ws + OFF_ADEC), (bf16_t*)(ws + OFF_SST), MIX, (bf16_t*)(ws + OFF_GLT)};
    if (IN(3)) for (int rp = 0; rp < NREP(3); ++rp) {
        for (int r2 = 0; r2 < NREP(12); ++r2) { ProbS5F P{U2, S5BF, 256, Fb}; gemm_phase(lds, P, G, bid); }
        for (int r2 = 0; r2 < NREP(13); ++r2) gla_a_phase(GP, lds, bid, G);
    }
    SEAM(3);
    if (IN(4)) for (int rp = 0; rp < NREP(4); ++rp) {
        for (int blk = bid; blk < 256; blk += G) ph_scans(GP, Fb, U2, s5p, lds, blk, NREP(16) > 0, true);
    }
    SEAM(4);
    if (IN(5)) for (int rp = 0; rp < NREP(5); ++rp) {
        for (int r2 = 0; r2 < NREP(14); ++r2) { ProbS5Y P{U2, S5BY, 512, a.in[18], YS}; gemm_phase(lds, P, G, bid); }
        for (int r2 = 0; r2 < NREP(15); ++r2) gla_c_phase(GP, lds, bid, G);
    }
    SEAM(5);
    if (IN(6)) for (int rp = 0; rp < NREP(6); ++rp) { ProbGlu P{YS, 512, WGLU, 512, 512, a.in[20], MIX}; gemm_phase(lds, P, G, bid); }
    SEAM(6);
    if (IN(7)) for (int rp = 0; rp < NREP(7); ++rp) { ProbOut P{MIX, DM, WOUT, DM, DM, a.in[0], mod, a.out}; gemm_phase(lds, P, G, bid); }
    SEAM(7);
    if (IN(8)) for (int rp = NREP(8) - 1; rp >= 0; --rp) ph_router(a.in[0], a.out, a.in[22], mod, a.in[23], a.in[24], H, cnt, list, gate, (int*)(ws + OFF_EPOS), lds, bid, G, rp == 0);
    SEAM(8);
    if (IN(9) && PROBE_VPH == 9) { build_ub(cnt, ub); FMoe1 P{H, WG, DM, cnt, list, a.in[26], ACT, (const LAS int*)ub, G}; gemm_phase<PROBE_VMODE>(lds, P, G, bid); }
    if (IN(9)) for (int rp = 0; rp < NREP(9); ++rp) { build_ub(cnt, ub); FMoe1 P{H, WG, DM, cnt, list, a.in[26], ACT, (const LAS int*)ub, G}; gemm_phase(lds, P, G, bid); }
    SEAM(9);
    if (IN(10) && PROBE_VPH == 10) { build_ub(cnt, ub); FMoe2 P{ACT, WD, DFF, cnt, a.in[28], YSL, (const LAS int*)ub, G}; gemm_phase<PROBE_VMODE>(lds, P, G, bid); }
    if (IN(10)) for (int rp = 0; rp < NREP(10); ++rp) { build_ub(cnt, ub); FMoe2 P{ACT, WD, DFF, cnt, a.in[28], YSL, (const LAS int*)ub, G}; gemm_phase(lds, P, G, bid); }
    SEAM(10);
    if (IN(11)) { build_ub(cnt, ub); for (int rp = NREP(11) - 1; rp >= 0; --rp) { FRESH_LANE; for (int tok = gw; tok < NTOK; tok += NGW) final_row(a.in[0], a.out, YSL, mod, a.in[29], gate, (const int*)(ws + OFF_EPOS), (const LAS int*)ub, tok, lane, rp ? (float*)(ws + OFF_WG) : nullptr); } }
    if (PROBE_TK >= 0) { if (PROBE_TK == 11) tstamp_sel = __builtin_amdgcn_s_memrealtime() - tstamp_prev;
        if (bid == 0) { const unsigned long long t0_ = __builtin_amdgcn_s_memrealtime(); while (__builtin_amdgcn_s_memrealtime() - t0_ < 4ull * tstamp_sel) __builtin_amdgcn_s_sleep(8); } }
#undef IN
#undef SEAM
}

#ifndef MEGA_SINGLE
#define MEGA_SINGLE 1
#endif
extern "C" void kernel_launch(void* const* d_in, const int* in_sizes, int n_in, void* d_out, int out_size, void* d_ws, size_t ws_size, hipStream_t stream) {
    static int grid = 0;
    if (grid == 0) {
        if (ws_size < WS_NEED || n_in != 30) { fprintf(stderr, "kernel_launch: workspace too small (%zu < %zu) or n_in %d != 30\n", ws_size, (size_t)WS_NEED, n_in); grid = -1; return; }
        int dev = 0, cus = 0, per_cu = 0;
        if (hipGetDevice(&dev) != hipSuccess || hipDeviceGetAttribute(&cus, hipDeviceAttributeMultiprocessorCount, dev) != hipSuccess) { grid = -1; return; }
        if (hipFuncSetAttribute((const void*)mega, hipFuncAttributeMaxDynamicSharedMemorySize, LDS_BYTES) != hipSuccess) { fprintf(stderr, "kernel_launch: hipFuncSetAttribute failed\n"); grid = -1; return; }
        if (hipOccupancyMaxActiveBlocksPerMultiprocessor(&per_cu, (const void*)mega, NTHR, LDS_BYTES) != hipSuccess || per_cu < 1) { fprintf(stderr, "kernel_launch: occupancy query says %d blocks per CU\n", per_cu); per_cu = 1; }
        (void)hipGetLastError();
        grid = cus;
    }
    if (grid < 0) return;
    (void)hipMemsetAsync((char*)d_ws + OFF_CTL, 0, 64 * 1024, stream);
    MArgs a{};
    for (int i = 0; i < 30; ++i) a.in[i] = (const float*)d_in[i];
    a.out = (float*)d_out; a.ws = (unsigned char*)d_ws;
#if MEGA_SINGLE
    a.ph_lo = 0; a.ph_hi = NPH;
    { void* args[] = {&a}; hipError_t e = hipLaunchCooperativeKernel((const void*)mega, dim3(grid), dim3(NTHR), args, LDS_BYTES, stream);
      if (e != hipSuccess) fprintf(stderr, "kernel_launch: cooperative launch failed: %s (grid %d)\n", hipGetErrorString(e), grid); }
#else
    for (int p = 0; p < NPH; ++p) { a.ph_lo = p; a.ph_hi = p + 1; hipLaunchKernelGGL(mega, dim3(grid), dim3(NTHR), LDS_BYTES, stream, a); }
#endif
}
```

```cpp
#include <hip/hip_runtime.h>
#include <stdint.h>
#include <stdio.h>

typedef unsigned short bf16_t;
#define DEVI __device__ __forceinline__
#define LAS __attribute__((address_space(3)))

constexpr int NB = 8, SEQ = 4096, DM = 1024, CTX = 256;
constexpr int NTOK = NB * SEQ;
constexpr int NCTX = NB * CTX;
constexpr int NROWS = NTOK + NCTX;
constexpr int INC = 2080, INP = 2304;
constexpr int NEXP = 32, TOPK = 4, DFF = 1024;
constexpr int LISTCAP = NTOK;
constexpr int MOEPAD = 256;

constexpr size_t MiB = 1024ull * 1024ull;
constexpr size_t OFF_CTL = 0;
constexpr size_t OFF_MOD = 64 * 1024;
constexpr size_t OFF_S5P = OFF_MOD + 256 * 1024;
constexpr size_t OFF_GATE = OFF_S5P + 1 * MiB;
constexpr size_t OFF_EPOS = OFF_GATE + 512 * 1024;
constexpr size_t OFF_LIST = OFF_EPOS + 512 * 1024;
constexpr size_t OFF_WIN = OFF_LIST + 4 * MiB;
constexpr size_t OFF_WGLU = OFF_WIN + (size_t)INP * DM * 2;
constexpr size_t OFF_WOUT = OFF_WGLU + 512 * 512 * 2;
constexpr size_t OFF_WG = OFF_WOUT + (size_t)DM * DM * 2;
constexpr size_t OFF_WD = OFF_WG + (size_t)NEXP * 2048 * DM * 2;
constexpr size_t OFF_S5BF = OFF_WD + (size_t)NEXP * DM * DFF * 2;
constexpr size_t OFF_S5BY = OFF_S5BF + (size_t)32 * 256 * 256 * 2;
constexpr size_t OFF_H = OFF_S5BY + (size_t)32 * 256 * 512 * 2;
constexpr size_t OFF_RA = OFF_H + (size_t)NROWS * DM * 2;
constexpr size_t OFF_QK = OFF_RA;
constexpr size_t OFF_V = OFF_QK + (size_t)NROWS * 512 * 2;
constexpr size_t OFF_R = OFF_V + (size_t)NROWS * 512 * 2;
constexpr size_t OFF_UT = OFF_R + (size_t)NROWS * 512 * 2;
constexpr size_t OFF_LR = OFF_UT + (size_t)NROWS * 512 * 2;
constexpr size_t OFF_U2 = OFF_LR + (size_t)NROWS * 32 * 4;
constexpr size_t OFF_YS = OFF_U2 + (size_t)32 * 2304 * 512 * 2;
constexpr size_t OFF_MIX = OFF_YS + (size_t)NTOK * 512 * 2;
constexpr size_t OFF_F = OFF_MIX + (size_t)NTOK * DM * 2;
constexpr size_t OFF_UCH = OFF_F + (size_t)32 * 2304 * 256 * 4;
constexpr size_t OFF_ADEC = OFF_UCH + (size_t)64 * 68 * 8192 * 2;
constexpr size_t OFF_SST = OFF_ADEC + (size_t)64 * 68 * 64 * 4;
constexpr size_t OFF_GLT = OFF_SST + (size_t)64 * 64 * 8192 * 2;
constexpr size_t OFF_RA_END = OFF_GLT + (size_t)2048 * 4 * 4096 * 2;
constexpr int ACT_ROWS = NTOK * TOPK + NEXP * MOEPAD;
constexpr size_t OFF_ACT = OFF_RA;
constexpr size_t OFF_YSL = OFF_ACT + (size_t)ACT_ROWS * DFF * 2;
constexpr size_t OFF_END2 = OFF_YSL + (size_t)ACT_ROWS * DM * 2;
constexpr size_t WS_NEED = OFF_RA_END > OFF_END2 ? OFF_RA_END : OFF_END2;
static_assert(WS_NEED <= 1024 * MiB, "workspace map exceeds 1 GiB");

constexpr int CW_CNT = 1024;
constexpr int CW_OFFS = 1088;
constexpr int CW_WQ = 1200;
constexpr int CW_MODC = 1216;
constexpr int CW_GAQ = 1240;

DEVI float bf2f(bf16_t b) { return __uint_as_float(((unsigned)b) << 16); }
DEVI bf16_t f2bf(float f) { unsigned u = __float_as_uint(f); u += 0x7fffu + ((u >> 16) & 1u); return (bf16_t)(u >> 16); }
DEVI unsigned pk2(float lo, float hi) { unsigned r; asm("v_cvt_pk_bf16_f32 %0, %1, %2" : "=v"(r) : "v"(lo), "v"(hi)); return r; }
DEVI float wave_sum(float v) {
#pragma unroll
    for (int o = 1; o < 64; o <<= 1) v += __shfl_xor(v, o);
    return v;
}
DEVI float sigmoidf_(float x) { return 1.f / (1.f + __expf(-x)); }
DEVI float siluf_(float x) { return x / (1.f + __expf(-x)); }
DEVI float logsigmoidf_(float g) { return fminf(g, 0.f) - __logf(1.f + __expf(-fabsf(g))); }
DEVI float gelu_tanh(float x) { const float u = 0.7978845608028654f * (x + 0.044715f * x * x * x); return x / (1.f + __expf(-2.f * u)); }

__global__ __launch_bounds__(256) void k_mod(const float* __restrict__ c, const float* __restrict__ c_ctx, const float* __restrict__ ada_w,
                                             const float* __restrict__ ada_b, float* __restrict__ mod) {
    __shared__ float s[9][1024];
    for (int i = threadIdx.x; i < 9 * 1024; i += 256) { const int r = i >> 10, k = i & 1023; const float v = r < 8 ? c[r * 1024 + k] : c_ctx[k]; s[r][k] = siluf_(v); }
    __syncthreads();
    const int j = blockIdx.x * 256 + threadIdx.x;
    float acc[9];
#pragma unroll
    for (int r = 0; r < 9; ++r) acc[r] = 0.f;
    for (int k = 0; k < 1024; ++k) { const float w = ada_w[(size_t)k * 6144 + j];
#pragma unroll
        for (int r = 0; r < 9; ++r) acc[r] += s[r][k] * w; }
    const float bb = ada_b[j];
#pragma unroll
    for (int r = 0; r < 9; ++r) mod[r * 6144 + j] = acc[r] + bb;
}

template <int MODE> DEVI int wsrc_col(int nd) { if (MODE == 1) { return ((nd >> 7) & 1) * 1024 + (nd >> 8) * 128 + (nd & 127); } return nd; }
template <int MODE> __global__ __launch_bounds__(256) void k_wconv(const float* __restrict__ src, bf16_t* __restrict__ dst, int K, int N, int Nd) {
    __shared__ float t[64][65];
    const int e = blockIdx.z; src += (size_t)e * K * N; dst += (size_t)e * Nd * K;
    const int n0 = blockIdx.x * 64, k0 = blockIdx.y * 64, tid = threadIdx.x, nl = tid & 63, kq = tid >> 6;
    const int nd = n0 + nl, sc = wsrc_col<MODE>(nd); const bool valid = sc < N;
#pragma unroll 4
    for (int i = 0; i < 16; ++i) { const int kk = kq + 4 * i; t[kk][nl] = valid ? src[(size_t)(k0 + kk) * N + sc] : 0.f; }
    __syncthreads();
#pragma unroll
    for (int i = 0; i < 2; ++i) { const int ch = tid + 256 * i, n = ch >> 3, c8 = ch & 7;
        uint4 o; o.x = pk2(t[c8 * 8 + 0][n], t[c8 * 8 + 1][n]); o.y = pk2(t[c8 * 8 + 2][n], t[c8 * 8 + 3][n]); o.z = pk2(t[c8 * 8 + 4][n], t[c8 * 8 + 5][n]); o.w = pk2(t[c8 * 8 + 6][n], t[c8 * 8 + 7][n]);
        *(uint4*)(dst + (size_t)(n0 + n) * K + k0 + c8 * 8) = o; }
}

struct S5P { float lamb[2][32][64][2]; float bbar[2][32][64][16][2]; float lam16[2][32][64][2]; };
DEVI void s5prep_one(const float* lam_re, const float* lam_im, const float* log_dt, const float* b_re, const float* b_im, S5P* P, int i) {
    const int p = i & 63, g = (i >> 6) & 31, d = i >> 11;
    const double dt = exp((double)log_dt[d * 32 + g]);
    const double lr = lam_re[i], li = lam_im[i];
    const double mag = exp(lr * dt), ar = mag * cos(li * dt), ai = mag * sin(li * dt);
    const double nr = ar - 1.0, ni = ai, den = lr * lr + li * li;
    const double cr = (nr * lr + ni * li) / den, ci = (ni * lr - nr * li) / den;
    P->lamb[d][g][p][0] = (float)ar; P->lamb[d][g][p][1] = (float)ai;
    for (int h = 0; h < 16; ++h) { const double br = b_re[(size_t)i * 16 + h], bi = b_im[(size_t)i * 16 + h];
        P->bbar[d][g][p][h][0] = (float)(cr * br - ci * bi); P->bbar[d][g][p][h][1] = (float)(cr * bi + ci * br); }
}
__global__ void k_s5prep(const float* lam_re, const float* lam_im, const float* log_dt, const float* b_re, const float* b_im, S5P* P) {
    const int i = blockIdx.x * blockDim.x + threadIdx.x; if (i >= 2 * 32 * 64) return;
    s5prep_one(lam_re, lam_im, log_dt, b_re, b_im, P, i);
}

DEVI void norm_row(const float* __restrict__ x, const float* __restrict__ ctx, const float* __restrict__ w, const float* __restrict__ mod,
                                              bf16_t* __restrict__ H, int row, int lane, int sh_off, int sc_off) {
    const float* src; int b;
    if (row < NTOK) { src = x + (size_t)row * DM; b = row / SEQ; } else { src = ctx + (size_t)(row - NTOK) * DM; b = 8; }
    float4 v[4]; float ss = 0.f;
#pragma unroll
    for (int j = 0; j < 4; ++j) { v[j] = *(const float4*)(src + lane * 4 + 256 * j); ss += v[j].x * v[j].x + v[j].y * v[j].y + v[j].z * v[j].z + v[j].w * v[j].w; }
    const float rstd = rsqrtf(wave_sum(ss) * (1.f / DM) + 1e-6f);
    const float* msh = mod + b * 6144 + sh_off; const float* msc = mod + b * 6144 + sc_off;
#pragma unroll
    for (int j = 0; j < 4; ++j) { const int k = lane * 4 + 256 * j;
        const float4 ww = *(const float4*)(w + k), sc = *(const float4*)(msc + k), sh = *(const float4*)(msh + k);
        uint2 o; o.x = pk2(v[j].x * rstd * ww.x * (1.f + sc.x) + sh.x, v[j].y * rstd * ww.y * (1.f + sc.y) + sh.y);
        o.y = pk2(v[j].z * rstd * ww.z * (1.f + sc.z) + sh.z, v[j].w * rstd * ww.w * (1.f + sc.w) + sh.w);
        *(uint2*)(H + (size_t)row * DM + k) = o; }
}
__global__ __launch_bounds__(256) void k_norm(const float* __restrict__ x, const float* __restrict__ ctx, const float* __restrict__ w, const float* __restrict__ mod,
                                              bf16_t* __restrict__ H, int nrows, int sh_off, int sc_off) {
    const int row = blockIdx.x * 4 + (threadIdx.x >> 6), lane = threadIdx.x & 63; if (row >= nrows) return;
    norm_row(x, ctx, w, mod, H, row, lane, sh_off, sc_off);
}

DEVI void dense_unit(int L, int nM, int nN, int& pm, int& pn) {
    const int nwg = nM * nN; int wgid = L; { const int q = nwg / 8, r = nwg % 8, xcd = wgid % 8, off = wgid / 8; wgid = (xcd < r ? xcd * (q + 1) : r * (q + 1) + (xcd - r) * q) + off; }
    const int nig = 8 * nN, gid = wgid / nig, fm = gid * 8, gsz = (nM - fm) < 8 ? (nM - fm) : 8;
    pm = fm + ((wgid % nig) % gsz); pn = (wgid % nig) / gsz;
}
template <class Prob> __global__ __launch_bounds__(256) void k_gemm_naive(Prob P) {
    __shared__ float As[32][68], Bs[32][68];
    const int z = blockIdx.z, M = P.M(z), r0 = blockIdx.y * 64, c0 = blockIdx.x * 64; if (r0 >= M) return;
    const int tid = threadIdx.x, tx = tid & 7, ty = tid >> 3, K = P.K;
    const int lr = tid >> 2, lk = (tid & 3) * 8;
    const bool arow_ok = (r0 + lr) < M;
    const bf16_t* ap = P.A + (size_t)(arow_ok ? P.arow(z, r0 + lr) : 0) * P.lda + lk;
    const bf16_t* bp = P.Bt(z) + (size_t)(c0 + lr) * P.ldb + lk;
    float acc[2][8];
#pragma unroll
    for (int i = 0; i < 2; ++i)
#pragma unroll
        for (int j = 0; j < 8; ++j) acc[i][j] = 0.f;
    for (int k0 = 0; k0 < K; k0 += 32) {
        uint4 av = arow_ok ? *(const uint4*)(ap + k0) : make_uint4(0, 0, 0, 0); const uint4 bv = *(const uint4*)(bp + k0);
        const unsigned aw[4] = {av.x, av.y, av.z, av.w}, bw[4] = {bv.x, bv.y, bv.z, bv.w};
        __syncthreads();
#pragma unroll
        for (int j = 0; j < 4; ++j) { As[lk + 2 * j][lr] = __uint_as_float(aw[j] << 16); As[lk + 2 * j + 1][lr] = __uint_as_float(aw[j] & 0xffff0000u);
            Bs[lk + 2 * j][lr] = __uint_as_float(bw[j] << 16); Bs[lk + 2 * j + 1][lr] = __uint_as_float(bw[j] & 0xffff0000u); }
        __syncthreads();
#pragma unroll 8
        for (int k = 0; k < 32; ++k) { const float a0 = As[k][ty * 2], a1 = As[k][ty * 2 + 1];
            const float4 b0 = *(const float4*)&Bs[k][tx * 8], b1 = *(const float4*)&Bs[k][tx * 8 + 4];
            const float bb[8] = {b0.x, b0.y, b0.z, b0.w, b1.x, b1.y, b1.z, b1.w};
#pragma unroll
            for (int j = 0; j < 8; ++j) { acc[0][j] += a0 * bb[j]; acc[1][j] += a1 * bb[j]; } }
    }
#pragma unroll
    for (int i = 0; i < 2; ++i) { const int r = r0 + ty * 2 + i; if (r < M) P.store(z, r, c0 + tx * 8, acc[i]); }
}

struct ProbIn {
    static constexpr bool HOIST = false, PAIR = false, FP8 = false;
    const bf16_t* A; int lda; const bf16_t* B; int ldb; int K; bf16_t *QK, *V, *R, *UT, *U2; float* LR;
    DEVI int M(int) const { return NROWS; }
    DEVI int arow(int, int r) const { return r; }
    DEVI int nunits() const { return (NROWS / 256) * (INP / 256); }
    DEVI void unit(int L, int& z, int& pm, int& pn) const { z = 0; dense_unit(L, NROWS / 256, INP / 256, pm, pn); }
    DEVI unsigned aoffb(int, int r) const { return (unsigned)r * (unsigned)(lda * 2); }
    DEVI const bf16_t* Bt(int) const { return B; }
    DEVI void store(int, int r, int c0, const float (&v)[8]) const {
        if (c0 >= INC) return;
        uint4 o; o.x = pk2(v[0], v[1]); o.y = pk2(v[2], v[3]); o.z = pk2(v[4], v[5]); o.w = pk2(v[6], v[7]);
        if (c0 < 512) { *(uint4*)(QK + (size_t)r * 512 + c0) = o; }
        else if (c0 < 1024) { *(uint4*)(V + (size_t)r * 512 + (c0 - 512)) = o; }
        else if (c0 < 1536) { *(uint4*)(R + (size_t)r * 512 + (c0 - 1024)) = o; }
        else if (c0 < 1568) { float* p = LR + (size_t)r * 32 + (c0 - 1536); *(float4*)p = make_float4(v[0], v[1], v[2], v[3]); *(float4*)(p + 4) = make_float4(v[4], v[5], v[6], v[7]); }
        else { const int j = c0 - 1568;
            const int g = j >> 4, ch = j & 15; int urow, ucol;
            if (r < NTOK) { const int b = r >> 12, n = r & 4095, gr = n >> 6, gc = n & 63, s = gc * 64 + gr; urow = b * 256 + (s >> 4); ucol = (s & 15) * 16 + ch; }
            else { const int q = r - NTOK, b = q >> 8, t = q & 255; urow = 2048 + b * 16 + (t >> 4); ucol = (t & 15) * 16 + ch; }
            *(uint4*)(U2 + ((size_t)g * 2304 + urow) * 512 + ucol) = o; }
    }
};
struct ProbGlu {
    static constexpr bool HOIST = false, PAIR = false, FP8 = false;
    const bf16_t* A; int lda; const bf16_t* B; int ldb; int K; const float* bias; bf16_t* MIX;
    DEVI int M(int) const { return NTOK; }
    DEVI int arow(int, int r) const { return r; }
    DEVI int nunits() const { return (NTOK / 256) * 2; }
    DEVI void unit(int L, int& z, int& pm, int& pn) const { z = 0; dense_unit(L, NTOK / 256, 2, pm, pn); }
    DEVI unsigned aoffb(int, int r) const { return (unsigned)r * (unsigned)(lda * 2); }
    DEVI const bf16_t* Bt(int) const { return B; }
    DEVI void store(int, int r, int c0, const float (&v)[8]) const {
        const uint4 yv = *(const uint4*)(A + (size_t)r * lda + c0); const unsigned yw[4] = {yv.x, yv.y, yv.z, yv.w}; float o[8];
#pragma unroll
        for (int j = 0; j < 4; ++j) { const float y0 = __uint_as_float(yw[j] << 16), y1 = __uint_as_float(yw[j] & 0xffff0000u);
            o[2 * j] = y0 * sigmoidf_(v[2 * j] + bias[c0 + 2 * j]); o[2 * j + 1] = y1 * sigmoidf_(v[2 * j + 1] + bias[c0 + 2 * j + 1]); }
        uint4 w; w.x = pk2(o[0], o[1]); w.y = pk2(o[2], o[3]); w.z = pk2(o[4], o[5]); w.w = pk2(o[6], o[7]);
        *(uint4*)(MIX + (size_t)r * DM + 512 + c0) = w;
    }
};
struct ProbOut {
    static constexpr bool HOIST = false, PAIR = false, FP8 = false;
    const bf16_t* A; int lda; const bf16_t* B; int ldb; int K; const float* x; const float* mod; float* X1;
    DEVI int M(int) const { return NTOK; }
    DEVI int arow(int, int r) const { return r; }
    DEVI int nunits() const { return (NTOK / 256) * 4; }
    DEVI void unit(int L, int& z, int& pm, int& pn) const { z = 0; dense_unit(L, NTOK / 256, 4, pm, pn); }
    DEVI unsigned aoffb(int, int r) const { return (unsigned)r * (unsigned)(lda * 2); }
    DEVI const bf16_t* Bt(int) const { return B; }
    DEVI void store(int, int r, int c0, const float (&v)[8]) const {
        uint4 o; o.x = pk2(v[0], v[1]); o.y = pk2(v[2], v[3]); o.z = pk2(v[4], v[5]); o.w = pk2(v[6], v[7]);
        *(uint4*)((bf16_t*)(X1 + (size_t)r * DM) + DM + c0) = o;
    }
};
struct ProbMoe1 {
    const bf16_t* A; int lda; const bf16_t* B; int ldb; int K; const int* cnt; const int* offs; const int* list; const float* b_gu; bf16_t* ACT;
    DEVI int M(int z) const { return cnt[z]; }
    DEVI int arow(int z, int r) const { return list[z * LISTCAP + r] >> 2; }
    DEVI const bf16_t* Bt(int z) const { return B + (size_t)z * 2048 * DM; }
    DEVI void store(int, int, int, const float (&)[8]) const {}
};
struct ProbMoe2 {
    const bf16_t* A; int lda; const bf16_t* B; int ldb; int K; const int* cnt; const int* offs; const int* list; const float* b_down; const float* gate; bf16_t* YSL;
    DEVI int M(int z) const { return cnt[z]; }
    DEVI int arow(int z, int r) const { return offs[z] + r; }
    DEVI const bf16_t* Bt(int z) const { return B + (size_t)z * DM * DFF; }
    DEVI void store(int z, int r, int c0, const float (&v)[8]) const {
        const int ent = list[z * LISTCAP + r]; const float gt = gate[ent]; const float* bd = b_down + (size_t)z * DM + c0;
        uint4 o; o.x = pk2((v[0] + bd[0]) * gt, (v[1] + bd[1]) * gt); o.y = pk2((v[2] + bd[2]) * gt, (v[3] + bd[3]) * gt);
        o.z = pk2((v[4] + bd[4]) * gt, (v[5] + bd[5]) * gt); o.w = pk2((v[6] + bd[6]) * gt, (v[7] + bd[7]) * gt);
        *(uint4*)(YSL + (size_t)ent * DM + c0) = o;
    }
};

DEVI void gla_naive_body(const bf16_t* __restrict__ QK, const bf16_t* __restrict__ V, const float* __restrict__ LR, const float* __restrict__ lr_up,
                                                   const float* __restrict__ lr_bias, float* __restrict__ OF, float* __restrict__ OB, LAS float* sm, int item) {
    LAS float* sq = sm; LAS float* sk = sm + 64; LAS float* sa = sm + 128; LAS float* sv = sm + 192; LAS float* red = sm + 320;
    const int dir = item & 1, hh = (item >> 1) & 3, b = item >> 3, tid = threadIdx.x, e = tid & 127, dg = tid >> 7;
    float up[16]; float bias = 0.f;
    if (tid < 64) { for (int r = 0; r < 16; ++r) up[r] = lr_up[dir * 4096 + r * 256 + hh * 64 + tid]; bias = lr_bias[dir * 256 + hh * 64 + tid]; }
    float S[16];
#pragma unroll
    for (int i = 0; i < 16; ++i) S[i] = 0.f;
    float* O = dir ? OB : OF;
    for (int step = 0; step < CTX + SEQ; ++step) {
        int row;
        if (step < CTX) row = NTOK + b * CTX + (dir ? CTX - 1 - step : step);
        else { const int t = step - CTX; row = b * SEQ + (dir ? SEQ - 1 - t : t); }
        if (tid < 64) { const float* lp = LR + (size_t)row * 32 + dir * 16; float g = bias;
#pragma unroll
            for (int r = 0; r < 16; ++r) g += lp[r] * up[r];
            sa[tid] = __expf(logsigmoidf_(g) * (1.f / 16.f));
            sq[tid] = bf2f(QK[(size_t)row * 512 + hh * 64 + tid]) * 0.125f; sk[tid] = bf2f(QK[(size_t)row * 512 + 256 + hh * 64 + tid]); }
        else if (tid < 192) sv[tid - 64] = bf2f(V[(size_t)row * 512 + hh * 128 + (tid - 64)]);
        __syncthreads();
        const float v = sv[e]; float part = 0.f;
#pragma unroll
        for (int i = 0; i < 16; ++i) { const int d = dg * 16 + i; S[i] = sa[d] * S[i] + sk[d] * v; part += sq[d] * S[i]; }
        if (step >= CTX) red[dg * 128 + e] = part;
        __syncthreads();
        if (step >= CTX && dg == 0) O[(size_t)row * 512 + hh * 128 + e] = (red[e] + red[128 + e]) + (red[256 + e] + red[384 + e]);
    }
}
__global__ __launch_bounds__(512) void k_gla_naive(const bf16_t* __restrict__ QK, const bf16_t* __restrict__ V, const float* __restrict__ LR, const float* __restrict__ lr_up,
                                                   const float* __restrict__ lr_bias, float* __restrict__ OF, float* __restrict__ OB) {
    __shared__ float sm[832];
    gla_naive_body(QK, V, LR, lr_up, lr_bias, OF, OB, (LAS float*)sm, blockIdx.x);
}
DEVI void gla_post_row(const float* __restrict__ OF, const float* __restrict__ OB, const bf16_t* __restrict__ R, const float* __restrict__ nw, bf16_t* __restrict__ MIX, int tok, int lane) {
    const int c0 = lane * 8;
    float o[8]; float ss = 0.f;
#pragma unroll
    for (int j = 0; j < 8; ++j) { o[j] = OF[(size_t)tok * 512 + c0 + j] + OB[(size_t)tok * 512 + c0 + j]; ss += o[j] * o[j]; }
    ss += __shfl_xor(ss, 1); ss += __shfl_xor(ss, 2); ss += __shfl_xor(ss, 4); ss += __shfl_xor(ss, 8);
    const float rstd = rsqrtf(ss * (1.f / 128.f) + 1e-6f);
    float w[8];
#pragma unroll
    for (int j = 0; j < 8; ++j) { const float r = bf2f(R[(size_t)tok * 512 + c0 + j]); w[j] = o[j] * rstd * nw[(c0 + j) & 127] * siluf_(r); }
    uint4 q; q.x = pk2(w[0], w[1]); q.y = pk2(w[2], w[3]); q.z = pk2(w[4], w[5]); q.w = pk2(w[6], w[7]);
    *(uint4*)(MIX + (size_t)tok * DM + c0) = q;
}
__global__ __launch_bounds__(256) void k_gla_post(const float* __restrict__ OF, const float* __restrict__ OB, const bf16_t* __restrict__ R, const float* __restrict__ nw, bf16_t* __restrict__ MIX) {
    gla_post_row(OF, OB, R, nw, MIX, blockIdx.x * 4 + (threadIdx.x >> 6), threadIdx.x & 63);
}

DEVI void s5_naive_body(const bf16_t* __restrict__ UT, const S5P* __restrict__ P, const float* __restrict__ c_re, const float* __restrict__ c_im,
                                                  float* __restrict__ YF, float* __restrict__ YB, LAS float* hsw  , int id, int lane) {
    const int g = id & 31, dir = (id >> 5) & 1, b = id >> 6;
    const float lr = P->lamb[dir][g][lane][0], li = P->lamb[dir][g][lane][1];
    float br[16], bi[16];
#pragma unroll
    for (int h = 0; h < 16; ++h) { br[h] = P->bbar[dir][g][lane][h][0]; bi[h] = P->bbar[dir][g][lane][h][1]; }
    const int ch = lane & 15, part = lane >> 4;
    float cr[16], ci[16];
#pragma unroll
    for (int i = 0; i < 16; ++i) { const size_t ix = (((size_t)dir * 32 + g) * 16 + ch) * 64 + part * 16 + i; cr[i] = c_re[ix]; ci[i] = c_im[ix]; }
    float hr = 0.f, hi = 0.f; float* Y = dir ? YB : YF;
    for (int step = 0; step < CTX + SEQ; ++step) {
        int row;
        if (step < CTX) row = NTOK + b * CTX + (dir ? CTX - 1 - step : step);
        else { const int t = step - CTX, s = dir ? SEQ - 1 - t : t; row = b * SEQ + (s & 63) * 64 + (s >> 6); }
        const uint4 u0 = *(const uint4*)(UT + (size_t)row * 512 + g * 16), u1 = *(const uint4*)(UT + (size_t)row * 512 + g * 16 + 8);
        const unsigned uw[8] = {u0.x, u0.y, u0.z, u0.w, u1.x, u1.y, u1.z, u1.w};
        float bur = 0.f, bui = 0.f;
#pragma unroll
        for (int j = 0; j < 8; ++j) { const float ua = __uint_as_float(uw[j] << 16), ub = __uint_as_float(uw[j] & 0xffff0000u);
            bur += br[2 * j] * ua + br[2 * j + 1] * ub; bui += bi[2 * j] * ua + bi[2 * j + 1] * ub; }
        const float nr = lr * hr - li * hi + bur, ni = lr * hi + li * hr + bui; hr = nr; hi = ni;
        if (step >= CTX) {
            hsw[lane] = hr; hsw[64 + lane] = hi;
            asm volatile("s_waitcnt lgkmcnt(0)" ::: "memory");
            float acc = 0.f;
#pragma unroll
            for (int i = 0; i < 16; ++i) acc += cr[i] * hsw[part * 16 + i] - ci[i] * hsw[64 + part * 16 + i];
            acc += __shfl_xor(acc, 16); acc += __shfl_xor(acc, 32);
            asm volatile("s_waitcnt lgkmcnt(0)" ::: "memory");
            if (lane < 16) Y[(size_t)row * 512 + g * 16 + lane] = acc;
        }
    }
}
__global__ __launch_bounds__(256) void k_s5_naive(const bf16_t* __restrict__ UT, const S5P* __restrict__ P, const float* __restrict__ c_re, const float* __restrict__ c_im,
                                                  float* __restrict__ YF, float* __restrict__ YB) {
    __shared__ float hs[4][128];
    const int w = threadIdx.x >> 6;
    s5_naive_body(UT, P, c_re, c_im, YF, YB, (LAS float*)hs[w], blockIdx.x * 4 + w, threadIdx.x & 63);
}
__global__ __launch_bounds__(256) void k_s5_post(const float* __restrict__ YF, const float* __restrict__ YB, const bf16_t* __restrict__ UT, const float* __restrict__ dvec, bf16_t* __restrict__ YS) {
    const size_t i = (size_t)blockIdx.x * 256 + threadIdx.x; const int j = (int)(i & 511);
    const float y = YF[i] + YB[i] + dvec[j] * bf2f(UT[i]);
    YS[i] = f2bf(gelu_tanh(y));
}

DEVI void router_row(const float* __restrict__ X1, const float* __restrict__ w, const float* __restrict__ mod, const float* __restrict__ rw, const float* __restrict__ rb,
                                                bf16_t* __restrict__ H2, int* __restrict__ cnt, int* __restrict__ list, float* __restrict__ gate, LAS float* hrw  , int tok, int lane) {
    const int b = tok / SEQ;
    const float* src = X1 + (size_t)tok * DM;
    float4 v[4]; float ss = 0.f;
#pragma unroll
    for (int j = 0; j < 4; ++j) { v[j] = *(const float4*)(src + lane * 4 + 256 * j); ss += v[j].x * v[j].x + v[j].y * v[j].y + v[j].z * v[j].z + v[j].w * v[j].w; }
    const float rstd = rsqrtf(wave_sum(ss) * (1.f / DM) + 1e-6f);
    const float* msh = mod + b * 6144 + 3072; const float* msc = mod + b * 6144 + 4096;
#pragma unroll
    for (int j = 0; j < 4; ++j) { const int k = lane * 4 + 256 * j;
        const float4 ww = *(const float4*)(w + k), sc = *(const float4*)(msc + k), sh = *(const float4*)(msh + k);
        float4 h; h.x = v[j].x * rstd * ww.x * (1.f + sc.x) + sh.x; h.y = v[j].y * rstd * ww.y * (1.f + sc.y) + sh.y; h.z = v[j].z * rstd * ww.z * (1.f + sc.z) + sh.z; h.w = v[j].w * rstd * ww.w * (1.f + sc.w) + sh.w;
        hrw[k] = h.x; hrw[k + 1] = h.y; hrw[k + 2] = h.z; hrw[k + 3] = h.w;
        uint2 o; o.x = pk2(h.x, h.y); o.y = pk2(h.z, h.w); *(uint2*)(H2 + (size_t)tok * DM + k) = o; }
    asm volatile("s_waitcnt lgkmcnt(0)" ::: "memory");
    const int e = lane & 31, half = lane >> 5; float lg = 0.f;
    for (int k = half * 512; k < half * 512 + 512; ++k) lg += hrw[k] * rw[k * 32 + e];
    lg += __shfl_xor(lg, 32); lg += rb[e];
    float val = lg; float tv[4]; int ti[4];
#pragma unroll
    for (int t = 0; t < 4; ++t) { float bv = val; int bi = e;
#pragma unroll
        for (int o = 1; o < 32; o <<= 1) { const float ov = __shfl_xor(bv, o); const int oi = __shfl_xor(bi, o); if (ov > bv || (ov == bv && oi < bi)) { bv = ov; bi = oi; } }
        tv[t] = bv; ti[t] = bi; if (e == bi) val = -3.0e38f; }
    const float e1 = __expf(tv[1] - tv[0]), e2 = __expf(tv[2] - tv[0]), e3 = __expf(tv[3] - tv[0]), inv = 1.f / (1.f + e1 + e2 + e3);
    if (lane < 4) { const float gv = lane == 0 ? inv : lane == 1 ? e1 * inv : lane == 2 ? e2 * inv : e3 * inv; const int ex = lane == 0 ? ti[0] : lane == 1 ? ti[1] : lane == 2 ? ti[2] : ti[3];
        const int slot = atomicAdd(&cnt[ex], 1); list[ex * LISTCAP + slot] = tok * 4 + lane; gate[tok * 4 + lane] = gv; }
}
__global__ __launch_bounds__(256) void k_router(const float* __restrict__ X1, const float* __restrict__ w, const float* __restrict__ mod, const float* __restrict__ rw, const float* __restrict__ rb,
                                                bf16_t* __restrict__ H2, int* __restrict__ cnt, int* __restrict__ list, float* __restrict__ gate) {
    __shared__ float hrow[4][1024];
    const int wv = threadIdx.x >> 6;
    router_row(X1, w, mod, rw, rb, H2, cnt, list, gate, (LAS float*)hrow[wv], blockIdx.x * 4 + wv, threadIdx.x & 63);
}
__global__ void k_offsets(const int* cnt, int* offs) { if (threadIdx.x == 0) { int o = 0; for (int e = 0; e < NEXP; ++e) { offs[e] = o; o += (cnt[e] + MOEPAD - 1) / MOEPAD * MOEPAD; } offs[NEXP] = o; } }

DEVI void final_row(const float* __restrict__ X, float* __restrict__ X1, const bf16_t* __restrict__ Y2, const float* __restrict__ mod, const float* __restrict__ fw, const float* __restrict__ gate, const int* __restrict__ epos,
                    const LAS int* ub, int tok, int lane, float* __restrict__ OUT = nullptr) {
    const int b = tok / SEQ;
    float* row = X1 + (size_t)tok * DM; float* orow = OUT ? OUT + (size_t)tok * DM : row; const float* g2 = mod + b * 6144 + 5120; const float* g1p = mod + b * 6144 + 2048;
    const float* xrow = X + (size_t)tok * DM; const bf16_t* mrow = (const bf16_t*)row + DM;
    const int4 ep = *(const int4*)(epos + tok * 4); const float4 gt = *(const float4*)(gate + tok * 4);
    const bf16_t* y0 = Y2 + (size_t)(ub[ep.x / LISTCAP] * 256 + ep.x % LISTCAP) * DM; const bf16_t* y1 = Y2 + (size_t)(ub[ep.y / LISTCAP] * 256 + ep.y % LISTCAP) * DM;
    const bf16_t* y2 = Y2 + (size_t)(ub[ep.z / LISTCAP] * 256 + ep.z % LISTCAP) * DM; const bf16_t* y3 = Y2 + (size_t)(ub[ep.w / LISTCAP] * 256 + ep.w % LISTCAP) * DM;
    float4 v[4]; float ss = 0.f;
#pragma unroll
    for (int j = 0; j < 4; ++j) { const int k = lane * 4 + 256 * j; v[j] = *(const float4*)(xrow + k);
        { const uint2 mm = *(const uint2*)(mrow + k); const float4 g1 = *(const float4*)(g1p + k);
          v[j].x += g1.x * __uint_as_float(mm.x << 16); v[j].y += g1.y * __uint_as_float(mm.x & 0xffff0000u); v[j].z += g1.z * __uint_as_float(mm.y << 16); v[j].w += g1.w * __uint_as_float(mm.y & 0xffff0000u); }
        const uint2 a0 = *(const uint2*)(y0 + k), a1 = *(const uint2*)(y1 + k), a2 = *(const uint2*)(y2 + k), a3 = *(const uint2*)(y3 + k);
        float f[4];
        f[0] = gt.x * __uint_as_float(a0.x << 16) + gt.y * __uint_as_float(a1.x << 16) + gt.z * __uint_as_float(a2.x << 16) + gt.w * __uint_as_float(a3.x << 16);
        f[1] = gt.x * __uint_as_float(a0.x & 0xffff0000u) + gt.y * __uint_as_float(a1.x & 0xffff0000u) + gt.z * __uint_as_float(a2.x & 0xffff0000u) + gt.w * __uint_as_float(a3.x & 0xffff0000u);
        f[2] = gt.x * __uint_as_float(a0.y << 16) + gt.y * __uint_as_float(a1.y << 16) + gt.z * __uint_as_float(a2.y << 16) + gt.w * __uint_as_float(a3.y << 16);
        f[3] = gt.x * __uint_as_float(a0.y & 0xffff0000u) + gt.y * __uint_as_float(a1.y & 0xffff0000u) + gt.z * __uint_as_float(a2.y & 0xffff0000u) + gt.w * __uint_as_float(a3.y & 0xffff0000u);
        const float4 gg = *(const float4*)(g2 + k);
        v[j].x += gg.x * f[0]; v[j].y += gg.y * f[1]; v[j].z += gg.z * f[2]; v[j].w += gg.w * f[3];
        ss += v[j].x * v[j].x + v[j].y * v[j].y + v[j].z * v[j].z + v[j].w * v[j].w; }
    const float rstd = rsqrtf(wave_sum(ss) * (1.f / DM) + 1e-6f);
#pragma unroll
    for (int j = 0; j < 4; ++j) { const int k = lane * 4 + 256 * j; const float4 ww = *(const float4*)(fw + k);
        *(float4*)(orow + k) = make_float4(v[j].x * rstd * ww.x, v[j].y * rstd * ww.y, v[j].z * rstd * ww.z, v[j].w * rstd * ww.w); }
}

typedef short bf16x8 __attribute__((ext_vector_type(8)));
typedef float f32x4 __attribute__((ext_vector_type(4)));
typedef unsigned u32x4 __attribute__((ext_vector_type(4)));
typedef unsigned u32x2 __attribute__((ext_vector_type(2)));
typedef int i32x4 __attribute__((ext_vector_type(4)));
typedef int i32x8 __attribute__((ext_vector_type(8)));
#ifndef MOE_FP8
#define MOE_FP8 1
#endif
DEVI unsigned pk4_fp8(float a, float b, float c, float d) { int w = 0; w = __builtin_amdgcn_cvt_pk_fp8_f32(a, b, w, false); w = __builtin_amdgcn_cvt_pk_fp8_f32(c, d, w, true); return (unsigned)w; }
constexpr int NWAVES = 8, NTHR = 512;
constexpr int BM = 256, BK = 64, HALF = 128, HTB = HALF * BK * 2, STAGE_BYTES = 8 * HTB;
constexpr int MISC_OFF = 147456, MISC_BYTES = 1024, LDS_BYTES = MISC_OFF + MISC_BYTES;
constexpr int CW_BAR = 4096;

#define XB_TMO      128
#define XB_XCNT(j)  (256  + 64 * (j))
#define XB_XSUB(j)  (1280 + 64 * (j))
#define XB_XGEN(j)  (2304 + 64 * (j))
#define XB_TOP      3328
#define XB_TOPGEN   3392
#define XCD_BAR_WORDS 3456
#define XB_SPIN_CAP (1u << 18)
DEVI unsigned xb_ld(unsigned* p)              { return __hip_atomic_load(p, __ATOMIC_RELAXED, __HIP_MEMORY_SCOPE_AGENT); }
DEVI unsigned xb_add(unsigned* p, unsigned v) { return __hip_atomic_fetch_add(p, v, __ATOMIC_RELAXED, __HIP_MEMORY_SCOPE_AGENT); }
DEVI unsigned xb_xcc_id() { return (unsigned)__builtin_amdgcn_s_getreg((3 << 11) | 20) & 0xFu; }
#define XB_SPIN(cond, bar) do { unsigned _sp = 0; while (cond) { __builtin_amdgcn_s_sleep(1); \
    if ((++_sp & 255u) == 0u) { if (xb_ld(&(bar)[XB_TMO])) break; if (_sp > XB_SPIN_CAP) { atomicAdd(&(bar)[XB_TMO], 1u); break; } } } } while (0)
struct XcdBarrier { unsigned* bar; unsigned x; volatile LAS unsigned* st; };
DEVI XcdBarrier xcd_barrier_post(unsigned* bar, volatile LAS unsigned* st) {
    XcdBarrier b; b.bar = bar; b.x = xb_xcc_id(); b.st = st;
    if (threadIdx.x == 0) (void)xb_add(&bar[XB_XCNT(b.x)], 1u);
    return b;
}
DEVI void xcd_barrier_complete(unsigned* bar, unsigned x, unsigned& nloc, unsigned& nx) {
    const unsigned G = gridDim.x * gridDim.y * gridDim.z;
    unsigned sum, cnt, mine, sp = 0u;
    for (;;) {
        sum = 0u; cnt = 0u; mine = 0u;
#pragma unroll
        for (unsigned j = 0; j < 16; ++j) { const unsigned c = xb_ld(&bar[XB_XCNT(j)]); sum += c; cnt += (c > 0u) ? 1u : 0u; mine = (j == x) ? c : mine; }
        if (sum == G) break;
        __builtin_amdgcn_s_sleep(1);
        if ((++sp & 255u) == 0u) { if (xb_ld(&bar[XB_TMO])) break; if (sp > XB_SPIN_CAP) { atomicAdd(&bar[XB_TMO], 1u); break; } }
    }
    nloc = mine > 0u ? mine : 1u; nx = cnt > 0u ? cnt : 1u;
}
DEVI void xcd_barrier(const XcdBarrier& b) {
    asm volatile("s_waitcnt vmcnt(0)" ::: "memory");
    __syncthreads();
    if (threadIdx.x == 0) {
        unsigned* bar = b.bar;
        __builtin_amdgcn_s_waitcnt(0);
        unsigned nloc = b.st[0], nx = b.st[1];
        if (nloc == 0u) { xcd_barrier_complete(bar, b.x, nloc, nx); b.st[0] = nloc; b.st[1] = nx; }
        const unsigned old = xb_add(&bar[XB_XSUB(b.x)], 1u);
        const unsigned gen = old / nloc;
        if (old + 1u == (gen + 1u) * nloc) {
            __builtin_amdgcn_fence(__ATOMIC_RELEASE, "agent");
            asm volatile("s_waitcnt vmcnt(0)" ::: "memory");
            const unsigned og = xb_add(&bar[XB_TOP], 1u);
            const unsigned tg = og / nx;
            if (og + 1u == (tg + 1u) * nx) xb_add(&bar[XB_TOPGEN], 1u);
            else XB_SPIN(xb_ld(&bar[XB_TOPGEN]) == tg, bar);
            __builtin_amdgcn_fence(__ATOMIC_ACQUIRE, "agent");
            xb_add(&bar[XB_XGEN(b.x)], 1u);
            asm volatile("s_waitcnt vmcnt(0)" ::: "memory");
        } else {
            XB_SPIN(xb_ld(&bar[XB_XGEN(b.x)]) == gen, bar);
            __builtin_amdgcn_fence(__ATOMIC_ACQUIRE, "agent");
            asm volatile("s_waitcnt vmcnt(0)" ::: "memory");
        }
    }
    __syncthreads();
}

DEVI int lds_byte(int r, int c) { const int st = (r >> 4) * 2 + (c >> 5), rr = r & 15, cc = c & 31, ob = rr * 64 + cc * 2; return st * 1024 + (ob ^ (((ob >> 9) & 1) << 5)); }
DEVI void stage_rc(int b, int& R, int& C) { const int st = b / 1024, sb = b % 1024, swz = sb ^ (((sb >> 9) & 1) << 5); R = (st >> 1) * 16 + swz / 64; C = (st & 1) * 32 + (swz % 64) / 2; }
DEVI int perm32(int rho) { const int n = rho >> 4, i = rho & 15; return 8 * (i >> 2) + 4 * n + (i & 3); }
template <int VMODE = 0, class Prob>
DEVI void gemm_phase(LAS unsigned char* lds, const Prob& P, int G, int c) {
    int tid = threadIdx.x; asm volatile("" : "+v"(tid));
    const int wid = __builtin_amdgcn_readfirstlane(tid >> 6), lane = tid & 63, wr = wid >> 2, wc = wid & 3, fr = lane & 15, fq = lane >> 4;
    const int K = P.K, nt = K / BK;
    const int nun = P.nunits();
    int L = c; if (L >= nun) return;
    int Rs0, Cs0, Rs1, Cs1; stage_rc(tid * 16, Rs0, Cs0); stage_rc(tid * 16 + 8192, Rs1, Cs1);
    unsigned voffB[2];
    voffB[0] = (unsigned)(((Rs0 & ~31) + perm32(Rs0 & 31)) * K + Cs0) * 2u; voffB[1] = (unsigned)(((Rs1 & ~31) + perm32(Rs1 & 31)) * K + Cs1) * 2u;
    const size_t kstep = (size_t)(BK * 2), hstepB = (size_t)HALF * K * 2, tstepB = 2 * hstepB;
    const unsigned ldsw = (unsigned)wid * 1024u;
    const int aoff = lds_byte(wr * 64 + fr, fq * 8), boff = lds_byte(wc * 32 + fr, fq * 8);
#define G_SA(b, h) (((b) * 2 + (h)) * HTB)
#define G_SB(b, h) ((4 + (b) * 2 + (h)) * HTB)
#define G_STAGE_B(bufoff, gbase) do { _Pragma("unroll") for (int _i = 0; _i < 2; ++_i) \
        __builtin_amdgcn_global_load_lds((const unsigned*)((const char*)(gbase) + voffB[_i]), (LAS unsigned*)(lds + (bufoff) + ldsw + _i * 8192), 16, 0, 0); } while (0)
#define G_STAGE_A(bufoff, gbase, v0, v1) do { \
        __builtin_amdgcn_global_load_lds((const unsigned*)((const char*)(gbase) + (v0)), (LAS unsigned*)(lds + (bufoff) + ldsw), 16, 0, 0); \
        __builtin_amdgcn_global_load_lds((const unsigned*)((const char*)(gbase) + (v1)), (LAS unsigned*)(lds + (bufoff) + ldsw + 8192), 16, 0, 0); } while (0)
#define G_LDA(dst, b, h) do { _Pragma("unroll") for (int m = 0; m < 4; ++m) _Pragma("unroll") for (int k = 0; k < 2; ++k) dst[m][k] = *(const LAS bf16x8*)(lds + G_SA(b, h) + aoff + m * 2048 + k * 1024); } while (0)
#define G_LDB(dst, b, h) do { _Pragma("unroll") for (int n = 0; n < 2; ++n) _Pragma("unroll") for (int k = 0; k < 2; ++k) dst[n][k] = *(const LAS bf16x8*)(lds + G_SB(b, h) + boff + n * 2048 + k * 1024); } while (0)
#define G_MMA(ai, bj, At, Bt) do { __builtin_amdgcn_s_setprio(1); _Pragma("unroll") for (int m = 0; m < 4; ++m) _Pragma("unroll") for (int n = 0; n < 2; ++n) { \
        if constexpr (Prob::FP8) { const i32x8 b8 = __builtin_shufflevector(__builtin_bit_cast(i32x4, Bt[n][0]), __builtin_bit_cast(i32x4, Bt[n][1]), 0, 1, 2, 3, 4, 5, 6, 7); \
            const i32x8 a8 = __builtin_shufflevector(__builtin_bit_cast(i32x4, At[m][0]), __builtin_bit_cast(i32x4, At[m][1]), 0, 1, 2, 3, 4, 5, 6, 7); \
            acc[ai][bj][m][n] = __builtin_amdgcn_mfma_scale_f32_16x16x128_f8f6f4(b8, a8, acc[ai][bj][m][n], 0, 0, 0, 0x7a7a7a7a, 0, 0x7f7f7f7f); } \
        else { _Pragma("unroll") for (int k = 0; k < 2; ++k) acc[ai][bj][m][n] = __builtin_amdgcn_mfma_f32_16x16x32_bf16(Bt[n][k], At[m][k], acc[ai][bj][m][n], 0, 0, 0); } } \
        __builtin_amdgcn_s_setprio(0); } while (0)
#define G_WAIT_V(n) asm volatile("s_waitcnt vmcnt(" #n ")" ::: "memory")
#define G_WAIT_L(n) asm volatile("s_waitcnt lgkmcnt(" #n ")" ::: "memory")
#define G_BAR __builtin_amdgcn_s_barrier()
#define G_SCHED __builtin_amdgcn_sched_barrier(0)
    int z, pm, pn; P.unit(L, z, pm, pn);
    z = __builtin_amdgcn_readfirstlane(z); pm = __builtin_amdgcn_readfirstlane(pm); pn = __builtin_amdgcn_readfirstlane(pn);
    unsigned vA00 = P.aoffb(z, pm * BM + Rs0) + Cs0 * 2, vA01 = P.aoffb(z, pm * BM + Rs1) + Cs1 * 2;
    unsigned vA10 = P.aoffb(z, pm * BM + HALF + Rs0) + Cs0 * 2, vA11 = P.aoffb(z, pm * BM + HALF + Rs1) + Cs1 * 2;
    const char* const Ab = (const char*)P.A;
    const char* cB = (const char*)P.Bt(z) + (size_t)pn * tstepB;
    f32x4 acc[2][2][4][2];
    bf16x8 At[4][2], B0[2][2], B1[2][2];
    G_STAGE_B(G_SB(0, 0), cB); G_STAGE_A(G_SA(0, 0), Ab, vA00, vA01); G_STAGE_B(G_SB(0, 1), cB + hstepB); G_STAGE_A(G_SA(0, 1), Ab, vA10, vA11);
    if (wr == 1) G_BAR;
    G_WAIT_V(4); G_BAR;
    G_STAGE_B(G_SB(1, 0), cB + kstep); G_STAGE_A(G_SA(1, 0), Ab + kstep, vA00, vA01); G_STAGE_B(G_SB(1, 1), cB + hstepB + kstep);
    G_WAIT_V(6); G_BAR;
    for (;;) {
        const int Ln = L + G; const bool has_next = Ln < nun;
        int nz = z, npm = pm, npn = pn; if (has_next) P.unit(Ln, nz, npm, npn);
        nz = __builtin_amdgcn_readfirstlane(nz); npm = __builtin_amdgcn_readfirstlane(npm); npn = __builtin_amdgcn_readfirstlane(npn);
        const char* nB = has_next ? (const char*)P.Bt(nz) + (size_t)npn * tstepB : cB;
        unsigned n00 = vA00, n01 = vA01, n10 = vA10, n11 = vA11;
        if (has_next) { n00 = P.aoffb(nz, npm * BM + Rs0) + Cs0 * 2; n01 = P.aoffb(nz, npm * BM + Rs1) + Cs1 * 2;
            n10 = P.aoffb(nz, npm * BM + HALF + Rs0) + Cs0 * 2; n11 = P.aoffb(nz, npm * BM + HALF + Rs1) + Cs1 * 2; }
#pragma unroll
        for (int a = 0; a < 2; ++a)
#pragma unroll
            for (int b = 0; b < 2; ++b)
#pragma unroll
                for (int m = 0; m < 4; ++m)
#pragma unroll
                    for (int n = 0; n < 2; ++n) acc[a][b][m][n] = (f32x4){0.f, 0.f, 0.f, 0.f};
#pragma unroll 1
        for (int t = 0; t < nt; t += 2) {
            const bool last = (t == nt - 2);
            const char* a1 = Ab + (size_t)(t + 1) * kstep;
            const char* a2 = last ? Ab : Ab + (size_t)(t + 2) * kstep; const char* b2 = last ? nB : cB + (size_t)(t + 2) * kstep;
            const char* a3 = a2 + kstep; const char* b3 = b2 + kstep;
            G_LDB(B0, 0, 0); G_SCHED; G_LDA(At, 0, 0); G_STAGE_A(G_SA(1, 1), a1, vA10, vA11);
            G_WAIT_L(8); G_BAR; G_WAIT_L(0); G_MMA(0, 0, At, B0); G_BAR; G_SCHED;
            if (last) { vA00 = n00; vA01 = n01; vA10 = n10; vA11 = n11; }
            G_LDB(B1, 0, 1); G_STAGE_B(G_SB(0, 0), b2);
            G_BAR; G_WAIT_L(0); G_MMA(0, 1, At, B1); G_BAR;
            G_LDA(At, 0, 1); G_STAGE_A(G_SA(0, 0), a2, vA00, vA01);
            G_BAR; G_WAIT_L(0); G_MMA(1, 0, At, B0); G_BAR; G_SCHED;
            G_STAGE_B(G_SB(0, 1), b2 + hstepB);
            G_WAIT_V(6); G_BAR; G_MMA(1, 1, At, B1); G_BAR;
            G_LDB(B0, 1, 0); G_SCHED; G_LDA(At, 1, 0); G_STAGE_A(G_SA(0, 1), a2, vA10, vA11);
            G_WAIT_L(8); G_BAR; G_WAIT_L(0); G_MMA(0, 0, At, B0); G_BAR; G_SCHED;
            G_LDB(B1, 1, 1); G_STAGE_B(G_SB(1, 0), b3);
            G_BAR; G_WAIT_L(0); G_MMA(0, 1, At, B1); G_BAR;
            G_LDA(At, 1, 1); G_STAGE_A(G_SA(1, 0), a3, vA00, vA01);
            G_BAR; G_WAIT_L(0); G_MMA(1, 0, At, B0); G_BAR; G_SCHED;
            G_STAGE_B(G_SB(1, 1), b3 + hstepB);
            G_WAIT_V(6); G_BAR; G_MMA(1, 1, At, B1); G_BAR;
        }
        if constexpr (VMODE == 1) {
#pragma unroll
            for (int a_ = 0; a_ < 2; ++a_)
#pragma unroll
                for (int b_ = 0; b_ < 2; ++b_)
#pragma unroll
                    for (int m_ = 0; m_ < 4; ++m_)
#pragma unroll
                        for (int n_ = 0; n_ < 2; ++n_) asm volatile("" :: "v"(acc[a_][b_][m_][n_]));
        } else
        { const int Mz = VMODE == 2 ? 0 : __builtin_amdgcn_readfirstlane(P.M(z));
          if constexpr (VMODE == 2) {
#pragma unroll
            for (int a_ = 0; a_ < 2; ++a_)
#pragma unroll
                for (int b_ = 0; b_ < 2; ++b_)
#pragma unroll
                    for (int m_ = 0; m_ < 4; ++m_)
#pragma unroll
                        for (int n_ = 0; n_ < 2; ++n_) asm volatile("" :: "v"(acc[a_][b_][m_][n_])); }
          const int cb0 = pn * BM + wc * 32 + 8 * fq, rb0 = pm * BM + wr * 64 + fr;
          if constexpr (Prob::PAIR) {
              const typename Prob::ColCtx cc = P.colctx(z, cb0);
              typename Prob::RowCtx rc[2][4];
#pragma unroll
              for (int ai = 0; ai < 2; ++ai)
#pragma unroll
                  for (int m = 0; m < 4; ++m) { const int row = rb0 + ai * HALF + m * 16; rc[ai][m] = P.rowctx(z, row, row < Mz); }
#pragma unroll
              for (int ai = 0; ai < 2; ++ai)
#pragma unroll
                  for (int m = 0; m < 4; ++m) { const int row = rb0 + ai * HALF + m * 16;
                      if (row < Mz) { const f32x4 g0 = acc[ai][0][m][0], g1 = acc[ai][0][m][1], l0 = acc[ai][1][m][0], l1 = acc[ai][1][m][1];
                          const float vg[8] = {g0[0], g0[1], g0[2], g0[3], g1[0], g1[1], g1[2], g1[3]}, vl[8] = {l0[0], l0[1], l0[2], l0[3], l1[0], l1[1], l1[2], l1[3]};
                          P.storepair(cc, rc[ai][m], vg, vl); } }
          } else if constexpr (Prob::HOIST) {
              typename Prob::ColCtx cc[2]; typename Prob::RowCtx rc[2][4];
#pragma unroll
              for (int bj = 0; bj < 2; ++bj) cc[bj] = P.colctx(z, cb0 + bj * HALF);
#pragma unroll
              for (int ai = 0; ai < 2; ++ai)
#pragma unroll
                  for (int m = 0; m < 4; ++m) { const int row = rb0 + ai * HALF + m * 16; rc[ai][m] = P.rowctx(z, row, row < Mz); }
#pragma unroll
              for (int ai = 0; ai < 2; ++ai)
#pragma unroll
                  for (int m = 0; m < 4; ++m) { const int row = rb0 + ai * HALF + m * 16;
                      if (row < Mz) {
#pragma unroll
                          for (int bj = 0; bj < 2; ++bj) { const f32x4 v0 = acc[ai][bj][m][0], v1 = acc[ai][bj][m][1];
                              const float v[8] = {v0[0], v0[1], v0[2], v0[3], v1[0], v1[1], v1[2], v1[3]};
                              P.storeh(cc[bj], rc[ai][m], cb0 + bj * HALF, v); } } }
          } else {
#pragma unroll
          for (int ai = 0; ai < 2; ++ai)
#pragma unroll
            for (int m = 0; m < 4; ++m) { const int row = rb0 + ai * HALF + m * 16;
                if (row < Mz) {
#pragma unroll
                    for (int bj = 0; bj < 2; ++bj) { const int c0 = cb0 + bj * HALF;
                        const f32x4 v0 = acc[ai][bj][m][0], v1 = acc[ai][bj][m][1];
                        const float v[8] = {v0[0], v0[1], v0[2], v0[3], v1[0], v1[1], v1[2], v1[3]};
                        P.store(z, row, c0, v); } }
                asm volatile("" ::: "memory"); } } }
        if (!has_next) break;
        z = nz; pm = npm; pn = npn; cB = nB; L = Ln;
    }
    G_WAIT_V(0);
    if (wr == 0) G_BAR;
    G_BAR;
}

template <int NT, bool REV> DEVI void moe_unit(const LAS int* ub, int L, int G, int& z, int& pm, int& pn) {
    const int nun = __builtin_amdgcn_readfirstlane(ub[NEXP]) * NT;
    int Lq = L;
    if ((G & 7) == 0) { const int i = L / G, c = L - i * G, x = c & 7, j = c >> 3, per = G >> 3; Lq = (i * 8 + x) * per + j; }
    if (Lq >= nun) { z = -1; pm = 0; pn = 0; return; }
    if (REV) Lq = nun - 1 - Lq;
    int e = 0; while (e < NEXP - 1 && Lq >= __builtin_amdgcn_readfirstlane(ub[e + 1]) * NT) ++e;
    const int l = Lq - __builtin_amdgcn_readfirstlane(ub[e]) * NT; z = e; pm = l / NT; pn = l % NT;
}
struct FMoe1 {
    static constexpr bool HOIST = true, PAIR = true, RV = false, FP8 = MOE_FP8 != 0; static constexpr int NT = 8;
    const bf16_t* A; const bf16_t* B; int K; const int* cnt; const int* list; const float* b_gu; bf16_t* ACT; const LAS int* ub; int G;
    struct ColCtx { float bg[8], bl[8]; int f0; }; struct RowCtx { bf16_t* p; };
    DEVI int ubs(int e) const { return __builtin_amdgcn_readfirstlane(ub[e]); }
    DEVI int nunits() const { const int n = ubs(NEXP) * NT; return (G & 7) == 0 ? (n + G - 1) / G * G : n; }
    DEVI void unit(int L, int& z, int& pm, int& pn) const { moe_unit<NT, RV>(ub, L, G, z, pm, pn); }
    DEVI int M(int z) const { return z < 0 ? 0 : cnt[z]; }
    DEVI unsigned aoffb(int z, int r) const { const int t = (z >= 0 && r < cnt[z]) ? (list[z * LISTCAP + r] >> 2) : 0; return (unsigned)t * (unsigned)(FP8 ? DM : DM * 2); }
    DEVI const bf16_t* Bt(int z) const { return (const bf16_t*)((const char*)B + (size_t)(z < 0 ? 0 : z) * 2048 * DM * (FP8 ? 1 : 2)); }
    DEVI ColCtx colctx(int z, int c0) const { ColCtx c; c.f0 = (c0 >> 8) * 128 + (c0 & 127); const float* bp = b_gu + (size_t)(z < 0 ? 0 : z) * 2048 + c.f0;
        const float4 g0 = *(const float4*)bp, g1 = *(const float4*)(bp + 4), l0 = *(const float4*)(bp + 1024), l1 = *(const float4*)(bp + 1028);
        c.bg[0] = g0.x; c.bg[1] = g0.y; c.bg[2] = g0.z; c.bg[3] = g0.w; c.bg[4] = g1.x; c.bg[5] = g1.y; c.bg[6] = g1.z; c.bg[7] = g1.w;
        c.bl[0] = l0.x; c.bl[1] = l0.y; c.bl[2] = l0.z; c.bl[3] = l0.w; c.bl[4] = l1.x; c.bl[5] = l1.y; c.bl[6] = l1.z; c.bl[7] = l1.w; return c; }
    DEVI RowCtx rowctx(int z, int r, bool) const { RowCtx x; x.p = (bf16_t*)((char*)ACT + (size_t)(ubs(z < 0 ? 0 : z) * 256 + r) * DFF * (FP8 ? 1 : 2)); return x; }
    DEVI void storepair(const ColCtx& c, const RowCtx& x, const float (&vg)[8], const float (&vl)[8]) const {
        typedef float f2 __attribute__((ext_vector_type(2))); unsigned w[4]; float af[8];
#pragma unroll
        for (int i = 0; i < 4; ++i) { f2 g = (f2){vg[2 * i], vg[2 * i + 1]} + (f2){c.bg[2 * i], c.bg[2 * i + 1]}, l = (f2){vl[2 * i], vl[2 * i + 1]} + (f2){c.bl[2 * i], c.bl[2 * i + 1]};
            g[0] = fminf(g[0], 7.f); g[1] = fminf(g[1], 7.f); l[0] = __builtin_amdgcn_fmed3f(l[0], -7.f, 7.f); l[1] = __builtin_amdgcn_fmed3f(l[1], -7.f, 7.f);
            const f2 t = g * (-1.702f * 1.44269504f); f2 e; e[0] = __builtin_amdgcn_exp2f(t[0]); e[1] = __builtin_amdgcn_exp2f(t[1]); e = e + 1.f;
            f2 r; r[0] = __builtin_amdgcn_rcpf(e[0]); r[1] = __builtin_amdgcn_rcpf(e[1]);
            const f2 a = (l + 1.f) * g * r; w[i] = pk2(a[0], a[1]); af[2 * i] = a[0]; af[2 * i + 1] = a[1]; }
        if constexpr (FP8) { uint2 o; o.x = pk4_fp8(af[0], af[1], af[2], af[3]); o.y = pk4_fp8(af[4], af[5], af[6], af[7]); *(uint2*)((char*)x.p + c.f0) = o; }
        else { uint4 o; o.x = w[0]; o.y = w[1]; o.z = w[2]; o.w = w[3]; *(uint4*)(x.p + c.f0) = o; } }
    DEVI void storeh(const ColCtx&, const RowCtx&, int, const float (&)[8]) const {}
    DEVI void store(int, int, int, const float (&)[8]) const {}
};
struct FMoe2 {
    static constexpr bool HOIST = true, PAIR = false, RV = true, FP8 = MOE_FP8 != 0; static constexpr int NT = 4;
    const bf16_t* A; const bf16_t* B; int K; const int* cnt; const float* b_down; bf16_t* Y2; const LAS int* ub; int G;
    struct ColCtx { float bd[8]; }; struct RowCtx { bf16_t* p; };
    DEVI int ubs(int e) const { return __builtin_amdgcn_readfirstlane(ub[e]); }
    DEVI int nunits() const { const int n = ubs(NEXP) * NT; return (G & 7) == 0 ? (n + G - 1) / G * G : n; }
    DEVI void unit(int L, int& z, int& pm, int& pn) const { moe_unit<NT, RV>(ub, L, G, z, pm, pn); }
    DEVI int M(int z) const { return z < 0 ? 0 : cnt[z]; }
    DEVI unsigned aoffb(int z, int r) const { return (unsigned)(ubs(z < 0 ? 0 : z) * 256 + r) * (unsigned)(FP8 ? DFF : DFF * 2); }
    DEVI const bf16_t* Bt(int z) const { return (const bf16_t*)((const char*)B + (size_t)(z < 0 ? 0 : z) * DM * DFF * (FP8 ? 1 : 2)); }
    DEVI ColCtx colctx(int z, int c0) const { ColCtx c; const float* bp = b_down + (size_t)(z < 0 ? 0 : z) * DM + c0; const float4 a = *(const float4*)bp, b = *(const float4*)(bp + 4);
        c.bd[0] = a.x; c.bd[1] = a.y; c.bd[2] = a.z; c.bd[3] = a.w; c.bd[4] = b.x; c.bd[5] = b.y; c.bd[6] = b.z; c.bd[7] = b.w; return c; }
    DEVI RowCtx rowctx(int z, int r, bool) const { RowCtx x; x.p = Y2 + (size_t)(ubs(z < 0 ? 0 : z) * 256 + r) * DM; return x; }
    DEVI void storeh(const ColCtx& c, const RowCtx& x, int c0, const float (&v)[8]) const {
        uint4 o; o.x = pk2(v[0] + c.bd[0], v[1] + c.bd[1]); o.y = pk2(v[2] + c.bd[2], v[3] + c.bd[3]); o.z = pk2(v[4] + c.bd[4], v[5] + c.bd[5]); o.w = pk2(v[6] + c.bd[6], v[7] + c.bd[7]);
        *(uint4*)(x.p + c0) = o; }
    DEVI void store(int, int, int, const float (&)[8]) const {}
};

struct MArgs { const float* in[30]; float* out; unsigned char* ws; int ph_lo, ph_hi; };
struct MArgs_in { const float *lam_re, *lam_im, *log_dt, *b_re, *b_im, *c_re, *c_im; };

constexpr int GL_LRS = 0, GL_TOT = 8192, GL_QF = 12288, GL_KF = 21504, GL_QB = 30720, GL_KB = 39936, GL_VT = 49152, GL_PP = 67584, GL_SSQ = 76800, GL_UST = 67584;
constexpr int GL_LD = 72;

struct GlaPtrs { const bf16_t* QK; const bf16_t* V; const bf16_t* R; const float* LR; const float* lr_up; const float* lr_bias; const float* nw; bf16_t* UCH; float* ADEC; bf16_t* SST; bf16_t* MIX; bf16_t* GLT; };

DEVI void gla_gates(const GlaPtrs& G, LAS unsigned char* lds, int h, int d, int to, float (&cf)[8], float (&cb)[8]) {
    const LAS float* LRS = (const LAS float*)(lds + GL_LRS); LAS float* TOT = (LAS float*)(lds + GL_TOT);
#pragma unroll
    for (int dir = 0; dir < 2; ++dir) {
        float up[16];
#pragma unroll
        for (int r = 0; r < 16; ++r) up[r] = G.lr_up[dir * 4096 + r * 256 + h * 64 + d];
        const float bias = G.lr_bias[dir * 256 + h * 64 + d];
        float la[8];
#pragma unroll
        for (int j = 0; j < 8; ++j) { const LAS f32x4* lp = (const LAS f32x4*)(LRS + (to * 8 + j) * 32 + dir * 16); float g = bias;
#pragma unroll
            for (int q = 0; q < 4; ++q) { const f32x4 x = lp[q]; g += x[0] * up[4 * q] + x[1] * up[4 * q + 1] + x[2] * up[4 * q + 2] + x[3] * up[4 * q + 3]; }
            la[j] = logsigmoidf_(g) * (1.f / 16.f); }
        if (dir == 0) { cf[0] = la[0];
#pragma unroll
            for (int j = 1; j < 8; ++j) cf[j] = cf[j - 1] + la[j];
            TOT[(0 * 8 + to) * 64 + d] = cf[7]; }
        else { cb[7] = la[7];
#pragma unroll
            for (int j = 6; j >= 0; --j) cb[j] = cb[j + 1] + la[j];
            TOT[(1 * 8 + to) * 64 + d] = cb[0]; }
    }
}
DEVI void gla_stage(const GlaPtrs& G, LAS unsigned char* lds, int row0, int h, int tid) {
    *(LAS f32x4*)(lds + GL_LRS + tid * 16) = *(const f32x4*)(G.LR + (size_t)row0 * 32 + tid * 4);
    const int ep = tid & 63, to = tid >> 6; unsigned w[8];
#pragma unroll
    for (int j = 0; j < 8; ++j) w[j] = *(const unsigned*)(G.V + (size_t)(row0 + to * 8 + j) * 512 + h * 128 + 2 * ep);
    u32x4 lo, hi;
    lo.x = (w[0] & 0xffffu) | (w[1] << 16); lo.y = (w[2] & 0xffffu) | (w[3] << 16); lo.z = (w[4] & 0xffffu) | (w[5] << 16); lo.w = (w[6] & 0xffffu) | (w[7] << 16);
    hi.x = (w[0] >> 16) | (w[1] & 0xffff0000u); hi.y = (w[2] >> 16) | (w[3] & 0xffff0000u); hi.z = (w[4] >> 16) | (w[5] & 0xffff0000u); hi.w = (w[6] >> 16) | (w[7] & 0xffff0000u);
    *(LAS u32x4*)(lds + GL_VT + ((2 * ep) * GL_LD + to * 8) * 2) = lo;
    *(LAS u32x4*)(lds + GL_VT + ((2 * ep + 1) * GL_LD + to * 8) * 2) = hi;
}

DEVI void gla_a_item(const GlaPtrs& G, LAS unsigned char* lds, int item) {
    int tid = threadIdx.x; asm volatile("" : "+v"(tid));
    const int wave = __builtin_amdgcn_readfirstlane(tid >> 6), lane = tid & 63, d = lane, to = wave, fr = lane & 15, fq = lane >> 4;
    const int ch = item % 68, bh = item / 68, h = bh & 3, b = bh >> 2;
    const int row0 = ch < 4 ? NTOK + b * CTX + ch * 64 : b * SEQ + (ch - 4) * 64;
    gla_stage(G, lds, row0, h, tid);
    bf16_t kk[8];
#pragma unroll
    for (int j = 0; j < 8; ++j) kk[j] = G.QK[(size_t)(row0 + to * 8 + j) * 512 + 256 + h * 64 + d];
    __syncthreads();
    float cf[8], cb[8];
    gla_gates(G, lds, h, d, to, cf, cb);
    __syncthreads();
    const LAS float* TOT = (const LAS float*)(lds + GL_TOT);
    float offf = 0.f, offb = 0.f, totf = 0.f, totb = 0.f;
#pragma unroll
    for (int t = 0; t < 8; ++t) { const float a = TOT[(0 * 8 + t) * 64 + d], c = TOT[(1 * 8 + t) * 64 + d]; totf += a; totb += c; if (t < to) offf += a; if (t > to) offb += c; }
    float of[8], ob[8];
#pragma unroll
    for (int j = 0; j < 8; ++j) { const float kf = bf2f(kk[j]); of[j] = kf * __expf(totf - (cf[j] + offf)); ob[j] = kf * __expf(totb - (cb[j] + offb)); }
    { u32x4 w; w.x = pk2(of[0], of[1]); w.y = pk2(of[2], of[3]); w.z = pk2(of[4], of[5]); w.w = pk2(of[6], of[7]); *(LAS u32x4*)(lds + GL_QF + (d * GL_LD + to * 8) * 2) = w;
      w.x = pk2(ob[0], ob[1]); w.y = pk2(ob[2], ob[3]); w.z = pk2(ob[4], ob[5]); w.w = pk2(ob[6], ob[7]); *(LAS u32x4*)(lds + GL_KF + (d * GL_LD + to * 8) * 2) = w; }
    const int chain_f = bh * 2, step_f = ch < 4 ? ch : ch, step_b = ch < 4 ? 3 - ch : 4 + (67 - ch);
    if (to == 0) { G.ADEC[((size_t)chain_f * 68 + step_f) * 64 + d] = __expf(totf); G.ADEC[((size_t)(chain_f + 1) * 68 + step_b) * 64 + d] = __expf(totb); }
    __syncthreads();
    f32x4 acc[2][4];
#pragma unroll
    for (int dr = 0; dr < 2; ++dr)
#pragma unroll
        for (int dt = 0; dt < 4; ++dt) acc[dr][dt] = (f32x4){0.f, 0.f, 0.f, 0.f};
#pragma unroll
    for (int ks = 0; ks < 2; ++ks) { const bf16x8 a = *(const LAS bf16x8*)(lds + GL_VT + ((wave * 16 + fr) * GL_LD + ks * 32 + fq * 8) * 2);
#pragma unroll
        for (int dt = 0; dt < 4; ++dt) { const bf16x8 b0 = *(const LAS bf16x8*)(lds + GL_QF + ((dt * 16 + fr) * GL_LD + ks * 32 + fq * 8) * 2);
            const bf16x8 b1 = *(const LAS bf16x8*)(lds + GL_KF + ((dt * 16 + fr) * GL_LD + ks * 32 + fq * 8) * 2);
            acc[0][dt] = __builtin_amdgcn_mfma_f32_16x16x32_bf16(a, b0, acc[0][dt], 0, 0, 0); acc[1][dt] = __builtin_amdgcn_mfma_f32_16x16x32_bf16(a, b1, acc[1][dt], 0, 0, 0); } }
#pragma unroll
    for (int dr = 0; dr < 2; ++dr)
#pragma unroll
        for (int dt = 0; dt < 4; ++dt)
#pragma unroll
            for (int rg = 0; rg < 4; ++rg) *(LAS bf16_t*)(lds + GL_UST + ((dr * 128 + wave * 16 + 4 * fq + rg) * 64 + dt * 16 + fr) * 2) = f2bf(acc[dr][dt][rg]);
    __syncthreads();
#pragma unroll
    for (int i = 0; i < 4; ++i) { const int q = tid + i * NTHR, dr = q >> 10, off = (q & 1023) * 8;
        const u32x4 w = *(const LAS u32x4*)(lds + GL_UST + (dr * 8192 + off) * 2);
        const size_t chain = (size_t)chain_f + dr; const int step = dr ? step_b : step_f;
        *(u32x4*)(G.UCH + (chain * 68 + step) * 8192 + off) = w; }
    __syncthreads();
}

DEVI void gla_b_block(const GlaPtrs& G, LAS unsigned char* lds, int blk) {
    int tid = threadIdx.x; asm volatile("" : "+v"(tid));
    const int chain = blk >> 2, e = (blk & 3) * 32 + (tid >> 4), d4 = (tid & 15) * 4;
    for (int i = tid; i < 68 * 16; i += NTHR) ((LAS f32x4*)lds)[i] = ((const f32x4*)(G.ADEC + (size_t)chain * 68 * 64))[i];
    __syncthreads();
    const bf16_t* up = G.UCH + ((size_t)chain * 68 * 128 + e) * 64 + d4;
    bf16_t* sp = G.SST + ((size_t)chain * 64 * 128 + e) * 64 + d4;
    float S0 = 0.f, S1 = 0.f, S2 = 0.f, S3 = 0.f;
    uint2 cur[17], nxt[17];
#pragma unroll
    for (int j = 0; j < 17; ++j) cur[j] = *(const uint2*)(up + (size_t)j * 8192);
#pragma unroll 1
    for (int bt = 0; bt < 4; ++bt) {
        if (bt < 3) {
#pragma unroll
            for (int j = 0; j < 17; ++j) nxt[j] = *(const uint2*)(up + (size_t)((bt + 1) * 17 + j) * 8192); }
#pragma unroll
        for (int j = 0; j < 17; ++j) { const int step = bt * 17 + j;
            if (step >= 4) { uint2 o; o.x = pk2(S0, S1); o.y = pk2(S2, S3); *(uint2*)(sp + (size_t)(step - 4) * 8192) = o; }
            const f32x4 a = *(const LAS f32x4*)(lds + (step * 64 + d4) * 4);
            S0 = a[0] * S0 + __uint_as_float(cur[j].x << 16); S1 = a[1] * S1 + __uint_as_float(cur[j].x & 0xffff0000u);
            S2 = a[2] * S2 + __uint_as_float(cur[j].y << 16); S3 = a[3] * S3 + __uint_as_float(cur[j].y & 0xffff0000u); }
#pragma unroll
        for (int j = 0; j < 17; ++j) cur[j] = nxt[j];
    }
    __syncthreads();
}

DEVI void gla_c_item(const GlaPtrs& G, LAS unsigned char* lds, int item) {
    int tid = threadIdx.x; asm volatile("" : "+v"(tid));
    const int wave = __builtin_amdgcn_readfirstlane(tid >> 6), lane = tid & 63, d = lane, to = wave, fr = lane & 15, fq = lane >> 4;
    const int c = item & 63, bh = item >> 6, h = bh & 3, b = bh >> 2;
    const int row0 = b * SEQ + c * 64;
    gla_stage(G, lds, row0, h, tid);
    bf16_t qq[8], kk[8];
#pragma unroll
    for (int j = 0; j < 8; ++j) { const size_t o = (size_t)(row0 + to * 8 + j) * 512 + h * 64 + d; qq[j] = G.QK[o]; kk[j] = G.QK[o + 256]; }
    __syncthreads();
    float cf[8], cb[8];
    gla_gates(G, lds, h, d, to, cf, cb);
    __syncthreads();
    { const LAS float* TOT = (const LAS float*)(lds + GL_TOT);
      float offf = 0.f, offb = 0.f;
#pragma unroll
      for (int t = 0; t < 8; ++t) { if (t < to) offf += TOT[(0 * 8 + t) * 64 + d]; if (t > to) offb += TOT[(1 * 8 + t) * 64 + d]; }
#pragma unroll
      for (int j = 0; j < 8; ++j) { const float qf = bf2f(qq[j]) * 0.125f, kf = bf2f(kk[j]);
          const float ef = __expf(fmaxf(cf[j] + offf, -80.f)), eb = __expf(fmaxf(cb[j] + offb, -80.f));
          const int o = ((to * 8 + j) * GL_LD + d) * 2;
          *(LAS bf16_t*)(lds + GL_QF + o) = f2bf(qf * ef); *(LAS bf16_t*)(lds + GL_KF + o) = f2bf(kf * __builtin_amdgcn_rcpf(ef));
          *(LAS bf16_t*)(lds + GL_QB + o) = f2bf(qf * eb); *(LAS bf16_t*)(lds + GL_KB + o) = f2bf(kf * __builtin_amdgcn_rcpf(eb)); } }
    __syncthreads();
    { const int ti = wave >> 1;
#pragma unroll
      for (int u = 0; u < 2; ++u) { const int tj = (wave & 1) * 2 + u;
          f32x4 af = (f32x4){0.f, 0.f, 0.f, 0.f}, ab = (f32x4){0.f, 0.f, 0.f, 0.f};
          if (tj <= ti) {
#pragma unroll
              for (int ks = 0; ks < 2; ++ks) { const bf16x8 a = *(const LAS bf16x8*)(lds + GL_KF + ((tj * 16 + fr) * GL_LD + ks * 32 + fq * 8) * 2), bb = *(const LAS bf16x8*)(lds + GL_QF + ((ti * 16 + fr) * GL_LD + ks * 32 + fq * 8) * 2);
                  af = __builtin_amdgcn_mfma_f32_16x16x32_bf16(a, bb, af, 0, 0, 0); } }
          if (tj >= ti) {
#pragma unroll
              for (int ks = 0; ks < 2; ++ks) { const bf16x8 a = *(const LAS bf16x8*)(lds + GL_KB + ((tj * 16 + fr) * GL_LD + ks * 32 + fq * 8) * 2), bb = *(const LAS bf16x8*)(lds + GL_QB + ((ti * 16 + fr) * GL_LD + ks * 32 + fq * 8) * 2);
                  ab = __builtin_amdgcn_mfma_f32_16x16x32_bf16(a, bb, ab, 0, 0, 0); } }
          float p[4];
#pragma unroll
          for (int rg = 0; rg < 4; ++rg) { const int i = ti * 16 + fr, j = tj * 16 + 4 * fq + rg; p[rg] = (j <= i ? af[rg] : 0.f) + (j >= i ? ab[rg] : 0.f); }
          u32x2 w; w.x = pk2(p[0], p[1]); w.y = pk2(p[2], p[3]);
          *(LAS u32x2*)(lds + GL_PP + ((ti * 16 + fr) * GL_LD + tj * 16 + 4 * fq) * 2) = w; } }
    __syncthreads();
    const int tg = wave & 3, eh = wave >> 2;
    f32x4 acc[4];
#pragma unroll
    for (int et = 0; et < 4; ++et) acc[et] = (f32x4){0.f, 0.f, 0.f, 0.f};
    { const bf16_t* Sf = G.SST + ((size_t)(bh * 2) * 64 + c) * 8192; const bf16_t* Sb = G.SST + ((size_t)(bh * 2 + 1) * 64 + (63 - c)) * 8192;
#pragma unroll
      for (int ks = 0; ks < 2; ++ks) {
          const int bo = ((tg * 16 + fr) * GL_LD + ks * 32 + fq * 8) * 2;
          const bf16x8 bP = *(const LAS bf16x8*)(lds + GL_PP + bo), bF = *(const LAS bf16x8*)(lds + GL_QF + bo), bB = *(const LAS bf16x8*)(lds + GL_QB + bo);
#pragma unroll
          for (int et = 0; et < 4; ++et) { const int e = eh * 64 + et * 16 + fr;
              const bf16x8 aV = *(const LAS bf16x8*)(lds + GL_VT + (e * GL_LD + ks * 32 + fq * 8) * 2);
              const bf16x8 aF = *(const bf16x8*)(Sf + e * 64 + ks * 32 + fq * 8), aB = *(const bf16x8*)(Sb + e * 64 + ks * 32 + fq * 8);
              acc[et] = __builtin_amdgcn_mfma_f32_16x16x32_bf16(aV, bP, acc[et], 0, 0, 0);
              acc[et] = __builtin_amdgcn_mfma_f32_16x16x32_bf16(aF, bF, acc[et], 0, 0, 0);
              acc[et] = __builtin_amdgcn_mfma_f32_16x16x32_bf16(aB, bB, acc[et], 0, 0, 0); } } }
    float ss = 0.f;
#pragma unroll
    for (int et = 0; et < 4; ++et) ss += acc[et][0] * acc[et][0] + acc[et][1] * acc[et][1] + acc[et][2] * acc[et][2] + acc[et][3] * acc[et][3];
    ss += __shfl_xor(ss, 16); ss += __shfl_xor(ss, 32);
    LAS float* SSQ = (LAS float*)(lds + GL_SSQ);
    if (fq == 0) SSQ[eh * 64 + tg * 16 + fr] = ss;
    __syncthreads();
    const float rstd = rsqrtf((SSQ[tg * 16 + fr] + SSQ[64 + tg * 16 + fr]) * (1.f / 128.f) + 1e-6f);
    const int tok = row0 + tg * 16 + fr;
#pragma unroll
    for (int et = 0; et < 4; ++et) { const int e = eh * 64 + et * 16 + 4 * fq;
        const uint2 rv = *(const uint2*)(G.R + (size_t)tok * 512 + h * 128 + e); const f32x4 nw = *(const f32x4*)(G.nw + e);
        const float r0 = __uint_as_float(rv.x << 16), r1 = __uint_as_float(rv.x & 0xffff0000u), r2 = __uint_as_float(rv.y << 16), r3 = __uint_as_float(rv.y & 0xffff0000u);
        uint2 w; w.x = pk2(acc[et][0] * rstd * nw[0] * siluf_(r0), acc[et][1] * rstd * nw[1] * siluf_(r1)); w.y = pk2(acc[et][2] * rstd * nw[2] * siluf_(r2), acc[et][3] * rstd * nw[3] * siluf_(r3));
        *(uint2*)(G.MIX + (size_t)tok * DM + h * 128 + e) = w; }
    __syncthreads();
}

constexpr int GL_SF = 77312, GL_SB = 95744, GL_RQ = 114176, GL_RK = 122368;

struct GateW { float up[2][16]; float bias[2]; };
DEVI GateW gla_gatew(const GlaPtrs& G, int h, int d) { GateW w;
#pragma unroll
    for (int dir = 0; dir < 2; ++dir) {
#pragma unroll
        for (int r = 0; r < 16; ++r) w.up[dir][r] = G.lr_up[dir * 4096 + r * 256 + h * 64 + d];
        w.bias[dir] = G.lr_bias[dir * 256 + h * 64 + d]; }
    return w; }
DEVI void gla_gates2(const GateW& W, LAS unsigned char* lds, int d, int to, float (&cf)[8], float (&cb)[8]) {
    const LAS float* LRS = (const LAS float*)(lds + GL_LRS); LAS float* TOT = (LAS float*)(lds + GL_TOT);
#pragma unroll
    for (int dir = 0; dir < 2; ++dir) {
        float la[8];
#pragma unroll
        for (int j = 0; j < 8; ++j) { const LAS f32x4* lp = (const LAS f32x4*)(LRS + (to * 8 + j) * 32 + dir * 16); float g = W.bias[dir];
#pragma unroll
            for (int q = 0; q < 4; ++q) { const f32x4 x = lp[q]; g += x[0] * W.up[dir][4 * q] + x[1] * W.up[dir][4 * q + 1] + x[2] * W.up[dir][4 * q + 2] + x[3] * W.up[dir][4 * q + 3]; }
            la[j] = logsigmoidf_(g) * (1.f / 16.f); }
        if (dir == 0) { cf[0] = la[0];
#pragma unroll
            for (int j = 1; j < 8; ++j) cf[j] = cf[j - 1] + la[j];
            TOT[(0 * 8 + to) * 64 + d] = cf[7]; }
        else { cb[7] = la[7];
#pragma unroll
            for (int j = 6; j >= 0; --j) cb[j] = cb[j + 1] + la[j];
            TOT[(1 * 8 + to) * 64 + d] = cb[0]; }
    }
}
struct GIn { f32x4 lr; unsigned vv[8]; u32x4 kraw; u32x4 qraw; u32x4 sraw[4]; u32x2 rr[4]; };
template <bool WQ> DEVI void gla_load_common(const GlaPtrs& G, int row0, int h, int tid, GIn& I) {
    I.lr = *(const f32x4*)(G.LR + (size_t)row0 * 32 + tid * 4);
    const int ep = tid & 63, to = tid >> 6;
#pragma unroll
    for (int j = 0; j < 8; ++j) I.vv[j] = *(const unsigned*)(G.V + (size_t)(row0 + to * 8 + j) * 512 + h * 128 + 2 * ep);
    const int tok = tid >> 3, chunk = tid & 7;
    I.kraw = *(const u32x4*)(G.QK + (size_t)(row0 + tok) * 512 + 256 + h * 64 + chunk * 8);
    if (WQ) I.qraw = *(const u32x4*)(G.QK + (size_t)(row0 + tok) * 512 + h * 64 + chunk * 8);
}
template <bool WQ> DEVI void gla_stage_common(LAS unsigned char* lds, int tid, const GIn& I) {
    *(LAS f32x4*)(lds + GL_LRS + tid * 16) = I.lr;
    const int ep = tid & 63, to = tid >> 6; const unsigned* w = I.vv;
    u32x4 lo, hi;
    lo.x = (w[0] & 0xffffu) | (w[1] << 16); lo.y = (w[2] & 0xffffu) | (w[3] << 16); lo.z = (w[4] & 0xffffu) | (w[5] << 16); lo.w = (w[6] & 0xffffu) | (w[7] << 16);
    hi.x = (w[0] >> 16) | (w[1] & 0xffff0000u); hi.y = (w[2] >> 16) | (w[3] & 0xffff0000u); hi.z = (w[4] >> 16) | (w[5] & 0xffff0000u); hi.w = (w[6] >> 16) | (w[7] & 0xffff0000u);
    *(LAS u32x4*)(lds + GL_VT + ((2 * ep) * GL_LD + to * 8) * 2) = lo;
    *(LAS u32x4*)(lds + GL_VT + ((2 * ep + 1) * GL_LD + to * 8) * 2) = hi;
    *(LAS u32x4*)(lds + GL_RK + tid * 16) = I.kraw;
    if (WQ) *(LAS u32x4*)(lds + GL_RQ + tid * 16) = I.qraw;
}

DEVI void gla_a_phase(const GlaPtrs& G, LAS unsigned char* lds, int bid, int Gsz) {
    int tid = threadIdx.x; asm volatile("" : "+v"(tid));
    const int wave = __builtin_amdgcn_readfirstlane(tid >> 6), lane = tid & 63, d = lane, to = wave, fr = lane & 15, fq = lane >> 4;
    constexpr int NIT = NB * 4 * 68;
    if (bid >= NIT) return;
#define GA_ROW0(it) (((it) % 68) < 4 ? NTOK + (((it) / 68) >> 2) * CTX + ((it) % 68) * 64 : (((it) / 68) >> 2) * SEQ + (((it) % 68) - 4) * 64)
    GIn cur; gla_load_common<true>(G, GA_ROW0(bid), (bid / 68) & 3, tid, cur);
    int hw = -1; GateW W;
    for (int item = bid; item < NIT; item += Gsz) {
        const int ch = item % 68, bh = item / 68, h = bh & 3;
        if (h != hw) { W = gla_gatew(G, h, d); hw = h; }
        gla_stage_common<true>(lds, tid, cur);
        __syncthreads();
        { const int nit = item + Gsz; if (nit < NIT) gla_load_common<true>(G, GA_ROW0(nit), (nit / 68) & 3, tid, cur); }
        float cf[8], cb[8];
        gla_gates2(W, lds, d, to, cf, cb);
        __syncthreads();
        const LAS float* TOT = (const LAS float*)(lds + GL_TOT);
        float offf = 0.f, offb = 0.f, totf = 0.f, totb = 0.f;
#pragma unroll
        for (int t = 0; t < 8; ++t) { const float a = TOT[(0 * 8 + t) * 64 + d], c = TOT[(1 * 8 + t) * 64 + d]; totf += a; totb += c; if (t < to) offf += a; if (t > to) offb += c; }
        float of[8], ob[8];
        bf16_t* gt = G.GLT + ((size_t)(bh * 64 + (ch - 4)) * 4) * 4096;
#pragma unroll
        for (int j = 0; j < 8; ++j) { const int ro = ((to * 8 + j) * 64 + d) * 2; const float kf = bf2f(*(const LAS bf16_t*)(lds + GL_RK + ro));
            of[j] = kf * __expf(totf - (cf[j] + offf)); ob[j] = kf * __expf(totb - (cb[j] + offb));
            if (ch >= 4) { const float qf = bf2f(*(const LAS bf16_t*)(lds + GL_RQ + ro)) * 0.125f;
                const float ef = __expf(fmaxf(cf[j] + offf, -80.f)), eb = __expf(fmaxf(cb[j] + offb, -80.f)); const int go = (to * 8 + j) * 64 + d;
                gt[go] = f2bf(qf * ef); gt[4096 + go] = f2bf(kf * __builtin_amdgcn_rcpf(ef)); gt[8192 + go] = f2bf(qf * eb); gt[12288 + go] = f2bf(kf * __builtin_amdgcn_rcpf(eb)); } }
        { u32x4 w; w.x = pk2(of[0], of[1]); w.y = pk2(of[2], of[3]); w.z = pk2(of[4], of[5]); w.w = pk2(of[6], of[7]); *(LAS u32x4*)(lds + GL_QF + (d * GL_LD + to * 8) * 2) = w;
          w.x = pk2(ob[0], ob[1]); w.y = pk2(ob[2], ob[3]); w.z = pk2(ob[4], ob[5]); w.w = pk2(ob[6], ob[7]); *(LAS u32x4*)(lds + GL_KF + (d * GL_LD + to * 8) * 2) = w; }
        const int chain_f = bh * 2, step_f = ch, step_b = ch < 4 ? 3 - ch : 71 - ch;
        if (to == 0) { G.ADEC[((size_t)chain_f * 68 + step_f) * 64 + d] = __expf(totf); G.ADEC[((size_t)(chain_f + 1) * 68 + step_b) * 64 + d] = __expf(totb); }
        __syncthreads();
        f32x4 acc[2][4];
#pragma unroll
        for (int dr = 0; dr < 2; ++dr)
#pragma unroll
            for (int dt = 0; dt < 4; ++dt) acc[dr][dt] = (f32x4){0.f, 0.f, 0.f, 0.f};
#pragma unroll
        for (int ks = 0; ks < 2; ++ks) { const bf16x8 a = *(const LAS bf16x8*)(lds + GL_VT + ((wave * 16 + fr) * GL_LD + ks * 32 + fq * 8) * 2);
#pragma unroll
            for (int dt = 0; dt < 4; ++dt) { const bf16x8 b0 = *(const LAS bf16x8*)(lds + GL_QF + ((dt * 16 + fr) * GL_LD + ks * 32 + fq * 8) * 2);
                const bf16x8 b1 = *(const LAS bf16x8*)(lds + GL_KF + ((dt * 16 + fr) * GL_LD + ks * 32 + fq * 8) * 2);
                acc[0][dt] = __builtin_amdgcn_mfma_f32_16x16x32_bf16(a, b0, acc[0][dt], 0, 0, 0); acc[1][dt] = __builtin_amdgcn_mfma_f32_16x16x32_bf16(a, b1, acc[1][dt], 0, 0, 0); } }
#pragma unroll
        for (int dr = 0; dr < 2; ++dr)
#pragma unroll
            for (int dt = 0; dt < 4; ++dt)
#pragma unroll
                for (int rg = 0; rg < 4; ++rg) *(LAS bf16_t*)(lds + GL_UST + ((dr * 128 + wave * 16 + 4 * fq + rg) * 64 + dt * 16 + fr) * 2) = f2bf(acc[dr][dt][rg]);
        __syncthreads();
#pragma unroll
        for (int i = 0; i < 4; ++i) { const int q = tid + i * NTHR, dr = q >> 10, off = (q & 1023) * 8;
            const u32x4 w = *(const LAS u32x4*)(lds + GL_UST + (dr * 8192 + off) * 2);
            const size_t chain = (size_t)chain_f + dr; const int step = dr ? step_b : step_f;
            *(u32x4*)(G.UCH + (chain * 68 + step) * 8192 + off) = w; }
    }
#undef GA_ROW0
    __syncthreads();
}

struct CIn { unsigned vv[8]; u32x4 tl[4]; u32x4 sraw[4]; u32x2 rr[4]; };
DEVI void gla_c_load(const GlaPtrs& G, int item, int tid, int wave, int fr, int fq, CIn& I) {
    const int c = item & 63, bh = item >> 6, h = bh & 3, b = bh >> 2, row0 = b * SEQ + c * 64;
    const int ep = tid & 63, to = tid >> 6;
#pragma unroll
    for (int j = 0; j < 8; ++j) I.vv[j] = *(const unsigned*)(G.V + (size_t)(row0 + to * 8 + j) * 512 + h * 128 + 2 * ep);
    const bf16_t* gt = G.GLT + (size_t)item * 4 * 4096;
#pragma unroll
    for (int t = 0; t < 4; ++t) I.tl[t] = *(const u32x4*)(gt + t * 4096 + tid * 8);
    const bf16_t* Sf = G.SST + ((size_t)(bh * 2) * 64 + c) * 8192; const bf16_t* Sb = G.SST + ((size_t)(bh * 2 + 1) * 64 + (63 - c)) * 8192;
    I.sraw[0] = *(const u32x4*)(Sf + tid * 8); I.sraw[1] = *(const u32x4*)(Sf + (tid + NTHR) * 8); I.sraw[2] = *(const u32x4*)(Sb + tid * 8); I.sraw[3] = *(const u32x4*)(Sb + (tid + NTHR) * 8);
    const int tg = wave & 3, eh = wave >> 2, tok = row0 + tg * 16 + fr;
#pragma unroll
    for (int et = 0; et < 4; ++et) I.rr[et] = *(const u32x2*)(G.R + (size_t)tok * 512 + h * 128 + eh * 64 + et * 16 + 4 * fq);
}
DEVI void gla_c_phase(const GlaPtrs& G, LAS unsigned char* lds, int bid, int Gsz) {
    int tid = threadIdx.x; asm volatile("" : "+v"(tid));
    const int wave = __builtin_amdgcn_readfirstlane(tid >> 6), lane = tid & 63, fr = lane & 15, fq = lane >> 4;
    constexpr int NIT = NB * 4 * 64;
    if (bid >= NIT) return;
    const int tg = wave & 3, eh = wave >> 2;
    f32x4 nwv[4];
#pragma unroll
    for (int et = 0; et < 4; ++et) nwv[et] = *(const f32x4*)(G.nw + eh * 64 + et * 16 + 4 * fq);
    CIn cur; gla_c_load(G, bid, tid, wave, fr, fq, cur);
    for (int item = bid; item < NIT; item += Gsz) {
        const int c = item & 63, bh = item >> 6, h = bh & 3, b = bh >> 2, row0 = b * SEQ + c * 64;
        { const int ep = tid & 63, to = tid >> 6; const unsigned* w = cur.vv;
          u32x4 lo, hi;
          lo.x = (w[0] & 0xffffu) | (w[1] << 16); lo.y = (w[2] & 0xffffu) | (w[3] << 16); lo.z = (w[4] & 0xffffu) | (w[5] << 16); lo.w = (w[6] & 0xffffu) | (w[7] << 16);
          hi.x = (w[0] >> 16) | (w[1] & 0xffff0000u); hi.y = (w[2] >> 16) | (w[3] & 0xffff0000u); hi.z = (w[4] >> 16) | (w[5] & 0xffff0000u); hi.w = (w[6] >> 16) | (w[7] & 0xffff0000u);
          *(LAS u32x4*)(lds + GL_VT + ((2 * ep) * GL_LD + to * 8) * 2) = lo; *(LAS u32x4*)(lds + GL_VT + ((2 * ep + 1) * GL_LD + to * 8) * 2) = hi; }
        { const int r0 = tid >> 3, ck = tid & 7;
          *(LAS u32x4*)(lds + GL_QF + (r0 * GL_LD + ck * 8) * 2) = cur.tl[0]; *(LAS u32x4*)(lds + GL_KF + (r0 * GL_LD + ck * 8) * 2) = cur.tl[1];
          *(LAS u32x4*)(lds + GL_QB + (r0 * GL_LD + ck * 8) * 2) = cur.tl[2]; *(LAS u32x4*)(lds + GL_KB + (r0 * GL_LD + ck * 8) * 2) = cur.tl[3];
          *(LAS u32x4*)(lds + GL_SF + (r0 * GL_LD + ck * 8) * 2) = cur.sraw[0]; *(LAS u32x4*)(lds + GL_SF + ((r0 + 64) * GL_LD + ck * 8) * 2) = cur.sraw[1];
          *(LAS u32x4*)(lds + GL_SB + (r0 * GL_LD + ck * 8) * 2) = cur.sraw[2]; *(LAS u32x4*)(lds + GL_SB + ((r0 + 64) * GL_LD + ck * 8) * 2) = cur.sraw[3]; }
        u32x2 rcur[4];
#pragma unroll
        for (int et = 0; et < 4; ++et) rcur[et] = cur.rr[et];
        __syncthreads();
        { const int nit = item + Gsz; if (nit < NIT) gla_c_load(G, nit, tid, wave, fr, fq, cur); }
        { const int ti = wave >> 1;
#pragma unroll
          for (int u = 0; u < 2; ++u) { const int tj = (wave & 1) * 2 + u;
              f32x4 af = (f32x4){0.f, 0.f, 0.f, 0.f}, ab = (f32x4){0.f, 0.f, 0.f, 0.f};
              if (tj <= ti) {
#pragma unroll
                  for (int ks = 0; ks < 2; ++ks) { const bf16x8 a = *(const LAS bf16x8*)(lds + GL_KF + ((tj * 16 + fr) * GL_LD + ks * 32 + fq * 8) * 2), bb = *(const LAS bf16x8*)(lds + GL_QF + ((ti * 16 + fr) * GL_LD + ks * 32 + fq * 8) * 2);
                      af = __builtin_amdgcn_mfma_f32_16x16x32_bf16(a, bb, af, 0, 0, 0); } }
              if (tj >= ti) {
#pragma unroll
                  for (int ks = 0; ks < 2; ++ks) { const bf16x8 a = *(const LAS bf16x8*)(lds + GL_KB + ((tj * 16 + fr) * GL_LD + ks * 32 + fq * 8) * 2), bb = *(const LAS bf16x8*)(lds + GL_QB + ((ti * 16 + fr) * GL_LD + ks * 32 + fq * 8) * 2);
                      ab = __builtin_amdgcn_mfma_f32_16x16x32_bf16(a, bb, ab, 0, 0, 0); } }
              float p[4];
#pragma unroll
              for (int rg = 0; rg < 4; ++rg) { const int i = ti * 16 + fr, j = tj * 16 + 4 * fq + rg; p[rg] = (j <= i ? af[rg] : 0.f) + (j >= i ? ab[rg] : 0.f); }
              u32x2 w; w.x = pk2(p[0], p[1]); w.y = pk2(p[2], p[3]);
              *(LAS u32x2*)(lds + GL_PP + ((ti * 16 + fr) * GL_LD + tj * 16 + 4 * fq) * 2) = w; } }
        __syncthreads();
        f32x4 acc[4];
#pragma unroll
        for (int et = 0; et < 4; ++et) acc[et] = (f32x4){0.f, 0.f, 0.f, 0.f};
#pragma unroll
        for (int ks = 0; ks < 2; ++ks) {
            const int bo = ((tg * 16 + fr) * GL_LD + ks * 32 + fq * 8) * 2;
            const bf16x8 bP = *(const LAS bf16x8*)(lds + GL_PP + bo), bF = *(const LAS bf16x8*)(lds + GL_QF + bo), bB = *(const LAS bf16x8*)(lds + GL_QB + bo);
#pragma unroll
            for (int et = 0; et < 4; ++et) { const int ao = ((eh * 64 + et * 16 + fr) * GL_LD + ks * 32 + fq * 8) * 2;
                const bf16x8 aV = *(const LAS bf16x8*)(lds + GL_VT + ao), aF = *(const LAS bf16x8*)(lds + GL_SF + ao), aB = *(const LAS bf16x8*)(lds + GL_SB + ao);
                acc[et] = __builtin_amdgcn_mfma_f32_16x16x32_bf16(aV, bP, acc[et], 0, 0, 0);
                acc[et] = __builtin_amdgcn_mfma_f32_16x16x32_bf16(aF, bF, acc[et], 0, 0, 0);
                acc[et] = __builtin_amdgcn_mfma_f32_16x16x32_bf16(aB, bB, acc[et], 0, 0, 0); } }
        float ss = 0.f;
#pragma unroll
        for (int et = 0; et < 4; ++et) ss += acc[et][0] * acc[et][0] + acc[et][1] * acc[et][1] + acc[et][2] * acc[et][2] + acc[et][3] * acc[et][3];
        ss += __shfl_xor(ss, 16); ss += __shfl_xor(ss, 32);
        LAS float* SSQ = (LAS float*)(lds + GL_SSQ);
        if (fq == 0) SSQ[eh * 64 + tg * 16 + fr] = ss;
        __syncthreads();
        const float rstd = rsqrtf((SSQ[tg * 16 + fr] + SSQ[64 + tg * 16 + fr]) * (1.f / 128.f) + 1e-6f);
        const int tok = row0 + tg * 16 + fr;
#pragma unroll
        for (int et = 0; et < 4; ++et) { const int e = eh * 64 + et * 16 + 4 * fq; const u32x2 rv = rcur[et];
            const float r0 = __uint_as_float(rv.x << 16), r1 = __uint_as_float(rv.x & 0xffff0000u), r2 = __uint_as_float(rv.y << 16), r3 = __uint_as_float(rv.y & 0xffff0000u);
            uint2 w; w.x = pk2(acc[et][0] * rstd * nwv[et][0] * siluf_(r0), acc[et][1] * rstd * nwv[et][1] * siluf_(r1)); w.y = pk2(acc[et][2] * rstd * nwv[et][2] * siluf_(r2), acc[et][3] * rstd * nwv[et][3] * siluf_(r3));
            *(uint2*)(G.MIX + (size_t)tok * DM + h * 128 + e) = w; }
    }
    __syncthreads();
}

DEVI void s5w_build(const MArgs_in& in, unsigned char* ws, LAS unsigned char* lds, int g) {
    LAS float* LP = (LAS float*)lds;
    LAS float* BB = LP + 2 * 17 * 64 * 2;
    LAS float* CC = BB + 2 * 64 * 16 * 2;
    LAS float* KK = CC + 2 * 16 * 64 * 2;
    LAS float* CO = KK + 2 * 16 * 256;
    const int tid = threadIdx.x;
    S5P* P = (S5P*)(ws + OFF_S5P);
    if (tid < 128) { const int p = tid & 63, d = tid >> 6; const int i = (d * 32 + g) * 64 + p;
        const double dt = exp((double)in.log_dt[d * 32 + g]), lr = in.lam_re[i], li = in.lam_im[i];
        const double mag = exp(lr * dt), ar = mag * cos(li * dt), ai = mag * sin(li * dt);
        { const double nr = ar - 1.0, ni = ai, den = lr * lr + li * li; CO[(d * 64 + p) * 2] = (float)((nr * lr + ni * li) / den); CO[(d * 64 + p) * 2 + 1] = (float)((ni * lr - nr * li) / den); }
        double pr = 1.0, pi = 0.0;
        for (int n = 0; n < 17; ++n) { LP[((d * 17 + n) * 64 + p) * 2] = (float)pr; LP[((d * 17 + n) * 64 + p) * 2 + 1] = (float)pi;
            if (n == 16) { P->lam16[d][g][p][0] = (float)pr; P->lam16[d][g][p][1] = (float)pi; }
            const double tr = pr * ar - pi * ai, ti = pr * ai + pi * ar; pr = tr; pi = ti; } }
    for (int t = tid; t < 2 * 16 * 64; t += NTHR) { const int p = t & 63, h = (t >> 6) & 15, d = t >> 10; const size_t ix = (((size_t)d * 32 + g) * 16 + h) * 64 + p;
        CC[((d * 16 + h) * 64 + p) * 2] = in.c_re[ix]; CC[((d * 16 + h) * 64 + p) * 2 + 1] = in.c_im[ix]; }
    __syncthreads();
    for (int t = tid; t < 2 * 64 * 16; t += NTHR) { const int h = t & 15, p = (t >> 4) & 63, d = t >> 10; const size_t ix = (((size_t)d * 32 + g) * 64 + p) * 16 + h;
        const float br = in.b_re[ix], bi = in.b_im[ix], cr = CO[(d * 64 + p) * 2], ci = CO[(d * 64 + p) * 2 + 1];
        BB[((d * 64 + p) * 16 + h) * 2] = cr * br - ci * bi; BB[((d * 64 + p) * 16 + h) * 2 + 1] = cr * bi + ci * br; }
    __syncthreads();
    { const int h = tid & 15, n = (tid >> 4) & 15, d = tid >> 8; float acc[16];
#pragma unroll
      for (int q = 0; q < 16; ++q) acc[q] = 0.f;
      for (int p = 0; p < 64; ++p) { const float cr = CC[((d * 16 + h) * 64 + p) * 2], ci = CC[((d * 16 + h) * 64 + p) * 2 + 1], lr = LP[((d * 17 + n) * 64 + p) * 2], li = LP[((d * 17 + n) * 64 + p) * 2 + 1];
          const float tr = cr * lr - ci * li, ti = cr * li + ci * lr; const LAS f32x4* bb = (const LAS f32x4*)(BB + ((d * 64 + p) * 16) * 2);
#pragma unroll
          for (int q = 0; q < 8; ++q) { const f32x4 x = bb[q]; acc[2 * q] += tr * x[0] - ti * x[1]; acc[2 * q + 1] += tr * x[2] - ti * x[3]; } }
#pragma unroll
      for (int q = 0; q < 16; ++q) KK[(d * 16 + n) * 256 + h * 16 + q] = acc[q]; }
    __syncthreads();
    bf16_t* BF = (bf16_t*)(ws + OFF_S5BF) + (size_t)g * 256 * 256;
    for (int t = tid; t < 256 * 32; t += NTHR) { const int k8 = t & 31, row = t >> 5, p = (row & 127) >> 1, im = row & 1, d = row >> 7; float o[8];
#pragma unroll
        for (int q = 0; q < 8; ++q) { const int k = k8 * 8 + q, j = k >> 4, hp = k & 15, pw = d ? j : 15 - j;
            const float lr = LP[((d * 17 + pw) * 64 + p) * 2], li = LP[((d * 17 + pw) * 64 + p) * 2 + 1], br = BB[((d * 64 + p) * 16 + hp) * 2], bi = BB[((d * 64 + p) * 16 + hp) * 2 + 1];
            o[q] = im ? lr * bi + li * br : lr * br - li * bi; }
        uint4 w; w.x = pk2(o[0], o[1]); w.y = pk2(o[2], o[3]); w.z = pk2(o[4], o[5]); w.w = pk2(o[6], o[7]);
        *(uint4*)(BF + (size_t)row * 256 + k8 * 8) = w; }
    bf16_t* BY = (bf16_t*)(ws + OFF_S5BY) + (size_t)g * 256 * 512;
    for (int t = tid; t < 256 * 64; t += NTHR) { const int k8 = t & 63, n = t >> 6, i = n >> 4, h = n & 15; float o[8];
#pragma unroll
        for (int q = 0; q < 8; ++q) { const int k = k8 * 8 + q; float v;
            if (k < 256) { const int j = k >> 4, hp = k & 15; v = 0.f; if (i >= j) v += KK[(0 * 16 + (i - j)) * 256 + h * 16 + hp]; if (j >= i) v += KK[(1 * 16 + (j - i)) * 256 + h * 16 + hp]; }
            else { const int d = (k - 256) >> 7, r = (k - 256) & 127, p = r >> 1, im = r & 1, pw = d ? 16 - i : i + 1;
                const float cr = CC[((d * 16 + h) * 64 + p) * 2], ci = CC[((d * 16 + h) * 64 + p) * 2 + 1], lr = LP[((d * 17 + pw) * 64 + p) * 2], li = LP[((d * 17 + pw) * 64 + p) * 2 + 1];
                v = im ? -(cr * li + ci * lr) : cr * lr - ci * li; }
            o[q] = v; }
        uint4 w; w.x = pk2(o[0], o[1]); w.y = pk2(o[2], o[3]); w.z = pk2(o[4], o[5]); w.w = pk2(o[6], o[7]);
        *(uint4*)(BY + (size_t)n * 512 + k8 * 8) = w; }
    __syncthreads();
}
struct ProbS5F {
    static constexpr bool HOIST = false, PAIR = false, FP8 = false;
    const bf16_t* A; const bf16_t* B; int K; float* F;
    DEVI int nunits() const { return 32 * 9; }
    DEVI void unit(int L, int& z, int& pm, int& pn) const { z = L & 31; pm = L >> 5; pn = 0; }
    DEVI int M(int) const { return 2304; }
    DEVI unsigned aoffb(int z, int r) const { return (unsigned)(z * 2304 + r) * 1024u; }
    DEVI const bf16_t* Bt(int z) const { return B + (size_t)z * 256 * 256; }
    DEVI void store(int z, int r, int c0, const float (&v)[8]) const { float* p = F + ((size_t)z * 2304 + r) * 256 + c0; *(float4*)p = make_float4(v[0], v[1], v[2], v[3]); *(float4*)(p + 4) = make_float4(v[4], v[5], v[6], v[7]); }
};
struct ProbS5Y {
    static constexpr bool HOIST = false, PAIR = false, FP8 = false;
    const bf16_t* A; const bf16_t* B; int K; const float* dvec; bf16_t* YS;
    DEVI int nunits() const { return 32 * 8; }
    DEVI void unit(int L, int& z, int& pm, int& pn) const { z = L & 31; pm = L >> 5; pn = 0; }
    DEVI int M(int) const { return 2048; }
    DEVI unsigned aoffb(int z, int r) const { return (unsigned)(z * 2304 + r) * 1024u; }
    DEVI const bf16_t* Bt(int z) const { return B + (size_t)z * 256 * 512; }
    DEVI void store(int z, int r, int c0, const float (&v)[8]) const {
        const int b = r >> 8, sq = ((r & 255) << 4) + (c0 >> 4), gc = sq >> 6, gr = sq & 63, tok = b * SEQ + gr * 64 + gc, ch = z * 16 + (c0 & 15);
        const uint4 uv = *(const uint4*)(A + ((size_t)z * 2304 + r) * 512 + c0); const unsigned uw[4] = {uv.x, uv.y, uv.z, uv.w};
        const float4 d0 = *(const float4*)(dvec + ch), d1 = *(const float4*)(dvec + ch + 4); const float dd[8] = {d0.x, d0.y, d0.z, d0.w, d1.x, d1.y, d1.z, d1.w}; float o[8];
#pragma unroll
        for (int j = 0; j < 4; ++j) { o[2 * j] = gelu_tanh(v[2 * j] + dd[2 * j] * __uint_as_float(uw[j] << 16)); o[2 * j + 1] = gelu_tanh(v[2 * j + 1] + dd[2 * j + 1] * __uint_as_float(uw[j] & 0xffff0000u)); }
        uint4 w; w.x = pk2(o[0], o[1]); w.y = pk2(o[2], o[3]); w.z = pk2(o[4], o[5]); w.w = pk2(o[6], o[7]);
        *(uint4*)(YS + (size_t)tok * 512 + ch) = w;
    }
};
typedef float f32x2_t __attribute__((ext_vector_type(2)));
DEVI int s5_row(int st, int b, int dir) { return st < 16 ? 2048 + b * 16 + (dir ? 15 - st : st) : b * 256 + (dir ? 271 - st : st - 16); }
DEVI void s5_carry(const float* __restrict__ F, bf16_t* __restrict__ U2, const S5P* __restrict__ P, int id, int lane) {
    const int g = id & 31, dir = (id >> 5) & 1, b = id >> 6;
    const float l16r = P->lam16[dir][g][lane][0], l16i = P->lam16[dir][g][lane][1];
    const float* Fg = F + (size_t)g * 2304 * 256 + dir * 128 + 2 * lane;
    bf16_t* Ug = U2 + (size_t)g * 2304 * 512 + 256 + dir * 128 + 2 * lane;
    float hr = 0.f, hi = 0.f;
    f32x2_t b0[17], b1[17], b2[17], b3[17];
#define S5_LOAD(buf, bt) do { _Pragma("unroll") for (int j = 0; j < 17; ++j) buf[j] = *(const f32x2_t*)(Fg + (size_t)s5_row((bt) * 17 + j, b, dir) * 256); } while (0)
#define S5_PROC(buf, bt) do { _Pragma("unroll") for (int j = 0; j < 17; ++j) { const int st = (bt) * 17 + j; \
        if (st >= 16) *(unsigned*)(Ug + (size_t)s5_row(st, b, dir) * 512) = pk2(hr, hi); \
        const float tr = l16r * hr - l16i * hi + buf[j][0], ti = l16r * hi + l16i * hr + buf[j][1]; hr = tr; hi = ti; } } while (0)
    S5_LOAD(b0, 0); S5_LOAD(b1, 1); S5_LOAD(b2, 2);
#pragma unroll 1
    for (int bt = 0; bt < 16; bt += 4) {
        S5_LOAD(b3, bt + 3); S5_PROC(b0, bt);
        if (bt + 4 < 16) S5_LOAD(b0, bt + 4);
        S5_PROC(b1, bt + 1);
        if (bt + 5 < 16) S5_LOAD(b1, bt + 5);
        S5_PROC(b2, bt + 2);
        if (bt + 6 < 16) S5_LOAD(b2, bt + 6);
        S5_PROC(b3, bt + 3);
    }
#undef S5_LOAD
#undef S5_PROC
}
DEVI void ph_scans(const GlaPtrs& G, const float* __restrict__ F, bf16_t* __restrict__ U2, const S5P* __restrict__ P, LAS unsigned char* lds, int blk, bool do_gla, bool do_s5) {
    int tid = threadIdx.x; asm volatile("" : "+v"(tid));
    const int wave = __builtin_amdgcn_readfirstlane(tid >> 6), lane = tid & 63;
    const int chain = blk >> 2;
    if (do_gla) for (int i = tid; i < 68 * 16; i += NTHR) ((LAS f32x4*)lds)[i] = ((const f32x4*)(G.ADEC + (size_t)chain * 68 * 64))[i];
    __syncthreads();
    if (wave < 4) { if (do_gla) {
        const int e = (blk & 3) * 32 + (tid >> 3), d8 = (tid & 7) * 8;
        const bf16_t* up = G.UCH + ((size_t)chain * 68 * 128 + e) * 64 + d8;
        bf16_t* sp = G.SST + ((size_t)chain * 64 * 128 + e) * 64 + d8;
        float S[8];
#pragma unroll
        for (int q = 0; q < 8; ++q) S[q] = 0.f;
        u32x4 cur[17], nxt[17];
#pragma unroll
        for (int j = 0; j < 17; ++j) cur[j] = *(const u32x4*)(up + (size_t)j * 8192);
#pragma unroll 1
        for (int bt = 0; bt < 4; ++bt) {
            if (bt < 3) {
#pragma unroll
                for (int j = 0; j < 17; ++j) nxt[j] = *(const u32x4*)(up + (size_t)((bt + 1) * 17 + j) * 8192); }
#pragma unroll
            for (int j = 0; j < 17; ++j) { const int step = bt * 17 + j;
                if (step >= 4) { u32x4 o; o.x = pk2(S[0], S[1]); o.y = pk2(S[2], S[3]); o.z = pk2(S[4], S[5]); o.w = pk2(S[6], S[7]); *(u32x4*)(sp + (size_t)(step - 4) * 8192) = o; }
                const f32x4 a0 = *(const LAS f32x4*)(lds + (step * 64 + d8) * 4), a1 = *(const LAS f32x4*)(lds + (step * 64 + d8 + 4) * 4);
                const unsigned w0 = cur[j].x, w1 = cur[j].y, w2 = cur[j].z, w3 = cur[j].w;
                S[0] = a0[0] * S[0] + __uint_as_float(w0 << 16); S[1] = a0[1] * S[1] + __uint_as_float(w0 & 0xffff0000u);
                S[2] = a0[2] * S[2] + __uint_as_float(w1 << 16); S[3] = a0[3] * S[3] + __uint_as_float(w1 & 0xffff0000u);
                S[4] = a1[0] * S[4] + __uint_as_float(w2 << 16); S[5] = a1[1] * S[5] + __uint_as_float(w2 & 0xffff0000u);
                S[6] = a1[2] * S[6] + __uint_as_float(w3 << 16); S[7] = a1[3] * S[7] + __uint_as_float(w3 & 0xffff0000u); }
#pragma unroll
            for (int j = 0; j < 17; ++j) cur[j] = nxt[j];
        } } }
    else if (wave < 6) { if (do_s5) s5_carry(F, U2, P, blk * 2 + (wave - 4), lane); }
    __syncthreads();
}


constexpr int NPH = 12;

struct WItem { const float* src; bf16_t* dst; int K, N, c0, n0, k0; bool act; bool f8; };
constexpr int WC_ITEMS = 18 * 4 + 4 * 2 + 8 * 4 + 32 * 16 * 4 + 32 * 8 * 4;
DEVI WItem wconv_decode(const MArgs& a, unsigned char* ws, int it) {
    constexpr int I0 = 18 * 4, I1 = I0 + 4 * 2, I2 = I1 + 8 * 4, I3 = I2 + 32 * 16 * 4, I4 = I3 + 32 * 8 * 4;
    WItem w; w.src = a.in[7]; w.dst = nullptr; w.K = DM; w.N = INC; w.c0 = 0; w.n0 = 0; w.k0 = 0; w.act = it < I4; w.f8 = MOE_FP8 && it >= I2;
    if (w.act) {
        if (it < I0) { w.src = a.in[7]; w.dst = (bf16_t*)(ws + OFF_WIN); w.K = DM; w.N = INC; w.n0 = (it % 18) * 128; w.k0 = (it / 18) * 256; w.c0 = w.n0; }
        else if (it < I1) { const int r = it - I0; w.src = a.in[19]; w.dst = (bf16_t*)(ws + OFF_WGLU); w.K = 512; w.N = 512; w.n0 = (r % 4) * 128; w.k0 = (r / 4) * 256; w.c0 = w.n0; }
        else if (it < I2) { const int r = it - I1; w.src = a.in[21]; w.dst = (bf16_t*)(ws + OFF_WOUT); w.K = DM; w.N = DM; w.n0 = (r % 8) * 128; w.k0 = (r / 8) * 256; w.c0 = w.n0; }
        else if (it < I3) { const int r = it - I2, e = r / 64, q = r % 64; w.src = a.in[25] + (size_t)e * DM * 2048; w.dst = (bf16_t*)(ws + OFF_WG + (size_t)e * 2048 * DM * (MOE_FP8 ? 1 : 2)); w.K = DM; w.N = 2048;
            w.n0 = (q % 16) * 128; w.k0 = (q / 16) * 256; w.c0 = wsrc_col<1>(w.n0); }
        else { const int r = it - I3, e = r / 32, q = r % 32; w.src = a.in[27] + (size_t)e * DFF * DM; w.dst = (bf16_t*)(ws + OFF_WD + (size_t)e * DM * DFF * (MOE_FP8 ? 1 : 2)); w.K = DFF; w.N = DM; w.n0 = (q % 8) * 128; w.k0 = (q / 8) * 256; w.c0 = w.n0; }
    }
    return w;
}
DEVI void wconv_load(const WItem& w, int tid, f32x4 (&r)[16]) {
    const int l32 = tid & 31, kr = tid >> 5, col = w.c0 + 4 * l32; const bool ok = col < w.N; const int cc = ok ? col : 0;
    if (w.f8) { const float* p = w.src + (size_t)(w.k0 + 4 * kr) * w.N + cc; const size_t st = (size_t)64 * w.N;
#pragma unroll
        for (int i = 0; i < 4; ++i)
#pragma unroll
            for (int j = 0; j < 4; ++j) r[4 * i + j] = *(const f32x4*)(p + i * st + (size_t)j * w.N);
        return; }
    const float* p = w.src + (size_t)(w.k0 + 2 * kr) * w.N + cc; const size_t st = (size_t)32 * w.N;
#pragma unroll
    for (int i = 0; i < 8; ++i) { r[2 * i] = *(const f32x4*)(p + i * st); r[2 * i + 1] = *(const f32x4*)(p + i * st + w.N); }
}
DEVI void wconv_store(const WItem& cur, LAS unsigned char* lds, int tid, const f32x4 (&rc)[16]) {
    constexpr int TS = 264;
    const int l32 = tid & 31, kr = tid >> 5;
    if (cur.f8) {
        const int sw8 = ((l32 >> 1) & 15) << 2;
#pragma unroll
        for (int i = 0; i < 4; ++i) { const int k = (4 * kr + 64 * i) ^ sw8;
#pragma unroll
            for (int c = 0; c < 4; ++c) *(LAS unsigned*)(lds + (4 * l32 + c) * 256 + k) = pk4_fp8(rc[4 * i][c] * 32.f, rc[4 * i + 1][c] * 32.f, rc[4 * i + 2][c] * 32.f, rc[4 * i + 3][c] * 32.f); }
        __syncthreads();
        if (cur.act) {
#pragma unroll
            for (int i = 0; i < 4; ++i) { const int ch = tid + NTHR * i, n = ch >> 4, c16 = ch & 15, t = (n >> 3) & 15, m = t & 3;
                const u32x4 v = *(const LAS u32x4*)(lds + n * 256 + ((c16 ^ (t >> 2)) * 16));
                u32x4 o; o.x = (m & 1) ? v.y : v.x; o.y = (m & 1) ? v.x : v.y; o.z = (m & 1) ? v.w : v.z; o.w = (m & 1) ? v.z : v.w;
                if (m & 2) { const unsigned t0 = o.x, t1 = o.y; o.x = o.z; o.y = o.w; o.z = t0; o.w = t1; }
                *(u32x4*)((char*)cur.dst + (size_t)(cur.n0 + n) * cur.K + cur.k0 + c16 * 16) = o; } }
        __syncthreads();
        return; }
    const float okf = (cur.c0 + 4 * l32 < cur.N) ? 1.f : 0.f;
    const int sw = ((l32 >> 1) & 15) << 1;
#pragma unroll
    for (int i = 0; i < 8; ++i) { const int k = (2 * kr + 32 * i) ^ sw;
#pragma unroll
        for (int c = 0; c < 4; ++c) *(LAS unsigned*)(lds + ((4 * l32 + c) * TS + k) * 2) = pk2(rc[2 * i][c] * okf, rc[2 * i + 1][c] * okf); }
    __syncthreads();
    if (cur.act) {
#pragma unroll
        for (int i = 0; i < 8; ++i) { const int ch = tid + NTHR * i, n = ch >> 5, c8 = ch & 31, sn = ((n >> 3) & 15) << 1, m = (sn >> 1) & 3;
            const u32x4 v = *(const LAS u32x4*)(lds + (n * TS + ((c8 ^ (sn >> 3)) * 8)) * 2);
            u32x4 o; o.x = (m & 1) ? v.y : v.x; o.y = (m & 1) ? v.x : v.y; o.z = (m & 1) ? v.w : v.z; o.w = (m & 1) ? v.z : v.w;
            if (m & 2) { const unsigned t0 = o.x, t1 = o.y; o.x = o.z; o.y = o.w; o.z = t0; o.w = t1; }
            *(u32x4*)(cur.dst + (size_t)(cur.n0 + n) * cur.K + cur.k0 + c8 * 8) = o; } }
    __syncthreads();
}
DEVI void ph_prep(const MArgs& a, LAS unsigned char* lds, int bid, int G) {
    const int tid = threadIdx.x, wave = tid >> 6, lane = tid & 63;
    unsigned char* ws = a.ws;
    const bool big = G > 136; const int nsp = big ? 32 : G;
    const bool special = !big || (bid >= 104 && bid < 136); const int sid = big ? bid - 104 : bid;
    if (special) {
        for (int i = sid * NTHR + tid; i < 2 * 32 * 64; i += nsp * NTHR) s5prep_one(a.in[11], a.in[12], a.in[13], a.in[14], a.in[15], (S5P*)(ws + OFF_S5P), i);
        for (int g = sid; g < 32; g += nsp) { MArgs_in in{a.in[11], a.in[12], a.in[13], a.in[14], a.in[15], a.in[16], a.in[17]}; s5w_build(in, ws, lds, g); }
    }
    { LAS float* s = (LAS float*)lds; LAS float* part = (LAS float*)(lds + 36864);
      const float* c = a.in[1]; const float* cc = a.in[3]; const float* ada_w = a.in[4]; float* MP = (float*)(ws + OFF_SST);
      typedef float f32x2 __attribute__((ext_vector_type(2)));
      bool have_s = false;
      for (int mi = bid; mi < 256; mi += G) {
          if (!have_s) { for (int i = tid; i < 9216; i += NTHR) { const int r = i >> 10, k = i & 1023; const float v = r < 8 ? c[r * 1024 + k] : cc[k]; s[i] = siluf_(v); } have_s = true; __syncthreads(); }
          const int ks = mi >> 4, cs = mi & 15, k0 = ks * 64 + wave * 8;
          f32x2 wv[3][8];
#pragma unroll
          for (int ps = 0; ps < 3; ++ps)
#pragma unroll
              for (int q = 0; q < 8; ++q) wv[ps][q] = *(const f32x2*)(ada_w + (size_t)(k0 + q) * 6144 + cs * 384 + ps * 128 + lane * 2);
#pragma unroll
          for (int ps = 0; ps < 3; ++ps) { float acc[9][2];
#pragma unroll
              for (int r = 0; r < 9; ++r) { acc[r][0] = 0.f; acc[r][1] = 0.f; }
#pragma unroll
              for (int q = 0; q < 8; ++q) {
#pragma unroll
                  for (int r = 0; r < 9; ++r) { const float sv = s[r * 1024 + k0 + q]; acc[r][0] += sv * wv[ps][q][0]; acc[r][1] += sv * wv[ps][q][1]; } }
#pragma unroll
              for (int r = 0; r < 9; ++r) { part[(wave * 9 + r) * 128 + lane * 2] = acc[r][0]; part[(wave * 9 + r) * 128 + lane * 2 + 1] = acc[r][1]; }
              __syncthreads();
              for (int i = tid; i < 9 * 128; i += NTHR) { const int r = i >> 7, l = i & 127; float sum = 0.f;
#pragma unroll
                  for (int w = 0; w < 8; ++w) sum += part[(w * 9 + r) * 128 + l];
                  MP[((size_t)ks * 9 + r) * 6144 + cs * 384 + ps * 128 + l] = sum; }
              __syncthreads(); }
          asm volatile("s_waitcnt vmcnt(0)" ::: "memory");
          __syncthreads();
          volatile LAS int* lastf = (volatile LAS int*)(lds + MISC_OFF + 248);
          if (tid == 0) { __builtin_amdgcn_fence(__ATOMIC_RELEASE, "agent"); asm volatile("s_waitcnt vmcnt(0)" ::: "memory");
              const unsigned old = __hip_atomic_fetch_add((unsigned*)(ws + OFF_CTL) + CW_MODC + cs, 1u, __ATOMIC_RELAXED, __HIP_MEMORY_SCOPE_AGENT);
              lastf[0] = (old == 15u) ? 1 : 0;
              if (old == 15u) { __builtin_amdgcn_fence(__ATOMIC_ACQUIRE, "agent"); asm volatile("s_waitcnt vmcnt(0)" ::: "memory"); } }
          __syncthreads();
          if (lastf[0]) { const float* ada_b = a.in[5]; float* mod = (float*)(ws + OFF_MOD);
              for (int i = tid; i < 9 * 384; i += NTHR) { const int r = i / 384, col = cs * 384 + i % 384; float sum = ada_b[col];
#pragma unroll
                  for (int k2 = 0; k2 < 16; ++k2) sum += __hip_atomic_load(MP + ((size_t)k2 * 9 + r) * 6144 + col, __ATOMIC_RELAXED, __HIP_MEMORY_SCOPE_AGENT);
                  mod[r * 6144 + col] = sum; } }
          __syncthreads();
      } }
    { unsigned* ctr = (unsigned*)(ws + OFF_CTL) + CW_WQ; volatile LAS int* q = (volatile LAS int*)(lds + MISC_OFF + 240);
      __syncthreads();
      if (tid == 0) { q[0] = (int)atomicAdd(ctr, 1u); q[1] = (int)atomicAdd(ctr, 1u); }
      __syncthreads();
      int ia = q[0], ib = q[1];
      f32x4 ra[16], rb[16];
      WItem wa = wconv_decode(a, ws, ia); wconv_load(wa, tid, ra);
      while (ia < WC_ITEMS) {
          const WItem wb = wconv_decode(a, ws, ib); wconv_load(wb, tid, rb);
          if (tid == 0) q[0] = (int)atomicAdd(ctr, 1u);
          wconv_store(wa, lds, tid, ra);
          ia = q[0];
          wa = wconv_decode(a, ws, ia); wconv_load(wa, tid, ra);
          if (tid == 0) q[1] = (int)atomicAdd(ctr, 1u);
          wconv_store(wb, lds, tid, rb);
          ib = q[1];
      } }
}


DEVI void ph_router(const float* __restrict__ X, const float* __restrict__ OUTB, const float* __restrict__ w, const float* __restrict__ mod, const float* __restrict__ rw, const float* __restrict__ rb,
                    bf16_t* __restrict__ H2, int* __restrict__ cnt, int* __restrict__ list, float* __restrict__ gate, int* __restrict__ epos, LAS unsigned char* lds, int bid, int G, bool commit) {
    int tid = threadIdx.x; asm volatile("" : "+v"(tid));
    const int wave = __builtin_amdgcn_readfirstlane(tid >> 6), lane = tid & 63, e16 = lane & 15, kq = lane >> 4;
    constexpr int HS = 1028;
    LAS float* hrow = (LAS float*)lds;
    LAS float* part = (LAS float*)(lds + 16 * HS * 4);
    LAS int* lcnt = (LAS int*)(lds + 16 * HS * 4 + 16384);
    LAS int* gbase = lcnt + 32; LAS int* ent = lcnt + 64;
    if (tid < 64) lcnt[tid] = 0;
    float wreg[2][32];
#pragma unroll
    for (int et = 0; et < 2; ++et)
#pragma unroll
        for (int q = 0; q < 32; ++q) wreg[et][q] = rw[(wave * 128 + kq * 32 + q) * 32 + et * 16 + e16];
    const float rbe = rb[lane & 31];
    const int per = (NTOK + G - 1) / G;
    const int t0 = bid * per, t1 = (t0 + per) < NTOK ? (t0 + per) : NTOK;
    const bool onebatch = (SEQ % per) == 0; const int b0 = t0 / SEQ;
    float4 cw[4], csc[4], csh[4], cg1[4];
#pragma unroll
    for (int j = 0; j < 4; ++j) { const int k = lane * 4 + 256 * j; cw[j] = *(const float4*)(w + k); csc[j] = *(const float4*)(mod + b0 * 6144 + 4096 + k); csh[j] = *(const float4*)(mod + b0 * 6144 + 3072 + k); cg1[j] = *(const float4*)(mod + b0 * 6144 + 2048 + k); }
    float4 v[2][4]; uint2 mx[2][4];
#pragma unroll
    for (int u = 0; u < 2; ++u) { const int tok = t0 + wave * 2 + u; if (tok < t1) {
#pragma unroll
        for (int j = 0; j < 4; ++j) { v[u][j] = *(const float4*)(X + (size_t)tok * DM + lane * 4 + 256 * j); mx[u][j] = *(const uint2*)((const bf16_t*)(OUTB + (size_t)tok * DM) + DM + lane * 4 + 256 * j); } } }
    for (int tb = t0; tb < t1; tb += 16) {
#pragma unroll
        for (int u = 0; u < 2; ++u) { const int tok = tb + wave * 2 + u;
            if (tok < t1) {
                const int b = tok / SEQ; float ss = 0.f; const float* g1p = mod + b * 6144 + 2048;
#pragma unroll
                for (int j = 0; j < 4; ++j) { const float4 g1 = onebatch ? cg1[j] : *(const float4*)(g1p + lane * 4 + 256 * j);
                    v[u][j].x += g1.x * __uint_as_float(mx[u][j].x << 16); v[u][j].y += g1.y * __uint_as_float(mx[u][j].x & 0xffff0000u);
                    v[u][j].z += g1.z * __uint_as_float(mx[u][j].y << 16); v[u][j].w += g1.w * __uint_as_float(mx[u][j].y & 0xffff0000u);
                    ss += v[u][j].x * v[u][j].x + v[u][j].y * v[u][j].y + v[u][j].z * v[u][j].z + v[u][j].w * v[u][j].w; }
                const float rstd = rsqrtf(wave_sum(ss) * (1.f / DM) + 1e-6f);
                const float* msh = mod + b * 6144 + 3072; const float* msc = mod + b * 6144 + 4096;
#pragma unroll
                for (int j = 0; j < 4; ++j) { const int k = lane * 4 + 256 * j;
                    const float4 ww = cw[j], sc = onebatch ? csc[j] : *(const float4*)(msc + k), sh = onebatch ? csh[j] : *(const float4*)(msh + k);
                    f32x4 hv; hv[0] = v[u][j].x * rstd * ww.x * (1.f + sc.x) + sh.x; hv[1] = v[u][j].y * rstd * ww.y * (1.f + sc.y) + sh.y; hv[2] = v[u][j].z * rstd * ww.z * (1.f + sc.z) + sh.z; hv[3] = v[u][j].w * rstd * ww.w * (1.f + sc.w) + sh.w;
                    *(LAS f32x4*)(hrow + (wave * 2 + u) * HS + k) = hv;
                    if (MOE_FP8) *(unsigned*)((char*)H2 + (size_t)tok * DM + k) = pk4_fp8(hv[0], hv[1], hv[2], hv[3]);
                    else { uint2 o; o.x = pk2(hv[0], hv[1]); o.y = pk2(hv[2], hv[3]); *(uint2*)(H2 + (size_t)tok * DM + k) = o; } }
            } else {
#pragma unroll
                for (int j = 0; j < 4; ++j) *(LAS f32x4*)(hrow + (wave * 2 + u) * HS + lane * 4 + 256 * j) = (f32x4){0.f, 0.f, 0.f, 0.f}; }
        }
#pragma unroll
        for (int u = 0; u < 2; ++u) { const int ntok = tb + 16 + wave * 2 + u; if (ntok < t1) {
#pragma unroll
            for (int j = 0; j < 4; ++j) { v[u][j] = *(const float4*)(X + (size_t)ntok * DM + lane * 4 + 256 * j); mx[u][j] = *(const uint2*)((const bf16_t*)(OUTB + (size_t)ntok * DM) + DM + lane * 4 + 256 * j); } } }
        __syncthreads();
        f32x4 acc0 = (f32x4){0.f, 0.f, 0.f, 0.f}, acc1 = (f32x4){0.f, 0.f, 0.f, 0.f};
#pragma unroll
        for (int i = 0; i < 8; ++i) { const f32x4 ar = *(const LAS f32x4*)(hrow + e16 * HS + wave * 128 + kq * 32 + 4 * i);
#pragma unroll
            for (int c = 0; c < 4; ++c) { acc0 = __builtin_amdgcn_mfma_f32_16x16x4f32(ar[c], wreg[0][4 * i + c], acc0, 0, 0, 0); acc1 = __builtin_amdgcn_mfma_f32_16x16x4f32(ar[c], wreg[1][4 * i + c], acc1, 0, 0, 0); } }
#pragma unroll
        for (int rg = 0; rg < 4; ++rg) { part[((wave * 2 + 0) * 16 + 4 * kq + rg) * 16 + e16] = acc0[rg]; part[((wave * 2 + 1) * 16 + 4 * kq + rg) * 16 + e16] = acc1[rg]; }
        __syncthreads();
        {
            const int t = wave * 2 + (lane >> 5), tk = tb + t, e = lane & 31, et = e >> 4, ee = e & 15;
            float lg = rbe;
#pragma unroll
            for (int q = 0; q < 8; ++q) lg += part[((q * 2 + et) * 16 + t) * 16 + ee];
            float val = lg; float tv[4]; int ti[4];
#pragma unroll
            for (int r = 0; r < 4; ++r) { float bv = val; int bi = e;
#pragma unroll
                for (int o = 1; o < 32; o <<= 1) { const float ov = __shfl_xor(bv, o); const int oi = __shfl_xor(bi, o); if (ov > bv || (ov == bv && oi < bi)) { bv = ov; bi = oi; } }
                tv[r] = bv; ti[r] = bi; if (e == bi) val = -3.0e38f; }
            const float e1 = __expf(tv[1] - tv[0]), e2 = __expf(tv[2] - tv[0]), e3 = __expf(tv[3] - tv[0]), inv = 1.f / (1.f + e1 + e2 + e3);
            if (e < 4 && tk < t1 && commit) { const float gv = e == 0 ? inv : e == 1 ? e1 * inv : e == 2 ? e2 * inv : e3 * inv; const int ex = e == 0 ? ti[0] : e == 1 ? ti[1] : e == 2 ? ti[2] : ti[3];
                const int ls = __hip_atomic_fetch_add(&lcnt[ex], 1, __ATOMIC_RELAXED, __HIP_MEMORY_SCOPE_WORKGROUP); ent[(tk - t0) * 4 + e] = (ex << 16) | ls; gate[tk * 4 + e] = gv; }
        }
    }
    __syncthreads();
    if (commit) {
        if (tid < NEXP) { const int c = lcnt[tid]; gbase[tid] = c ? atomicAdd(&cnt[tid], c) : 0; }
        __syncthreads();
        for (int i = tid; i < (t1 - t0) * 4; i += NTHR) { const int en = ent[i], ex = en >> 16, slot = gbase[ex] + (en & 0xffff), tk4 = t0 * 4 + i;
            list[ex * LISTCAP + slot] = tk4; epos[tk4] = ex * LISTCAP + slot; }
    }
    __syncthreads();
}

DEVI void build_ub(const int* cnt, volatile LAS int* ub) {
    if (threadIdx.x == 0) { int o = 0; for (int e = 0; e < NEXP; ++e) { ub[e] = o; o += (cnt[e] + 255) >> 8; } ub[NEXP] = o; }
    __syncthreads();
}

__global__ void __launch_bounds__(NTHR, 2) mega(MArgs a) {
    extern __shared__ __attribute__((aligned(16))) unsigned char lds_raw[];
    LAS unsigned char* lds = (LAS unsigned char*)lds_raw;
    volatile LAS unsigned* MISC = (volatile LAS unsigned*)(lds + MISC_OFF);
    const int tid = threadIdx.x, wave = __builtin_amdgcn_readfirstlane(tid >> 6), G = gridDim.x, bid = blockIdx.x;
    const int gw = bid * NWAVES + wave, NGW = G * NWAVES;
    for (int u = tid; u < MISC_BYTES / 4; u += NTHR) MISC[u] = 0u;
    __syncthreads();
    unsigned char* ws = a.ws; unsigned* ctl = (unsigned*)(ws + OFF_CTL);
    const bool multi = (a.ph_hi - a.ph_lo) > 1;
    XcdBarrier bar; bar.bar = ctl + CW_BAR; bar.x = 0; bar.st = MISC;
    if (multi) bar = xcd_barrier_post(ctl + CW_BAR, MISC);
    volatile LAS int* ub = (volatile LAS int*)(MISC + 16);
#ifndef PROBE_REP
#define PROBE_REP 0
#endif
#define IN(k) (a.ph_lo <= (k) && (k) < a.ph_hi)
#define NREP(k) (1 + ((PROBE_REP >> (k)) & 1))
#ifndef PROBE_VPH
#define PROBE_VPH -1
#endif
#ifndef PROBE_VMODE
#define PROBE_VMODE 1
#endif
#define FRESH_LANE int ft_ = threadIdx.x; asm volatile("" : "+v"(ft_)); const int lane = ft_ & 63; (void)lane
#ifndef PROBE_TK
#define PROBE_TK -1
#endif
    unsigned long long tstamp_prev = 0ull, tstamp_sel = 0ull;
    if (PROBE_TK >= 0) tstamp_prev = __builtin_amdgcn_s_memrealtime();
#define SEAM(k) do { if (IN(k) && IN((k) + 1)) xcd_barrier(bar); if (PROBE_TK >= 0) { const unsigned long long tn_ = __builtin_amdgcn_s_memrealtime(); if ((k) == PROBE_TK) tstamp_sel = tn_ - tstamp_prev; tstamp_prev = tn_; } } while (0)
    float* mod = (float*)(ws + OFF_MOD); S5P* s5p = (S5P*)(ws + OFF_S5P); float* gate = (float*)(ws + OFF_GATE); int* list = (int*)(ws + OFF_LIST);
    bf16_t* WIN = (bf16_t*)(ws + OFF_WIN); bf16_t* WGLU = (bf16_t*)(ws + OFF_WGLU); bf16_t* WOUT = (bf16_t*)(ws + OFF_WOUT); bf16_t* WG = (bf16_t*)(ws + OFF_WG); bf16_t* WD = (bf16_t*)(ws + OFF_WD);
    bf16_t* H = (bf16_t*)(ws + OFF_H); bf16_t* QK = (bf16_t*)(ws + OFF_QK); bf16_t* V = (bf16_t*)(ws + OFF_V); bf16_t* R = (bf16_t*)(ws + OFF_R); bf16_t* UT = (bf16_t*)(ws + OFF_UT);
    float* LR = (float*)(ws + OFF_LR); bf16_t* U2 = (bf16_t*)(ws + OFF_U2);
    bf16_t* YS = (bf16_t*)(ws + OFF_YS); bf16_t* MIX = (bf16_t*)(ws + OFF_MIX); bf16_t* ACT = (bf16_t*)(ws + OFF_ACT); bf16_t* YSL = (bf16_t*)(ws + OFF_YSL);
    int* cnt = (int*)(ctl + CW_CNT);

    if (IN(0)) for (int rp = 0; rp < NREP(0); ++rp) ph_prep(a, lds, bid, G);
    SEAM(0);
    if (IN(1)) for (int rp = 0; rp < NREP(1); ++rp) { FRESH_LANE; for (int row = gw; row < NROWS; row += NGW) norm_row(a.in[0], a.in[2], a.in[6], mod, H, row, lane, 0, 1024); }
    SEAM(1);
    if (IN(2) && PROBE_VPH == 2) { ProbIn P{H, DM, WIN, DM, DM, QK, V, R, UT, U2, LR}; gemm_phase<PROBE_VMODE>(lds, P, G, bid); }
    if (IN(2)) for (int rp = 0; rp < NREP(2); ++rp) { ProbIn P{H, DM, WIN, DM, DM, QK, V, R, UT, U2, LR}; gemm_phase(lds, P, G, bid); }
    SEAM(2);
    float* Fb = (float*)(ws + OFF_F); bf16_t* S5BF = (bf16_t*)(ws + OFF_S5BF); bf16_t* S5BY = (bf16_t*)(ws + OFF_S5BY);
    const GlaPtrs GP{QK, V, R, LR, a.in[8], a.in[9], a.in[10], (bf16_t*)(ws + OFF_UCH), (float*)(ws + OFF_ADEC), (bf16_t*)(ws + OFF_SST), MIX, (bf16_t*)(ws + OFF_GLT)};
    if (IN(3)) for (int rp = 0; rp < NREP(3); ++rp) {
        for (int r2 = 0; r2 < NREP(12); ++r2) { ProbS5F P{U2, S5BF, 256, Fb}; gemm_phase(lds, P, G, bid); }
        for (int r2 = 0; r2 < NREP(13); ++r2) gla_a_phase(GP, lds, bid, G);
    }
    SEAM(3);
    if (IN(4)) for (int rp = 0; rp < NREP(4); ++rp) {
        for (int blk = bid; blk < 256; blk += G) ph_scans(GP, Fb, U2, s5p, lds, blk, NREP(16) > 0, true);
    }
    SEAM(4);
    if (IN(5)) for (int rp = 0; rp < NREP(5); ++rp) {
        for (int r2 = 0; r2 < NREP(14); ++r2) { ProbS5Y P{U2, S5BY, 512, a.in[18], YS}; gemm_phase(lds, P, G, bid); }
        for (int r2 = 0; r2 < NREP(15); ++r2) gla_c_phase(GP, lds, bid, G);
    }
    SEAM(5);
    if (IN(6)) for (int rp = 0; rp < NREP(6); ++rp) { ProbGlu P{YS, 512, WGLU, 512, 512, a.in[20], MIX}; gemm_phase(lds, P, G, bid); }
    SEAM(6);
    if (IN(7)) for (int rp = 0; rp < NREP(7); ++rp) { ProbOut P{MIX, DM, WOUT, DM, DM, a.in[0], mod, a.out}; gemm_phase(lds, P, G, bid); }
    SEAM(7);
    if (IN(8)) for (int rp = NREP(8) - 1; rp >= 0; --rp) ph_router(a.in[0], a.out, a.in[22], mod, a.in[23], a.in[24], H, cnt, list, gate, (int*)(ws + OFF_EPOS), lds, bid, G, rp == 0);
    SEAM(8);
    if (IN(9) && PROBE_VPH == 9) { build_ub(cnt, ub); FMoe1 P{H, WG, MOE_FP8 ? DM / 2 : DM, cnt, list, a.in[26], ACT, (const LAS int*)ub, G}; gemm_phase<PROBE_VMODE>(lds, P, G, bid); }
    if (IN(9)) for (int rp = 0; rp < NREP(9); ++rp) { build_ub(cnt, ub); FMoe1 P{H, WG, MOE_FP8 ? DM / 2 : DM, cnt, list, a.in[26], ACT, (const LAS int*)ub, G}; gemm_phase(lds, P, G, bid); }
    SEAM(9);
    if (IN(10) && PROBE_VPH == 10) { build_ub(cnt, ub); FMoe2 P{ACT, WD, MOE_FP8 ? DFF / 2 : DFF, cnt, a.in[28], YSL, (const LAS int*)ub, G}; gemm_phase<PROBE_VMODE>(lds, P, G, bid); }
    if (IN(10)) for (int rp = 0; rp < NREP(10); ++rp) { build_ub(cnt, ub); FMoe2 P{ACT, WD, MOE_FP8 ? DFF / 2 : DFF, cnt, a.in[28], YSL, (const LAS int*)ub, G}; gemm_phase(lds, P, G, bid); }
    SEAM(10);
    if (IN(11)) { build_ub(cnt, ub); for (int rp = NREP(11) - 1; rp >= 0; --rp) { FRESH_LANE; for (int tok = gw; tok < NTOK; tok += NGW) final_row(a.in[0], a.out, YSL, mod, a.in[29], gate, (const int*)(ws + OFF_EPOS), (const LAS int*)ub, tok, lane, rp ? (float*)(ws + OFF_WG) : nullptr); } }
    if (PROBE_TK >= 0) { if (PROBE_TK == 11) tstamp_sel = __builtin_amdgcn_s_memrealtime() - tstamp_prev;
        if (bid == 0) { const unsigned long long t0_ = __builtin_amdgcn_s_memrealtime(); while (__builtin_amdgcn_s_memrealtime() - t0_ < 4ull * tstamp_sel) __builtin_amdgcn_s_sleep(8); } }
#undef IN
#undef SEAM
}

#ifndef MEGA_SINGLE
#define MEGA_SINGLE 1
#endif
extern "C" void kernel_launch(void* const* d_in, const int* in_sizes, int n_in, void* d_out, int out_size, void* d_ws, size_t ws_size, hipStream_t stream) {
    static int grid = 0;
    if (grid == 0) {
        if (ws_size < WS_NEED || n_in != 30) { fprintf(stderr, "kernel_launch: workspace too small (%zu < %zu) or n_in %d != 30\n", ws_size, (size_t)WS_NEED, n_in); grid = -1; return; }
        int dev = 0, cus = 0, per_cu = 0;
        if (hipGetDevice(&dev) != hipSuccess || hipDeviceGetAttribute(&cus, hipDeviceAttributeMultiprocessorCount, dev) != hipSuccess) { grid = -1; return; }
        if (hipFuncSetAttribute((const void*)mega, hipFuncAttributeMaxDynamicSharedMemorySize, LDS_BYTES) != hipSuccess) { fprintf(stderr, "kernel_launch: hipFuncSetAttribute failed\n"); grid = -1; return; }
        if (hipOccupancyMaxActiveBlocksPerMultiprocessor(&per_cu, (const void*)mega, NTHR, LDS_BYTES) != hipSuccess || per_cu < 1) { fprintf(stderr, "kernel_launch: occupancy query says %d blocks per CU\n", per_cu); per_cu = 1; }
        (void)hipGetLastError();
        grid = cus;
    }
    if (grid < 0) return;
    (void)hipMemsetAsync((char*)d_ws + OFF_CTL, 0, 64 * 1024, stream);
    MArgs a{};
    for (int i = 0; i < 30; ++i) a.in[i] = (const float*)d_in[i];
    a.out = (float*)d_out; a.ws = (unsigned char*)d_ws;
#if MEGA_SINGLE
    a.ph_lo = 0; a.ph_hi = NPH;
    { void* args[] = {&a}; hipError_t e = hipLaunchCooperativeKernel((const void*)mega, dim3(grid), dim3(NTHR), args, LDS_BYTES, stream);
      if (e != hipSuccess) fprintf(stderr, "kernel_launch: cooperative launch failed: %s (grid %d)\n", hipGetErrorString(e), grid); }
#else
    for (int p = 0; p < NPH; ++p) { a.ph_lo = p; a.ph_hi = p + 1; hipLaunchKernelGGL(mega, dim3(grid), dim3(NTHR), LDS_BYTES, stream, a); }
#endif
}
```

```cpp
#include <hip/hip_runtime.h>
#include <stdint.h>
#include <stdio.h>

typedef unsigned short bf16_t;
#define DEVI __device__ __forceinline__
#define LAS __attribute__((address_space(3)))
#ifndef MOE_FP8
#define MOE_FP8 1
#endif
DEVI unsigned pk4_fp8(float a, float b, float c, float d) { int w = 0; w = __builtin_amdgcn_cvt_pk_fp8_f32(a, b, w, false); w = __builtin_amdgcn_cvt_pk_fp8_f32(c, d, w, true); return (unsigned)w; }

constexpr int NB = 8, SEQ = 4096, DM = 1024, CTX = 256;
constexpr int NTOK = NB * SEQ;
constexpr int NCTX = NB * CTX;
constexpr int NROWS = NTOK + NCTX;
constexpr int INC = 2080, INP = 2304;
constexpr int NEXP = 32, TOPK = 4, DFF = 1024;
constexpr int LISTCAP = NTOK;
constexpr int MOEPAD = 256;

constexpr size_t MiB = 1024ull * 1024ull;
constexpr size_t OFF_CTL = 0;
constexpr size_t OFF_MOD = 64 * 1024;
constexpr size_t OFF_S5P = OFF_MOD + 256 * 1024;
constexpr size_t OFF_GATE = OFF_S5P + 1 * MiB;
constexpr size_t OFF_EPOS = OFF_GATE + 512 * 1024;
constexpr size_t OFF_LIST = OFF_EPOS + 512 * 1024;
constexpr size_t OFF_WIN = OFF_LIST + 4 * MiB;
constexpr size_t OFF_WGLU = OFF_WIN + (size_t)INP * DM * 2;
constexpr size_t OFF_WOUT = OFF_WGLU + 512 * 512 * 2;
constexpr size_t OFF_WG = OFF_WOUT + (size_t)DM * DM * 2;
constexpr size_t OFF_WD = OFF_WG + (size_t)NEXP * 2048 * DM * 2;
constexpr size_t OFF_S5BF = OFF_WD + (size_t)NEXP * DM * DFF * 2;
constexpr size_t OFF_S5BY = OFF_S5BF + (size_t)32 * 256 * 256 * 2;
constexpr size_t OFF_H = OFF_S5BY + (size_t)32 * 256 * 512 * 2;
constexpr size_t OFF_RA = OFF_H + (size_t)NROWS * DM * 2;
constexpr size_t OFF_QK = OFF_RA;
constexpr size_t OFF_V = OFF_QK + (size_t)NROWS * 512 * 2;
constexpr size_t OFF_R = OFF_V + (size_t)NROWS * 512 * 2;
constexpr size_t OFF_UT = OFF_R + (size_t)NROWS * 512 * 2;
constexpr size_t OFF_LR = OFF_UT + (size_t)NROWS * 512 * 2;
constexpr size_t OFF_U2 = OFF_LR + (size_t)NROWS * 32 * 4;
constexpr size_t OFF_YS = OFF_U2 + (size_t)32 * 2304 * 512 * 2;
constexpr size_t OFF_MIX = OFF_YS + (size_t)NTOK * 512 * 2;
constexpr size_t OFF_F = OFF_MIX + (size_t)NTOK * DM * 2;
constexpr size_t OFF_UCH = OFF_F + (size_t)32 * 2304 * 256 * 4;
constexpr size_t OFF_ADEC = OFF_UCH + (size_t)64 * 68 * 8192 * 2;
constexpr size_t OFF_SST = OFF_ADEC + (size_t)64 * 68 * 64 * 4;
constexpr size_t OFF_GLT = OFF_SST + (size_t)64 * 64 * 8192 * 2;
constexpr size_t OFF_RA_END = OFF_GLT + (size_t)2048 * 4 * 4096 * 2;
constexpr int ACT_ROWS = NTOK * TOPK + NEXP * MOEPAD;
constexpr size_t OFF_ACT = OFF_RA;
constexpr size_t OFF_YSL = OFF_ACT + (size_t)ACT_ROWS * DFF * 2;
constexpr size_t OFF_END2 = OFF_YSL + (size_t)ACT_ROWS * DM * 2;
constexpr size_t WS_NEED = OFF_RA_END > OFF_END2 ? OFF_RA_END : OFF_END2;
static_assert(WS_NEED <= 1024 * MiB, "workspace map exceeds 1 GiB");

constexpr int CW_CNT = 1024;
constexpr int CW_OFFS = 1088;
constexpr int CW_WQ = 1200;
constexpr int CW_MODC = 1216;
constexpr int CW_GAQ = 1240;

DEVI float bf2f(bf16_t b) { return __uint_as_float(((unsigned)b) << 16); }
DEVI bf16_t f2bf(float f) { unsigned u = __float_as_uint(f); u += 0x7fffu + ((u >> 16) & 1u); return (bf16_t)(u >> 16); }
DEVI unsigned pk2(float lo, float hi) { unsigned r; asm("v_cvt_pk_bf16_f32 %0, %1, %2" : "=v"(r) : "v"(lo), "v"(hi)); return r; }
DEVI float wave_sum(float v) {
#pragma unroll
    for (int o = 1; o < 64; o <<= 1) v += __shfl_xor(v, o);
    return v;
}
DEVI float sigmoidf_(float x) { return 1.f / (1.f + __expf(-x)); }
DEVI float siluf_(float x) { return x / (1.f + __expf(-x)); }
DEVI float logsigmoidf_(float g) { return fminf(g, 0.f) - __logf(1.f + __expf(-fabsf(g))); }
DEVI float gelu_tanh(float x) { const float u = 0.7978845608028654f * (x + 0.044715f * x * x * x); return x / (1.f + __expf(-2.f * u)); }

__global__ __launch_bounds__(256) void k_mod(const float* __restrict__ c, const float* __restrict__ c_ctx, const float* __restrict__ ada_w,
                                             const float* __restrict__ ada_b, float* __restrict__ mod) {
    __shared__ float s[9][1024];
    for (int i = threadIdx.x; i < 9 * 1024; i += 256) { const int r = i >> 10, k = i & 1023; const float v = r < 8 ? c[r * 1024 + k] : c_ctx[k]; s[r][k] = siluf_(v); }
    __syncthreads();
    const int j = blockIdx.x * 256 + threadIdx.x;
    float acc[9];
#pragma unroll
    for (int r = 0; r < 9; ++r) acc[r] = 0.f;
    for (int k = 0; k < 1024; ++k) { const float w = ada_w[(size_t)k * 6144 + j];
#pragma unroll
        for (int r = 0; r < 9; ++r) acc[r] += s[r][k] * w; }
    const float bb = ada_b[j];
#pragma unroll
    for (int r = 0; r < 9; ++r) mod[r * 6144 + j] = acc[r] + bb;
}

template <int MODE> DEVI int wsrc_col(int nd) { if (MODE == 1) { return ((nd >> 7) & 1) * 1024 + (nd >> 8) * 128 + (nd & 127); } return nd; }
template <int MODE> __global__ __launch_bounds__(256) void k_wconv(const float* __restrict__ src, bf16_t* __restrict__ dst, int K, int N, int Nd) {
    __shared__ float t[64][65];
    const int e = blockIdx.z; src += (size_t)e * K * N; dst += (size_t)e * Nd * K;
    const int n0 = blockIdx.x * 64, k0 = blockIdx.y * 64, tid = threadIdx.x, nl = tid & 63, kq = tid >> 6;
    const int nd = n0 + nl, sc = wsrc_col<MODE>(nd); const bool valid = sc < N;
#pragma unroll 4
    for (int i = 0; i < 16; ++i) { const int kk = kq + 4 * i; t[kk][nl] = valid ? src[(size_t)(k0 + kk) * N + sc] : 0.f; }
    __syncthreads();
#pragma unroll
    for (int i = 0; i < 2; ++i) { const int ch = tid + 256 * i, n = ch >> 3, c8 = ch & 7;
        uint4 o; o.x = pk2(t[c8 * 8 + 0][n], t[c8 * 8 + 1][n]); o.y = pk2(t[c8 * 8 + 2][n], t[c8 * 8 + 3][n]); o.z = pk2(t[c8 * 8 + 4][n], t[c8 * 8 + 5][n]); o.w = pk2(t[c8 * 8 + 6][n], t[c8 * 8 + 7][n]);
        *(uint4*)(dst + (size_t)(n0 + n) * K + k0 + c8 * 8) = o; }
}

struct S5P { float lamb[2][32][64][2]; float bbar[2][32][64][16][2]; float lam16[2][32][64][2]; };
DEVI void s5prep_one(const float* lam_re, const float* lam_im, const float* log_dt, const float* b_re, const float* b_im, S5P* P, int i) {
    const int p = i & 63, g = (i >> 6) & 31, d = i >> 11;
    const double dt = exp((double)log_dt[d * 32 + g]);
    const double lr = lam_re[i], li = lam_im[i];
    const double mag = exp(lr * dt), ar = mag * cos(li * dt), ai = mag * sin(li * dt);
    const double nr = ar - 1.0, ni = ai, den = lr * lr + li * li;
    const double cr = (nr * lr + ni * li) / den, ci = (ni * lr - nr * li) / den;
    P->lamb[d][g][p][0] = (float)ar; P->lamb[d][g][p][1] = (float)ai;
    for (int h = 0; h < 16; ++h) { const double br = b_re[(size_t)i * 16 + h], bi = b_im[(size_t)i * 16 + h];
        P->bbar[d][g][p][h][0] = (float)(cr * br - ci * bi); P->bbar[d][g][p][h][1] = (float)(cr * bi + ci * br); }
}
__global__ void k_s5prep(const float* lam_re, const float* lam_im, const float* log_dt, const float* b_re, const float* b_im, S5P* P) {
    const int i = blockIdx.x * blockDim.x + threadIdx.x; if (i >= 2 * 32 * 64) return;
    s5prep_one(lam_re, lam_im, log_dt, b_re, b_im, P, i);
}

DEVI void norm_row(const float* __restrict__ x, const float* __restrict__ ctx, const float* __restrict__ w, const float* __restrict__ mod,
                                              bf16_t* __restrict__ H, int row, int lane, int sh_off, int sc_off) {
    const float* src; int b;
    if (row < NTOK) { src = x + (size_t)row * DM; b = row / SEQ; } else { src = ctx + (size_t)(row - NTOK) * DM; b = 8; }
    float4 v[4]; float ss = 0.f;
#pragma unroll
    for (int j = 0; j < 4; ++j) { v[j] = *(const float4*)(src + lane * 4 + 256 * j); ss += v[j].x * v[j].x + v[j].y * v[j].y + v[j].z * v[j].z + v[j].w * v[j].w; }
    const float rstd = rsqrtf(wave_sum(ss) * (1.f / DM) + 1e-6f);
    const float* msh = mod + b * 6144 + sh_off; const float* msc = mod + b * 6144 + sc_off;
#pragma unroll
    for (int j = 0; j < 4; ++j) { const int k = lane * 4 + 256 * j;
        const float4 ww = *(const float4*)(w + k), sc = *(const float4*)(msc + k), sh = *(const float4*)(msh + k);
        uint2 o; o.x = pk2(v[j].x * rstd * ww.x * (1.f + sc.x) + sh.x, v[j].y * rstd * ww.y * (1.f + sc.y) + sh.y);
        o.y = pk2(v[j].z * rstd * ww.z * (1.f + sc.z) + sh.z, v[j].w * rstd * ww.w * (1.f + sc.w) + sh.w);
        *(uint2*)(H + (size_t)row * DM + k) = o; }
}
__global__ __launch_bounds__(256) void k_norm(const float* __restrict__ x, const float* __restrict__ ctx, const float* __restrict__ w, const float* __restrict__ mod,
                                              bf16_t* __restrict__ H, int nrows, int sh_off, int sc_off) {
    const int row = blockIdx.x * 4 + (threadIdx.x >> 6), lane = threadIdx.x & 63; if (row >= nrows) return;
    norm_row(x, ctx, w, mod, H, row, lane, sh_off, sc_off);
}

DEVI void dense_unit(int L, int nM, int nN, int& pm, int& pn) {
    const int nwg = nM * nN; int wgid = L; { const int q = nwg / 8, r = nwg % 8, xcd = wgid % 8, off = wgid / 8; wgid = (xcd < r ? xcd * (q + 1) : r * (q + 1) + (xcd - r) * q) + off; }
    const int nig = 8 * nN, gid = wgid / nig, fm = gid * 8, gsz = (nM - fm) < 8 ? (nM - fm) : 8;
    pm = fm + ((wgid % nig) % gsz); pn = (wgid % nig) / gsz;
}
template <class Prob> __global__ __launch_bounds__(256) void k_gemm_naive(Prob P) {
    __shared__ float As[32][68], Bs[32][68];
    const int z = blockIdx.z, M = P.M(z), r0 = blockIdx.y * 64, c0 = blockIdx.x * 64; if (r0 >= M) return;
    const int tid = threadIdx.x, tx = tid & 7, ty = tid >> 3, K = P.K;
    const int lr = tid >> 2, lk = (tid & 3) * 8;
    const bool arow_ok = (r0 + lr) < M;
    const bf16_t* ap = P.A + (size_t)(arow_ok ? P.arow(z, r0 + lr) : 0) * P.lda + lk;
    const bf16_t* bp = P.Bt(z) + (size_t)(c0 + lr) * P.ldb + lk;
    float acc[2][8];
#pragma unroll
    for (int i = 0; i < 2; ++i)
#pragma unroll
        for (int j = 0; j < 8; ++j) acc[i][j] = 0.f;
    for (int k0 = 0; k0 < K; k0 += 32) {
        uint4 av = arow_ok ? *(const uint4*)(ap + k0) : make_uint4(0, 0, 0, 0); const uint4 bv = *(const uint4*)(bp + k0);
        const unsigned aw[4] = {av.x, av.y, av.z, av.w}, bw[4] = {bv.x, bv.y, bv.z, bv.w};
        __syncthreads();
#pragma unroll
        for (int j = 0; j < 4; ++j) { As[lk + 2 * j][lr] = __uint_as_float(aw[j] << 16); As[lk + 2 * j + 1][lr] = __uint_as_float(aw[j] & 0xffff0000u);
            Bs[lk + 2 * j][lr] = __uint_as_float(bw[j] << 16); Bs[lk + 2 * j + 1][lr] = __uint_as_float(bw[j] & 0xffff0000u); }
        __syncthreads();
#pragma unroll 8
        for (int k = 0; k < 32; ++k) { const float a0 = As[k][ty * 2], a1 = As[k][ty * 2 + 1];
            const float4 b0 = *(const float4*)&Bs[k][tx * 8], b1 = *(const float4*)&Bs[k][tx * 8 + 4];
            const float bb[8] = {b0.x, b0.y, b0.z, b0.w, b1.x, b1.y, b1.z, b1.w};
#pragma unroll
            for (int j = 0; j < 8; ++j) { acc[0][j] += a0 * bb[j]; acc[1][j] += a1 * bb[j]; } }
    }
#pragma unroll
    for (int i = 0; i < 2; ++i) { const int r = r0 + ty * 2 + i; if (r < M) P.store(z, r, c0 + tx * 8, acc[i]); }
}

struct ProbIn {
    static constexpr bool HOIST = false, PAIR = false, FP8 = false;
    const bf16_t* A; int lda; const bf16_t* B; int ldb; int K; bf16_t *QK, *V, *R, *UT, *U2; float* LR;
    DEVI int M(int) const { return NROWS; }
    DEVI int arow(int, int r) const { return r; }
    DEVI int nunits() const { return (NROWS / 256) * (INP / 256); }
    DEVI void unit(int L, int& z, int& pm, int& pn) const { z = 0; dense_unit(L, NROWS / 256, INP / 256, pm, pn); }
    DEVI unsigned aoffb(int, int r) const { return (unsigned)r * (unsigned)(lda * 2); }
    DEVI const bf16_t* Bt(int) const { return B; }
    DEVI void store(int, int r, int c0, const float (&v)[8]) const {
        if (c0 >= INC) return;
        uint4 o; o.x = pk2(v[0], v[1]); o.y = pk2(v[2], v[3]); o.z = pk2(v[4], v[5]); o.w = pk2(v[6], v[7]);
        if (c0 < 512) { *(uint4*)(QK + (size_t)r * 512 + c0) = o; }
        else if (c0 < 1024) { *(uint4*)(V + (size_t)r * 512 + (c0 - 512)) = o; }
        else if (c0 < 1536) { *(uint4*)(R + (size_t)r * 512 + (c0 - 1024)) = o; }
        else if (c0 < 1568) { float* p = LR + (size_t)r * 32 + (c0 - 1536); *(float4*)p = make_float4(v[0], v[1], v[2], v[3]); *(float4*)(p + 4) = make_float4(v[4], v[5], v[6], v[7]); }
        else { const int j = c0 - 1568;
            const int g = j >> 4, ch = j & 15; int urow, ucol;
            if (r < NTOK) { const int b = r >> 12, n = r & 4095, gr = n >> 6, gc = n & 63, s = gc * 64 + gr; urow = b * 256 + (s >> 4); ucol = (s & 15) * 16 + ch; }
            else { const int q = r - NTOK, b = q >> 8, t = q & 255; urow = 2048 + b * 16 + (t >> 4); ucol = (t & 15) * 16 + ch; }
            *(uint4*)(U2 + ((size_t)g * 2304 + urow) * 512 + ucol) = o; }
    }
};
struct ProbGlu {
    static constexpr bool HOIST = false, PAIR = false, FP8 = false;
    const bf16_t* A; int lda; const bf16_t* B; int ldb; int K; const float* bias; bf16_t* MIX;
    DEVI int M(int) const { return NTOK; }
    DEVI int arow(int, int r) const { return r; }
    DEVI int nunits() const { return (NTOK / 256) * 2; }
    DEVI void unit(int L, int& z, int& pm, int& pn) const { z = 0; dense_unit(L, NTOK / 256, 2, pm, pn); }
    DEVI unsigned aoffb(int, int r) const { return (unsigned)r * (unsigned)(lda * 2); }
    DEVI const bf16_t* Bt(int) const { return B; }
    DEVI void store(int, int r, int c0, const float (&v)[8]) const {
        const uint4 yv = *(const uint4*)(A + (size_t)r * lda + c0); const unsigned yw[4] = {yv.x, yv.y, yv.z, yv.w}; float o[8];
#pragma unroll
        for (int j = 0; j < 4; ++j) { const float y0 = __uint_as_float(yw[j] << 16), y1 = __uint_as_float(yw[j] & 0xffff0000u);
            o[2 * j] = y0 * sigmoidf_(v[2 * j] + bias[c0 + 2 * j]); o[2 * j + 1] = y1 * sigmoidf_(v[2 * j + 1] + bias[c0 + 2 * j + 1]); }
        uint4 w; w.x = pk2(o[0], o[1]); w.y = pk2(o[2], o[3]); w.z = pk2(o[4], o[5]); w.w = pk2(o[6], o[7]);
        *(uint4*)(MIX + (size_t)r * DM + 512 + c0) = w;
    }
};
struct ProbOut {
    static constexpr bool HOIST = false, PAIR = false, FP8 = false;
    const bf16_t* A; int lda; const bf16_t* B; int ldb; int K; const float* x; const float* mod; float* X1;
    DEVI int M(int) const { return NTOK; }
    DEVI int arow(int, int r) const { return r; }
    DEVI int nunits() const { return (NTOK / 256) * 4; }
    DEVI void unit(int L, int& z, int& pm, int& pn) const { z = 0; dense_unit(L, NTOK / 256, 4, pm, pn); }
    DEVI unsigned aoffb(int, int r) const { return (unsigned)r * (unsigned)(lda * 2); }
    DEVI const bf16_t* Bt(int) const { return B; }
    DEVI void store(int, int r, int c0, const float (&v)[8]) const {
        uint4 o; o.x = pk2(v[0], v[1]); o.y = pk2(v[2], v[3]); o.z = pk2(v[4], v[5]); o.w = pk2(v[6], v[7]);
        *(uint4*)((bf16_t*)(X1 + (size_t)r * DM) + DM + c0) = o;
    }
};
struct ProbMoe1 {
    const bf16_t* A; int lda; const bf16_t* B; int ldb; int K; const int* cnt; const int* offs; const int* list; const float* b_gu; bf16_t* ACT;
    DEVI int M(int z) const { return cnt[z]; }
    DEVI int arow(int z, int r) const { return list[z * LISTCAP + r] >> 2; }
    DEVI const bf16_t* Bt(int z) const { return B + (size_t)z * 2048 * DM; }
    DEVI void store(int, int, int, const float (&)[8]) const {}
};
struct ProbMoe2 {
    const bf16_t* A; int lda; const bf16_t* B; int ldb; int K; const int* cnt; const int* offs; const int* list; const float* b_down; const float* gate; bf16_t* YSL;
    DEVI int M(int z) const { return cnt[z]; }
    DEVI int arow(int z, int r) const { return offs[z] + r; }
    DEVI const bf16_t* Bt(int z) const { return B + (size_t)z * DM * DFF; }
    DEVI void store(int z, int r, int c0, const float (&v)[8]) const {
        const int ent = list[z * LISTCAP + r]; const float gt = gate[ent]; const float* bd = b_down + (size_t)z * DM + c0;
        uint4 o; o.x = pk2((v[0] + bd[0]) * gt, (v[1] + bd[1]) * gt); o.y = pk2((v[2] + bd[2]) * gt, (v[3] + bd[3]) * gt);
        o.z = pk2((v[4] + bd[4]) * gt, (v[5] + bd[5]) * gt); o.w = pk2((v[6] + bd[6]) * gt, (v[7] + bd[7]) * gt);
        *(uint4*)(YSL + (size_t)ent * DM + c0) = o;
    }
};

DEVI void gla_naive_body(const bf16_t* __restrict__ QK, const bf16_t* __restrict__ V, const float* __restrict__ LR, const float* __restrict__ lr_up,
                                                   const float* __restrict__ lr_bias, float* __restrict__ OF, float* __restrict__ OB, LAS float* sm, int item) {
    LAS float* sq = sm; LAS float* sk = sm + 64; LAS float* sa = sm + 128; LAS float* sv = sm + 192; LAS float* red = sm + 320;
    const int dir = item & 1, hh = (item >> 1) & 3, b = item >> 3, tid = threadIdx.x, e = tid & 127, dg = tid >> 7;
    float up[16]; float bias = 0.f;
    if (tid < 64) { for (int r = 0; r < 16; ++r) up[r] = lr_up[dir * 4096 + r * 256 + hh * 64 + tid]; bias = lr_bias[dir * 256 + hh * 64 + tid]; }
    float S[16];
#pragma unroll
    for (int i = 0; i < 16; ++i) S[i] = 0.f;
    float* O = dir ? OB : OF;
    for (int step = 0; step < CTX + SEQ; ++step) {
        int row;
        if (step < CTX) row = NTOK + b * CTX + (dir ? CTX - 1 - step : step);
        else { const int t = step - CTX; row = b * SEQ + (dir ? SEQ - 1 - t : t); }
        if (tid < 64) { const float* lp = LR + (size_t)row * 32 + dir * 16; float g = bias;
#pragma unroll
            for (int r = 0; r < 16; ++r) g += lp[r] * up[r];
            sa[tid] = __expf(logsigmoidf_(g) * (1.f / 16.f));
            sq[tid] = bf2f(QK[(size_t)row * 512 + hh * 64 + tid]) * 0.125f; sk[tid] = bf2f(QK[(size_t)row * 512 + 256 + hh * 64 + tid]); }
        else if (tid < 192) sv[tid - 64] = bf2f(V[(size_t)row * 512 + hh * 128 + (tid - 64)]);
        __syncthreads();
        const float v = sv[e]; float part = 0.f;
#pragma unroll
        for (int i = 0; i < 16; ++i) { const int d = dg * 16 + i; S[i] = sa[d] * S[i] + sk[d] * v; part += sq[d] * S[i]; }
        if (step >= CTX) red[dg * 128 + e] = part;
        __syncthreads();
        if (step >= CTX && dg == 0) O[(size_t)row * 512 + hh * 128 + e] = (red[e] + red[128 + e]) + (red[256 + e] + red[384 + e]);
    }
}
__global__ __launch_bounds__(512) void k_gla_naive(const bf16_t* __restrict__ QK, const bf16_t* __restrict__ V, const float* __restrict__ LR, const float* __restrict__ lr_up,
                                                   const float* __restrict__ lr_bias, float* __restrict__ OF, float* __restrict__ OB) {
    __shared__ float sm[832];
    gla_naive_body(QK, V, LR, lr_up, lr_bias, OF, OB, (LAS float*)sm, blockIdx.x);
}
DEVI void gla_post_row(const float* __restrict__ OF, const float* __restrict__ OB, const bf16_t* __restrict__ R, const float* __restrict__ nw, bf16_t* __restrict__ MIX, int tok, int lane) {
    const int c0 = lane * 8;
    float o[8]; float ss = 0.f;
#pragma unroll
    for (int j = 0; j < 8; ++j) { o[j] = OF[(size_t)tok * 512 + c0 + j] + OB[(size_t)tok * 512 + c0 + j]; ss += o[j] * o[j]; }
    ss += __shfl_xor(ss, 1); ss += __shfl_xor(ss, 2); ss += __shfl_xor(ss, 4); ss += __shfl_xor(ss, 8);
    const float rstd = rsqrtf(ss * (1.f / 128.f) + 1e-6f);
    float w[8];
#pragma unroll
    for (int j = 0; j < 8; ++j) { const float r = bf2f(R[(size_t)tok * 512 + c0 + j]); w[j] = o[j] * rstd * nw[(c0 + j) & 127] * siluf_(r); }
    uint4 q; q.x = pk2(w[0], w[1]); q.y = pk2(w[2], w[3]); q.z = pk2(w[4], w[5]); q.w = pk2(w[6], w[7]);
    *(uint4*)(MIX + (size_t)tok * DM + c0) = q;
}
__global__ __launch_bounds__(256) void k_gla_post(const float* __restrict__ OF, const float* __restrict__ OB, const bf16_t* __restrict__ R, const float* __restrict__ nw, bf16_t* __restrict__ MIX) {
    gla_post_row(OF, OB, R, nw, MIX, blockIdx.x * 4 + (threadIdx.x >> 6), threadIdx.x & 63);
}

DEVI void s5_naive_body(const bf16_t* __restrict__ UT, const S5P* __restrict__ P, const float* __restrict__ c_re, const float* __restrict__ c_im,
                                                  float* __restrict__ YF, float* __restrict__ YB, LAS float* hsw  , int id, int lane) {
    const int g = id & 31, dir = (id >> 5) & 1, b = id >> 6;
    const float lr = P->lamb[dir][g][lane][0], li = P->lamb[dir][g][lane][1];
    float br[16], bi[16];
#pragma unroll
    for (int h = 0; h < 16; ++h) { br[h] = P->bbar[dir][g][lane][h][0]; bi[h] = P->bbar[dir][g][lane][h][1]; }
    const int ch = lane & 15, part = lane >> 4;
    float cr[16], ci[16];
#pragma unroll
    for (int i = 0; i < 16; ++i) { const size_t ix = (((size_t)dir * 32 + g) * 16 + ch) * 64 + part * 16 + i; cr[i] = c_re[ix]; ci[i] = c_im[ix]; }
    float hr = 0.f, hi = 0.f; float* Y = dir ? YB : YF;
    for (int step = 0; step < CTX + SEQ; ++step) {
        int row;
        if (step < CTX) row = NTOK + b * CTX + (dir ? CTX - 1 - step : step);
        else { const int t = step - CTX, s = dir ? SEQ - 1 - t : t; row = b * SEQ + (s & 63) * 64 + (s >> 6); }
        const uint4 u0 = *(const uint4*)(UT + (size_t)row * 512 + g * 16), u1 = *(const uint4*)(UT + (size_t)row * 512 + g * 16 + 8);
        const unsigned uw[8] = {u0.x, u0.y, u0.z, u0.w, u1.x, u1.y, u1.z, u1.w};
        float bur = 0.f, bui = 0.f;
#pragma unroll
        for (int j = 0; j < 8; ++j) { const float ua = __uint_as_float(uw[j] << 16), ub = __uint_as_float(uw[j] & 0xffff0000u);
            bur += br[2 * j] * ua + br[2 * j + 1] * ub; bui += bi[2 * j] * ua + bi[2 * j + 1] * ub; }
        const float nr = lr * hr - li * hi + bur, ni = lr * hi + li * hr + bui; hr = nr; hi = ni;
        if (step >= CTX) {
            hsw[lane] = hr; hsw[64 + lane] = hi;
            asm volatile("s_waitcnt lgkmcnt(0)" ::: "memory");
            float acc = 0.f;
#pragma unroll
            for (int i = 0; i < 16; ++i) acc += cr[i] * hsw[part * 16 + i] - ci[i] * hsw[64 + part * 16 + i];
            acc += __shfl_xor(acc, 16); acc += __shfl_xor(acc, 32);
            asm volatile("s_waitcnt lgkmcnt(0)" ::: "memory");
            if (lane < 16) Y[(size_t)row * 512 + g * 16 + lane] = acc;
        }
    }
}
__global__ __launch_bounds__(256) void k_s5_naive(const bf16_t* __restrict__ UT, const S5P* __restrict__ P, const float* __restrict__ c_re, const float* __restrict__ c_im,
                                                  float* __restrict__ YF, float* __restrict__ YB) {
    __shared__ float hs[4][128];
    const int w = threadIdx.x >> 6;
    s5_naive_body(UT, P, c_re, c_im, YF, YB, (LAS float*)hs[w], blockIdx.x * 4 + w, threadIdx.x & 63);
}
__global__ __launch_bounds__(256) void k_s5_post(const float* __restrict__ YF, const float* __restrict__ YB, const bf16_t* __restrict__ UT, const float* __restrict__ dvec, bf16_t* __restrict__ YS) {
    const size_t i = (size_t)blockIdx.x * 256 + threadIdx.x; const int j = (int)(i & 511);
    const float y = YF[i] + YB[i] + dvec[j] * bf2f(UT[i]);
    YS[i] = f2bf(gelu_tanh(y));
}

DEVI void router_row(const float* __restrict__ X1, const float* __restrict__ w, const float* __restrict__ mod, const float* __restrict__ rw, const float* __restrict__ rb,
                                                bf16_t* __restrict__ H2, int* __restrict__ cnt, int* __restrict__ list, float* __restrict__ gate, LAS float* hrw  , int tok, int lane) {
    const int b = tok / SEQ;
    const float* src = X1 + (size_t)tok * DM;
    float4 v[4]; float ss = 0.f;
#pragma unroll
    for (int j = 0; j < 4; ++j) { v[j] = *(const float4*)(src + lane * 4 + 256 * j); ss += v[j].x * v[j].x + v[j].y * v[j].y + v[j].z * v[j].z + v[j].w * v[j].w; }
    const float rstd = rsqrtf(wave_sum(ss) * (1.f / DM) + 1e-6f);
    const float* msh = mod + b * 6144 + 3072; const float* msc = mod + b * 6144 + 4096;
#pragma unroll
    for (int j = 0; j < 4; ++j) { const int k = lane * 4 + 256 * j;
        const float4 ww = *(const float4*)(w + k), sc = *(const float4*)(msc + k), sh = *(const float4*)(msh + k);
        float4 h; h.x = v[j].x * rstd * ww.x * (1.f + sc.x) + sh.x; h.y = v[j].y * rstd * ww.y * (1.f + sc.y) + sh.y; h.z = v[j].z * rstd * ww.z * (1.f + sc.z) + sh.z; h.w = v[j].w * rstd * ww.w * (1.f + sc.w) + sh.w;
        hrw[k] = h.x; hrw[k + 1] = h.y; hrw[k + 2] = h.z; hrw[k + 3] = h.w;
        uint2 o; o.x = pk2(h.x, h.y); o.y = pk2(h.z, h.w); *(uint2*)(H2 + (size_t)tok * DM + k) = o; }
    asm volatile("s_waitcnt lgkmcnt(0)" ::: "memory");
    const int e = lane & 31, half = lane >> 5; float lg = 0.f;
    for (int k = half * 512; k < half * 512 + 512; ++k) lg += hrw[k] * rw[k * 32 + e];
    lg += __shfl_xor(lg, 32); lg += rb[e];
    float val = lg; float tv[4]; int ti[4];
#pragma unroll
    for (int t = 0; t < 4; ++t) { float bv = val; int bi = e;
#pragma unroll
        for (int o = 1; o < 32; o <<= 1) { const float ov = __shfl_xor(bv, o); const int oi = __shfl_xor(bi, o); if (ov > bv || (ov == bv && oi < bi)) { bv = ov; bi = oi; } }
        tv[t] = bv; ti[t] = bi; if (e == bi) val = -3.0e38f; }
    const float e1 = __expf(tv[1] - tv[0]), e2 = __expf(tv[2] - tv[0]), e3 = __expf(tv[3] - tv[0]), inv = 1.f / (1.f + e1 + e2 + e3);
    if (lane < 4) { const float gv = lane == 0 ? inv : lane == 1 ? e1 * inv : lane == 2 ? e2 * inv : e3 * inv; const int ex = lane == 0 ? ti[0] : lane == 1 ? ti[1] : lane == 2 ? ti[2] : ti[3];
        const int slot = atomicAdd(&cnt[ex], 1); list[ex * LISTCAP + slot] = tok * 4 + lane; gate[tok * 4 + lane] = gv; }
}
__global__ __launch_bounds__(256) void k_router(const float* __restrict__ X1, const float* __restrict__ w, const float* __restrict__ mod, const float* __restrict__ rw, const float* __restrict__ rb,
                                                bf16_t* __restrict__ H2, int* __restrict__ cnt, int* __restrict__ list, float* __restrict__ gate) {
    __shared__ float hrow[4][1024];
    const int wv = threadIdx.x >> 6;
    router_row(X1, w, mod, rw, rb, H2, cnt, list, gate, (LAS float*)hrow[wv], blockIdx.x * 4 + wv, threadIdx.x & 63);
}
__global__ void k_offsets(const int* cnt, int* offs) { if (threadIdx.x == 0) { int o = 0; for (int e = 0; e < NEXP; ++e) { offs[e] = o; o += (cnt[e] + MOEPAD - 1) / MOEPAD * MOEPAD; } offs[NEXP] = o; } }

DEVI void final_row(const float* __restrict__ X, float* __restrict__ X1, const bf16_t* __restrict__ Y2, const float* __restrict__ mod, const float* __restrict__ fw, const float* __restrict__ gate, const int* __restrict__ epos,
                    const LAS int* ub, int tok, int lane, float* __restrict__ OUT = nullptr) {
    const int b = tok / SEQ;
    float* row = X1 + (size_t)tok * DM; float* orow = OUT ? OUT + (size_t)tok * DM : row; const float* g2 = mod + b * 6144 + 5120; const float* g1p = mod + b * 6144 + 2048;
    const float* xrow = X + (size_t)tok * DM; const bf16_t* mrow = (const bf16_t*)row + DM;
    const int4 ep = *(const int4*)(epos + tok * 4); const float4 gt = *(const float4*)(gate + tok * 4);
    constexpr int YB = MOE_FP8 ? 1 : 2;
    const char* y0 = (const char*)Y2 + (size_t)(ub[ep.x / LISTCAP] * 256 + ep.x % LISTCAP) * DM * YB; const char* y1 = (const char*)Y2 + (size_t)(ub[ep.y / LISTCAP] * 256 + ep.y % LISTCAP) * DM * YB;
    const char* y2 = (const char*)Y2 + (size_t)(ub[ep.z / LISTCAP] * 256 + ep.z % LISTCAP) * DM * YB; const char* y3 = (const char*)Y2 + (size_t)(ub[ep.w / LISTCAP] * 256 + ep.w % LISTCAP) * DM * YB;
    float4 v[4]; float ss = 0.f;
#pragma unroll
    for (int j = 0; j < 4; ++j) { const int k = lane * 4 + 256 * j; v[j] = *(const float4*)(xrow + k);
        { const uint2 mm = *(const uint2*)(mrow + k); const float4 g1 = *(const float4*)(g1p + k);
          v[j].x += g1.x * __uint_as_float(mm.x << 16); v[j].y += g1.y * __uint_as_float(mm.x & 0xffff0000u); v[j].z += g1.z * __uint_as_float(mm.y << 16); v[j].w += g1.w * __uint_as_float(mm.y & 0xffff0000u); }
        float f[4];
        if (MOE_FP8) { const int q0 = *(const int*)(y0 + k), q1 = *(const int*)(y1 + k), q2 = *(const int*)(y2 + k), q3 = *(const int*)(y3 + k);
            f[0] = gt.x * __builtin_amdgcn_cvt_f32_fp8(q0, 0) + gt.y * __builtin_amdgcn_cvt_f32_fp8(q1, 0) + gt.z * __builtin_amdgcn_cvt_f32_fp8(q2, 0) + gt.w * __builtin_amdgcn_cvt_f32_fp8(q3, 0);
            f[1] = gt.x * __builtin_amdgcn_cvt_f32_fp8(q0, 1) + gt.y * __builtin_amdgcn_cvt_f32_fp8(q1, 1) + gt.z * __builtin_amdgcn_cvt_f32_fp8(q2, 1) + gt.w * __builtin_amdgcn_cvt_f32_fp8(q3, 1);
            f[2] = gt.x * __builtin_amdgcn_cvt_f32_fp8(q0, 2) + gt.y * __builtin_amdgcn_cvt_f32_fp8(q1, 2) + gt.z * __builtin_amdgcn_cvt_f32_fp8(q2, 2) + gt.w * __builtin_amdgcn_cvt_f32_fp8(q3, 2);
            f[3] = gt.x * __builtin_amdgcn_cvt_f32_fp8(q0, 3) + gt.y * __builtin_amdgcn_cvt_f32_fp8(q1, 3) + gt.z * __builtin_amdgcn_cvt_f32_fp8(q2, 3) + gt.w * __builtin_amdgcn_cvt_f32_fp8(q3, 3);
        } else {
        const uint2 a0 = *(const uint2*)(y0 + 2 * k), a1 = *(const uint2*)(y1 + 2 * k), a2 = *(const uint2*)(y2 + 2 * k), a3 = *(const uint2*)(y3 + 2 * k);
        f[0] = gt.x * __uint_as_float(a0.x << 16) + gt.y * __uint_as_float(a1.x << 16) + gt.z * __uint_as_float(a2.x << 16) + gt.w * __uint_as_float(a3.x << 16);
        f[1] = gt.x * __uint_as_float(a0.x & 0xffff0000u) + gt.y * __uint_as_float(a1.x & 0xffff0000u) + gt.z * __uint_as_float(a2.x & 0xffff0000u) + gt.w * __uint_as_float(a3.x & 0xffff0000u);
        f[2] = gt.x * __uint_as_float(a0.y << 16) + gt.y * __uint_as_float(a1.y << 16) + gt.z * __uint_as_float(a2.y << 16) + gt.w * __uint_as_float(a3.y << 16);
        f[3] = gt.x * __uint_as_float(a0.y & 0xffff0000u) + gt.y * __uint_as_float(a1.y & 0xffff0000u) + gt.z * __uint_as_float(a2.y & 0xffff0000u) + gt.w * __uint_as_float(a3.y & 0xffff0000u); }
        const float4 gg = *(const float4*)(g2 + k);
        v[j].x += gg.x * f[0]; v[j].y += gg.y * f[1]; v[j].z += gg.z * f[2]; v[j].w += gg.w * f[3];
        ss += v[j].x * v[j].x + v[j].y * v[j].y + v[j].z * v[j].z + v[j].w * v[j].w; }
    const float rstd = rsqrtf(wave_sum(ss) * (1.f / DM) + 1e-6f);
#pragma unroll
    for (int j = 0; j < 4; ++j) { const int k = lane * 4 + 256 * j; const float4 ww = *(const float4*)(fw + k);
        *(float4*)(orow + k) = make_float4(v[j].x * rstd * ww.x, v[j].y * rstd * ww.y, v[j].z * rstd * ww.z, v[j].w * rstd * ww.w); }
}

typedef short bf16x8 __attribute__((ext_vector_type(8)));
typedef float f32x4 __attribute__((ext_vector_type(4)));
typedef unsigned u32x4 __attribute__((ext_vector_type(4)));
typedef unsigned u32x2 __attribute__((ext_vector_type(2)));
typedef int i32x4 __attribute__((ext_vector_type(4)));
typedef int i32x8 __attribute__((ext_vector_type(8)));

constexpr int NWAVES = 8, NTHR = 512;
constexpr int BM = 256, BK = 64, HALF = 128, HTB = HALF * BK * 2, STAGE_BYTES = 8 * HTB;
constexpr int MISC_OFF = 147456, MISC_BYTES = 1024, LDS_BYTES = MISC_OFF + MISC_BYTES;
constexpr int CW_BAR = 4096;

#define XB_TMO      128
#define XB_XCNT(j)  (256  + 64 * (j))
#define XB_XSUB(j)  (1280 + 64 * (j))
#define XB_XGEN(j)  (2304 + 64 * (j))
#define XB_TOP      3328
#define XB_TOPGEN   3392
#define XCD_BAR_WORDS 3456
#define XB_SPIN_CAP (1u << 18)
DEVI unsigned xb_ld(unsigned* p)              { return __hip_atomic_load(p, __ATOMIC_RELAXED, __HIP_MEMORY_SCOPE_AGENT); }
DEVI unsigned xb_add(unsigned* p, unsigned v) { return __hip_atomic_fetch_add(p, v, __ATOMIC_RELAXED, __HIP_MEMORY_SCOPE_AGENT); }
DEVI unsigned xb_xcc_id() { return (unsigned)__builtin_amdgcn_s_getreg((3 << 11) | 20) & 0xFu; }
#define XB_SPIN(cond, bar) do { unsigned _sp = 0; while (cond) { __builtin_amdgcn_s_sleep(1); \
    if ((++_sp & 255u) == 0u) { if (xb_ld(&(bar)[XB_TMO])) break; if (_sp > XB_SPIN_CAP) { atomicAdd(&(bar)[XB_TMO], 1u); break; } } } } while (0)
struct XcdBarrier { unsigned* bar; unsigned x; volatile LAS unsigned* st; };
DEVI XcdBarrier xcd_barrier_post(unsigned* bar, volatile LAS unsigned* st) {
    XcdBarrier b; b.bar = bar; b.x = xb_xcc_id(); b.st = st;
    if (threadIdx.x == 0) (void)xb_add(&bar[XB_XCNT(b.x)], 1u);
    return b;
}
DEVI void xcd_barrier_complete(unsigned* bar, unsigned x, unsigned& nloc, unsigned& nx) {
    const unsigned G = gridDim.x * gridDim.y * gridDim.z;
    unsigned sum, cnt, mine, sp = 0u;
    for (;;) {
        sum = 0u; cnt = 0u; mine = 0u;
#pragma unroll
        for (unsigned j = 0; j < 16; ++j) { const unsigned c = xb_ld(&bar[XB_XCNT(j)]); sum += c; cnt += (c > 0u) ? 1u : 0u; mine = (j == x) ? c : mine; }
        if (sum == G) break;
        __builtin_amdgcn_s_sleep(1);
        if ((++sp & 255u) == 0u) { if (xb_ld(&bar[XB_TMO])) break; if (sp > XB_SPIN_CAP) { atomicAdd(&bar[XB_TMO], 1u); break; } }
    }
    nloc = mine > 0u ? mine : 1u; nx = cnt > 0u ? cnt : 1u;
}
DEVI void xcd_barrier(const XcdBarrier& b) {
    asm volatile("s_waitcnt vmcnt(0)" ::: "memory");
    __syncthreads();
    if (threadIdx.x == 0) {
        unsigned* bar = b.bar;
        __builtin_amdgcn_s_waitcnt(0);
        unsigned nloc = b.st[0], nx = b.st[1];
        if (nloc == 0u) { xcd_barrier_complete(bar, b.x, nloc, nx); b.st[0] = nloc; b.st[1] = nx; }
        const unsigned old = xb_add(&bar[XB_XSUB(b.x)], 1u);
        const unsigned gen = old / nloc;
        if (old + 1u == (gen + 1u) * nloc) {
            __builtin_amdgcn_fence(__ATOMIC_RELEASE, "agent");
            asm volatile("s_waitcnt vmcnt(0)" ::: "memory");
            const unsigned og = xb_add(&bar[XB_TOP], 1u);
            const unsigned tg = og / nx;
            if (og + 1u == (tg + 1u) * nx) xb_add(&bar[XB_TOPGEN], 1u);
            else XB_SPIN(xb_ld(&bar[XB_TOPGEN]) == tg, bar);
            __builtin_amdgcn_fence(__ATOMIC_ACQUIRE, "agent");
            xb_add(&bar[XB_XGEN(b.x)], 1u);
            asm volatile("s_waitcnt vmcnt(0)" ::: "memory");
        } else {
            XB_SPIN(xb_ld(&bar[XB_XGEN(b.x)]) == gen, bar);
            __builtin_amdgcn_fence(__ATOMIC_ACQUIRE, "agent");
            asm volatile("s_waitcnt vmcnt(0)" ::: "memory");
        }
    }
    __syncthreads();
}

DEVI int lds_byte(int r, int c) { const int st = (r >> 4) * 2 + (c >> 5), rr = r & 15, cc = c & 31, ob = rr * 64 + cc * 2; return st * 1024 + (ob ^ (((ob >> 9) & 1) << 5)); }
DEVI void stage_rc(int b, int& R, int& C) { const int st = b / 1024, sb = b % 1024, swz = sb ^ (((sb >> 9) & 1) << 5); R = (st >> 1) * 16 + swz / 64; C = (st & 1) * 32 + (swz % 64) / 2; }
DEVI int perm32(int rho) { const int n = rho >> 4, i = rho & 15; return 8 * (i >> 2) + 4 * n + (i & 3); }
template <int VMODE = 0, class Prob>
DEVI void gemm_phase(LAS unsigned char* lds, const Prob& P, int G, int c) {
    int tid = threadIdx.x; asm volatile("" : "+v"(tid));
    const int wid = __builtin_amdgcn_readfirstlane(tid >> 6), lane = tid & 63, wr = wid >> 2, wc = wid & 3, fr = lane & 15, fq = lane >> 4;
    const int K = P.K, nt = K / BK;
    const int nun = P.nunits();
    int L = c; if (L >= nun) return;
    int Rs0, Cs0, Rs1, Cs1; stage_rc(tid * 16, Rs0, Cs0); stage_rc(tid * 16 + 8192, Rs1, Cs1);
    unsigned voffB[2];
    voffB[0] = (unsigned)(((Rs0 & ~31) + perm32(Rs0 & 31)) * K + Cs0) * 2u; voffB[1] = (unsigned)(((Rs1 & ~31) + perm32(Rs1 & 31)) * K + Cs1) * 2u;
    const size_t kstep = (size_t)(BK * 2), hstepB = (size_t)HALF * K * 2, tstepB = 2 * hstepB;
    const unsigned ldsw = (unsigned)wid * 1024u;
    const int aoff = lds_byte(wr * 64 + fr, fq * 8), boff = lds_byte(wc * 32 + fr, fq * 8);
#define G_SA(b, h) (((b) * 2 + (h)) * HTB)
#define G_SB(b, h) ((4 + (b) * 2 + (h)) * HTB)
#define G_STAGE_B(bufoff, gbase) do { _Pragma("unroll") for (int _i = 0; _i < 2; ++_i) \
        __builtin_amdgcn_global_load_lds((const unsigned*)((const char*)(gbase) + voffB[_i]), (LAS unsigned*)(lds + (bufoff) + ldsw + _i * 8192), 16, 0, 0); } while (0)
#define G_STAGE_A(bufoff, gbase, v0, v1) do { \
        __builtin_amdgcn_global_load_lds((const unsigned*)((const char*)(gbase) + (v0)), (LAS unsigned*)(lds + (bufoff) + ldsw), 16, 0, 0); \
        __builtin_amdgcn_global_load_lds((const unsigned*)((const char*)(gbase) + (v1)), (LAS unsigned*)(lds + (bufoff) + ldsw + 8192), 16, 0, 0); } while (0)
#define G_LDA(dst, b, h) do { _Pragma("unroll") for (int m = 0; m < 4; ++m) _Pragma("unroll") for (int k = 0; k < 2; ++k) dst[m][k] = *(const LAS bf16x8*)(lds + G_SA(b, h) + aoff + m * 2048 + k * 1024); } while (0)
#define G_LDB(dst, b, h) do { _Pragma("unroll") for (int n = 0; n < 2; ++n) _Pragma("unroll") for (int k = 0; k < 2; ++k) dst[n][k] = *(const LAS bf16x8*)(lds + G_SB(b, h) + boff + n * 2048 + k * 1024); } while (0)
#define G_MMA(ai, bj, At, Bt) do { __builtin_amdgcn_s_setprio(1); _Pragma("unroll") for (int m = 0; m < 4; ++m) _Pragma("unroll") for (int n = 0; n < 2; ++n) { \
        if constexpr (Prob::FP8) { const i32x8 b8 = __builtin_shufflevector(__builtin_bit_cast(i32x4, Bt[n][0]), __builtin_bit_cast(i32x4, Bt[n][1]), 0, 1, 2, 3, 4, 5, 6, 7); \
            const i32x8 a8 = __builtin_shufflevector(__builtin_bit_cast(i32x4, At[m][0]), __builtin_bit_cast(i32x4, At[m][1]), 0, 1, 2, 3, 4, 5, 6, 7); \
            acc[ai][bj][m][n] = __builtin_amdgcn_mfma_scale_f32_16x16x128_f8f6f4(b8, a8, acc[ai][bj][m][n], 0, 0, 0, 0x7a7a7a7a, 0, 0x7f7f7f7f); } \
        else { _Pragma("unroll") for (int k = 0; k < 2; ++k) acc[ai][bj][m][n] = __builtin_amdgcn_mfma_f32_16x16x32_bf16(Bt[n][k], At[m][k], acc[ai][bj][m][n], 0, 0, 0); } } \
        __builtin_amdgcn_s_setprio(0); } while (0)
#define G_WAIT_V(n) asm volatile("s_waitcnt vmcnt(" #n ")" ::: "memory")
#define G_WAIT_L(n) asm volatile("s_waitcnt lgkmcnt(" #n ")" ::: "memory")
#define G_BAR __builtin_amdgcn_s_barrier()
#define G_SCHED __builtin_amdgcn_sched_barrier(0)
    int z, pm, pn; P.unit(L, z, pm, pn);
    z = __builtin_amdgcn_readfirstlane(z); pm = __builtin_amdgcn_readfirstlane(pm); pn = __builtin_amdgcn_readfirstlane(pn);
    unsigned vA00 = P.aoffb(z, pm * BM + Rs0) + Cs0 * 2, vA01 = P.aoffb(z, pm * BM + Rs1) + Cs1 * 2;
    unsigned vA10 = P.aoffb(z, pm * BM + HALF + Rs0) + Cs0 * 2, vA11 = P.aoffb(z, pm * BM + HALF + Rs1) + Cs1 * 2;
    const char* const Ab = (const char*)P.A;
    const char* cB = (const char*)P.Bt(z) + (size_t)pn * tstepB;
    f32x4 acc[2][2][4][2];
    bf16x8 At[4][2], B0[2][2], B1[2][2];
    G_STAGE_B(G_SB(0, 0), cB); G_STAGE_A(G_SA(0, 0), Ab, vA00, vA01); G_STAGE_B(G_SB(0, 1), cB + hstepB); G_STAGE_A(G_SA(0, 1), Ab, vA10, vA11);
    if (wr == 1) G_BAR;
    G_WAIT_V(4); G_BAR;
    G_STAGE_B(G_SB(1, 0), cB + kstep); G_STAGE_A(G_SA(1, 0), Ab + kstep, vA00, vA01); G_STAGE_B(G_SB(1, 1), cB + hstepB + kstep);
    G_WAIT_V(6); G_BAR;
    for (;;) {
        const int Ln = L + G; const bool has_next = Ln < nun;
        int nz = z, npm = pm, npn = pn; if (has_next) P.unit(Ln, nz, npm, npn);
        nz = __builtin_amdgcn_readfirstlane(nz); npm = __builtin_amdgcn_readfirstlane(npm); npn = __builtin_amdgcn_readfirstlane(npn);
        const char* nB = has_next ? (const char*)P.Bt(nz) + (size_t)npn * tstepB : cB;
        unsigned n00 = vA00, n01 = vA01, n10 = vA10, n11 = vA11;
        if (has_next) { n00 = P.aoffb(nz, npm * BM + Rs0) + Cs0 * 2; n01 = P.aoffb(nz, npm * BM + Rs1) + Cs1 * 2;
            n10 = P.aoffb(nz, npm * BM + HALF + Rs0) + Cs0 * 2; n11 = P.aoffb(nz, npm * BM + HALF + Rs1) + Cs1 * 2; }
#pragma unroll
        for (int a = 0; a < 2; ++a)
#pragma unroll
            for (int b = 0; b < 2; ++b)
#pragma unroll
                for (int m = 0; m < 4; ++m)
#pragma unroll
                    for (int n = 0; n < 2; ++n) acc[a][b][m][n] = (f32x4){0.f, 0.f, 0.f, 0.f};
#pragma unroll 1
        for (int t = 0; t < nt; t += 2) {
            const bool last = (t == nt - 2);
            const char* a1 = Ab + (size_t)(t + 1) * kstep;
            const char* a2 = last ? Ab : Ab + (size_t)(t + 2) * kstep; const char* b2 = last ? nB : cB + (size_t)(t + 2) * kstep;
            const char* a3 = a2 + kstep; const char* b3 = b2 + kstep;
            G_LDB(B0, 0, 0); G_SCHED; G_LDA(At, 0, 0); G_STAGE_A(G_SA(1, 1), a1, vA10, vA11);
            G_WAIT_L(8); G_BAR; G_WAIT_L(0); G_MMA(0, 0, At, B0); G_BAR; G_SCHED;
            if (last) { vA00 = n00; vA01 = n01; vA10 = n10; vA11 = n11; }
            G_LDB(B1, 0, 1); G_STAGE_B(G_SB(0, 0), b2);
            G_BAR; G_WAIT_L(0); G_MMA(0, 1, At, B1); G_BAR;
            G_LDA(At, 0, 1); G_STAGE_A(G_SA(0, 0), a2, vA00, vA01);
            G_BAR; G_WAIT_L(0); G_MMA(1, 0, At, B0); G_BAR; G_SCHED;
            G_STAGE_B(G_SB(0, 1), b2 + hstepB);
            G_WAIT_V(6); G_BAR; G_MMA(1, 1, At, B1); G_BAR;
            G_LDB(B0, 1, 0); G_SCHED; G_LDA(At, 1, 0); G_STAGE_A(G_SA(0, 1), a2, vA10, vA11);
            G_WAIT_L(8); G_BAR; G_WAIT_L(0); G_MMA(0, 0, At, B0); G_BAR; G_SCHED;
            G_LDB(B1, 1, 1); G_STAGE_B(G_SB(1, 0), b3);
            G_BAR; G_WAIT_L(0); G_MMA(0, 1, At, B1); G_BAR;
            G_LDA(At, 1, 1); G_STAGE_A(G_SA(1, 0), a3, vA00, vA01);
            G_BAR; G_WAIT_L(0); G_MMA(1, 0, At, B0); G_BAR; G_SCHED;
            G_STAGE_B(G_SB(1, 1), b3 + hstepB);
            G_WAIT_V(6); G_BAR; G_MMA(1, 1, At, B1); G_BAR;
        }
        if constexpr (VMODE == 1) {
#pragma unroll
            for (int a_ = 0; a_ < 2; ++a_)
#pragma unroll
                for (int b_ = 0; b_ < 2; ++b_)
#pragma unroll
                    for (int m_ = 0; m_ < 4; ++m_)
#pragma unroll
                        for (int n_ = 0; n_ < 2; ++n_) asm volatile("" :: "v"(acc[a_][b_][m_][n_]));
        } else
        { const int Mz = VMODE == 2 ? 0 : __builtin_amdgcn_readfirstlane(P.M(z));
          if constexpr (VMODE == 2) {
#pragma unroll
            for (int a_ = 0; a_ < 2; ++a_)
#pragma unroll
                for (int b_ = 0; b_ < 2; ++b_)
#pragma unroll
                    for (int m_ = 0; m_ < 4; ++m_)
#pragma unroll
                        for (int n_ = 0; n_ < 2; ++n_) asm volatile("" :: "v"(acc[a_][b_][m_][n_])); }
          const int cb0 = pn * BM + wc * 32 + 8 * fq, rb0 = pm * BM + wr * 64 + fr;
          if constexpr (Prob::PAIR) {
              const typename Prob::ColCtx cc = P.colctx(z, cb0);
              typename Prob::RowCtx rc[2][4];
#pragma unroll
              for (int ai = 0; ai < 2; ++ai)
#pragma unroll
                  for (int m = 0; m < 4; ++m) { const int row = rb0 + ai * HALF + m * 16; rc[ai][m] = P.rowctx(z, row, row < Mz); }
#pragma unroll
              for (int ai = 0; ai < 2; ++ai)
#pragma unroll
                  for (int m = 0; m < 4; ++m) { const int row = rb0 + ai * HALF + m * 16;
                      if (row < Mz) { const f32x4 g0 = acc[ai][0][m][0], g1 = acc[ai][0][m][1], l0 = acc[ai][1][m][0], l1 = acc[ai][1][m][1];
                          const float vg[8] = {g0[0], g0[1], g0[2], g0[3], g1[0], g1[1], g1[2], g1[3]}, vl[8] = {l0[0], l0[1], l0[2], l0[3], l1[0], l1[1], l1[2], l1[3]};
                          P.storepair(cc, rc[ai][m], vg, vl); } }
          } else if constexpr (Prob::HOIST) {
              typename Prob::ColCtx cc[2]; typename Prob::RowCtx rc[2][4];
#pragma unroll
              for (int bj = 0; bj < 2; ++bj) cc[bj] = P.colctx(z, cb0 + bj * HALF);
#pragma unroll
              for (int ai = 0; ai < 2; ++ai)
#pragma unroll
                  for (int m = 0; m < 4; ++m) { const int row = rb0 + ai * HALF + m * 16; rc[ai][m] = P.rowctx(z, row, row < Mz); }
#pragma unroll
              for (int ai = 0; ai < 2; ++ai)
#pragma unroll
                  for (int m = 0; m < 4; ++m) { const int row = rb0 + ai * HALF + m * 16;
                      if (row < Mz) {
#pragma unroll
                          for (int bj = 0; bj < 2; ++bj) { const f32x4 v0 = acc[ai][bj][m][0], v1 = acc[ai][bj][m][1];
                              const float v[8] = {v0[0], v0[1], v0[2], v0[3], v1[0], v1[1], v1[2], v1[3]};
                              P.storeh(cc[bj], rc[ai][m], cb0 + bj * HALF, v); } } }
          } else {
#pragma unroll
          for (int ai = 0; ai < 2; ++ai)
#pragma unroll
            for (int m = 0; m < 4; ++m) { const int row = rb0 + ai * HALF + m * 16;
                if (row < Mz) {
#pragma unroll
                    for (int bj = 0; bj < 2; ++bj) { const int c0 = cb0 + bj * HALF;
                        const f32x4 v0 = acc[ai][bj][m][0], v1 = acc[ai][bj][m][1];
                        const float v[8] = {v0[0], v0[1], v0[2], v0[3], v1[0], v1[1], v1[2], v1[3]};
                        P.store(z, row, c0, v); } }
                asm volatile("" ::: "memory"); } } }
        if (!has_next) break;
        z = nz; pm = npm; pn = npn; cB = nB; L = Ln;
    }
    G_WAIT_V(0);
    if (wr == 0) G_BAR;
    G_BAR;
}

template <int NT, bool REV> DEVI void moe_unit(const LAS int* ub, int L, int G, int& z, int& pm, int& pn) {
    const int nun = __builtin_amdgcn_readfirstlane(ub[NEXP]) * NT;
    int Lq = L;
    if ((G & 7) == 0) { const int i = L / G, c = L - i * G, x = c & 7, j = c >> 3, per = G >> 3; Lq = (i * 8 + x) * per + j; }
    if (Lq >= nun) { z = -1; pm = 0; pn = 0; return; }
    if (REV) Lq = nun - 1 - Lq;
    int e = 0; while (e < NEXP - 1 && Lq >= __builtin_amdgcn_readfirstlane(ub[e + 1]) * NT) ++e;
    const int l = Lq - __builtin_amdgcn_readfirstlane(ub[e]) * NT; z = e; pm = l / NT; pn = l % NT;
}
struct FMoe1 {
    static constexpr bool HOIST = true, PAIR = true, RV = false, FP8 = MOE_FP8 != 0; static constexpr int NT = 8;
    const bf16_t* A; const bf16_t* B; int K; const int* cnt; const int* list; const float* b_gu; bf16_t* ACT; const LAS int* ub; int G;
    struct ColCtx { float bg[8], bl[8]; int f0; }; struct RowCtx { bf16_t* p; };
    DEVI int ubs(int e) const { return __builtin_amdgcn_readfirstlane(ub[e]); }
    DEVI int nunits() const { const int n = ubs(NEXP) * NT; return (G & 7) == 0 ? (n + G - 1) / G * G : n; }
    DEVI void unit(int L, int& z, int& pm, int& pn) const { moe_unit<NT, RV>(ub, L, G, z, pm, pn); }
    DEVI int M(int z) const { return z < 0 ? 0 : cnt[z]; }
    DEVI unsigned aoffb(int z, int r) const { const int t = (z >= 0 && r < cnt[z]) ? (list[z * LISTCAP + r] >> 2) : 0; return (unsigned)t * (unsigned)(FP8 ? DM : DM * 2); }
    DEVI const bf16_t* Bt(int z) const { return (const bf16_t*)((const char*)B + (size_t)(z < 0 ? 0 : z) * 2048 * DM * (FP8 ? 1 : 2)); }
    DEVI ColCtx colctx(int z, int c0) const { ColCtx c; c.f0 = (c0 >> 8) * 128 + (c0 & 127); const float* bp = b_gu + (size_t)(z < 0 ? 0 : z) * 2048 + c.f0;
        const float4 g0 = *(const float4*)bp, g1 = *(const float4*)(bp + 4), l0 = *(const float4*)(bp + 1024), l1 = *(const float4*)(bp + 1028);
        c.bg[0] = g0.x; c.bg[1] = g0.y; c.bg[2] = g0.z; c.bg[3] = g0.w; c.bg[4] = g1.x; c.bg[5] = g1.y; c.bg[6] = g1.z; c.bg[7] = g1.w;
        c.bl[0] = l0.x; c.bl[1] = l0.y; c.bl[2] = l0.z; c.bl[3] = l0.w; c.bl[4] = l1.x; c.bl[5] = l1.y; c.bl[6] = l1.z; c.bl[7] = l1.w; return c; }
    DEVI RowCtx rowctx(int z, int r, bool) const { RowCtx x; x.p = (bf16_t*)((char*)ACT + (size_t)(ubs(z < 0 ? 0 : z) * 256 + r) * DFF * (FP8 ? 1 : 2)); return x; }
    DEVI void storepair(const ColCtx& c, const RowCtx& x, const float (&vg)[8], const float (&vl)[8]) const {
        typedef float f2 __attribute__((ext_vector_type(2))); unsigned w[4]; float af[8];
#pragma unroll
        for (int i = 0; i < 4; ++i) { f2 g = (f2){vg[2 * i], vg[2 * i + 1]} + (f2){c.bg[2 * i], c.bg[2 * i + 1]}, l = (f2){vl[2 * i], vl[2 * i + 1]} + (f2){c.bl[2 * i], c.bl[2 * i + 1]};
            g[0] = fminf(g[0], 7.f); g[1] = fminf(g[1], 7.f); l[0] = __builtin_amdgcn_fmed3f(l[0], -7.f, 7.f); l[1] = __builtin_amdgcn_fmed3f(l[1], -7.f, 7.f);
            const f2 t = g * (-1.702f * 1.44269504f); f2 e; e[0] = __builtin_amdgcn_exp2f(t[0]); e[1] = __builtin_amdgcn_exp2f(t[1]); e = e + 1.f;
            f2 r; r[0] = __builtin_amdgcn_rcpf(e[0]); r[1] = __builtin_amdgcn_rcpf(e[1]);
            const f2 a = (l + 1.f) * g * r; w[i] = pk2(a[0], a[1]); af[2 * i] = a[0]; af[2 * i + 1] = a[1]; }
        if constexpr (FP8) { uint2 o; o.x = pk4_fp8(af[0], af[1], af[2], af[3]); o.y = pk4_fp8(af[4], af[5], af[6], af[7]); *(uint2*)((char*)x.p + c.f0) = o; }
        else { uint4 o; o.x = w[0]; o.y = w[1]; o.z = w[2]; o.w = w[3]; *(uint4*)(x.p + c.f0) = o; } }
    DEVI void storeh(const ColCtx&, const RowCtx&, int, const float (&)[8]) const {}
    DEVI void store(int, int, int, const float (&)[8]) const {}
};
struct FMoe2 {
    static constexpr bool HOIST = true, PAIR = false, RV = true, FP8 = MOE_FP8 != 0; static constexpr int NT = 4;
    const bf16_t* A; const bf16_t* B; int K; const int* cnt; const float* b_down; bf16_t* Y2; const LAS int* ub; int G;
    struct ColCtx { float bd[8]; }; struct RowCtx { bf16_t* p; };
    DEVI int ubs(int e) const { return __builtin_amdgcn_readfirstlane(ub[e]); }
    DEVI int nunits() const { const int n = ubs(NEXP) * NT; return (G & 7) == 0 ? (n + G - 1) / G * G : n; }
    DEVI void unit(int L, int& z, int& pm, int& pn) const { moe_unit<NT, RV>(ub, L, G, z, pm, pn); }
    DEVI int M(int z) const { return z < 0 ? 0 : cnt[z]; }
    DEVI unsigned aoffb(int z, int r) const { return (unsigned)(ubs(z < 0 ? 0 : z) * 256 + r) * (unsigned)(FP8 ? DFF : DFF * 2); }
    DEVI const bf16_t* Bt(int z) const { return (const bf16_t*)((const char*)B + (size_t)(z < 0 ? 0 : z) * DM * DFF * (FP8 ? 1 : 2)); }
    DEVI ColCtx colctx(int z, int c0) const { ColCtx c; const float* bp = b_down + (size_t)(z < 0 ? 0 : z) * DM + c0; const float4 a = *(const float4*)bp, b = *(const float4*)(bp + 4);
        c.bd[0] = a.x; c.bd[1] = a.y; c.bd[2] = a.z; c.bd[3] = a.w; c.bd[4] = b.x; c.bd[5] = b.y; c.bd[6] = b.z; c.bd[7] = b.w; return c; }
    DEVI RowCtx rowctx(int z, int r, bool) const { RowCtx x; x.p = (bf16_t*)((char*)Y2 + (size_t)(ubs(z < 0 ? 0 : z) * 256 + r) * DM * (FP8 ? 1 : 2)); return x; }
    DEVI void storeh(const ColCtx& c, const RowCtx& x, int c0, const float (&v)[8]) const {
        if constexpr (FP8) { uint2 o; o.x = pk4_fp8(v[0] + c.bd[0], v[1] + c.bd[1], v[2] + c.bd[2], v[3] + c.bd[3]); o.y = pk4_fp8(v[4] + c.bd[4], v[5] + c.bd[5], v[6] + c.bd[6], v[7] + c.bd[7]); *(uint2*)((char*)x.p + c0) = o; }
        else { uint4 o; o.x = pk2(v[0] + c.bd[0], v[1] + c.bd[1]); o.y = pk2(v[2] + c.bd[2], v[3] + c.bd[3]); o.z = pk2(v[4] + c.bd[4], v[5] + c.bd[5]); o.w = pk2(v[6] + c.bd[6], v[7] + c.bd[7]);
            *(uint4*)(x.p + c0) = o; } }
    DEVI void store(int, int, int, const float (&)[8]) const {}
};

struct MArgs { const float* in[30]; float* out; unsigned char* ws; int ph_lo, ph_hi; };
struct MArgs_in { const float *lam_re, *lam_im, *log_dt, *b_re, *b_im, *c_re, *c_im; };

constexpr int GL_LRS = 0, GL_TOT = 8192, GL_QF = 12288, GL_KF = 21504, GL_QB = 30720, GL_KB = 39936, GL_VT = 49152, GL_PP = 67584, GL_SSQ = 76800, GL_UST = 67584;
constexpr int GL_LD = 72;

struct GlaPtrs { const bf16_t* QK; const bf16_t* V; const bf16_t* R; const float* LR; const float* lr_up; const float* lr_bias; const float* nw; bf16_t* UCH; float* ADEC; bf16_t* SST; bf16_t* MIX; bf16_t* GLT; };

DEVI void gla_gates(const GlaPtrs& G, LAS unsigned char* lds, int h, int d, int to, float (&cf)[8], float (&cb)[8]) {
    const LAS float* LRS = (const LAS float*)(lds + GL_LRS); LAS float* TOT = (LAS float*)(lds + GL_TOT);
#pragma unroll
    for (int dir = 0; dir < 2; ++dir) {
        float up[16];
#pragma unroll
        for (int r = 0; r < 16; ++r) up[r] = G.lr_up[dir * 4096 + r * 256 + h * 64 + d];
        const float bias = G.lr_bias[dir * 256 + h * 64 + d];
        float la[8];
#pragma unroll
        for (int j = 0; j < 8; ++j) { const LAS f32x4* lp = (const LAS f32x4*)(LRS + (to * 8 + j) * 32 + dir * 16); float g = bias;
#pragma unroll
            for (int q = 0; q < 4; ++q) { const f32x4 x = lp[q]; g += x[0] * up[4 * q] + x[1] * up[4 * q + 1] + x[2] * up[4 * q + 2] + x[3] * up[4 * q + 3]; }
            la[j] = logsigmoidf_(g) * (1.f / 16.f); }
        if (dir == 0) { cf[0] = la[0];
#pragma unroll
            for (int j = 1; j < 8; ++j) cf[j] = cf[j - 1] + la[j];
            TOT[(0 * 8 + to) * 64 + d] = cf[7]; }
        else { cb[7] = la[7];
#pragma unroll
            for (int j = 6; j >= 0; --j) cb[j] = cb[j + 1] + la[j];
            TOT[(1 * 8 + to) * 64 + d] = cb[0]; }
    }
}
DEVI void gla_stage(const GlaPtrs& G, LAS unsigned char* lds, int row0, int h, int tid) {
    *(LAS f32x4*)(lds + GL_LRS + tid * 16) = *(const f32x4*)(G.LR + (size_t)row0 * 32 + tid * 4);
    const int ep = tid & 63, to = tid >> 6; unsigned w[8];
#pragma unroll
    for (int j = 0; j < 8; ++j) w[j] = *(const unsigned*)(G.V + (size_t)(row0 + to * 8 + j) * 512 + h * 128 + 2 * ep);
    u32x4 lo, hi;
    lo.x = (w[0] & 0xffffu) | (w[1] << 16); lo.y = (w[2] & 0xffffu) | (w[3] << 16); lo.z = (w[4] & 0xffffu) | (w[5] << 16); lo.w = (w[6] & 0xffffu) | (w[7] << 16);
    hi.x = (w[0] >> 16) | (w[1] & 0xffff0000u); hi.y = (w[2] >> 16) | (w[3] & 0xffff0000u); hi.z = (w[4] >> 16) | (w[5] & 0xffff0000u); hi.w = (w[6] >> 16) | (w[7] & 0xffff0000u);
    *(LAS u32x4*)(lds + GL_VT + ((2 * ep) * GL_LD + to * 8) * 2) = lo;
    *(LAS u32x4*)(lds + GL_VT + ((2 * ep + 1) * GL_LD + to * 8) * 2) = hi;
}

DEVI void gla_a_item(const GlaPtrs& G, LAS unsigned char* lds, int item) {
    int tid = threadIdx.x; asm volatile("" : "+v"(tid));
    const int wave = __builtin_amdgcn_readfirstlane(tid >> 6), lane = tid & 63, d = lane, to = wave, fr = lane & 15, fq = lane >> 4;
    const int ch = item % 68, bh = item / 68, h = bh & 3, b = bh >> 2;
    const int row0 = ch < 4 ? NTOK + b * CTX + ch * 64 : b * SEQ + (ch - 4) * 64;
    gla_stage(G, lds, row0, h, tid);
    bf16_t kk[8];
#pragma unroll
    for (int j = 0; j < 8; ++j) kk[j] = G.QK[(size_t)(row0 + to * 8 + j) * 512 + 256 + h * 64 + d];
    __syncthreads();
    float cf[8], cb[8];
    gla_gates(G, lds, h, d, to, cf, cb);
    __syncthreads();
    const LAS float* TOT = (const LAS float*)(lds + GL_TOT);
    float offf = 0.f, offb = 0.f, totf = 0.f, totb = 0.f;
#pragma unroll
    for (int t = 0; t < 8; ++t) { const float a = TOT[(0 * 8 + t) * 64 + d], c = TOT[(1 * 8 + t) * 64 + d]; totf += a; totb += c; if (t < to) offf += a; if (t > to) offb += c; }
    float of[8], ob[8];
#pragma unroll
    for (int j = 0; j < 8; ++j) { const float kf = bf2f(kk[j]); of[j] = kf * __expf(totf - (cf[j] + offf)); ob[j] = kf * __expf(totb - (cb[j] + offb)); }
    { u32x4 w; w.x = pk2(of[0], of[1]); w.y = pk2(of[2], of[3]); w.z = pk2(of[4], of[5]); w.w = pk2(of[6], of[7]); *(LAS u32x4*)(lds + GL_QF + (d * GL_LD + to * 8) * 2) = w;
      w.x = pk2(ob[0], ob[1]); w.y = pk2(ob[2], ob[3]); w.z = pk2(ob[4], ob[5]); w.w = pk2(ob[6], ob[7]); *(LAS u32x4*)(lds + GL_KF + (d * GL_LD + to * 8) * 2) = w; }
    const int chain_f = bh * 2, step_f = ch < 4 ? ch : ch, step_b = ch < 4 ? 3 - ch : 4 + (67 - ch);
    if (to == 0) { G.ADEC[((size_t)chain_f * 68 + step_f) * 64 + d] = __expf(totf); G.ADEC[((size_t)(chain_f + 1) * 68 + step_b) * 64 + d] = __expf(totb); }
    __syncthreads();
    f32x4 acc[2][4];
#pragma unroll
    for (int dr = 0; dr < 2; ++dr)
#pragma unroll
        for (int dt = 0; dt < 4; ++dt) acc[dr][dt] = (f32x4){0.f, 0.f, 0.f, 0.f};
#pragma unroll
    for (int ks = 0; ks < 2; ++ks) { const bf16x8 a = *(const LAS bf16x8*)(lds + GL_VT + ((wave * 16 + fr) * GL_LD + ks * 32 + fq * 8) * 2);
#pragma unroll
        for (int dt = 0; dt < 4; ++dt) { const bf16x8 b0 = *(const LAS bf16x8*)(lds + GL_QF + ((dt * 16 + fr) * GL_LD + ks * 32 + fq * 8) * 2);
            const bf16x8 b1 = *(const LAS bf16x8*)(lds + GL_KF + ((dt * 16 + fr) * GL_LD + ks * 32 + fq * 8) * 2);
            acc[0][dt] = __builtin_amdgcn_mfma_f32_16x16x32_bf16(a, b0, acc[0][dt], 0, 0, 0); acc[1][dt] = __builtin_amdgcn_mfma_f32_16x16x32_bf16(a, b1, acc[1][dt], 0, 0, 0); } }
#pragma unroll
    for (int dr = 0; dr < 2; ++dr)
#pragma unroll
        for (int dt = 0; dt < 4; ++dt)
#pragma unroll
            for (int rg = 0; rg < 4; ++rg) *(LAS bf16_t*)(lds + GL_UST + ((dr * 128 + wave * 16 + 4 * fq + rg) * 64 + dt * 16 + fr) * 2) = f2bf(acc[dr][dt][rg]);
    __syncthreads();
#pragma unroll
    for (int i = 0; i < 4; ++i) { const int q = tid + i * NTHR, dr = q >> 10, off = (q & 1023) * 8;
        const u32x4 w = *(const LAS u32x4*)(lds + GL_UST + (dr * 8192 + off) * 2);
        const size_t chain = (size_t)chain_f + dr; const int step = dr ? step_b : step_f;
        *(u32x4*)(G.UCH + (chain * 68 + step) * 8192 + off) = w; }
    __syncthreads();
}

DEVI void gla_b_block(const GlaPtrs& G, LAS unsigned char* lds, int blk) {
    int tid = threadIdx.x; asm volatile("" : "+v"(tid));
    const int chain = blk >> 2, e = (blk & 3) * 32 + (tid >> 4), d4 = (tid & 15) * 4;
    for (int i = tid; i < 68 * 16; i += NTHR) ((LAS f32x4*)lds)[i] = ((const f32x4*)(G.ADEC + (size_t)chain * 68 * 64))[i];
    __syncthreads();
    const bf16_t* up = G.UCH + ((size_t)chain * 68 * 128 + e) * 64 + d4;
    bf16_t* sp = G.SST + ((size_t)chain * 64 * 128 + e) * 64 + d4;
    float S0 = 0.f, S1 = 0.f, S2 = 0.f, S3 = 0.f;
    uint2 cur[17], nxt[17];
#pragma unroll
    for (int j = 0; j < 17; ++j) cur[j] = *(const uint2*)(up + (size_t)j * 8192);
#pragma unroll 1
    for (int bt = 0; bt < 4; ++bt) {
        if (bt < 3) {
#pragma unroll
            for (int j = 0; j < 17; ++j) nxt[j] = *(const uint2*)(up + (size_t)((bt + 1) * 17 + j) * 8192); }
#pragma unroll
        for (int j = 0; j < 17; ++j) { const int step = bt * 17 + j;
            if (step >= 4) { uint2 o; o.x = pk2(S0, S1); o.y = pk2(S2, S3); *(uint2*)(sp + (size_t)(step - 4) * 8192) = o; }
            const f32x4 a = *(const LAS f32x4*)(lds + (step * 64 + d4) * 4);
            S0 = a[0] * S0 + __uint_as_float(cur[j].x << 16); S1 = a[1] * S1 + __uint_as_float(cur[j].x & 0xffff0000u);
            S2 = a[2] * S2 + __uint_as_float(cur[j].y << 16); S3 = a[3] * S3 + __uint_as_float(cur[j].y & 0xffff0000u); }
#pragma unroll
        for (int j = 0; j < 17; ++j) cur[j] = nxt[j];
    }
    __syncthreads();
}

DEVI void gla_c_item(const GlaPtrs& G, LAS unsigned char* lds, int item) {
    int tid = threadIdx.x; asm volatile("" : "+v"(tid));
    const int wave = __builtin_amdgcn_readfirstlane(tid >> 6), lane = tid & 63, d = lane, to = wave, fr = lane & 15, fq = lane >> 4;
    const int c = item & 63, bh = item >> 6, h = bh & 3, b = bh >> 2;
    const int row0 = b * SEQ + c * 64;
    gla_stage(G, lds, row0, h, tid);
    bf16_t qq[8], kk[8];
#pragma unroll
    for (int j = 0; j < 8; ++j) { const size_t o = (size_t)(row0 + to * 8 + j) * 512 + h * 64 + d; qq[j] = G.QK[o]; kk[j] = G.QK[o + 256]; }
    __syncthreads();
    float cf[8], cb[8];
    gla_gates(G, lds, h, d, to, cf, cb);
    __syncthreads();
    { const LAS float* TOT = (const LAS float*)(lds + GL_TOT);
      float offf = 0.f, offb = 0.f;
#pragma unroll
      for (int t = 0; t < 8; ++t) { if (t < to) offf += TOT[(0 * 8 + t) * 64 + d]; if (t > to) offb += TOT[(1 * 8 + t) * 64 + d]; }
#pragma unroll
      for (int j = 0; j < 8; ++j) { const float qf = bf2f(qq[j]) * 0.125f, kf = bf2f(kk[j]);
          const float ef = __expf(fmaxf(cf[j] + offf, -80.f)), eb = __expf(fmaxf(cb[j] + offb, -80.f));
          const int o = ((to * 8 + j) * GL_LD + d) * 2;
          *(LAS bf16_t*)(lds + GL_QF + o) = f2bf(qf * ef); *(LAS bf16_t*)(lds + GL_KF + o) = f2bf(kf * __builtin_amdgcn_rcpf(ef));
          *(LAS bf16_t*)(lds + GL_QB + o) = f2bf(qf * eb); *(LAS bf16_t*)(lds + GL_KB + o) = f2bf(kf * __builtin_amdgcn_rcpf(eb)); } }
    __syncthreads();
    { const int ti = wave >> 1;
#pragma unroll
      for (int u = 0; u < 2; ++u) { const int tj = (wave & 1) * 2 + u;
          f32x4 af = (f32x4){0.f, 0.f, 0.f, 0.f}, ab = (f32x4){0.f, 0.f, 0.f, 0.f};
          if (tj <= ti) {
#pragma unroll
              for (int ks = 0; ks < 2; ++ks) { const bf16x8 a = *(const LAS bf16x8*)(lds + GL_KF + ((tj * 16 + fr) * GL_LD + ks * 32 + fq * 8) * 2), bb = *(const LAS bf16x8*)(lds + GL_QF + ((ti * 16 + fr) * GL_LD + ks * 32 + fq * 8) * 2);
                  af = __builtin_amdgcn_mfma_f32_16x16x32_bf16(a, bb, af, 0, 0, 0); } }
          if (tj >= ti) {
#pragma unroll
              for (int ks = 0; ks < 2; ++ks) { const bf16x8 a = *(const LAS bf16x8*)(lds + GL_KB + ((tj * 16 + fr) * GL_LD + ks * 32 + fq * 8) * 2), bb = *(const LAS bf16x8*)(lds + GL_QB + ((ti * 16 + fr) * GL_LD + ks * 32 + fq * 8) * 2);
                  ab = __builtin_amdgcn_mfma_f32_16x16x32_bf16(a, bb, ab, 0, 0, 0); } }
          float p[4];
#pragma unroll
          for (int rg = 0; rg < 4; ++rg) { const int i = ti * 16 + fr, j = tj * 16 + 4 * fq + rg; p[rg] = (j <= i ? af[rg] : 0.f) + (j >= i ? ab[rg] : 0.f); }
          u32x2 w; w.x = pk2(p[0], p[1]); w.y = pk2(p[2], p[3]);
          *(LAS u32x2*)(lds + GL_PP + ((ti * 16 + fr) * GL_LD + tj * 16 + 4 * fq) * 2) = w; } }
    __syncthreads();
    const int tg = wave & 3, eh = wave >> 2;
    f32x4 acc[4];
#pragma unroll
    for (int et = 0; et < 4; ++et) acc[et] = (f32x4){0.f, 0.f, 0.f, 0.f};
    { const bf16_t* Sf = G.SST + ((size_t)(bh * 2) * 64 + c) * 8192; const bf16_t* Sb = G.SST + ((size_t)(bh * 2 + 1) * 64 + (63 - c)) * 8192;
#pragma unroll
      for (int ks = 0; ks < 2; ++ks) {
          const int bo = ((tg * 16 + fr) * GL_LD + ks * 32 + fq * 8) * 2;
          const bf16x8 bP = *(const LAS bf16x8*)(lds + GL_PP + bo), bF = *(const LAS bf16x8*)(lds + GL_QF + bo), bB = *(const LAS bf16x8*)(lds + GL_QB + bo);
#pragma unroll
          for (int et = 0; et < 4; ++et) { const int e = eh * 64 + et * 16 + fr;
              const bf16x8 aV = *(const LAS bf16x8*)(lds + GL_VT + (e * GL_LD + ks * 32 + fq * 8) * 2);
              const bf16x8 aF = *(const bf16x8*)(Sf + e * 64 + ks * 32 + fq * 8), aB = *(const bf16x8*)(Sb + e * 64 + ks * 32 + fq * 8);
              acc[et] = __builtin_amdgcn_mfma_f32_16x16x32_bf16(aV, bP, acc[et], 0, 0, 0);
              acc[et] = __builtin_amdgcn_mfma_f32_16x16x32_bf16(aF, bF, acc[et], 0, 0, 0);
              acc[et] = __builtin_amdgcn_mfma_f32_16x16x32_bf16(aB, bB, acc[et], 0, 0, 0); } } }
    float ss = 0.f;
#pragma unroll
    for (int et = 0; et < 4; ++et) ss += acc[et][0] * acc[et][0] + acc[et][1] * acc[et][1] + acc[et][2] * acc[et][2] + acc[et][3] * acc[et][3];
    ss += __shfl_xor(ss, 16); ss += __shfl_xor(ss, 32);
    LAS float* SSQ = (LAS float*)(lds + GL_SSQ);
    if (fq == 0) SSQ[eh * 64 + tg * 16 + fr] = ss;
    __syncthreads();
    const float rstd = rsqrtf((SSQ[tg * 16 + fr] + SSQ[64 + tg * 16 + fr]) * (1.f / 128.f) + 1e-6f);
    const int tok = row0 + tg * 16 + fr;
#pragma unroll
    for (int et = 0; et < 4; ++et) { const int e = eh * 64 + et * 16 + 4 * fq;
        const uint2 rv = *(const uint2*)(G.R + (size_t)tok * 512 + h * 128 + e); const f32x4 nw = *(const f32x4*)(G.nw + e);
        const float r0 = __uint_as_float(rv.x << 16), r1 = __uint_as_float(rv.x & 0xffff0000u), r2 = __uint_as_float(rv.y << 16), r3 = __uint_as_float(rv.y & 0xffff0000u);
        uint2 w; w.x = pk2(acc[et][0] * rstd * nw[0] * siluf_(r0), acc[et][1] * rstd * nw[1] * siluf_(r1)); w.y = pk2(acc[et][2] * rstd * nw[2] * siluf_(r2), acc[et][3] * rstd * nw[3] * siluf_(r3));
        *(uint2*)(G.MIX + (size_t)tok * DM + h * 128 + e) = w; }
    __syncthreads();
}

constexpr int GL_SF = 77312, GL_SB = 95744, GL_RQ = 114176, GL_RK = 122368;

struct GateW { float up[2][16]; float bias[2]; };
DEVI GateW gla_gatew(const GlaPtrs& G, int h, int d) { GateW w;
#pragma unroll
    for (int dir = 0; dir < 2; ++dir) {
#pragma unroll
        for (int r = 0; r < 16; ++r) w.up[dir][r] = G.lr_up[dir * 4096 + r * 256 + h * 64 + d];
        w.bias[dir] = G.lr_bias[dir * 256 + h * 64 + d]; }
    return w; }
DEVI void gla_gates2(const GateW& W, LAS unsigned char* lds, int d, int to, float (&cf)[8], float (&cb)[8]) {
    const LAS float* LRS = (const LAS float*)(lds + GL_LRS); LAS float* TOT = (LAS float*)(lds + GL_TOT);
#pragma unroll
    for (int dir = 0; dir < 2; ++dir) {
        float la[8];
#pragma unroll
        for (int j = 0; j < 8; ++j) { const LAS f32x4* lp = (const LAS f32x4*)(LRS + (to * 8 + j) * 32 + dir * 16); float g = W.bias[dir];
#pragma unroll
            for (int q = 0; q < 4; ++q) { const f32x4 x = lp[q]; g += x[0] * W.up[dir][4 * q] + x[1] * W.up[dir][4 * q + 1] + x[2] * W.up[dir][4 * q + 2] + x[3] * W.up[dir][4 * q + 3]; }
            la[j] = logsigmoidf_(g) * (1.f / 16.f); }
        if (dir == 0) { cf[0] = la[0];
#pragma unroll
            for (int j = 1; j < 8; ++j) cf[j] = cf[j - 1] + la[j];
            TOT[(0 * 8 + to) * 64 + d] = cf[7]; }
        else { cb[7] = la[7];
#pragma unroll
            for (int j = 6; j >= 0; --j) cb[j] = cb[j + 1] + la[j];
            TOT[(1 * 8 + to) * 64 + d] = cb[0]; }
    }
}
struct GIn { f32x4 lr; unsigned vv[8]; u32x4 kraw; u32x4 qraw; u32x4 sraw[4]; u32x2 rr[4]; };
template <bool WQ> DEVI void gla_load_common(const GlaPtrs& G, int row0, int h, int tid, GIn& I) {
    I.lr = *(const f32x4*)(G.LR + (size_t)row0 * 32 + tid * 4);
    const int ep = tid & 63, to = tid >> 6;
#pragma unroll
    for (int j = 0; j < 8; ++j) I.vv[j] = *(const unsigned*)(G.V + (size_t)(row0 + to * 8 + j) * 512 + h * 128 + 2 * ep);
    const int tok = tid >> 3, chunk = tid & 7;
    I.kraw = *(const u32x4*)(G.QK + (size_t)(row0 + tok) * 512 + 256 + h * 64 + chunk * 8);
    if (WQ) I.qraw = *(const u32x4*)(G.QK + (size_t)(row0 + tok) * 512 + h * 64 + chunk * 8);
}
template <bool WQ> DEVI void gla_stage_common(LAS unsigned char* lds, int tid, const GIn& I) {
    *(LAS f32x4*)(lds + GL_LRS + tid * 16) = I.lr;
    const int ep = tid & 63, to = tid >> 6; const unsigned* w = I.vv;
    u32x4 lo, hi;
    lo.x = (w[0] & 0xffffu) | (w[1] << 16); lo.y = (w[2] & 0xffffu) | (w[3] << 16); lo.z = (w[4] & 0xffffu) | (w[5] << 16); lo.w = (w[6] & 0xffffu) | (w[7] << 16);
    hi.x = (w[0] >> 16) | (w[1] & 0xffff0000u); hi.y = (w[2] >> 16) | (w[3] & 0xffff0000u); hi.z = (w[4] >> 16) | (w[5] & 0xffff0000u); hi.w = (w[6] >> 16) | (w[7] & 0xffff0000u);
    *(LAS u32x4*)(lds + GL_VT + ((2 * ep) * GL_LD + to * 8) * 2) = lo;
    *(LAS u32x4*)(lds + GL_VT + ((2 * ep + 1) * GL_LD + to * 8) * 2) = hi;
    *(LAS u32x4*)(lds + GL_RK + tid * 16) = I.kraw;
    if (WQ) *(LAS u32x4*)(lds + GL_RQ + tid * 16) = I.qraw;
}

DEVI void gla_a_phase(const GlaPtrs& G, LAS unsigned char* lds, int bid, int Gsz) {
    int tid = threadIdx.x; asm volatile("" : "+v"(tid));
    const int wave = __builtin_amdgcn_readfirstlane(tid >> 6), lane = tid & 63, d = lane, to = wave, fr = lane & 15, fq = lane >> 4;
    constexpr int NIT = NB * 4 * 68;
    if (bid >= NIT) return;
#define GA_ROW0(it) (((it) % 68) < 4 ? NTOK + (((it) / 68) >> 2) * CTX + ((it) % 68) * 64 : (((it) / 68) >> 2) * SEQ + (((it) % 68) - 4) * 64)
    GIn cur; gla_load_common<true>(G, GA_ROW0(bid), (bid / 68) & 3, tid, cur);
    int hw = -1; GateW W;
    for (int item = bid; item < NIT; item += Gsz) {
        const int ch = item % 68, bh = item / 68, h = bh & 3;
        if (h != hw) { W = gla_gatew(G, h, d); hw = h; }
        gla_stage_common<true>(lds, tid, cur);
        __syncthreads();
        { const int nit = item + Gsz; if (nit < NIT) gla_load_common<true>(G, GA_ROW0(nit), (nit / 68) & 3, tid, cur); }
        float cf[8], cb[8];
        gla_gates2(W, lds, d, to, cf, cb);
        __syncthreads();
        const LAS float* TOT = (const LAS float*)(lds + GL_TOT);
        float offf = 0.f, offb = 0.f, totf = 0.f, totb = 0.f;
#pragma unroll
        for (int t = 0; t < 8; ++t) { const float a = TOT[(0 * 8 + t) * 64 + d], c = TOT[(1 * 8 + t) * 64 + d]; totf += a; totb += c; if (t < to) offf += a; if (t > to) offb += c; }
        float of[8], ob[8];
        bf16_t* gt = G.GLT + ((size_t)(bh * 64 + (ch - 4)) * 4) * 4096;
#pragma unroll
        for (int j = 0; j < 8; ++j) { const int ro = ((to * 8 + j) * 64 + d) * 2; const float kf = bf2f(*(const LAS bf16_t*)(lds + GL_RK + ro));
            of[j] = kf * __expf(totf - (cf[j] + offf)); ob[j] = kf * __expf(totb - (cb[j] + offb));
            if (ch >= 4) { const float qf = bf2f(*(const LAS bf16_t*)(lds + GL_RQ + ro)) * 0.125f;
                const float ef = __expf(fmaxf(cf[j] + offf, -80.f)), eb = __expf(fmaxf(cb[j] + offb, -80.f)); const int go = (to * 8 + j) * 64 + d;
                gt[go] = f2bf(qf * ef); gt[4096 + go] = f2bf(kf * __builtin_amdgcn_rcpf(ef)); gt[8192 + go] = f2bf(qf * eb); gt[12288 + go] = f2bf(kf * __builtin_amdgcn_rcpf(eb)); } }
        { u32x4 w; w.x = pk2(of[0], of[1]); w.y = pk2(of[2], of[3]); w.z = pk2(of[4], of[5]); w.w = pk2(of[6], of[7]); *(LAS u32x4*)(lds + GL_QF + (d * GL_LD + to * 8) * 2) = w;
          w.x = pk2(ob[0], ob[1]); w.y = pk2(ob[2], ob[3]); w.z = pk2(ob[4], ob[5]); w.w = pk2(ob[6], ob[7]); *(LAS u32x4*)(lds + GL_KF + (d * GL_LD + to * 8) * 2) = w; }
        const int chain_f = bh * 2, step_f = ch, step_b = ch < 4 ? 3 - ch : 71 - ch;
        if (to == 0) { G.ADEC[((size_t)chain_f * 68 + step_f) * 64 + d] = __expf(totf); G.ADEC[((size_t)(chain_f + 1) * 68 + step_b) * 64 + d] = __expf(totb); }
        __syncthreads();
        f32x4 acc[2][4];
#pragma unroll
        for (int dr = 0; dr < 2; ++dr)
#pragma unroll
            for (int dt = 0; dt < 4; ++dt) acc[dr][dt] = (f32x4){0.f, 0.f, 0.f, 0.f};
#pragma unroll
        for (int ks = 0; ks < 2; ++ks) { const bf16x8 a = *(const LAS bf16x8*)(lds + GL_VT + ((wave * 16 + fr) * GL_LD + ks * 32 + fq * 8) * 2);
#pragma unroll
            for (int dt = 0; dt < 4; ++dt) { const bf16x8 b0 = *(const LAS bf16x8*)(lds + GL_QF + ((dt * 16 + fr) * GL_LD + ks * 32 + fq * 8) * 2);
                const bf16x8 b1 = *(const LAS bf16x8*)(lds + GL_KF + ((dt * 16 + fr) * GL_LD + ks * 32 + fq * 8) * 2);
                acc[0][dt] = __builtin_amdgcn_mfma_f32_16x16x32_bf16(a, b0, acc[0][dt], 0, 0, 0); acc[1][dt] = __builtin_amdgcn_mfma_f32_16x16x32_bf16(a, b1, acc[1][dt], 0, 0, 0); } }
#pragma unroll
        for (int dr = 0; dr < 2; ++dr)
#pragma unroll
            for (int dt = 0; dt < 4; ++dt)
#pragma unroll
                for (int rg = 0; rg < 4; ++rg) *(LAS bf16_t*)(lds + GL_UST + ((dr * 128 + wave * 16 + 4 * fq + rg) * 64 + dt * 16 + fr) * 2) = f2bf(acc[dr][dt][rg]);
        __syncthreads();
#pragma unroll
        for (int i = 0; i < 4; ++i) { const int q = tid + i * NTHR, dr = q >> 10, off = (q & 1023) * 8;
            const u32x4 w = *(const LAS u32x4*)(lds + GL_UST + (dr * 8192 + off) * 2);
            const size_t chain = (size_t)chain_f + dr; const int step = dr ? step_b : step_f;
            *(u32x4*)(G.UCH + (chain * 68 + step) * 8192 + off) = w; }
    }
#undef GA_ROW0
    __syncthreads();
}

struct CIn { unsigned vv[8]; u32x4 tl[4]; u32x4 sraw[4]; u32x2 rr[4]; };
DEVI void gla_c_load(const GlaPtrs& G, int item, int tid, int wave, int fr, int fq, CIn& I) {
    const int c = item & 63, bh = item >> 6, h = bh & 3, b = bh >> 2, row0 = b * SEQ + c * 64;
    const int ep = tid & 63, to = tid >> 6;
#pragma unroll
    for (int j = 0; j < 8; ++j) I.vv[j] = *(const unsigned*)(G.V + (size_t)(row0 + to * 8 + j) * 512 + h * 128 + 2 * ep);
    const bf16_t* gt = G.GLT + (size_t)item * 4 * 4096;
#pragma unroll
    for (int t = 0; t < 4; ++t) I.tl[t] = *(const u32x4*)(gt + t * 4096 + tid * 8);
    const bf16_t* Sf = G.SST + ((size_t)(bh * 2) * 64 + c) * 8192; const bf16_t* Sb = G.SST + ((size_t)(bh * 2 + 1) * 64 + (63 - c)) * 8192;
    I.sraw[0] = *(const u32x4*)(Sf + tid * 8); I.sraw[1] = *(const u32x4*)(Sf + (tid + NTHR) * 8); I.sraw[2] = *(const u32x4*)(Sb + tid * 8); I.sraw[3] = *(const u32x4*)(Sb + (tid + NTHR) * 8);
    const int tg = wave & 3, eh = wave >> 2, tok = row0 + tg * 16 + fr;
#pragma unroll
    for (int et = 0; et < 4; ++et) I.rr[et] = *(const u32x2*)(G.R + (size_t)tok * 512 + h * 128 + eh * 64 + et * 16 + 4 * fq);
}
DEVI void gla_c_phase(const GlaPtrs& G, LAS unsigned char* lds, int bid, int Gsz) {
    int tid = threadIdx.x; asm volatile("" : "+v"(tid));
    const int wave = __builtin_amdgcn_readfirstlane(tid >> 6), lane = tid & 63, fr = lane & 15, fq = lane >> 4;
    constexpr int NIT = NB * 4 * 64;
    if (bid >= NIT) return;
    const int tg = wave & 3, eh = wave >> 2;
    f32x4 nwv[4];
#pragma unroll
    for (int et = 0; et < 4; ++et) nwv[et] = *(const f32x4*)(G.nw + eh * 64 + et * 16 + 4 * fq);
    CIn cur; gla_c_load(G, bid, tid, wave, fr, fq, cur);
    for (int item = bid; item < NIT; item += Gsz) {
        const int c = item & 63, bh = item >> 6, h = bh & 3, b = bh >> 2, row0 = b * SEQ + c * 64;
        { const int ep = tid & 63, to = tid >> 6; const unsigned* w = cur.vv;
          u32x4 lo, hi;
          lo.x = (w[0] & 0xffffu) | (w[1] << 16); lo.y = (w[2] & 0xffffu) | (w[3] << 16); lo.z = (w[4] & 0xffffu) | (w[5] << 16); lo.w = (w[6] & 0xffffu) | (w[7] << 16);
          hi.x = (w[0] >> 16) | (w[1] & 0xffff0000u); hi.y = (w[2] >> 16) | (w[3] & 0xffff0000u); hi.z = (w[4] >> 16) | (w[5] & 0xffff0000u); hi.w = (w[6] >> 16) | (w[7] & 0xffff0000u);
          *(LAS u32x4*)(lds + GL_VT + ((2 * ep) * GL_LD + to * 8) * 2) = lo; *(LAS u32x4*)(lds + GL_VT + ((2 * ep + 1) * GL_LD + to * 8) * 2) = hi; }
        { const int r0 = tid >> 3, ck = tid & 7;
          *(LAS u32x4*)(lds + GL_QF + (r0 * GL_LD + ck * 8) * 2) = cur.tl[0]; *(LAS u32x4*)(lds + GL_KF + (r0 * GL_LD + ck * 8) * 2) = cur.tl[1];
          *(LAS u32x4*)(lds + GL_QB + (r0 * GL_LD + ck * 8) * 2) = cur.tl[2]; *(LAS u32x4*)(lds + GL_KB + (r0 * GL_LD + ck * 8) * 2) = cur.tl[3];
          *(LAS u32x4*)(lds + GL_SF + (r0 * GL_LD + ck * 8) * 2) = cur.sraw[0]; *(LAS u32x4*)(lds + GL_SF + ((r0 + 64) * GL_LD + ck * 8) * 2) = cur.sraw[1];
          *(LAS u32x4*)(lds + GL_SB + (r0 * GL_LD + ck * 8) * 2) = cur.sraw[2]; *(LAS u32x4*)(lds + GL_SB + ((r0 + 64) * GL_LD + ck * 8) * 2) = cur.sraw[3]; }
        u32x2 rcur[4];
#pragma unroll
        for (int et = 0; et < 4; ++et) rcur[et] = cur.rr[et];
        __syncthreads();
        { const int nit = item + Gsz; if (nit < NIT) gla_c_load(G, nit, tid, wave, fr, fq, cur); }
        { const int ti = wave >> 1;
#pragma unroll
          for (int u = 0; u < 2; ++u) { const int tj = (wave & 1) * 2 + u;
              f32x4 af = (f32x4){0.f, 0.f, 0.f, 0.f}, ab = (f32x4){0.f, 0.f, 0.f, 0.f};
              if (tj <= ti) {
#pragma unroll
                  for (int ks = 0; ks < 2; ++ks) { const bf16x8 a = *(const LAS bf16x8*)(lds + GL_KF + ((tj * 16 + fr) * GL_LD + ks * 32 + fq * 8) * 2), bb = *(const LAS bf16x8*)(lds + GL_QF + ((ti * 16 + fr) * GL_LD + ks * 32 + fq * 8) * 2);
                      af = __builtin_amdgcn_mfma_f32_16x16x32_bf16(a, bb, af, 0, 0, 0); } }
              if (tj >= ti) {
#pragma unroll
                  for (int ks = 0; ks < 2; ++ks) { const bf16x8 a = *(const LAS bf16x8*)(lds + GL_KB + ((tj * 16 + fr) * GL_LD + ks * 32 + fq * 8) * 2), bb = *(const LAS bf16x8*)(lds + GL_QB + ((ti * 16 + fr) * GL_LD + ks * 32 + fq * 8) * 2);
                      ab = __builtin_amdgcn_mfma_f32_16x16x32_bf16(a, bb, ab, 0, 0, 0); } }
              float p[4];
#pragma unroll
              for (int rg = 0; rg < 4; ++rg) { const int i = ti * 16 + fr, j = tj * 16 + 4 * fq + rg; p[rg] = (j <= i ? af[rg] : 0.f) + (j >= i ? ab[rg] : 0.f); }
              u32x2 w; w.x = pk2(p[0], p[1]); w.y = pk2(p[2], p[3]);
              *(LAS u32x2*)(lds + GL_PP + ((ti * 16 + fr) * GL_LD + tj * 16 + 4 * fq) * 2) = w; } }
        __syncthreads();
        f32x4 acc[4];
#pragma unroll
        for (int et = 0; et < 4; ++et) acc[et] = (f32x4){0.f, 0.f, 0.f, 0.f};
#pragma unroll
        for (int ks = 0; ks < 2; ++ks) {
            const int bo = ((tg * 16 + fr) * GL_LD + ks * 32 + fq * 8) * 2;
            const bf16x8 bP = *(const LAS bf16x8*)(lds + GL_PP + bo), bF = *(const LAS bf16x8*)(lds + GL_QF + bo), bB = *(const LAS bf16x8*)(lds + GL_QB + bo);
#pragma unroll
            for (int et = 0; et < 4; ++et) { const int ao = ((eh * 64 + et * 16 + fr) * GL_LD + ks * 32 + fq * 8) * 2;
                const bf16x8 aV = *(const LAS bf16x8*)(lds + GL_VT + ao), aF = *(const LAS bf16x8*)(lds + GL_SF + ao), aB = *(const LAS bf16x8*)(lds + GL_SB + ao);
                acc[et] = __builtin_amdgcn_mfma_f32_16x16x32_bf16(aV, bP, acc[et], 0, 0, 0);
                acc[et] = __builtin_amdgcn_mfma_f32_16x16x32_bf16(aF, bF, acc[et], 0, 0, 0);
                acc[et] = __builtin_amdgcn_mfma_f32_16x16x32_bf16(aB, bB, acc[et], 0, 0, 0); } }
        float ss = 0.f;
#pragma unroll
        for (int et = 0; et < 4; ++et) ss += acc[et][0] * acc[et][0] + acc[et][1] * acc[et][1] + acc[et][2] * acc[et][2] + acc[et][3] * acc[et][3];
        ss += __shfl_xor(ss, 16); ss += __shfl_xor(ss, 32);
        LAS float* SSQ = (LAS float*)(lds + GL_SSQ);
        if (fq == 0) SSQ[eh * 64 + tg * 16 + fr] = ss;
        __syncthreads();
        const float rstd = rsqrtf((SSQ[tg * 16 + fr] + SSQ[64 + tg * 16 + fr]) * (1.f / 128.f) + 1e-6f);
        const int tok = row0 + tg * 16 + fr;
#pragma unroll
        for (int et = 0; et < 4; ++et) { const int e = eh * 64 + et * 16 + 4 * fq; const u32x2 rv = rcur[et];
            const float r0 = __uint_as_float(rv.x << 16), r1 = __uint_as_float(rv.x & 0xffff0000u), r2 = __uint_as_float(rv.y << 16), r3 = __uint_as_float(rv.y & 0xffff0000u);
            uint2 w; w.x = pk2(acc[et][0] * rstd * nwv[et][0] * siluf_(r0), acc[et][1] * rstd * nwv[et][1] * siluf_(r1)); w.y = pk2(acc[et][2] * rstd * nwv[et][2] * siluf_(r2), acc[et][3] * rstd * nwv[et][3] * siluf_(r3));
            *(uint2*)(G.MIX + (size_t)tok * DM + h * 128 + e) = w; }
    }
    __syncthreads();
}

DEVI void s5w_build(const MArgs_in& in, unsigned char* ws, LAS unsigned char* lds, int g) {
    LAS float* LP = (LAS float*)lds;
    LAS float* BB = LP + 2 * 17 * 64 * 2;
    LAS float* CC = BB + 2 * 64 * 16 * 2;
    LAS float* KK = CC + 2 * 16 * 64 * 2;
    LAS float* CO = KK + 2 * 16 * 256;
    const int tid = threadIdx.x;
    S5P* P = (S5P*)(ws + OFF_S5P);
    if (tid < 128) { const int p = tid & 63, d = tid >> 6; const int i = (d * 32 + g) * 64 + p;
        const double dt = exp((double)in.log_dt[d * 32 + g]), lr = in.lam_re[i], li = in.lam_im[i];
        const double mag = exp(lr * dt), ar = mag * cos(li * dt), ai = mag * sin(li * dt);
        { const double nr = ar - 1.0, ni = ai, den = lr * lr + li * li; CO[(d * 64 + p) * 2] = (float)((nr * lr + ni * li) / den); CO[(d * 64 + p) * 2 + 1] = (float)((ni * lr - nr * li) / den); }
        double pr = 1.0, pi = 0.0;
        for (int n = 0; n < 17; ++n) { LP[((d * 17 + n) * 64 + p) * 2] = (float)pr; LP[((d * 17 + n) * 64 + p) * 2 + 1] = (float)pi;
            if (n == 16) { P->lam16[d][g][p][0] = (float)pr; P->lam16[d][g][p][1] = (float)pi; }
            const double tr = pr * ar - pi * ai, ti = pr * ai + pi * ar; pr = tr; pi = ti; } }
    for (int t = tid; t < 2 * 16 * 64; t += NTHR) { const int p = t & 63, h = (t >> 6) & 15, d = t >> 10; const size_t ix = (((size_t)d * 32 + g) * 16 + h) * 64 + p;
        CC[((d * 16 + h) * 64 + p) * 2] = in.c_re[ix]; CC[((d * 16 + h) * 64 + p) * 2 + 1] = in.c_im[ix]; }
    __syncthreads();
    for (int t = tid; t < 2 * 64 * 16; t += NTHR) { const int h = t & 15, p = (t >> 4) & 63, d = t >> 10; const size_t ix = (((size_t)d * 32 + g) * 64 + p) * 16 + h;
        const float br = in.b_re[ix], bi = in.b_im[ix], cr = CO[(d * 64 + p) * 2], ci = CO[(d * 64 + p) * 2 + 1];
        BB[((d * 64 + p) * 16 + h) * 2] = cr * br - ci * bi; BB[((d * 64 + p) * 16 + h) * 2 + 1] = cr * bi + ci * br; }
    __syncthreads();
    { const int h = tid & 15, n = (tid >> 4) & 15, d = tid >> 8; float acc[16];
#pragma unroll
      for (int q = 0; q < 16; ++q) acc[q] = 0.f;
      for (int p = 0; p < 64; ++p) { const float cr = CC[((d * 16 + h) * 64 + p) * 2], ci = CC[((d * 16 + h) * 64 + p) * 2 + 1], lr = LP[((d * 17 + n) * 64 + p) * 2], li = LP[((d * 17 + n) * 64 + p) * 2 + 1];
          const float tr = cr * lr - ci * li, ti = cr * li + ci * lr; const LAS f32x4* bb = (const LAS f32x4*)(BB + ((d * 64 + p) * 16) * 2);
#pragma unroll
          for (int q = 0; q < 8; ++q) { const f32x4 x = bb[q]; acc[2 * q] += tr * x[0] - ti * x[1]; acc[2 * q + 1] += tr * x[2] - ti * x[3]; } }
#pragma unroll
      for (int q = 0; q < 16; ++q) KK[(d * 16 + n) * 256 + h * 16 + q] = acc[q]; }
    __syncthreads();
    bf16_t* BF = (bf16_t*)(ws + OFF_S5BF) + (size_t)g * 256 * 256;
    for (int t = tid; t < 256 * 32; t += NTHR) { const int k8 = t & 31, row = t >> 5, p = (row & 127) >> 1, im = row & 1, d = row >> 7; float o[8];
#pragma unroll
        for (int q = 0; q < 8; ++q) { const int k = k8 * 8 + q, j = k >> 4, hp = k & 15, pw = d ? j : 15 - j;
            const float lr = LP[((d * 17 + pw) * 64 + p) * 2], li = LP[((d * 17 + pw) * 64 + p) * 2 + 1], br = BB[((d * 64 + p) * 16 + hp) * 2], bi = BB[((d * 64 + p) * 16 + hp) * 2 + 1];
            o[q] = im ? lr * bi + li * br : lr * br - li * bi; }
        uint4 w; w.x = pk2(o[0], o[1]); w.y = pk2(o[2], o[3]); w.z = pk2(o[4], o[5]); w.w = pk2(o[6], o[7]);
        *(uint4*)(BF + (size_t)row * 256 + k8 * 8) = w; }
    bf16_t* BY = (bf16_t*)(ws + OFF_S5BY) + (size_t)g * 256 * 512;
    for (int t = tid; t < 256 * 64; t += NTHR) { const int k8 = t & 63, n = t >> 6, i = n >> 4, h = n & 15; float o[8];
#pragma unroll
        for (int q = 0; q < 8; ++q) { const int k = k8 * 8 + q; float v;
            if (k < 256) { const int j = k >> 4, hp = k & 15; v = 0.f; if (i >= j) v += KK[(0 * 16 + (i - j)) * 256 + h * 16 + hp]; if (j >= i) v += KK[(1 * 16 + (j - i)) * 256 + h * 16 + hp]; }
            else { const int d = (k - 256) >> 7, r = (k - 256) & 127, p = r >> 1, im = r & 1, pw = d ? 16 - i : i + 1;
                const float cr = CC[((d * 16 + h) * 64 + p) * 2], ci = CC[((d * 16 + h) * 64 + p) * 2 + 1], lr = LP[((d * 17 + pw) * 64 + p) * 2], li = LP[((d * 17 + pw) * 64 + p) * 2 + 1];
                v = im ? -(cr * li + ci * lr) : cr * lr - ci * li; }
            o[q] = v; }
        uint4 w; w.x = pk2(o[0], o[1]); w.y = pk2(o[2], o[3]); w.z = pk2(o[4], o[5]); w.w = pk2(o[6], o[7]);
        *(uint4*)(BY + (size_t)n * 512 + k8 * 8) = w; }
    __syncthreads();
}
struct ProbS5F {
    static constexpr bool HOIST = false, PAIR = false, FP8 = false;
    const bf16_t* A; const bf16_t* B; int K; float* F;
    DEVI int nunits() const { return 32 * 9; }
    DEVI void unit(int L, int& z, int& pm, int& pn) const { z = L & 31; pm = L >> 5; pn = 0; }
    DEVI int M(int) const { return 2304; }
    DEVI unsigned aoffb(int z, int r) const { return (unsigned)(z * 2304 + r) * 1024u; }
    DEVI const bf16_t* Bt(int z) const { return B + (size_t)z * 256 * 256; }
    DEVI void store(int z, int r, int c0, const float (&v)[8]) const { float* p = F + ((size_t)z * 2304 + r) * 256 + c0; *(float4*)p = make_float4(v[0], v[1], v[2], v[3]); *(float4*)(p + 4) = make_float4(v[4], v[5], v[6], v[7]); }
};
struct ProbS5Y {
    static constexpr bool HOIST = false, PAIR = false, FP8 = false;
    const bf16_t* A; const bf16_t* B; int K; const float* dvec; bf16_t* YS;
    DEVI int nunits() const { return 32 * 8; }
    DEVI void unit(int L, int& z, int& pm, int& pn) const { z = L & 31; pm = L >> 5; pn = 0; }
    DEVI int M(int) const { return 2048; }
    DEVI unsigned aoffb(int z, int r) const { return (unsigned)(z * 2304 + r) * 1024u; }
    DEVI const bf16_t* Bt(int z) const { return B + (size_t)z * 256 * 512; }
    DEVI void store(int z, int r, int c0, const float (&v)[8]) const {
        const int b = r >> 8, sq = ((r & 255) << 4) + (c0 >> 4), gc = sq >> 6, gr = sq & 63, tok = b * SEQ + gr * 64 + gc, ch = z * 16 + (c0 & 15);
        const uint4 uv = *(const uint4*)(A + ((size_t)z * 2304 + r) * 512 + c0); const unsigned uw[4] = {uv.x, uv.y, uv.z, uv.w};
        const float4 d0 = *(const float4*)(dvec + ch), d1 = *(const float4*)(dvec + ch + 4); const float dd[8] = {d0.x, d0.y, d0.z, d0.w, d1.x, d1.y, d1.z, d1.w}; float o[8];
#pragma unroll
        for (int j = 0; j < 4; ++j) { o[2 * j] = gelu_tanh(v[2 * j] + dd[2 * j] * __uint_as_float(uw[j] << 16)); o[2 * j + 1] = gelu_tanh(v[2 * j + 1] + dd[2 * j + 1] * __uint_as_float(uw[j] & 0xffff0000u)); }
        uint4 w; w.x = pk2(o[0], o[1]); w.y = pk2(o[2], o[3]); w.z = pk2(o[4], o[5]); w.w = pk2(o[6], o[7]);
        *(uint4*)(YS + (size_t)tok * 512 + ch) = w;
    }
};
typedef float f32x2_t __attribute__((ext_vector_type(2)));
DEVI int s5_row(int st, int b, int dir) { return st < 16 ? 2048 + b * 16 + (dir ? 15 - st : st) : b * 256 + (dir ? 271 - st : st - 16); }
DEVI void s5_carry(const float* __restrict__ F, bf16_t* __restrict__ U2, const S5P* __restrict__ P, int id, int lane) {
    const int g = id & 31, dir = (id >> 5) & 1, b = id >> 6;
    const float l16r = P->lam16[dir][g][lane][0], l16i = P->lam16[dir][g][lane][1];
    const float* Fg = F + (size_t)g * 2304 * 256 + dir * 128 + 2 * lane;
    bf16_t* Ug = U2 + (size_t)g * 2304 * 512 + 256 + dir * 128 + 2 * lane;
    float hr = 0.f, hi = 0.f;
    f32x2_t b0[17], b1[17], b2[17], b3[17];
#define S5_LOAD(buf, bt) do { _Pragma("unroll") for (int j = 0; j < 17; ++j) buf[j] = *(const f32x2_t*)(Fg + (size_t)s5_row((bt) * 17 + j, b, dir) * 256); } while (0)
#define S5_PROC(buf, bt) do { _Pragma("unroll") for (int j = 0; j < 17; ++j) { const int st = (bt) * 17 + j; \
        if (st >= 16) *(unsigned*)(Ug + (size_t)s5_row(st, b, dir) * 512) = pk2(hr, hi); \
        const float tr = l16r * hr - l16i * hi + buf[j][0], ti = l16r * hi + l16i * hr + buf[j][1]; hr = tr; hi = ti; } } while (0)
    S5_LOAD(b0, 0); S5_LOAD(b1, 1); S5_LOAD(b2, 2);
#pragma unroll 1
    for (int bt = 0; bt < 16; bt += 4) {
        S5_LOAD(b3, bt + 3); S5_PROC(b0, bt);
        if (bt + 4 < 16) S5_LOAD(b0, bt + 4);
        S5_PROC(b1, bt + 1);
        if (bt + 5 < 16) S5_LOAD(b1, bt + 5);
        S5_PROC(b2, bt + 2);
        if (bt + 6 < 16) S5_LOAD(b2, bt + 6);
        S5_PROC(b3, bt + 3);
    }
#undef S5_LOAD
#undef S5_PROC
}
DEVI void ph_scans(const GlaPtrs& G, const float* __restrict__ F, bf16_t* __restrict__ U2, const S5P* __restrict__ P, LAS unsigned char* lds, int blk, bool do_gla, bool do_s5) {
    int tid = threadIdx.x; asm volatile("" : "+v"(tid));
    const int wave = __builtin_amdgcn_readfirstlane(tid >> 6), lane = tid & 63;
    const int chain = blk >> 2;
    if (do_gla) for (int i = tid; i < 68 * 16; i += NTHR) ((LAS f32x4*)lds)[i] = ((const f32x4*)(G.ADEC + (size_t)chain * 68 * 64))[i];
    __syncthreads();
    if (wave < 4) { if (do_gla) {
        const int e = (blk & 3) * 32 + (tid >> 3), d8 = (tid & 7) * 8;
        const bf16_t* up = G.UCH + ((size_t)chain * 68 * 128 + e) * 64 + d8;
        bf16_t* sp = G.SST + ((size_t)chain * 64 * 128 + e) * 64 + d8;
        float S[8];
#pragma unroll
        for (int q = 0; q < 8; ++q) S[q] = 0.f;
        u32x4 cur[17], nxt[17];
#pragma unroll
        for (int j = 0; j < 17; ++j) cur[j] = *(const u32x4*)(up + (size_t)j * 8192);
#pragma unroll 1
        for (int bt = 0; bt < 4; ++bt) {
            if (bt < 3) {
#pragma unroll
                for (int j = 0; j < 17; ++j) nxt[j] = *(const u32x4*)(up + (size_t)((bt + 1) * 17 + j) * 8192); }
#pragma unroll
            for (int j = 0; j < 17; ++j) { const int step = bt * 17 + j;
                if (step >= 4) { u32x4 o; o.x = pk2(S[0], S[1]); o.y = pk2(S[2], S[3]); o.z = pk2(S[4], S[5]); o.w = pk2(S[6], S[7]); *(u32x4*)(sp + (size_t)(step - 4) * 8192) = o; }
                const f32x4 a0 = *(const LAS f32x4*)(lds + (step * 64 + d8) * 4), a1 = *(const LAS f32x4*)(lds + (step * 64 + d8 + 4) * 4);
                const unsigned w0 = cur[j].x, w1 = cur[j].y, w2 = cur[j].z, w3 = cur[j].w;
                S[0] = a0[0] * S[0] + __uint_as_float(w0 << 16); S[1] = a0[1] * S[1] + __uint_as_float(w0 & 0xffff0000u);
                S[2] = a0[2] * S[2] + __uint_as_float(w1 << 16); S[3] = a0[3] * S[3] + __uint_as_float(w1 & 0xffff0000u);
                S[4] = a1[0] * S[4] + __uint_as_float(w2 << 16); S[5] = a1[1] * S[5] + __uint_as_float(w2 & 0xffff0000u);
                S[6] = a1[2] * S[6] + __uint_as_float(w3 << 16); S[7] = a1[3] * S[7] + __uint_as_float(w3 & 0xffff0000u); }
#pragma unroll
            for (int j = 0; j < 17; ++j) cur[j] = nxt[j];
        } } }
    else if (wave < 6) { if (do_s5) s5_carry(F, U2, P, blk * 2 + (wave - 4), lane); }
    __syncthreads();
}


constexpr int NPH = 12;

struct WItem { const float* src; bf16_t* dst; int K, N, c0, n0, k0; bool act; bool f8; };
constexpr int WC_ITEMS = 18 * 4 + 4 * 2 + 8 * 4 + 32 * 16 * 4 + 32 * 8 * 4;
DEVI WItem wconv_decode(const MArgs& a, unsigned char* ws, int it) {
    constexpr int I0 = 18 * 4, I1 = I0 + 4 * 2, I2 = I1 + 8 * 4, I3 = I2 + 32 * 16 * 4, I4 = I3 + 32 * 8 * 4;
    WItem w; w.src = a.in[7]; w.dst = nullptr; w.K = DM; w.N = INC; w.c0 = 0; w.n0 = 0; w.k0 = 0; w.act = it < I4; w.f8 = MOE_FP8 && it >= I2;
    if (w.act) {
        if (it < I0) { w.src = a.in[7]; w.dst = (bf16_t*)(ws + OFF_WIN); w.K = DM; w.N = INC; w.n0 = (it % 18) * 128; w.k0 = (it / 18) * 256; w.c0 = w.n0; }
        else if (it < I1) { const int r = it - I0; w.src = a.in[19]; w.dst = (bf16_t*)(ws + OFF_WGLU); w.K = 512; w.N = 512; w.n0 = (r % 4) * 128; w.k0 = (r / 4) * 256; w.c0 = w.n0; }
        else if (it < I2) { const int r = it - I1; w.src = a.in[21]; w.dst = (bf16_t*)(ws + OFF_WOUT); w.K = DM; w.N = DM; w.n0 = (r % 8) * 128; w.k0 = (r / 8) * 256; w.c0 = w.n0; }
        else if (it < I3) { const int r = it - I2, e = r / 64, q = r % 64; w.src = a.in[25] + (size_t)e * DM * 2048; w.dst = (bf16_t*)(ws + OFF_WG + (size_t)e * 2048 * DM * (MOE_FP8 ? 1 : 2)); w.K = DM; w.N = 2048;
            w.n0 = (q % 16) * 128; w.k0 = (q / 16) * 256; w.c0 = wsrc_col<1>(w.n0); }
        else { const int r = it - I3, e = r / 32, q = r % 32; w.src = a.in[27] + (size_t)e * DFF * DM; w.dst = (bf16_t*)(ws + OFF_WD + (size_t)e * DM * DFF * (MOE_FP8 ? 1 : 2)); w.K = DFF; w.N = DM; w.n0 = (q % 8) * 128; w.k0 = (q / 8) * 256; w.c0 = w.n0; }
    }
    return w;
}
DEVI void wconv_load(const WItem& w, int tid, f32x4 (&r)[16]) {
    const int l32 = tid & 31, kr = tid >> 5, col = w.c0 + 4 * l32; const bool ok = col < w.N; const int cc = ok ? col : 0;
    if (w.f8) { const float* p = w.src + (size_t)(w.k0 + 4 * kr) * w.N + cc; const size_t st = (size_t)64 * w.N;
#pragma unroll
        for (int i = 0; i < 4; ++i)
#pragma unroll
            for (int j = 0; j < 4; ++j) r[4 * i + j] = *(const f32x4*)(p + i * st + (size_t)j * w.N);
        return; }
    const float* p = w.src + (size_t)(w.k0 + 2 * kr) * w.N + cc; const size_t st = (size_t)32 * w.N;
#pragma unroll
    for (int i = 0; i < 8; ++i) { r[2 * i] = *(const f32x4*)(p + i * st); r[2 * i + 1] = *(const f32x4*)(p + i * st + w.N); }
}
DEVI void wconv_store(const WItem& cur, LAS unsigned char* lds, int tid, const f32x4 (&rc)[16]) {
    constexpr int TS = 264;
    const int l32 = tid & 31, kr = tid >> 5;
    if (cur.f8) {
        const int sw8 = ((l32 >> 1) & 15) << 2;
#pragma unroll
        for (int i = 0; i < 4; ++i) { const int k = (4 * kr + 64 * i) ^ sw8;
#pragma unroll
            for (int c = 0; c < 4; ++c) *(LAS unsigned*)(lds + (4 * l32 + c) * 256 + k) = pk4_fp8(rc[4 * i][c] * 32.f, rc[4 * i + 1][c] * 32.f, rc[4 * i + 2][c] * 32.f, rc[4 * i + 3][c] * 32.f); }
        __syncthreads();
        if (cur.act) {
#pragma unroll
            for (int i = 0; i < 4; ++i) { const int ch = tid + NTHR * i, n = ch >> 4, c16 = ch & 15, t = (n >> 3) & 15, m = t & 3;
                const u32x4 v = *(const LAS u32x4*)(lds + n * 256 + ((c16 ^ (t >> 2)) * 16));
                u32x4 o; o.x = (m & 1) ? v.y : v.x; o.y = (m & 1) ? v.x : v.y; o.z = (m & 1) ? v.w : v.z; o.w = (m & 1) ? v.z : v.w;
                if (m & 2) { const unsigned t0 = o.x, t1 = o.y; o.x = o.z; o.y = o.w; o.z = t0; o.w = t1; }
                *(u32x4*)((char*)cur.dst + (size_t)(cur.n0 + n) * cur.K + cur.k0 + c16 * 16) = o; } }
        __syncthreads();
        return; }
    const float okf = (cur.c0 + 4 * l32 < cur.N) ? 1.f : 0.f;
    const int sw = ((l32 >> 1) & 15) << 1;
#pragma unroll
    for (int i = 0; i < 8; ++i) { const int k = (2 * kr + 32 * i) ^ sw;
#pragma unroll
        for (int c = 0; c < 4; ++c) *(LAS unsigned*)(lds + ((4 * l32 + c) * TS + k) * 2) = pk2(rc[2 * i][c] * okf, rc[2 * i + 1][c] * okf); }
    __syncthreads();
    if (cur.act) {
#pragma unroll
        for (int i = 0; i < 8; ++i) { const int ch = tid + NTHR * i, n = ch >> 5, c8 = ch & 31, sn = ((n >> 3) & 15) << 1, m = (sn >> 1) & 3;
            const u32x4 v = *(const LAS u32x4*)(lds + (n * TS + ((c8 ^ (sn >> 3)) * 8)) * 2);
            u32x4 o; o.x = (m & 1) ? v.y : v.x; o.y = (m & 1) ? v.x : v.y; o.z = (m & 1) ? v.w : v.z; o.w = (m & 1) ? v.z : v.w;
            if (m & 2) { const unsigned t0 = o.x, t1 = o.y; o.x = o.z; o.y = o.w; o.z = t0; o.w = t1; }
            *(u32x4*)(cur.dst + (size_t)(cur.n0 + n) * cur.K + cur.k0 + c8 * 8) = o; } }
    __syncthreads();
}
DEVI void ph_prep(const MArgs& a, LAS unsigned char* lds, int bid, int G) {
    const int tid = threadIdx.x, wave = tid >> 6, lane = tid & 63;
    unsigned char* ws = a.ws;
    const bool big = G > 136; const int nsp = big ? 32 : G;
    const bool special = !big || (bid >= 104 && bid < 136); const int sid = big ? bid - 104 : bid;
    if (special) {
        for (int i = sid * NTHR + tid; i < 2 * 32 * 64; i += nsp * NTHR) s5prep_one(a.in[11], a.in[12], a.in[13], a.in[14], a.in[15], (S5P*)(ws + OFF_S5P), i);
        for (int g = sid; g < 32; g += nsp) { MArgs_in in{a.in[11], a.in[12], a.in[13], a.in[14], a.in[15], a.in[16], a.in[17]}; s5w_build(in, ws, lds, g); }
    }
    { LAS float* s = (LAS float*)lds; LAS float* part = (LAS float*)(lds + 36864);
      const float* c = a.in[1]; const float* cc = a.in[3]; const float* ada_w = a.in[4]; float* MP = (float*)(ws + OFF_SST);
      typedef float f32x2 __attribute__((ext_vector_type(2)));
      bool have_s = false;
      for (int mi = bid; mi < 256; mi += G) {
          if (!have_s) { for (int i = tid; i < 9216; i += NTHR) { const int r = i >> 10, k = i & 1023; const float v = r < 8 ? c[r * 1024 + k] : cc[k]; s[i] = siluf_(v); } have_s = true; __syncthreads(); }
          const int ks = mi >> 4, cs = mi & 15, k0 = ks * 64 + wave * 8;
          f32x2 wv[3][8];
#pragma unroll
          for (int ps = 0; ps < 3; ++ps)
#pragma unroll
              for (int q = 0; q < 8; ++q) wv[ps][q] = *(const f32x2*)(ada_w + (size_t)(k0 + q) * 6144 + cs * 384 + ps * 128 + lane * 2);
#pragma unroll
          for (int ps = 0; ps < 3; ++ps) { float acc[9][2];
#pragma unroll
              for (int r = 0; r < 9; ++r) { acc[r][0] = 0.f; acc[r][1] = 0.f; }
#pragma unroll
              for (int q = 0; q < 8; ++q) {
#pragma unroll
                  for (int r = 0; r < 9; ++r) { const float sv = s[r * 1024 + k0 + q]; acc[r][0] += sv * wv[ps][q][0]; acc[r][1] += sv * wv[ps][q][1]; } }
#pragma unroll
              for (int r = 0; r < 9; ++r) { part[(wave * 9 + r) * 128 + lane * 2] = acc[r][0]; part[(wave * 9 + r) * 128 + lane * 2 + 1] = acc[r][1]; }
              __syncthreads();
              for (int i = tid; i < 9 * 128; i += NTHR) { const int r = i >> 7, l = i & 127; float sum = 0.f;
#pragma unroll
                  for (int w = 0; w < 8; ++w) sum += part[(w * 9 + r) * 128 + l];
                  MP[((size_t)ks * 9 + r) * 6144 + cs * 384 + ps * 128 + l] = sum; }
              __syncthreads(); }
          asm volatile("s_waitcnt vmcnt(0)" ::: "memory");
          __syncthreads();
          volatile LAS int* lastf = (volatile LAS int*)(lds + MISC_OFF + 248);
          if (tid == 0) { __builtin_amdgcn_fence(__ATOMIC_RELEASE, "agent"); asm volatile("s_waitcnt vmcnt(0)" ::: "memory");
              const unsigned old = __hip_atomic_fetch_add((unsigned*)(ws + OFF_CTL) + CW_MODC + cs, 1u, __ATOMIC_RELAXED, __HIP_MEMORY_SCOPE_AGENT);
              lastf[0] = (old == 15u) ? 1 : 0;
              if (old == 15u) { __builtin_amdgcn_fence(__ATOMIC_ACQUIRE, "agent"); asm volatile("s_waitcnt vmcnt(0)" ::: "memory"); } }
          __syncthreads();
          if (lastf[0]) { const float* ada_b = a.in[5]; float* mod = (float*)(ws + OFF_MOD);
              for (int i = tid; i < 9 * 384; i += NTHR) { const int r = i / 384, col = cs * 384 + i % 384; float sum = ada_b[col];
#pragma unroll
                  for (int k2 = 0; k2 < 16; ++k2) sum += __hip_atomic_load(MP + ((size_t)k2 * 9 + r) * 6144 + col, __ATOMIC_RELAXED, __HIP_MEMORY_SCOPE_AGENT);
                  mod[r * 6144 + col] = sum; } }
          __syncthreads();
      } }
    { unsigned* ctr = (unsigned*)(ws + OFF_CTL) + CW_WQ; volatile LAS int* q = (volatile LAS int*)(lds + MISC_OFF + 240);
      __syncthreads();
      if (tid == 0) { q[0] = (int)atomicAdd(ctr, 1u); q[1] = (int)atomicAdd(ctr, 1u); }
      __syncthreads();
      int ia = q[0], ib = q[1];
      f32x4 ra[16], rb[16];
      WItem wa = wconv_decode(a, ws, ia); wconv_load(wa, tid, ra);
      while (ia < WC_ITEMS) {
          const WItem wb = wconv_decode(a, ws, ib); wconv_load(wb, tid, rb);
          if (tid == 0) q[0] = (int)atomicAdd(ctr, 1u);
          wconv_store(wa, lds, tid, ra);
          ia = q[0];
          wa = wconv_decode(a, ws, ia); wconv_load(wa, tid, ra);
          if (tid == 0) q[1] = (int)atomicAdd(ctr, 1u);
          wconv_store(wb, lds, tid, rb);
          ib = q[1];
      } }
}


DEVI void ph_router(const float* __restrict__ X, const float* __restrict__ OUTB, const float* __restrict__ w, const float* __restrict__ mod, const float* __restrict__ rw, const float* __restrict__ rb,
                    bf16_t* __restrict__ H2, int* __restrict__ cnt, int* __restrict__ list, float* __restrict__ gate, int* __restrict__ epos, LAS unsigned char* lds, int bid, int G, bool commit) {
    int tid = threadIdx.x; asm volatile("" : "+v"(tid));
    const int wave = __builtin_amdgcn_readfirstlane(tid >> 6), lane = tid & 63, e16 = lane & 15, kq = lane >> 4;
    constexpr int HS = 1028;
    LAS float* hrow = (LAS float*)lds;
    LAS float* part = (LAS float*)(lds + 16 * HS * 4);
    LAS int* lcnt = (LAS int*)(lds + 16 * HS * 4 + 16384);
    LAS int* gbase = lcnt + 32; LAS int* ent = lcnt + 64;
    if (tid < 64) lcnt[tid] = 0;
    float wreg[2][32];
#pragma unroll
    for (int et = 0; et < 2; ++et)
#pragma unroll
        for (int q = 0; q < 32; ++q) wreg[et][q] = rw[(wave * 128 + kq * 32 + q) * 32 + et * 16 + e16];
    const float rbe = rb[lane & 31];
    const int per = (NTOK + G - 1) / G;
    const int t0 = bid * per, t1 = (t0 + per) < NTOK ? (t0 + per) : NTOK;
    const bool onebatch = (SEQ % per) == 0; const int b0 = t0 / SEQ;
    float4 cw[4], csc[4], csh[4], cg1[4];
#pragma unroll
    for (int j = 0; j < 4; ++j) { const int k = lane * 4 + 256 * j; cw[j] = *(const float4*)(w + k); csc[j] = *(const float4*)(mod + b0 * 6144 + 4096 + k); csh[j] = *(const float4*)(mod + b0 * 6144 + 3072 + k); cg1[j] = *(const float4*)(mod + b0 * 6144 + 2048 + k); }
    float4 v[2][4]; uint2 mx[2][4];
#pragma unroll
    for (int u = 0; u < 2; ++u) { const int tok = t0 + wave * 2 + u; if (tok < t1) {
#pragma unroll
        for (int j = 0; j < 4; ++j) { v[u][j] = *(const float4*)(X + (size_t)tok * DM + lane * 4 + 256 * j); mx[u][j] = *(const uint2*)((const bf16_t*)(OUTB + (size_t)tok * DM) + DM + lane * 4 + 256 * j); } } }
    for (int tb = t0; tb < t1; tb += 16) {
#pragma unroll
        for (int u = 0; u < 2; ++u) { const int tok = tb + wave * 2 + u;
            if (tok < t1) {
                const int b = tok / SEQ; float ss = 0.f; const float* g1p = mod + b * 6144 + 2048;
#pragma unroll
                for (int j = 0; j < 4; ++j) { const float4 g1 = onebatch ? cg1[j] : *(const float4*)(g1p + lane * 4 + 256 * j);
                    v[u][j].x += g1.x * __uint_as_float(mx[u][j].x << 16); v[u][j].y += g1.y * __uint_as_float(mx[u][j].x & 0xffff0000u);
                    v[u][j].z += g1.z * __uint_as_float(mx[u][j].y << 16); v[u][j].w += g1.w * __uint_as_float(mx[u][j].y & 0xffff0000u);
                    ss += v[u][j].x * v[u][j].x + v[u][j].y * v[u][j].y + v[u][j].z * v[u][j].z + v[u][j].w * v[u][j].w; }
                const float rstd = rsqrtf(wave_sum(ss) * (1.f / DM) + 1e-6f);
                const float* msh = mod + b * 6144 + 3072; const float* msc = mod + b * 6144 + 4096;
#pragma unroll
                for (int j = 0; j < 4; ++j) { const int k = lane * 4 + 256 * j;
                    const float4 ww = cw[j], sc = onebatch ? csc[j] : *(const float4*)(msc + k), sh = onebatch ? csh[j] : *(const float4*)(msh + k);
                    f32x4 hv; hv[0] = v[u][j].x * rstd * ww.x * (1.f + sc.x) + sh.x; hv[1] = v[u][j].y * rstd * ww.y * (1.f + sc.y) + sh.y; hv[2] = v[u][j].z * rstd * ww.z * (1.f + sc.z) + sh.z; hv[3] = v[u][j].w * rstd * ww.w * (1.f + sc.w) + sh.w;
                    *(LAS f32x4*)(hrow + (wave * 2 + u) * HS + k) = hv;
                    if (MOE_FP8) *(unsigned*)((char*)H2 + (size_t)tok * DM + k) = pk4_fp8(hv[0], hv[1], hv[2], hv[3]);
                    else { uint2 o; o.x = pk2(hv[0], hv[1]); o.y = pk2(hv[2], hv[3]); *(uint2*)(H2 + (size_t)tok * DM + k) = o; } }
            } else {
#pragma unroll
                for (int j = 0; j < 4; ++j) *(LAS f32x4*)(hrow + (wave * 2 + u) * HS + lane * 4 + 256 * j) = (f32x4){0.f, 0.f, 0.f, 0.f}; }
        }
#pragma unroll
        for (int u = 0; u < 2; ++u) { const int ntok = tb + 16 + wave * 2 + u; if (ntok < t1) {
#pragma unroll
            for (int j = 0; j < 4; ++j) { v[u][j] = *(const float4*)(X + (size_t)ntok * DM + lane * 4 + 256 * j); mx[u][j] = *(const uint2*)((const bf16_t*)(OUTB + (size_t)ntok * DM) + DM + lane * 4 + 256 * j); } } }
        __syncthreads();
        f32x4 acc0 = (f32x4){0.f, 0.f, 0.f, 0.f}, acc1 = (f32x4){0.f, 0.f, 0.f, 0.f};
#pragma unroll
        for (int i = 0; i < 8; ++i) { const f32x4 ar = *(const LAS f32x4*)(hrow + e16 * HS + wave * 128 + kq * 32 + 4 * i);
#pragma unroll
            for (int c = 0; c < 4; ++c) { acc0 = __builtin_amdgcn_mfma_f32_16x16x4f32(ar[c], wreg[0][4 * i + c], acc0, 0, 0, 0); acc1 = __builtin_amdgcn_mfma_f32_16x16x4f32(ar[c], wreg[1][4 * i + c], acc1, 0, 0, 0); } }
#pragma unroll
        for (int rg = 0; rg < 4; ++rg) { part[((wave * 2 + 0) * 16 + 4 * kq + rg) * 16 + e16] = acc0[rg]; part[((wave * 2 + 1) * 16 + 4 * kq + rg) * 16 + e16] = acc1[rg]; }
        __syncthreads();
        {
            const int t = wave * 2 + (lane >> 5), tk = tb + t, e = lane & 31, et = e >> 4, ee = e & 15;
            float lg = rbe;
#pragma unroll
            for (int q = 0; q < 8; ++q) lg += part[((q * 2 + et) * 16 + t) * 16 + ee];
            float val = lg; float tv[4]; int ti[4];
#pragma unroll
            for (int r = 0; r < 4; ++r) { float bv = val; int bi = e;
#pragma unroll
                for (int o = 1; o < 32; o <<= 1) { const float ov = __shfl_xor(bv, o); const int oi = __shfl_xor(bi, o); if (ov > bv || (ov == bv && oi < bi)) { bv = ov; bi = oi; } }
                tv[r] = bv; ti[r] = bi; if (e == bi) val = -3.0e38f; }
            const float e1 = __expf(tv[1] - tv[0]), e2 = __expf(tv[2] - tv[0]), e3 = __expf(tv[3] - tv[0]), inv = 1.f / (1.f + e1 + e2 + e3);
            if (e < 4 && tk < t1 && commit) { const float gv = e == 0 ? inv : e == 1 ? e1 * inv : e == 2 ? e2 * inv : e3 * inv; const int ex = e == 0 ? ti[0] : e == 1 ? ti[1] : e == 2 ? ti[2] : ti[3];
                const int ls = __hip_atomic_fetch_add(&lcnt[ex], 1, __ATOMIC_RELAXED, __HIP_MEMORY_SCOPE_WORKGROUP); ent[(tk - t0) * 4 + e] = (ex << 16) | ls; gate[tk * 4 + e] = gv; }
        }
    }
    __syncthreads();
    if (commit) {
        if (tid < NEXP) { const int c = lcnt[tid]; gbase[tid] = c ? atomicAdd(&cnt[tid], c) : 0; }
        __syncthreads();
        for (int i = tid; i < (t1 - t0) * 4; i += NTHR) { const int en = ent[i], ex = en >> 16, slot = gbase[ex] + (en & 0xffff), tk4 = t0 * 4 + i;
            list[ex * LISTCAP + slot] = tk4; epos[tk4] = ex * LISTCAP + slot; }
    }
    __syncthreads();
}

DEVI void build_ub(const int* cnt, volatile LAS int* ub) {
    if (threadIdx.x == 0) { int o = 0; for (int e = 0; e < NEXP; ++e) { ub[e] = o; o += (cnt[e] + 255) >> 8; } ub[NEXP] = o; }
    __syncthreads();
}

__global__ void __launch_bounds__(NTHR, 2) mega(MArgs a) {
    extern __shared__ __attribute__((aligned(16))) unsigned char lds_raw[];
    LAS unsigned char* lds = (LAS unsigned char*)lds_raw;
    volatile LAS unsigned* MISC = (volatile LAS unsigned*)(lds + MISC_OFF);
    const int tid = threadIdx.x, wave = __builtin_amdgcn_readfirstlane(tid >> 6), G = gridDim.x, bid = blockIdx.x;
    const int gw = bid * NWAVES + wave, NGW = G * NWAVES;
    for (int u = tid; u < MISC_BYTES / 4; u += NTHR) MISC[u] = 0u;
    __syncthreads();
    unsigned char* ws = a.ws; unsigned* ctl = (unsigned*)(ws + OFF_CTL);
    const bool multi = (a.ph_hi - a.ph_lo) > 1;
    XcdBarrier bar; bar.bar = ctl + CW_BAR; bar.x = 0; bar.st = MISC;
    if (multi) bar = xcd_barrier_post(ctl + CW_BAR, MISC);
    volatile LAS int* ub = (volatile LAS int*)(MISC + 16);
#ifndef PROBE_REP
#define PROBE_REP 0
#endif
#define IN(k) (a.ph_lo <= (k) && (k) < a.ph_hi)
#define NREP(k) (1 + ((PROBE_REP >> (k)) & 1))
#ifndef PROBE_VPH
#define PROBE_VPH -1
#endif
#ifndef PROBE_VMODE
#define PROBE_VMODE 1
#endif
#define FRESH_LANE int ft_ = threadIdx.x; asm volatile("" : "+v"(ft_)); const int lane = ft_ & 63; (void)lane
#ifndef PROBE_TK
#define PROBE_TK -1
#endif
    unsigned long long tstamp_prev = 0ull, tstamp_sel = 0ull;
    if (PROBE_TK >= 0) tstamp_prev = __builtin_amdgcn_s_memrealtime();
#define SEAM(k) do { if (IN(k) && IN((k) + 1)) xcd_barrier(bar); if (PROBE_TK >= 0) { const unsigned long long tn_ = __builtin_amdgcn_s_memrealtime(); if ((k) == PROBE_TK) tstamp_sel = tn_ - tstamp_prev; tstamp_prev = tn_; } } while (0)
    float* mod = (float*)(ws + OFF_MOD); S5P* s5p = (S5P*)(ws + OFF_S5P); float* gate = (float*)(ws + OFF_GATE); int* list = (int*)(ws + OFF_LIST);
    bf16_t* WIN = (bf16_t*)(ws + OFF_WIN); bf16_t* WGLU = (bf16_t*)(ws + OFF_WGLU); bf16_t* WOUT = (bf16_t*)(ws + OFF_WOUT); bf16_t* WG = (bf16_t*)(ws + OFF_WG); bf16_t* WD = (bf16_t*)(ws + OFF_WD);
    bf16_t* H = (bf16_t*)(ws + OFF_H); bf16_t* QK = (bf16_t*)(ws + OFF_QK); bf16_t* V = (bf16_t*)(ws + OFF_V); bf16_t* R = (bf16_t*)(ws + OFF_R); bf16_t* UT = (bf16_t*)(ws + OFF_UT);
    float* LR = (float*)(ws + OFF_LR); bf16_t* U2 = (bf16_t*)(ws + OFF_U2);
    bf16_t* YS = (bf16_t*)(ws + OFF_YS); bf16_t* MIX = (bf16_t*)(ws + OFF_MIX); bf16_t* ACT = (bf16_t*)(ws + OFF_ACT); bf16_t* YSL = (bf16_t*)(ws + OFF_YSL);
    int* cnt = (int*)(ctl + CW_CNT);

    if (IN(0)) for (int rp = 0; rp < NREP(0); ++rp) ph_prep(a, lds, bid, G);
    SEAM(0);
    if (IN(1)) for (int rp = 0; rp < NREP(1); ++rp) { FRESH_LANE; for (int row = gw; row < NROWS; row += NGW) norm_row(a.in[0], a.in[2], a.in[6], mod, H, row, lane, 0, 1024); }
    SEAM(1);
    if (IN(2) && PROBE_VPH == 2) { ProbIn P{H, DM, WIN, DM, DM, QK, V, R, UT, U2, LR}; gemm_phase<PROBE_VMODE>(lds, P, G, bid); }
    if (IN(2)) for (int rp = 0; rp < NREP(2); ++rp) { ProbIn P{H, DM, WIN, DM, DM, QK, V, R, UT, U2, LR}; gemm_phase(lds, P, G, bid); }
    SEAM(2);
    float* Fb = (float*)(ws + OFF_F); bf16_t* S5BF = (bf16_t*)(ws + OFF_S5BF); bf16_t* S5BY = (bf16_t*)(ws + OFF_S5BY);
    const GlaPtrs GP{QK, V, R, LR, a.in[8], a.in[9], a.in[10], (bf16_t*)(ws + OFF_UCH), (float*)(ws + OFF_ADEC), (bf16_t*)(ws + OFF_SST), MIX, (bf16_t*)(ws + OFF_GLT)};
    if (IN(3)) for (int rp = 0; rp < NREP(3); ++rp) {
        for (int r2 = 0; r2 < NREP(12); ++r2) { ProbS5F P{U2, S5BF, 256, Fb}; gemm_phase(lds, P, G, bid); }
        for (int r2 = 0; r2 < NREP(13); ++r2) gla_a_phase(GP, lds, bid, G);
    }
    SEAM(3);
    if (IN(4)) for (int rp = 0; rp < NREP(4); ++rp) {
        for (int blk = bid; blk < 256; blk += G) ph_scans(GP, Fb, U2, s5p, lds, blk, NREP(16) > 0, true);
    }
    SEAM(4);
    if (IN(5)) for (int rp = 0; rp < NREP(5); ++rp) {
        for (int r2 = 0; r2 < NREP(14); ++r2) { ProbS5Y P{U2, S5BY, 512, a.in[18], YS}; gemm_phase(lds, P, G, bid); }
        for (int r2 = 0; r2 < NREP(15); ++r2) gla_c_phase(GP, lds, bid, G);
    }
    SEAM(5);
    if (IN(6)) for (int rp = 0; rp < NREP(6); ++rp) { ProbGlu P{YS, 512, WGLU, 512, 512, a.in[20], MIX}; gemm_phase(lds, P, G, bid); }
    SEAM(6);
    if (IN(7)) for (int rp = 0; rp < NREP(7); ++rp) { ProbOut P{MIX, DM, WOUT, DM, DM, a.in[0], mod, a.out}; gemm_phase(lds, P, G, bid); }
    SEAM(7);
    if (IN(8)) for (int rp = NREP(8) - 1; rp >= 0; --rp) ph_router(a.in[0], a.out, a.in[22], mod, a.in[23], a.in[24], H, cnt, list, gate, (int*)(ws + OFF_EPOS), lds, bid, G, rp == 0);
    SEAM(8);
    if (IN(9) && PROBE_VPH == 9) { build_ub(cnt, ub); FMoe1 P{H, WG, MOE_FP8 ? DM / 2 : DM, cnt, list, a.in[26], ACT, (const LAS int*)ub, G}; gemm_phase<PROBE_VMODE>(lds, P, G, bid); }
    if (IN(9)) for (int rp = 0; rp < NREP(9); ++rp) { build_ub(cnt, ub); FMoe1 P{H, WG, MOE_FP8 ? DM / 2 : DM, cnt, list, a.in[26], ACT, (const LAS int*)ub, G}; gemm_phase(lds, P, G, bid); }
    SEAM(9);
    if (IN(10) && PROBE_VPH == 10) { build_ub(cnt, ub); FMoe2 P{ACT, WD, MOE_FP8 ? DFF / 2 : DFF, cnt, a.in[28], YSL, (const LAS int*)ub, G}; gemm_phase<PROBE_VMODE>(lds, P, G, bid); }
    if (IN(10)) for (int rp = 0; rp < NREP(10); ++rp) { build_ub(cnt, ub); FMoe2 P{ACT, WD, MOE_FP8 ? DFF / 2 : DFF, cnt, a.in[28], YSL, (const LAS int*)ub, G}; gemm_phase(lds, P, G, bid); }
    SEAM(10);
    if (IN(11)) { build_ub(cnt, ub); for (int rp = NREP(11) - 1; rp >= 0; --rp) { FRESH_LANE; for (int tok = gw; tok < NTOK; tok += NGW) final_row(a.in[0], a.out, YSL, mod, a.in[29], gate, (const int*)(ws + OFF_EPOS), (const LAS int*)ub, tok, lane, rp ? (float*)(ws + OFF_WG) : nullptr); } }
    if (PROBE_TK >= 0) { if (PROBE_TK == 11) tstamp_sel = __builtin_amdgcn_s_memrealtime() - tstamp_prev;
        if (bid == 0) { const unsigned long long t0_ = __builtin_amdgcn_s_memrealtime(); while (__builtin_amdgcn_s_memrealtime() - t0_ < 4ull * tstamp_sel) __builtin_amdgcn_s_sleep(8); } }
#undef IN
#undef SEAM
}

#ifndef MEGA_SINGLE
#define MEGA_SINGLE 1
#endif
extern "C" void kernel_launch(void* const* d_in, const int* in_sizes, int n_in, void* d_out, int out_size, void* d_ws, size_t ws_size, hipStream_t stream) {
    static int grid = 0;
    if (grid == 0) {
        if (ws_size < WS_NEED || n_in != 30) { fprintf(stderr, "kernel_launch: workspace too small (%zu < %zu) or n_in %d != 30\n", ws_size, (size_t)WS_NEED, n_in); grid = -1; return; }
        int dev = 0, cus = 0, per_cu = 0;
        if (hipGetDevice(&dev) != hipSuccess || hipDeviceGetAttribute(&cus, hipDeviceAttributeMultiprocessorCount, dev) != hipSuccess) { grid = -1; return; }
        if (hipFuncSetAttribute((const void*)mega, hipFuncAttributeMaxDynamicSharedMemorySize, LDS_BYTES) != hipSuccess) { fprintf(stderr, "kernel_launch: hipFuncSetAttribute failed\n"); grid = -1; return; }
        if (hipOccupancyMaxActiveBlocksPerMultiprocessor(&per_cu, (const void*)mega, NTHR, LDS_BYTES) != hipSuccess || per_cu < 1) { fprintf(stderr, "kernel_launch: occupancy query says %d blocks per CU\n", per_cu); per_cu = 1; }
        (void)hipGetLastError();
        grid = cus;
    }
    if (grid < 0) return;
    (void)hipMemsetAsync((char*)d_ws + OFF_CTL, 0, 64 * 1024, stream);
    MArgs a{};
    for (int i = 0; i < 30; ++i) a.in[i] = (const float*)d_in[i];
    a.out = (float*)d_out; a.ws = (unsigned char*)d_ws;
#if MEGA_SINGLE
    a.ph_lo = 0; a.ph_hi = NPH;
    { void* args[] = {&a}; hipError_t e = hipLaunchCooperativeKernel((const void*)mega, dim3(grid), dim3(NTHR), args, LDS_BYTES, stream);
      if (e != hipSuccess) fprintf(stderr, "kernel_launch: cooperative launch failed: %s (grid %d)\n", hipGetErrorString(e), grid); }
#else
    for (int p = 0; p < NPH; ++p) { a.ph_lo = p; a.ph_hi = p + 1; hipLaunchKernelGGL(mega, dim3(grid), dim3(NTHR), LDS_BYTES, stream, a); }
#endif
}
```

```cpp
#include <hip/hip_runtime.h>
#include <stdint.h>
#include <stdio.h>

typedef unsigned short bf16_t;
#define DEVI __device__ __forceinline__
#define LAS __attribute__((address_space(3)))
#ifndef MOE_FP8
#define MOE_FP8 1
#endif
DEVI unsigned pk4_fp8(float a, float b, float c, float d) { int w = 0; w = __builtin_amdgcn_cvt_pk_fp8_f32(a, b, w, false); w = __builtin_amdgcn_cvt_pk_fp8_f32(c, d, w, true); return (unsigned)w; }

constexpr int NB = 8, SEQ = 4096, DM = 1024, CTX = 256;
constexpr int NTOK = NB * SEQ;
constexpr int NCTX = NB * CTX;
constexpr int NROWS = NTOK + NCTX;
constexpr int INC = 2080, INP = 2304;
constexpr int NEXP = 32, TOPK = 4, DFF = 1024;
constexpr int LISTCAP = NTOK;
constexpr int MOEPAD = 256;

constexpr size_t MiB = 1024ull * 1024ull;
constexpr size_t OFF_CTL = 0;
constexpr size_t OFF_MOD = 64 * 1024;
constexpr size_t OFF_S5P = OFF_MOD + 256 * 1024;
constexpr size_t OFF_GATE = OFF_S5P + 1 * MiB;
constexpr size_t OFF_EPOS = OFF_GATE + 512 * 1024;
constexpr size_t OFF_LIST = OFF_EPOS + 512 * 1024;
constexpr size_t OFF_WIN = OFF_LIST + 4 * MiB;
constexpr size_t OFF_WGLU = OFF_WIN + (size_t)INP * DM * 2;
constexpr size_t OFF_WOUT = OFF_WGLU + 512 * 512 * 2;
constexpr size_t OFF_WG = OFF_WOUT + (size_t)DM * DM * 2;
constexpr size_t OFF_WD = OFF_WG + (size_t)NEXP * 2048 * DM * 2;
constexpr size_t OFF_S5BF = OFF_WD + (size_t)NEXP * DM * DFF * 2;
constexpr size_t OFF_S5BY = OFF_S5BF + (size_t)32 * 256 * 256 * 2;
constexpr size_t OFF_H = OFF_S5BY + (size_t)32 * 256 * 512 * 2;
constexpr size_t OFF_RA = OFF_H + (size_t)NROWS * DM * 2;
constexpr size_t OFF_QK = OFF_RA;
constexpr size_t OFF_V = OFF_QK + (size_t)NROWS * 512 * 2;
constexpr size_t OFF_R = OFF_V + (size_t)NROWS * 512 * 2;
constexpr size_t OFF_UT = OFF_R + (size_t)NROWS * 512 * 2;
constexpr size_t OFF_LR = OFF_UT + (size_t)NROWS * 512 * 2;
constexpr size_t OFF_U2 = OFF_LR + (size_t)NROWS * 32 * 4;
constexpr size_t OFF_YS = OFF_U2 + (size_t)32 * 2304 * 512 * 2;
constexpr size_t OFF_MIX = OFF_YS + (size_t)NTOK * 512 * 2;
constexpr size_t OFF_F = OFF_MIX + (size_t)NTOK * DM * 2;
constexpr size_t OFF_UCH = OFF_F + (size_t)32 * 2304 * 256 * 4;
constexpr size_t OFF_ADEC = OFF_UCH + (size_t)64 * 68 * 8192 * 2;
constexpr size_t OFF_SST = OFF_ADEC + (size_t)64 * 68 * 64 * 4;
constexpr size_t OFF_GLT = OFF_SST + (size_t)64 * 64 * 8192 * 2;
constexpr size_t OFF_RA_END = OFF_GLT + (size_t)2048 * 4 * 4096 * 2;
constexpr int ACT_ROWS = NTOK * TOPK + NEXP * MOEPAD;
constexpr size_t OFF_ACT = OFF_RA;
constexpr size_t OFF_YSL = OFF_ACT + (size_t)ACT_ROWS * DFF * 2;
constexpr size_t OFF_END2 = OFF_YSL + (size_t)ACT_ROWS * DM * 2;
constexpr size_t WS_NEED = OFF_RA_END > OFF_END2 ? OFF_RA_END : OFF_END2;
static_assert(WS_NEED <= 1024 * MiB, "workspace map exceeds 1 GiB");

constexpr int CW_CNT = 1024;
constexpr int CW_OFFS = 1088;
constexpr int CW_WQ = 1200;
constexpr int CW_MODC = 1216;
constexpr int CW_GAQ = 1240;

DEVI float bf2f(bf16_t b) { return __uint_as_float(((unsigned)b) << 16); }
DEVI bf16_t f2bf(float f) { unsigned u = __float_as_uint(f); u += 0x7fffu + ((u >> 16) & 1u); return (bf16_t)(u >> 16); }
typedef float pk_f2v __attribute__((ext_vector_type(2))); typedef __bf16 pk_bf2v __attribute__((ext_vector_type(2)));
DEVI unsigned pk2(float lo, float hi) { const pk_f2v f = {lo, hi}; const pk_bf2v b = __builtin_convertvector(f, pk_bf2v); return __builtin_bit_cast(unsigned, b); }
DEVI float wave_sum(float v) {
#pragma unroll
    for (int o = 1; o < 64; o <<= 1) v += __shfl_xor(v, o);
    return v;
}
DEVI float sigmoidf_(float x) { return __builtin_amdgcn_rcpf(1.f + __expf(-x)); }
DEVI float siluf_(float x) { return x * __builtin_amdgcn_rcpf(1.f + __expf(-x)); }
DEVI float logsigmoidf_(float g) { return fminf(g, 0.f) - __logf(1.f + __expf(-fabsf(g))); }
DEVI float gelu_tanh(float x) { const float u = 0.7978845608028654f * (x + 0.044715f * x * x * x); return x * __builtin_amdgcn_rcpf(1.f + __expf(-2.f * u)); }

__global__ __launch_bounds__(256) void k_mod(const float* __restrict__ c, const float* __restrict__ c_ctx, const float* __restrict__ ada_w,
                                             const float* __restrict__ ada_b, float* __restrict__ mod) {
    __shared__ float s[9][1024];
    for (int i = threadIdx.x; i < 9 * 1024; i += 256) { const int r = i >> 10, k = i & 1023; const float v = r < 8 ? c[r * 1024 + k] : c_ctx[k]; s[r][k] = siluf_(v); }
    __syncthreads();
    const int j = blockIdx.x * 256 + threadIdx.x;
    float acc[9];
#pragma unroll
    for (int r = 0; r < 9; ++r) acc[r] = 0.f;
    for (int k = 0; k < 1024; ++k) { const float w = ada_w[(size_t)k * 6144 + j];
#pragma unroll
        for (int r = 0; r < 9; ++r) acc[r] += s[r][k] * w; }
    const float bb = ada_b[j];
#pragma unroll
    for (int r = 0; r < 9; ++r) mod[r * 6144 + j] = acc[r] + bb;
}

template <int MODE> DEVI int wsrc_col(int nd) { if (MODE == 1) { return ((nd >> 7) & 1) * 1024 + (nd >> 8) * 128 + (nd & 127); } return nd; }
template <int MODE> __global__ __launch_bounds__(256) void k_wconv(const float* __restrict__ src, bf16_t* __restrict__ dst, int K, int N, int Nd) {
    __shared__ float t[64][65];
    const int e = blockIdx.z; src += (size_t)e * K * N; dst += (size_t)e * Nd * K;
    const int n0 = blockIdx.x * 64, k0 = blockIdx.y * 64, tid = threadIdx.x, nl = tid & 63, kq = tid >> 6;
    const int nd = n0 + nl, sc = wsrc_col<MODE>(nd); const bool valid = sc < N;
#pragma unroll 4
    for (int i = 0; i < 16; ++i) { const int kk = kq + 4 * i; t[kk][nl] = valid ? src[(size_t)(k0 + kk) * N + sc] : 0.f; }
    __syncthreads();
#pragma unroll
    for (int i = 0; i < 2; ++i) { const int ch = tid + 256 * i, n = ch >> 3, c8 = ch & 7;
        uint4 o; o.x = pk2(t[c8 * 8 + 0][n], t[c8 * 8 + 1][n]); o.y = pk2(t[c8 * 8 + 2][n], t[c8 * 8 + 3][n]); o.z = pk2(t[c8 * 8 + 4][n], t[c8 * 8 + 5][n]); o.w = pk2(t[c8 * 8 + 6][n], t[c8 * 8 + 7][n]);
        *(uint4*)(dst + (size_t)(n0 + n) * K + k0 + c8 * 8) = o; }
}

struct S5P { float lamb[2][32][64][2]; float bbar[2][32][64][16][2]; float lam16[2][32][64][2]; };
DEVI void s5prep_one(const float* lam_re, const float* lam_im, const float* log_dt, const float* b_re, const float* b_im, S5P* P, int i) {
    const int p = i & 63, g = (i >> 6) & 31, d = i >> 11;
    const double dt = exp((double)log_dt[d * 32 + g]);
    const double lr = lam_re[i], li = lam_im[i];
    const double mag = exp(lr * dt), ar = mag * cos(li * dt), ai = mag * sin(li * dt);
    const double nr = ar - 1.0, ni = ai, den = lr * lr + li * li;
    const double cr = (nr * lr + ni * li) / den, ci = (ni * lr - nr * li) / den;
    P->lamb[d][g][p][0] = (float)ar; P->lamb[d][g][p][1] = (float)ai;
    for (int h = 0; h < 16; ++h) { const double br = b_re[(size_t)i * 16 + h], bi = b_im[(size_t)i * 16 + h];
        P->bbar[d][g][p][h][0] = (float)(cr * br - ci * bi); P->bbar[d][g][p][h][1] = (float)(cr * bi + ci * br); }
}
__global__ void k_s5prep(const float* lam_re, const float* lam_im, const float* log_dt, const float* b_re, const float* b_im, S5P* P) {
    const int i = blockIdx.x * blockDim.x + threadIdx.x; if (i >= 2 * 32 * 64) return;
    s5prep_one(lam_re, lam_im, log_dt, b_re, b_im, P, i);
}

DEVI void norm_row(const float* __restrict__ x, const float* __restrict__ ctx, const float* __restrict__ w, const float* __restrict__ mod,
                                              bf16_t* __restrict__ H, int row, int lane, int sh_off, int sc_off) {
    const float* src; int b;
    if (row < NTOK) { src = x + (size_t)row * DM; b = row / SEQ; } else { src = ctx + (size_t)(row - NTOK) * DM; b = 8; }
    float4 v[4]; float ss = 0.f;
#pragma unroll
    for (int j = 0; j < 4; ++j) { v[j] = *(const float4*)(src + lane * 4 + 256 * j); ss += v[j].x * v[j].x + v[j].y * v[j].y + v[j].z * v[j].z + v[j].w * v[j].w; }
    const float rstd = rsqrtf(wave_sum(ss) * (1.f / DM) + 1e-6f);
    const float* msh = mod + b * 6144 + sh_off; const float* msc = mod + b * 6144 + sc_off;
#pragma unroll
    for (int j = 0; j < 4; ++j) { const int k = lane * 4 + 256 * j;
        const float4 ww = *(const float4*)(w + k), sc = *(const float4*)(msc + k), sh = *(const float4*)(msh + k);
        uint2 o; o.x = pk2(v[j].x * rstd * ww.x * (1.f + sc.x) + sh.x, v[j].y * rstd * ww.y * (1.f + sc.y) + sh.y);
        o.y = pk2(v[j].z * rstd * ww.z * (1.f + sc.z) + sh.z, v[j].w * rstd * ww.w * (1.f + sc.w) + sh.w);
        *(uint2*)(H + (size_t)row * DM + k) = o; }
}
__global__ __launch_bounds__(256) void k_norm(const float* __restrict__ x, const float* __restrict__ ctx, const float* __restrict__ w, const float* __restrict__ mod,
                                              bf16_t* __restrict__ H, int nrows, int sh_off, int sc_off) {
    const int row = blockIdx.x * 4 + (threadIdx.x >> 6), lane = threadIdx.x & 63; if (row >= nrows) return;
    norm_row(x, ctx, w, mod, H, row, lane, sh_off, sc_off);
}

DEVI void dense_unit(int L, int nM, int nN, int& pm, int& pn) {
    const int nwg = nM * nN; int wgid = L; { const int q = nwg / 8, r = nwg % 8, xcd = wgid % 8, off = wgid / 8; wgid = (xcd < r ? xcd * (q + 1) : r * (q + 1) + (xcd - r) * q) + off; }
    const int nig = 8 * nN, gid = wgid / nig, fm = gid * 8, gsz = (nM - fm) < 8 ? (nM - fm) : 8;
    pm = fm + ((wgid % nig) % gsz); pn = (wgid % nig) / gsz;
}
template <class Prob> __global__ __launch_bounds__(256) void k_gemm_naive(Prob P) {
    __shared__ float As[32][68], Bs[32][68];
    const int z = blockIdx.z, M = P.M(z), r0 = blockIdx.y * 64, c0 = blockIdx.x * 64; if (r0 >= M) return;
    const int tid = threadIdx.x, tx = tid & 7, ty = tid >> 3, K = P.K;
    const int lr = tid >> 2, lk = (tid & 3) * 8;
    const bool arow_ok = (r0 + lr) < M;
    const bf16_t* ap = P.A + (size_t)(arow_ok ? P.arow(z, r0 + lr) : 0) * P.lda + lk;
    const bf16_t* bp = P.Bt(z) + (size_t)(c0 + lr) * P.ldb + lk;
    float acc[2][8];
#pragma unroll
    for (int i = 0; i < 2; ++i)
#pragma unroll
        for (int j = 0; j < 8; ++j) acc[i][j] = 0.f;
    for (int k0 = 0; k0 < K; k0 += 32) {
        uint4 av = arow_ok ? *(const uint4*)(ap + k0) : make_uint4(0, 0, 0, 0); const uint4 bv = *(const uint4*)(bp + k0);
        const unsigned aw[4] = {av.x, av.y, av.z, av.w}, bw[4] = {bv.x, bv.y, bv.z, bv.w};
        __syncthreads();
#pragma unroll
        for (int j = 0; j < 4; ++j) { As[lk + 2 * j][lr] = __uint_as_float(aw[j] << 16); As[lk + 2 * j + 1][lr] = __uint_as_float(aw[j] & 0xffff0000u);
            Bs[lk + 2 * j][lr] = __uint_as_float(bw[j] << 16); Bs[lk + 2 * j + 1][lr] = __uint_as_float(bw[j] & 0xffff0000u); }
        __syncthreads();
#pragma unroll 8
        for (int k = 0; k < 32; ++k) { const float a0 = As[k][ty * 2], a1 = As[k][ty * 2 + 1];
            const float4 b0 = *(const float4*)&Bs[k][tx * 8], b1 = *(const float4*)&Bs[k][tx * 8 + 4];
            const float bb[8] = {b0.x, b0.y, b0.z, b0.w, b1.x, b1.y, b1.z, b1.w};
#pragma unroll
            for (int j = 0; j < 8; ++j) { acc[0][j] += a0 * bb[j]; acc[1][j] += a1 * bb[j]; } }
    }
#pragma unroll
    for (int i = 0; i < 2; ++i) { const int r = r0 + ty * 2 + i; if (r < M) P.store(z, r, c0 + tx * 8, acc[i]); }
}

struct ProbIn {
    static constexpr bool HOIST = false, PAIR = false, FP8 = false, SW16 = false, LBIAS = false, GATHK = false;
    const bf16_t* A; int lda; const bf16_t* B; int ldb; int K; bf16_t *QK, *V, *R, *UT, *U2; float* LR;
    DEVI int M(int) const { return NROWS; }
    DEVI int arow(int, int r) const { return r; }
    DEVI int nunits() const { return (NROWS / 256) * (INP / 256); }
    DEVI void unit(int L, int& z, int& pm, int& pn) const { z = 0; dense_unit(L, NROWS / 256, INP / 256, pm, pn); }
    DEVI int tokrow(int r) const { if (r >= NTOK) return r; const int b = r >> 12, sq = r & 4095; return b * 4096 + (sq & 63) * 64 + (sq >> 6); }
    DEVI unsigned aoffb(int, int r) const { return (unsigned)tokrow(r) * (unsigned)(lda * 2); }
    DEVI const bf16_t* Bt(int) const { return B; }
    DEVI void store(int, int rg, int c0, const float (&v)[8]) const {
        if (c0 >= INC) return;
        const int r = tokrow(rg);
        uint4 o; o.x = pk2(v[0], v[1]); o.y = pk2(v[2], v[3]); o.z = pk2(v[4], v[5]); o.w = pk2(v[6], v[7]);
        if (c0 < 512) { *(uint4*)(QK + (size_t)r * 512 + c0) = o; }
        else if (c0 < 1024) { *(uint4*)(V + (size_t)r * 512 + (c0 - 512)) = o; }
        else if (c0 < 1536) { *(uint4*)(R + (size_t)r * 512 + (c0 - 1024)) = o; }
        else if (c0 < 1568) { float* p = LR + (size_t)r * 32 + (c0 - 1536); *(float4*)p = make_float4(v[0], v[1], v[2], v[3]); *(float4*)(p + 4) = make_float4(v[4], v[5], v[6], v[7]); }
        else { const int j = c0 - 1568;
            const int g = j >> 4, ch = j & 15; int urow, ucol;
            if (r < NTOK) { const int b = rg >> 12, s = rg & 4095; urow = b * 256 + (s >> 4); ucol = (s & 15) * 16 + ch; }
            else { const int q = r - NTOK, b = q >> 8, t = q & 255; urow = 2048 + b * 16 + (t >> 4); ucol = (t & 15) * 16 + ch; }
            *(uint4*)(U2 + ((size_t)g * 2304 + urow) * 512 + ucol) = o; }
    }
};
constexpr unsigned YSG_ZS = (unsigned)NB * SEQ * 32u;
DEVI int scan2tok(int r) { const int b = r >> 12, sq = r & 4095; return b * 4096 + (sq & 63) * 64 + (sq >> 6); }
struct ProbGlu {
    static constexpr bool HOIST = true, PAIR = false, FP8 = false, ROW2 = true, SW16 = false, LBIAS = false, GATHK = true;
    const bf16_t* A; int lda; const bf16_t* B; int ldb; int K; const float* bias; bf16_t* MIX;
    struct ColCtx { float b[8]; }; struct RowCtx { uint4 y[2]; bf16_t* p; };
    DEVI int M(int) const { return NTOK; }
    DEVI int arow(int, int r) const { return r; }
    DEVI int nunits() const { return (NTOK / 256) * 2; }
    DEVI void unit(int L, int& z, int& pm, int& pn) const { z = 0; dense_unit(L, NTOK / 256, 2, pm, pn); }
    DEVI unsigned aoffb(int, int r) const { return (unsigned)r * 32u; }
    DEVI unsigned acoff(int cs) const { return (unsigned)(cs >> 4) * YSG_ZS + (unsigned)(cs & 15) * 2u; }
    DEVI size_t kstepA() const { return (size_t)4 * YSG_ZS; }
    DEVI const bf16_t* Bt(int) const { return B; }
    DEVI ColCtx colctx(int, int c0) const { ColCtx c; const float4 a = *(const float4*)(bias + c0), b2 = *(const float4*)(bias + c0 + 4);
        c.b[0] = a.x; c.b[1] = a.y; c.b[2] = a.z; c.b[3] = a.w; c.b[4] = b2.x; c.b[5] = b2.y; c.b[6] = b2.z; c.b[7] = b2.w; return c; }
    int cbq;
    DEVI RowCtx rowctx2z(int, int r, int cb0) const { RowCtx x; const char* yp = (const char*)A + (size_t)r * 32 + (size_t)(cb0 >> 4) * YSG_ZS + (cb0 & 15) * 2;
        x.y[0] = *(const uint4*)yp; x.y[1] = *(const uint4*)(yp + (size_t)8 * YSG_ZS); x.p = MIX + (size_t)scan2tok(r) * DM + 512; return x; }
    DEVI void storeh(const ColCtx& c, const RowCtx& x, int c0, const float (&v)[8]) const {
        const uint4 yv = x.y[(c0 >> 7) & 1]; const unsigned yw[4] = {yv.x, yv.y, yv.z, yv.w}; float o[8];
#pragma unroll
        for (int j = 0; j < 4; ++j) { const float y0 = __uint_as_float(yw[j] << 16), y1 = __uint_as_float(yw[j] & 0xffff0000u);
            o[2 * j] = y0 * __builtin_amdgcn_rcpf(1.f + __expf(-(v[2 * j] + c.b[2 * j]))); o[2 * j + 1] = y1 * __builtin_amdgcn_rcpf(1.f + __expf(-(v[2 * j + 1] + c.b[2 * j + 1]))); }
        uint4 w; w.x = pk2(o[0], o[1]); w.y = pk2(o[2], o[3]); w.z = pk2(o[4], o[5]); w.w = pk2(o[6], o[7]);
        *(uint4*)(x.p + c0) = w; }
    DEVI void store(int, int, int, const float (&)[8]) const {}
};
struct ProbOut {
    static constexpr bool HOIST = false, PAIR = false, FP8 = false, SW16 = false, LBIAS = false, GATHK = false;
    const bf16_t* A; int lda; const bf16_t* B; int ldb; int K; const float* x; const float* mod; float* X1;
    DEVI int M(int) const { return NTOK; }
    DEVI int arow(int, int r) const { return r; }
    DEVI int nunits() const { return (NTOK / 256) * 4; }
    DEVI void unit(int L, int& z, int& pm, int& pn) const { z = 0; dense_unit(L, NTOK / 256, 4, pm, pn); }
    DEVI unsigned aoffb(int, int r) const { return (unsigned)r * (unsigned)(lda * 2); }
    DEVI const bf16_t* Bt(int) const { return B; }
    DEVI void store(int, int r, int c0, const float (&v)[8]) const {
        uint4 o; o.x = pk2(v[0], v[1]); o.y = pk2(v[2], v[3]); o.z = pk2(v[4], v[5]); o.w = pk2(v[6], v[7]);
        *(uint4*)((bf16_t*)(X1 + (size_t)r * DM) + DM + c0) = o;
    }
};
struct ProbMoe1 {
    const bf16_t* A; int lda; const bf16_t* B; int ldb; int K; const int* cnt; const int* offs; const int* list; const float* b_gu; bf16_t* ACT;
    DEVI int M(int z) const { return cnt[z]; }
    DEVI int arow(int z, int r) const { return list[z * LISTCAP + r] >> 2; }
    DEVI const bf16_t* Bt(int z) const { return B + (size_t)z * 2048 * DM; }
    DEVI void store(int, int, int, const float (&)[8]) const {}
};
struct ProbMoe2 {
    const bf16_t* A; int lda; const bf16_t* B; int ldb; int K; const int* cnt; const int* offs; const int* list; const float* b_down; const float* gate; bf16_t* YSL;
    DEVI int M(int z) const { return cnt[z]; }
    DEVI int arow(int z, int r) const { return offs[z] + r; }
    DEVI const bf16_t* Bt(int z) const { return B + (size_t)z * DM * DFF; }
    DEVI void store(int z, int r, int c0, const float (&v)[8]) const {
        const int ent = list[z * LISTCAP + r]; const float gt = gate[ent]; const float* bd = b_down + (size_t)z * DM + c0;
        uint4 o; o.x = pk2((v[0] + bd[0]) * gt, (v[1] + bd[1]) * gt); o.y = pk2((v[2] + bd[2]) * gt, (v[3] + bd[3]) * gt);
        o.z = pk2((v[4] + bd[4]) * gt, (v[5] + bd[5]) * gt); o.w = pk2((v[6] + bd[6]) * gt, (v[7] + bd[7]) * gt);
        *(uint4*)(YSL + (size_t)ent * DM + c0) = o;
    }
};

DEVI void gla_naive_body(const bf16_t* __restrict__ QK, const bf16_t* __restrict__ V, const float* __restrict__ LR, const float* __restrict__ lr_up,
                                                   const float* __restrict__ lr_bias, float* __restrict__ OF, float* __restrict__ OB, LAS float* sm, int item) {
    LAS float* sq = sm; LAS float* sk = sm + 64; LAS float* sa = sm + 128; LAS float* sv = sm + 192; LAS float* red = sm + 320;
    const int dir = item & 1, hh = (item >> 1) & 3, b = item >> 3, tid = threadIdx.x, e = tid & 127, dg = tid >> 7;
    float up[16]; float bias = 0.f;
    if (tid < 64) { for (int r = 0; r < 16; ++r) up[r] = lr_up[dir * 4096 + r * 256 + hh * 64 + tid]; bias = lr_bias[dir * 256 + hh * 64 + tid]; }
    float S[16];
#pragma unroll
    for (int i = 0; i < 16; ++i) S[i] = 0.f;
    float* O = dir ? OB : OF;
    for (int step = 0; step < CTX + SEQ; ++step) {
        int row;
        if (step < CTX) row = NTOK + b * CTX + (dir ? CTX - 1 - step : step);
        else { const int t = step - CTX; row = b * SEQ + (dir ? SEQ - 1 - t : t); }
        if (tid < 64) { const float* lp = LR + (size_t)row * 32 + dir * 16; float g = bias;
#pragma unroll
            for (int r = 0; r < 16; ++r) g += lp[r] * up[r];
            sa[tid] = __expf(logsigmoidf_(g) * (1.f / 16.f));
            sq[tid] = bf2f(QK[(size_t)row * 512 + hh * 64 + tid]) * 0.125f; sk[tid] = bf2f(QK[(size_t)row * 512 + 256 + hh * 64 + tid]); }
        else if (tid < 192) sv[tid - 64] = bf2f(V[(size_t)row * 512 + hh * 128 + (tid - 64)]);
        __syncthreads();
        const float v = sv[e]; float part = 0.f;
#pragma unroll
        for (int i = 0; i < 16; ++i) { const int d = dg * 16 + i; S[i] = sa[d] * S[i] + sk[d] * v; part += sq[d] * S[i]; }
        if (step >= CTX) red[dg * 128 + e] = part;
        __syncthreads();
        if (step >= CTX && dg == 0) O[(size_t)row * 512 + hh * 128 + e] = (red[e] + red[128 + e]) + (red[256 + e] + red[384 + e]);
    }
}
__global__ __launch_bounds__(512) void k_gla_naive(const bf16_t* __restrict__ QK, const bf16_t* __restrict__ V, const float* __restrict__ LR, const float* __restrict__ lr_up,
                                                   const float* __restrict__ lr_bias, float* __restrict__ OF, float* __restrict__ OB) {
    __shared__ float sm[832];
    gla_naive_body(QK, V, LR, lr_up, lr_bias, OF, OB, (LAS float*)sm, blockIdx.x);
}
DEVI void gla_post_row(const float* __restrict__ OF, const float* __restrict__ OB, const bf16_t* __restrict__ R, const float* __restrict__ nw, bf16_t* __restrict__ MIX, int tok, int lane) {
    const int c0 = lane * 8;
    float o[8]; float ss = 0.f;
#pragma unroll
    for (int j = 0; j < 8; ++j) { o[j] = OF[(size_t)tok * 512 + c0 + j] + OB[(size_t)tok * 512 + c0 + j]; ss += o[j] * o[j]; }
    ss += __shfl_xor(ss, 1); ss += __shfl_xor(ss, 2); ss += __shfl_xor(ss, 4); ss += __shfl_xor(ss, 8);
    const float rstd = rsqrtf(ss * (1.f / 128.f) + 1e-6f);
    float w[8];
#pragma unroll
    for (int j = 0; j < 8; ++j) { const float r = bf2f(R[(size_t)tok * 512 + c0 + j]); w[j] = o[j] * rstd * nw[(c0 + j) & 127] * siluf_(r); }
    uint4 q; q.x = pk2(w[0], w[1]); q.y = pk2(w[2], w[3]); q.z = pk2(w[4], w[5]); q.w = pk2(w[6], w[7]);
    *(uint4*)(MIX + (size_t)tok * DM + c0) = q;
}
__global__ __launch_bounds__(256) void k_gla_post(const float* __restrict__ OF, const float* __restrict__ OB, const bf16_t* __restrict__ R, const float* __restrict__ nw, bf16_t* __restrict__ MIX) {
    gla_post_row(OF, OB, R, nw, MIX, blockIdx.x * 4 + (threadIdx.x >> 6), threadIdx.x & 63);
}

DEVI void s5_naive_body(const bf16_t* __restrict__ UT, const S5P* __restrict__ P, const float* __restrict__ c_re, const float* __restrict__ c_im,
                                                  float* __restrict__ YF, float* __restrict__ YB, LAS float* hsw  , int id, int lane) {
    const int g = id & 31, dir = (id >> 5) & 1, b = id >> 6;
    const float lr = P->lamb[dir][g][lane][0], li = P->lamb[dir][g][lane][1];
    float br[16], bi[16];
#pragma unroll
    for (int h = 0; h < 16; ++h) { br[h] = P->bbar[dir][g][lane][h][0]; bi[h] = P->bbar[dir][g][lane][h][1]; }
    const int ch = lane & 15, part = lane >> 4;
    float cr[16], ci[16];
#pragma unroll
    for (int i = 0; i < 16; ++i) { const size_t ix = (((size_t)dir * 32 + g) * 16 + ch) * 64 + part * 16 + i; cr[i] = c_re[ix]; ci[i] = c_im[ix]; }
    float hr = 0.f, hi = 0.f; float* Y = dir ? YB : YF;
    for (int step = 0; step < CTX + SEQ; ++step) {
        int row;
        if (step < CTX) row = NTOK + b * CTX + (dir ? CTX - 1 - step : step);
        else { const int t = step - CTX, s = dir ? SEQ - 1 - t : t; row = b * SEQ + (s & 63) * 64 + (s >> 6); }
        const uint4 u0 = *(const uint4*)(UT + (size_t)row * 512 + g * 16), u1 = *(const uint4*)(UT + (size_t)row * 512 + g * 16 + 8);
        const unsigned uw[8] = {u0.x, u0.y, u0.z, u0.w, u1.x, u1.y, u1.z, u1.w};
        float bur = 0.f, bui = 0.f;
#pragma unroll
        for (int j = 0; j < 8; ++j) { const float ua = __uint_as_float(uw[j] << 16), ub = __uint_as_float(uw[j] & 0xffff0000u);
            bur += br[2 * j] * ua + br[2 * j + 1] * ub; bui += bi[2 * j] * ua + bi[2 * j + 1] * ub; }
        const float nr = lr * hr - li * hi + bur, ni = lr * hi + li * hr + bui; hr = nr; hi = ni;
        if (step >= CTX) {
            hsw[lane] = hr; hsw[64 + lane] = hi;
            asm volatile("s_waitcnt lgkmcnt(0)" ::: "memory");
            float acc = 0.f;
#pragma unroll
            for (int i = 0; i < 16; ++i) acc += cr[i] * hsw[part * 16 + i] - ci[i] * hsw[64 + part * 16 + i];
            acc += __shfl_xor(acc, 16); acc += __shfl_xor(acc, 32);
            asm volatile("s_waitcnt lgkmcnt(0)" ::: "memory");
            if (lane < 16) Y[(size_t)row * 512 + g * 16 + lane] = acc;
        }
    }
}
__global__ __launch_bounds__(256) void k_s5_naive(const bf16_t* __restrict__ UT, const S5P* __restrict__ P, const float* __restrict__ c_re, const float* __restrict__ c_im,
                                                  float* __restrict__ YF, float* __restrict__ YB) {
    __shared__ float hs[4][128];
    const int w = threadIdx.x >> 6;
    s5_naive_body(UT, P, c_re, c_im, YF, YB, (LAS float*)hs[w], blockIdx.x * 4 + w, threadIdx.x & 63);
}
__global__ __launch_bounds__(256) void k_s5_post(const float* __restrict__ YF, const float* __restrict__ YB, const bf16_t* __restrict__ UT, const float* __restrict__ dvec, bf16_t* __restrict__ YS) {
    const size_t i = (size_t)blockIdx.x * 256 + threadIdx.x; const int j = (int)(i & 511);
    const float y = YF[i] + YB[i] + dvec[j] * bf2f(UT[i]);
    YS[i] = f2bf(gelu_tanh(y));
}

DEVI void router_row(const float* __restrict__ X1, const float* __restrict__ w, const float* __restrict__ mod, const float* __restrict__ rw, const float* __restrict__ rb,
                                                bf16_t* __restrict__ H2, int* __restrict__ cnt, int* __restrict__ list, float* __restrict__ gate, LAS float* hrw  , int tok, int lane) {
    const int b = tok / SEQ;
    const float* src = X1 + (size_t)tok * DM;
    float4 v[4]; float ss = 0.f;
#pragma unroll
    for (int j = 0; j < 4; ++j) { v[j] = *(const float4*)(src + lane * 4 + 256 * j); ss += v[j].x * v[j].x + v[j].y * v[j].y + v[j].z * v[j].z + v[j].w * v[j].w; }
    const float rstd = rsqrtf(wave_sum(ss) * (1.f / DM) + 1e-6f);
    const float* msh = mod + b * 6144 + 3072; const float* msc = mod + b * 6144 + 4096;
#pragma unroll
    for (int j = 0; j < 4; ++j) { const int k = lane * 4 + 256 * j;
        const float4 ww = *(const float4*)(w + k), sc = *(const float4*)(msc + k), sh = *(const float4*)(msh + k);
        float4 h; h.x = v[j].x * rstd * ww.x * (1.f + sc.x) + sh.x; h.y = v[j].y * rstd * ww.y * (1.f + sc.y) + sh.y; h.z = v[j].z * rstd * ww.z * (1.f + sc.z) + sh.z; h.w = v[j].w * rstd * ww.w * (1.f + sc.w) + sh.w;
        hrw[k] = h.x; hrw[k + 1] = h.y; hrw[k + 2] = h.z; hrw[k + 3] = h.w;
        uint2 o; o.x = pk2(h.x, h.y); o.y = pk2(h.z, h.w); *(uint2*)(H2 + (size_t)tok * DM + k) = o; }
    asm volatile("s_waitcnt lgkmcnt(0)" ::: "memory");
    const int e = lane & 31, half = lane >> 5; float lg = 0.f;
    for (int k = half * 512; k < half * 512 + 512; ++k) lg += hrw[k] * rw[k * 32 + e];
    lg += __shfl_xor(lg, 32); lg += rb[e];
    float val = lg; float tv[4]; int ti[4];
#pragma unroll
    for (int t = 0; t < 4; ++t) { float bv = val; int bi = e;
#pragma unroll
        for (int o = 1; o < 32; o <<= 1) { const float ov = __shfl_xor(bv, o); const int oi = __shfl_xor(bi, o); if (ov > bv || (ov == bv && oi < bi)) { bv = ov; bi = oi; } }
        tv[t] = bv; ti[t] = bi; if (e == bi) val = -3.0e38f; }
    const float e1 = __expf(tv[1] - tv[0]), e2 = __expf(tv[2] - tv[0]), e3 = __expf(tv[3] - tv[0]), inv = 1.f / (1.f + e1 + e2 + e3);
    if (lane < 4) { const float gv = lane == 0 ? inv : lane == 1 ? e1 * inv : lane == 2 ? e2 * inv : e3 * inv; const int ex = lane == 0 ? ti[0] : lane == 1 ? ti[1] : lane == 2 ? ti[2] : ti[3];
        const int slot = atomicAdd(&cnt[ex], 1); list[ex * LISTCAP + slot] = tok * 4 + lane; gate[tok * 4 + lane] = gv; }
}
__global__ __launch_bounds__(256) void k_router(const float* __restrict__ X1, const float* __restrict__ w, const float* __restrict__ mod, const float* __restrict__ rw, const float* __restrict__ rb,
                                                bf16_t* __restrict__ H2, int* __restrict__ cnt, int* __restrict__ list, float* __restrict__ gate) {
    __shared__ float hrow[4][1024];
    const int wv = threadIdx.x >> 6;
    router_row(X1, w, mod, rw, rb, H2, cnt, list, gate, (LAS float*)hrow[wv], blockIdx.x * 4 + wv, threadIdx.x & 63);
}
__global__ void k_offsets(const int* cnt, int* offs) { if (threadIdx.x == 0) { int o = 0; for (int e = 0; e < NEXP; ++e) { offs[e] = o; o += (cnt[e] + MOEPAD - 1) / MOEPAD * MOEPAD; } offs[NEXP] = o; } }

DEVI void final_row(const float* __restrict__ X, float* __restrict__ X1, const bf16_t* __restrict__ Y2, const float* __restrict__ mod, const float* __restrict__ fw, const float* __restrict__ gate, const int* __restrict__ epos,
                    const LAS int* ub, int tok, int lane, float* __restrict__ OUT = nullptr) {
    const int b = tok / SEQ;
    float* row = X1 + (size_t)tok * DM; float* orow = OUT ? OUT + (size_t)tok * DM : row; const float* g2 = mod + b * 6144 + 5120; const float* g1p = mod + b * 6144 + 2048;
    const float* xrow = X + (size_t)tok * DM; const bf16_t* mrow = (const bf16_t*)row + DM;
    const int4 ep = *(const int4*)(epos + tok * 4); const float4 gt = *(const float4*)(gate + tok * 4);
    constexpr int YB = MOE_FP8 ? 1 : 2;
    const char* y0 = (const char*)Y2 + (size_t)(ub[ep.x / LISTCAP] * 256 + ep.x % LISTCAP) * DM * YB; const char* y1 = (const char*)Y2 + (size_t)(ub[ep.y / LISTCAP] * 256 + ep.y % LISTCAP) * DM * YB;
    const char* y2 = (const char*)Y2 + (size_t)(ub[ep.z / LISTCAP] * 256 + ep.z % LISTCAP) * DM * YB; const char* y3 = (const char*)Y2 + (size_t)(ub[ep.w / LISTCAP] * 256 + ep.w % LISTCAP) * DM * YB;
    float4 v[4]; float ss = 0.f;
#pragma unroll
    for (int j = 0; j < 4; ++j) { const int k = lane * 4 + 256 * j; v[j] = *(const float4*)(xrow + k);
        { const uint2 mm = *(const uint2*)(mrow + k); const float4 g1 = *(const float4*)(g1p + k);
          v[j].x += g1.x * __uint_as_float(mm.x << 16); v[j].y += g1.y * __uint_as_float(mm.x & 0xffff0000u); v[j].z += g1.z * __uint_as_float(mm.y << 16); v[j].w += g1.w * __uint_as_float(mm.y & 0xffff0000u); }
        float f[4];
        if (MOE_FP8) { const int q0 = *(const int*)(y0 + k), q1 = *(const int*)(y1 + k), q2 = *(const int*)(y2 + k), q3 = *(const int*)(y3 + k);
            f[0] = gt.x * __builtin_amdgcn_cvt_f32_fp8(q0, 0) + gt.y * __builtin_amdgcn_cvt_f32_fp8(q1, 0) + gt.z * __builtin_amdgcn_cvt_f32_fp8(q2, 0) + gt.w * __builtin_amdgcn_cvt_f32_fp8(q3, 0);
            f[1] = gt.x * __builtin_amdgcn_cvt_f32_fp8(q0, 1) + gt.y * __builtin_amdgcn_cvt_f32_fp8(q1, 1) + gt.z * __builtin_amdgcn_cvt_f32_fp8(q2, 1) + gt.w * __builtin_amdgcn_cvt_f32_fp8(q3, 1);
            f[2] = gt.x * __builtin_amdgcn_cvt_f32_fp8(q0, 2) + gt.y * __builtin_amdgcn_cvt_f32_fp8(q1, 2) + gt.z * __builtin_amdgcn_cvt_f32_fp8(q2, 2) + gt.w * __builtin_amdgcn_cvt_f32_fp8(q3, 2);
            f[3] = gt.x * __builtin_amdgcn_cvt_f32_fp8(q0, 3) + gt.y * __builtin_amdgcn_cvt_f32_fp8(q1, 3) + gt.z * __builtin_amdgcn_cvt_f32_fp8(q2, 3) + gt.w * __builtin_amdgcn_cvt_f32_fp8(q3, 3);
        } else {
        const uint2 a0 = *(const uint2*)(y0 + 2 * k), a1 = *(const uint2*)(y1 + 2 * k), a2 = *(const uint2*)(y2 + 2 * k), a3 = *(const uint2*)(y3 + 2 * k);
        f[0] = gt.x * __uint_as_float(a0.x << 16) + gt.y * __uint_as_float(a1.x << 16) + gt.z * __uint_as_float(a2.x << 16) + gt.w * __uint_as_float(a3.x << 16);
        f[1] = gt.x * __uint_as_float(a0.x & 0xffff0000u) + gt.y * __uint_as_float(a1.x & 0xffff0000u) + gt.z * __uint_as_float(a2.x & 0xffff0000u) + gt.w * __uint_as_float(a3.x & 0xffff0000u);
        f[2] = gt.x * __uint_as_float(a0.y << 16) + gt.y * __uint_as_float(a1.y << 16) + gt.z * __uint_as_float(a2.y << 16) + gt.w * __uint_as_float(a3.y << 16);
        f[3] = gt.x * __uint_as_float(a0.y & 0xffff0000u) + gt.y * __uint_as_float(a1.y & 0xffff0000u) + gt.z * __uint_as_float(a2.y & 0xffff0000u) + gt.w * __uint_as_float(a3.y & 0xffff0000u); }
        const float4 gg = *(const float4*)(g2 + k);
        v[j].x += gg.x * f[0]; v[j].y += gg.y * f[1]; v[j].z += gg.z * f[2]; v[j].w += gg.w * f[3];
        ss += v[j].x * v[j].x + v[j].y * v[j].y + v[j].z * v[j].z + v[j].w * v[j].w; }
    const float rstd = rsqrtf(wave_sum(ss) * (1.f / DM) + 1e-6f);
#pragma unroll
    for (int j = 0; j < 4; ++j) { const int k = lane * 4 + 256 * j; const float4 ww = *(const float4*)(fw + k);
        *(float4*)(orow + k) = make_float4(v[j].x * rstd * ww.x, v[j].y * rstd * ww.y, v[j].z * rstd * ww.z, v[j].w * rstd * ww.w); }
}

typedef short bf16x8 __attribute__((ext_vector_type(8)));
typedef float f32x4 __attribute__((ext_vector_type(4)));
typedef unsigned u32x4 __attribute__((ext_vector_type(4)));
typedef unsigned u32x2 __attribute__((ext_vector_type(2)));
typedef int i32x4 __attribute__((ext_vector_type(4)));
typedef int i32x8 __attribute__((ext_vector_type(8)));

constexpr int NWAVES = 8, NTHR = 512;
constexpr int BM = 256, BK = 64, HALF = 128, HTB = HALF * BK * 2, STAGE_BYTES = 8 * HTB;
constexpr int MISC_OFF = 147456, MISC_BYTES = 1024, LDS_BYTES = MISC_OFF + MISC_BYTES;
constexpr int CW_BAR = 4096;

#define XB_TMO      128
#define XB_XCNT(j)  (256  + 64 * (j))
#define XB_XSUB(j)  (1280 + 64 * (j))
#define XB_XGEN(j)  (2304 + 64 * (j))
#define XB_TOP      3328
#define XB_TOPGEN   3392
#define XCD_BAR_WORDS 3456
#define XB_SPIN_CAP (1u << 18)
DEVI unsigned xb_ld(unsigned* p)              { return __hip_atomic_load(p, __ATOMIC_RELAXED, __HIP_MEMORY_SCOPE_AGENT); }
DEVI unsigned xb_add(unsigned* p, unsigned v) { return __hip_atomic_fetch_add(p, v, __ATOMIC_RELAXED, __HIP_MEMORY_SCOPE_AGENT); }
DEVI unsigned xb_xcc_id() { return (unsigned)__builtin_amdgcn_s_getreg((3 << 11) | 20) & 0xFu; }
#define XB_SPIN(cond, bar) do { unsigned _sp = 0; while (cond) { __builtin_amdgcn_s_sleep(1); \
    if ((++_sp & 255u) == 0u) { if (xb_ld(&(bar)[XB_TMO])) break; if (_sp > XB_SPIN_CAP) { atomicAdd(&(bar)[XB_TMO], 1u); break; } } } } while (0)
struct XcdBarrier { unsigned* bar; unsigned x; volatile LAS unsigned* st; };
DEVI XcdBarrier xcd_barrier_post(unsigned* bar, volatile LAS unsigned* st) {
    XcdBarrier b; b.bar = bar; b.x = xb_xcc_id(); b.st = st;
    if (threadIdx.x == 0) (void)xb_add(&bar[XB_XCNT(b.x)], 1u);
    return b;
}
DEVI void xcd_barrier_complete(unsigned* bar, unsigned x, unsigned& nloc, unsigned& nx) {
    const unsigned G = gridDim.x * gridDim.y * gridDim.z;
    unsigned sum, cnt, mine, sp = 0u;
    for (;;) {
        sum = 0u; cnt = 0u; mine = 0u;
#pragma unroll
        for (unsigned j = 0; j < 16; ++j) { const unsigned c = xb_ld(&bar[XB_XCNT(j)]); sum += c; cnt += (c > 0u) ? 1u : 0u; mine = (j == x) ? c : mine; }
        if (sum == G) break;
        __builtin_amdgcn_s_sleep(1);
        if ((++sp & 255u) == 0u) { if (xb_ld(&bar[XB_TMO])) break; if (sp > XB_SPIN_CAP) { atomicAdd(&bar[XB_TMO], 1u); break; } }
    }
    nloc = mine > 0u ? mine : 1u; nx = cnt > 0u ? cnt : 1u;
}
DEVI void xcd_barrier(const XcdBarrier& b) {
    asm volatile("s_waitcnt vmcnt(0)" ::: "memory");
    __syncthreads();
    if (threadIdx.x == 0) {
        unsigned* bar = b.bar;
        __builtin_amdgcn_s_waitcnt(0);
        unsigned nloc = b.st[0], nx = b.st[1];
        if (nloc == 0u) { xcd_barrier_complete(bar, b.x, nloc, nx); b.st[0] = nloc; b.st[1] = nx; }
        const unsigned old = xb_add(&bar[XB_XSUB(b.x)], 1u);
        const unsigned gen = old / nloc;
        if (old + 1u == (gen + 1u) * nloc) {
            __builtin_amdgcn_fence(__ATOMIC_RELEASE, "agent");
            asm volatile("s_waitcnt vmcnt(0)" ::: "memory");
            const unsigned og = xb_add(&bar[XB_TOP], 1u);
            const unsigned tg = og / nx;
            if (og + 1u == (tg + 1u) * nx) xb_add(&bar[XB_TOPGEN], 1u);
            else XB_SPIN(xb_ld(&bar[XB_TOPGEN]) == tg, bar);
            __builtin_amdgcn_fence(__ATOMIC_ACQUIRE, "agent");
            xb_add(&bar[XB_XGEN(b.x)], 1u);
            asm volatile("s_waitcnt vmcnt(0)" ::: "memory");
        } else {
            XB_SPIN(xb_ld(&bar[XB_XGEN(b.x)]) == gen, bar);
            __builtin_amdgcn_fence(__ATOMIC_ACQUIRE, "agent");
            asm volatile("s_waitcnt vmcnt(0)" ::: "memory");
        }
    }
    __syncthreads();
}

DEVI int lds_byte(int r, int c) { const int st = (r >> 4) * 2 + (c >> 5), rr = r & 15, cc = c & 31, ob = rr * 64 + cc * 2; return st * 1024 + (ob ^ (((ob >> 9) & 1) << 5)); }
DEVI void stage_rc(int b, int& R, int& C) { const int st = b / 1024, sb = b % 1024, swz = sb ^ (((sb >> 9) & 1) << 5); R = (st >> 1) * 16 + swz / 64; C = (st & 1) * 32 + (swz % 64) / 2; }
DEVI int perm32(int rho) { const int n = rho >> 4, i = rho & 15; return 8 * (i >> 2) + 4 * n + (i & 3); }
template <int VMODE = 0, class Prob>
DEVI void gemm_phase(LAS unsigned char* lds, const Prob& P, int G, int c) {
    int tid = threadIdx.x; asm volatile("" : "+v"(tid));
    const int wid = __builtin_amdgcn_readfirstlane(tid >> 6), lane = tid & 63, wr = wid >> 2, wc = wid & 3, fr = lane & 15, fq = lane >> 4;
    const int K = P.K, nt = K / BK;
    const int nun = P.nunits();
    int L = c; if (L >= nun) return;
    int Rs0, Cs0, Rs1, Cs1; stage_rc(tid * 16, Rs0, Cs0); stage_rc(tid * 16 + 8192, Rs1, Cs1);
    unsigned voffB[2];
    voffB[0] = (unsigned)(((Rs0 & ~31) + perm32(Rs0 & 31)) * K + Cs0) * 2u; voffB[1] = (unsigned)(((Rs1 & ~31) + perm32(Rs1 & 31)) * K + Cs1) * 2u;
    const size_t kstep = (size_t)(BK * 2), hstepB = (size_t)HALF * K * 2, tstepB = 2 * hstepB;
    size_t kstepA = kstep; unsigned cA0 = (unsigned)Cs0 * 2u;
    if constexpr (Prob::GATHK) { kstepA = P.kstepA(); cA0 = P.acoff(Cs0); }
    const unsigned cA1 = cA0;
    const unsigned ldsw = (unsigned)wid * 1024u;
    const int aoff = lds_byte(wr * 64 + fr, fq * 8), boff = lds_byte(wc * 32 + fr, fq * 8);
#define G_SA(b, h) (((b) * 2 + (h)) * HTB)
#define G_SB(b, h) ((4 + (b) * 2 + (h)) * HTB)
#define G_STAGE_B(bufoff, gbase) do { _Pragma("unroll") for (int _i = 0; _i < 2; ++_i) \
        __builtin_amdgcn_global_load_lds((const unsigned*)((const char*)(gbase) + voffB[_i]), (LAS unsigned*)(lds + (bufoff) + ldsw + _i * 8192), 16, 0, 0); } while (0)
#define G_STAGE_A(bufoff, gbase, v0, v1) do { \
        __builtin_amdgcn_global_load_lds((const unsigned*)((const char*)(gbase) + (v0)), (LAS unsigned*)(lds + (bufoff) + ldsw), 16, 0, 0); \
        __builtin_amdgcn_global_load_lds((const unsigned*)((const char*)(gbase) + (v1)), (LAS unsigned*)(lds + (bufoff) + ldsw + 8192), 16, 0, 0); } while (0)
#define G_LDA(dst, b, h) do { _Pragma("unroll") for (int m = 0; m < 4; ++m) _Pragma("unroll") for (int k = 0; k < 2; ++k) dst[m][k] = *(const LAS bf16x8*)(lds + G_SA(b, h) + aoff + m * 2048 + k * 1024); } while (0)
#define G_LDB(dst, b, h) do { _Pragma("unroll") for (int n = 0; n < 2; ++n) _Pragma("unroll") for (int k = 0; k < 2; ++k) dst[n][k] = *(const LAS bf16x8*)(lds + G_SB(b, h) + boff + n * 2048 + k * 1024); } while (0)
#define G_MMA(ai, bj, At, Bt) do { __builtin_amdgcn_s_setprio(1); _Pragma("unroll") for (int m = 0; m < 4; ++m) _Pragma("unroll") for (int n = 0; n < 2; ++n) { \
        if constexpr (Prob::FP8) { const i32x8 b8 = __builtin_shufflevector(__builtin_bit_cast(i32x4, Bt[n][0]), __builtin_bit_cast(i32x4, Bt[n][1]), 0, 1, 2, 3, 4, 5, 6, 7); \
            const i32x8 a8 = __builtin_shufflevector(__builtin_bit_cast(i32x4, At[m][0]), __builtin_bit_cast(i32x4, At[m][1]), 0, 1, 2, 3, 4, 5, 6, 7); \
            acc[ai][bj][m][n] = __builtin_amdgcn_mfma_scale_f32_16x16x128_f8f6f4(b8, a8, acc[ai][bj][m][n], 0, 0, 0, 0x7a7a7a7a, 0, 0x7f7f7f7f); } \
        else { _Pragma("unroll") for (int k = 0; k < 2; ++k) acc[ai][bj][m][n] = __builtin_amdgcn_mfma_f32_16x16x32_bf16(Bt[n][k], At[m][k], acc[ai][bj][m][n], 0, 0, 0); } } \
        __builtin_amdgcn_s_setprio(0); } while (0)
#define G_WAIT_V(n) asm volatile("s_waitcnt vmcnt(" #n ")" ::: "memory")
#define G_WAIT_L(n) asm volatile("s_waitcnt lgkmcnt(" #n ")" ::: "memory")
#define G_BAR __builtin_amdgcn_s_barrier()
#define G_SCHED __builtin_amdgcn_sched_barrier(0)
    int z, pm, pn; P.unit(L, z, pm, pn);
    z = __builtin_amdgcn_readfirstlane(z); pm = __builtin_amdgcn_readfirstlane(pm); pn = __builtin_amdgcn_readfirstlane(pn);
    unsigned vA00 = P.aoffb(z, pm * BM + Rs0) + cA0, vA01 = P.aoffb(z, pm * BM + Rs1) + cA1;
    unsigned vA10 = P.aoffb(z, pm * BM + HALF + Rs0) + cA0, vA11 = P.aoffb(z, pm * BM + HALF + Rs1) + cA1;
    const char* const Ab = (const char*)P.A;
    const char* cB = (const char*)P.Bt(z) + (size_t)pn * tstepB;
    f32x4 acc[2][2][4][2];
    bf16x8 At[4][2], B0[2][2], B1[2][2];
    int par = 0;
    G_STAGE_B(G_SB(0, 0), cB); G_STAGE_A(G_SA(0, 0), Ab, vA00, vA01); G_STAGE_B(G_SB(0, 1), cB + hstepB); G_STAGE_A(G_SA(0, 1), Ab, vA10, vA11);
    if (wr == 1) G_BAR;
    G_WAIT_V(4); G_BAR;
    G_STAGE_B(G_SB(1, 0), cB + kstep); G_STAGE_A(G_SA(1, 0), Ab + kstepA, vA00, vA01); G_STAGE_B(G_SB(1, 1), cB + hstepB + kstep);
    G_WAIT_V(6); G_BAR;
    for (;;) {
        const int Ln = L + G; const bool has_next = Ln < nun;
        if constexpr (Prob::LBIAS) { if (wid == 0) __builtin_amdgcn_global_load_lds((const unsigned*)P.bias_src(z, pn, lane), (LAS unsigned*)(lds + STAGE_BYTES + par * 1024), 16, 0, 0); }
        const int Mz = (VMODE == 1 || VMODE == 2 || VMODE == 3) ? 0 : __builtin_amdgcn_readfirstlane(P.M(z));
        int nz = z, npm = pm, npn = pn; if (has_next) P.unit(Ln, nz, npm, npn);
        nz = __builtin_amdgcn_readfirstlane(nz); npm = __builtin_amdgcn_readfirstlane(npm); npn = __builtin_amdgcn_readfirstlane(npn);
        if constexpr (VMODE == 3) { nz = z; npm = pm; npn = pn; }
        const char* nB = has_next ? (const char*)P.Bt(nz) + (size_t)npn * tstepB : cB;
        unsigned n00 = vA00, n01 = vA01, n10 = vA10, n11 = vA11;
        if (has_next) { n00 = P.aoffb(nz, npm * BM + Rs0) + cA0; n01 = P.aoffb(nz, npm * BM + Rs1) + cA1;
            n10 = P.aoffb(nz, npm * BM + HALF + Rs0) + cA0; n11 = P.aoffb(nz, npm * BM + HALF + Rs1) + cA1; }
#pragma unroll
        for (int a = 0; a < 2; ++a)
#pragma unroll
            for (int b = 0; b < 2; ++b)
#pragma unroll
                for (int m = 0; m < 4; ++m)
#pragma unroll
                    for (int n = 0; n < 2; ++n) acc[a][b][m][n] = (f32x4){0.f, 0.f, 0.f, 0.f};
#pragma unroll 1
        for (int t = 0; t < nt; t += 2) {
            const bool last = (t == nt - 2);
            const char* a1 = Ab + (size_t)(t + 1) * kstepA;
            const char* a2 = last ? Ab : Ab + (size_t)(t + 2) * kstepA; const char* b2 = last ? nB : cB + (size_t)(t + 2) * kstep;
            const char* a3 = a2 + kstepA; const char* b3 = b2 + kstep;
            G_LDB(B0, 0, 0); G_SCHED; G_LDA(At, 0, 0); G_STAGE_A(G_SA(1, 1), a1, vA10, vA11);
            G_WAIT_L(8); G_BAR; G_WAIT_L(0); G_MMA(0, 0, At, B0); G_BAR; G_SCHED;
            if (last) { vA00 = n00; vA01 = n01; vA10 = n10; vA11 = n11; }
            G_LDB(B1, 0, 1); G_STAGE_B(G_SB(0, 0), b2);
            G_BAR; G_WAIT_L(0); G_MMA(0, 1, At, B1); G_BAR;
            G_LDA(At, 0, 1); G_STAGE_A(G_SA(0, 0), a2, vA00, vA01);
            G_BAR; G_WAIT_L(0); G_MMA(1, 0, At, B0); G_BAR; G_SCHED;
            G_STAGE_B(G_SB(0, 1), b2 + hstepB);
            G_WAIT_V(6); G_BAR; G_MMA(1, 1, At, B1); G_BAR;
            G_LDB(B0, 1, 0); G_SCHED; G_LDA(At, 1, 0); G_STAGE_A(G_SA(0, 1), a2, vA10, vA11);
            G_WAIT_L(8); G_BAR; G_WAIT_L(0); G_MMA(0, 0, At, B0); G_BAR; G_SCHED;
            G_LDB(B1, 1, 1); G_STAGE_B(G_SB(1, 0), b3);
            G_BAR; G_WAIT_L(0); G_MMA(0, 1, At, B1); G_BAR;
            G_LDA(At, 1, 1); G_STAGE_A(G_SA(1, 0), a3, vA00, vA01);
            G_BAR; G_WAIT_L(0); G_MMA(1, 0, At, B0); G_BAR; G_SCHED;
            G_STAGE_B(G_SB(1, 1), b3 + hstepB);
            G_WAIT_V(6); G_BAR; G_MMA(1, 1, At, B1); G_BAR;
        }
        if constexpr (VMODE == 1 || VMODE == 3) {
#pragma unroll
            for (int a_ = 0; a_ < 2; ++a_)
#pragma unroll
                for (int b_ = 0; b_ < 2; ++b_)
#pragma unroll
                    for (int m_ = 0; m_ < 4; ++m_)
#pragma unroll
                        for (int n_ = 0; n_ < 2; ++n_) asm volatile("" :: "v"(acc[a_][b_][m_][n_]));
        } else
        {
          if constexpr (VMODE == 2) {
#pragma unroll
            for (int a_ = 0; a_ < 2; ++a_)
#pragma unroll
                for (int b_ = 0; b_ < 2; ++b_)
#pragma unroll
                    for (int m_ = 0; m_ < 4; ++m_)
#pragma unroll
                        for (int n_ = 0; n_ < 2; ++n_) asm volatile("" :: "v"(acc[a_][b_][m_][n_])); }
          const int cb0 = pn * BM + wc * 32 + 8 * fq, rb0 = pm * BM + wr * 64 + fr;
          if constexpr (Prob::SW16) {
              const int odd = fq & 1, cbe = cb0 - 8 * odd;
              typename Prob::ColCtx cc[2]; const LAS float* bl = (const LAS float*)(lds + STAGE_BYTES + par * 1024) + wc * 32 + 8 * fq;
              if constexpr (Prob::LBIAS) { cc[0] = P.colctx_l(bl, cb0); if constexpr (!Prob::PAIR) cc[1] = P.colctx_l(bl + HALF, cb0 + HALF); }
              else { cc[0] = P.colctx(z, cb0); if constexpr (!Prob::PAIR) cc[1] = P.colctx(z, cb0 + HALF); }
#pragma unroll
              for (int ai = 0; ai < 2; ++ai)
#pragma unroll
                  for (int mp = 0; mp < 2; ++mp) { const int row = rb0 + ai * HALF + (2 * mp + odd) * 16; const typename Prob::RowCtx rx = P.rowctx(z, row, row < Mz);
#pragma unroll
                      for (int bj = 0; bj < (Prob::PAIR ? 1 : 2); ++bj) { uint2 p, q;
                          if constexpr (Prob::PAIR) { p = P.pack8(cc[0], acc[ai][0][2 * mp][0], acc[ai][0][2 * mp][1], acc[ai][1][2 * mp][0], acc[ai][1][2 * mp][1]);
                              q = P.pack8(cc[0], acc[ai][0][2 * mp + 1][0], acc[ai][0][2 * mp + 1][1], acc[ai][1][2 * mp + 1][0], acc[ai][1][2 * mp + 1][1]); }
                          else { p = P.pack8(cc[bj], acc[ai][bj][2 * mp][0], acc[ai][bj][2 * mp][1]); q = P.pack8(cc[bj], acc[ai][bj][2 * mp + 1][0], acc[ai][bj][2 * mp + 1][1]); }
                          const auto sx = __builtin_amdgcn_permlane16_swap(p.x, q.x, false, false); const auto sy = __builtin_amdgcn_permlane16_swap(p.y, q.y, false, false);
                          if (row < Mz) { uint4 o; o.x = sx[0]; o.y = sy[0]; o.z = sx[1]; o.w = sy[1]; P.store16(rx, cbe + bj * HALF, o); } } }
          } else if constexpr (Prob::PAIR) {
              const typename Prob::ColCtx cc = P.colctx(z, cb0);
              typename Prob::RowCtx rc[2][4];
#pragma unroll
              for (int ai = 0; ai < 2; ++ai)
#pragma unroll
                  for (int m = 0; m < 4; ++m) { const int row = rb0 + ai * HALF + m * 16; rc[ai][m] = P.rowctx(z, row, row < Mz); }
#pragma unroll
              for (int ai = 0; ai < 2; ++ai)
#pragma unroll
                  for (int m = 0; m < 4; ++m) { const int row = rb0 + ai * HALF + m * 16;
                      if (row < Mz) { const f32x4 g0 = acc[ai][0][m][0], g1 = acc[ai][0][m][1], l0 = acc[ai][1][m][0], l1 = acc[ai][1][m][1];
                          const float vg[8] = {g0[0], g0[1], g0[2], g0[3], g1[0], g1[1], g1[2], g1[3]}, vl[8] = {l0[0], l0[1], l0[2], l0[3], l1[0], l1[1], l1[2], l1[3]};
                          P.storepair(cc, rc[ai][m], vg, vl); } }
          } else if constexpr (Prob::HOIST) {
              typename Prob::ColCtx cc[2]; typename Prob::RowCtx rc[2][4];
#pragma unroll
              for (int bj = 0; bj < 2; ++bj) cc[bj] = P.colctx(z, cb0 + bj * HALF);
#pragma unroll
              for (int ai = 0; ai < 2; ++ai)
#pragma unroll
                  for (int m = 0; m < 4; ++m) { const int row = rb0 + ai * HALF + m * 16; if constexpr (Prob::ROW2) rc[ai][m] = P.rowctx2z(z, row, cb0); else rc[ai][m] = P.rowctx(z, row, row < Mz); }
#pragma unroll
              for (int ai = 0; ai < 2; ++ai)
#pragma unroll
                  for (int m = 0; m < 4; ++m) { const int row = rb0 + ai * HALF + m * 16;
                      if (row < Mz) {
#pragma unroll
                          for (int bj = 0; bj < 2; ++bj) { const f32x4 v0 = acc[ai][bj][m][0], v1 = acc[ai][bj][m][1];
                              const float v[8] = {v0[0], v0[1], v0[2], v0[3], v1[0], v1[1], v1[2], v1[3]};
                              P.storeh(cc[bj], rc[ai][m], cb0 + bj * HALF, v); } } }
          } else {
#pragma unroll
          for (int ai = 0; ai < 2; ++ai)
#pragma unroll
            for (int m = 0; m < 4; ++m) { const int row = rb0 + ai * HALF + m * 16;
                if (row < Mz) {
#pragma unroll
                    for (int bj = 0; bj < 2; ++bj) { const int c0 = cb0 + bj * HALF;
                        const f32x4 v0 = acc[ai][bj][m][0], v1 = acc[ai][bj][m][1];
                        const float v[8] = {v0[0], v0[1], v0[2], v0[3], v1[0], v1[1], v1[2], v1[3]};
                        P.store(z, row, c0, v); } }
                asm volatile("" ::: "memory"); } } }
        if (!has_next) break;
        z = nz; pm = npm; pn = npn; cB = nB; L = Ln; par ^= 1;
    }
    G_WAIT_V(0);
    if (wr == 0) G_BAR;
    G_BAR;
}

template <int NT, bool REV> DEVI void moe_unit(const LAS int* ub, int L, int G, int& z, int& pm, int& pn) {
    const int nun = __builtin_amdgcn_readfirstlane(ub[NEXP]) * NT;
    int Lq = L;
    if ((G & 7) == 0) { const int i = L / G, c = L - i * G, x = c & 7, j = c >> 3, per = G >> 3; Lq = (i * 8 + x) * per + j; }
    if (Lq >= nun) { z = -1; pm = 0; pn = 0; return; }
    if (REV) Lq = nun - 1 - Lq;
    const int tl = ub[(threadIdx.x & 31) + 1] * NT;
    const int e = __popcll(__ballot(Lq >= tl) & 0x7fffffffull);
    const int l = Lq - __builtin_amdgcn_readfirstlane(ub[e]) * NT; z = e; pm = l / NT; pn = l % NT;
}
struct FMoe1 {
    static constexpr bool HOIST = true, PAIR = true, RV = false, FP8 = MOE_FP8 != 0, SW16 = FP8, LBIAS = SW16, GATHK = false; static constexpr int NT = 8;
    const bf16_t* A; const bf16_t* B; int K; const int* cnt; const int* list; const float* b_gu; bf16_t* ACT; const LAS int* ub; int G;
    struct ColCtx { float bg[8], bl[8]; int f0; }; struct RowCtx { bf16_t* p; };
    DEVI int ubs(int e) const { return __builtin_amdgcn_readfirstlane(ub[e]); }
    DEVI int nunits() const { const int n = ubs(NEXP) * NT; return (G & 7) == 0 ? (n + G - 1) / G * G : n; }
    DEVI void unit(int L, int& z, int& pm, int& pn) const { moe_unit<NT, RV>(ub, L, G, z, pm, pn); }
    DEVI int M(int z) const { return z < 0 ? 0 : cnt[z]; }
    DEVI unsigned aoffb(int z, int r) const { const int t = (z >= 0 && r < cnt[z]) ? (list[z * LISTCAP + r] >> 2) : 0; return (unsigned)t * (unsigned)(FP8 ? DM : DM * 2); }
    DEVI const bf16_t* Bt(int z) const { return (const bf16_t*)((const char*)B + (size_t)(z < 0 ? 0 : z) * 2048 * DM * (FP8 ? 1 : 2)); }
    DEVI ColCtx colctx(int z, int c0) const { ColCtx c; c.f0 = (c0 >> 8) * 128 + (c0 & 127); const float* bp = b_gu + (size_t)(z < 0 ? 0 : z) * 2048 + c.f0;
        const float4 g0 = *(const float4*)bp, g1 = *(const float4*)(bp + 4), l0 = *(const float4*)(bp + 1024), l1 = *(const float4*)(bp + 1028);
        c.bg[0] = g0.x; c.bg[1] = g0.y; c.bg[2] = g0.z; c.bg[3] = g0.w; c.bg[4] = g1.x; c.bg[5] = g1.y; c.bg[6] = g1.z; c.bg[7] = g1.w;
        c.bl[0] = l0.x; c.bl[1] = l0.y; c.bl[2] = l0.z; c.bl[3] = l0.w; c.bl[4] = l1.x; c.bl[5] = l1.y; c.bl[6] = l1.z; c.bl[7] = l1.w; return c; }
    DEVI RowCtx rowctx(int z, int r, bool) const { RowCtx x; x.p = (bf16_t*)((char*)ACT + (size_t)(ubs(z < 0 ? 0 : z) * 256 + r) * DFF * (FP8 ? 1 : 2)); return x; }
    DEVI const float* bias_src(int z, int pn, int lane) const { return b_gu + (size_t)(z < 0 ? 0 : z) * 2048 + (lane >> 5) * 1024 + pn * 128 + (lane & 31) * 4; }
    DEVI ColCtx colctx_l(const LAS float* bl, int c0) const { ColCtx c; c.f0 = (c0 >> 8) * 128 + (c0 & 127); const f32x4 g0 = *(const LAS f32x4*)bl, g1 = *(const LAS f32x4*)(bl + 4), l0 = *(const LAS f32x4*)(bl + 128), l1 = *(const LAS f32x4*)(bl + 132);
        c.bg[0] = g0[0]; c.bg[1] = g0[1]; c.bg[2] = g0[2]; c.bg[3] = g0[3]; c.bg[4] = g1[0]; c.bg[5] = g1[1]; c.bg[6] = g1[2]; c.bg[7] = g1[3];
        c.bl[0] = l0[0]; c.bl[1] = l0[1]; c.bl[2] = l0[2]; c.bl[3] = l0[3]; c.bl[4] = l1[0]; c.bl[5] = l1[1]; c.bl[6] = l1[2]; c.bl[7] = l1[3]; return c; }
    DEVI void storepair(const ColCtx& c, const RowCtx& x, const float (&vg)[8], const float (&vl)[8]) const {
        typedef float f2 __attribute__((ext_vector_type(2))); unsigned w[4]; float af[8];
#pragma unroll
        for (int i = 0; i < 4; ++i) { f2 g = (f2){vg[2 * i], vg[2 * i + 1]} + (f2){c.bg[2 * i], c.bg[2 * i + 1]}, l = (f2){vl[2 * i], vl[2 * i + 1]} + (f2){c.bl[2 * i], c.bl[2 * i + 1]};
            g[0] = fminf(g[0], 7.f); g[1] = fminf(g[1], 7.f); l[0] = __builtin_amdgcn_fmed3f(l[0], -7.f, 7.f); l[1] = __builtin_amdgcn_fmed3f(l[1], -7.f, 7.f);
            const f2 t = g * (-1.702f * 1.44269504f); f2 e; e[0] = __builtin_amdgcn_exp2f(t[0]); e[1] = __builtin_amdgcn_exp2f(t[1]); e = e + 1.f;
            f2 r; r[0] = __builtin_amdgcn_rcpf(e[0]); r[1] = __builtin_amdgcn_rcpf(e[1]);
            const f2 a = (l + 1.f) * g * r; w[i] = pk2(a[0], a[1]); af[2 * i] = a[0]; af[2 * i + 1] = a[1]; }
        if constexpr (FP8) { uint2 o; o.x = pk4_fp8(af[0], af[1], af[2], af[3]); o.y = pk4_fp8(af[4], af[5], af[6], af[7]); *(uint2*)((char*)x.p + c.f0) = o; }
        else { uint4 o; o.x = w[0]; o.y = w[1]; o.z = w[2]; o.w = w[3]; *(uint4*)(x.p + c.f0) = o; } }
    DEVI uint2 pack8(const ColCtx& c, const f32x4 g0, const f32x4 g1, const f32x4 l0, const f32x4 l1) const {
        typedef float f2 __attribute__((ext_vector_type(2))); const float vg[8] = {g0[0], g0[1], g0[2], g0[3], g1[0], g1[1], g1[2], g1[3]}, vl[8] = {l0[0], l0[1], l0[2], l0[3], l1[0], l1[1], l1[2], l1[3]}; float af[8];
#pragma unroll
        for (int i = 0; i < 4; ++i) { f2 g = (f2){vg[2 * i], vg[2 * i + 1]} + (f2){c.bg[2 * i], c.bg[2 * i + 1]}, l = (f2){vl[2 * i], vl[2 * i + 1]} + (f2){c.bl[2 * i], c.bl[2 * i + 1]};
            g[0] = fminf(g[0], 7.f); g[1] = fminf(g[1], 7.f); l[0] = __builtin_amdgcn_fmed3f(l[0], -7.f, 7.f); l[1] = __builtin_amdgcn_fmed3f(l[1], -7.f, 7.f);
            const f2 t = g * (-1.702f * 1.44269504f); f2 e; e[0] = __builtin_amdgcn_exp2f(t[0]); e[1] = __builtin_amdgcn_exp2f(t[1]); e = e + 1.f;
            f2 r; r[0] = __builtin_amdgcn_rcpf(e[0]); r[1] = __builtin_amdgcn_rcpf(e[1]);
            const f2 a = (l + 1.f) * g * r; af[2 * i] = a[0]; af[2 * i + 1] = a[1]; }
        uint2 o; o.x = pk4_fp8(af[0], af[1], af[2], af[3]); o.y = pk4_fp8(af[4], af[5], af[6], af[7]); return o; }
    DEVI void store16(const RowCtx& x, int c0, const uint4& o) const { *(uint4*)((char*)x.p + (c0 >> 8) * 128 + (c0 & 127)) = o; }
    DEVI void storeh(const ColCtx&, const RowCtx&, int, const float (&)[8]) const {}
    DEVI void store(int, int, int, const float (&)[8]) const {}
};
struct FMoe2 {
    static constexpr bool HOIST = true, PAIR = false, RV = true, FP8 = MOE_FP8 != 0, ROW2 = false, SW16 = FP8, LBIAS = SW16, GATHK = false; static constexpr int NT = 4;
    const bf16_t* A; const bf16_t* B; int K; const int* cnt; const float* b_down; bf16_t* Y2; const LAS int* ub; int G;
    struct ColCtx { float bd[8]; }; struct RowCtx { bf16_t* p; };
    DEVI int ubs(int e) const { return __builtin_amdgcn_readfirstlane(ub[e]); }
    DEVI int nunits() const { const int n = ubs(NEXP) * NT; return (G & 7) == 0 ? (n + G - 1) / G * G : n; }
    DEVI void unit(int L, int& z, int& pm, int& pn) const { moe_unit<NT, RV>(ub, L, G, z, pm, pn); }
    DEVI int M(int z) const { return z < 0 ? 0 : cnt[z]; }
    DEVI unsigned aoffb(int z, int r) const { return (unsigned)(ubs(z < 0 ? 0 : z) * 256 + r) * (unsigned)(FP8 ? DFF : DFF * 2); }
    DEVI const bf16_t* Bt(int z) const { return (const bf16_t*)((const char*)B + (size_t)(z < 0 ? 0 : z) * DM * DFF * (FP8 ? 1 : 2)); }
    DEVI ColCtx colctx(int z, int c0) const { ColCtx c; const float* bp = b_down + (size_t)(z < 0 ? 0 : z) * DM + c0; const float4 a = *(const float4*)bp, b = *(const float4*)(bp + 4);
        c.bd[0] = a.x; c.bd[1] = a.y; c.bd[2] = a.z; c.bd[3] = a.w; c.bd[4] = b.x; c.bd[5] = b.y; c.bd[6] = b.z; c.bd[7] = b.w; return c; }
    DEVI RowCtx rowctx(int z, int r, bool) const { RowCtx x; x.p = (bf16_t*)((char*)Y2 + (size_t)(ubs(z < 0 ? 0 : z) * 256 + r) * DM * (FP8 ? 1 : 2)); return x; }
    DEVI const float* bias_src(int z, int pn, int lane) const { return b_down + (size_t)(z < 0 ? 0 : z) * DM + pn * 256 + lane * 4; }
    DEVI ColCtx colctx_l(const LAS float* bl, int) const { ColCtx c; const f32x4 a = *(const LAS f32x4*)bl, b = *(const LAS f32x4*)(bl + 4);
        c.bd[0] = a[0]; c.bd[1] = a[1]; c.bd[2] = a[2]; c.bd[3] = a[3]; c.bd[4] = b[0]; c.bd[5] = b[1]; c.bd[6] = b[2]; c.bd[7] = b[3]; return c; }
    DEVI void storeh(const ColCtx& c, const RowCtx& x, int c0, const float (&v)[8]) const {
        if constexpr (FP8) { uint2 o; o.x = pk4_fp8(v[0] + c.bd[0], v[1] + c.bd[1], v[2] + c.bd[2], v[3] + c.bd[3]); o.y = pk4_fp8(v[4] + c.bd[4], v[5] + c.bd[5], v[6] + c.bd[6], v[7] + c.bd[7]); *(uint2*)((char*)x.p + c0) = o; }
        else { uint4 o; o.x = pk2(v[0] + c.bd[0], v[1] + c.bd[1]); o.y = pk2(v[2] + c.bd[2], v[3] + c.bd[3]); o.z = pk2(v[4] + c.bd[4], v[5] + c.bd[5]); o.w = pk2(v[6] + c.bd[6], v[7] + c.bd[7]);
            *(uint4*)(x.p + c0) = o; } }
    DEVI uint2 pack8(const ColCtx& c, const f32x4 v0, const f32x4 v1) const { uint2 o; o.x = pk4_fp8(v0[0] + c.bd[0], v0[1] + c.bd[1], v0[2] + c.bd[2], v0[3] + c.bd[3]); o.y = pk4_fp8(v1[0] + c.bd[4], v1[1] + c.bd[5], v1[2] + c.bd[6], v1[3] + c.bd[7]); return o; }
    DEVI void store16(const RowCtx& x, int c0, const uint4& o) const { *(uint4*)((char*)x.p + c0) = o; }
    DEVI void store(int, int, int, const float (&)[8]) const {}
};

struct MArgs { const float* in[30]; float* out; unsigned char* ws; int ph_lo, ph_hi; };
struct MArgs_in { const float *lam_re, *lam_im, *log_dt, *b_re, *b_im, *c_re, *c_im; };

constexpr int GL_LRS = 0, GL_TOT = 8192, GL_QF = 12288, GL_KF = 21504, GL_QB = 30720, GL_KB = 39936, GL_VT = 49152, GL_PP = 67584, GL_SSQ = 76800, GL_UST = 67584;
constexpr int GL_LD = 72;

struct GlaPtrs { const bf16_t* QK; const bf16_t* V; const bf16_t* R; const float* LR; const float* lr_up; const float* lr_bias; const float* nw; bf16_t* UCH; float* ADEC; bf16_t* SST; bf16_t* MIX; bf16_t* GLT; };

DEVI void gla_gates(const GlaPtrs& G, LAS unsigned char* lds, int h, int d, int to, float (&cf)[8], float (&cb)[8]) {
    const LAS float* LRS = (const LAS float*)(lds + GL_LRS); LAS float* TOT = (LAS float*)(lds + GL_TOT);
#pragma unroll
    for (int dir = 0; dir < 2; ++dir) {
        float up[16];
#pragma unroll
        for (int r = 0; r < 16; ++r) up[r] = G.lr_up[dir * 4096 + r * 256 + h * 64 + d];
        const float bias = G.lr_bias[dir * 256 + h * 64 + d];
        float la[8];
#pragma unroll
        for (int j = 0; j < 8; ++j) { const LAS f32x4* lp = (const LAS f32x4*)(LRS + (to * 8 + j) * 32 + dir * 16); float g = bias;
#pragma unroll
            for (int q = 0; q < 4; ++q) { const f32x4 x = lp[q]; g += x[0] * up[4 * q] + x[1] * up[4 * q + 1] + x[2] * up[4 * q + 2] + x[3] * up[4 * q + 3]; }
            la[j] = logsigmoidf_(g) * (1.f / 16.f); }
        if (dir == 0) { cf[0] = la[0];
#pragma unroll
            for (int j = 1; j < 8; ++j) cf[j] = cf[j - 1] + la[j];
            TOT[(0 * 8 + to) * 64 + d] = cf[7]; }
        else { cb[7] = la[7];
#pragma unroll
            for (int j = 6; j >= 0; --j) cb[j] = cb[j + 1] + la[j];
            TOT[(1 * 8 + to) * 64 + d] = cb[0]; }
    }
}
DEVI void gla_stage(const GlaPtrs& G, LAS unsigned char* lds, int row0, int h, int tid) {
    *(LAS f32x4*)(lds + GL_LRS + tid * 16) = *(const f32x4*)(G.LR + (size_t)row0 * 32 + tid * 4);
    const int ep = tid & 63, to = tid >> 6; unsigned w[8];
#pragma unroll
    for (int j = 0; j < 8; ++j) w[j] = *(const unsigned*)(G.V + (size_t)(row0 + to * 8 + j) * 512 + h * 128 + 2 * ep);
    u32x4 lo, hi;
    lo.x = (w[0] & 0xffffu) | (w[1] << 16); lo.y = (w[2] & 0xffffu) | (w[3] << 16); lo.z = (w[4] & 0xffffu) | (w[5] << 16); lo.w = (w[6] & 0xffffu) | (w[7] << 16);
    hi.x = (w[0] >> 16) | (w[1] & 0xffff0000u); hi.y = (w[2] >> 16) | (w[3] & 0xffff0000u); hi.z = (w[4] >> 16) | (w[5] & 0xffff0000u); hi.w = (w[6] >> 16) | (w[7] & 0xffff0000u);
    *(LAS u32x4*)(lds + GL_VT + ((2 * ep) * GL_LD + to * 8) * 2) = lo;
    *(LAS u32x4*)(lds + GL_VT + ((2 * ep + 1) * GL_LD + to * 8) * 2) = hi;
}

DEVI void gla_a_item(const GlaPtrs& G, LAS unsigned char* lds, int item) {
    int tid = threadIdx.x; asm volatile("" : "+v"(tid));
    const int wave = __builtin_amdgcn_readfirstlane(tid >> 6), lane = tid & 63, d = lane, to = wave, fr = lane & 15, fq = lane >> 4;
    const int ch = item % 68, bh = item / 68, h = bh & 3, b = bh >> 2;
    const int row0 = ch < 4 ? NTOK + b * CTX + ch * 64 : b * SEQ + (ch - 4) * 64;
    gla_stage(G, lds, row0, h, tid);
    bf16_t kk[8];
#pragma unroll
    for (int j = 0; j < 8; ++j) kk[j] = G.QK[(size_t)(row0 + to * 8 + j) * 512 + 256 + h * 64 + d];
    __syncthreads();
    float cf[8], cb[8];
    gla_gates(G, lds, h, d, to, cf, cb);
    __syncthreads();
    const LAS float* TOT = (const LAS float*)(lds + GL_TOT);
    float offf = 0.f, offb = 0.f, totf = 0.f, totb = 0.f;
#pragma unroll
    for (int t = 0; t < 8; ++t) { const float a = TOT[(0 * 8 + t) * 64 + d], c = TOT[(1 * 8 + t) * 64 + d]; totf += a; totb += c; if (t < to) offf += a; if (t > to) offb += c; }
    float of[8], ob[8];
#pragma unroll
    for (int j = 0; j < 8; ++j) { const float kf = bf2f(kk[j]); of[j] = kf * __expf(totf - (cf[j] + offf)); ob[j] = kf * __expf(totb - (cb[j] + offb)); }
    { u32x4 w; w.x = pk2(of[0], of[1]); w.y = pk2(of[2], of[3]); w.z = pk2(of[4], of[5]); w.w = pk2(of[6], of[7]); *(LAS u32x4*)(lds + GL_QF + (d * GL_LD + to * 8) * 2) = w;
      w.x = pk2(ob[0], ob[1]); w.y = pk2(ob[2], ob[3]); w.z = pk2(ob[4], ob[5]); w.w = pk2(ob[6], ob[7]); *(LAS u32x4*)(lds + GL_KF + (d * GL_LD + to * 8) * 2) = w; }
    const int chain_f = bh * 2, step_f = ch < 4 ? ch : ch, step_b = ch < 4 ? 3 - ch : 4 + (67 - ch);
    if (to == 0) { G.ADEC[((size_t)chain_f * 68 + step_f) * 64 + d] = __expf(totf); G.ADEC[((size_t)(chain_f + 1) * 68 + step_b) * 64 + d] = __expf(totb); }
    __syncthreads();
    f32x4 acc[2][4];
#pragma unroll
    for (int dr = 0; dr < 2; ++dr)
#pragma unroll
        for (int dt = 0; dt < 4; ++dt) acc[dr][dt] = (f32x4){0.f, 0.f, 0.f, 0.f};
#pragma unroll
    for (int ks = 0; ks < 2; ++ks) { const bf16x8 a = *(const LAS bf16x8*)(lds + GL_VT + ((wave * 16 + fr) * GL_LD + ks * 32 + fq * 8) * 2);
#pragma unroll
        for (int dt = 0; dt < 4; ++dt) { const bf16x8 b0 = *(const LAS bf16x8*)(lds + GL_QF + ((dt * 16 + fr) * GL_LD + ks * 32 + fq * 8) * 2);
            const bf16x8 b1 = *(const LAS bf16x8*)(lds + GL_KF + ((dt * 16 + fr) * GL_LD + ks * 32 + fq * 8) * 2);
            acc[0][dt] = __builtin_amdgcn_mfma_f32_16x16x32_bf16(a, b0, acc[0][dt], 0, 0, 0); acc[1][dt] = __builtin_amdgcn_mfma_f32_16x16x32_bf16(a, b1, acc[1][dt], 0, 0, 0); } }
#pragma unroll
    for (int dr = 0; dr < 2; ++dr)
#pragma unroll
        for (int dt = 0; dt < 4; ++dt)
#pragma unroll
            for (int rg = 0; rg < 4; ++rg) *(LAS bf16_t*)(lds + GL_UST + ((dr * 128 + wave * 16 + 4 * fq + rg) * 64 + dt * 16 + fr) * 2) = f2bf(acc[dr][dt][rg]);
    __syncthreads();
#pragma unroll
    for (int i = 0; i < 4; ++i) { const int q = tid + i * NTHR, dr = q >> 10, off = (q & 1023) * 8;
        const u32x4 w = *(const LAS u32x4*)(lds + GL_UST + (dr * 8192 + off) * 2);
        const size_t chain = (size_t)chain_f + dr; const int step = dr ? step_b : step_f;
        *(u32x4*)(G.UCH + (chain * 68 + step) * 8192 + off) = w; }
    __syncthreads();
}

DEVI void gla_b_block(const GlaPtrs& G, LAS unsigned char* lds, int blk) {
    int tid = threadIdx.x; asm volatile("" : "+v"(tid));
    const int chain = blk >> 2, e = (blk & 3) * 32 + (tid >> 4), d4 = (tid & 15) * 4;
    for (int i = tid; i < 68 * 16; i += NTHR) ((LAS f32x4*)lds)[i] = ((const f32x4*)(G.ADEC + (size_t)chain * 68 * 64))[i];
    __syncthreads();
    const bf16_t* up = G.UCH + ((size_t)chain * 68 * 128 + e) * 64 + d4;
    bf16_t* sp = G.SST + ((size_t)chain * 64 * 128 + e) * 64 + d4;
    float S0 = 0.f, S1 = 0.f, S2 = 0.f, S3 = 0.f;
    uint2 cur[17], nxt[17];
#pragma unroll
    for (int j = 0; j < 17; ++j) cur[j] = *(const uint2*)(up + (size_t)j * 8192);
#pragma unroll 1
    for (int bt = 0; bt < 4; ++bt) {
        if (bt < 3) {
#pragma unroll
            for (int j = 0; j < 17; ++j) nxt[j] = *(const uint2*)(up + (size_t)((bt + 1) * 17 + j) * 8192); }
#pragma unroll
        for (int j = 0; j < 17; ++j) { const int step = bt * 17 + j;
            if (step >= 4) { uint2 o; o.x = pk2(S0, S1); o.y = pk2(S2, S3); *(uint2*)(sp + (size_t)(step - 4) * 8192) = o; }
            const f32x4 a = *(const LAS f32x4*)(lds + (step * 64 + d4) * 4);
            S0 = a[0] * S0 + __uint_as_float(cur[j].x << 16); S1 = a[1] * S1 + __uint_as_float(cur[j].x & 0xffff0000u);
            S2 = a[2] * S2 + __uint_as_float(cur[j].y << 16); S3 = a[3] * S3 + __uint_as_float(cur[j].y & 0xffff0000u); }
#pragma unroll
        for (int j = 0; j < 17; ++j) cur[j] = nxt[j];
    }
    __syncthreads();
}

DEVI void gla_c_item(const GlaPtrs& G, LAS unsigned char* lds, int item) {
    int tid = threadIdx.x; asm volatile("" : "+v"(tid));
    const int wave = __builtin_amdgcn_readfirstlane(tid >> 6), lane = tid & 63, d = lane, to = wave, fr = lane & 15, fq = lane >> 4;
    const int c = item & 63, bh = item >> 6, h = bh & 3, b = bh >> 2;
    const int row0 = b * SEQ + c * 64;
    gla_stage(G, lds, row0, h, tid);
    bf16_t qq[8], kk[8];
#pragma unroll
    for (int j = 0; j < 8; ++j) { const size_t o = (size_t)(row0 + to * 8 + j) * 512 + h * 64 + d; qq[j] = G.QK[o]; kk[j] = G.QK[o + 256]; }
    __syncthreads();
    float cf[8], cb[8];
    gla_gates(G, lds, h, d, to, cf, cb);
    __syncthreads();
    { const LAS float* TOT = (const LAS float*)(lds + GL_TOT);
      float offf = 0.f, offb = 0.f;
#pragma unroll
      for (int t = 0; t < 8; ++t) { if (t < to) offf += TOT[(0 * 8 + t) * 64 + d]; if (t > to) offb += TOT[(1 * 8 + t) * 64 + d]; }
#pragma unroll
      for (int j = 0; j < 8; ++j) { const float qf = bf2f(qq[j]) * 0.125f, kf = bf2f(kk[j]);
          const float ef = __expf(fmaxf(cf[j] + offf, -80.f)), eb = __expf(fmaxf(cb[j] + offb, -80.f));
          const int o = ((to * 8 + j) * GL_LD + d) * 2;
          *(LAS bf16_t*)(lds + GL_QF + o) = f2bf(qf * ef); *(LAS bf16_t*)(lds + GL_KF + o) = f2bf(kf * __builtin_amdgcn_rcpf(ef));
          *(LAS bf16_t*)(lds + GL_QB + o) = f2bf(qf * eb); *(LAS bf16_t*)(lds + GL_KB + o) = f2bf(kf * __builtin_amdgcn_rcpf(eb)); } }
    __syncthreads();
    { const int ti = wave >> 1;
#pragma unroll
      for (int u = 0; u < 2; ++u) { const int tj = (wave & 1) * 2 + u;
          f32x4 af = (f32x4){0.f, 0.f, 0.f, 0.f}, ab = (f32x4){0.f, 0.f, 0.f, 0.f};
          if (tj <= ti) {
#pragma unroll
              for (int ks = 0; ks < 2; ++ks) { const bf16x8 a = *(const LAS bf16x8*)(lds + GL_KF + ((tj * 16 + fr) * GL_LD + ks * 32 + fq * 8) * 2), bb = *(const LAS bf16x8*)(lds + GL_QF + ((ti * 16 + fr) * GL_LD + ks * 32 + fq * 8) * 2);
                  af = __builtin_amdgcn_mfma_f32_16x16x32_bf16(a, bb, af, 0, 0, 0); } }
          if (tj >= ti) {
#pragma unroll
              for (int ks = 0; ks < 2; ++ks) { const bf16x8 a = *(const LAS bf16x8*)(lds + GL_KB + ((tj * 16 + fr) * GL_LD + ks * 32 + fq * 8) * 2), bb = *(const LAS bf16x8*)(lds + GL_QB + ((ti * 16 + fr) * GL_LD + ks * 32 + fq * 8) * 2);
                  ab = __builtin_amdgcn_mfma_f32_16x16x32_bf16(a, bb, ab, 0, 0, 0); } }
          float p[4];
#pragma unroll
          for (int rg = 0; rg < 4; ++rg) { const int i = ti * 16 + fr, j = tj * 16 + 4 * fq + rg; p[rg] = (j <= i ? af[rg] : 0.f) + (j >= i ? ab[rg] : 0.f); }
          u32x2 w; w.x = pk2(p[0], p[1]); w.y = pk2(p[2], p[3]);
          *(LAS u32x2*)(lds + GL_PP + ((ti * 16 + fr) * GL_LD + tj * 16 + 4 * fq) * 2) = w; } }
    __syncthreads();
    const int tg = wave & 3, eh = wave >> 2;
    f32x4 acc[4];
#pragma unroll
    for (int et = 0; et < 4; ++et) acc[et] = (f32x4){0.f, 0.f, 0.f, 0.f};
    { const bf16_t* Sf = G.SST + ((size_t)(bh * 2) * 64 + c) * 8192; const bf16_t* Sb = G.SST + ((size_t)(bh * 2 + 1) * 64 + (63 - c)) * 8192;
#pragma unroll
      for (int ks = 0; ks < 2; ++ks) {
          const int bo = ((tg * 16 + fr) * GL_LD + ks * 32 + fq * 8) * 2;
          const bf16x8 bP = *(const LAS bf16x8*)(lds + GL_PP + bo), bF = *(const LAS bf16x8*)(lds + GL_QF + bo), bB = *(const LAS bf16x8*)(lds + GL_QB + bo);
#pragma unroll
          for (int et = 0; et < 4; ++et) { const int e = eh * 64 + et * 16 + fr;
              const bf16x8 aV = *(const LAS bf16x8*)(lds + GL_VT + (e * GL_LD + ks * 32 + fq * 8) * 2);
              const bf16x8 aF = *(const bf16x8*)(Sf + e * 64 + ks * 32 + fq * 8), aB = *(const bf16x8*)(Sb + e * 64 + ks * 32 + fq * 8);
              acc[et] = __builtin_amdgcn_mfma_f32_16x16x32_bf16(aV, bP, acc[et], 0, 0, 0);
              acc[et] = __builtin_amdgcn_mfma_f32_16x16x32_bf16(aF, bF, acc[et], 0, 0, 0);
              acc[et] = __builtin_amdgcn_mfma_f32_16x16x32_bf16(aB, bB, acc[et], 0, 0, 0); } } }
    float ss = 0.f;
#pragma unroll
    for (int et = 0; et < 4; ++et) ss += acc[et][0] * acc[et][0] + acc[et][1] * acc[et][1] + acc[et][2] * acc[et][2] + acc[et][3] * acc[et][3];
    ss += __shfl_xor(ss, 16); ss += __shfl_xor(ss, 32);
    LAS float* SSQ = (LAS float*)(lds + GL_SSQ);
    if (fq == 0) SSQ[eh * 64 + tg * 16 + fr] = ss;
    __syncthreads();
    const float rstd = rsqrtf((SSQ[tg * 16 + fr] + SSQ[64 + tg * 16 + fr]) * (1.f / 128.f) + 1e-6f);
    const int tok = row0 + tg * 16 + fr;
#pragma unroll
    for (int et = 0; et < 4; ++et) { const int e = eh * 64 + et * 16 + 4 * fq;
        const uint2 rv = *(const uint2*)(G.R + (size_t)tok * 512 + h * 128 + e); const f32x4 nw = *(const f32x4*)(G.nw + e);
        const float r0 = __uint_as_float(rv.x << 16), r1 = __uint_as_float(rv.x & 0xffff0000u), r2 = __uint_as_float(rv.y << 16), r3 = __uint_as_float(rv.y & 0xffff0000u);
        uint2 w; w.x = pk2(acc[et][0] * rstd * nw[0] * siluf_(r0), acc[et][1] * rstd * nw[1] * siluf_(r1)); w.y = pk2(acc[et][2] * rstd * nw[2] * siluf_(r2), acc[et][3] * rstd * nw[3] * siluf_(r3));
        *(uint2*)(G.MIX + (size_t)tok * DM + h * 128 + e) = w; }
    __syncthreads();
}

constexpr int GL_GT0 = 30720, GL_GT1 = 130560;
constexpr int GL_SF = 77312, GL_SB = 95744, GL_RQ = 114176, GL_RK = 122368;

struct GateW { float up[2][16]; float bias[2]; };
DEVI GateW gla_gatew(const GlaPtrs& G, int h, int d) { GateW w;
#pragma unroll
    for (int dir = 0; dir < 2; ++dir) {
#pragma unroll
        for (int r = 0; r < 16; ++r) w.up[dir][r] = G.lr_up[dir * 4096 + r * 256 + h * 64 + d];
        w.bias[dir] = G.lr_bias[dir * 256 + h * 64 + d]; }
    return w; }
DEVI void gla_gates2(const GateW& W, LAS unsigned char* lds, int d, int to, float (&cf)[8], float (&cb)[8]) {
    const LAS float* LRS = (const LAS float*)(lds + GL_LRS); LAS float* TOT = (LAS float*)(lds + GL_TOT);
#pragma unroll
    for (int dir = 0; dir < 2; ++dir) {
        float la[8];
#pragma unroll
        for (int j = 0; j < 8; ++j) { const LAS f32x4* lp = (const LAS f32x4*)(LRS + (to * 8 + j) * 32 + dir * 16);
            typedef float f2 __attribute__((ext_vector_type(2))); f2 g2 = (f2){W.bias[dir], 0.f};
#pragma unroll
            for (int q = 0; q < 4; ++q) { const f32x4 x = lp[q]; g2 += (f2){x[0], x[1]} * (f2){W.up[dir][4 * q], W.up[dir][4 * q + 1]}; g2 += (f2){x[2], x[3]} * (f2){W.up[dir][4 * q + 2], W.up[dir][4 * q + 3]}; }
            la[j] = logsigmoidf_(g2[0] + g2[1]) * (1.f / 16.f); }
        if (dir == 0) { cf[0] = la[0];
#pragma unroll
            for (int j = 1; j < 8; ++j) cf[j] = cf[j - 1] + la[j];
            TOT[(0 * 8 + to) * 64 + d] = cf[7]; }
        else { cb[7] = la[7];
#pragma unroll
            for (int j = 6; j >= 0; --j) cb[j] = cb[j + 1] + la[j];
            TOT[(1 * 8 + to) * 64 + d] = cb[0]; }
    }
}
struct GIn { f32x4 lr; unsigned vv[8]; u32x4 kraw; u32x4 qraw; u32x4 sraw[4]; u32x2 rr[4]; };
template <bool WQ> DEVI void gla_load_common(const GlaPtrs& G, int row0, int h, int tid, GIn& I) {
    I.lr = *(const f32x4*)(G.LR + (size_t)row0 * 32 + tid * 4);
    const int ep = tid & 63, to = tid >> 6;
#pragma unroll
    for (int j = 0; j < 8; ++j) I.vv[j] = *(const unsigned*)(G.V + (size_t)(row0 + to * 8 + j) * 512 + h * 128 + 2 * ep);
    const int tok = tid >> 3, chunk = tid & 7;
    I.kraw = *(const u32x4*)(G.QK + (size_t)(row0 + tok) * 512 + 256 + h * 64 + chunk * 8);
    if (WQ) I.qraw = *(const u32x4*)(G.QK + (size_t)(row0 + tok) * 512 + h * 64 + chunk * 8);
}
template <bool WQ> DEVI void gla_stage_common(LAS unsigned char* lds, int tid, const GIn& I) {
    *(LAS f32x4*)(lds + GL_LRS + tid * 16) = I.lr;
    const int ep = tid & 63, to = tid >> 6; const unsigned* w = I.vv;
    u32x4 lo, hi;
    lo.x = (w[0] & 0xffffu) | (w[1] << 16); lo.y = (w[2] & 0xffffu) | (w[3] << 16); lo.z = (w[4] & 0xffffu) | (w[5] << 16); lo.w = (w[6] & 0xffffu) | (w[7] << 16);
    hi.x = (w[0] >> 16) | (w[1] & 0xffff0000u); hi.y = (w[2] >> 16) | (w[3] & 0xffff0000u); hi.z = (w[4] >> 16) | (w[5] & 0xffff0000u); hi.w = (w[6] >> 16) | (w[7] & 0xffff0000u);
    *(LAS u32x4*)(lds + GL_VT + ((2 * ep) * GL_LD + to * 8) * 2) = lo;
    *(LAS u32x4*)(lds + GL_VT + ((2 * ep + 1) * GL_LD + to * 8) * 2) = hi;
    *(LAS u32x4*)(lds + GL_RK + tid * 16) = I.kraw;
    if (WQ) *(LAS u32x4*)(lds + GL_RQ + tid * 16) = I.qraw;
}

DEVI int gla_a_item_of(int c, int n, int Gsz) { constexpr int NIT = NB * 4 * 68;
    if (Gsz != 256) { const int it = c + n * Gsz; return it < NIT ? it : -1; }
    const int q = (c >> 2) + 64 * n; if (q >= NB * 68) return -1;
    return ((q / 68) * 4 + (c & 3)) * 68 + q % 68; }
DEVI void gla_a_phase(const GlaPtrs& G, LAS unsigned char* lds, int bid, int Gsz) {
    int tid = threadIdx.x; asm volatile("" : "+v"(tid));
    const int wave = __builtin_amdgcn_readfirstlane(tid >> 6), lane = tid & 63, d = lane, to = wave, fr = lane & 15, fq = lane >> 4;
    constexpr int NIT = NB * 4 * 68;
    if (bid >= NIT) return;
#define GA_ROW0(it) (((it) % 68) < 4 ? NTOK + (((it) / 68) >> 2) * CTX + ((it) % 68) * 64 : (((it) / 68) >> 2) * SEQ + (((it) % 68) - 4) * 64)
    const int item0 = gla_a_item_of(bid, 0, Gsz);
    GIn cur; gla_load_common<true>(G, GA_ROW0(item0), (item0 / 68) & 3, tid, cur);
    const bool onehead = Gsz == 256;
    GateW W = gla_gatew(G, (item0 / 68) & 3, d);
    for (int nloc = 0, item = item0; item >= 0; ++nloc) {
        const int ch = item % 68, bh = item / 68, h = bh & 3; (void)h;
        const int nit = gla_a_item_of(bid, nloc + 1, Gsz);
        gla_stage_common<true>(lds, tid, cur);
        __syncthreads();
        if (nit >= 0) gla_load_common<true>(G, GA_ROW0(nit), (nit / 68) & 3, tid, cur);
        float cf[8], cb[8];
        gla_gates2(W, lds, d, to, cf, cb);
        if (!onehead) W = gla_gatew(G, ((nit >= 0 ? nit : item) / 68) & 3, d);
        __syncthreads();
        const LAS float* TOT = (const LAS float*)(lds + GL_TOT);
        float offf = 0.f, offb = 0.f, totf = 0.f, totb = 0.f;
#pragma unroll
        for (int t = 0; t < 8; ++t) { const float a = TOT[(0 * 8 + t) * 64 + d], c = TOT[(1 * 8 + t) * 64 + d]; totf += a; totb += c; if (t < to) offf += a; if (t > to) offb += c; }
        float of[8], ob[8];
        bf16_t* gt = G.GLT + ((size_t)(bh * 64 + (ch - 4)) * 4) * 4096;
#pragma unroll
        for (int j = 0; j < 8; ++j) { const int ro = ((to * 8 + j) * 64 + d) * 2; const float kf = bf2f(*(const LAS bf16_t*)(lds + GL_RK + ro));
            of[j] = kf * __expf(totf - (cf[j] + offf)); ob[j] = kf * __expf(totb - (cb[j] + offb));
            if (ch >= 4) { const float qf = bf2f(*(const LAS bf16_t*)(lds + GL_RQ + ro)) * 0.125f;
                const float ef = __expf(fmaxf(cf[j] + offf, -80.f)), eb = __expf(fmaxf(cb[j] + offb, -80.f)); const int go = (to * 8 + j) * 64 + d;
                *(LAS bf16_t*)(lds + GL_GT0 + go * 2) = f2bf(qf * ef); *(LAS bf16_t*)(lds + GL_GT0 + 8192 + go * 2) = f2bf(kf * __builtin_amdgcn_rcpf(ef));
                *(LAS bf16_t*)(lds + GL_GT1 + go * 2) = f2bf(qf * eb); *(LAS bf16_t*)(lds + GL_GT1 + 8192 + go * 2) = f2bf(kf * __builtin_amdgcn_rcpf(eb)); } }
        { u32x4 w; w.x = pk2(of[0], of[1]); w.y = pk2(of[2], of[3]); w.z = pk2(of[4], of[5]); w.w = pk2(of[6], of[7]); *(LAS u32x4*)(lds + GL_QF + (d * GL_LD + to * 8) * 2) = w;
          w.x = pk2(ob[0], ob[1]); w.y = pk2(ob[2], ob[3]); w.z = pk2(ob[4], ob[5]); w.w = pk2(ob[6], ob[7]); *(LAS u32x4*)(lds + GL_KF + (d * GL_LD + to * 8) * 2) = w; }
        const int chain_f = bh * 2, step_f = ch, step_b = ch < 4 ? 3 - ch : 71 - ch;
        if (to == 0) { G.ADEC[((size_t)chain_f * 68 + step_f) * 64 + d] = __expf(totf); G.ADEC[((size_t)(chain_f + 1) * 68 + step_b) * 64 + d] = __expf(totb); }
        __syncthreads();
        if (ch >= 4) { const u32x4 g0 = *(const LAS u32x4*)(lds + GL_GT0 + tid * 16), g1 = *(const LAS u32x4*)(lds + GL_GT0 + 8192 + tid * 16), g2 = *(const LAS u32x4*)(lds + GL_GT1 + tid * 16), g3 = *(const LAS u32x4*)(lds + GL_GT1 + 8192 + tid * 16);
            *(u32x4*)(gt + tid * 8) = g0; *(u32x4*)(gt + 4096 + tid * 8) = g1; *(u32x4*)(gt + 8192 + tid * 8) = g2; *(u32x4*)(gt + 12288 + tid * 8) = g3; }
        f32x4 acc[2][4];
#pragma unroll
        for (int dr = 0; dr < 2; ++dr)
#pragma unroll
            for (int dt = 0; dt < 4; ++dt) acc[dr][dt] = (f32x4){0.f, 0.f, 0.f, 0.f};
#pragma unroll
        for (int ks = 0; ks < 2; ++ks) { const bf16x8 a = *(const LAS bf16x8*)(lds + GL_VT + ((wave * 16 + fr) * GL_LD + ks * 32 + fq * 8) * 2);
#pragma unroll
            for (int dt = 0; dt < 4; ++dt) { const bf16x8 b0 = *(const LAS bf16x8*)(lds + GL_QF + ((dt * 16 + fr) * GL_LD + ks * 32 + fq * 8) * 2);
                const bf16x8 b1 = *(const LAS bf16x8*)(lds + GL_KF + ((dt * 16 + fr) * GL_LD + ks * 32 + fq * 8) * 2);
                acc[0][dt] = __builtin_amdgcn_mfma_f32_16x16x32_bf16(b0, a, acc[0][dt], 0, 0, 0); acc[1][dt] = __builtin_amdgcn_mfma_f32_16x16x32_bf16(b1, a, acc[1][dt], 0, 0, 0); } }
#pragma unroll
        for (int dr = 0; dr < 2; ++dr)
#pragma unroll
            for (int dt = 0; dt < 4; ++dt) { u32x2 w2; w2[0] = pk2(acc[dr][dt][0], acc[dr][dt][1]); w2[1] = pk2(acc[dr][dt][2], acc[dr][dt][3]);
                *(LAS u32x2*)(lds + GL_UST + dr * 18432 + (wave * 16 + fr) * 144 + (dt * 16 + 4 * fq) * 2) = w2; }
        __syncthreads();
#pragma unroll
        for (int i = 0; i < 4; ++i) { const int q = tid + i * NTHR, dr = q >> 10, off = (q & 1023) * 8;
            const u32x4 w = *(const LAS u32x4*)(lds + GL_UST + dr * 18432 + ((q & 1023) >> 3) * 144 + (q & 7) * 16);
            const size_t chain = (size_t)chain_f + dr; const int step = dr ? step_b : step_f;
            *(u32x4*)(G.UCH + (chain * 68 + step) * 8192 + off) = w; }
        item = nit;
    }
#undef GA_ROW0
    __syncthreads();
}

struct CIn { unsigned vv[8]; u32x4 tl[4]; u32x4 sraw[4]; u32x2 rr[4]; };
DEVI void gla_c_load(const GlaPtrs& G, int item, int tid, int wave, int fr, int fq, CIn& I) {
    const int c = item & 63, bh = item >> 6, h = bh & 3, b = bh >> 2, row0 = b * SEQ + c * 64;
    const int ep = tid & 63, to = tid >> 6;
#pragma unroll
    for (int j = 0; j < 8; ++j) I.vv[j] = *(const unsigned*)(G.V + (size_t)(row0 + to * 8 + j) * 512 + h * 128 + 2 * ep);
    const bf16_t* gt = G.GLT + (size_t)item * 4 * 4096;
#pragma unroll
    for (int t = 0; t < 4; ++t) I.tl[t] = *(const u32x4*)(gt + t * 4096 + tid * 8);
    const bf16_t* Sf = G.SST + ((size_t)(bh * 2) * 64 + c) * 8192; const bf16_t* Sb = G.SST + ((size_t)(bh * 2 + 1) * 64 + (63 - c)) * 8192;
    I.sraw[0] = *(const u32x4*)(Sf + tid * 8); I.sraw[1] = *(const u32x4*)(Sf + (tid + NTHR) * 8); I.sraw[2] = *(const u32x4*)(Sb + tid * 8); I.sraw[3] = *(const u32x4*)(Sb + (tid + NTHR) * 8);
    const int tg = wave & 3, eh = wave >> 2, tok = row0 + tg * 16 + fr;
#pragma unroll
    for (int et = 0; et < 4; ++et) I.rr[et] = *(const u32x2*)(G.R + (size_t)tok * 512 + h * 128 + eh * 64 + et * 16 + 4 * fq);
}
DEVI void gla_c_phase(const GlaPtrs& G, LAS unsigned char* lds, int bid, int Gsz) {
    int tid = threadIdx.x; asm volatile("" : "+v"(tid));
    const int wave = __builtin_amdgcn_readfirstlane(tid >> 6), lane = tid & 63, fr = lane & 15, fq = lane >> 4;
    constexpr int NIT = NB * 4 * 64;
    if (bid >= NIT) return;
    const int tg = wave & 3, eh = wave >> 2;
    f32x4 nwv[4];
#pragma unroll
    for (int et = 0; et < 4; ++et) nwv[et] = *(const f32x4*)(G.nw + eh * 64 + et * 16 + 4 * fq);
    CIn cur; gla_c_load(G, bid, tid, wave, fr, fq, cur);
    for (int item = bid; item < NIT; item += Gsz) {
        const int c = item & 63, bh = item >> 6, h = bh & 3, b = bh >> 2, row0 = b * SEQ + c * 64;
#ifdef PROBE_GC
        unsigned long long tg0_ = __builtin_amdgcn_s_memrealtime();
#define GC_MARK(k) do { const unsigned long long tn_ = __builtin_amdgcn_s_memrealtime(); if (PROBE_GC == (k) && tid == 0) { volatile LAS unsigned* ac_ = (volatile LAS unsigned*)(lds + MISC_OFF + 512); ac_[0] = ac_[0] + (unsigned)(tn_ - tg0_); } tg0_ = tn_; } while (0)
#else
#define GC_MARK(k) do {} while (0)
#endif
        { const int ep = tid & 63, to = tid >> 6; const unsigned* w = cur.vv;
          u32x4 lo, hi;
          lo.x = (w[0] & 0xffffu) | (w[1] << 16); lo.y = (w[2] & 0xffffu) | (w[3] << 16); lo.z = (w[4] & 0xffffu) | (w[5] << 16); lo.w = (w[6] & 0xffffu) | (w[7] << 16);
          hi.x = (w[0] >> 16) | (w[1] & 0xffff0000u); hi.y = (w[2] >> 16) | (w[3] & 0xffff0000u); hi.z = (w[4] >> 16) | (w[5] & 0xffff0000u); hi.w = (w[6] >> 16) | (w[7] & 0xffff0000u);
          *(LAS u32x4*)(lds + GL_VT + ((2 * ep) * GL_LD + to * 8) * 2) = lo; *(LAS u32x4*)(lds + GL_VT + ((2 * ep + 1) * GL_LD + to * 8) * 2) = hi; }
        { const int r0 = tid >> 3, ck = tid & 7;
          *(LAS u32x4*)(lds + GL_QF + (r0 * GL_LD + ck * 8) * 2) = cur.tl[0]; *(LAS u32x4*)(lds + GL_KF + (r0 * GL_LD + ck * 8) * 2) = cur.tl[1];
          *(LAS u32x4*)(lds + GL_QB + (r0 * GL_LD + ck * 8) * 2) = cur.tl[2]; *(LAS u32x4*)(lds + GL_KB + (r0 * GL_LD + ck * 8) * 2) = cur.tl[3];
          *(LAS u32x4*)(lds + GL_SF + (r0 * GL_LD + ck * 8) * 2) = cur.sraw[0]; *(LAS u32x4*)(lds + GL_SF + ((r0 + 64) * GL_LD + ck * 8) * 2) = cur.sraw[1];
          *(LAS u32x4*)(lds + GL_SB + (r0 * GL_LD + ck * 8) * 2) = cur.sraw[2]; *(LAS u32x4*)(lds + GL_SB + ((r0 + 64) * GL_LD + ck * 8) * 2) = cur.sraw[3]; }
        u32x2 rcur[4];
#pragma unroll
        for (int et = 0; et < 4; ++et) rcur[et] = cur.rr[et];
        __syncthreads();
        GC_MARK(0);
        { const int ti = wave >> 1;
#pragma unroll
          for (int u = 0; u < 2; ++u) { const int tj = (wave & 1) * 2 + u;
              f32x4 af = (f32x4){0.f, 0.f, 0.f, 0.f}, ab = (f32x4){0.f, 0.f, 0.f, 0.f};
              if (tj <= ti) {
#pragma unroll
                  for (int ks = 0; ks < 2; ++ks) { const bf16x8 a = *(const LAS bf16x8*)(lds + GL_KF + ((tj * 16 + fr) * GL_LD + ks * 32 + fq * 8) * 2), bb = *(const LAS bf16x8*)(lds + GL_QF + ((ti * 16 + fr) * GL_LD + ks * 32 + fq * 8) * 2);
                      af = __builtin_amdgcn_mfma_f32_16x16x32_bf16(a, bb, af, 0, 0, 0); } }
              if (tj >= ti) {
#pragma unroll
                  for (int ks = 0; ks < 2; ++ks) { const bf16x8 a = *(const LAS bf16x8*)(lds + GL_KB + ((tj * 16 + fr) * GL_LD + ks * 32 + fq * 8) * 2), bb = *(const LAS bf16x8*)(lds + GL_QB + ((ti * 16 + fr) * GL_LD + ks * 32 + fq * 8) * 2);
                      ab = __builtin_amdgcn_mfma_f32_16x16x32_bf16(a, bb, ab, 0, 0, 0); } }
              float p[4];
#pragma unroll
              for (int rg = 0; rg < 4; ++rg) { const int i = ti * 16 + fr, j = tj * 16 + 4 * fq + rg; p[rg] = (j <= i ? af[rg] : 0.f) + (j >= i ? ab[rg] : 0.f); }
              u32x2 w; w.x = pk2(p[0], p[1]); w.y = pk2(p[2], p[3]);
              *(LAS u32x2*)(lds + GL_PP + ((ti * 16 + fr) * GL_LD + tj * 16 + 4 * fq) * 2) = w; } }
        __syncthreads();
        GC_MARK(1);
        { const int nit = item + Gsz; if (nit < NIT) gla_c_load(G, nit, tid, wave, fr, fq, cur); }
        f32x4 acc[4];
#pragma unroll
        for (int et = 0; et < 4; ++et) acc[et] = (f32x4){0.f, 0.f, 0.f, 0.f};
#pragma unroll
        for (int ks = 0; ks < 2; ++ks) {
            const int bo = ((tg * 16 + fr) * GL_LD + ks * 32 + fq * 8) * 2;
            const bf16x8 bP = *(const LAS bf16x8*)(lds + GL_PP + bo), bF = *(const LAS bf16x8*)(lds + GL_QF + bo), bB = *(const LAS bf16x8*)(lds + GL_QB + bo);
#pragma unroll
            for (int et = 0; et < 4; ++et) { const int ao = ((eh * 64 + et * 16 + fr) * GL_LD + ks * 32 + fq * 8) * 2;
                const bf16x8 aV = *(const LAS bf16x8*)(lds + GL_VT + ao), aF = *(const LAS bf16x8*)(lds + GL_SF + ao), aB = *(const LAS bf16x8*)(lds + GL_SB + ao);
                acc[et] = __builtin_amdgcn_mfma_f32_16x16x32_bf16(aV, bP, acc[et], 0, 0, 0);
                acc[et] = __builtin_amdgcn_mfma_f32_16x16x32_bf16(aF, bF, acc[et], 0, 0, 0);
                acc[et] = __builtin_amdgcn_mfma_f32_16x16x32_bf16(aB, bB, acc[et], 0, 0, 0); } }
        float ss = 0.f;
#pragma unroll
        for (int et = 0; et < 4; ++et) ss += acc[et][0] * acc[et][0] + acc[et][1] * acc[et][1] + acc[et][2] * acc[et][2] + acc[et][3] * acc[et][3];
        ss += __shfl_xor(ss, 16); ss += __shfl_xor(ss, 32);
        LAS float* SSQ = (LAS float*)(lds + GL_SSQ);
        if (fq == 0) SSQ[eh * 64 + tg * 16 + fr] = ss;
        __syncthreads();
        GC_MARK(2);
        const float rstd = rsqrtf((SSQ[tg * 16 + fr] + SSQ[64 + tg * 16 + fr]) * (1.f / 128.f) + 1e-6f);
        const int tok = row0 + tg * 16 + fr;
#pragma unroll
        for (int et = 0; et < 4; ++et) { const int e = eh * 64 + et * 16 + 4 * fq; const u32x2 rv = rcur[et];
            const float r0 = __uint_as_float(rv.x << 16), r1 = __uint_as_float(rv.x & 0xffff0000u), r2 = __uint_as_float(rv.y << 16), r3 = __uint_as_float(rv.y & 0xffff0000u);
            uint2 w; w.x = pk2(acc[et][0] * rstd * nwv[et][0] * siluf_(r0), acc[et][1] * rstd * nwv[et][1] * siluf_(r1)); w.y = pk2(acc[et][2] * rstd * nwv[et][2] * siluf_(r2), acc[et][3] * rstd * nwv[et][3] * siluf_(r3));
            *(uint2*)(G.MIX + (size_t)tok * DM + h * 128 + e) = w; }
        GC_MARK(3);
    }
    __syncthreads();
}

DEVI void s5w_build(const MArgs_in& in, unsigned char* ws, LAS unsigned char* lds, int g) {
    LAS float* LP = (LAS float*)lds;
    LAS float* BB = LP + 2 * 17 * 64 * 2;
    LAS float* CC = BB + 2 * 64 * 16 * 2;
    LAS float* KK = CC + 2 * 16 * 64 * 2;
    LAS float* CO = KK + 2 * 16 * 256;
    const int tid = threadIdx.x;
    S5P* P = (S5P*)(ws + OFF_S5P);
    if (tid < 128) { const int p = tid & 63, d = tid >> 6; const int i = (d * 32 + g) * 64 + p;
        const double dt = exp((double)in.log_dt[d * 32 + g]), lr = in.lam_re[i], li = in.lam_im[i];
        const double mag = exp(lr * dt), ar = mag * cos(li * dt), ai = mag * sin(li * dt);
        { const double nr = ar - 1.0, ni = ai, den = lr * lr + li * li; CO[(d * 64 + p) * 2] = (float)((nr * lr + ni * li) / den); CO[(d * 64 + p) * 2 + 1] = (float)((ni * lr - nr * li) / den); }
        double pr = 1.0, pi = 0.0;
        for (int n = 0; n < 17; ++n) { LP[((d * 17 + n) * 64 + p) * 2] = (float)pr; LP[((d * 17 + n) * 64 + p) * 2 + 1] = (float)pi;
            if (n == 16) { P->lam16[d][g][p][0] = (float)pr; P->lam16[d][g][p][1] = (float)pi; }
            const double tr = pr * ar - pi * ai, ti = pr * ai + pi * ar; pr = tr; pi = ti; } }
    for (int t = tid; t < 2 * 16 * 64; t += NTHR) { const int p = t & 63, h = (t >> 6) & 15, d = t >> 10; const size_t ix = (((size_t)d * 32 + g) * 16 + h) * 64 + p;
        CC[((d * 16 + h) * 64 + p) * 2] = in.c_re[ix]; CC[((d * 16 + h) * 64 + p) * 2 + 1] = in.c_im[ix]; }
    __syncthreads();
    for (int t = tid; t < 2 * 64 * 16; t += NTHR) { const int h = t & 15, p = (t >> 4) & 63, d = t >> 10; const size_t ix = (((size_t)d * 32 + g) * 64 + p) * 16 + h;
        const float br = in.b_re[ix], bi = in.b_im[ix], cr = CO[(d * 64 + p) * 2], ci = CO[(d * 64 + p) * 2 + 1];
        BB[((d * 64 + p) * 16 + h) * 2] = cr * br - ci * bi; BB[((d * 64 + p) * 16 + h) * 2 + 1] = cr * bi + ci * br; }
    __syncthreads();
    { const int h = tid & 15, n = (tid >> 4) & 15, d = tid >> 8; float acc[16];
#pragma unroll
      for (int q = 0; q < 16; ++q) acc[q] = 0.f;
      for (int p = 0; p < 64; ++p) { const float cr = CC[((d * 16 + h) * 64 + p) * 2], ci = CC[((d * 16 + h) * 64 + p) * 2 + 1], lr = LP[((d * 17 + n) * 64 + p) * 2], li = LP[((d * 17 + n) * 64 + p) * 2 + 1];
          const float tr = cr * lr - ci * li, ti = cr * li + ci * lr; const LAS f32x4* bb = (const LAS f32x4*)(BB + ((d * 64 + p) * 16) * 2);
#pragma unroll
          for (int q = 0; q < 8; ++q) { const f32x4 x = bb[q]; acc[2 * q] += tr * x[0] - ti * x[1]; acc[2 * q + 1] += tr * x[2] - ti * x[3]; } }
#pragma unroll
      for (int q = 0; q < 16; ++q) KK[(d * 16 + n) * 256 + h * 16 + q] = acc[q]; }
    __syncthreads();
    bf16_t* BF = (bf16_t*)(ws + OFF_S5BF) + (size_t)g * 256 * 256;
    for (int t = tid; t < 256 * 32; t += NTHR) { const int k8 = t & 31, row = t >> 5, p = (row & 127) >> 1, im = row & 1, d = row >> 7; float o[8];
#pragma unroll
        for (int q = 0; q < 8; ++q) { const int k = k8 * 8 + q, j = k >> 4, hp = k & 15, pw = d ? j : 15 - j;
            const float lr = LP[((d * 17 + pw) * 64 + p) * 2], li = LP[((d * 17 + pw) * 64 + p) * 2 + 1], br = BB[((d * 64 + p) * 16 + hp) * 2], bi = BB[((d * 64 + p) * 16 + hp) * 2 + 1];
            o[q] = im ? lr * bi + li * br : lr * br - li * bi; }
        uint4 w; w.x = pk2(o[0], o[1]); w.y = pk2(o[2], o[3]); w.z = pk2(o[4], o[5]); w.w = pk2(o[6], o[7]);
        *(uint4*)(BF + (size_t)row * 256 + k8 * 8) = w; }
    bf16_t* BY = (bf16_t*)(ws + OFF_S5BY) + (size_t)g * 256 * 512;
    for (int t = tid; t < 256 * 64; t += NTHR) { const int k8 = t & 63, n = t >> 6, i = n >> 4, h = n & 15; float o[8];
#pragma unroll
        for (int q = 0; q < 8; ++q) { const int k = k8 * 8 + q; float v;
            if (k < 256) { const int j = k >> 4, hp = k & 15; v = 0.f; if (i >= j) v += KK[(0 * 16 + (i - j)) * 256 + h * 16 + hp]; if (j >= i) v += KK[(1 * 16 + (j - i)) * 256 + h * 16 + hp]; }
            else { const int d = (k - 256) >> 7, r = (k - 256) & 127, p = r >> 1, im = r & 1, pw = d ? 16 - i : i + 1;
                const float cr = CC[((d * 16 + h) * 64 + p) * 2], ci = CC[((d * 16 + h) * 64 + p) * 2 + 1], lr = LP[((d * 17 + pw) * 64 + p) * 2], li = LP[((d * 17 + pw) * 64 + p) * 2 + 1];
                v = im ? -(cr * li + ci * lr) : cr * lr - ci * li; }
            o[q] = v; }
        uint4 w; w.x = pk2(o[0], o[1]); w.y = pk2(o[2], o[3]); w.z = pk2(o[4], o[5]); w.w = pk2(o[6], o[7]);
        *(uint4*)(BY + (size_t)n * 512 + k8 * 8) = w; }
    __syncthreads();
}
struct ProbS5F {
    static constexpr bool HOIST = false, PAIR = false, FP8 = false, SW16 = false, LBIAS = false, GATHK = false;
    const bf16_t* A; const bf16_t* B; int K; float* F;
    DEVI int nunits() const { return 32 * 9; }
    DEVI void unit(int L, int& z, int& pm, int& pn) const { z = L & 31; pm = L >> 5; pn = 0; }
    DEVI int M(int) const { return 2304; }
    DEVI unsigned aoffb(int z, int r) const { return (unsigned)(z * 2304 + r) * 1024u; }
    DEVI const bf16_t* Bt(int z) const { return B + (size_t)z * 256 * 256; }
    DEVI void store(int z, int r, int c0, const float (&v)[8]) const { bf16_t* p = (bf16_t*)F + ((size_t)z * 2304 + r) * 256 + c0;
        uint4 o; o.x = pk2(v[0], v[1]); o.y = pk2(v[2], v[3]); o.z = pk2(v[4], v[5]); o.w = pk2(v[6], v[7]); *(uint4*)p = o; }
};
struct ProbS5Y {
    static constexpr bool HOIST = true, PAIR = false, FP8 = false, ROW2 = true, SW16 = false, LBIAS = false, GATHK = false;
    const bf16_t* A; const bf16_t* B; int K; const float* dvec; bf16_t* YS; int zc;
    struct ColCtx { float d[8]; int ch; }; struct RowCtx { uint4 u[2]; int b, s16; };
    DEVI int nunits() const { return 32 * 8; }
    DEVI void unit(int L, int& z, int& pm, int& pn) const { z = L & 31; pm = L >> 5; pn = 0; }
    DEVI int M(int) const { return 2048; }
    DEVI unsigned aoffb(int z, int r) const { return (unsigned)(z * 2304 + r) * 1024u; }
    DEVI const bf16_t* Bt(int z) const { return B + (size_t)z * 256 * 512; }
    DEVI ColCtx colctx(int z, int c0) const { ColCtx c; c.ch = z * 16 + (c0 & 15); const float4 d0 = *(const float4*)(dvec + c.ch), d1 = *(const float4*)(dvec + c.ch + 4);
        c.d[0] = d0.x; c.d[1] = d0.y; c.d[2] = d0.z; c.d[3] = d0.w; c.d[4] = d1.x; c.d[5] = d1.y; c.d[6] = d1.z; c.d[7] = d1.w; return c; }
    DEVI RowCtx rowctx2z(int z, int r, int cb0) const { RowCtx x; const bf16_t* p = A + ((size_t)z * 2304 + r) * 512 + cb0; x.u[0] = *(const uint4*)p; x.u[1] = *(const uint4*)(p + 128); x.b = r >> 8; x.s16 = (r & 255) << 4; return x; }
    DEVI void storeh(const ColCtx& c, const RowCtx& x, int c0, const float (&v)[8]) const {
        const int sq = x.s16 + (c0 >> 4), gc = sq >> 6, gr = sq & 63, tok = x.b * SEQ + gr * 64 + gc;
        const uint4 uv = x.u[(c0 >> 7) & 1]; const unsigned uw[4] = {uv.x, uv.y, uv.z, uv.w}; float o[8];
#pragma unroll
        for (int j = 0; j < 4; ++j) { o[2 * j] = gelu_tanh(v[2 * j] + c.d[2 * j] * __uint_as_float(uw[j] << 16)); o[2 * j + 1] = gelu_tanh(v[2 * j + 1] + c.d[2 * j + 1] * __uint_as_float(uw[j] & 0xffff0000u)); }
        uint4 w; w.x = pk2(o[0], o[1]); w.y = pk2(o[2], o[3]); w.z = pk2(o[4], o[5]); w.w = pk2(o[6], o[7]);
        (void)tok; *(uint4*)(YS + ((size_t)((c.ch >> 4) * NB + x.b) * 4096 * 16 + (size_t)x.s16 * 16 + c0)) = w; }
    DEVI void store(int, int, int, const float (&)[8]) const {}
};
typedef float f32x2_t __attribute__((ext_vector_type(2)));
DEVI void s5_carry(const float* __restrict__ F, bf16_t* __restrict__ U2, const S5P* __restrict__ P, int id, int lane) {
    const int g = id & 31, dir = (id >> 5) & 1, b = id >> 6;
    const float l16r = P->lam16[dir][g][lane][0], l16i = P->lam16[dir][g][lane][1];
    const bf16_t* Fg = (const bf16_t*)F + (size_t)g * 2304 * 256 + dir * 128 + 2 * lane;
    bf16_t* Ug = U2 + (size_t)g * 2304 * 512 + 256 + dir * 128 + 2 * lane;
    float hr = 0.f, hi = 0.f;
    const int sgn = dir ? -1 : 1;
    unsigned b0[16], b1[16], b2[16], b3[16];
#define S5_R0(bt) ((bt) == 0 ? 2048 + b * 16 + (dir ? 15 : 0) : b * 256 + (dir ? 255 - 16 * ((bt) - 1) : 16 * ((bt) - 1)))
#define S5_LOAD(buf, bt) do { const bf16_t* p_ = Fg + (ptrdiff_t)S5_R0(bt) * 256; _Pragma("unroll") for (int j = 0; j < 16; ++j) buf[j] = *(const unsigned*)(p_ + (ptrdiff_t)(sgn * j) * 256); } while (0)
#define S5_PROC(buf, bt) do { bf16_t* u_ = Ug + (ptrdiff_t)S5_R0(bt) * 512; const bool st_ = (bt) > 0; _Pragma("unroll") for (int j = 0; j < 16; ++j) { \
        if (st_) *(unsigned*)(u_ + (ptrdiff_t)(sgn * j) * 512) = pk2(hr, hi); \
        const float tr = l16r * hr - l16i * hi + __uint_as_float(buf[j] << 16), ti = l16r * hi + l16i * hr + __uint_as_float(buf[j] & 0xffff0000u); hr = tr; hi = ti; } } while (0)
    S5_LOAD(b0, 0); S5_LOAD(b1, 1); S5_LOAD(b2, 2);
    S5_LOAD(b3, 3); S5_PROC(b0, 0);
#pragma unroll 1
    for (int bt = 1; bt < 17; bt += 4) {
        if (bt + 3 < 17) S5_LOAD(b0, bt + 3);
        S5_PROC(b1, bt);
        if (bt + 4 < 17) S5_LOAD(b1, bt + 4);
        S5_PROC(b2, bt + 1);
        if (bt + 5 < 17) S5_LOAD(b2, bt + 5);
        S5_PROC(b3, bt + 2);
        if (bt + 6 < 17) S5_LOAD(b3, bt + 6);
        S5_PROC(b0, bt + 3);
    }
#undef S5_R0
#undef S5_LOAD
#undef S5_PROC
}
DEVI void ph_scans(const GlaPtrs& G, const float* __restrict__ F, bf16_t* __restrict__ U2, const S5P* __restrict__ P, LAS unsigned char* lds, int blk, bool do_gla, bool do_s5) {
    int tid = threadIdx.x; asm volatile("" : "+v"(tid));
    const int wave = __builtin_amdgcn_readfirstlane(tid >> 6), lane = tid & 63;
    const int chain = blk >> 2;
    if (do_gla) for (int i = tid; i < 68 * 16; i += NTHR) ((LAS f32x4*)lds)[i] = ((const f32x4*)(G.ADEC + (size_t)chain * 68 * 64))[i];
    __syncthreads();
    if (wave < 4) { if (do_gla) {
        const int e = (blk & 3) * 32 + (tid >> 3), d8 = (tid & 7) * 8;
        const bf16_t* up = G.UCH + ((size_t)chain * 68 * 128 + e) * 64 + d8;
        bf16_t* sp = G.SST + ((size_t)chain * 64 * 128 + e) * 64 + d8;
        float S[8];
#pragma unroll
        for (int q = 0; q < 8; ++q) S[q] = 0.f;
        u32x4 cur[17], nxt[17];
#pragma unroll
        for (int j = 0; j < 17; ++j) cur[j] = *(const u32x4*)(up + (size_t)j * 8192);
#pragma unroll 1
        for (int bt = 0; bt < 4; ++bt) {
            if (bt < 3) {
#pragma unroll
                for (int j = 0; j < 17; ++j) nxt[j] = *(const u32x4*)(up + (size_t)((bt + 1) * 17 + j) * 8192); }
#pragma unroll
            for (int j = 0; j < 17; ++j) { const int step = bt * 17 + j;
                if (step >= 4) { u32x4 o; o.x = pk2(S[0], S[1]); o.y = pk2(S[2], S[3]); o.z = pk2(S[4], S[5]); o.w = pk2(S[6], S[7]); *(u32x4*)(sp + (size_t)(step - 4) * 8192) = o; }
                const f32x4 a0 = *(const LAS f32x4*)(lds + (step * 64 + d8) * 4), a1 = *(const LAS f32x4*)(lds + (step * 64 + d8 + 4) * 4);
                const unsigned w0 = cur[j].x, w1 = cur[j].y, w2 = cur[j].z, w3 = cur[j].w;
                S[0] = a0[0] * S[0] + __uint_as_float(w0 << 16); S[1] = a0[1] * S[1] + __uint_as_float(w0 & 0xffff0000u);
                S[2] = a0[2] * S[2] + __uint_as_float(w1 << 16); S[3] = a0[3] * S[3] + __uint_as_float(w1 & 0xffff0000u);
                S[4] = a1[0] * S[4] + __uint_as_float(w2 << 16); S[5] = a1[1] * S[5] + __uint_as_float(w2 & 0xffff0000u);
                S[6] = a1[2] * S[6] + __uint_as_float(w3 << 16); S[7] = a1[3] * S[7] + __uint_as_float(w3 & 0xffff0000u); }
#pragma unroll
            for (int j = 0; j < 17; ++j) cur[j] = nxt[j];
        } } }
    else if (wave < 6) { if (do_s5) s5_carry(F, U2, P, blk * 2 + (wave - 4), lane); }
    __syncthreads();
}


constexpr int NPH = 12;

struct WItem { const float* src; bf16_t* dst; int K, N, c0, n0, k0; bool act; bool f8; bool gu; };
constexpr int WC_ITEMS = 18 * 4 + 4 * 2 + 8 * 4 + 32 * 16 * 4 + 32 * 8 * 4;
DEVI WItem wconv_decode(const MArgs& a, unsigned char* ws, int it) {
    constexpr int I0 = 18 * 4, I1 = I0 + 4 * 2, I2 = I1 + 8 * 4, I3 = I2 + 32 * 16 * 4, I4 = I3 + 32 * 8 * 4;
    if (it >= I2 && it < I4 - 112) { const int r = it - I2; it = I2 + (((1479 - (r >> 1)) << 1) | (r & 1)); }
    WItem w; w.src = a.in[7]; w.dst = nullptr; w.K = DM; w.N = INC; w.c0 = 0; w.n0 = 0; w.k0 = 0; w.act = it < I4; w.f8 = MOE_FP8 && it >= I2; w.gu = false;
    if (w.act) {
        if (it < I0) { w.src = a.in[7]; w.dst = (bf16_t*)(ws + OFF_WIN); w.K = DM; w.N = INC; w.n0 = (it % 18) * 128; w.k0 = (it / 18) * 256; w.c0 = w.n0; }
        else if (it < I1) { const int r = it - I0; w.src = a.in[19]; w.dst = (bf16_t*)(ws + OFF_WGLU); w.K = 512; w.N = 512; w.n0 = (r % 4) * 128; w.k0 = (r / 4) * 256; w.c0 = w.n0; }
        else if (it < I2) { const int r = it - I1; w.src = a.in[21]; w.dst = (bf16_t*)(ws + OFF_WOUT); w.K = DM; w.N = DM; w.n0 = (r % 8) * 128; w.k0 = (r / 8) * 256; w.c0 = w.n0; }
        else if (it < I3) { const int r = it - I2, e = r / 64, q = r % 64; w.src = a.in[25] + (size_t)e * DM * 2048; w.dst = (bf16_t*)(ws + OFF_WG + (size_t)e * 2048 * DM * (MOE_FP8 ? 1 : 2)); w.K = DM; w.N = 2048;
            if (MOE_FP8) { const int blk = q % 8; w.gu = true; w.c0 = blk * 256; w.n0 = (blk & 3) * 512 + (blk >> 2) * 128; w.k0 = (q / 8) * 128; }
            else { w.n0 = (q % 16) * 128; w.k0 = (q / 16) * 256; w.c0 = wsrc_col<1>(w.n0); } }
        else { const int r = it - I3, e = r / 32, q = r % 32; w.src = a.in[27] + (size_t)e * DFF * DM; w.dst = (bf16_t*)(ws + OFF_WD + (size_t)e * DM * DFF * (MOE_FP8 ? 1 : 2)); w.K = DFF; w.N = DM;
            if (MOE_FP8) { w.n0 = (q % 4) * 256; w.k0 = (q / 4) * 128; w.c0 = w.n0; } else { w.n0 = (q % 8) * 128; w.k0 = (q / 8) * 256; w.c0 = w.n0; } }
    }
    return w;
}
DEVI void wconv_load(const WItem& w, int tid, f32x4 (&r)[16]) {
    const int l32 = tid & 31, kr = tid >> 5, col = w.c0 + 4 * l32; const bool ok = col < w.N; const int cc = ok ? col : 0;
    if (w.f8) { const int l64 = tid & 63, kr8 = tid >> 6;
        const int colf = w.c0 + 4 * l64;
        const float* p = w.src + (size_t)(w.k0 + 4 * kr8) * w.N + colf; const size_t st = (size_t)32 * w.N;
#pragma unroll
        for (int i = 0; i < 4; ++i)
#pragma unroll
            for (int j = 0; j < 4; ++j) r[4 * i + j] = *(const f32x4*)(p + i * st + (size_t)j * w.N);
        return; }
    const float* p = w.src + (size_t)(w.k0 + 2 * kr) * w.N + cc; const size_t st = (size_t)32 * w.N;
#pragma unroll
    for (int i = 0; i < 8; ++i) { r[2 * i] = *(const f32x4*)(p + i * st); r[2 * i + 1] = *(const f32x4*)(p + i * st + w.N); }
}
DEVI void wconv_store(const WItem& cur, LAS unsigned char* lds, int tid, const f32x4 (&rc)[16], volatile LAS int* q = nullptr, int pend = 0) {
    constexpr int TS = 264;
    const int l32 = tid & 31, kr = tid >> 5;
    if (cur.f8) {
        const int l64 = tid & 63, kr8 = tid >> 6, sw8 = (l64 & 31) << 2;
#pragma unroll
        for (int i = 0; i < 4; ++i) { const int k = (4 * kr8 + 32 * i) ^ sw8;
#pragma unroll
            for (int c = 0; c < 4; ++c) *(LAS unsigned*)(lds + (4 * l64 + c) * 128 + k) = pk4_fp8(rc[4 * i][c] * 32.f, rc[4 * i + 1][c] * 32.f, rc[4 * i + 2][c] * 32.f, rc[4 * i + 3][c] * 32.f); }
        if (q && tid == 0) q[0] = pend;
        __syncthreads();
        if (cur.act) {
#pragma unroll
            for (int i = 0; i < 4; ++i) { const int ch = tid + NTHR * i, n = ch >> 3, c16 = ch & 7, t = (n >> 2) & 31, m = t & 3;
                const u32x4 v = *(const LAS u32x4*)(lds + n * 128 + ((c16 ^ (t >> 2)) * 16));
                u32x4 o; o.x = (m & 1) ? v.y : v.x; o.y = (m & 1) ? v.x : v.y; o.z = (m & 1) ? v.w : v.z; o.w = (m & 1) ? v.z : v.w;
                if (m & 2) { const unsigned t0 = o.x, t1 = o.y; o.x = o.z; o.y = o.w; o.z = t0; o.w = t1; }
                const int drow = cur.n0 + (cur.gu ? (n >> 7) * 256 + (n & 127) : n);
                *(u32x4*)((char*)cur.dst + (size_t)drow * cur.K + cur.k0 + c16 * 16) = o; } }
        return; }
    const float okf = (cur.c0 + 4 * l32 < cur.N) ? 1.f : 0.f;
    const int sw = ((l32 >> 1) & 15) << 1;
#pragma unroll
    for (int i = 0; i < 8; ++i) { const int k = (2 * kr + 32 * i) ^ sw;
#pragma unroll
        for (int c = 0; c < 4; ++c) *(LAS unsigned*)(lds + ((4 * l32 + c) * TS + k) * 2) = pk2(rc[2 * i][c] * okf, rc[2 * i + 1][c] * okf); }
    if (q && tid == 0) q[0] = pend;
    __syncthreads();
    if (cur.act) {
#pragma unroll
        for (int i = 0; i < 8; ++i) { const int ch = tid + NTHR * i, n = ch >> 5, c8 = ch & 31, sn = ((n >> 3) & 15) << 1, m = (sn >> 1) & 3;
            const u32x4 v = *(const LAS u32x4*)(lds + (n * TS + ((c8 ^ (sn >> 3)) * 8)) * 2);
            u32x4 o; o.x = (m & 1) ? v.y : v.x; o.y = (m & 1) ? v.x : v.y; o.z = (m & 1) ? v.w : v.z; o.w = (m & 1) ? v.z : v.w;
            if (m & 2) { const unsigned t0 = o.x, t1 = o.y; o.x = o.z; o.y = o.w; o.z = t0; o.w = t1; }
            *(u32x4*)(cur.dst + (size_t)(cur.n0 + n) * cur.K + cur.k0 + c8 * 8) = o; } }
}
DEVI int wc_deferred(int G) { constexpr int NU = (NROWS / 256) * (INP / 256); return G == 256 ? 2 * (5 * 256 - NU) : 0; }
DEVI void ph_prep(const MArgs& a, LAS unsigned char* lds, int bid, int G) {
    const int tid = threadIdx.x, wave = tid >> 6, lane = tid & 63;
    unsigned char* ws = a.ws;
    const bool big = G > 136; const int nsp = big ? 32 : G;
    const bool special = !big || (bid >= 104 && bid < 136); const int sid = big ? bid - 104 : bid;
#ifdef PROBE_SP
    const unsigned long long tsp0_ = __builtin_amdgcn_s_memrealtime();
#endif
    if (special) {
        for (int g = sid; g < 32; g += nsp) { MArgs_in in{a.in[11], a.in[12], a.in[13], a.in[14], a.in[15], a.in[16], a.in[17]}; s5w_build(in, ws, lds, g); }
    }
#ifdef PROBE_SP
    if (PROBE_SP == 1 && bid == 104 && tid == 0) ((volatile LAS unsigned*)(lds + MISC_OFF + 512))[0] = (unsigned)(__builtin_amdgcn_s_memrealtime() - tsp0_);
#endif
    { LAS float* s = (LAS float*)lds; LAS float* part = (LAS float*)(lds + 36864);
      const float* c = a.in[1]; const float* cc = a.in[3]; const float* ada_w = a.in[4]; float* MP = (float*)(ws + OFF_SST);
      typedef float f32x2 __attribute__((ext_vector_type(2)));
      bool have_s = false;
      for (int mi = bid; mi < 256; mi += G) {
          if (!have_s) { for (int i = tid; i < 9216; i += NTHR) { const int r = i >> 10, k = i & 1023; const float v = r < 8 ? c[r * 1024 + k] : cc[k]; s[i] = siluf_(v); } have_s = true; __syncthreads(); }
          const int ks = mi >> 4, cs = mi & 15, k0 = ks * 64 + wave * 8;
          f32x2 wv[3][8];
#pragma unroll
          for (int ps = 0; ps < 3; ++ps)
#pragma unroll
              for (int q = 0; q < 8; ++q) wv[ps][q] = *(const f32x2*)(ada_w + (size_t)(k0 + q) * 6144 + cs * 384 + ps * 128 + lane * 2);
#pragma unroll
          for (int ps = 0; ps < 3; ++ps) { float acc[9][2];
#pragma unroll
              for (int r = 0; r < 9; ++r) { acc[r][0] = 0.f; acc[r][1] = 0.f; }
#pragma unroll
              for (int q = 0; q < 8; ++q) {
#pragma unroll
                  for (int r = 0; r < 9; ++r) { const float sv = s[r * 1024 + k0 + q]; acc[r][0] += sv * wv[ps][q][0]; acc[r][1] += sv * wv[ps][q][1]; } }
#pragma unroll
              for (int r = 0; r < 9; ++r) { part[(wave * 9 + r) * 128 + lane * 2] = acc[r][0]; part[(wave * 9 + r) * 128 + lane * 2 + 1] = acc[r][1]; }
              __syncthreads();
              for (int i = tid; i < 9 * 128; i += NTHR) { const int r = i >> 7, l = i & 127; float sum = 0.f;
#pragma unroll
                  for (int w = 0; w < 8; ++w) sum += part[(w * 9 + r) * 128 + l];
                  MP[((size_t)ks * 9 + r) * 6144 + cs * 384 + ps * 128 + l] = sum; }
              __syncthreads(); }
          asm volatile("s_waitcnt vmcnt(0)" ::: "memory");
          __syncthreads();
          volatile LAS int* lastf = (volatile LAS int*)(lds + MISC_OFF + 248);
          if (tid == 0) { __builtin_amdgcn_fence(__ATOMIC_RELEASE, "agent"); asm volatile("s_waitcnt vmcnt(0)" ::: "memory");
              const unsigned old = __hip_atomic_fetch_add((unsigned*)(ws + OFF_CTL) + CW_MODC + cs, 1u, __ATOMIC_RELAXED, __HIP_MEMORY_SCOPE_AGENT);
              lastf[0] = (old == 15u) ? 1 : 0;
              if (old == 15u) { __builtin_amdgcn_fence(__ATOMIC_ACQUIRE, "agent"); asm volatile("s_waitcnt vmcnt(0)" ::: "memory"); } }
          __syncthreads();
          if (lastf[0]) { const float* ada_b = a.in[5]; float* mod = (float*)(ws + OFF_MOD);
              for (int i = tid; i < 9 * 384; i += NTHR) { const int r = i / 384, col = cs * 384 + i % 384; float sum = ada_b[col];
#pragma unroll
                  for (int k2 = 0; k2 < 16; ++k2) sum += __hip_atomic_load(MP + ((size_t)k2 * 9 + r) * 6144 + col, __ATOMIC_RELAXED, __HIP_MEMORY_SCOPE_AGENT);
                  mod[r * 6144 + col] = sum; } }
          __syncthreads();
      } }
#ifdef PROBE_SP
    if (PROBE_SP == 2 && bid == 0 && tid == 0) ((volatile LAS unsigned*)(lds + MISC_OFF + 512))[0] = (unsigned)(__builtin_amdgcn_s_memrealtime() - tsp0_);
    const unsigned long long tsp1_ = __builtin_amdgcn_s_memrealtime();
#endif
    { unsigned* ctr = (unsigned*)(ws + OFF_CTL) + CW_WQ; volatile LAS int* q = (volatile LAS int*)(lds + MISC_OFF + 240);
      __syncthreads();
      if (tid == 0) q[0] = (int)atomicAdd(ctr, 2u);
      __syncthreads();
      int ia = q[0], ib = ia + 1;
      f32x4 ra[16], rb[16];
      WItem wa = wconv_decode(a, ws, ia); wconv_load(wa, tid, ra);
      const int wc_lim = WC_ITEMS - wc_deferred(G);
      while (ia < wc_lim) {
          int pend = 0; if (tid == 0) pend = (int)atomicAdd(ctr, 2u);
          const WItem wb = wconv_decode(a, ws, ib); wconv_load(wb, tid, rb);
          wconv_store(wa, lds, tid, ra, q, pend);
          ia = q[0];
          wa = wconv_decode(a, ws, ia); wconv_load(wa, tid, ra);
          wconv_store(wb, lds + 69632, tid, rb);
          ib = ia + 1;
#ifdef PROBE_SP
          if (PROBE_SP == 4 && bid == 0 && tid == 0) ((volatile LAS unsigned*)(lds + MISC_OFF + 512))[0] += 50u;
#endif
      }
      __syncthreads(); }
#ifdef PROBE_SP
    if (PROBE_SP == 3 && bid == 0 && tid == 0) ((volatile LAS unsigned*)(lds + MISC_OFF + 512))[0] = (unsigned)(__builtin_amdgcn_s_memrealtime() - tsp1_);
#endif
}


struct RIn { float4 v[2][4]; };
DEVI void router_load(const float* __restrict__ X, int tb, int t1, int wave, int lane, RIn& I) {
#pragma unroll
    for (int u = 0; u < 2; ++u) { int tok = tb + wave * 2 + u; tok = tok < t1 ? tok : t1 - 1;
#pragma unroll
        for (int j = 0; j < 4; ++j) I.v[u][j] = *(const float4*)(X + (size_t)tok * DM + lane * 4 + 256 * j); }
}
DEVI void router_load_mix(const float* __restrict__ OUTB, int tb, int t1, int wave, int lane, uint2 (&mx)[2][4]) {
#pragma unroll
    for (int u = 0; u < 2; ++u) { int tok = tb + wave * 2 + u; tok = tok < t1 ? tok : t1 - 1;
#pragma unroll
        for (int j = 0; j < 4; ++j) mx[u][j] = *(const uint2*)((const bf16_t*)(OUTB + (size_t)tok * DM) + DM + lane * 4 + 256 * j); }
}
DEVI void ph_router(const float* __restrict__ X, const float* __restrict__ OUTB, const float* __restrict__ w, const float* __restrict__ mod, const float* __restrict__ rw, const float* __restrict__ rb,
                    bf16_t* __restrict__ H2, int* __restrict__ cnt, int* __restrict__ list, float* __restrict__ gate, int* __restrict__ epos, LAS unsigned char* lds, int bid, int G, bool commit) {
    int tid = threadIdx.x; asm volatile("" : "+v"(tid));
    const int wave = __builtin_amdgcn_readfirstlane(tid >> 6), lane = tid & 63, e16 = lane & 15, kq = lane >> 4;
    constexpr int HS = 1028;
    LAS float* hrow = (LAS float*)lds;
    LAS float* part = (LAS float*)(lds + 16 * HS * 4);
    LAS int* lcnt = (LAS int*)(lds + 16 * HS * 4 + 16384);
    LAS int* gbase = lcnt + 32; LAS int* ent = lcnt + 64;
    LAS float* cst = (LAS float*)(lds + 90112);
    bf16x8 whi[2][4], wlo[2][4];
#pragma unroll
    for (int et = 0; et < 2; ++et)
#pragma unroll
        for (int sq = 0; sq < 4; ++sq) { u32x4 h4, l4;
#pragma unroll
            for (int jp = 0; jp < 4; ++jp) { const int k = wave * 128 + 32 * sq + 8 * kq + 2 * jp; const float f0 = rw[k * 32 + et * 16 + e16], f1 = rw[(k + 1) * 32 + et * 16 + e16];
                const unsigned hp = pk2(f0, f1); h4[jp] = hp; l4[jp] = pk2(f0 - __uint_as_float(hp << 16), f1 - __uint_as_float(hp & 0xffff0000u)); }
            whi[et][sq] = __builtin_bit_cast(bf16x8, h4); wlo[et][sq] = __builtin_bit_cast(bf16x8, l4); }
    const float rbe = rb[lane & 31];
    static_assert(SEQ % 128 == 0 && NTOK % 128 == 0, "router chunks of 128 tokens must not straddle a batch");
  for (int ci = bid; ci < NTOK / 128; ci += G) {
    const int t0 = ci * 128, t1 = t0 + 128, b0 = t0 / SEQ;
    __syncthreads();
    if (tid < 64) lcnt[tid] = 0;
    for (int i = tid; i < 1024; i += NTHR) { cst[i] = w[i]; cst[1024 + i] = mod[b0 * 6144 + 4096 + i]; cst[2048 + i] = mod[b0 * 6144 + 3072 + i]; cst[3072 + i] = mod[b0 * 6144 + 2048 + i]; }
    __syncthreads();
    uint2 mx[2][4];
    auto pass = [&](int tb, RIn& I) {
        float ssu[2];
#pragma unroll
        for (int u = 0; u < 2; ++u) { float ss = 0.f;
#pragma unroll
            for (int j = 0; j < 4; ++j) { const int k = lane * 4 + 256 * j; const f32x4 g1 = *(const LAS f32x4*)(cst + 3072 + k);
                I.v[u][j].x += g1[0] * __uint_as_float(mx[u][j].x << 16); I.v[u][j].y += g1[1] * __uint_as_float(mx[u][j].x & 0xffff0000u);
                I.v[u][j].z += g1[2] * __uint_as_float(mx[u][j].y << 16); I.v[u][j].w += g1[3] * __uint_as_float(mx[u][j].y & 0xffff0000u);
                ss += I.v[u][j].x * I.v[u][j].x + I.v[u][j].y * I.v[u][j].y + I.v[u][j].z * I.v[u][j].z + I.v[u][j].w * I.v[u][j].w; }
            ssu[u] = ss; }
        router_load_mix(OUTB, tb + 16, t1, wave, lane, mx);
#pragma unroll
        for (int u = 0; u < 2; ++u) { const int tok = tb + wave * 2 + u;
            if (tok < t1) {
                { bf16_t* xb = (bf16_t*)(const_cast<float*>(OUTB) + (size_t)tok * DM);
#pragma unroll
                  for (int j = 0; j < 4; ++j) { uint2 o; o.x = pk2(I.v[u][j].x, I.v[u][j].y); o.y = pk2(I.v[u][j].z, I.v[u][j].w); *(uint2*)(xb + lane * 4 + 256 * j) = o; } }
                const float rstd = rsqrtf(wave_sum(ssu[u]) * (1.f / DM) + 1e-6f);
#pragma unroll
                for (int j = 0; j < 4; ++j) { const int k = lane * 4 + 256 * j; const f32x4 ww = *(const LAS f32x4*)(cst + k), sc = *(const LAS f32x4*)(cst + 1024 + k), sh = *(const LAS f32x4*)(cst + 2048 + k);
                    f32x4 hv; hv[0] = I.v[u][j].x * rstd * ww[0] * (1.f + sc[0]) + sh[0]; hv[1] = I.v[u][j].y * rstd * ww[1] * (1.f + sc[1]) + sh[1]; hv[2] = I.v[u][j].z * rstd * ww[2] * (1.f + sc[2]) + sh[2]; hv[3] = I.v[u][j].w * rstd * ww[3] * (1.f + sc[3]) + sh[3];
                    *(LAS f32x4*)(hrow + (wave * 2 + u) * HS + k) = hv;
                    if (!MOE_FP8) { uint2 o; o.x = pk2(hv[0], hv[1]); o.y = pk2(hv[2], hv[3]); *(uint2*)(H2 + (size_t)tok * DM + k) = o; } }
                if (MOE_FP8) {
                    const LAS f32x4* hp = (const LAS f32x4*)(hrow + (wave * 2 + u) * HS + lane * 16);
                    const f32x4 a0 = hp[0], a1 = hp[1], a2 = hp[2], a3 = hp[3];
                    u32x4 o; o.x = pk4_fp8(a0[0], a0[1], a0[2], a0[3]); o.y = pk4_fp8(a1[0], a1[1], a1[2], a1[3]); o.z = pk4_fp8(a2[0], a2[1], a2[2], a2[3]); o.w = pk4_fp8(a3[0], a3[1], a3[2], a3[3]);
                    *(u32x4*)((char*)H2 + (size_t)tok * DM + lane * 16) = o; }
            } else {
#pragma unroll
                for (int j = 0; j < 4; ++j) *(LAS f32x4*)(hrow + (wave * 2 + u) * HS + lane * 4 + 256 * j) = (f32x4){0.f, 0.f, 0.f, 0.f}; }
        }
        router_load(X, tb + 32, t1, wave, lane, I);
        __syncthreads();
        f32x4 acc0 = (f32x4){0.f, 0.f, 0.f, 0.f}, acc1 = (f32x4){0.f, 0.f, 0.f, 0.f};
#pragma unroll
        for (int sq = 0; sq < 4; ++sq) { const LAS f32x4* hp = (const LAS f32x4*)(hrow + e16 * HS + wave * 128 + 32 * sq + 8 * kq); const f32x4 a0 = hp[0], a1 = hp[1];
            u32x4 h4, l4;
            h4[0] = pk2(a0[0], a0[1]); h4[1] = pk2(a0[2], a0[3]); h4[2] = pk2(a1[0], a1[1]); h4[3] = pk2(a1[2], a1[3]);
            l4[0] = pk2(a0[0] - __uint_as_float(h4[0] << 16), a0[1] - __uint_as_float(h4[0] & 0xffff0000u)); l4[1] = pk2(a0[2] - __uint_as_float(h4[1] << 16), a0[3] - __uint_as_float(h4[1] & 0xffff0000u));
            l4[2] = pk2(a1[0] - __uint_as_float(h4[2] << 16), a1[1] - __uint_as_float(h4[2] & 0xffff0000u)); l4[3] = pk2(a1[2] - __uint_as_float(h4[3] << 16), a1[3] - __uint_as_float(h4[3] & 0xffff0000u));
            const bf16x8 ahi = __builtin_bit_cast(bf16x8, h4), alo = __builtin_bit_cast(bf16x8, l4);
            acc0 = __builtin_amdgcn_mfma_f32_16x16x32_bf16(ahi, whi[0][sq], acc0, 0, 0, 0); acc1 = __builtin_amdgcn_mfma_f32_16x16x32_bf16(ahi, whi[1][sq], acc1, 0, 0, 0);
            acc0 = __builtin_amdgcn_mfma_f32_16x16x32_bf16(ahi, wlo[0][sq], acc0, 0, 0, 0); acc1 = __builtin_amdgcn_mfma_f32_16x16x32_bf16(ahi, wlo[1][sq], acc1, 0, 0, 0);
            acc0 = __builtin_amdgcn_mfma_f32_16x16x32_bf16(alo, whi[0][sq], acc0, 0, 0, 0); acc1 = __builtin_amdgcn_mfma_f32_16x16x32_bf16(alo, whi[1][sq], acc1, 0, 0, 0); }
#pragma unroll
        for (int rg = 0; rg < 4; ++rg) { part[((wave * 2 + 0) * 16 + 4 * kq + rg) * 16 + e16] = acc0[rg]; part[((wave * 2 + 1) * 16 + 4 * kq + rg) * 16 + e16] = acc1[rg]; }
        __syncthreads();
        {
            const int t = wave * 2 + (lane >> 5), tk = tb + t, e = lane & 31, et = e >> 4, ee = e & 15;
            float lg = rbe;
#pragma unroll
            for (int q = 0; q < 8; ++q) lg += part[((q * 2 + et) * 16 + t) * 16 + ee];
            float val = lg; float tv[4]; int ti[4];
#pragma unroll
            for (int r = 0; r < 4; ++r) { float bv = val; int bi = e;
#pragma unroll
                for (int o = 1; o < 32; o <<= 1) { const float ov = __shfl_xor(bv, o); const int oi = __shfl_xor(bi, o); if (ov > bv || (ov == bv && oi < bi)) { bv = ov; bi = oi; } }
                tv[r] = bv; ti[r] = bi; if (e == bi) val = -3.0e38f; }
            const float e1 = __expf(tv[1] - tv[0]), e2 = __expf(tv[2] - tv[0]), e3 = __expf(tv[3] - tv[0]), inv = 1.f / (1.f + e1 + e2 + e3);
            if (e < 4 && tk < t1 && commit) { const float gv = e == 0 ? inv : e == 1 ? e1 * inv : e == 2 ? e2 * inv : e3 * inv; const int ex = e == 0 ? ti[0] : e == 1 ? ti[1] : e == 2 ? ti[2] : ti[3];
                const int ls = __hip_atomic_fetch_add(&lcnt[ex], 1, __ATOMIC_RELAXED, __HIP_MEMORY_SCOPE_WORKGROUP); ent[(tk - t0) * 4 + e] = (ex << 16) | ls; gate[tk * 4 + e] = gv; }
        }
    };
    RIn A, B;
    router_load(X, t0, t1, wave, lane, A); router_load_mix(OUTB, t0, t1, wave, lane, mx); router_load(X, t0 + 16, t1, wave, lane, B);
    for (int tb = t0; tb < t1; tb += 32) { pass(tb, A); pass(tb + 16, B); }
    __syncthreads();
    if (commit) {
        if (tid < NEXP) { const int c = lcnt[tid]; gbase[tid] = c ? atomicAdd(&cnt[tid], c) : 0; }
        __syncthreads();
        for (int i = tid; i < (t1 - t0) * 4; i += NTHR) { const int en = ent[i], ex = en >> 16, slot = gbase[ex] + (en & 0xffff), tk4 = t0 * 4 + i;
            list[ex * LISTCAP + slot] = tk4; epos[tk4] = ex * LISTCAP + slot; }
    }
  }
    __syncthreads();
}

DEVI void build_ub(const int* cnt, volatile LAS int* ub) {
    if (threadIdx.x < 64) { const int e = threadIdx.x & 31; const int t = (cnt[e] + 255) >> 8; int inc = t;
#pragma unroll
        for (int o = 1; o < 32; o <<= 1) { const int v = __shfl_up(inc, o, 32); if (e >= o) inc += v; }
        if (threadIdx.x < 32) { ub[e] = inc - t; if (e == 31) ub[NEXP] = inc; } }
    __syncthreads();
}

struct FinIn { uint2 xb[4]; int q[4][4]; float4 gt; };
DEVI void final_load(const float* __restrict__ X, const float* __restrict__ X1, const bf16_t* __restrict__ Y2, const float* __restrict__ gate, const int* __restrict__ epos, const LAS int* ub, const float* __restrict__ mod, int tok, int lane, FinIn& I) {
    const int4 ep = *(const int4*)(epos + tok * 4); I.gt = *(const float4*)(gate + tok * 4);
    const char* y[4];
    y[0] = (const char*)Y2 + (size_t)(ub[ep.x / LISTCAP] * 256 + ep.x % LISTCAP) * DM; y[1] = (const char*)Y2 + (size_t)(ub[ep.y / LISTCAP] * 256 + ep.y % LISTCAP) * DM;
    y[2] = (const char*)Y2 + (size_t)(ub[ep.z / LISTCAP] * 256 + ep.z % LISTCAP) * DM; y[3] = (const char*)Y2 + (size_t)(ub[ep.w / LISTCAP] * 256 + ep.w % LISTCAP) * DM;
    const bf16_t* xrow = (const bf16_t*)(X1 + (size_t)tok * DM);
#pragma unroll
    for (int j = 0; j < 4; ++j) { const int k = lane * 4 + 256 * j; I.xb[j] = *(const uint2*)(xrow + k);
#pragma unroll
        for (int e = 0; e < 4; ++e) I.q[e][j] = *(const int*)(y[e] + k); }
}
DEVI void final_finish(float* __restrict__ X1, const float4 (&g1v)[4], const float4 (&g2v)[4], const float4 (&fwv)[4], int tok, int lane, const FinIn& I, float* __restrict__ OUT) {
    float* orow = (OUT ? OUT : X1) + (size_t)tok * DM;
    float4 v[4]; float ss = 0.f;
#pragma unroll
    for (int j = 0; j < 4; ++j) { { const uint2 xb = I.xb[j]; v[j] = make_float4(__uint_as_float(xb.x << 16), __uint_as_float(xb.x & 0xffff0000u), __uint_as_float(xb.y << 16), __uint_as_float(xb.y & 0xffff0000u)); }
        const int q0 = I.q[0][j], q1 = I.q[1][j], q2 = I.q[2][j], q3 = I.q[3][j]; const float4 gt = I.gt; float f[4];
        f[0] = gt.x * __builtin_amdgcn_cvt_f32_fp8(q0, 0) + gt.y * __builtin_amdgcn_cvt_f32_fp8(q1, 0) + gt.z * __builtin_amdgcn_cvt_f32_fp8(q2, 0) + gt.w * __builtin_amdgcn_cvt_f32_fp8(q3, 0);
        f[1] = gt.x * __builtin_amdgcn_cvt_f32_fp8(q0, 1) + gt.y * __builtin_amdgcn_cvt_f32_fp8(q1, 1) + gt.z * __builtin_amdgcn_cvt_f32_fp8(q2, 1) + gt.w * __builtin_amdgcn_cvt_f32_fp8(q3, 1);
        f[2] = gt.x * __builtin_amdgcn_cvt_f32_fp8(q0, 2) + gt.y * __builtin_amdgcn_cvt_f32_fp8(q1, 2) + gt.z * __builtin_amdgcn_cvt_f32_fp8(q2, 2) + gt.w * __builtin_amdgcn_cvt_f32_fp8(q3, 2);
        f[3] = gt.x * __builtin_amdgcn_cvt_f32_fp8(q0, 3) + gt.y * __builtin_amdgcn_cvt_f32_fp8(q1, 3) + gt.z * __builtin_amdgcn_cvt_f32_fp8(q2, 3) + gt.w * __builtin_amdgcn_cvt_f32_fp8(q3, 3);
        const float4 gg = g2v[j];
        v[j].x += gg.x * f[0]; v[j].y += gg.y * f[1]; v[j].z += gg.z * f[2]; v[j].w += gg.w * f[3];
        ss += v[j].x * v[j].x + v[j].y * v[j].y + v[j].z * v[j].z + v[j].w * v[j].w; }
    const float rstd = rsqrtf(wave_sum(ss) * (1.f / DM) + 1e-6f);
#pragma unroll
    for (int j = 0; j < 4; ++j) { const int k = lane * 4 + 256 * j;
        *(float4*)(orow + k) = make_float4(v[j].x * rstd * fwv[j].x, v[j].y * rstd * fwv[j].y, v[j].z * rstd * fwv[j].z, v[j].w * rstd * fwv[j].w); }
}
__global__ void __launch_bounds__(NTHR, 2) mega(MArgs a) {
    extern __shared__ __attribute__((aligned(16))) unsigned char lds_raw[];
    LAS unsigned char* lds = (LAS unsigned char*)lds_raw;
    volatile LAS unsigned* MISC = (volatile LAS unsigned*)(lds + MISC_OFF);
    const int tid = threadIdx.x, wave = __builtin_amdgcn_readfirstlane(tid >> 6), G = gridDim.x, bid = blockIdx.x;
    const int gw = bid * NWAVES + wave, NGW = G * NWAVES;
    for (int u = tid; u < MISC_BYTES / 4; u += NTHR) MISC[u] = 0u;
    __syncthreads();
    unsigned char* ws = a.ws; unsigned* ctl = (unsigned*)(ws + OFF_CTL);
    const bool multi = (a.ph_hi - a.ph_lo) > 1;
    XcdBarrier bar; bar.bar = ctl + CW_BAR; bar.x = 0; bar.st = MISC;
    if (multi) bar = xcd_barrier_post(ctl + CW_BAR, MISC);
    volatile LAS int* ub = (volatile LAS int*)(MISC + 16);
#ifndef PROBE_REP
#define PROBE_REP 0
#endif
#define IN(k) (a.ph_lo <= (k) && (k) < a.ph_hi)
#define NREP(k) (1 + ((PROBE_REP >> (k)) & 1))
#ifndef PROBE_VPH
#define PROBE_VPH -1
#endif
#ifndef PROBE_VMODE
#define PROBE_VMODE 1
#endif
#define FRESH_LANE int ft_ = threadIdx.x; asm volatile("" : "+v"(ft_)); const int lane = ft_ & 63; (void)lane
#ifndef PROBE_TK
#define PROBE_TK -1
#endif
    unsigned long long tstamp_prev = 0ull, tstamp_sel = 0ull;
    if (PROBE_TK >= 0) tstamp_prev = __builtin_amdgcn_s_memrealtime();
#ifndef PROBE_CLK
#define PROBE_CLK -1
#endif
    unsigned long long cyc_prev = 0ull, cyc_sel = 0ull, rt_prev = 0ull, rt_sel = 1ull;
#define SEAM(k) do { if (IN(k) && IN((k) + 1)) xcd_barrier(bar); if (PROBE_TK >= 0) { const unsigned long long tn_ = __builtin_amdgcn_s_memrealtime(); if ((k) == PROBE_TK) tstamp_sel = tn_ - tstamp_prev; tstamp_prev = tn_; } \
        if (PROBE_CLK >= 0) { const unsigned long long cn_ = __builtin_amdgcn_s_memtime(), rn_ = __builtin_amdgcn_s_memrealtime(); if ((k) == PROBE_CLK) { cyc_sel = cn_ - cyc_prev; rt_sel = rn_ - rt_prev; } cyc_prev = cn_; rt_prev = rn_; } } while (0)
    float* mod = (float*)(ws + OFF_MOD); S5P* s5p = (S5P*)(ws + OFF_S5P); float* gate = (float*)(ws + OFF_GATE); int* list = (int*)(ws + OFF_LIST);
    bf16_t* WIN = (bf16_t*)(ws + OFF_WIN); bf16_t* WGLU = (bf16_t*)(ws + OFF_WGLU); bf16_t* WOUT = (bf16_t*)(ws + OFF_WOUT); bf16_t* WG = (bf16_t*)(ws + OFF_WG); bf16_t* WD = (bf16_t*)(ws + OFF_WD);
    bf16_t* H = (bf16_t*)(ws + OFF_H); bf16_t* QK = (bf16_t*)(ws + OFF_QK); bf16_t* V = (bf16_t*)(ws + OFF_V); bf16_t* R = (bf16_t*)(ws + OFF_R); bf16_t* UT = (bf16_t*)(ws + OFF_UT);
    float* LR = (float*)(ws + OFF_LR); bf16_t* U2 = (bf16_t*)(ws + OFF_U2);
    bf16_t* YS = (bf16_t*)(ws + OFF_YS); bf16_t* MIX = (bf16_t*)(ws + OFF_MIX); bf16_t* ACT = (bf16_t*)(ws + OFF_ACT); bf16_t* YSL = (bf16_t*)(ws + OFF_YSL);
    int* cnt = (int*)(ctl + CW_CNT);

    if (IN(0)) for (int rp = 0; rp < NREP(0); ++rp) ph_prep(a, lds, bid, G);
    SEAM(0);
    if (IN(1)) for (int rp = 0; rp < NREP(1); ++rp) { FRESH_LANE;
        const float* xin = a.in[0]; const float* cin = a.in[2]; const float* nwp = a.in[6];
        float4 wv[4];
#pragma unroll
        for (int j = 0; j < 4; ++j) wv[j] = *(const float4*)(nwp + lane * 4 + 256 * j);
        auto rsrc = [&](int r) -> const float* { r = r < NROWS ? r : NROWS - 1; return r < NTOK ? xin + (size_t)r * DM : cin + (size_t)(r - NTOK) * DM; };
        float4 va[4], vb[4];
        { const float* s0 = rsrc(gw); const float* s1 = rsrc(gw + NGW);
#pragma unroll
          for (int j = 0; j < 4; ++j) va[j] = *(const float4*)(s0 + lane * 4 + 256 * j);
#pragma unroll
          for (int j = 0; j < 4; ++j) vb[j] = *(const float4*)(s1 + lane * 4 + 256 * j); }
        auto one = [&](int row, float4 (&v)[4]) {
            float ss = 0.f; float4 c[4], csc[4], csh[4];
            const int rr = row < NROWS ? row : NROWS - 1;
            { const float* mb = mod + (rr < NTOK ? rr / SEQ : 8) * 6144;
#pragma unroll
              for (int j = 0; j < 4; ++j) { csh[j] = *(const float4*)(mb + lane * 4 + 256 * j); csc[j] = *(const float4*)(mb + 1024 + lane * 4 + 256 * j); } }
#pragma unroll
            for (int j = 0; j < 4; ++j) { c[j] = v[j]; ss += v[j].x * v[j].x + v[j].y * v[j].y + v[j].z * v[j].z + v[j].w * v[j].w; }
            { const float* ns = rsrc(row + 2 * NGW);
#pragma unroll
              for (int j = 0; j < 4; ++j) v[j] = *(const float4*)(ns + lane * 4 + 256 * j); }
            const float rstd = rsqrtf(wave_sum(ss) * (1.f / DM) + 1e-6f);
            if (row < NROWS) {
#pragma unroll
                for (int j = 0; j < 4; ++j) { const int k = lane * 4 + 256 * j; const float4 sc = csc[j], sh = csh[j];
                    uint2 o; o.x = pk2(c[j].x * rstd * wv[j].x * (1.f + sc.x) + sh.x, c[j].y * rstd * wv[j].y * (1.f + sc.y) + sh.y);
                    o.y = pk2(c[j].z * rstd * wv[j].z * (1.f + sc.z) + sh.z, c[j].w * rstd * wv[j].w * (1.f + sc.w) + sh.w);
                    *(uint2*)(H + (size_t)row * DM + k) = o; } } };
#pragma unroll 1
        for (int row = gw; row < NROWS; row += 2 * NGW) { one(row, va); one(row + NGW, vb); } }
    SEAM(1);
    if (IN(2) && PROBE_VPH == 2) { ProbIn P{H, DM, WIN, DM, DM, QK, V, R, UT, U2, LR}; gemm_phase<PROBE_VMODE>(lds, P, G, bid); }
    if (IN(2)) for (int rp = 0; rp < NREP(2); ++rp) { ProbIn P{H, DM, WIN, DM, DM, QK, V, R, UT, U2, LR}; gemm_phase(lds, P, G, bid); }
    if (IN(2) && wc_deferred(G) > 0) { constexpr int NU = (NROWS / 256) * (INP / 256);
        if (4 * G + bid >= NU) { int tq = threadIdx.x; asm volatile("" : "+v"(tq)); const int it0 = WC_ITEMS - wc_deferred(G) + 2 * (4 * G + bid - NU);
            f32x4 ra[16], rb[16]; const WItem wa = wconv_decode(a, ws, it0), wb = wconv_decode(a, ws, it0 + 1);
            wconv_load(wa, tq, ra); wconv_load(wb, tq, rb); wconv_store(wa, lds, tq, ra); wconv_store(wb, lds + 69632, tq, rb); __syncthreads(); } }
    SEAM(2);
    float* Fb = (float*)(ws + OFF_F); bf16_t* S5BF = (bf16_t*)(ws + OFF_S5BF); bf16_t* S5BY = (bf16_t*)(ws + OFF_S5BY);
    const GlaPtrs GP{QK, V, R, LR, a.in[8], a.in[9], a.in[10], (bf16_t*)(ws + OFF_UCH), (float*)(ws + OFF_ADEC), (bf16_t*)(ws + OFF_SST), MIX, (bf16_t*)(ws + OFF_GLT)};
    if (IN(3)) for (int rp = 0; rp < NREP(3); ++rp) {
        for (int r2 = 0; r2 < NREP(12); ++r2) { ProbS5F P{U2, S5BF, 256, Fb}; gemm_phase(lds, P, G, (bid + 32) % G); }
        for (int r2 = 0; r2 < NREP(13); ++r2) gla_a_phase(GP, lds, bid, G);
    }
    SEAM(3);
    if (IN(4)) for (int rp = 0; rp < NREP(4); ++rp) {
        for (int blk = bid; blk < 256; blk += G) ph_scans(GP, Fb, U2, s5p, lds, blk, NREP(16) > 0, true);
    }
    SEAM(4);
    if (IN(5)) for (int rp = 0; rp < NREP(5); ++rp) {
        const bool gemm_first = ((bid >> 3) & 1) == 0;
        if (gemm_first) for (int r2 = 0; r2 < NREP(14); ++r2) { ProbS5Y P{U2, S5BY, 512, a.in[18], YS, 0}; gemm_phase(lds, P, G, bid); }
        for (int r2 = 0; r2 < NREP(15); ++r2) gla_c_phase(GP, lds, bid, G);
        if (!gemm_first) for (int r2 = 0; r2 < NREP(14); ++r2) { ProbS5Y P{U2, S5BY, 512, a.in[18], YS, 0}; gemm_phase(lds, P, G, bid); }
    }
    SEAM(5);
    if (IN(6)) for (int rp = 0; rp < NREP(6); ++rp) { ProbGlu P{YS, 512, WGLU, 512, 512, a.in[20], MIX, 0}; gemm_phase(lds, P, G, bid); }
    SEAM(6);
    if (IN(7)) for (int rp = 0; rp < NREP(7); ++rp) { ProbOut P{MIX, DM, WOUT, DM, DM, a.in[0], mod, a.out}; gemm_phase(lds, P, G, bid); }
    SEAM(7);
    if (IN(8)) for (int rp = NREP(8) - 1; rp >= 0; --rp) ph_router(a.in[0], a.out, a.in[22], mod, a.in[23], a.in[24], H, cnt, list, gate, (int*)(ws + OFF_EPOS), lds, bid, G, rp == 0);
    SEAM(8);
    if (IN(9) && PROBE_VPH == 9) { build_ub(cnt, ub); FMoe1 P{H, WG, MOE_FP8 ? DM / 2 : DM, cnt, list, a.in[26], ACT, (const LAS int*)ub, G}; gemm_phase<PROBE_VMODE>(lds, P, G, bid); }
    if (IN(9)) for (int rp = 0; rp < NREP(9); ++rp) { build_ub(cnt, ub); FMoe1 P{H, WG, MOE_FP8 ? DM / 2 : DM, cnt, list, a.in[26], ACT, (const LAS int*)ub, G}; gemm_phase(lds, P, G, bid); }
    SEAM(9);
    if (IN(10) && PROBE_VPH == 10) { build_ub(cnt, ub); FMoe2 P{ACT, WD, MOE_FP8 ? DFF / 2 : DFF, cnt, a.in[28], YSL, (const LAS int*)ub, G}; gemm_phase<PROBE_VMODE>(lds, P, G, bid); }
    if (IN(10)) for (int rp = 0; rp < NREP(10); ++rp) { if (!IN(9)) build_ub(cnt, ub); FMoe2 P{ACT, WD, MOE_FP8 ? DFF / 2 : DFF, cnt, a.in[28], YSL, (const LAS int*)ub, G}; gemm_phase(lds, P, G, bid); }
    SEAM(10);
    if (IN(11)) { if (!IN(9)) build_ub(cnt, ub);
        if (MOE_FP8) { for (int rp = NREP(11) - 1; rp >= 0; --rp) { FRESH_LANE;
            float4 fwv[4];
#pragma unroll
            for (int j = 0; j < 4; ++j) fwv[j] = *(const float4*)(a.in[29] + lane * 4 + 256 * j);
            FinIn cur; if (gw < NTOK) final_load(a.in[0], a.out, YSL, gate, (const int*)(ws + OFF_EPOS), (const LAS int*)ub, mod, gw, lane, cur);
            for (int tok = gw; tok < NTOK; tok += NGW) { FinIn nxt; const int nt = tok + NGW; const bool hn = nt < NTOK;
                float4 g1v[4], g2v[4];
                { const float* g2p = mod + (tok / SEQ) * 6144 + 5120;
#pragma unroll
                  for (int j = 0; j < 4; ++j) { g1v[j] = make_float4(0.f, 0.f, 0.f, 0.f); g2v[j] = *(const float4*)(g2p + lane * 4 + 256 * j); } }
                if (hn) final_load(a.in[0], a.out, YSL, gate, (const int*)(ws + OFF_EPOS), (const LAS int*)ub, mod, nt, lane, nxt);
                final_finish(a.out, g1v, g2v, fwv, tok, lane, cur, rp ? (float*)(ws + OFF_WG) : nullptr);
                if (hn) cur = nxt; } } }
        else for (int rp = NREP(11) - 1; rp >= 0; --rp) { FRESH_LANE; for (int tok = gw; tok < NTOK; tok += NGW) final_row(a.in[0], a.out, YSL, mod, a.in[29], gate, (const int*)(ws + OFF_EPOS), (const LAS int*)ub, tok, lane, rp ? (float*)(ws + OFF_WG) : nullptr); } }
#ifdef PROBE_SP
    if (bid == (PROBE_SP == 1 ? 104 : 0)) { const unsigned long long t0_ = __builtin_amdgcn_s_memrealtime(), sp_ = 4ull * MISC[128]; while (__builtin_amdgcn_s_memrealtime() - t0_ < sp_) __builtin_amdgcn_s_sleep(8); }
#endif
#ifdef PROBE_GC
    if (bid == 0) { const unsigned long long t0_ = __builtin_amdgcn_s_memrealtime(), sp_ = 4ull * MISC[128]; while (__builtin_amdgcn_s_memrealtime() - t0_ < sp_) __builtin_amdgcn_s_sleep(8); }
#endif
#ifdef PROBE_WW
    if (bid == 0) { const unsigned long long t0_ = __builtin_amdgcn_s_memrealtime(), sp_ = 4ull * MISC[128]; while (__builtin_amdgcn_s_memrealtime() - t0_ < sp_) __builtin_amdgcn_s_sleep(8); }
#endif
    if (PROBE_CLK >= 0 && bid == 0) { const unsigned long long t0_ = __builtin_amdgcn_s_memrealtime(), sp_ = cyc_sel * 1000ull / (rt_sel ? rt_sel : 1ull); while (__builtin_amdgcn_s_memrealtime() - t0_ < sp_) __builtin_amdgcn_s_sleep(8); }
    if (PROBE_TK >= 0) { if (PROBE_TK == 11) tstamp_sel = __builtin_amdgcn_s_memrealtime() - tstamp_prev;
        if (bid == 0) { const unsigned long long t0_ = __builtin_amdgcn_s_memrealtime(); while (__builtin_amdgcn_s_memrealtime() - t0_ < 4ull * tstamp_sel) __builtin_amdgcn_s_sleep(8); } }
#undef IN
#undef SEAM
}

#ifndef MEGA_SINGLE
#define MEGA_SINGLE 1
#endif
extern "C" void kernel_launch(void* const* d_in, const int* in_sizes, int n_in, void* d_out, int out_size, void* d_ws, size_t ws_size, hipStream_t stream) {
    static int grid = 0;
    if (grid == 0) {
        if (ws_size < WS_NEED || n_in != 30) { fprintf(stderr, "kernel_launch: workspace too small (%zu < %zu) or n_in %d != 30\n", ws_size, (size_t)WS_NEED, n_in); grid = -1; return; }
        int dev = 0, cus = 0, per_cu = 0;
        if (hipGetDevice(&dev) != hipSuccess || hipDeviceGetAttribute(&cus, hipDeviceAttributeMultiprocessorCount, dev) != hipSuccess) { grid = -1; return; }
        if (hipFuncSetAttribute((const void*)mega, hipFuncAttributeMaxDynamicSharedMemorySize, LDS_BYTES) != hipSuccess) { fprintf(stderr, "kernel_launch: hipFuncSetAttribute failed\n"); grid = -1; return; }
        if (hipOccupancyMaxActiveBlocksPerMultiprocessor(&per_cu, (const void*)mega, NTHR, LDS_BYTES) != hipSuccess || per_cu < 1) { fprintf(stderr, "kernel_launch: occupancy query says %d blocks per CU\n", per_cu); per_cu = 1; }
        (void)hipGetLastError();
        grid = cus;
    }
    if (grid < 0) return;
    (void)hipMemsetAsync((char*)d_ws + OFF_CTL, 0, 64 * 1024, stream);
    MArgs a{};
    for (int i = 0; i < 30; ++i) a.in[i] = (const float*)d_in[i];
    a.out = (float*)d_out; a.ws = (unsigned char*)d_ws;
#if MEGA_SINGLE
    a.ph_lo = 0; a.ph_hi = NPH;
    { void* args[] = {&a}; hipError_t e = hipLaunchCooperativeKernel((const void*)mega, dim3(grid), dim3(NTHR), args, LDS_BYTES, stream);
      if (e != hipSuccess) fprintf(stderr, "kernel_launch: cooperative launch failed: %s (grid %d)\n", hipGetErrorString(e), grid); }
#else
    for (int p = 0; p < NPH; ++p) { a.ph_lo = p; a.ph_hi = p + 1; hipLaunchKernelGGL(mega, dim3(grid), dim3(NTHR), LDS_BYTES, stream, a); }
#endif
}
```
